# Optimizing an MI355X kernel written in HIP

```python
import math
import jax, jax.numpy as jnp
from jax import lax
import numpy as np

D_MODEL = 4096
BATCH = 1
SEQ = 16384
DEPTH = 1

HEAD_DIM = 128
DSA_HEADS = 16
DSA_KV_HEADS = 4
IDX_HEADS = 32
IDX_DIM = 64
DSA_TOPK = 256
NSA_HEADS = 16
NSA_KV_HEADS = 4
CMP_LEN = 32
CMP_STRIDE = 16
CMP_HIDDEN = 256
SLC_LEN = 64
SLC_TOP = 16
WIN = 512
FORCE_SCORE = 1e9
PEER_HEADS = 8
PEER_NKEYS = 128
PEER_QDIM = 256
PEER_TOPK = 16
N_EXPERTS = PEER_NKEYS * PEER_NKEYS
REL_BUCKETS = 32
REL_MAX_DIST = 2048
N_ATTN_HEADS = DSA_HEADS + NSA_HEADS
QBLK = 128
EPS = 1e-6
IN_SPLITS = (DSA_HEADS * HEAD_DIM, DSA_KV_HEADS * HEAD_DIM, DSA_KV_HEADS * HEAD_DIM,
             IDX_HEADS * IDX_DIM, IDX_DIM, IDX_HEADS,
             NSA_HEADS * HEAD_DIM, 6 * NSA_KV_HEADS * HEAD_DIM, 3 * NSA_HEADS,
             2 * D_MODEL)
IN_COLS = sum(IN_SPLITS)

kernel_name = 'hybrid_dsa_nsa_peer_block'


def rms_norm(x, g):
    xf = x.astype(jnp.float32)
    y = xf * lax.rsqrt(jnp.mean(xf * xf, axis=-1, keepdims=True) + EPS)
    return (y * g.astype(jnp.float32)).astype(x.dtype)


def rel_bucket(dist):
    n = jnp.maximum(dist, 0)
    exact = REL_BUCKETS // 2
    nf = jnp.maximum(n, 1).astype(jnp.float32)
    log_b = exact + (jnp.log(nf / exact) / math.log(REL_MAX_DIST / exact) * (REL_BUCKETS - exact)).astype(jnp.int32)
    return jnp.where(n < exact, n, jnp.minimum(log_b, REL_BUCKETS - 1))


def masked_softmax(logits, mask):
    s = jnp.where(mask, logits.astype(jnp.float32), -jnp.inf)
    m = jnp.max(s, axis=-1, keepdims=True)
    m = jnp.where(jnp.isfinite(m), m, 0.0)
    e = jnp.exp(s - m)
    return e / jnp.maximum(jnp.sum(e, axis=-1, keepdims=True), 1e-30)


def map_blocks(fn, n_tokens):
    nb = n_tokens // QBLK
    out = lax.map(fn, jnp.arange(nb) * QBLK)
    out = jnp.moveaxis(out, 0, 1)
    return out.reshape(out.shape[0], nb * QBLK, *out.shape[3:])


def dsa_mixer(q, k, v, qi, ki, wi, table):
    B, T, H, dh = q.shape
    G = k.shape[2]
    R = H // G
    n_top = min(DSA_TOPK, T // 4)
    key_pos = jnp.arange(T)
    scale = dh ** -0.5
    wi = wi * IDX_HEADS ** -0.5

    def block(q0):
        tq = q0 + jnp.arange(QBLK)
        qi_b = lax.dynamic_slice_in_dim(qi, q0, QBLK, axis=1)
        wi_b = lax.dynamic_slice_in_dim(wi, q0, QBLK, axis=1)
        s = jnp.einsum('bqhd,bkd->bqhk', qi_b, ki) * IDX_DIM ** -0.5
        score = jnp.einsum('bqhk,bqh->bqk', jax.nn.relu(s), wi_b).astype(jnp.float32)
        score = jnp.where((key_pos[None, :] <= tq[:, None])[None], score, -jnp.inf)
        _, idx = lax.top_k(score, n_top)
        valid = idx <= tq[None, :, None]
        k_sel = jax.vmap(lambda a, i: a[i])(k, idx)
        v_sel = jax.vmap(lambda a, i: a[i])(v, idx)
        q_b = lax.dynamic_slice_in_dim(q, q0, QBLK, axis=1).reshape(B, QBLK, G, R, dh)
        logits = jnp.einsum('bqgrd,bqkgd->bqgrk', q_b, k_sel).astype(jnp.float32) * scale
        bias = table[rel_bucket(tq[None, :, None] - idx)]
        bias = jnp.moveaxis(bias.reshape(B, QBLK, n_top, G, R), 2, -1)
        p = masked_softmax(logits + bias, valid[:, :, None, None, :])
        o = jnp.einsum('bqgrk,bqkgd->bqgrd', p.astype(v.dtype), v_sel)
        return o.reshape(B, QBLK, H * dh)

    return map_blocks(block, T)


def compress_blocks(x, pe, w1, w2):
    T = x.shape[1]
    n_cmp = (T - CMP_LEN) // CMP_STRIDE + 1
    pos = (jnp.arange(n_cmp) * CMP_STRIDE)[:, None] + jnp.arange(CMP_LEN)[None, :]
    blk = x[:, pos] + pe[None, None, :, None, :]
    hid = jax.nn.gelu(jnp.einsum('bnlgd,lde->bnge', blk, w1))
    return jnp.einsum('bnge,ed->bngd', hid, w2)


def nsa_mixer(q, k_cmp, v_cmp, ks, vs, kw, vw, gates, table):
    B, T, H, dh = q.shape
    G = ks.shape[2]
    R = H // G
    n_cmp = k_cmp.shape[1]
    n_slc = T // SLC_LEN
    n_sel = min(SLC_TOP, n_slc)
    scale = dh ** -0.5
    cmp_end = jnp.arange(n_cmp) * CMP_STRIDE + CMP_LEN - 1
    c_start = jnp.arange(n_cmp)[:, None] * CMP_STRIDE
    s_start = jnp.arange(n_slc)[None, :] * SLC_LEN
    overlap = ((c_start < s_start + SLC_LEN) & (c_start + CMP_LEN > s_start)).astype(jnp.float32)
    tbl = table.reshape(REL_BUCKETS, G, R)
    ks_blk = jnp.moveaxis(ks.reshape(B, n_slc, SLC_LEN, G, dh), 3, 1)
    vs_blk = jnp.moveaxis(vs.reshape(B, n_slc, SLC_LEN, G, dh), 3, 1)
    kw_pad = jnp.pad(kw, ((0, 0), (WIN, 0), (0, 0), (0, 0)))
    vw_pad = jnp.pad(vw, ((0, 0), (WIN, 0), (0, 0), (0, 0)))
    b_idx = jnp.arange(B)[:, None, None, None]
    g_idx = jnp.arange(G)[None, None, :, None]
    blk_id = jnp.arange(n_slc)

    def block(q0):
        tq = q0 + jnp.arange(QBLK)
        q_b = lax.dynamic_slice_in_dim(q, q0, QBLK, axis=1).reshape(B, QBLK, G, R, dh)
        lc = jnp.einsum('bqgrd,bngd->bqgrn', q_b, k_cmp).astype(jnp.float32) * scale
        dist_c = tq[:, None] - cmp_end[None, :]
        lc = lc + jnp.transpose(tbl[rel_bucket(dist_c)], (0, 2, 3, 1))
        pc = masked_softmax(lc, (dist_c >= 0)[:, None, None, :])
        o_c = jnp.einsum('bqgrn,bngd->bqgrd', pc.astype(v_cmp.dtype), v_cmp)
        imp = jnp.einsum('bqgn,nm->bqgm', pc.sum(axis=3), overlap)
        cur = tq // SLC_LEN
        forced = (blk_id[None, :] == 0) | (blk_id[None, :] == cur[:, None]) | (blk_id[None, :] == cur[:, None] - 1)
        admissible = blk_id[None, :] * SLC_LEN <= tq[:, None]
        imp = jnp.where(forced[None, :, None, :], FORCE_SCORE, imp)
        imp = jnp.where(admissible[None, :, None, :], imp, -jnp.inf)
        _, sel = lax.top_k(imp, n_sel)
        k_sel = ks_blk[b_idx, g_idx, sel]
        v_sel = vs_blk[b_idx, g_idx, sel]
        pos = sel[..., None] * SLC_LEN + jnp.arange(SLC_LEN)
        dist_s = tq[None, :, None, None, None] - pos
        ls = jnp.einsum('bqgrd,bqgnld->bqgrnl', q_b, k_sel).astype(jnp.float32) * scale
        bias_s = tbl[rel_bucket(dist_s), g_idx[..., None]]
        ls = (ls + jnp.moveaxis(bias_s, -1, 3)).reshape(B, QBLK, G, R, n_sel * SLC_LEN)
        ps = masked_softmax(ls, (dist_s >= 0).reshape(B, QBLK, G, 1, n_sel * SLC_LEN))
        o_s = jnp.einsum('bqgrk,bqgkd->bqgrd', ps.astype(vs.dtype), v_sel.reshape(B, QBLK, G, n_sel * SLC_LEN, dh))
        kw_b = lax.dynamic_slice_in_dim(kw_pad, q0, WIN + QBLK, axis=1)
        vw_b = lax.dynamic_slice_in_dim(vw_pad, q0, WIN + QBLK, axis=1)
        kpos = q0 - WIN + jnp.arange(WIN + QBLK)
        dist_w = tq[:, None] - kpos[None, :]
        mask_w = (dist_w >= 0) & (dist_w < WIN) & (kpos[None, :] >= 0)
        lw = jnp.einsum('bqgrd,bkgd->bqgrk', q_b, kw_b).astype(jnp.float32) * scale
        lw = lw + jnp.transpose(tbl[rel_bucket(dist_w)], (0, 2, 3, 1))
        pw = masked_softmax(lw, mask_w[:, None, None, :])
        o_w = jnp.einsum('bqgrk,bkgd->bqgrd', pw.astype(vw.dtype), vw_b)
        g_b = jax.nn.sigmoid(lax.dynamic_slice_in_dim(gates, q0, QBLK, axis=1).astype(jnp.float32)).reshape(B, QBLK, G, R, 3)
        o = g_b[..., 0:1] * o_c + g_b[..., 1:2] * o_s + g_b[..., 2:3] * o_w
        return o.astype(q.dtype).reshape(B, QBLK, H * dh)

    return map_blocks(block, T)


def token_mixer(h, table, w_in, gq_a, gk_a, gq_b, gk_cmp, gk_slc, gk_win, cmp_pe_k, cmp_w1_k, cmp_w2_k,
                cmp_pe_v, cmp_w1_v, cmp_w2_v, w_branch_a, w_branch_b, w_out):
    B, T, _ = h.shape
    proj = h @ w_in
    offs = [int(o) for o in np.cumsum(IN_SPLITS)[:-1]]
    qa, ka, va, qi, ki, wi, qb, kvb, gb, gm = jnp.split(proj, offs, axis=-1)
    qa = rms_norm(qa.reshape(B, T, DSA_HEADS, HEAD_DIM), gq_a)
    ka = rms_norm(ka.reshape(B, T, DSA_KV_HEADS, HEAD_DIM), gk_a)
    va = va.reshape(B, T, DSA_KV_HEADS, HEAD_DIM)
    y_a = dsa_mixer(qa, ka, va, qi.reshape(B, T, IDX_HEADS, IDX_DIM), ki, wi, table[:, :DSA_HEADS])
    qb = rms_norm(qb.reshape(B, T, NSA_HEADS, HEAD_DIM), gq_b)
    kvb = kvb.reshape(B, T, 6, NSA_KV_HEADS, HEAD_DIM)
    k_cmp = rms_norm(compress_blocks(kvb[:, :, 0], cmp_pe_k, cmp_w1_k, cmp_w2_k), gk_cmp)
    v_cmp = compress_blocks(kvb[:, :, 1], cmp_pe_v, cmp_w1_v, cmp_w2_v)
    y_b = nsa_mixer(qb, k_cmp, v_cmp, rms_norm(kvb[:, :, 2], gk_slc), kvb[:, :, 3],
                    rms_norm(kvb[:, :, 4], gk_win), kvb[:, :, 5], gb, table[:, DSA_HEADS:])
    g_a, g_b = jnp.split(jax.nn.sigmoid(gm), 2, axis=-1)
    merged = g_a * (y_a @ w_branch_a) + g_b * (y_b @ w_branch_b)
    return merged @ w_out


def peer_ffn(h, w_q, sub_keys, u, v):
    B, T, _ = h.shape
    q = (h @ w_q).reshape(B, T, PEER_HEADS, 2, PEER_QDIM // 2)
    s = jnp.einsum('bthcd,hcnd->bthcn', q, sub_keys).astype(jnp.float32)
    s1, i1 = lax.top_k(s[..., 0, :], PEER_TOPK)
    s2, i2 = lax.top_k(s[..., 1, :], PEER_TOPK)
    cand = (s1[..., :, None] + s2[..., None, :]).reshape(B, T, PEER_HEADS, PEER_TOPK * PEER_TOPK)
    cand_id = (i1[..., :, None] * PEER_NKEYS + i2[..., None, :]).reshape(B, T, PEER_HEADS, PEER_TOPK * PEER_TOPK)
    top_s, top_pos = lax.top_k(cand, PEER_TOPK)
    expert = jnp.take_along_axis(cand_id, top_pos, axis=-1).reshape(B, T, PEER_HEADS * PEER_TOPK)
    gate = jax.nn.softmax(top_s, axis=-1).reshape(B, T, PEER_HEADS * PEER_TOPK)

    def block(t0):
        h_b = lax.dynamic_slice_in_dim(h, t0, QBLK, axis=1)
        e_b = lax.dynamic_slice_in_dim(expert, t0, QBLK, axis=1)
        g_b = lax.dynamic_slice_in_dim(gate, t0, QBLK, axis=1)
        a = jnp.einsum('bqkd,bqd->bqk', u[e_b], h_b).astype(jnp.float32)
        act = (jax.nn.gelu(a) * g_b).astype(h.dtype)
        return jnp.einsum('bqk,bqkd->bqd', act, v[e_b])

    return map_blocks(block, T)


def setup_inputs(seed: int = 0) -> dict:
    key = jax.random.key(seed)
    ks = jax.random.split(key, 32)
    D, dh, L = D_MODEL, HEAD_DIM, DEPTH

    def nrm(k, shape, scale):
        return jax.random.normal(k, shape, jnp.float32) * scale

    return {
        'x': nrm(ks[0], (BATCH, SEQ, D), 1.0),
        'c': nrm(ks[1], (BATCH, D), 1.0),
        'rel_bias': nrm(ks[2], (REL_BUCKETS, N_ATTN_HEADS), 0.5),
        'w_ada': nrm(ks[3], (L, D, 6 * D), 0.5 * D ** -0.5),
        'b_ada': nrm(ks[4], (L, 6 * D), 0.02),
        'g_mix': 1.0 + nrm(ks[5], (L, D), 0.02),
        'w_in': nrm(ks[6], (L, D, IN_COLS), D ** -0.5),
        'gq_a': 1.0 + nrm(ks[7], (L, dh), 0.02),
        'gk_a': 1.0 + nrm(ks[8], (L, dh), 0.02),
        'gq_b': 1.0 + nrm(ks[9], (L, dh), 0.02),
        'gk_cmp': 1.0 + nrm(ks[10], (L, dh), 0.02),
        'gk_slc': 1.0 + nrm(ks[11], (L, dh), 0.02),
        'gk_win': 1.0 + nrm(ks[12], (L, dh), 0.02),
        'cmp_pe_k': nrm(ks[13], (L, CMP_LEN, dh), 0.1),
        'cmp_w1_k': nrm(ks[14], (L, CMP_LEN, dh, CMP_HIDDEN), (CMP_LEN * dh) ** -0.5),
        'cmp_w2_k': nrm(ks[15], (L, CMP_HIDDEN, dh), CMP_HIDDEN ** -0.5),
        'cmp_pe_v': nrm(ks[16], (L, CMP_LEN, dh), 0.1),
        'cmp_w1_v': nrm(ks[17], (L, CMP_LEN, dh, CMP_HIDDEN), (CMP_LEN * dh) ** -0.5),
        'cmp_w2_v': nrm(ks[18], (L, CMP_HIDDEN, dh), CMP_HIDDEN ** -0.5),
        'w_branch_a': nrm(ks[19], (L, DSA_HEADS * dh, D), (DSA_HEADS * dh) ** -0.5),
        'w_branch_b': nrm(ks[20], (L, NSA_HEADS * dh, D), (NSA_HEADS * dh) ** -0.5),
        'w_out': nrm(ks[21], (L, D, D), D ** -0.5),
        'g_ffn': 1.0 + nrm(ks[22], (L, D), 0.02),
        'w_peer_q': nrm(ks[23], (L, D, PEER_HEADS * PEER_QDIM), D ** -0.5),
        'peer_sub_keys': nrm(ks[24], (L, PEER_HEADS, 2, PEER_NKEYS, PEER_QDIM // 2), (PEER_QDIM // 2) ** -0.5),
        'peer_u': nrm(ks[25], (L, N_EXPERTS, D), D ** -0.5),
        'peer_v': nrm(ks[26], (L, N_EXPERTS, D), 0.2),
    }


def reference(x, c, rel_bias, w_ada, b_ada, g_mix, w_in, gq_a, gk_a, gq_b, gk_cmp, gk_slc, gk_win,
              cmp_pe_k, cmp_w1_k, cmp_w2_k, cmp_pe_v, cmp_w1_v, cmp_w2_v, w_branch_a, w_branch_b, w_out,
              g_ffn, w_peer_q, peer_sub_keys, peer_u, peer_v):
    for i in range(DEPTH):
        mod = (c @ w_ada[i] + b_ada[i])[:, None, :]
        sh1, sc1, gt1, sh2, sc2, gt2 = jnp.split(mod, 6, axis=-1)
        h = rms_norm(x, g_mix[i]) * (1 + sc1) + sh1
        x = x + gt1 * token_mixer(h, rel_bias, w_in[i], gq_a[i], gk_a[i], gq_b[i], gk_cmp[i], gk_slc[i], gk_win[i],
                                  cmp_pe_k[i], cmp_w1_k[i], cmp_w2_k[i], cmp_pe_v[i], cmp_w1_v[i], cmp_w2_v[i],
                                  w_branch_a[i], w_branch_b[i], w_out[i])
        h = rms_norm(x, g_ffn[i]) * (1 + sc2) + sh2
        x = x + gt2 * peer_ffn(h, w_peer_q[i], peer_sub_keys[i], peer_u[i], peer_v[i])
    return x
```

```cpp
#include <hip/hip_runtime.h>
#include <cstdio>
#include <cstdint>

#define LAS __attribute__((address_space(3)))
typedef unsigned short bf16_t;
typedef unsigned long long u64;
typedef short bf16x8 __attribute__((ext_vector_type(8)));
typedef float f32x4 __attribute__((ext_vector_type(4)));
typedef float f32x16 __attribute__((ext_vector_type(16)));
typedef unsigned u32x4 __attribute__((ext_vector_type(4)));
typedef unsigned u32x2 __attribute__((ext_vector_type(2)));
typedef __bf16 bf2_t __attribute__((ext_vector_type(2)));
typedef float f32x2 __attribute__((ext_vector_type(2)));
typedef float f32x32 __attribute__((ext_vector_type(32)));
typedef unsigned u32x6 __attribute__((ext_vector_type(6)));

constexpr int T = 16384, D = 4096, NP = 18688;
constexpr int P_QA = 0, P_KA = 2048, P_VA = 2560, P_QI = 3072, P_QB = 5120, P_KC = 7168, P_VC = 7680, P_KS = 8192, P_VS = 8704,
              P_KW = 9216, P_VW = 9728, P_KI = 10240, P_WI = 10304, P_GB = 10336, P_GM = 10496;
constexpr int NP_BF = 10496, NP_F8 = 8192;
constexpr int NCMP = 1023;
constexpr float EPS = 1e-6f;
constexpr int NTHREADS = 512;
constexpr int LDS_BYTES = 160 * 1024;

constexpr size_t MB = 1024ull * 1024ull;
constexpr size_t WS_CTL = 0;
constexpr size_t WS_MOD = 64 * 1024;
constexpr size_t WS_B1 = 192 * 1024;
constexpr size_t WS_B1P = 196 * 1024;
constexpr size_t WS_W1T = 512 * 1024;
constexpr size_t WS_SUBK = WS_W1T + 4 * MB;
constexpr size_t WS_HID = WS_SUBK + 512 * 1024;
constexpr size_t WS_KCMP = WS_HID + 8 * MB;
constexpr size_t WS_VCMPT = WS_KCMP + 1 * MB;
constexpr size_t WS_KIC = WS_VCMPT + 1 * MB;
constexpr size_t WS_KC = WS_KIC + 2 * MB;
constexpr size_t WS_VST = WS_KC + 32 * MB + 64 * 1024;
constexpr size_t WS_VWT = WS_VST + 16 * MB;
constexpr size_t WS_WBA = WS_VWT + 16 * MB;
constexpr size_t WS_WBB = WS_WBA + 16 * MB;
constexpr size_t WS_WOUT = WS_WBB + 16 * MB;
constexpr size_t WS_WQ = WS_WOUT + 32 * MB;
constexpr size_t WS_PU = WS_WQ + 16 * MB;
constexpr size_t WS_PV = WS_PU + 128 * MB;
constexpr size_t WS_PU4 = WS_PU + 56 * MB, WS_PV4 = WS_PV + 56 * MB;
constexpr size_t WS_PROJ = WS_PV + 128 * MB;
constexpr size_t WS_WIN = WS_PROJ + (size_t)T * NP * 2;
constexpr size_t WS_H = WS_WIN + (size_t)NP * D * 2;
constexpr size_t WS_KA = WS_H + 128 * MB;
constexpr size_t WS_VA = WS_KA + 16 * MB;
constexpr size_t WS_KSC = WS_VA + 16 * MB;
constexpr size_t WS_KWC = WS_KSC + 16 * MB;
constexpr size_t WS_HIDP = WS_KWC + 16 * MB;
constexpr size_t WS_OACC = WS_HIDP + 64 * MB;
constexpr size_t WS_H8 = WS_OACC + 32 * MB;
constexpr size_t WS_END = WS_H8 + 64 * MB;
constexpr size_t WS_WIN8 = WS_WIN + (size_t)NP_BF * D * 2;
constexpr size_t WS_YA = WS_WIN, WS_YB = WS_WIN + 64 * MB, WS_H2 = WS_WIN;
constexpr size_t WS_MERGED = WS_H, WS_PQ = WS_H;
constexpr size_t CTL_BAR = 0, CTL_CNT = 16384;

__device__ __forceinline__ float bf2f(bf16_t b) { return __uint_as_float(((unsigned)b) << 16); }
__device__ __forceinline__ float bflo(unsigned u) { return __uint_as_float(u << 16); }
__device__ __forceinline__ float bfhi(unsigned u) { return __uint_as_float(u & 0xFFFF0000u); }
__device__ __forceinline__ unsigned cvt_pk_bf16(float lo, float hi) { unsigned r; asm volatile("v_cvt_pk_bf16_f32 %0, %1, %2" : "=v"(r) : "v"(lo), "v"(hi)); return r; }
__device__ __forceinline__ bf16_t f2bf(float f) { return (bf16_t)(cvt_pk_bf16(f, 0.f) & 0xFFFFu); }
__device__ __forceinline__ float dot2bf(unsigned a, unsigned b, float c) { return __builtin_amdgcn_fdot2_f32_bf16(__builtin_bit_cast(bf2_t, a), __builtin_bit_cast(bf2_t, b), c, false); }
template <int CTRL> __device__ __forceinline__ float dppf(float v) { return __builtin_bit_cast(float, __builtin_amdgcn_update_dpp(0, __builtin_bit_cast(int, v), CTRL, 0xF, 0xF, true)); }
template <int CTRL> __device__ __forceinline__ unsigned dppu(unsigned v) { return (unsigned)__builtin_amdgcn_update_dpp(0, (int)v, CTRL, 0xF, 0xF, true); }
__device__ __forceinline__ void swap32f(float& a, float& b) { asm volatile("s_nop 1\n\tv_permlane32_swap_b32 %0, %1" : "+v"(a), "+v"(b)); }
__device__ __forceinline__ void swap16f(float& a, float& b) { asm volatile("s_nop 1\n\tv_permlane16_swap_b32 %0, %1" : "+v"(a), "+v"(b)); }
__device__ __forceinline__ void swap32u(unsigned& a, unsigned& b) { asm volatile("s_nop 1\n\tv_permlane32_swap_b32 %0, %1" : "+v"(a), "+v"(b)); }
__device__ __forceinline__ void swap16u(unsigned& a, unsigned& b) { asm volatile("s_nop 1\n\tv_permlane16_swap_b32 %0, %1" : "+v"(a), "+v"(b)); }
__device__ __forceinline__ float fmax_fast(float a, float b) { float r; asm("v_max_f32 %0, %1, %2" : "=v"(r) : "v"(a), "v"(b)); return r; }
__device__ __forceinline__ float xsum32(float v) { float a = v, b = v; swap32f(a, b); return a + b; }
__device__ __forceinline__ float xsum16(float v) { float a = v, b = v; swap16f(a, b); return a + b; }
__device__ __forceinline__ float xmax32(float v) { float a = v, b = v; swap32f(a, b); return fmax_fast(a, b); }
__device__ __forceinline__ float xmax16(float v) { float a = v, b = v; swap16f(a, b); return fmax_fast(a, b); }
__device__ __forceinline__ float xor32f(float v, int h) { float a = v, b = v; swap32f(a, b); return h ? a : b; }
__device__ __forceinline__ float wave_sum(float v) { v += dppf<0xB1>(v); v += dppf<0x4E>(v); v += dppf<0x141>(v); v += dppf<0x140>(v); return xsum16(xsum32(v)); }
__device__ __forceinline__ float wave_max(float v) { v = fmax_fast(v, dppf<0xB1>(v)); v = fmax_fast(v, dppf<0x4E>(v)); v = fmax_fast(v, dppf<0x141>(v)); v = fmax_fast(v, dppf<0x140>(v)); return xmax16(xmax32(v)); }
__device__ __forceinline__ unsigned umaxu(unsigned a, unsigned b) { return a > b ? a : b; }
__device__ __forceinline__ unsigned wave_maxu(unsigned v) { v = umaxu(v, dppu<0xB1>(v)); v = umaxu(v, dppu<0x4E>(v)); v = umaxu(v, dppu<0x141>(v)); v = umaxu(v, dppu<0x140>(v));
    unsigned a = v, b = v; swap32u(a, b); v = umaxu(a, b); a = v; b = v; swap16u(a, b); return umaxu(a, b); }
__device__ __forceinline__ void lds_sync() { asm volatile("s_waitcnt lgkmcnt(0)" ::: "memory"); __builtin_amdgcn_wave_barrier(); }
__device__ __forceinline__ float gelu_tanh(float x) { const float u = 0.7978845608028654f * (x + 0.044715f * x * x * x); const float e = __expf(2.f * u); return 0.5f * x * (2.f - 2.f / (e + 1.f)); }
__device__ __forceinline__ float sigmoidf_(float x) { return __builtin_amdgcn_rcpf(1.f + __expf(-x)); }
__device__ __forceinline__ unsigned sortable(float s) { unsigned b = __float_as_uint(s); return b ^ ((b >> 31) ? 0xFFFFFFFFu : 0x80000000u); }

#define XB_TMO      128
#define XB_XCNT(j)  (256  + 64 * (j))
#define XB_XSUB(j)  (1280 + 64 * (j))
#define XB_XGEN(j)  (2304 + 64 * (j))
#define XB_TOP      3328
#define XB_TOPGEN   3392
#define XCD_BAR_WORDS 3456
#define XB_SPIN_CAP (1u << 24)
__device__ __forceinline__ unsigned xb_ld(unsigned* p)              { return __hip_atomic_load(p, __ATOMIC_RELAXED, __HIP_MEMORY_SCOPE_AGENT); }
__device__ __forceinline__ unsigned xb_add(unsigned* p, unsigned v) { return __hip_atomic_fetch_add(p, v, __ATOMIC_RELAXED, __HIP_MEMORY_SCOPE_AGENT); }
__device__ __forceinline__ unsigned xb_xcc_id() { return (unsigned)__builtin_amdgcn_s_getreg((3 << 11) | 20) & 0xFu; }
#define XB_SPIN(cond, bar) do { unsigned _sp = 0; while (cond) { __builtin_amdgcn_s_sleep(1); \
    if ((++_sp & 255u) == 0u) { if (xb_ld(&(bar)[XB_TMO])) break; if (_sp > XB_SPIN_CAP) { atomicAdd(&(bar)[XB_TMO], 1u); break; } } } } while (0)
struct XcdBarrier { unsigned* bar; unsigned x; volatile LAS unsigned* st; };
__device__ __forceinline__ XcdBarrier xcd_barrier_post(unsigned* bar, volatile LAS unsigned* st) {
    XcdBarrier b; b.bar = bar; b.x = xb_xcc_id(); b.st = st;
    if (threadIdx.x == 0) (void)xb_add(&bar[XB_XCNT(b.x)], 1u);
    return b;
}
__device__ __forceinline__ void xcd_barrier_complete(unsigned* bar, unsigned x, unsigned& nloc, unsigned& nx) {
    const unsigned G = gridDim.x * gridDim.y * gridDim.z;
    unsigned sum, cnt, mine, sp = 0u;
    for (;;) {
        sum = 0u; cnt = 0u; mine = 0u;
#pragma unroll
        for (unsigned j = 0; j < 16; ++j) { const unsigned c = xb_ld(&bar[XB_XCNT(j)]); sum += c; cnt += (c > 0u) ? 1u : 0u; mine = (j == x) ? c : mine; }
        if (sum == G) break;
        __builtin_amdgcn_s_sleep(1);
        if ((++sp & 255u) == 0u) { if (xb_ld(&bar[XB_TMO])) break; if (sp > XB_SPIN_CAP) { atomicAdd(&bar[XB_TMO], 1u); break; } }
    }
    nloc = mine > 0u ? mine : 1u; nx = cnt > 0u ? cnt : 1u;
}
__device__ __forceinline__ void xcd_barrier(const XcdBarrier& b) {
    asm volatile("s_waitcnt vmcnt(0)" ::: "memory");
    __syncthreads();
    if (threadIdx.x == 0) {
        unsigned* bar = b.bar;
        __builtin_amdgcn_s_waitcnt(0);
        unsigned nloc = b.st[0], nx = b.st[1];
        if (nloc == 0u) { xcd_barrier_complete(bar, b.x, nloc, nx); b.st[0] = nloc; b.st[1] = nx; }
        const unsigned old = xb_add(&bar[XB_XSUB(b.x)], 1u);
        const unsigned gen = old / nloc;
        if (old + 1u == (gen + 1u) * nloc) {
            __builtin_amdgcn_fence(__ATOMIC_RELEASE, "agent");
            asm volatile("s_waitcnt vmcnt(0)" ::: "memory");
            const unsigned og = xb_add(&bar[XB_TOP], 1u);
            const unsigned tg = og / nx;
            if (og + 1u == (tg + 1u) * nx) xb_add(&bar[XB_TOPGEN], 1u);
            else XB_SPIN(xb_ld(&bar[XB_TOPGEN]) == tg, bar);
            __builtin_amdgcn_fence(__ATOMIC_ACQUIRE, "agent");
            xb_add(&bar[XB_XGEN(b.x)], 1u);
            asm volatile("s_waitcnt vmcnt(0)" ::: "memory");
        } else {
            XB_SPIN(xb_ld(&bar[XB_XGEN(b.x)]) == gen, bar);
            __builtin_amdgcn_fence(__ATOMIC_ACQUIRE, "agent");
            asm volatile("s_waitcnt vmcnt(0)" ::: "memory");
        }
    }
    __syncthreads();
}

namespace pg8 {
constexpr int BM = 256, BK = 64, HALF = 128, HTB = HALF * BK * 2, STAGE_BYTES = 8 * HTB, NXCD = 8, WGM = 8;
__host__ __device__ __forceinline__ int lds_byte(int r, int c) { const int st = (r >> 4) * 2 + (c >> 5), rr = r & 15, cc = c & 31, ob = rr * 64 + cc * 2; return st * 1024 + (ob ^ (((ob >> 9) & 1) << 5)); }
__host__ __device__ __forceinline__ void stage_rc(int b, int& R, int& C) { const int st = b / 1024, sb = b % 1024, swz = sb ^ (((sb >> 9) & 1) << 5); R = (st >> 1) * 16 + swz / 64; C = (st & 1) * 32 + (swz % 64) / 2; }
__host__ __device__ __forceinline__ int perm32(int rho) { const int n = rho >> 4, i = rho & 15; return 8 * (i >> 2) + 4 * n + (i & 3); }
struct Unit { int pm, pn, kofs; };
struct Gemm { const bf16_t* A; const bf16_t* Bt; int M, N, K, lda, ldb; };
struct StaticOrder {
    int nM, nN, nwg, G, c;
    __host__ __device__ void init(int M, int N, int G_, int c_) { nM = M / BM; nN = N / BM; nwg = nM * nN; G = G_; c = c_; }
    __host__ __device__ bool next(int i, Unit& u) const {
        const long L = (long)i * G + c; if (L >= nwg) return false;
        int wgid = (int)L; { const int q = nwg / NXCD, r = nwg % NXCD, xcd = wgid % NXCD, off = wgid / NXCD; wgid = (xcd < r ? xcd * (q + 1) : r * (q + 1) + (xcd - r) * q) + off; }
        const int nig = WGM * nN, gid = wgid / nig, fm = gid * WGM, gsz = (nM - fm) < WGM ? (nM - fm) : WGM;
        u.pm = fm + ((wgid % nig) % gsz); u.pn = (wgid % nig) / gsz; u.kofs = 0; return true;
    }
};
struct Fp8Order {
    int c;
    __host__ __device__ bool next(int i, Unit& u) const {
        const int cnt = c < 64 ? 6 : (c < 192 ? 9 : 8); if (i >= cnt) return false;
        const int off = c < 64 ? 6 * c : (c < 192 ? 384 + 9 * (c - 64) : 1536 + 8 * (c - 192));
        const int L = off + i; u.pm = L & 63; u.pn = L >> 6; u.kofs = 0; return true; }
};
struct CmpOrder {
    int G, c;
    __host__ __device__ bool next(int i, Unit& u) const { const long L = (long)i * G + c; if (L >= 256) return false; u.pm = (int)(L & 31); u.pn = u.pm >> 4; u.kofs = (int)(L >> 5) * 512; return true; }
};

struct EpiPlain {
    static constexpr bool PERM = true;
    bf16_t* O; int ldc; float scale;
    __device__ __forceinline__ void operator()(const f32x4 (&acc)[2][2][4][2], const Unit& u, int wr, int wc, int fr, int fq) const {
        const int row0 = u.pm * BM + wr * 64 + fr, col0 = u.pn * BM + wc * 32 + 8 * fq;
#pragma unroll
        for (int ai = 0; ai < 2; ++ai)
#pragma unroll
            for (int m = 0; m < 4; ++m) { bf16_t* rowp = O + (size_t)(row0 + ai * HALF + m * 16) * ldc + col0;
#pragma unroll
                for (int bj = 0; bj < 2; ++bj) { const f32x4 v0 = acc[ai][bj][m][0] * scale, v1 = acc[ai][bj][m][1] * scale;
                    u32x4 w; w.x = cvt_pk_bf16(v0[0], v0[1]); w.y = cvt_pk_bf16(v0[2], v0[3]); w.z = cvt_pk_bf16(v1[0], v1[1]); w.w = cvt_pk_bf16(v1[2], v1[3]);
                    *(u32x4*)(rowp + bj * HALF) = w; } }
    }
};
struct EpiSigU8 {
    static constexpr bool PERM = true;
    unsigned char* O; int ldb; float scale;
    __device__ __forceinline__ void operator()(const f32x4 (&acc)[2][2][4][2], const Unit& u, int wr, int wc, int fr, int fq) const {
        const int row0 = u.pm * BM + wr * 64 + fr, col0 = u.pn * BM + wc * 32 + 8 * fq;
#pragma unroll
        for (int ai = 0; ai < 2; ++ai)
#pragma unroll
            for (int m = 0; m < 4; ++m) { unsigned char* rowp = O + (size_t)(row0 + ai * HALF + m * 16) * ldb + col0;
#pragma unroll
                for (int bj = 0; bj < 2; ++bj) { const f32x4 v0 = acc[ai][bj][m][0] * scale, v1 = acc[ai][bj][m][1] * scale;
                    unsigned w0 = 0u, w1 = 0u;
                    w0 = __builtin_amdgcn_cvt_pk_u8_f32(255.f * sigmoidf_(v0[0]), 0, w0); w0 = __builtin_amdgcn_cvt_pk_u8_f32(255.f * sigmoidf_(v0[1]), 1, w0);
                    w0 = __builtin_amdgcn_cvt_pk_u8_f32(255.f * sigmoidf_(v0[2]), 2, w0); w0 = __builtin_amdgcn_cvt_pk_u8_f32(255.f * sigmoidf_(v0[3]), 3, w0);
                    w1 = __builtin_amdgcn_cvt_pk_u8_f32(255.f * sigmoidf_(v1[0]), 0, w1); w1 = __builtin_amdgcn_cvt_pk_u8_f32(255.f * sigmoidf_(v1[1]), 1, w1);
                    w1 = __builtin_amdgcn_cvt_pk_u8_f32(255.f * sigmoidf_(v1[2]), 2, w1); w1 = __builtin_amdgcn_cvt_pk_u8_f32(255.f * sigmoidf_(v1[3]), 3, w1);
                    *(u32x2*)(rowp + bj * HALF) = (u32x2){w0, w1}; } }
    }
};
template <int SECOND> struct EpiGate {
    static constexpr bool PERM = true;
    bf16_t* O; int ldc; const unsigned char* gate; int ldg; float scale; unsigned char* O8;
    __device__ __forceinline__ void operator()(const f32x4 (&acc)[2][2][4][2], const Unit& u, int wr, int wc, int fr, int fq) const {
        const int row0 = u.pm * BM + wr * 64 + fr, col0 = u.pn * BM + wc * 32 + 8 * fq;
#pragma unroll
        for (int ai = 0; ai < 2; ++ai)
#pragma unroll
            for (int m = 0; m < 4; ++m) { const size_t row = (size_t)(row0 + ai * HALF + m * 16); bf16_t* rowp = O + row * ldc + col0; const unsigned char* gp = gate + row * ldg + col0;
#pragma unroll
                for (int bj = 0; bj < 2; ++bj) { const f32x4 v0 = acc[ai][bj][m][0] * scale, v1 = acc[ai][bj][m][1] * scale;
                    const u32x2 gv = *(const u32x2*)(gp + bj * HALF);
                    float r[8];
#pragma unroll
                    for (int e = 0; e < 4; ++e) { r[e] = (float)((gv.x >> (8 * e)) & 0xFFu) * v0[e]; r[4 + e] = (float)((gv.y >> (8 * e)) & 0xFFu) * v1[e]; }
                    if (SECOND) { const u32x4 pv = *(const u32x4*)(rowp + bj * HALF);
                        r[0] += bflo(pv.x); r[1] += bfhi(pv.x); r[2] += bflo(pv.y); r[3] += bfhi(pv.y); r[4] += bflo(pv.z); r[5] += bfhi(pv.z); r[6] += bflo(pv.w); r[7] += bfhi(pv.w);
                        int p0 = __builtin_amdgcn_cvt_pk_fp8_f32(r[0] * 32.f, r[1] * 32.f, 0, false); p0 = __builtin_amdgcn_cvt_pk_fp8_f32(r[2] * 32.f, r[3] * 32.f, p0, true);
                        int p1 = __builtin_amdgcn_cvt_pk_fp8_f32(r[4] * 32.f, r[5] * 32.f, 0, false); p1 = __builtin_amdgcn_cvt_pk_fp8_f32(r[6] * 32.f, r[7] * 32.f, p1, true);
                        *(u32x2*)(O8 + row * ldc + col0 + bj * HALF) = (u32x2){(unsigned)p0, (unsigned)p1};
                    } else {
                    u32x4 w; w.x = cvt_pk_bf16(r[0], r[1]); w.y = cvt_pk_bf16(r[2], r[3]); w.z = cvt_pk_bf16(r[4], r[5]); w.w = cvt_pk_bf16(r[6], r[7]);
                    *(u32x4*)(rowp + bj * HALF) = w; } } }
    }
};
struct EpiResid {
    static constexpr bool PERM = false;
    float* C; const float* X; const float* gt; int ldc; float scale;
    __device__ __forceinline__ void operator()(const f32x4 (&acc)[2][2][4][2], const Unit& u, int wr, int wc, int fr, int fq) const {
        const int row0 = u.pm * BM + wr * 64 + fr, col0 = u.pn * BM + wc * 32 + 4 * fq;
        f32x4 gv[2][2];
#pragma unroll
        for (int bj = 0; bj < 2; ++bj)
#pragma unroll
            for (int n = 0; n < 2; ++n) gv[bj][n] = *(const f32x4*)(gt + col0 + bj * HALF + n * 16) * scale;
#pragma unroll
        for (int ai = 0; ai < 2; ++ai)
#pragma unroll
            for (int m = 0; m < 4; ++m) { const size_t off = (size_t)(row0 + ai * HALF + m * 16) * ldc + col0;
#pragma unroll
                for (int bj = 0; bj < 2; ++bj)
#pragma unroll
                    for (int n = 0; n < 2; ++n) { const f32x4 xv = *(const f32x4*)(X + off + bj * HALF + n * 16);
                        *(f32x4*)(C + off + bj * HALF + n * 16) = xv + gv[bj][n] * acc[ai][bj][m][n]; } }
    }
};
struct EpiSlab {
    static constexpr bool PERM = false;
    float* C;
    __device__ __forceinline__ void operator()(const f32x4 (&acc)[2][2][4][2], const Unit& u, int wr, int wc, int fr, int fq) const {
        const int row0 = u.pm * BM + wr * 64 + fr, col0 = wc * 32 + 4 * fq;
        float* base = C + (size_t)(u.kofs >> 9) * 8192 * 256;
#pragma unroll
        for (int ai = 0; ai < 2; ++ai)
#pragma unroll
            for (int m = 0; m < 4; ++m) { float* rowp = base + (size_t)(row0 + ai * HALF + m * 16) * 256 + col0;
#pragma unroll
                for (int bj = 0; bj < 2; ++bj)
#pragma unroll
                    for (int n = 0; n < 2; ++n) *(f32x4*)(rowp + bj * HALF + n * 16) = acc[ai][bj][m][n]; }
    }
};

typedef int i32x8 __attribute__((ext_vector_type(8)));
template <class Epi, class Sched, bool FP8 = false>
__device__ __forceinline__ void gemm_phase(LAS unsigned char* lds, const Gemm g, const Sched& S, const Epi& E) {
    const int tid = threadIdx.x, wid = __builtin_amdgcn_readfirstlane(tid >> 6), lane = tid & 63, wr = wid >> 2, wc = wid & 3, fr = lane & 15, fq = lane >> 4;
    const int K = g.K, nt = K / BK, lda = g.lda, ldb = g.ldb;
    unsigned voffA[2], voffB[2];
#pragma unroll
    for (int i = 0; i < 2; ++i) { int R, C; stage_rc(tid * 16 + i * 8192, R, C); const int Rb = Epi::PERM ? ((R & ~31) + perm32(R & 31)) : R;
        voffA[i] = (unsigned)(R * lda + C) * 2u; voffB[i] = (unsigned)(Rb * ldb + C) * 2u; }
    const size_t kstep = (size_t)(BK * 2);
    const size_t hstepA = (size_t)HALF * lda * 2, hstepB = (size_t)HALF * ldb * 2;
    const size_t tstepA = 2 * hstepA, tstepB = 2 * hstepB;
    const unsigned ldsw = (unsigned)wid * 1024u;
    const int aoff = lds_byte(wr * 64 + fr, fq * 8), boff = lds_byte(wc * 32 + fr, fq * 8);
#define PG8_SA(b, h) (((b) * 2 + (h)) * HTB)
#define PG8_SB(b, h) ((4 + (b) * 2 + (h)) * HTB)
#define PG8_STAGE(bufoff, gbase, voff) do { _Pragma("unroll") for (int _i = 0; _i < 2; ++_i) \
        __builtin_amdgcn_global_load_lds((const unsigned*)((const char*)(gbase) + (voff)[_i]), (LAS unsigned*)(lds + (bufoff) + ldsw + _i * 8192), 16, 0, 0); } while (0)
#define PG8_LDA(dst, b, h) do { _Pragma("unroll") for (int m = 0; m < 4; ++m) { if constexpr (FP8) dst##8[m] = __builtin_shufflevector(*(const LAS i32x4_*)(lds + PG8_SA(b, h) + aoff + m * 2048), *(const LAS i32x4_*)(lds + PG8_SA(b, h) + aoff + m * 2048 + 1024), 0, 1, 2, 3, 4, 5, 6, 7); \
        else { _Pragma("unroll") for (int k = 0; k < 2; ++k) dst[m][k] = *(const LAS bf16x8*)(lds + PG8_SA(b, h) + aoff + m * 2048 + k * 1024); } } } while (0)
#define PG8_LDB(dst, b, h) do { _Pragma("unroll") for (int n = 0; n < 2; ++n) { if constexpr (FP8) dst##8[n] = __builtin_shufflevector(*(const LAS i32x4_*)(lds + PG8_SB(b, h) + boff + n * 2048), *(const LAS i32x4_*)(lds + PG8_SB(b, h) + boff + n * 2048 + 1024), 0, 1, 2, 3, 4, 5, 6, 7); \
        else { _Pragma("unroll") for (int k = 0; k < 2; ++k) dst[n][k] = *(const LAS bf16x8*)(lds + PG8_SB(b, h) + boff + n * 2048 + k * 1024); } } } while (0)
typedef int i32x4_ __attribute__((ext_vector_type(4)));
#define PG8_MMA(ai, bj, At, Bt) do { __builtin_amdgcn_s_setprio(1); _Pragma("unroll") for (int m = 0; m < 4; ++m) _Pragma("unroll") for (int n = 0; n < 2; ++n) { \
        if constexpr (FP8) asm volatile("v_mfma_scale_f32_16x16x128_f8f6f4 %0, %1, %2, %0, %3, %3 op_sel_hi:[0,0,0]" : "+v"(acc[ai][bj][m][n]) : "v"(Bt##8[n]), "v"(At##8[m]), "v"(one_scale)); \
        else { _Pragma("unroll") for (int k = 0; k < 2; ++k) acc[ai][bj][m][n] = __builtin_amdgcn_mfma_f32_16x16x32_bf16(Bt[n][k], At[m][k], acc[ai][bj][m][n], 0, 0, 0); } } \
        __builtin_amdgcn_s_setprio(0); } while (0)
#define PG8_WAIT_V(n) asm volatile("s_waitcnt vmcnt(" #n ")" ::: "memory")
#define PG8_WAIT_L(n) asm volatile("s_waitcnt lgkmcnt(" #n ")" ::: "memory")
#define PG8_BAR __builtin_amdgcn_s_barrier()
#define PG8_SCHED __builtin_amdgcn_sched_barrier(0)
    Unit cur, nxt; int ui = 0;
    if (!S.next(0, cur)) return;
    f32x4 acc[2][2][4][2];
#pragma unroll
    for (int a = 0; a < 2; ++a)
#pragma unroll
        for (int b = 0; b < 2; ++b)
#pragma unroll
            for (int m = 0; m < 4; ++m)
#pragma unroll
                for (int n = 0; n < 2; ++n) acc[a][b][m][n] = (f32x4){0.f, 0.f, 0.f, 0.f};
    bf16x8 At[4][2], B0[2][2], B1[2][2];
    i32x8 At8[4], B08[2], B18[2];
    const int one_scale = 0x7F7F7F7F;
    const char* cA = (const char*)g.A + (size_t)cur.pm * tstepA + (size_t)cur.kofs * 2; const char* cB = (const char*)g.Bt + (size_t)cur.pn * tstepB + (size_t)cur.kofs * 2;
    PG8_STAGE(PG8_SB(0, 0), cB, voffB); PG8_STAGE(PG8_SB(0, 1), cB + hstepB, voffB); PG8_STAGE(PG8_SA(0, 0), cA, voffA); PG8_STAGE(PG8_SA(0, 1), cA + hstepA, voffA);
    if (wr == 1) PG8_BAR;
    PG8_WAIT_V(2); PG8_BAR;
    PG8_STAGE(PG8_SB(1, 0), cB + kstep, voffB); PG8_STAGE(PG8_SA(1, 0), cA + kstep, voffA); PG8_STAGE(PG8_SB(1, 1), cB + hstepB + kstep, voffB);
    PG8_WAIT_V(6); PG8_BAR;
    for (;;) {
        const bool has_next = S.next(ui + 1, nxt);
        const char* nA = has_next ? (const char*)g.A + (size_t)nxt.pm * tstepA + (size_t)nxt.kofs * 2 : cA; const char* nB = has_next ? (const char*)g.Bt + (size_t)nxt.pn * tstepB + (size_t)nxt.kofs * 2 : cB;
        for (int t = 0; t < nt; t += 2) {
            const bool last = (t == nt - 2);
            const char* a1 = cA + (size_t)(t + 1) * kstep;
            const char* a2 = last ? nA : cA + (size_t)(t + 2) * kstep; const char* b2 = last ? nB : cB + (size_t)(t + 2) * kstep;
            const char* a3 = a2 + kstep; const char* b3 = b2 + kstep;
            PG8_LDB(B0, 0, 0); PG8_LDB(B1, 0, 1); PG8_SCHED; PG8_LDA(At, 0, 0); PG8_STAGE(PG8_SA(1, 1), a1 + hstepA, voffA);
            PG8_WAIT_V(8); PG8_WAIT_L(0); PG8_BAR; PG8_MMA(0, 0, At, B0); PG8_MMA(0, 1, At, B1); PG8_BAR; PG8_SCHED;
            PG8_LDA(At, 0, 1); PG8_STAGE(PG8_SB(0, 0), b2, voffB); PG8_STAGE(PG8_SB(0, 1), b2 + hstepB, voffB); PG8_STAGE(PG8_SA(0, 0), a2, voffA);
            PG8_WAIT_V(8); PG8_WAIT_L(0); PG8_BAR; PG8_MMA(1, 0, At, B0); PG8_MMA(1, 1, At, B1); PG8_BAR; PG8_SCHED;
            PG8_LDB(B0, 1, 0); PG8_LDB(B1, 1, 1); PG8_SCHED; PG8_LDA(At, 1, 0); PG8_STAGE(PG8_SA(0, 1), a2 + hstepA, voffA);
            PG8_WAIT_V(8); PG8_WAIT_L(0); PG8_BAR; PG8_MMA(0, 0, At, B0); PG8_MMA(0, 1, At, B1); PG8_BAR; PG8_SCHED;
            PG8_LDA(At, 1, 1); PG8_STAGE(PG8_SB(1, 0), b3, voffB); PG8_STAGE(PG8_SB(1, 1), b3 + hstepB, voffB); PG8_STAGE(PG8_SA(1, 0), a3, voffA);
            PG8_WAIT_V(8); PG8_WAIT_L(0); PG8_BAR; PG8_MMA(1, 0, At, B0); PG8_MMA(1, 1, At, B1); PG8_BAR; PG8_SCHED;
        }
        if (wr == 0) PG8_BAR;
        if constexpr (FP8) asm volatile("s_nop 15\n\ts_nop 15\n\ts_nop 15" ::: "memory");
        E(acc, cur, wr, wc, fr, fq);
        if (!has_next) break;
#pragma unroll
        for (int a = 0; a < 2; ++a)
#pragma unroll
            for (int b = 0; b < 2; ++b)
#pragma unroll
                for (int m = 0; m < 4; ++m)
#pragma unroll
                    for (int n = 0; n < 2; ++n) acc[a][b][m][n] = (f32x4){0.f, 0.f, 0.f, 0.f};
        cur = nxt; cA = nA; cB = nB; ++ui;
        if (wr == 1) PG8_BAR;
    }
    PG8_WAIT_V(0);
    PG8_BAR;
#undef PG8_SA
#undef PG8_SB
#undef PG8_STAGE
#undef PG8_LDA
#undef PG8_LDB
#undef PG8_MMA
#undef PG8_WAIT_V
#undef PG8_WAIT_L
#undef PG8_BAR
#undef PG8_SCHED
}
}

struct Args { const float* in[27]; float* out; unsigned char* ws; int ph_lo, ph_hi; };
struct Ctx { const float* const* in; float* out; unsigned char* ws; LAS unsigned char* lds; int tid, lane, wave; };

enum { I_X = 0, I_C, I_RELB, I_WADA, I_BADA, I_GMIX, I_WIN, I_GQA, I_GKA, I_GQB, I_GKCMP, I_GKSLC, I_GKWIN, I_PEK, I_W1K, I_W2K, I_PEV, I_W1V, I_W2V,
       I_WBA, I_WBB, I_WOUT, I_GFFN, I_WPQ, I_SUBK, I_PU, I_PV };

__device__ __forceinline__ int map_col(int c) {
    if (c < 5120) return c; if (c < 10240) return c + 96; if (c < 10336) return c - 5120; if (c < 10384) return c; if (c < 10496) return -1; return c - 112;
}

template <bool REMAP>
__device__ __forceinline__ void tconv_tile(const Ctx& C, const float* src, int srcN, bf16_t* dst, int dstK, int n0, int k0) {
    LAS float* tile = (LAS float*)C.lds;
    const int tx = C.tid & 31, ty = C.tid >> 5;
    const int nn = n0 + 4 * tx; const int sc = REMAP ? map_col(nn) : nn;
    f32x4 v[8];
#pragma unroll
    for (int i = 0; i < 8; ++i) { const int k = ty + 16 * i; v[i] = (sc >= 0) ? *(const f32x4*)(src + (size_t)(k0 + k) * srcN + sc) : (f32x4){0.f, 0.f, 0.f, 0.f}; }
#pragma unroll
    for (int i = 0; i < 8; ++i) { const int k = ty + 16 * i; LAS float* q = tile + k * 129 + 4 * tx; q[0] = v[i][0]; q[1] = v[i][1]; q[2] = v[i][2]; q[3] = v[i][3]; }
    __syncthreads();
#pragma unroll
    for (int i = 0; i < 4; ++i) { const int task = C.tid + 512 * i; const int nl = task >> 4, kc = task & 15;
        float e[8];
#pragma unroll
        for (int j = 0; j < 8; ++j) e[j] = tile[(kc * 8 + j) * 129 + nl];
        u32x4 w; w.x = cvt_pk_bf16(e[0], e[1]); w.y = cvt_pk_bf16(e[2], e[3]); w.z = cvt_pk_bf16(e[4], e[5]); w.w = cvt_pk_bf16(e[6], e[7]);
        *(u32x4*)(dst + (size_t)(n0 + nl) * dstK + k0 + kc * 8) = w; }
    __syncthreads();
}

template <bool REMAP>
__device__ __forceinline__ void tconv_tile_f8(const Ctx& C, const float* src, int srcN, unsigned char* dst, int dstK, int n0, int k0) {
    LAS float* tile = (LAS float*)C.lds;
    const int tx = C.tid & 31, ty = C.tid >> 5;
    const int nn = n0 + 4 * tx; const int sc = REMAP ? map_col(nn) : nn;
    f32x4 v[8];
#pragma unroll
    for (int i = 0; i < 8; ++i) { const int k = ty + 16 * i; v[i] = (sc >= 0) ? *(const f32x4*)(src + (size_t)(k0 + k) * srcN + sc) : (f32x4){0.f, 0.f, 0.f, 0.f}; }
#pragma unroll
    for (int i = 0; i < 8; ++i) { const int k = ty + 16 * i; LAS float* q = tile + k * 129 + 4 * tx; q[0] = v[i][0]; q[1] = v[i][1]; q[2] = v[i][2]; q[3] = v[i][3]; }
    __syncthreads();
#pragma unroll
    for (int i = 0; i < 2; ++i) { const int task = C.tid + 512 * i; const int nl = task >> 3, kc = task & 7;
        float e[16];
#pragma unroll
        for (int j = 0; j < 16; ++j) e[j] = tile[(kc * 16 + j) * 129 + nl] * 64.f;
        u32x4 w;
#pragma unroll
        for (int q4 = 0; q4 < 4; ++q4) { int p = __builtin_amdgcn_cvt_pk_fp8_f32(e[4 * q4], e[4 * q4 + 1], 0, false); p = __builtin_amdgcn_cvt_pk_fp8_f32(e[4 * q4 + 2], e[4 * q4 + 3], p, true); w[q4] = (unsigned)p; }
        *(u32x4*)(dst + (size_t)(n0 + nl) * dstK + k0 + kc * 16) = w; }
    __syncthreads();
}

__device__ __forceinline__ void wq_subkey_tile(const Ctx& C, int blk, int k0) {
    LAS float* As = (LAS float*)C.lds;
    LAS float* Bs = As + 128 * 132;
    const int tid = C.tid;
    const float* sk = C.in[I_SUBK] + (size_t)blk * 128 * 128; const float* wq = C.in[I_WPQ] + (size_t)k0 * 2048 + blk * 128;
#pragma unroll
    for (int i = 0; i < 8; ++i) { const int idx = tid + 512 * i, r = idx >> 5, c4 = idx & 31;
        const f32x4 a = *(const f32x4*)(sk + (size_t)r * 128 + 4 * c4), b = *(const f32x4*)(wq + (size_t)r * 2048 + 4 * c4);
        *(LAS f32x4*)(As + r * 132 + 4 * c4) = a; *(LAS f32x4*)(Bs + r * 132 + 4 * c4) = b; }
    __syncthreads();
    const int tn = tid >> 4, tk = tid & 15;
    float acc[4][8];
#pragma unroll
    for (int i = 0; i < 4; ++i)
#pragma unroll
        for (int j = 0; j < 8; ++j) acc[i][j] = 0.f;
#pragma unroll 2
    for (int d4 = 0; d4 < 32; ++d4) {
        f32x4 a[4], b[8];
#pragma unroll
        for (int i = 0; i < 4; ++i) a[i] = *(LAS const f32x4*)(As + (4 * tn + i) * 132 + 4 * d4);
#pragma unroll
        for (int j = 0; j < 8; ++j) b[j] = *(LAS const f32x4*)(Bs + (2 * tk + 32 * (j >> 1) + (j & 1)) * 132 + 4 * d4);
#pragma unroll
        for (int i = 0; i < 4; ++i)
#pragma unroll
            for (int j = 0; j < 8; ++j) acc[i][j] += a[i][0] * b[j][0] + a[i][1] * b[j][1] + a[i][2] * b[j][2] + a[i][3] * b[j][3];
    }
    bf16_t* dst = (bf16_t*)(C.ws + WS_WQ) + (size_t)(blk * 128 + 4 * tn) * 4096 + k0 + 2 * tk;
#pragma unroll
    for (int i = 0; i < 4; ++i)
#pragma unroll
        for (int j = 0; j < 4; ++j) *(unsigned*)(dst + (size_t)i * 4096 + 32 * j) = cvt_pk_bf16(acc[i][2 * j], acc[i][2 * j + 1]);
    __syncthreads();
}

__device__ __forceinline__ void peer_row_convert(const Ctx& C, int grow, int lane) {
            const bool second = grow >= 16384; const int row = grow & 16383;
            const float* src = C.in[second ? I_PV : I_PU] + (size_t)row * 4096;
            unsigned char* dst6 = C.ws + (second ? WS_PV : WS_PU) + (size_t)row * 3072;
            f32x16 v[4]; float am = 0.f;
#pragma unroll
            for (int i4 = 0; i4 < 4; ++i4)
#pragma unroll
                for (int q = 0; q < 4; ++q) { const f32x4 t4 = *(const f32x4*)(src + 16 * (lane + 64 * i4) + 4 * q);
                    v[i4][4 * q] = t4[0]; v[i4][4 * q + 1] = t4[1]; v[i4][4 * q + 2] = t4[2]; v[i4][4 * q + 3] = t4[3];
                    am = fmaxf(am, fmaxf(fmaxf(fabsf(t4[0]), fabsf(t4[1])), fmaxf(fabsf(t4[2]), fabsf(t4[3])))); }
            am = wave_max(am);
            const float sc = am > 0.f ? am * (1.f / 7.f) : 1.f, inv = 1.f / sc;
#pragma unroll
            for (int i4 = 0; i4 < 4; ++i4) v[i4] *= inv;
            const u32x6 pa = __builtin_amdgcn_cvt_scalef32_2xpk16_fp6_f32(v[0], v[1], 1.0f), pb = __builtin_amdgcn_cvt_scalef32_2xpk16_fp6_f32(v[2], v[3], 1.0f);
            *(u32x4*)(dst6 + 16 * lane) = (u32x4){pa[0], pa[1], pa[2], pa[3]};
            *(u32x4*)(dst6 + 1024 + 16 * lane) = (u32x4){pa[4], pa[5], pb[0], pb[1]};
            *(u32x4*)(dst6 + 2048 + 16 * lane) = (u32x4){pb[2], pb[3], pb[4], pb[5]};
            ((float*)(C.ws + (second ? WS_PV : WS_PU) + 96 * MB))[row] = sc;
            { float al = 0.f;
#pragma unroll
              for (int i4 = 0; i4 < 4; ++i4)
#pragma unroll
                  for (int j = 0; j < 16; ++j) al = fmaxf(al, fabsf(v[i4][j]));
              const float s4 = al > 0.f ? al * (1.f / 6.f) : 1.f, inv4 = 1.f / s4;
              unsigned wa[4] = {0u, 0u, 0u, 0u}, wb[4] = {0u, 0u, 0u, 0u};
#define PK4(d_) do { wa[d_] = __builtin_amdgcn_cvt_scalef32_pk_fp4_f32(wa[d_], v[0][4 * (d_)] * inv4, v[1][4 * (d_)] * inv4, 1.0f, 0); wa[d_] = __builtin_amdgcn_cvt_scalef32_pk_fp4_f32(wa[d_], v[0][4 * (d_) + 1] * inv4, v[1][4 * (d_) + 1] * inv4, 1.0f, 1); \
                     wa[d_] = __builtin_amdgcn_cvt_scalef32_pk_fp4_f32(wa[d_], v[0][4 * (d_) + 2] * inv4, v[1][4 * (d_) + 2] * inv4, 1.0f, 2); wa[d_] = __builtin_amdgcn_cvt_scalef32_pk_fp4_f32(wa[d_], v[0][4 * (d_) + 3] * inv4, v[1][4 * (d_) + 3] * inv4, 1.0f, 3); \
                     wb[d_] = __builtin_amdgcn_cvt_scalef32_pk_fp4_f32(wb[d_], v[2][4 * (d_)] * inv4, v[3][4 * (d_)] * inv4, 1.0f, 0); wb[d_] = __builtin_amdgcn_cvt_scalef32_pk_fp4_f32(wb[d_], v[2][4 * (d_) + 1] * inv4, v[3][4 * (d_) + 1] * inv4, 1.0f, 1); \
                     wb[d_] = __builtin_amdgcn_cvt_scalef32_pk_fp4_f32(wb[d_], v[2][4 * (d_) + 2] * inv4, v[3][4 * (d_) + 2] * inv4, 1.0f, 2); wb[d_] = __builtin_amdgcn_cvt_scalef32_pk_fp4_f32(wb[d_], v[2][4 * (d_) + 3] * inv4, v[3][4 * (d_) + 3] * inv4, 1.0f, 3); } while (0)
              PK4(0); PK4(1); PK4(2); PK4(3);
#undef PK4
              unsigned char* dst4 = C.ws + (second ? WS_PV4 : WS_PU4) + (size_t)row * 2176;
              *(u32x4*)(dst4 + 16 * lane) = (u32x4){wa[0], wa[1], wa[2], wa[3]};
              *(u32x4*)(dst4 + 1024 + 16 * lane) = (u32x4){wb[0], wb[1], wb[2], wb[3]};
              *(bf16_t*)(dst4 + 2048 + 2 * lane) = f2bf(sc * s4); }

}

__device__ __forceinline__ void p0_prologue(const Ctx& C) {
    constexpr int N_MOD = 256, N_WIN = (NP / 128) * (D / 128), N_W1 = 2 * 32, N_B1 = 64;
    constexpr int E0 = N_MOD, E1 = E0 + N_B1, E2 = E1 + N_WIN, E7 = E2 + N_W1, E8 = E7 + N_W1, E11 = E8;
    const int tid = C.tid;
    for (int it = blockIdx.x; it < E11; it += gridDim.x) {
        if (it < E0) {
            const int b = it; LAS float* red = (LAS float*)C.lds;
            const float* cvec = C.in[I_C]; const float* w = C.in[I_WADA];
            if (tid < 504) { const int cg = tid % 24, rs = tid / 24;
                f32x4 acc = {0.f, 0.f, 0.f, 0.f};
                const float* wp = w + 96 * b + 4 * cg;
#pragma unroll 4
                for (int k = rs; k < D; k += 21) { const float cv = cvec[k]; const f32x4 wv = *(const f32x4*)(wp + (size_t)k * 24576); acc += cv * wv; }
                *(LAS f32x4*)(red + (rs * 24 + cg) * 4) = acc; }
            __syncthreads();
            if (tid < 24) { f32x4 s = *(const f32x4*)(C.in[I_BADA] + 96 * b + 4 * tid);
                for (int rs = 0; rs < 21; ++rs) s += *(LAS f32x4*)(red + (rs * 24 + tid) * 4);
                *(f32x4*)((float*)(C.ws + WS_MOD) + 96 * b + 4 * tid) = s; }
            __syncthreads();
        } else if (it < E1) {
            const int s = (it - E0) >> 5, sl = (it - E0) & 31; const float* pe = C.in[s ? I_PEV : I_PEK]; const float* w1 = C.in[s ? I_W1V : I_W1K];
            const int e = tid & 255, half = tid >> 8; float a = 0.f;
            const int kb = sl * 128 + half * 64;
#pragma unroll 16
            for (int k = kb; k < kb + 64; ++k) a += pe[k] * w1[(size_t)k * 256 + e];
            LAS float* red = (LAS float*)C.lds; red[tid] = a; __syncthreads();
            if (tid < 256) ((float*)(C.ws + WS_B1P))[(s * 32 + sl) * 256 + tid] = red[tid] + red[tid + 256];
            __syncthreads();
        } else if (it < E2) { const int i = it - E1; const int n0 = (i / 32) * 128, k0 = (i % 32) * 128;
            if (n0 < NP_BF) tconv_tile<true>(C, C.in[I_WIN], 18576, (bf16_t*)(C.ws + WS_WIN), D, n0, k0);
            else tconv_tile_f8<true>(C, C.in[I_WIN], 18576, C.ws + WS_WIN8 - (size_t)NP_BF * D, D, n0, k0);
        } else if (it < E7) { const int i = it - E2; tconv_tile<false>(C, C.in[I_W1K], 256, (bf16_t*)(C.ws + WS_W1T), 4096, (i / 32) * 128, (i % 32) * 128);
        } else if (it < E8) { const int i = it - E7; tconv_tile<false>(C, C.in[I_W1V], 256, (bf16_t*)(C.ws + WS_W1T) + (size_t)256 * 4096, 4096, (i / 32) * 128, (i % 32) * 128);
        }
    }
}

__device__ __forceinline__ void norm_mod_phase(const Ctx& C, const float* xin, const float* gain, const float* sh, const float* sc, bf16_t* hout, unsigned char* h8out = nullptr) {
    LAS float* la = (LAS float*)C.lds; LAS float* lb = la + D;
    for (int i = C.tid; i < D / 4; i += NTHREADS) { const f32x4 g4 = *(const f32x4*)(gain + 4 * i), s4 = *(const f32x4*)(sc + 4 * i), h4 = *(const f32x4*)(sh + 4 * i);
        *(LAS f32x4*)(la + 4 * i) = g4 * (s4 + 1.f); *(LAS f32x4*)(lb + 4 * i) = h4; }
    __syncthreads();
    const int rstep = gridDim.x * 8;
    int row = blockIdx.x * 8 + C.wave;
    f32x4 v[16], vn[16];
    if (row < T) {
#pragma unroll
        for (int i = 0; i < 16; ++i) v[i] = ((const f32x4*)(xin + (size_t)row * D))[C.lane + 64 * i]; }
#pragma unroll 1
    for (; row < T; row += rstep) {
        const int nrow = row + rstep;
        if (nrow < T) {
#pragma unroll
            for (int i = 0; i < 16; ++i) vn[i] = ((const f32x4*)(xin + (size_t)nrow * D))[C.lane + 64 * i]; }
        float ss = 0.f;
#pragma unroll
        for (int i = 0; i < 16; ++i) ss += v[i][0] * v[i][0] + v[i][1] * v[i][1] + v[i][2] * v[i][2] + v[i][3] * v[i][3];
        ss = wave_sum(ss);
        const float rstd = rsqrtf(ss * (1.f / 4096.f) + EPS);
#pragma unroll
        for (int i = 0; i < 16; ++i) { const int col = 4 * (C.lane + 64 * i);
            const f32x4 a4 = *(LAS const f32x4*)(la + col), b4 = *(LAS const f32x4*)(lb + col);
            float y[4];
#pragma unroll
            for (int j = 0; j < 4; ++j) y[j] = v[i][j] * rstd * a4[j] + b4[j];
            u32x2 w; w.x = cvt_pk_bf16(y[0], y[1]); w.y = cvt_pk_bf16(y[2], y[3]);
            *(u32x2*)(hout + (size_t)row * D + col) = w;
            if (h8out) { int p = __builtin_amdgcn_cvt_pk_fp8_f32(y[0], y[1], 0, false); p = __builtin_amdgcn_cvt_pk_fp8_f32(y[2], y[3], p, true); *(unsigned*)(h8out + (size_t)row * D + col) = (unsigned)p; } }
#pragma unroll
        for (int i = 0; i < 16; ++i) v[i] = vn[i];
    }
    __syncthreads();
}

__device__ __forceinline__ void p3_post(const Ctx& C) {
    bf16_t* proj = (bf16_t*)(C.ws + WS_PROJ);
    const int tid = C.tid;
    const float qscale = 0.08838834764831845f;
    if (blockIdx.x == 0) { float a = 0.f; const float* part = (const float*)(C.ws + WS_B1P) + (size_t)(tid >> 8) * 32 * 256 + (tid & 255);
        for (int sl = 0; sl < 32; ++sl) a += part[sl * 256]; ((float*)(C.ws + WS_B1))[tid] = a; }
    for (int item = blockIdx.x; item < T / 64; item += gridDim.x) {
        const int t0 = item * 64;
#pragma unroll 1
        for (int hb = tid >> 4; hb < 64 * 44; hb += 128) {
            const int l16 = tid & 15;
            u32x4 raw[4]; bf16_t* dstp[4]; const float* gain[4]; float scl[4]; bool isk8[4];
#pragma unroll
            for (int u = 0; u < 4; ++u) { const int hr = hb + 32 * u; const int tok = hr / 44, hh = hr % 44; int col; isk8[u] = (hh >= 16 && hh < 20);
                if (hh < 16) { col = P_QA + 128 * hh; gain[u] = C.in[I_GQA]; scl[u] = qscale; dstp[u] = proj + (size_t)(t0 + tok) * NP + col; }
                else if (hh < 20) { col = P_KA + 128 * (hh - 16); gain[u] = C.in[I_GKA]; scl[u] = 1.f; dstp[u] = (bf16_t*)(C.ws + WS_KA + (size_t)(t0 + tok) * 512 + 128 * (hh - 16)); }
                else if (hh < 36) { col = P_QB + 128 * (hh - 20); gain[u] = C.in[I_GQB]; scl[u] = qscale * 1.4426950408889634f; dstp[u] = proj + (size_t)(t0 + tok) * NP + col; }
                else if (hh < 40) { col = P_KS + 128 * (hh - 36); gain[u] = C.in[I_GKSLC]; scl[u] = 1.f; dstp[u] = (bf16_t*)(C.ws + WS_KSC) + ((size_t)(hh - 36) * T + t0 + tok) * 128; }
                else { col = P_KW + 128 * (hh - 40); gain[u] = C.in[I_GKWIN]; scl[u] = 1.f; dstp[u] = (bf16_t*)(C.ws + WS_KWC) + ((size_t)(hh - 40) * T + t0 + tok) * 128; }
                raw[u] = *(const u32x4*)(proj + (size_t)(t0 + tok) * NP + col + 8 * l16); }
#pragma unroll
            for (int u = 0; u < 4; ++u) {
                float v[8] = {bflo(raw[u].x), bfhi(raw[u].x), bflo(raw[u].y), bfhi(raw[u].y), bflo(raw[u].z), bfhi(raw[u].z), bflo(raw[u].w), bfhi(raw[u].w)};
                float ss = 0.f;
#pragma unroll
                for (int j = 0; j < 8; ++j) ss += v[j] * v[j];
                ss += dppf<0xB1>(ss); ss += dppf<0x4E>(ss); ss += dppf<0x141>(ss); ss += dppf<0x140>(ss);
                const float rstd = rsqrtf(ss * (1.f / 128.f) + EPS) * scl[u];
                const f32x4 g0 = *(const f32x4*)(gain[u] + 8 * l16), g1 = *(const f32x4*)(gain[u] + 8 * l16 + 4);
                if (isk8[u]) {
                    const float r8 = rstd * 64.f;
                    int p0 = __builtin_amdgcn_cvt_pk_fp8_f32(v[0] * r8 * g0[0], v[1] * r8 * g0[1], 0, false); p0 = __builtin_amdgcn_cvt_pk_fp8_f32(v[2] * r8 * g0[2], v[3] * r8 * g0[3], p0, true);
                    int p1 = __builtin_amdgcn_cvt_pk_fp8_f32(v[4] * r8 * g1[0], v[5] * r8 * g1[1], 0, false); p1 = __builtin_amdgcn_cvt_pk_fp8_f32(v[6] * r8 * g1[2], v[7] * r8 * g1[3], p1, true);
                    *(u32x2*)((unsigned char*)dstp[u] + 8 * l16) = (u32x2){(unsigned)p0, (unsigned)p1};
                } else {
                u32x4 w; w.x = cvt_pk_bf16(v[0] * rstd * g0[0], v[1] * rstd * g0[1]); w.y = cvt_pk_bf16(v[2] * rstd * g0[2], v[3] * rstd * g0[3]);
                w.z = cvt_pk_bf16(v[4] * rstd * g1[0], v[5] * rstd * g1[1]); w.w = cvt_pk_bf16(v[6] * rstd * g1[2], v[7] * rstd * g1[3]);
                *(u32x4*)(dstp[u] + 8 * l16) = w; } }
        }
        bf16_t* Kc = (bf16_t*)(C.ws + WS_KC); bf16_t* Vc = Kc + (size_t)4 * T * 128;
#pragma unroll
        for (int i = 0; i < 8; ++i) { const int idx = tid + 512 * i, tok = idx >> 6, c16 = idx & 63, g = c16 >> 4, d8 = c16 & 15;
            const bf16_t* src = proj + (size_t)(t0 + tok) * NP + 8 * c16;
            const size_t dof = ((size_t)g * T + t0 + tok) * 128 + 8 * d8;
            *(u32x4*)(Kc + dof) = *(const u32x4*)(src + P_KC);
            *(u32x4*)(Vc + dof) = *(const u32x4*)(src + P_VC);
            { const u32x4 rv = *(const u32x4*)(src + P_VA);
              float v[8] = {bflo(rv.x), bfhi(rv.x), bflo(rv.y), bfhi(rv.y), bflo(rv.z), bfhi(rv.z), bflo(rv.w), bfhi(rv.w)};
              float am = 0.f;
#pragma unroll
              for (int j = 0; j < 8; ++j) am = fmaxf(am, fabsf(v[j]));
              am = fmax_fast(am, dppf<0xB1>(am)); am = fmax_fast(am, dppf<0x4E>(am)); am = fmax_fast(am, dppf<0x141>(am)); am = fmax_fast(am, dppf<0x140>(am));
              const float sc = am > 0.f ? am * (1.f / 448.f) : 1.f, inv = 1.f / sc;
              int p0 = __builtin_amdgcn_cvt_pk_fp8_f32(v[0] * inv, v[1] * inv, 0, false); p0 = __builtin_amdgcn_cvt_pk_fp8_f32(v[2] * inv, v[3] * inv, p0, true);
              int p1 = __builtin_amdgcn_cvt_pk_fp8_f32(v[4] * inv, v[5] * inv, 0, false); p1 = __builtin_amdgcn_cvt_pk_fp8_f32(v[6] * inv, v[7] * inv, p1, true);
              *(u32x2*)(C.ws + WS_VA + (size_t)(t0 + tok) * 512 + 8 * c16) = (u32x2){(unsigned)p0, (unsigned)p1};
              if (d8 == 0) ((float*)(C.ws + WS_VA + 8 * MB))[(size_t)(t0 + tok) * 4 + g] = sc; } }
        { const int tok = tid >> 3, c8 = tid & 7;
          *(u32x4*)((bf16_t*)(C.ws + WS_KIC) + (size_t)(t0 + tok) * 64 + 8 * c8) = *(const u32x4*)(proj + (size_t)(t0 + tok) * NP + P_KI + 8 * c8); }
#pragma unroll 1
        for (int which = 0; which < 2; ++which) {
            const int pcol = which ? P_VW : P_VS; bf16_t* dstT = (bf16_t*)(C.ws + (which ? WS_VWT : WS_VST));
            LAS unsigned* tl = (LAS unsigned*)C.lds;
#pragma unroll
            for (int i = 0; i < 8; ++i) { const int idx = tid + 512 * i, tok = idx >> 6, c16 = idx & 63;
                const u32x4 v = *(const u32x4*)(proj + (size_t)(t0 + tok) * NP + pcol + 8 * c16);
                LAS unsigned* q = tl + tok * 257 + 4 * c16; q[0] = v.x; q[1] = v.y; q[2] = v.z; q[3] = v.w; }
            __syncthreads();
#pragma unroll
            for (int i = 0; i < 8; ++i) { const int task = tid + 512 * i, col = task >> 3, tc = task & 7;
                unsigned short e[8];
#pragma unroll
                for (int j = 0; j < 8; ++j) { const unsigned dw = tl[(8 * tc + j) * 257 + (col >> 1)]; e[j] = (col & 1) ? (unsigned short)(dw >> 16) : (unsigned short)(dw & 0xFFFFu); }
                u32x4 w; w.x = e[0] | ((unsigned)e[1] << 16); w.y = e[2] | ((unsigned)e[3] << 16); w.z = e[4] | ((unsigned)e[5] << 16); w.w = e[6] | ((unsigned)e[7] << 16);
                *(u32x4*)(dstT + (size_t)col * T + t0 + 8 * tc) = w; }
            __syncthreads();
        }
    }
}

__device__ __forceinline__ void p5_cmp_out(const Ctx& C) {
    const float* part = (const float*)(C.ws + WS_HIDP); const float* b1 = (const float*)(C.ws + WS_B1);
    bf16_t* kcmp = (bf16_t*)(C.ws + WS_KCMP); bf16_t* vcT = (bf16_t*)(C.ws + WS_VCMPT);
    LAS float* hl = (LAS float*)(C.lds) + C.wave * 1024;
    const int lane = C.lane;
    for (int grp = blockIdx.x * 8 + C.wave; grp < 2048; grp += gridDim.x * 8) {
        const int R0 = grp * 4; const bool isv = R0 >= 4096;
        lds_sync();
        const f32x4 bb = *(const f32x4*)(b1 + (isv ? 256 : 0) + 4 * lane);
#pragma unroll
        for (int r = 0; r < 4; ++r) { f32x4 a = bb;
#pragma unroll
            for (int ks = 0; ks < 8; ++ks) a += *(const f32x4*)(part + ((size_t)ks * 8192 + R0 + r) * 256 + 4 * lane);
            f32x4 hg; hg[0] = gelu_tanh(a[0]); hg[1] = gelu_tanh(a[1]); hg[2] = gelu_tanh(a[2]); hg[3] = gelu_tanh(a[3]);
            *(LAS f32x4*)(hl + r * 256 + 4 * lane) = hg; }
        lds_sync();
        const float* w2 = C.in[isv ? I_W2V : I_W2K];
        float acc[4][2];
#pragma unroll
        for (int r = 0; r < 4; ++r) { acc[r][0] = 0.f; acc[r][1] = 0.f; }
#pragma unroll 8
        for (int e = 0; e < 256; ++e) { const float2 wv = *(const float2*)(w2 + e * 128 + 2 * lane);
#pragma unroll
            for (int r = 0; r < 4; ++r) { const float hv = hl[r * 256 + e]; acc[r][0] += hv * wv.x; acc[r][1] += hv * wv.y; } }
#pragma unroll
        for (int r = 0; r < 4; ++r) { const int R = R0 + r, Rl = R & 4095, g = Rl >> 10, n = Rl & 1023;
            const float a0 = (n < NCMP) ? acc[r][0] : 0.f, a1 = (n < NCMP) ? acc[r][1] : 0.f;
            if (!isv) { const float ss = wave_sum(a0 * a0 + a1 * a1); const float rstd = rsqrtf(ss * (1.f / 128.f) + EPS);
                const float2 gg = *(const float2*)(C.in[I_GKCMP] + 2 * lane);
                *(unsigned*)(kcmp + (size_t)Rl * 128 + 2 * lane) = (n < NCMP) ? cvt_pk_bf16(a0 * rstd * gg.x, a1 * rstd * gg.y) : 0u; }
            else { vcT[((size_t)g * 128 + 2 * lane) * 1024 + n] = f2bf(a0); vcT[((size_t)g * 128 + 2 * lane + 1) * 1024 + n] = f2bf(a1); } }
    }
}

constexpr int P6_WAVE_LDS = 18432, P6_SHARED = 8192;
__device__ __forceinline__ f32x16 mfma32(bf16x8 a, bf16x8 b, f32x16 c) { return __builtin_amdgcn_mfma_f32_32x32x16_bf16(a, b, c, 0, 0, 0); }
__device__ __forceinline__ int swap23(int r) { return (r & 0x13) | ((r & 4) << 1) | ((r & 8) >> 1); }

__device__ __forceinline__ void topk_prune(LAS u64* buf, int& cnt, u64& tau, LAS unsigned* hist, int lane) {
    u64 e[8];
#pragma unroll
    for (int i = 0; i < 8; ++i) { const int idx = lane + 64 * i; e[i] = idx < cnt ? buf[idx] : 0ull; }
    u64 prefix = 0ull; unsigned need = 256u;
    const u64 lt = (1ull << lane) - 1ull;
#pragma unroll 1
    for (int p = 0; p < 6; ++p) {
        const int shift = 40 - 8 * p;
        *(LAS u32x4*)(hist + 4 * lane) = (u32x4){0u, 0u, 0u, 0u};
        lds_sync();
#pragma unroll
        for (int i = 0; i < 8; ++i) { const bool m = (e[i] != 0ull) && ((e[i] >> (shift + 8)) == (prefix >> (shift + 8)));
            if (m) __hip_atomic_fetch_add(hist + (unsigned)((e[i] >> shift) & 255ull), 1u, __ATOMIC_RELAXED, __HIP_MEMORY_SCOPE_WORKGROUP); }
        lds_sync();
        const u32x4 c = *(LAS u32x4*)(hist + 4 * lane);
        const unsigned tot = c.x + c.y + c.z + c.w;
        unsigned pre = tot;
        pre += (unsigned)__builtin_amdgcn_update_dpp(0, (int)pre, 0x111, 0xF, 0xF, true); pre += (unsigned)__builtin_amdgcn_update_dpp(0, (int)pre, 0x112, 0xF, 0xF, true);
        pre += (unsigned)__builtin_amdgcn_update_dpp(0, (int)pre, 0x114, 0xF, 0xF, true); pre += (unsigned)__builtin_amdgcn_update_dpp(0, (int)pre, 0x118, 0xF, 0xF, true);
        const unsigned r0 = (unsigned)__builtin_amdgcn_readlane((int)pre, 15), r1 = (unsigned)__builtin_amdgcn_readlane((int)pre, 31), r2 = (unsigned)__builtin_amdgcn_readlane((int)pre, 47), r3 = (unsigned)__builtin_amdgcn_readlane((int)pre, 63);
        const int row = lane >> 4;
        pre += (row == 1) ? r0 : (row == 2) ? (r0 + r1) : (row == 3) ? (r0 + r1 + r2) : 0u;
        const unsigned a3 = (r0 + r1 + r2 + r3) - pre, a2 = a3 + c.w, a1 = a2 + c.z, a0 = a1 + c.y;
        int found = -1; unsigned above = 0u;
        if (a3 < need && need <= a3 + c.w) { found = 3; above = a3; }
        else if (a2 < need && need <= a2 + c.z) { found = 2; above = a2; }
        else if (a1 < need && need <= a1 + c.y) { found = 1; above = a1; }
        else if (a0 < need && need <= a0 + c.x) { found = 0; above = a0; }
        const u64 bm = __ballot(found >= 0);
        const int src = bm ? (__ffsll((long long)bm) - 1) : 0;
        const int bin = __builtin_amdgcn_readlane(4 * lane + found, src); const unsigned ab = (unsigned)__builtin_amdgcn_readlane((int)above, src);
        prefix |= ((u64)(unsigned)bin) << shift; need -= ab;
        lds_sync();
    }
    tau = prefix;
    int base = 0;
#pragma unroll
    for (int i = 0; i < 8; ++i) { const bool keep = (e[i] >= tau) && (e[i] != 0ull); const u64 m = __ballot(keep);
        if (keep) buf[base + __popcll(m & lt)] = e[i]; base += __popcll(m); }
    cnt = base;
    lds_sync();
}

#ifndef DSA_PROBE_MODE
#define DSA_PROBE_MODE 0
#endif
__device__ __forceinline__ void dsa_item(const Ctx& C, int qp, LAS unsigned char* wl, LAS const unsigned char* bkt, LAS const float* tbl, int pmode = 0) {
    const int lane = C.lane, r = lane & 31, h = lane >> 5;
    const bf16_t* proj = (const bf16_t*)(C.ws + WS_PROJ); const bf16_t* kic = (const bf16_t*)(C.ws + WS_KIC);
    unsigned char* ya = C.ws + WS_YA;
    const int t0 = 2 * qp;
    LAS u64* buf0 = (LAS u64*)wl; LAS u64* buf1 = (LAS u64*)(wl + 4096);
    LAS unsigned* hist = (LAS unsigned*)(wl + 8192);
    LAS unsigned char* qst = wl + 9216;
    LAS float* pl = (LAS float*)(wl + 10240);
    LAS unsigned* idxs = (LAS unsigned*)(wl + 14336);
    const u64 lt = (1ull << lane) - 1ull;
    {
    bf16x8 A[2][4]; unsigned wp[2][8];
#pragma unroll
    for (int q = 0; q < 2; ++q) {
        const bf16_t* pr = proj + (size_t)(t0 + q) * NP;
#pragma unroll
        for (int kk = 0; kk < 4; ++kk) A[q][kk] = *(const bf16x8*)(pr + P_QI + 64 * r + 32 * h + 8 * kk);
#pragma unroll
        for (int k2 = 0; k2 < 8; ++k2) { const int reg = 2 * k2; wp[q][k2] = *(const unsigned*)(pr + P_WI + (reg & 3) + 8 * (reg >> 2) + 4 * h); }
    }
    int cnt0 = 0, cnt1 = 0; u64 tau0 = 0ull, tau1 = 0ull;
    const int nkeys = (pmode == 2) ? 0 : t0 + 2;
    LAS unsigned char* stg = wl + 9216;
    const unsigned ixo0 = (unsigned)(((lane >> 3) * 64 + 8 * ((lane & 7) ^ ((lane >> 4) & 7))) * 2), ixo1 = (unsigned)(((lane >> 3) * 64 + 8 * ((lane & 7) ^ ((4 + (lane >> 4)) & 7))) * 2);
#define IX_STAGE(j0_) do { const char* _tb = (const char*)kic + (size_t)(j0_) * 128; _Pragma("unroll") for (int _i = 0; _i < 8; ++_i) \
        __builtin_amdgcn_global_load_lds((const unsigned*)(_tb + _i * 1024 + ((_i & 1) ? ixo1 : ixo0)), (LAS unsigned*)(stg + _i * 1024), 16, 0, 0); } while (0)
    if (nkeys > 0) IX_STAGE(0);
#pragma unroll 1
    for (int j0 = 0; j0 < nkeys; j0 += 64) {
        bf16x8 BA[4], BB[4];
        asm volatile("s_waitcnt vmcnt(0)" ::: "memory");
#pragma unroll
        for (int kk = 0; kk < 4; ++kk) { const int sw = (r >> 1) & 7;
            BA[kk] = *(LAS const bf16x8*)(stg + r * 128 + 16 * ((4 * h + kk) ^ sw));
            BB[kk] = *(LAS const bf16x8*)(stg + (32 + r) * 128 + 16 * ((4 * h + kk) ^ sw)); }
        asm volatile("s_waitcnt lgkmcnt(0)" ::: "memory");
        if (j0 + 64 < nkeys) IX_STAGE(j0 + 64);
        const int kidx = j0 + lane;
        f32x16 accA0, accB0, accA1, accB1;
#pragma unroll
        for (int i = 0; i < 16; ++i) { accA0[i] = 0.f; accB0[i] = 0.f; accA1[i] = 0.f; accB1[i] = 0.f; }
#pragma unroll
        for (int kk = 0; kk < 4; ++kk) { accA0 = mfma32(A[0][kk], BA[kk], accA0); accB0 = mfma32(A[0][kk], BB[kk], accB0); }
#pragma unroll
        for (int kk = 0; kk < 4; ++kk) { accA1 = mfma32(A[1][kk], BA[kk], accA1); accB1 = mfma32(A[1][kk], BB[kk], accB1); }
        float sc[2];
        { float pA = 0.f, pB = 0.f;
#pragma unroll
          for (int i = 0; i < 16; ++i) { const float wv = (i & 1) ? bfhi(wp[0][i >> 1]) : bflo(wp[0][i >> 1]);
              const float ta = __int_as_float(max(__float_as_int(accA0[i]), 0)), tb = __int_as_float(max(__float_as_int(accB0[i]), 0));
              pA = __builtin_fmaf(ta, wv, pA); pB = __builtin_fmaf(tb, wv, pB); }
          swap32f(pA, pB); sc[0] = pA + pB; }
        __builtin_amdgcn_sched_group_barrier(0x008, 8, 0);
#pragma unroll
        for (int i = 0; i < 8; ++i) { __builtin_amdgcn_sched_group_barrier(0x008, 1, 0); __builtin_amdgcn_sched_group_barrier(0x002, 9, 0); }
        { float pA = 0.f, pB = 0.f;
#pragma unroll
          for (int i = 0; i < 16; ++i) { const float wv = (i & 1) ? bfhi(wp[1][i >> 1]) : bflo(wp[1][i >> 1]);
              const float ta = __int_as_float(max(__float_as_int(accA1[i]), 0)), tb = __int_as_float(max(__float_as_int(accB1[i]), 0));
              pA = __builtin_fmaf(ta, wv, pA); pB = __builtin_fmaf(tb, wv, pB); }
          swap32f(pA, pB); sc[1] = pA + pB; }
#pragma unroll
        for (int q = 0; q < 2; ++q) {
            const float s = sc[q];
            const bool valid = kidx <= t0 + q;
            const u64 key = ((u64)sortable(s) << 14) | (u64)(unsigned)(16383 - kidx);
            const u64 tau = q ? tau1 : tau0;
            const bool pass = valid && key > tau && (pmode != 3);
            const u64 mask = __ballot(pass);
            if (mask) {
                LAS u64* buf = q ? buf1 : buf0; int& cnt = q ? cnt1 : cnt0;
                if (pass) buf[cnt + __popcll(mask & lt)] = key;
                cnt += __popcll(mask);
                if (cnt > 512 - 64) { lds_sync(); topk_prune(buf, cnt, q ? tau1 : tau0, hist, lane); }
            }
        }
    }
#undef IX_STAGE
    lds_sync();
    if (cnt0 > 256) topk_prune(buf0, cnt0, tau0, hist, lane);
    if (cnt1 > 256) topk_prune(buf1, cnt1, tau1, hist, lane);
    if (pmode == 2) { cnt0 = min(t0 + 1, 256); cnt1 = min(t0 + 2, 256);
#pragma unroll
        for (int i = 0; i < 4; ++i) { const int j = lane + 64 * i; buf0[j] = (u64)(unsigned)(16383 - ((j * 61) % (t0 + 1))); buf1[j] = (u64)(unsigned)(16383 - ((j * 59) % (t0 + 2))); } }
    if (lane == 0) { hist[0] = (unsigned)cnt0; hist[1] = (unsigned)cnt1; }
    lds_sync();
    }
    __builtin_amdgcn_s_setprio(0);
    if (pmode == 1 || pmode == 3) return;
    const int kq = lane >> 4, l16 = lane & 15;
    LAS float* plq = (LAS float*)wl;
    LAS unsigned short* idx2 = (LAS unsigned short*)(wl + 16384);
    LAS float* invl = (LAS float*)(wl + 17408);
    const int nsel0 = (int)hist[0], nsel1 = (int)hist[1];
    { unsigned iv0[4], iv1[4];
#pragma unroll
      for (int i = 0; i < 4; ++i) { const int j = lane + 64 * i; iv0[i] = (j < nsel0) ? (16383u - (unsigned)(buf0[j] & 0x3FFFull)) : 0u; iv1[i] = (j < nsel1) ? (16383u - (unsigned)(buf1[j] & 0x3FFFull)) : 0u; }
      lds_sync();
#pragma unroll
      for (int i = 0; i < 4; ++i) { const int j = lane + 64 * i; idx2[j] = (unsigned short)iv0[i]; idx2[256 + j] = (unsigned short)iv1[i]; }
      lds_sync(); }
    const unsigned char* KAp = (const unsigned char*)(C.ws + WS_KA) + 32 * kq;
    const float lsc = 1.f / (64.f * 512.f);
#pragma unroll 1
    for (int q = 0; q < 2; ++q) {
        const int t = t0 + q; const int nsel = q ? nsel1 : nsel0; LAS const unsigned short* idxs = idx2 + 256 * q;
        const bf16_t* prq = proj + (size_t)t * NP;
        lds_sync();
        {
            long Bz[4][4];
#pragma unroll
            for (int g = 0; g < 4; ++g)
#pragma unroll
                for (int sI = 0; sI < 4; ++sI) { long z = 0;
                    if ((l16 >> 2) == g) { const u32x4 raw = *(const u32x4*)(prq + P_QA + l16 * 128 + 32 * kq + 8 * sI);
                        int p0 = __builtin_amdgcn_cvt_pk_fp8_f32(bflo(raw.x) * 512.f, bfhi(raw.x) * 512.f, 0, false); p0 = __builtin_amdgcn_cvt_pk_fp8_f32(bflo(raw.y) * 512.f, bfhi(raw.y) * 512.f, p0, true);
                        int p1 = __builtin_amdgcn_cvt_pk_fp8_f32(bflo(raw.z) * 512.f, bfhi(raw.z) * 512.f, 0, false); p1 = __builtin_amdgcn_cvt_pk_fp8_f32(bflo(raw.w) * 512.f, bfhi(raw.w) * 512.f, p1, true);
                        z = (long)(((unsigned long long)(unsigned)p1 << 32) | (unsigned long long)(unsigned)p0); }
                    Bz[g][sI] = z; }
            u32x4 A0[2][2], A1[2][2];
            { const unsigned char* kr = KAp + (size_t)idxs[l16] * 512;
#pragma unroll
              for (int g = 0; g < 2; ++g) { A0[g][0] = *(const u32x4*)(kr + g * 128); A0[g][1] = *(const u32x4*)(kr + g * 128 + 16); } }
#pragma unroll 1
            for (int tile = 0; tile < 16; ++tile) {
                { const unsigned char* kr = KAp + (size_t)idxs[16 * tile + l16] * 512 + 256;
#pragma unroll
                  for (int g = 0; g < 2; ++g) { A1[g][0] = *(const u32x4*)(kr + g * 128); A1[g][1] = *(const u32x4*)(kr + g * 128 + 16); } }
                f32x4 acc = {0.f, 0.f, 0.f, 0.f};
#pragma unroll
                for (int g = 0; g < 2; ++g)
#pragma unroll
                    for (int sI = 0; sI < 4; ++sI) { const u32x4 v = A0[g][sI >> 1]; const long a = (sI & 1) ? (long)(((unsigned long long)v.w << 32) | v.z) : (long)(((unsigned long long)v.y << 32) | v.x);
                        acc = __builtin_amdgcn_mfma_f32_16x16x32_fp8_fp8(a, Bz[g][sI], acc, 0, 0, 0); }
                asm volatile("" ::: "memory");
                if (tile < 15) { const unsigned char* kr = KAp + (size_t)idxs[16 * (tile + 1) + l16] * 512;
#pragma unroll
                    for (int g = 0; g < 2; ++g) { A0[g][0] = *(const u32x4*)(kr + g * 128); A0[g][1] = *(const u32x4*)(kr + g * 128 + 16); } }
#pragma unroll
                for (int g = 0; g < 2; ++g)
#pragma unroll
                    for (int sI = 0; sI < 4; ++sI) { const u32x4 v = A1[g][sI >> 1]; const long a = (sI & 1) ? (long)(((unsigned long long)v.w << 32) | v.z) : (long)(((unsigned long long)v.y << 32) | v.x);
                        acc = __builtin_amdgcn_mfma_f32_16x16x32_fp8_fp8(a, Bz[2 + g][sI], acc, 0, 0, 0); }
#pragma unroll
                for (int r = 0; r < 4; ++r) { const int j = 16 * tile + 4 * kq + r; const int idx = (int)idxs[j]; const bool valid = j < nsel;
                    const int b = bkt[min(max(t - idx, 0), 2048)];
                    plq[j * 16 + l16] = valid ? (acc[r] * lsc + tbl[b * 32 + l16]) : -1e30f; }
            }
        }
        lds_sync();
        {
            float mx[16];
#pragma unroll
            for (int hh = 0; hh < 16; ++hh) mx[hh] = -1e30f;
#pragma unroll 1
            for (int ps = 0; ps < 4; ++ps) { const int j = ps * 64 + lane;
#pragma unroll
                for (int c4 = 0; c4 < 4; ++c4) { const f32x4 lv = *(LAS f32x4*)(plq + 16 * j + 4 * c4);
#pragma unroll
                    for (int e = 0; e < 4; ++e) mx[4 * c4 + e] = fmaxf(mx[4 * c4 + e], lv[e]); } }
#pragma unroll
            for (int hh = 0; hh < 16; ++hh) mx[hh] = wave_max(mx[hh]);
            float zs[16];
#pragma unroll
            for (int hh = 0; hh < 16; ++hh) zs[hh] = 0.f;
#pragma unroll 1
            for (int ps = 0; ps < 4; ++ps) { const int j = ps * 64 + lane; const bool valid = j < nsel;
                const f32x4 vsc = *(const f32x4*)((const float*)(C.ws + WS_VA + 8 * MB) + (size_t)idxs[j] * 4);
#pragma unroll
                for (int c4 = 0; c4 < 4; ++c4) { f32x4 lv = *(LAS f32x4*)(plq + 16 * j + 4 * c4);
#pragma unroll
                    for (int e = 0; e < 4; ++e) { const float p = valid ? __expf(lv[e] - mx[4 * c4 + e]) : 0.f; lv[e] = p * vsc[c4]; zs[4 * c4 + e] += p; }
                    *(LAS f32x4*)(plq + 16 * j + 4 * c4) = lv; } }
#pragma unroll
            for (int hh = 0; hh < 16; ++hh) { const float z = wave_sum(zs[hh]); if (lane == 0) invl[hh] = 1.f / fmaxf(z, 1e-30f); }
        }
        lds_sync();
#pragma unroll 1
        for (int g = 0; g < 4; ++g) {
            const f32x4 inv4 = *(LAS f32x4*)(invl + 4 * g);
            f32x2 o2[4][4];
#pragma unroll
            for (int rr = 0; rr < 4; ++rr)
#pragma unroll
                for (int d = 0; d < 4; ++d) o2[rr][d] = (f32x2){0.f, 0.f};
            const unsigned char* vbase = C.ws + WS_VA + 128 * g + 8 * l16;
            const int nb = (nsel + 31) >> 5;
            u32x2 vc[8], vn[8];
#pragma unroll
            for (int u = 0; u < 8; ++u) { const int idx = (int)idxs[4 * u + kq]; vc[u] = *(const u32x2*)(vbase + (size_t)idx * 512); }
#pragma unroll 1
            for (int bb = 0; bb < nb; ++bb) {
                if (bb + 1 < nb) {
#pragma unroll
                    for (int u = 0; u < 8; ++u) { const int idx = (int)idxs[32 * (bb + 1) + 4 * u + kq]; vn[u] = *(const u32x2*)(vbase + (size_t)idx * 512); } }
#pragma unroll
                for (int u = 0; u < 8; ++u) { const f32x4 p4 = *(LAS f32x4*)(plq + 16 * (32 * bb + 4 * u + kq) + 4 * g);
                    const f32x2 va = __builtin_amdgcn_cvt_pk_f32_fp8((int)vc[u].x, false), vb = __builtin_amdgcn_cvt_pk_f32_fp8((int)vc[u].x, true),
                                vcc = __builtin_amdgcn_cvt_pk_f32_fp8((int)vc[u].y, false), vd = __builtin_amdgcn_cvt_pk_f32_fp8((int)vc[u].y, true);
#pragma unroll
                    for (int rr = 0; rr < 4; ++rr) { const f32x2 pp = {p4[rr], p4[rr]};
                        o2[rr][0] = pp * va + o2[rr][0]; o2[rr][1] = pp * vb + o2[rr][1]; o2[rr][2] = pp * vcc + o2[rr][2]; o2[rr][3] = pp * vd + o2[rr][3]; } }
#pragma unroll
                for (int u = 0; u < 8; ++u) vc[u] = vn[u];
            }
            float o[4][8];
#pragma unroll
            for (int rr = 0; rr < 4; ++rr)
#pragma unroll
                for (int d = 0; d < 4; ++d) { o[rr][2 * d] = xsum16(xsum32(o2[rr][d].x)) * inv4[rr]; o[rr][2 * d + 1] = xsum16(xsum32(o2[rr][d].y)) * inv4[rr]; }
            if (kq == 0) {
#pragma unroll
                for (int rr = 0; rr < 4; ++rr) { int p0 = __builtin_amdgcn_cvt_pk_fp8_f32(o[rr][0] * 16.f, o[rr][1] * 16.f, 0, false); p0 = __builtin_amdgcn_cvt_pk_fp8_f32(o[rr][2] * 16.f, o[rr][3] * 16.f, p0, true);
                    int p1 = __builtin_amdgcn_cvt_pk_fp8_f32(o[rr][4] * 16.f, o[rr][5] * 16.f, 0, false); p1 = __builtin_amdgcn_cvt_pk_fp8_f32(o[rr][6] * 16.f, o[rr][7] * 16.f, p1, true);
                    *(u32x2*)(ya + (size_t)t * 2048 + (4 * g + rr) * 128 + 8 * l16) = (u32x2){(unsigned)p0, (unsigned)p1}; } }
        }
    }
}

constexpr int N2_KS = 0, N2_VS = 32768, N2_LUT = 65536, N2_IMP = 81920, N2_SEL = N2_IMP + 64 * 260 * 4, N2_UNI = N2_SEL + 2048, N2_LIST = N2_UNI + 64, N2_BKT = N2_LIST + 3 * 512, N2_TBL = N2_BKT + 2304, N2_END = N2_TBL + 4096;
static_assert(N2_END <= LDS_BYTES - 16, "NSA LDS map");
struct N2Src { const bf16_t* kbase; size_t kld; int krmax; const bf16_t* vT; size_t vld; };
__device__ __forceinline__ void n2_stage(const N2Src& s, int m, bool withV, LAS unsigned char* kbuf, LAS unsigned char* vbuf, int wave, int lane) {
#pragma unroll
    for (int j = 0; j < 2; ++j) { const int slot = (wave * 2 + j) * 64 + lane; const int row = slot >> 4, ch = (slot & 15) ^ (row & 15);
        __builtin_amdgcn_global_load_lds((const unsigned*)(s.kbase + (size_t)min(64 * m + row, s.krmax) * s.kld + 8 * ch), (LAS unsigned*)(kbuf + (wave * 2 + j) * 1024), 16, 0, 0); }
    if (withV) {
#pragma unroll
        for (int j = 0; j < 2; ++j) { const int slot = (wave * 2 + j) * 64 + lane; const int row = slot >> 3, ch = (slot & 7) ^ ((row >> 1) & 7);
            __builtin_amdgcn_global_load_lds((const unsigned*)(s.vT + (size_t)row * s.vld + 64 * m + 8 * ch), (LAS unsigned*)(vbuf + (wave * 2 + j) * 1024), 16, 0, 0); } }
}
__device__ __forceinline__ f32x16 n2_qk(const bf16x8 (&Bq)[8], LAS const unsigned char* kbuf, int hf, int rho, int h) {
    const int kr = 32 * hf + rho;
    f32x16 S;
#pragma unroll
    for (int i = 0; i < 16; ++i) S[i] = 0.f;
#pragma unroll
    for (int kk = 0; kk < 8; ++kk) { const int ch = 8 * h + kk; const bf16x8 a = *(LAS const bf16x8*)(kbuf + kr * 256 + 16 * (ch ^ (rho & 15))); S = mfma32(a, Bq[kk], S); }
    return S;
}
__device__ __forceinline__ void n2_pv(f32x16 (&O)[4], const float (&p)[16], LAS const unsigned char* vbuf, int hf, int lane) {
    bf16x8 pk[2];
#pragma unroll
    for (int s = 0; s < 2; ++s) { u32x4 w; w.x = cvt_pk_bf16(p[8 * s + 0], p[8 * s + 1]); w.y = cvt_pk_bf16(p[8 * s + 2], p[8 * s + 3]); w.z = cvt_pk_bf16(p[8 * s + 4], p[8 * s + 5]); w.w = cvt_pk_bf16(p[8 * s + 6], p[8 * s + 7]);
        pk[s] = __builtin_bit_cast(bf16x8, w); }
    const int r = lane & 31, h = lane >> 5;
#pragma unroll
    for (int dt = 0; dt < 4; ++dt)
#pragma unroll
        for (int s = 0; s < 2; ++s) { const int row = dt * 32 + r, ch = 4 * hf + 2 * s + h;
            const bf16x8 a = *(LAS const bf16x8*)(vbuf + row * 128 + 16 * (ch ^ ((r >> 1) & 7))); O[dt] = mfma32(a, pk[s], O[dt]); }
}
constexpr float N2_MASKED = -3.0e38f, N2_MINIT = -1.0e30f, LOG2E = 1.4426950408889634f;
template <int MODE, bool DEFER = false>
__device__ __forceinline__ float n2_bias_mask(f32x16& S, int posbase, int t, int t0w, int h, int ncv, int ncv0, unsigned sb, bool before_cur, float b31, LAS const bf16_t* lutr, LAS const unsigned char* bkt, LAS const float* tblh) {
    bool farT, fullT;
    if (MODE == 0) { farT = (t0w - (16 * (posbase + 31) + 31)) >= 1513; fullT = (posbase + 31) < ncv0; }
    else if (MODE == 1) { farT = (t0w - (posbase + 31)) >= 1513; fullT = before_cur; }
    else { farT = false; fullT = (posbase + 31 <= t0w) && ((t0w + 7 - posbase) < 512); }
    float cbu = b31;
    if (MODE != 0 && fullT && !farT) { const int b0 = (int)bkt[min(t0w - (posbase + 31), 2048)], b1 = (int)bkt[min(t0w + 7 - posbase, 2048)];
        if (b0 == b1) { farT = true; cbu = tblh[b0 * 32] * LOG2E; } }
    if (farT && fullT) {
        if (MODE == 1 && sb == 0u) {
#pragma unroll
            for (int reg = 0; reg < 16; ++reg) S[reg] = N2_MASKED;
            return 0.f; }
        if (DEFER) return cbu;
#pragma unroll
        for (int reg = 0; reg < 16; ++reg) S[reg] = S[reg] + cbu;
    } else {
#pragma unroll
        for (int reg = 0; reg < 16; ++reg) { const int pos = posbase + (reg & 7) + 8 * h + 16 * (reg >> 3);
            const int dist = (MODE == 0) ? (t - (16 * pos + 31)) : (t - pos);
            bool v;
            if (MODE == 0) v = pos < ncv; else if (MODE == 1) v = (sb != 0u) && (pos <= t); else v = (pos <= t) && (dist < 512);
            const float bias = bf2f(lutr[min(max(dist, 0), 2047)]);
            S[reg] = v ? (S[reg] + bias) : N2_MASKED; }
    }
    return 0.f;
}
__device__ __forceinline__ float n2_tilemax(const f32x16& S) {
    float a = fmax_fast(S[0], S[1]), b = fmax_fast(S[2], S[3]), c = fmax_fast(S[4], S[5]), d = fmax_fast(S[6], S[7]);
    float e = fmax_fast(S[8], S[9]), f = fmax_fast(S[10], S[11]), g = fmax_fast(S[12], S[13]), hh = fmax_fast(S[14], S[15]);
    a = fmax_fast(a, b); c = fmax_fast(c, d); e = fmax_fast(e, f); g = fmax_fast(g, hh); a = fmax_fast(a, c); e = fmax_fast(e, g); return fmax_fast(a, e);
}
__device__ __forceinline__ void n2_stat(const f32x16& S, float& m, float& Z) {
    const float mn = fmax_fast(m, n2_tilemax(S));
    float z = 0.f;
#pragma unroll
    for (int i = 0; i < 16; ++i) z += __builtin_amdgcn_exp2f(S[i] - mn);
    Z = Z * __builtin_amdgcn_exp2f(m - mn) + z; m = mn;
}
__device__ __forceinline__ void n2_combine(float& m, float& Z) {
    float ma = m, mb = m; swap32f(ma, mb); const float M = fmax_fast(ma, mb);
    Z = xsum32(Z * __builtin_amdgcn_exp2f(m - M)); m = M;
}
enum { N2_STATS = 0, N2_IMPP = 1, N2_PV = 2, N2_ONLINE = 3, N2_IMPV = 4 };
struct N2Lane { int t, t0w, h, rho, qq, rr, lane, ncv, ncv0, ncv7, cur; float b31; LAS const bf16_t* lutr; LAS const unsigned char* bkt; LAS const float* tblh; };
template <int MODE, int PASS>
__device__ __forceinline__ void n2_branch(const Ctx& C, int g, LAS const unsigned short* list, int n, const N2Lane& L, const bf16x8 (&Bq)[8], f32x16 (&O)[4],
                                          float& m, float& Z, float scale, LAS const unsigned* selq, LAS float* impw, float scale2 = 1.f) {
    if (n <= 0) return;
    constexpr bool withV = (PASS == N2_PV || PASS == N2_ONLINE || PASS == N2_IMPV);
    constexpr int NSL = (PASS == N2_IMPV) ? 2 : 4, LA = NSL - 1;
    N2Src src;
    if (MODE == 0) { src.kbase = (const bf16_t*)(C.ws + WS_KCMP) + (size_t)g * 1024 * 128; src.kld = 128; src.krmax = 1023; src.vT = (const bf16_t*)(C.ws + WS_VCMPT) + (size_t)g * 128 * 1024; src.vld = 1024; }
    else if (MODE == 1) { src.kbase = (const bf16_t*)(C.ws + WS_KSC) + (size_t)g * T * 128; src.kld = 128; src.krmax = T - 1; src.vT = (const bf16_t*)(C.ws + WS_VST) + (size_t)g * 128 * T; src.vld = (size_t)T; }
    else { src.kbase = (const bf16_t*)(C.ws + WS_KWC) + (size_t)g * T * 128; src.kld = 128; src.krmax = T - 1; src.vT = (const bf16_t*)(C.ws + WS_VWT) + (size_t)g * 128 * T; src.vld = (size_t)T; }
    LAS unsigned char* lds = C.lds;
#define N2_KSLOT(s_) (withV ? (((s_) < 2) ? (N2_KS + (s_) * 16384) : (N2_IMP + ((s_) - 2) * 32768)) : (N2_KS + (s_) * 16384))
#define N2_VSLOT(s_) (((s_) < 2) ? (N2_VS + (s_) * 16384) : (N2_IMP + ((s_) - 2) * 32768 + 16384))
#define N2_RAW_BARRIER() do { asm volatile("s_waitcnt lgkmcnt(0)" ::: "memory"); __builtin_amdgcn_s_barrier(); asm volatile("" ::: "memory"); } while (0)
#define N2_WAIT_LANDED() do { if (LA == 1) asm volatile("s_waitcnt vmcnt(0)" ::: "memory"); else if (withV) asm volatile("s_waitcnt vmcnt(8)" ::: "memory"); else asm volatile("s_waitcnt vmcnt(4)" ::: "memory"); } while (0)
#pragma unroll
    for (int j = 0; j < LA; ++j) if (j < n) n2_stage(src, (int)list[j], withV, lds + N2_KSLOT(j), lds + N2_VSLOT(j), C.wave, C.lane);
    if (n >= LA) N2_WAIT_LANDED(); else asm volatile("s_waitcnt vmcnt(0)" ::: "memory");
    N2_RAW_BARRIER();
#pragma unroll 1
    for (int i = 0; i < n; ++i) {
        const int mb = (int)list[i];
        if (i + LA < n) { const int sl = (i + LA) & (NSL - 1); n2_stage(src, (int)list[i + LA], withV, lds + N2_KSLOT(sl), lds + N2_VSLOT(sl), C.wave, C.lane); }
        LAS const unsigned char* kbuf = lds + N2_KSLOT(i & (NSL - 1)); LAS const unsigned char* vbuf = lds + N2_VSLOT(i & (NSL - 1));
        bool need; unsigned sb = 1u;
        if (MODE == 0) need = (64 * mb) < L.ncv7;
        else if (MODE == 1) { const unsigned sw = selq[mb >> 5]; sb = (sw >> (mb & 31)) & 1u; need = __ballot(sb != 0u) != 0ull; }
        else need = (64 * mb + 63 >= L.t0w - 511) && (64 * mb <= L.t0w + 7);
        if (need) {
#pragma unroll 1
            for (int hf = 0; hf < 2; ++hf) {
                const int posbase = 64 * mb + 32 * hf;
                f32x16 S = n2_qk(Bq, kbuf, hf, L.rho, L.h);
                const float cbd = n2_bias_mask<MODE, PASS == N2_ONLINE>(S, posbase, L.t, L.t0w, L.h, L.ncv, L.ncv0, sb, mb < L.cur, L.b31, L.lutr, L.bkt, L.tblh);
                if (PASS == N2_STATS) { n2_stat(S, m, Z); }
                else if (PASS == N2_IMPP || PASS == N2_IMPV) {
                    float p[16];
#pragma unroll
                    for (int r = 0; r < 16; ++r) p[r] = __builtin_amdgcn_exp2f(S[r] - m) * scale;
#pragma unroll
                    for (int G = 0; G < 4; ++G) { float q4 = p[4 * G] + p[4 * G + 1] + p[4 * G + 2] + p[4 * G + 3], e = p[4 * G + 3];
                        q4 += dppf<0xB1>(q4); q4 += dppf<0x4E>(q4); e += dppf<0xB1>(e); e += dppf<0x4E>(e);
                        const int nb = posbase + ((4 * G) & 7) + 8 * L.h + 16 * ((4 * G) >> 3); const int mq = nb >> 2;
                        if (L.rr == 0) { __hip_atomic_fetch_add(impw + L.qq * 260 + mq, q4, __ATOMIC_RELAXED, __HIP_MEMORY_SCOPE_WORKGROUP);
                                         __hip_atomic_fetch_add(impw + L.qq * 260 + mq + 1, e, __ATOMIC_RELAXED, __HIP_MEMORY_SCOPE_WORKGROUP); } }
                    if (PASS == N2_IMPV) {
#pragma unroll
                        for (int r = 0; r < 16; ++r) p[r] *= scale2;
                        n2_pv(O, p, vbuf, hf, L.lane); }
                } else if (PASS == N2_PV) {
                    float p[16];
#pragma unroll
                    for (int r = 0; r < 16; ++r) p[r] = __builtin_amdgcn_exp2f(S[r] - m) * scale;
                    n2_pv(O, p, vbuf, hf, L.lane);
                } else {
                    const float tm = xmax32(n2_tilemax(S) + cbd);
                    const float mn = fmax_fast(m, tm);
                    if (__ballot(mn > m + 8.f)) { const float al = __builtin_amdgcn_exp2f(m - mn); Z *= al;
#pragma unroll
                        for (int dt = 0; dt < 4; ++dt)
#pragma unroll
                            for (int r = 0; r < 16; ++r) O[dt][r] *= al;
                        m = mn; }
                    float p[16]; float zs = 0.f;
                    const float c2 = cbd - m;
#pragma unroll
                    for (int r = 0; r < 16; ++r) { p[r] = __builtin_amdgcn_exp2f(S[r] + c2); zs += p[r]; }
                    Z += zs;
                    n2_pv(O, p, vbuf, hf, L.lane);
                }
            }
        }
        if (i + LA < n) N2_WAIT_LANDED(); else asm volatile("s_waitcnt vmcnt(0)" ::: "memory");
        N2_RAW_BARRIER();
    }
#undef N2_WAIT_LANDED
#undef N2_RAW_BARRIER
#undef N2_KSLOT
#undef N2_VSLOT
}

__device__ __forceinline__ void nsa2_item(const Ctx& C, int QB, int g) {
    LAS unsigned char* lds = C.lds;
    const int tid = C.tid, lane = C.lane, wave = C.wave;
    const int c = lane & 31, h = lane >> 5, qq = c >> 2, rr = c & 3;
    const int t0 = 64 * QB, t0w = t0 + 8 * wave, t = t0w + qq, head = 4 * g + rr;
    const bf16_t* proj = (const bf16_t*)(C.ws + WS_PROJ);
    LAS bf16_t* lut = (LAS bf16_t*)(lds + N2_LUT);
    LAS float* imp = (LAS float*)(lds + N2_IMP);
    LAS unsigned* selw = (LAS unsigned*)(lds + N2_SEL);
    LAS unsigned* uni = (LAS unsigned*)(lds + N2_UNI);
    LAS unsigned short* listC = (LAS unsigned short*)(lds + N2_LIST); LAS unsigned short* listS = listC + 256; LAS unsigned short* listW = listC + 512;
    LAS const unsigned char* bkt = lds + N2_BKT; LAS const float* tbl = (LAS const float*)(lds + N2_TBL);
    __syncthreads();
    for (int i = tid; i < 8192; i += NTHREADS) { const int r4 = i >> 11, d = i & 2047; lut[i] = f2bf(tbl[(int)bkt[d] * 32 + 16 + 4 * g + r4] * LOG2E); }
    for (int i = tid; i < 64 * 260; i += NTHREADS) imp[i] = 0.f;
    const int ncv_wg = (t0 + 63 >= 31) ? ((t0 + 63 - 31) >> 4) + 1 : 0; const int nC = (ncv_wg + 63) >> 6;
    const int wlo = max(t0 - 511, 0) >> 6; const int nW = QB - wlo + 1;
    if (tid < nC) listC[tid] = (unsigned short)tid;
    if (tid < nW) listW[tid] = (unsigned short)(wlo + tid);
    bf16x8 Bq[8];
#pragma unroll
    for (int kk = 0; kk < 8; ++kk) Bq[kk] = *(const bf16x8*)(proj + (size_t)t * NP + P_QB + 128 * head + 64 * h + 8 * kk);
    const float g0 = sigmoidf_(bf2f(proj[(size_t)t * NP + P_GB + 3 * head + 0]));
    const float g1 = sigmoidf_(bf2f(proj[(size_t)t * NP + P_GB + 3 * head + 1]));
    const float g2 = sigmoidf_(bf2f(proj[(size_t)t * NP + P_GB + 3 * head + 2]));
    f32x16 O[4];
#pragma unroll
    for (int dt = 0; dt < 4; ++dt)
#pragma unroll
        for (int i = 0; i < 16; ++i) O[dt][i] = 0.f;
    N2Lane L; L.t = t; L.t0w = t0w; L.h = h; L.rho = swap23(c); L.qq = qq; L.rr = rr; L.lane = lane;
    L.ncv = t >= 31 ? ((t - 31) >> 4) + 1 : 0; L.ncv0 = t0w >= 31 ? ((t0w - 31) >> 4) + 1 : 0; L.ncv7 = (t0w + 7 >= 31) ? ((t0w + 7 - 31) >> 4) + 1 : 0; L.cur = QB;
    L.b31 = tbl[31 * 32 + 16 + head] * LOG2E; L.lutr = lut + rr * 2048; L.bkt = bkt; L.tblh = tbl + 16 + head;
    LAS const unsigned* selq = selw + (wave * 8 + qq) * 8;
    LAS float* impw = imp + wave * 8 * 260;
    __syncthreads();
    float mC = N2_MINIT, ZC = 0.f;
    n2_branch<0, N2_STATS>(C, g, listC, nC, L, Bq, O, mC, ZC, 0.f, selq, impw);
    n2_combine(mC, ZC);
    const float invZC = 1.f / fmaxf(ZC, 1e-30f);
    n2_branch<0, N2_IMPV>(C, g, listC, nC, L, Bq, O, mC, ZC, invZC, selq, impw, g0);
#define N2_OACC() ({ unsigned to_ = (unsigned)tid; asm volatile("" : "+v"(to_)); (f32x4*)(C.ws + WS_OACC) + (size_t)blockIdx.x * 16 * 512 + to_; })
    f32x4* oacc = N2_OACC();
#pragma unroll
    for (int dt = 0; dt < 4; ++dt)
#pragma unroll
        for (int G = 0; G < 4; ++G) { oacc[(dt * 4 + G) * 512] = (f32x4){O[dt][4 * G], O[dt][4 * G + 1], O[dt][4 * G + 2], O[dt][4 * G + 3]}; O[dt][4 * G] = 0.f; O[dt][4 * G + 1] = 0.f; O[dt][4 * G + 2] = 0.f; O[dt][4 * G + 3] = 0.f; }
    lds_sync();
#pragma unroll 1
    for (int q8 = 0; q8 < 8; ++q8) {
        const int cur = QB;
        unsigned word = 0u;
        if (cur + 1 <= 16) { if (lane == 0) word = (1u << (cur + 1)) - 1u; }
        else {
            unsigned key[4];
#pragma unroll
            for (int i = 0; i < 4; ++i) { const int mblk = lane + 64 * i; const bool ok = mblk >= 1 && mblk <= cur - 2;
                key[i] = ok ? ((__float_as_uint(impw[q8 * 260 + mblk]) & 0xFFFFFF00u) | (unsigned)(255 - mblk)) : 0u; }
#pragma unroll 1
            for (int round = 0; round < 13; ++round) {
                unsigned lm = key[0] > key[1] ? key[0] : key[1]; const unsigned lm2 = key[2] > key[3] ? key[2] : key[3]; lm = lm > lm2 ? lm : lm2;
                const unsigned W = wave_maxu(lm);
#pragma unroll
                for (int i = 0; i < 4; ++i) if (key[i] == W) key[i] = 0u;
                const int mw = 255 - (int)(W & 0xFFu);
                if (W != 0u && lane == (mw >> 5)) word |= 1u << (mw & 31);
            }
            if (lane == 0) word |= 1u;
            if (lane == (cur >> 5)) word |= 1u << (cur & 31);
            if (lane == ((cur - 1) >> 5)) word |= 1u << ((cur - 1) & 31);
        }
        if (lane < 8) selw[(wave * 8 + q8) * 8 + lane] = word;
    }
    __syncthreads();
    if (tid < 8) { unsigned u = 0u; for (int q = 0; q < 64; ++q) u |= selw[q * 8 + tid]; uni[tid] = u; }
    __syncthreads();
    if (tid == 0) { int n = 0; for (int mblk = 0; mblk <= QB; ++mblk) if ((uni[mblk >> 5] >> (mblk & 31)) & 1u) listS[n++] = (unsigned short)mblk; uni[8] = (unsigned)n; }
    __syncthreads();
    const int nS = (int)uni[8];
    float mS = N2_MINIT, ZS = 0.f;
    n2_branch<1, N2_ONLINE>(C, g, listS, nS, L, Bq, O, mS, ZS, 0.f, selq, impw);
    { ZS = xsum32(ZS); const float sc = g1 / fmaxf(ZS, 1e-30f);
#pragma unroll
      for (int dt = 0; dt < 4; ++dt)
#pragma unroll
          for (int r = 0; r < 16; ++r) O[dt][r] *= sc; }
    oacc = N2_OACC();
#pragma unroll
    for (int dt = 0; dt < 4; ++dt)
#pragma unroll
        for (int G = 0; G < 4; ++G) { const f32x4 a = oacc[(dt * 4 + G) * 512];
            oacc[(dt * 4 + G) * 512] = (f32x4){O[dt][4 * G] + a[0], O[dt][4 * G + 1] + a[1], O[dt][4 * G + 2] + a[2], O[dt][4 * G + 3] + a[3]};
            O[dt][4 * G] = 0.f; O[dt][4 * G + 1] = 0.f; O[dt][4 * G + 2] = 0.f; O[dt][4 * G + 3] = 0.f; }
    float mW = N2_MINIT, ZW = 0.f;
    n2_branch<2, N2_ONLINE>(C, g, listW, nW, L, Bq, O, mW, ZW, 0.f, selq, impw);
    oacc = N2_OACC();
    { ZW = xsum32(ZW); const float sc = g2 / fmaxf(ZW, 1e-30f);
#pragma unroll
      for (int dt = 0; dt < 4; ++dt)
#pragma unroll
          for (int G = 0; G < 4; ++G) { const f32x4 a = oacc[(dt * 4 + G) * 512];
              O[dt][4 * G] = O[dt][4 * G] * sc + a[0]; O[dt][4 * G + 1] = O[dt][4 * G + 1] * sc + a[1]; O[dt][4 * G + 2] = O[dt][4 * G + 2] * sc + a[2]; O[dt][4 * G + 3] = O[dt][4 * G + 3] * sc + a[3]; } }
    unsigned char* yb = C.ws + WS_YB + (size_t)t * 2048 + head * 128;
#pragma unroll
    for (int dt = 0; dt < 4; ++dt)
#pragma unroll
        for (int G = 0; G < 4; ++G) { int p = __builtin_amdgcn_cvt_pk_fp8_f32(O[dt][4 * G] * 16.f, O[dt][4 * G + 1] * 16.f, 0, false); p = __builtin_amdgcn_cvt_pk_fp8_f32(O[dt][4 * G + 2] * 16.f, O[dt][4 * G + 3] * 16.f, p, true);
            *(unsigned*)(yb + dt * 32 + 8 * G + 4 * h) = (unsigned)p; }
}

#ifndef NREP_DSA
#define NREP_DSA 1
#endif
#ifndef NREP_NSA
#define NREP_NSA 1
#endif
__device__ __forceinline__ void p6_mixers(const Ctx& C, int which  , int crep = 0) {
    const Ctx& C0_ = C;
    unsigned* counter = (unsigned*)(C.ws + WS_CTL + CTL_CNT) + 128 * crep;
    static_assert(8 * P6_WAVE_LDS <= N2_BKT, "DSA per-wave LDS vs the shared bias tables");
    LAS unsigned char* bkt = C.lds + N2_BKT; LAS float* tbl = (LAS float*)(C.lds + N2_TBL);
    for (int d = C.tid; d <= 2048; d += NTHREADS) { int b;
        if (d < 16) b = d; else { b = 16 + (int)(logf((float)d / 16.f) / logf(128.f) * 16.f); b = b < 31 ? b : 31; }
        bkt[d] = (unsigned char)b; }
    for (int i = C.tid; i < 1024; i += NTHREADS) tbl[i] = C.in[I_RELB][i];
    __syncthreads();
    if (which != 2) {
        LAS unsigned char* wl = C.lds + C.wave * P6_WAVE_LDS;
#pragma unroll 1
        for (int rep = 0; rep < NREP_DSA; ++rep)
        for (;;) {
            int it = 0;
            if (C.lane == 0) it = (int)atomicAdd(counter + 128 * rep, 1u);
            it = __builtin_amdgcn_readfirstlane(it);
            if (it >= 8192) break;
            if (C.wave >= 4) __builtin_amdgcn_s_setprio(2);
            dsa_item(C, 8191 - it, wl, bkt, tbl, (rep < NREP_DSA - 1) ? DSA_PROBE_MODE : 0);
#pragma unroll 1
            for (int rr = 0; rr < 4; ++rr) peer_row_convert(C, 4 * it + rr, C.lane);
        }
        __builtin_amdgcn_s_setprio(0);
        __syncthreads();
    }
    if (which != 1) {
        LAS int* slot = (LAS int*)(C.lds + N2_UNI + 48);
#pragma unroll 1
        for (int rep = 0; rep < NREP_NSA; ++rep)
        for (;;) {
            __syncthreads();
            if (C.tid == 0) *slot = (int)atomicAdd(counter + 64 + 128 * rep, 1u);
            __syncthreads();
            const int it = *slot;
            if (it >= 1024) break;
            nsa2_item(C, 255 - (it >> 2), it & 3);
#pragma unroll 1
            for (int c = 0; c < 3; ++c) { const int j = it + 1024 * c; if (j >= 2560) break;
                __syncthreads();
                Ctx C = C0_; { int t_ = threadIdx.x; asm volatile("" : "+v"(t_)); C.tid = t_; C.lane = t_ & 63; C.wave = __builtin_amdgcn_readfirstlane(t_ >> 6); }
                if (j < 512) tconv_tile_f8<false>(C, C.in[I_WBA], 4096, C.ws + WS_WBA, 2048, (j / 16) * 128, (j % 16) * 128);
                else if (j < 1024) { const int i = j - 512; tconv_tile_f8<false>(C, C.in[I_WBB], 4096, C.ws + WS_WBB, 2048, (i / 16) * 128, (i % 16) * 128); }
                else if (j < 2048) { const int i = j - 1024; tconv_tile_f8<false>(C, C.in[I_WOUT], 4096, C.ws + WS_WOUT, 4096, (i / 32) * 128, (i % 32) * 128); }
                else { const int i = j - 2048; wq_subkey_tile(C, i >> 5, (i & 31) * 128); } }
        }
        __syncthreads();
    }
}

static __device__ const unsigned P12_IJ4[16] = {
    0xE0331000u, 0xF0401101u, 0xFF411202u, 0xFF421303u, 0xFF501404u, 0xFF511505u, 0xFF601606u, 0xFF611707u, 0xFF702008u, 0xFF712109u, 0xFF80220Au, 0xFF90230Bu, 0xFFA0240Cu, 0xFFB0300Du, 0xFFC0310Eu, 0xFFD0320Fu };
typedef __bf16 bf16x32_t __attribute__((ext_vector_type(32)));
typedef unsigned u32x16 __attribute__((ext_vector_type(16)));
typedef _Float16 h2_t __attribute__((ext_vector_type(2)));
typedef _Float16 h32_t __attribute__((ext_vector_type(32)));
__device__ __forceinline__ unsigned rowmax_u(unsigned v) { v = umaxu(v, dppu<0xB1>(v)); v = umaxu(v, dppu<0x4E>(v)); v = umaxu(v, dppu<0x141>(v)); v = umaxu(v, dppu<0x140>(v)); return v; }
__device__ __forceinline__ float rowmax_f(float v) { v = fmax_fast(v, dppf<0xB1>(v)); v = fmax_fast(v, dppf<0x4E>(v)); v = fmax_fast(v, dppf<0x141>(v)); v = fmax_fast(v, dppf<0x140>(v)); return v; }
__device__ __forceinline__ float rowsum_f(float v) { v += dppf<0xB1>(v); v += dppf<0x4E>(v); v += dppf<0x141>(v); v += dppf<0x140>(v); return v; }
#define P12_CE(a_, b_) do { const unsigned hi_ = umaxu(a_, b_), lo_ = (a_) < (b_) ? (a_) : (b_); a_ = hi_; b_ = lo_; } while (0)
__device__ __forceinline__ void p12_route(const bf16_t* srow, LAS float* tops, LAS int* topi, LAS unsigned short* exl, LAS float* gtl, int lane, unsigned ij4) {
    const int row = lane >> 4, l16 = lane & 15;
#pragma unroll 1
    for (int q = 0; q < 4; ++q) {
        const int p = 4 * q + row;
        const u32x4 raw = *(const u32x4*)(srow + p * 128 + 8 * l16);
        unsigned k[8];
#pragma unroll
        for (int e = 0; e < 8; ++e) { const unsigned bits = (e & 1) ? (raw[e >> 1] & 0xFFFF0000u) : (raw[e >> 1] << 16);
            k[e] = ((bits ^ ((bits >> 31) ? 0xFFFFFFFFu : 0x80000000u)) & 0xFFFFFF80u) | (unsigned)(127 - (8 * l16 + e)); }
        P12_CE(k[0], k[2]); P12_CE(k[1], k[3]); P12_CE(k[4], k[6]); P12_CE(k[5], k[7]);
        P12_CE(k[0], k[4]); P12_CE(k[1], k[5]); P12_CE(k[2], k[6]); P12_CE(k[3], k[7]);
        P12_CE(k[0], k[1]); P12_CE(k[2], k[3]); P12_CE(k[4], k[5]); P12_CE(k[6], k[7]);
        P12_CE(k[2], k[4]); P12_CE(k[3], k[5]);
        P12_CE(k[1], k[4]); P12_CE(k[3], k[6]);
        P12_CE(k[1], k[2]); P12_CE(k[3], k[4]); P12_CE(k[5], k[6]);
        unsigned myW = 0u;
#pragma unroll
        for (int r = 0; r < 16; ++r) {
            const unsigned W = rowmax_u(k[0]);
            const bool pop = k[0] == W;
#pragma unroll
            for (int e = 0; e < 7; ++e) k[e] = pop ? k[e + 1] : k[e];
            k[7] = pop ? 0u : k[7];
            myW = (l16 == r) ? W : myW;
        }
        const unsigned sb = myW & 0xFFFFFF80u;
        const unsigned bits = (sb & 0x80000000u) ? (sb ^ 0x80000000u) : ((~sb) & 0xFFFF0000u);
        tops[p * 16 + l16] = __uint_as_float(bits); topi[p * 16 + l16] = 127 - (int)(myW & 0x7Fu);
    }
    lds_sync();
#pragma unroll 1
    for (int q2 = 0; q2 < 2; ++q2) {
        const int hh = 4 * q2 + row;
        LAS const float* t1 = tops + (2 * hh) * 16; LAS const float* t2 = t1 + 16;
        unsigned k[4];
#pragma unroll
        for (int c = 0; c < 4; ++c) { const unsigned ij = (ij4 >> (8 * c)) & 0xFFu; const float cv = t1[ij >> 4] + t2[ij & 15u];
            k[c] = (ij != 0xFFu) ? ((sortable(cv) & 0xFFFFFF00u) | (255u - ij)) : 0u; }
        P12_CE(k[0], k[1]); P12_CE(k[2], k[3]); P12_CE(k[0], k[2]); P12_CE(k[1], k[3]); P12_CE(k[1], k[2]);
        unsigned myW = 0u;
#pragma unroll
        for (int r = 0; r < 16; ++r) {
            const unsigned W = rowmax_u(k[0]);
            const bool pop = k[0] == W;
            k[0] = pop ? k[1] : k[0]; k[1] = pop ? k[2] : k[1]; k[2] = pop ? k[3] : k[2]; k[3] = pop ? 0u : k[3];
            myW = (l16 == r) ? W : myW;
        }
        const unsigned flat = 255u - (myW & 0xFFu); const int ci = (int)(flat >> 4), cj = (int)(flat & 15u);
        const float cv = t1[ci] + t2[cj];
        const float ev = __expf(cv - rowmax_f(cv));
        const float es = rowsum_f(ev);
        exl[hh * 16 + l16] = (unsigned short)(topi[(2 * hh) * 16 + ci] * 128 + topi[(2 * hh + 1) * 16 + cj]);
        gtl[hh * 16 + l16] = ev * __builtin_amdgcn_rcpf(es);
    }
    lds_sync();
}
#undef P12_CE
__device__ __forceinline__ float gelu_fast(float x) { const float u = 0.7978845608028654f * (x + 0.044715f * x * x * x); const float e = __expf(2.f * u); return x - x * __builtin_amdgcn_rcpf(e + 1.f); }

#ifndef P12_HI
#define P12_HI 4
#endif
__device__ __forceinline__ void p12_peer(const Ctx& C, float* dst) {
    const bf16_t* pq = (const bf16_t*)(C.ws + WS_PQ);
    const bf16_t* h2 = (const bf16_t*)(C.ws + WS_H2);
    const float* gt2 = (const float*)(C.ws + WS_MOD) + 5 * D;
    const int lane = C.lane;
    LAS unsigned char* wl = C.lds + C.wave * 8192;
    LAS unsigned short* exl = (LAS unsigned short*)wl;
    LAS float* gtl = (LAS float*)(wl + 2048);
    LAS float* tops = (LAS float*)(wl + 6144);
    LAS int* topi = (LAS int*)(wl + 7168);
    const unsigned ij4 = P12_IJ4[lane & 15];
    const unsigned lo16 = 16u * (unsigned)lane; const unsigned char* pu6 = C.ws + WS_PU; const unsigned char* pv6 = C.ws + WS_PV;
    const float* su = (const float*)(C.ws + WS_PU + 96 * MB); const float* sv = (const float*)(C.ws + WS_PV + 96 * MB);
    const unsigned char* pu4 = C.ws + WS_PU4; const unsigned char* pv4 = C.ws + WS_PV4;
    const int tstride = gridDim.x * 8;
    for (int tb = blockIdx.x * 8 + C.wave; tb < T; tb += 8 * tstride) {
        int nb = 0;
#pragma unroll 1
        for (int s = 0; s < 8; ++s) { const int t = tb + s * tstride; if (t >= T) break;
            p12_route(pq + (size_t)t * 2048, tops, topi, exl + s * 128, gtl + s * 128, lane, ij4); ++nb; }
        const int nflat = nb * 128;
        u32x4 UA[3], VA[3], UB[3], VB[3], UC[3], VC[3], UD[3], VD[3]; float suA, svA, suB, svB, suC, svC, suD, svD;
#define P12_FMT(idx_) ((((idx_) & 15) < P12_HI) ? 6 : 4)
#define P12_LOAD(S, idx_, fmt_) do { const int e_ = __builtin_amdgcn_readfirstlane((int)exl[(idx_) < nflat ? (idx_) : nflat - 1]); \
        if ((fmt_) == 6) { const unsigned char* pu_ = pu6 + (size_t)e_ * 3072 + lo16; const unsigned char* pv_ = pv6 + (size_t)e_ * 3072 + lo16; \
            U##S[0] = *(const u32x4*)pu_; U##S[1] = *(const u32x4*)(pu_ + 1024); U##S[2] = *(const u32x4*)(pu_ + 2048); \
            V##S[0] = *(const u32x4*)pv_; V##S[1] = *(const u32x4*)(pv_ + 1024); V##S[2] = *(const u32x4*)(pv_ + 2048); su##S = su[e_]; sv##S = sv[e_]; } \
        else { const unsigned char* pu_ = pu4 + (size_t)e_ * 2176; const unsigned char* pv_ = pv4 + (size_t)e_ * 2176; \
            U##S[0] = *(const u32x4*)(pu_ + lo16); U##S[1] = *(const u32x4*)(pu_ + 1024 + lo16); su##S = bf2f(*(const bf16_t*)(pu_ + 2048 + 2 * lane)); \
            V##S[0] = *(const u32x4*)(pv_ + lo16); V##S[1] = *(const u32x4*)(pv_ + 1024 + lo16); sv##S = bf2f(*(const bf16_t*)(pv_ + 2048 + 2 * lane)); } } while (0)
#define P12_U4(w_, hh_, j_) do { \
        a0_ = dot2bf(__builtin_bit_cast(unsigned, __builtin_amdgcn_cvt_scalef32_pk_bf16_fp4((w_), 1.0f, 0)), hh_[(j_)], a0_); a1_ = dot2bf(__builtin_bit_cast(unsigned, __builtin_amdgcn_cvt_scalef32_pk_bf16_fp4((w_), 1.0f, 1)), hh_[(j_) + 1], a1_); \
        a2_ = dot2bf(__builtin_bit_cast(unsigned, __builtin_amdgcn_cvt_scalef32_pk_bf16_fp4((w_), 1.0f, 2)), hh_[(j_) + 2], a2_); a3_ = dot2bf(__builtin_bit_cast(unsigned, __builtin_amdgcn_cvt_scalef32_pk_bf16_fp4((w_), 1.0f, 3)), hh_[(j_) + 3], a3_); } while (0)
#define P12_V4(w_, oo_, j_) do { \
        oo_[(j_)] = act2_ * __builtin_amdgcn_cvt_scalef32_pk_f16_fp4((w_), 1.0f, 0) + oo_[(j_)]; oo_[(j_) + 1] = act2_ * __builtin_amdgcn_cvt_scalef32_pk_f16_fp4((w_), 1.0f, 1) + oo_[(j_) + 1]; \
        oo_[(j_) + 2] = act2_ * __builtin_amdgcn_cvt_scalef32_pk_f16_fp4((w_), 1.0f, 2) + oo_[(j_) + 2]; oo_[(j_) + 3] = act2_ * __builtin_amdgcn_cvt_scalef32_pk_f16_fp4((w_), 1.0f, 3) + oo_[(j_) + 3]; } while (0)
#define P12_COMPUTE(S, idx_, fmt_) do { float a0_ = 0.f, a1_ = 0.f, a2_ = 0.f, a3_ = 0.f; \
        if ((fmt_) == 6) { \
            const u32x16 ua_ = __builtin_bit_cast(u32x16, __builtin_amdgcn_cvt_scalef32_pk32_bf16_fp6((u32x6){U##S[0].x, U##S[0].y, U##S[0].z, U##S[0].w, U##S[1].x, U##S[1].y}, 1.0f)); \
            const u32x16 ub_ = __builtin_bit_cast(u32x16, __builtin_amdgcn_cvt_scalef32_pk32_bf16_fp6((u32x6){U##S[1].z, U##S[1].w, U##S[2].x, U##S[2].y, U##S[2].z, U##S[2].w}, 1.0f)); \
            _Pragma("unroll") for (int j = 0; j < 16; j += 4) { a0_ = dot2bf(ua_[j], hA[j], a0_); a1_ = dot2bf(ua_[j + 1], hA[j + 1], a1_); a2_ = dot2bf(ua_[j + 2], hA[j + 2], a2_); a3_ = dot2bf(ua_[j + 3], hA[j + 3], a3_); } \
            _Pragma("unroll") for (int j = 0; j < 16; j += 4) { a0_ = dot2bf(ub_[j], hB[j], a0_); a1_ = dot2bf(ub_[j + 1], hB[j + 1], a1_); a2_ = dot2bf(ub_[j + 2], hB[j + 2], a2_); a3_ = dot2bf(ub_[j + 3], hB[j + 3], a3_); } \
            const float a_ = wave_sum((a0_ + a1_) + (a2_ + a3_)) * su##S; \
            const float act_ = gelu_fast(a_) * gtl[idx_] * sv##S; const h2_t act2_ = {(_Float16)act_, (_Float16)act_}; \
            const h32_t va_ = __builtin_amdgcn_cvt_scalef32_pk32_f16_fp6((u32x6){V##S[0].x, V##S[0].y, V##S[0].z, V##S[0].w, V##S[1].x, V##S[1].y}, 1.0f); \
            _Pragma("unroll") for (int j = 0; j < 16; ++j) oA[j] = act2_ * (h2_t){va_[2 * j], va_[2 * j + 1]} + oA[j]; \
            const h32_t vb_ = __builtin_amdgcn_cvt_scalef32_pk32_f16_fp6((u32x6){V##S[1].z, V##S[1].w, V##S[2].x, V##S[2].y, V##S[2].z, V##S[2].w}, 1.0f); \
            _Pragma("unroll") for (int j = 0; j < 16; ++j) oB[j] = act2_ * (h2_t){vb_[2 * j], vb_[2 * j + 1]} + oB[j]; \
        } else { \
            P12_U4(U##S[0].x, hA, 0); P12_U4(U##S[0].y, hA, 4); P12_U4(U##S[0].z, hA, 8); P12_U4(U##S[0].w, hA, 12); \
            P12_U4(U##S[1].x, hB, 0); P12_U4(U##S[1].y, hB, 4); P12_U4(U##S[1].z, hB, 8); P12_U4(U##S[1].w, hB, 12); \
            const float a_ = wave_sum(((a0_ + a1_) + (a2_ + a3_)) * su##S); \
            const float act_ = gelu_fast(a_) * gtl[idx_] * sv##S; const h2_t act2_ = {(_Float16)act_, (_Float16)act_}; \
            P12_V4(V##S[0].x, oA, 0); P12_V4(V##S[0].y, oA, 4); P12_V4(V##S[0].z, oA, 8); P12_V4(V##S[0].w, oA, 12); \
            P12_V4(V##S[1].x, oB, 0); P12_V4(V##S[1].y, oB, 4); P12_V4(V##S[1].z, oB, 8); P12_V4(V##S[1].w, oB, 12); } } while (0)
        P12_LOAD(A, 0, P12_FMT(0)); P12_LOAD(B, 1, P12_FMT(1)); P12_LOAD(C, 2, P12_FMT(2)); P12_LOAD(D, 3, P12_FMT(3));
#pragma unroll 1
        for (int s = 0; s < nb; ++s) {
            const int t = tb + s * tstride;
            unsigned hA[16], hB[16];
            { u32x4 ra[4], rb[4];
#pragma unroll
              for (int i = 0; i < 4; ++i) { ra[i] = *(const u32x4*)(h2 + (size_t)t * D + 16 * lane + 1024 * i); rb[i] = *(const u32x4*)(h2 + (size_t)t * D + 16 * lane + 1024 * i + 8); }
#pragma unroll
              for (int q = 0; q < 4; ++q) {
                  hA[2 * q] = __builtin_amdgcn_perm(ra[1][q], ra[0][q], 0x05040100u); hA[2 * q + 1] = __builtin_amdgcn_perm(ra[1][q], ra[0][q], 0x07060302u);
                  hA[8 + 2 * q] = __builtin_amdgcn_perm(rb[1][q], rb[0][q], 0x05040100u); hA[8 + 2 * q + 1] = __builtin_amdgcn_perm(rb[1][q], rb[0][q], 0x07060302u);
                  hB[2 * q] = __builtin_amdgcn_perm(ra[3][q], ra[2][q], 0x05040100u); hB[2 * q + 1] = __builtin_amdgcn_perm(ra[3][q], ra[2][q], 0x07060302u);
                  hB[8 + 2 * q] = __builtin_amdgcn_perm(rb[3][q], rb[2][q], 0x05040100u); hB[8 + 2 * q + 1] = __builtin_amdgcn_perm(rb[3][q], rb[2][q], 0x07060302u); } }
            h2_t oA[16], oB[16];
#pragma unroll
            for (int j = 0; j < 16; ++j) { oA[j] = (h2_t){(_Float16)0.f, (_Float16)0.f}; oB[j] = (h2_t){(_Float16)0.f, (_Float16)0.f}; }
#pragma unroll 1
            for (int hh = 0; hh < 8; ++hh) {
                const int f0 = s * 128 + hh * 16;
#pragma unroll
                for (int k = 0; k < 16; k += 4) {
                    P12_COMPUTE(A, f0 + k, P12_FMT(k)); P12_LOAD(A, f0 + k + 4, P12_FMT(k + 4));
                    P12_COMPUTE(B, f0 + k + 1, P12_FMT(k + 1)); P12_LOAD(B, f0 + k + 5, P12_FMT(k + 5));
                    P12_COMPUTE(C, f0 + k + 2, P12_FMT(k + 2)); P12_LOAD(C, f0 + k + 6, P12_FMT(k + 6));
                    P12_COMPUTE(D, f0 + k + 3, P12_FMT(k + 3)); P12_LOAD(D, f0 + k + 7, P12_FMT(k + 7));
                }
            }
#pragma unroll
            for (int i = 0; i < 4; ++i) { const int d0 = 16 * lane + 1024 * i; const float* op = C.out + (size_t)t * D + d0; float* dp = dst + (size_t)t * D + d0;
#pragma unroll
                for (int q = 0; q < 4; ++q) { const f32x4 xv = *(const f32x4*)(op + 4 * q); const f32x4 gv = *(const f32x4*)(gt2 + d0 + 4 * q); f32x4 r;
#pragma unroll
                    for (int j = 0; j < 4; ++j) { const h2_t ov = (i < 2) ? oA[4 * q + j] : oB[4 * q + j]; r[j] = xv[j] + gv[j] * ((i & 1) ? (float)ov.y : (float)ov.x); }
                    __builtin_nontemporal_store(r, (f32x4*)(dp + 4 * q)); } }
        }
#undef P12_U4
#undef P12_V4
#undef P12_FMT
#undef P12_LOAD
#undef P12_COMPUTE
        lds_sync();
    }
}

constexpr int N_PHASES = 13;
#ifndef DBG_MIX
#define DBG_MIX 0
#endif
__global__ void __launch_bounds__(NTHREADS, 2) fwd(Args args) {
    extern __shared__ __attribute__((aligned(16))) unsigned char lds_raw[];
    Ctx C0; C0.in = args.in; C0.out = args.out; C0.ws = args.ws; C0.lds = (LAS unsigned char*)lds_raw;
    C0.tid = threadIdx.x; C0.lane = C0.tid & 63; C0.wave = __builtin_amdgcn_readfirstlane(C0.tid >> 6);
#define PHASE_CTX() Ctx C = C0; { int t_ = threadIdx.x; asm volatile("" : "+v"(t_)); C.tid = t_; C.lane = t_ & 63; C.wave = __builtin_amdgcn_readfirstlane(t_ >> 6); }
    const Ctx& C = C0;
    const int lo = args.ph_lo, hi = args.ph_hi;
    const bool fused = (hi - lo) > 1;
    volatile LAS unsigned* bst = (volatile LAS unsigned*)(C.lds + LDS_BYTES - 16);
    XcdBarrier bar; bar.bar = (unsigned*)(C.ws + WS_CTL + CTL_BAR); bar.x = 0; bar.st = bst;
    if (fused) { if (C.tid == 0) { bst[0] = 0u; bst[1] = 0u; bst[2] = 0u; bst[3] = 0u; } __syncthreads(); bar = xcd_barrier_post((unsigned*)(C.ws + WS_CTL + CTL_BAR), bst); }
#ifndef ONLY_PHASE
#define ONLY_PHASE -1
#endif
#define IN(k) (lo <= (k) && (k) < hi && (ONLY_PHASE < 0 || ONLY_PHASE == (k)))
#ifndef REP_PHASE
#define REP_PHASE -1
#endif
#define REP(k, ...) if (REP_PHASE == (k)) { __VA_ARGS__ }
#define SEAM(k) do { if (IN(k) && IN((k) + 1)) xcd_barrier(bar); } while (0)
    const float* mod = (const float*)(C.ws + WS_MOD);
    bf16_t* proj = (bf16_t*)(C.ws + WS_PROJ);
    if (IN(0)) { PHASE_CTX(); REP(0, p0_prologue(C); __syncthreads();) p0_prologue(C); } SEAM(0);
    if (IN(1)) { PHASE_CTX(); norm_mod_phase(C, C.in[I_X], C.in[I_GMIX], mod + 0 * D, mod + 1 * D, (bf16_t*)(C.ws + WS_H), C.ws + WS_H8); } SEAM(1);
    if (IN(2)) { PHASE_CTX(); pg8::Gemm g{(const bf16_t*)(C.ws + WS_H), (const bf16_t*)(C.ws + WS_WIN), T, NP_BF, D, D, D}; pg8::StaticOrder S; S.init(T, NP_BF, gridDim.x, blockIdx.x);
                 pg8::EpiPlain E{proj, NP, 1.f}; pg8::gemm_phase(C.lds, g, S, E);
                 pg8::Gemm g8{(const bf16_t*)(C.ws + WS_H8), (const bf16_t*)(C.ws + WS_WIN8), T, NP_F8, D / 2, D / 2, D / 2}; pg8::Fp8Order S8{(int)blockIdx.x};
                 pg8::EpiSigU8 E8{(unsigned char*)(proj + P_GM), NP * 2, 1.f / 64.f}; pg8::gemm_phase<pg8::EpiSigU8, pg8::Fp8Order, true>(C.lds, g8, S8, E8); } SEAM(2);
    if (IN(3)) { PHASE_CTX(); p3_post(C); } SEAM(3);
    if (IN(4)) { PHASE_CTX(); pg8::Gemm g{(const bf16_t*)(C.ws + WS_KC), (const bf16_t*)(C.ws + WS_W1T), 8192, 512, 512, 2048, D}; pg8::CmpOrder S{(int)gridDim.x, (int)blockIdx.x};
                 pg8::EpiSlab E{(float*)(C.ws + WS_HIDP)}; pg8::gemm_phase(C.lds, g, S, E); } SEAM(4);
    if (IN(5)) { PHASE_CTX(); p5_cmp_out(C); } SEAM(5);
    if (IN(6)) { PHASE_CTX(); p6_mixers(C, DBG_MIX); } SEAM(6);
    if (IN(7)) { PHASE_CTX(); pg8::Gemm g{(const bf16_t*)(C.ws + WS_YA), (const bf16_t*)(C.ws + WS_WBA), T, D, 1024, 1024, 1024};   pg8::StaticOrder S; S.init(T, D, gridDim.x, blockIdx.x);
                 pg8::EpiGate<0> E{(bf16_t*)(C.ws + WS_MERGED), D, (const unsigned char*)(proj + P_GM), NP * 2, 1.f / (16.f * 64.f * 255.f), nullptr}; pg8::gemm_phase<pg8::EpiGate<0>, pg8::StaticOrder, true>(C.lds, g, S, E); } if (IN(7) && IN(8)) __syncthreads();
    if (IN(8)) { PHASE_CTX(); pg8::Gemm g{(const bf16_t*)(C.ws + WS_YB), (const bf16_t*)(C.ws + WS_WBB), T, D, 1024, 1024, 1024}; pg8::StaticOrder S; S.init(T, D, gridDim.x, blockIdx.x);
                 pg8::EpiGate<1> E{(bf16_t*)(C.ws + WS_MERGED), D, (const unsigned char*)(proj + P_GM) + 4096, NP * 2, 1.f / (16.f * 64.f * 255.f), C.ws + WS_H8}; pg8::gemm_phase<pg8::EpiGate<1>, pg8::StaticOrder, true>(C.lds, g, S, E); } SEAM(8);
    if (IN(9)) { PHASE_CTX(); pg8::Gemm g{(const bf16_t*)(C.ws + WS_H8), (const bf16_t*)(C.ws + WS_WOUT), T, D, D / 2, D / 2, D / 2};   pg8::StaticOrder S; S.init(T, D, gridDim.x, blockIdx.x);
                 pg8::EpiResid E{C.out, C.in[I_X], mod + 2 * D, D, 1.f / (32.f * 64.f)}; pg8::gemm_phase<pg8::EpiResid, pg8::StaticOrder, true>(C.lds, g, S, E); } SEAM(9);
    if (IN(10)) { PHASE_CTX(); norm_mod_phase(C, C.out, C.in[I_GFFN], mod + 3 * D, mod + 4 * D, (bf16_t*)(C.ws + WS_H2)); } SEAM(10);
    if (IN(11)) { PHASE_CTX(); pg8::Gemm g{(const bf16_t*)(C.ws + WS_H2), (const bf16_t*)(C.ws + WS_WQ), T, 2048, D, D, D}; pg8::StaticOrder S; S.init(T, 2048, gridDim.x, blockIdx.x);
                  pg8::EpiPlain E{(bf16_t*)(C.ws + WS_PQ), 2048, 1.f}; pg8::gemm_phase(C.lds, g, S, E); } SEAM(11);
    if (IN(12)) { PHASE_CTX(); REP(12, p12_peer(C, (float*)(C.ws + WS_PROJ)); __syncthreads();) p12_peer(C, C.out); }
#undef IN
#undef SEAM
}

#ifndef N_LAUNCH_MODE
#define N_LAUNCH_MODE 1
#endif
extern "C" void kernel_launch(void* const* d_in, const int* in_sizes, int n_in, void* d_out, int out_size, void* d_ws, size_t ws_size, hipStream_t stream) {
    static int grid = 0;
    if (grid == 0) {
        if (n_in != 27 || out_size != T * D || ws_size < WS_END) { fprintf(stderr, "kernel_launch: unexpected shapes (n_in %d out %d ws %zu need %zu)\n", n_in, out_size, ws_size, (size_t)WS_END); grid = -1; return; }
        int dev = 0, cus = 0;
        if (hipGetDevice(&dev) != hipSuccess || hipDeviceGetAttribute(&cus, hipDeviceAttributeMultiprocessorCount, dev) != hipSuccess) { grid = -1; return; }
        if (hipFuncSetAttribute((const void*)fwd, hipFuncAttributeMaxDynamicSharedMemorySize, LDS_BYTES) != hipSuccess) { fprintf(stderr, "kernel_launch: hipFuncSetAttribute failed\n"); grid = -1; return; }
        int per_cu = 0;
        if (hipOccupancyMaxActiveBlocksPerMultiprocessor(&per_cu, (const void*)fwd, NTHREADS, LDS_BYTES) != hipSuccess || per_cu < 1) { fprintf(stderr, "kernel_launch: occupancy query says %d\n", per_cu); }
        (void)hipGetLastError();
        grid = cus;
    }
    if (grid < 0) return;
    (void)hipMemsetAsync((char*)d_ws + WS_CTL, 0, 64 * 1024, stream);
    Args a{};
    for (int i = 0; i < 27; ++i) a.in[i] = (const float*)d_in[i];
    a.out = (float*)d_out; a.ws = (unsigned char*)d_ws;
#if N_LAUNCH_MODE == 1
    a.ph_lo = 0; a.ph_hi = N_PHASES;
    hipLaunchKernelGGL(fwd, dim3(grid), dim3(NTHREADS), LDS_BYTES, stream, a);
#else
    for (int p = 0; p < N_PHASES; ++p) { a.ph_lo = p; a.ph_hi = p + 1; hipLaunchKernelGGL(fwd, dim3(grid), dim3(NTHREADS), LDS_BYTES, stream, a); }
#endif
}
```

```cpp
#include <hip/hip_runtime.h>
#include <cstdio>
#include <cstdint>

#define LAS __attribute__((address_space(3)))
typedef unsigned short bf16_t;
typedef unsigned long long u64;
typedef short bf16x8 __attribute__((ext_vector_type(8)));
typedef float f32x4 __attribute__((ext_vector_type(4)));
typedef float f32x16 __attribute__((ext_vector_type(16)));
typedef unsigned u32x4 __attribute__((ext_vector_type(4)));
typedef unsigned u32x2 __attribute__((ext_vector_type(2)));
typedef __bf16 bf2_t __attribute__((ext_vector_type(2)));
typedef float f32x2 __attribute__((ext_vector_type(2)));
typedef float f32x32 __attribute__((ext_vector_type(32)));
typedef unsigned u32x6 __attribute__((ext_vector_type(6)));

constexpr int T = 16384, D = 4096, NP = 18688;
constexpr int P_QA = 0, P_KA = 2048, P_VA = 2560, P_QI = 3072, P_QB = 5120, P_KC = 7168, P_VC = 7680, P_KS = 8192, P_VS = 8704,
              P_KW = 9216, P_VW = 9728, P_KI = 10240, P_WI = 10304, P_GB = 10336, P_GM = 10496;
constexpr int NP_BF = 10496, NP_F8 = 8192;
constexpr int NCMP = 1023;
constexpr float EPS = 1e-6f;
constexpr int NTHREADS = 512;
constexpr int LDS_BYTES = 160 * 1024;

constexpr size_t MB = 1024ull * 1024ull;
constexpr size_t WS_CTL = 0;
constexpr size_t WS_MOD = 64 * 1024;
constexpr size_t WS_B1 = 192 * 1024;
constexpr size_t WS_B1P = 196 * 1024;
constexpr size_t WS_W1T = 512 * 1024;
constexpr size_t WS_SUBK = WS_W1T + 4 * MB;
constexpr size_t WS_HID = WS_SUBK + 512 * 1024;
constexpr size_t WS_KCMP = WS_HID + 8 * MB;
constexpr size_t WS_VCMPT = WS_KCMP + 1 * MB;
constexpr size_t WS_KIC = WS_VCMPT + 1 * MB;
constexpr size_t WS_KC = WS_KIC + 2 * MB;
constexpr size_t WS_VST = WS_KC + 32 * MB + 64 * 1024;
constexpr size_t WS_VWT = WS_VST + 16 * MB;
constexpr size_t WS_WBA = WS_VWT + 16 * MB;
constexpr size_t WS_WBB = WS_WBA + 16 * MB;
constexpr size_t WS_WOUT = WS_WBB + 16 * MB;
constexpr size_t WS_WQ = WS_WOUT + 32 * MB;
constexpr size_t WS_PU = WS_WQ + 16 * MB;
constexpr size_t WS_PV = WS_PU + 128 * MB;
constexpr size_t WS_PU4 = WS_PU + 56 * MB, WS_PV4 = WS_PV + 56 * MB;
constexpr size_t WS_PROJ = WS_PV + 128 * MB;
constexpr size_t WS_WIN = WS_PROJ + (size_t)T * NP * 2;
constexpr size_t WS_H = WS_WIN + (size_t)NP * D * 2;
constexpr size_t WS_KA = WS_H + 128 * MB;
constexpr size_t WS_VA = WS_KA + 16 * MB;
constexpr size_t WS_KSC = WS_VA + 16 * MB;
constexpr size_t WS_KWC = WS_KSC + 16 * MB;
constexpr size_t WS_HIDP = WS_KWC + 16 * MB;
constexpr size_t WS_OACC = WS_HIDP + 64 * MB;
constexpr size_t WS_H8 = WS_OACC + 32 * MB;
constexpr size_t WS_END = WS_H8 + 64 * MB;
constexpr size_t WS_WIN8 = WS_WIN + (size_t)NP_BF * D * 2;
constexpr size_t WS_YA = WS_WIN, WS_YB = WS_WIN + 64 * MB, WS_H2 = WS_WIN;
constexpr size_t WS_MERGED = WS_H, WS_PQ = WS_H;
constexpr size_t CTL_BAR = 0, CTL_CNT = 16384;

__device__ __forceinline__ float bf2f(bf16_t b) { return __uint_as_float(((unsigned)b) << 16); }
__device__ __forceinline__ float bflo(unsigned u) { return __uint_as_float(u << 16); }
__device__ __forceinline__ float bfhi(unsigned u) { return __uint_as_float(u & 0xFFFF0000u); }
__device__ __forceinline__ unsigned cvt_pk_bf16(float lo, float hi) { unsigned r; asm volatile("v_cvt_pk_bf16_f32 %0, %1, %2" : "=v"(r) : "v"(lo), "v"(hi)); return r; }
__device__ __forceinline__ bf16_t f2bf(float f) { return (bf16_t)(cvt_pk_bf16(f, 0.f) & 0xFFFFu); }
__device__ __forceinline__ float dot2bf(unsigned a, unsigned b, float c) { return __builtin_amdgcn_fdot2_f32_bf16(__builtin_bit_cast(bf2_t, a), __builtin_bit_cast(bf2_t, b), c, false); }
template <int CTRL> __device__ __forceinline__ float dppf(float v) { return __builtin_bit_cast(float, __builtin_amdgcn_update_dpp(0, __builtin_bit_cast(int, v), CTRL, 0xF, 0xF, true)); }
template <int CTRL> __device__ __forceinline__ unsigned dppu(unsigned v) { return (unsigned)__builtin_amdgcn_update_dpp(0, (int)v, CTRL, 0xF, 0xF, true); }
__device__ __forceinline__ void swap32f(float& a, float& b) { asm volatile("s_nop 1\n\tv_permlane32_swap_b32 %0, %1" : "+v"(a), "+v"(b)); }
__device__ __forceinline__ void swap16f(float& a, float& b) { asm volatile("s_nop 1\n\tv_permlane16_swap_b32 %0, %1" : "+v"(a), "+v"(b)); }
__device__ __forceinline__ void swap32u(unsigned& a, unsigned& b) { asm volatile("s_nop 1\n\tv_permlane32_swap_b32 %0, %1" : "+v"(a), "+v"(b)); }
__device__ __forceinline__ void swap16u(unsigned& a, unsigned& b) { asm volatile("s_nop 1\n\tv_permlane16_swap_b32 %0, %1" : "+v"(a), "+v"(b)); }
__device__ __forceinline__ float fmax_fast(float a, float b) { float r; asm("v_max_f32 %0, %1, %2" : "=v"(r) : "v"(a), "v"(b)); return r; }
__device__ __forceinline__ float xsum32(float v) { float a = v, b = v; swap32f(a, b); return a + b; }
__device__ __forceinline__ float xsum16(float v) { float a = v, b = v; swap16f(a, b); return a + b; }
__device__ __forceinline__ float xmax32(float v) { float a = v, b = v; swap32f(a, b); return fmax_fast(a, b); }
__device__ __forceinline__ float xmax16(float v) { float a = v, b = v; swap16f(a, b); return fmax_fast(a, b); }
__device__ __forceinline__ float xor32f(float v, int h) { float a = v, b = v; swap32f(a, b); return h ? a : b; }
__device__ __forceinline__ float wave_sum(float v) { v += dppf<0xB1>(v); v += dppf<0x4E>(v); v += dppf<0x141>(v); v += dppf<0x140>(v); return xsum16(xsum32(v)); }
__device__ __forceinline__ float wave_max(float v) { v = fmax_fast(v, dppf<0xB1>(v)); v = fmax_fast(v, dppf<0x4E>(v)); v = fmax_fast(v, dppf<0x141>(v)); v = fmax_fast(v, dppf<0x140>(v)); return xmax16(xmax32(v)); }
__device__ __forceinline__ unsigned umaxu(unsigned a, unsigned b) { return a > b ? a : b; }
__device__ __forceinline__ unsigned wave_maxu(unsigned v) { v = umaxu(v, dppu<0xB1>(v)); v = umaxu(v, dppu<0x4E>(v)); v = umaxu(v, dppu<0x141>(v)); v = umaxu(v, dppu<0x140>(v));
    unsigned a = v, b = v; swap32u(a, b); v = umaxu(a, b); a = v; b = v; swap16u(a, b); return umaxu(a, b); }
__device__ __forceinline__ void lds_sync() { asm volatile("s_waitcnt lgkmcnt(0)" ::: "memory"); __builtin_amdgcn_wave_barrier(); }
__device__ __forceinline__ float gelu_tanh(float x) { const float u = 0.7978845608028654f * (x + 0.044715f * x * x * x); const float e = __expf(2.f * u); return 0.5f * x * (2.f - 2.f / (e + 1.f)); }
__device__ __forceinline__ float sigmoidf_(float x) { return __builtin_amdgcn_rcpf(1.f + __expf(-x)); }
__device__ __forceinline__ unsigned sortable(float s) { unsigned b = __float_as_uint(s); return b ^ ((b >> 31) ? 0xFFFFFFFFu : 0x80000000u); }

#define XB_TMO      128
#define XB_XCNT(j)  (256  + 64 * (j))
#define XB_XSUB(j)  (1280 + 64 * (j))
#define XB_XGEN(j)  (2304 + 64 * (j))
#define XB_TOP      3328
#define XB_TOPGEN   3392
#define XCD_BAR_WORDS 3456
#define XB_SPIN_CAP (1u << 24)
__device__ __forceinline__ unsigned xb_ld(unsigned* p)              { return __hip_atomic_load(p, __ATOMIC_RELAXED, __HIP_MEMORY_SCOPE_AGENT); }
__device__ __forceinline__ unsigned xb_add(unsigned* p, unsigned v) { return __hip_atomic_fetch_add(p, v, __ATOMIC_RELAXED, __HIP_MEMORY_SCOPE_AGENT); }
__device__ __forceinline__ unsigned xb_xcc_id() { return (unsigned)__builtin_amdgcn_s_getreg((3 << 11) | 20) & 0xFu; }
#define XB_SPIN(cond, bar) do { unsigned _sp = 0; while (cond) { __builtin_amdgcn_s_sleep(1); \
    if ((++_sp & 255u) == 0u) { if (xb_ld(&(bar)[XB_TMO])) break; if (_sp > XB_SPIN_CAP) { atomicAdd(&(bar)[XB_TMO], 1u); break; } } } } while (0)
struct XcdBarrier { unsigned* bar; unsigned x; volatile LAS unsigned* st; };
__device__ __forceinline__ XcdBarrier xcd_barrier_post(unsigned* bar, volatile LAS unsigned* st) {
    XcdBarrier b; b.bar = bar; b.x = xb_xcc_id(); b.st = st;
    if (threadIdx.x == 0) (void)xb_add(&bar[XB_XCNT(b.x)], 1u);
    return b;
}
__device__ __forceinline__ void xcd_barrier_complete(unsigned* bar, unsigned x, unsigned& nloc, unsigned& nx) {
    const unsigned G = gridDim.x * gridDim.y * gridDim.z;
    unsigned sum, cnt, mine, sp = 0u;
    for (;;) {
        sum = 0u; cnt = 0u; mine = 0u;
#pragma unroll
        for (unsigned j = 0; j < 16; ++j) { const unsigned c = xb_ld(&bar[XB_XCNT(j)]); sum += c; cnt += (c > 0u) ? 1u : 0u; mine = (j == x) ? c : mine; }
        if (sum == G) break;
        __builtin_amdgcn_s_sleep(1);
        if ((++sp & 255u) == 0u) { if (xb_ld(&bar[XB_TMO])) break; if (sp > XB_SPIN_CAP) { atomicAdd(&bar[XB_TMO], 1u); break; } }
    }
    nloc = mine > 0u ? mine : 1u; nx = cnt > 0u ? cnt : 1u;
}
__device__ __forceinline__ void xcd_barrier(const XcdBarrier& b) {
    asm volatile("s_waitcnt vmcnt(0)" ::: "memory");
    __syncthreads();
    if (threadIdx.x == 0) {
        unsigned* bar = b.bar;
        __builtin_amdgcn_s_waitcnt(0);
        unsigned nloc = b.st[0], nx = b.st[1];
        if (nloc == 0u) { xcd_barrier_complete(bar, b.x, nloc, nx); b.st[0] = nloc; b.st[1] = nx; }
        const unsigned old = xb_add(&bar[XB_XSUB(b.x)], 1u);
        const unsigned gen = old / nloc;
        if (old + 1u == (gen + 1u) * nloc) {
            __builtin_amdgcn_fence(__ATOMIC_RELEASE, "agent");
            asm volatile("s_waitcnt vmcnt(0)" ::: "memory");
            const unsigned og = xb_add(&bar[XB_TOP], 1u);
            const unsigned tg = og / nx;
            if (og + 1u == (tg + 1u) * nx) xb_add(&bar[XB_TOPGEN], 1u);
            else XB_SPIN(xb_ld(&bar[XB_TOPGEN]) == tg, bar);
            __builtin_amdgcn_fence(__ATOMIC_ACQUIRE, "agent");
            xb_add(&bar[XB_XGEN(b.x)], 1u);
            asm volatile("s_waitcnt vmcnt(0)" ::: "memory");
        } else {
            XB_SPIN(xb_ld(&bar[XB_XGEN(b.x)]) == gen, bar);
            __builtin_amdgcn_fence(__ATOMIC_ACQUIRE, "agent");
            asm volatile("s_waitcnt vmcnt(0)" ::: "memory");
        }
    }
    __syncthreads();
}

namespace pg8 {
constexpr int BM = 256, BK = 64, HALF = 128, HTB = HALF * BK * 2, STAGE_BYTES = 8 * HTB, NXCD = 8, WGM = 8;
__host__ __device__ __forceinline__ int lds_byte(int r, int c) { const int st = (r >> 4) * 2 + (c >> 5), rr = r & 15, cc = c & 31, ob = rr * 64 + cc * 2; return st * 1024 + (ob ^ (((ob >> 9) & 1) << 5)); }
__host__ __device__ __forceinline__ void stage_rc(int b, int& R, int& C) { const int st = b / 1024, sb = b % 1024, swz = sb ^ (((sb >> 9) & 1) << 5); R = (st >> 1) * 16 + swz / 64; C = (st & 1) * 32 + (swz % 64) / 2; }
__host__ __device__ __forceinline__ int perm32(int rho) { const int n = rho >> 4, i = rho & 15; return 8 * (i >> 2) + 4 * n + (i & 3); }
struct Unit { int pm, pn, kofs; };
struct Gemm { const bf16_t* A; const bf16_t* Bt; int M, N, K, lda, ldb; };
struct StaticOrder {
    int nM, nN, nwg, G, c;
    __host__ __device__ void init(int M, int N, int G_, int c_) { nM = M / BM; nN = N / BM; nwg = nM * nN; G = G_; c = c_; }
    __host__ __device__ bool next(int i, Unit& u) const {
        const long L = (long)i * G + c; if (L >= nwg) return false;
        int wgid = (int)L; { const int q = nwg / NXCD, r = nwg % NXCD, xcd = wgid % NXCD, off = wgid / NXCD; wgid = (xcd < r ? xcd * (q + 1) : r * (q + 1) + (xcd - r) * q) + off; }
        const int nig = WGM * nN, gid = wgid / nig, fm = gid * WGM, gsz = (nM - fm) < WGM ? (nM - fm) : WGM;
        u.pm = fm + ((wgid % nig) % gsz); u.pn = (wgid % nig) / gsz; u.kofs = 0; return true;
    }
};
struct Fp8Order {
    int c;
    __host__ __device__ bool next(int i, Unit& u) const {
        const int cnt = c < 64 ? 6 : (c < 192 ? 9 : 8); if (i >= cnt) return false;
        const int off = c < 64 ? 6 * c : (c < 192 ? 384 + 9 * (c - 64) : 1536 + 8 * (c - 192));
        const int L = off + i; u.pm = L & 63; u.pn = L >> 6; u.kofs = 0; return true; }
};
struct CmpOrder {
    int G, c;
    __host__ __device__ bool next(int i, Unit& u) const { const long L = (long)i * G + c; if (L >= 256) return false; u.pm = (int)(L & 31); u.pn = u.pm >> 4; u.kofs = (int)(L >> 5) * 512; return true; }
};

struct EpiPlain {
    static constexpr bool PERM = true;
    bf16_t* O; int ldc; float scale;
    __device__ __forceinline__ void operator()(const f32x4 (&acc)[2][2][4][2], const Unit& u, int wr, int wc, int fr, int fq) const {
        const int row0 = u.pm * BM + wr * 64 + fr, col0 = u.pn * BM + wc * 32 + 8 * fq;
#pragma unroll
        for (int ai = 0; ai < 2; ++ai)
#pragma unroll
            for (int m = 0; m < 4; ++m) { bf16_t* rowp = O + (size_t)(row0 + ai * HALF + m * 16) * ldc + col0;
#pragma unroll
                for (int bj = 0; bj < 2; ++bj) { const f32x4 v0 = acc[ai][bj][m][0] * scale, v1 = acc[ai][bj][m][1] * scale;
                    u32x4 w; w.x = cvt_pk_bf16(v0[0], v0[1]); w.y = cvt_pk_bf16(v0[2], v0[3]); w.z = cvt_pk_bf16(v1[0], v1[1]); w.w = cvt_pk_bf16(v1[2], v1[3]);
                    *(u32x4*)(rowp + bj * HALF) = w; } }
    }
};
struct EpiSigU8 {
    static constexpr bool PERM = true;
    unsigned char* O; int ldb; float scale;
    __device__ __forceinline__ void operator()(const f32x4 (&acc)[2][2][4][2], const Unit& u, int wr, int wc, int fr, int fq) const {
        const int row0 = u.pm * BM + wr * 64 + fr, col0 = u.pn * BM + wc * 32 + 8 * fq;
#pragma unroll
        for (int ai = 0; ai < 2; ++ai)
#pragma unroll
            for (int m = 0; m < 4; ++m) { unsigned char* rowp = O + (size_t)(row0 + ai * HALF + m * 16) * ldb + col0;
#pragma unroll
                for (int bj = 0; bj < 2; ++bj) { const f32x4 v0 = acc[ai][bj][m][0] * scale, v1 = acc[ai][bj][m][1] * scale;
                    unsigned w0 = 0u, w1 = 0u;
                    w0 = __builtin_amdgcn_cvt_pk_u8_f32(255.f * sigmoidf_(v0[0]), 0, w0); w0 = __builtin_amdgcn_cvt_pk_u8_f32(255.f * sigmoidf_(v0[1]), 1, w0);
                    w0 = __builtin_amdgcn_cvt_pk_u8_f32(255.f * sigmoidf_(v0[2]), 2, w0); w0 = __builtin_amdgcn_cvt_pk_u8_f32(255.f * sigmoidf_(v0[3]), 3, w0);
                    w1 = __builtin_amdgcn_cvt_pk_u8_f32(255.f * sigmoidf_(v1[0]), 0, w1); w1 = __builtin_amdgcn_cvt_pk_u8_f32(255.f * sigmoidf_(v1[1]), 1, w1);
                    w1 = __builtin_amdgcn_cvt_pk_u8_f32(255.f * sigmoidf_(v1[2]), 2, w1); w1 = __builtin_amdgcn_cvt_pk_u8_f32(255.f * sigmoidf_(v1[3]), 3, w1);
                    *(u32x2*)(rowp + bj * HALF) = (u32x2){w0, w1}; } }
    }
};
template <int SECOND> struct EpiGate {
    static constexpr bool PERM = true;
    bf16_t* O; int ldc; const unsigned char* gate; int ldg; float scale; unsigned char* O8;
    __device__ __forceinline__ void operator()(const f32x4 (&acc)[2][2][4][2], const Unit& u, int wr, int wc, int fr, int fq) const {
        const int row0 = u.pm * BM + wr * 64 + fr, col0 = u.pn * BM + wc * 32 + 8 * fq;
#pragma unroll
        for (int ai = 0; ai < 2; ++ai)
#pragma unroll
            for (int m = 0; m < 4; ++m) { const size_t row = (size_t)(row0 + ai * HALF + m * 16); bf16_t* rowp = O + row * ldc + col0; const unsigned char* gp = gate + row * ldg + col0;
#pragma unroll
                for (int bj = 0; bj < 2; ++bj) { const f32x4 v0 = acc[ai][bj][m][0] * scale, v1 = acc[ai][bj][m][1] * scale;
                    const u32x2 gv = *(const u32x2*)(gp + bj * HALF);
                    float r[8];
#pragma unroll
                    for (int e = 0; e < 4; ++e) { r[e] = (float)((gv.x >> (8 * e)) & 0xFFu) * v0[e]; r[4 + e] = (float)((gv.y >> (8 * e)) & 0xFFu) * v1[e]; }
                    if (SECOND) { const u32x4 pv = *(const u32x4*)(rowp + bj * HALF);
                        r[0] += bflo(pv.x); r[1] += bfhi(pv.x); r[2] += bflo(pv.y); r[3] += bfhi(pv.y); r[4] += bflo(pv.z); r[5] += bfhi(pv.z); r[6] += bflo(pv.w); r[7] += bfhi(pv.w);
                        int p0 = __builtin_amdgcn_cvt_pk_fp8_f32(r[0] * 32.f, r[1] * 32.f, 0, false); p0 = __builtin_amdgcn_cvt_pk_fp8_f32(r[2] * 32.f, r[3] * 32.f, p0, true);
                        int p1 = __builtin_amdgcn_cvt_pk_fp8_f32(r[4] * 32.f, r[5] * 32.f, 0, false); p1 = __builtin_amdgcn_cvt_pk_fp8_f32(r[6] * 32.f, r[7] * 32.f, p1, true);
                        *(u32x2*)(O8 + row * ldc + col0 + bj * HALF) = (u32x2){(unsigned)p0, (unsigned)p1};
                    } else {
                    u32x4 w; w.x = cvt_pk_bf16(r[0], r[1]); w.y = cvt_pk_bf16(r[2], r[3]); w.z = cvt_pk_bf16(r[4], r[5]); w.w = cvt_pk_bf16(r[6], r[7]);
                    *(u32x4*)(rowp + bj * HALF) = w; } } }
    }
};
struct EpiResid {
    static constexpr bool PERM = false;
    float* C; const float* X; const float* gt; int ldc; float scale;
    __device__ __forceinline__ void operator()(const f32x4 (&acc)[2][2][4][2], const Unit& u, int wr, int wc, int fr, int fq) const {
        const int row0 = u.pm * BM + wr * 64 + fr, col0 = u.pn * BM + wc * 32 + 4 * fq;
        f32x4 gv[2][2];
#pragma unroll
        for (int bj = 0; bj < 2; ++bj)
#pragma unroll
            for (int n = 0; n < 2; ++n) gv[bj][n] = *(const f32x4*)(gt + col0 + bj * HALF + n * 16) * scale;
#pragma unroll
        for (int ai = 0; ai < 2; ++ai)
#pragma unroll
            for (int m = 0; m < 4; ++m) { const size_t off = (size_t)(row0 + ai * HALF + m * 16) * ldc + col0;
#pragma unroll
                for (int bj = 0; bj < 2; ++bj)
#pragma unroll
                    for (int n = 0; n < 2; ++n) { const f32x4 xv = *(const f32x4*)(X + off + bj * HALF + n * 16);
                        *(f32x4*)(C + off + bj * HALF + n * 16) = xv + gv[bj][n] * acc[ai][bj][m][n]; } }
    }
};
struct EpiSlab {
    static constexpr bool PERM = false;
    float* C;
    __device__ __forceinline__ void operator()(const f32x4 (&acc)[2][2][4][2], const Unit& u, int wr, int wc, int fr, int fq) const {
        const int row0 = u.pm * BM + wr * 64 + fr, col0 = wc * 32 + 4 * fq;
        float* base = C + (size_t)(u.kofs >> 9) * 8192 * 256;
#pragma unroll
        for (int ai = 0; ai < 2; ++ai)
#pragma unroll
            for (int m = 0; m < 4; ++m) { float* rowp = base + (size_t)(row0 + ai * HALF + m * 16) * 256 + col0;
#pragma unroll
                for (int bj = 0; bj < 2; ++bj)
#pragma unroll
                    for (int n = 0; n < 2; ++n) *(f32x4*)(rowp + bj * HALF + n * 16) = acc[ai][bj][m][n]; }
    }
};

typedef int i32x8 __attribute__((ext_vector_type(8)));
template <class Epi, class Sched, bool FP8 = false>
__device__ __forceinline__ void gemm_phase(LAS unsigned char* lds, const Gemm g, const Sched& S, const Epi& E) {
    const int tid = threadIdx.x, wid = __builtin_amdgcn_readfirstlane(tid >> 6), lane = tid & 63, wr = wid >> 2, wc = wid & 3, fr = lane & 15, fq = lane >> 4;
    const int K = g.K, nt = K / BK, lda = g.lda, ldb = g.ldb;
    unsigned voffA[2], voffB[2];
#pragma unroll
    for (int i = 0; i < 2; ++i) { int R, C; stage_rc(tid * 16 + i * 8192, R, C); const int Rb = Epi::PERM ? ((R & ~31) + perm32(R & 31)) : R;
        voffA[i] = (unsigned)(R * lda + C) * 2u; voffB[i] = (unsigned)(Rb * ldb + C) * 2u; }
    const size_t kstep = (size_t)(BK * 2);
    const size_t hstepA = (size_t)HALF * lda * 2, hstepB = (size_t)HALF * ldb * 2;
    const size_t tstepA = 2 * hstepA, tstepB = 2 * hstepB;
    const unsigned ldsw = (unsigned)wid * 1024u;
    const int aoff = lds_byte(wr * 64 + fr, fq * 8), boff = lds_byte(wc * 32 + fr, fq * 8);
#define PG8_SA(b, h) (((b) * 2 + (h)) * HTB)
#define PG8_SB(b, h) ((4 + (b) * 2 + (h)) * HTB)
#define PG8_STAGE(bufoff, gbase, voff) do { _Pragma("unroll") for (int _i = 0; _i < 2; ++_i) \
        __builtin_amdgcn_global_load_lds((const unsigned*)((const char*)(gbase) + (voff)[_i]), (LAS unsigned*)(lds + (bufoff) + ldsw + _i * 8192), 16, 0, 0); } while (0)
#define PG8_LDA(dst, b, h) do { _Pragma("unroll") for (int m = 0; m < 4; ++m) { if constexpr (FP8) dst##8[m] = __builtin_shufflevector(*(const LAS i32x4_*)(lds + PG8_SA(b, h) + aoff + m * 2048), *(const LAS i32x4_*)(lds + PG8_SA(b, h) + aoff + m * 2048 + 1024), 0, 1, 2, 3, 4, 5, 6, 7); \
        else { _Pragma("unroll") for (int k = 0; k < 2; ++k) dst[m][k] = *(const LAS bf16x8*)(lds + PG8_SA(b, h) + aoff + m * 2048 + k * 1024); } } } while (0)
#define PG8_LDB(dst, b, h) do { _Pragma("unroll") for (int n = 0; n < 2; ++n) { if constexpr (FP8) dst##8[n] = __builtin_shufflevector(*(const LAS i32x4_*)(lds + PG8_SB(b, h) + boff + n * 2048), *(const LAS i32x4_*)(lds + PG8_SB(b, h) + boff + n * 2048 + 1024), 0, 1, 2, 3, 4, 5, 6, 7); \
        else { _Pragma("unroll") for (int k = 0; k < 2; ++k) dst[n][k] = *(const LAS bf16x8*)(lds + PG8_SB(b, h) + boff + n * 2048 + k * 1024); } } } while (0)
typedef int i32x4_ __attribute__((ext_vector_type(4)));
#define PG8_MMA(ai, bj, At, Bt) do { __builtin_amdgcn_s_setprio(1); _Pragma("unroll") for (int m = 0; m < 4; ++m) _Pragma("unroll") for (int n = 0; n < 2; ++n) { \
        if constexpr (FP8) asm volatile("v_mfma_scale_f32_16x16x128_f8f6f4 %0, %1, %2, %0, %3, %3 op_sel_hi:[0,0,0]" : "+v"(acc[ai][bj][m][n]) : "v"(Bt##8[n]), "v"(At##8[m]), "v"(one_scale)); \
        else { _Pragma("unroll") for (int k = 0; k < 2; ++k) acc[ai][bj][m][n] = __builtin_amdgcn_mfma_f32_16x16x32_bf16(Bt[n][k], At[m][k], acc[ai][bj][m][n], 0, 0, 0); } } \
        __builtin_amdgcn_s_setprio(0); } while (0)
#define PG8_WAIT_V(n) asm volatile("s_waitcnt vmcnt(" #n ")" ::: "memory")
#define PG8_WAIT_L(n) asm volatile("s_waitcnt lgkmcnt(" #n ")" ::: "memory")
#define PG8_BAR __builtin_amdgcn_s_barrier()
#define PG8_SCHED __builtin_amdgcn_sched_barrier(0)
    Unit cur, nxt; int ui = 0;
    if (!S.next(0, cur)) return;
    f32x4 acc[2][2][4][2];
#pragma unroll
    for (int a = 0; a < 2; ++a)
#pragma unroll
        for (int b = 0; b < 2; ++b)
#pragma unroll
            for (int m = 0; m < 4; ++m)
#pragma unroll
                for (int n = 0; n < 2; ++n) acc[a][b][m][n] = (f32x4){0.f, 0.f, 0.f, 0.f};
    bf16x8 At[4][2], B0[2][2], B1[2][2];
    i32x8 At8[4], B08[2], B18[2];
    const int one_scale = 0x7F7F7F7F;
    const char* cA = (const char*)g.A + (size_t)cur.pm * tstepA + (size_t)cur.kofs * 2; const char* cB = (const char*)g.Bt + (size_t)cur.pn * tstepB + (size_t)cur.kofs * 2;
    PG8_STAGE(PG8_SB(0, 0), cB, voffB); PG8_STAGE(PG8_SB(0, 1), cB + hstepB, voffB); PG8_STAGE(PG8_SA(0, 0), cA, voffA); PG8_STAGE(PG8_SA(0, 1), cA + hstepA, voffA);
    if (wr == 1) PG8_BAR;
    PG8_WAIT_V(2); PG8_BAR;
    PG8_STAGE(PG8_SB(1, 0), cB + kstep, voffB); PG8_STAGE(PG8_SA(1, 0), cA + kstep, voffA); PG8_STAGE(PG8_SB(1, 1), cB + hstepB + kstep, voffB);
    PG8_WAIT_V(6); PG8_BAR;
    for (;;) {
        const bool has_next = S.next(ui + 1, nxt);
        const char* nA = has_next ? (const char*)g.A + (size_t)nxt.pm * tstepA + (size_t)nxt.kofs * 2 : cA; const char* nB = has_next ? (const char*)g.Bt + (size_t)nxt.pn * tstepB + (size_t)nxt.kofs * 2 : cB;
        for (int t = 0; t < nt; t += 2) {
            const bool last = (t == nt - 2);
            const char* a1 = cA + (size_t)(t + 1) * kstep;
            const char* a2 = last ? nA : cA + (size_t)(t + 2) * kstep; const char* b2 = last ? nB : cB + (size_t)(t + 2) * kstep;
            const char* a3 = a2 + kstep; const char* b3 = b2 + kstep;
            PG8_LDB(B0, 0, 0); PG8_LDB(B1, 0, 1); PG8_SCHED; PG8_LDA(At, 0, 0); PG8_STAGE(PG8_SA(1, 1), a1 + hstepA, voffA);
            PG8_WAIT_V(8); PG8_WAIT_L(0); PG8_BAR; PG8_MMA(0, 0, At, B0); PG8_MMA(0, 1, At, B1); PG8_BAR; PG8_SCHED;
            PG8_LDA(At, 0, 1); PG8_STAGE(PG8_SB(0, 0), b2, voffB); PG8_STAGE(PG8_SB(0, 1), b2 + hstepB, voffB); PG8_STAGE(PG8_SA(0, 0), a2, voffA);
            PG8_WAIT_V(8); PG8_WAIT_L(0); PG8_BAR; PG8_MMA(1, 0, At, B0); PG8_MMA(1, 1, At, B1); PG8_BAR; PG8_SCHED;
            PG8_LDB(B0, 1, 0); PG8_LDB(B1, 1, 1); PG8_SCHED; PG8_LDA(At, 1, 0); PG8_STAGE(PG8_SA(0, 1), a2 + hstepA, voffA);
            PG8_WAIT_V(8); PG8_WAIT_L(0); PG8_BAR; PG8_MMA(0, 0, At, B0); PG8_MMA(0, 1, At, B1); PG8_BAR; PG8_SCHED;
            PG8_LDA(At, 1, 1); PG8_STAGE(PG8_SB(1, 0), b3, voffB); PG8_STAGE(PG8_SB(1, 1), b3 + hstepB, voffB); PG8_STAGE(PG8_SA(1, 0), a3, voffA);
            PG8_WAIT_V(8); PG8_WAIT_L(0); PG8_BAR; PG8_MMA(1, 0, At, B0); PG8_MMA(1, 1, At, B1); PG8_BAR; PG8_SCHED;
        }
        if (wr == 0) PG8_BAR;
        if constexpr (FP8) asm volatile("s_nop 15\n\ts_nop 15\n\ts_nop 15" ::: "memory");
        E(acc, cur, wr, wc, fr, fq);
        if (!has_next) break;
#pragma unroll
        for (int a = 0; a < 2; ++a)
#pragma unroll
            for (int b = 0; b < 2; ++b)
#pragma unroll
                for (int m = 0; m < 4; ++m)
#pragma unroll
                    for (int n = 0; n < 2; ++n) acc[a][b][m][n] = (f32x4){0.f, 0.f, 0.f, 0.f};
        cur = nxt; cA = nA; cB = nB; ++ui;
        if (wr == 1) PG8_BAR;
    }
    PG8_WAIT_V(0);
    PG8_BAR;
#undef PG8_SA
#undef PG8_SB
#undef PG8_STAGE
#undef PG8_LDA
#undef PG8_LDB
#undef PG8_MMA
#undef PG8_WAIT_V
#undef PG8_WAIT_L
#undef PG8_BAR
#undef PG8_SCHED
}
}

struct Args { const float* in[27]; float* out; unsigned char* ws; int ph_lo, ph_hi; };
struct Ctx { const float* const* in; float* out; unsigned char* ws; LAS unsigned char* lds; int tid, lane, wave; };

enum { I_X = 0, I_C, I_RELB, I_WADA, I_BADA, I_GMIX, I_WIN, I_GQA, I_GKA, I_GQB, I_GKCMP, I_GKSLC, I_GKWIN, I_PEK, I_W1K, I_W2K, I_PEV, I_W1V, I_W2V,
       I_WBA, I_WBB, I_WOUT, I_GFFN, I_WPQ, I_SUBK, I_PU, I_PV };

__device__ __forceinline__ int map_col(int c) {
    if (c < 5120) return c; if (c < 10240) return c + 96; if (c < 10336) return c - 5120; if (c < 10384) return c; if (c < 10496) return -1; return c - 112;
}

template <bool REMAP>
__device__ __forceinline__ void tconv_tile(const Ctx& C, const float* src, int srcN, bf16_t* dst, int dstK, int n0, int k0) {
    LAS float* tile = (LAS float*)C.lds;
    const int tx = C.tid & 31, ty = C.tid >> 5;
    const int nn = n0 + 4 * tx; const int sc = REMAP ? map_col(nn) : nn;
    f32x4 v[8];
#pragma unroll
    for (int i = 0; i < 8; ++i) { const int k = ty + 16 * i; v[i] = (sc >= 0) ? *(const f32x4*)(src + (size_t)(k0 + k) * srcN + sc) : (f32x4){0.f, 0.f, 0.f, 0.f}; }
#pragma unroll
    for (int i = 0; i < 8; ++i) { const int k = ty + 16 * i; LAS float* q = tile + k * 129 + 4 * tx; q[0] = v[i][0]; q[1] = v[i][1]; q[2] = v[i][2]; q[3] = v[i][3]; }
    __syncthreads();
#pragma unroll
    for (int i = 0; i < 4; ++i) { const int task = C.tid + 512 * i; const int nl = task >> 4, kc = task & 15;
        float e[8];
#pragma unroll
        for (int j = 0; j < 8; ++j) e[j] = tile[(kc * 8 + j) * 129 + nl];
        u32x4 w; w.x = cvt_pk_bf16(e[0], e[1]); w.y = cvt_pk_bf16(e[2], e[3]); w.z = cvt_pk_bf16(e[4], e[5]); w.w = cvt_pk_bf16(e[6], e[7]);
        *(u32x4*)(dst + (size_t)(n0 + nl) * dstK + k0 + kc * 8) = w; }
    __syncthreads();
}

template <bool REMAP>
__device__ __forceinline__ void tconv_tile_f8(const Ctx& C, const float* src, int srcN, unsigned char* dst, int dstK, int n0, int k0) {
    LAS float* tile = (LAS float*)C.lds;
    const int tx = C.tid & 31, ty = C.tid >> 5;
    const int nn = n0 + 4 * tx; const int sc = REMAP ? map_col(nn) : nn;
    f32x4 v[8];
#pragma unroll
    for (int i = 0; i < 8; ++i) { const int k = ty + 16 * i; v[i] = (sc >= 0) ? *(const f32x4*)(src + (size_t)(k0 + k) * srcN + sc) : (f32x4){0.f, 0.f, 0.f, 0.f}; }
#pragma unroll
    for (int i = 0; i < 8; ++i) { const int k = ty + 16 * i; LAS float* q = tile + k * 129 + 4 * tx; q[0] = v[i][0]; q[1] = v[i][1]; q[2] = v[i][2]; q[3] = v[i][3]; }
    __syncthreads();
#pragma unroll
    for (int i = 0; i < 2; ++i) { const int task = C.tid + 512 * i; const int nl = task >> 3, kc = task & 7;
        float e[16];
#pragma unroll
        for (int j = 0; j < 16; ++j) e[j] = tile[(kc * 16 + j) * 129 + nl] * 64.f;
        u32x4 w;
#pragma unroll
        for (int q4 = 0; q4 < 4; ++q4) { int p = __builtin_amdgcn_cvt_pk_fp8_f32(e[4 * q4], e[4 * q4 + 1], 0, false); p = __builtin_amdgcn_cvt_pk_fp8_f32(e[4 * q4 + 2], e[4 * q4 + 3], p, true); w[q4] = (unsigned)p; }
        *(u32x4*)(dst + (size_t)(n0 + nl) * dstK + k0 + kc * 16) = w; }
    __syncthreads();
}

__device__ __forceinline__ void wq_subkey_tile(const Ctx& C, int blk, int k0) {
    LAS float* As = (LAS float*)C.lds;
    LAS float* Bs = As + 128 * 132;
    const int tid = C.tid;
    const float* sk = C.in[I_SUBK] + (size_t)blk * 128 * 128; const float* wq = C.in[I_WPQ] + (size_t)k0 * 2048 + blk * 128;
#pragma unroll
    for (int i = 0; i < 8; ++i) { const int idx = tid + 512 * i, r = idx >> 5, c4 = idx & 31;
        const f32x4 a = *(const f32x4*)(sk + (size_t)r * 128 + 4 * c4), b = *(const f32x4*)(wq + (size_t)r * 2048 + 4 * c4);
        *(LAS f32x4*)(As + r * 132 + 4 * c4) = a; *(LAS f32x4*)(Bs + r * 132 + 4 * c4) = b; }
    __syncthreads();
    const int tn = tid >> 4, tk = tid & 15;
    float acc[4][8];
#pragma unroll
    for (int i = 0; i < 4; ++i)
#pragma unroll
        for (int j = 0; j < 8; ++j) acc[i][j] = 0.f;
#pragma unroll 2
    for (int d4 = 0; d4 < 32; ++d4) {
        f32x4 a[4], b[8];
#pragma unroll
        for (int i = 0; i < 4; ++i) a[i] = *(LAS const f32x4*)(As + (4 * tn + i) * 132 + 4 * d4);
#pragma unroll
        for (int j = 0; j < 8; ++j) b[j] = *(LAS const f32x4*)(Bs + (2 * tk + 32 * (j >> 1) + (j & 1)) * 132 + 4 * d4);
#pragma unroll
        for (int i = 0; i < 4; ++i)
#pragma unroll
            for (int j = 0; j < 8; ++j) acc[i][j] += a[i][0] * b[j][0] + a[i][1] * b[j][1] + a[i][2] * b[j][2] + a[i][3] * b[j][3];
    }
    bf16_t* dst = (bf16_t*)(C.ws + WS_WQ) + (size_t)(blk * 128 + 4 * tn) * 4096 + k0 + 2 * tk;
#pragma unroll
    for (int i = 0; i < 4; ++i)
#pragma unroll
        for (int j = 0; j < 4; ++j) *(unsigned*)(dst + (size_t)i * 4096 + 32 * j) = cvt_pk_bf16(acc[i][2 * j], acc[i][2 * j + 1]);
    __syncthreads();
}

__device__ __forceinline__ void peer_row_convert(const Ctx& C, int grow, int lane) {
            const bool second = grow >= 16384; const int row = grow & 16383;
            const float* src = C.in[second ? I_PV : I_PU] + (size_t)row * 4096;
            unsigned char* dst6 = C.ws + (second ? WS_PV : WS_PU) + (size_t)row * 3072;
            f32x16 v[4]; float am = 0.f;
#pragma unroll
            for (int i4 = 0; i4 < 4; ++i4)
#pragma unroll
                for (int q = 0; q < 4; ++q) { const f32x4 t4 = *(const f32x4*)(src + 16 * (lane + 64 * i4) + 4 * q);
                    v[i4][4 * q] = t4[0]; v[i4][4 * q + 1] = t4[1]; v[i4][4 * q + 2] = t4[2]; v[i4][4 * q + 3] = t4[3];
                    am = fmaxf(am, fmaxf(fmaxf(fabsf(t4[0]), fabsf(t4[1])), fmaxf(fabsf(t4[2]), fabsf(t4[3])))); }
            am = wave_max(am);
            const float sc = am > 0.f ? am * (1.f / 7.f) : 1.f, inv = 1.f / sc;
#pragma unroll
            for (int i4 = 0; i4 < 4; ++i4) v[i4] *= inv;
            const u32x6 pa = __builtin_amdgcn_cvt_scalef32_2xpk16_fp6_f32(v[0], v[1], 1.0f), pb = __builtin_amdgcn_cvt_scalef32_2xpk16_fp6_f32(v[2], v[3], 1.0f);
            *(u32x4*)(dst6 + 16 * lane) = (u32x4){pa[0], pa[1], pa[2], pa[3]};
            *(u32x4*)(dst6 + 1024 + 16 * lane) = (u32x4){pa[4], pa[5], pb[0], pb[1]};
            *(u32x4*)(dst6 + 2048 + 16 * lane) = (u32x4){pb[2], pb[3], pb[4], pb[5]};
            ((float*)(C.ws + (second ? WS_PV : WS_PU) + 96 * MB))[row] = sc;
            float al = 0.f;
#pragma unroll
            for (int i4 = 0; i4 < 4; ++i4)
#pragma unroll
                for (int j = 0; j < 16; ++j) al = fmaxf(al, fabsf(v[i4][j]));
            if (!second) {
                const float s4 = al > 0.f ? al * (1.f / 7.f) : 1.f, inv4 = 1.f / s4;
                unsigned w8[8];
#pragma unroll
                for (int d = 0; d < 8; ++d) { unsigned w = 0u;
#pragma unroll
                    for (int e = 0; e < 8; ++e) { const int q = (int)__builtin_rintf(v[d >> 1][8 * (d & 1) + e] * inv4); w |= ((unsigned)q & 0xFu) << (4 * e); }
                    w8[d] = w; }
                unsigned char* dst4 = C.ws + WS_PU4 + (size_t)row * 2176;
                *(u32x4*)(dst4 + 16 * lane) = (u32x4){w8[0], w8[1], w8[2], w8[3]};
                *(u32x4*)(dst4 + 1024 + 16 * lane) = (u32x4){w8[4], w8[5], w8[6], w8[7]};
                *(bf16_t*)(dst4 + 2048 + 2 * lane) = f2bf(sc * s4);
            } else {
              const float s4 = al > 0.f ? al * (1.f / 6.f) : 1.f, inv4 = 1.f / s4;
              unsigned wa[4] = {0u, 0u, 0u, 0u}, wb[4] = {0u, 0u, 0u, 0u};
#define PK4(d_) do { wa[d_] = __builtin_amdgcn_cvt_scalef32_pk_fp4_f32(wa[d_], v[0][4 * (d_)] * inv4, v[1][4 * (d_)] * inv4, 1.0f, 0); wa[d_] = __builtin_amdgcn_cvt_scalef32_pk_fp4_f32(wa[d_], v[0][4 * (d_) + 1] * inv4, v[1][4 * (d_) + 1] * inv4, 1.0f, 1); \
                     wa[d_] = __builtin_amdgcn_cvt_scalef32_pk_fp4_f32(wa[d_], v[0][4 * (d_) + 2] * inv4, v[1][4 * (d_) + 2] * inv4, 1.0f, 2); wa[d_] = __builtin_amdgcn_cvt_scalef32_pk_fp4_f32(wa[d_], v[0][4 * (d_) + 3] * inv4, v[1][4 * (d_) + 3] * inv4, 1.0f, 3); \
                     wb[d_] = __builtin_amdgcn_cvt_scalef32_pk_fp4_f32(wb[d_], v[2][4 * (d_)] * inv4, v[3][4 * (d_)] * inv4, 1.0f, 0); wb[d_] = __builtin_amdgcn_cvt_scalef32_pk_fp4_f32(wb[d_], v[2][4 * (d_) + 1] * inv4, v[3][4 * (d_) + 1] * inv4, 1.0f, 1); \
                     wb[d_] = __builtin_amdgcn_cvt_scalef32_pk_fp4_f32(wb[d_], v[2][4 * (d_) + 2] * inv4, v[3][4 * (d_) + 2] * inv4, 1.0f, 2); wb[d_] = __builtin_amdgcn_cvt_scalef32_pk_fp4_f32(wb[d_], v[2][4 * (d_) + 3] * inv4, v[3][4 * (d_) + 3] * inv4, 1.0f, 3); } while (0)
              PK4(0); PK4(1); PK4(2); PK4(3);
#undef PK4
              unsigned char* dst4 = C.ws + (second ? WS_PV4 : WS_PU4) + (size_t)row * 2176;
              *(u32x4*)(dst4 + 16 * lane) = (u32x4){wa[0], wa[1], wa[2], wa[3]};
              *(u32x4*)(dst4 + 1024 + 16 * lane) = (u32x4){wb[0], wb[1], wb[2], wb[3]};
              *(bf16_t*)(dst4 + 2048 + 2 * lane) = f2bf(sc * s4); }

}

__device__ __forceinline__ void p0_prologue(const Ctx& C) {
    constexpr int N_MOD = 256, N_WIN = (NP / 128) * (D / 128), N_W1 = 2 * 32, N_B1 = 64;
    constexpr int E0 = N_MOD, E1 = E0 + N_B1, E2 = E1 + N_WIN, E7 = E2 + N_W1, E8 = E7 + N_W1, E11 = E8;
    const int tid = C.tid;
    for (int it = blockIdx.x; it < E11; it += gridDim.x) {
        if (it < E0) {
            const int b = it; LAS float* red = (LAS float*)C.lds;
            const float* cvec = C.in[I_C]; const float* w = C.in[I_WADA];
            if (tid < 504) { const int cg = tid % 24, rs = tid / 24;
                f32x4 acc = {0.f, 0.f, 0.f, 0.f};
                const float* wp = w + 96 * b + 4 * cg;
#pragma unroll 4
                for (int k = rs; k < D; k += 21) { const float cv = cvec[k]; const f32x4 wv = *(const f32x4*)(wp + (size_t)k * 24576); acc += cv * wv; }
                *(LAS f32x4*)(red + (rs * 24 + cg) * 4) = acc; }
            __syncthreads();
            if (tid < 24) { f32x4 s = *(const f32x4*)(C.in[I_BADA] + 96 * b + 4 * tid);
                for (int rs = 0; rs < 21; ++rs) s += *(LAS f32x4*)(red + (rs * 24 + tid) * 4);
                *(f32x4*)((float*)(C.ws + WS_MOD) + 96 * b + 4 * tid) = s; }
            __syncthreads();
        } else if (it < E1) {
            const int s = (it - E0) >> 5, sl = (it - E0) & 31; const float* pe = C.in[s ? I_PEV : I_PEK]; const float* w1 = C.in[s ? I_W1V : I_W1K];
            const int e = tid & 255, half = tid >> 8; float a = 0.f;
            const int kb = sl * 128 + half * 64;
#pragma unroll 16
            for (int k = kb; k < kb + 64; ++k) a += pe[k] * w1[(size_t)k * 256 + e];
            LAS float* red = (LAS float*)C.lds; red[tid] = a; __syncthreads();
            if (tid < 256) ((float*)(C.ws + WS_B1P))[(s * 32 + sl) * 256 + tid] = red[tid] + red[tid + 256];
            __syncthreads();
        } else if (it < E2) { const int i = it - E1; const int n0 = (i / 32) * 128, k0 = (i % 32) * 128;
            if (n0 < NP_BF) tconv_tile<true>(C, C.in[I_WIN], 18576, (bf16_t*)(C.ws + WS_WIN), D, n0, k0);
            else tconv_tile_f8<true>(C, C.in[I_WIN], 18576, C.ws + WS_WIN8 - (size_t)NP_BF * D, D, n0, k0);
        } else if (it < E7) { const int i = it - E2; tconv_tile<false>(C, C.in[I_W1K], 256, (bf16_t*)(C.ws + WS_W1T), 4096, (i / 32) * 128, (i % 32) * 128);
        } else if (it < E8) { const int i = it - E7; tconv_tile<false>(C, C.in[I_W1V], 256, (bf16_t*)(C.ws + WS_W1T) + (size_t)256 * 4096, 4096, (i / 32) * 128, (i % 32) * 128);
        }
    }
}

__device__ __forceinline__ void norm_mod_phase(const Ctx& C, const float* xin, const float* gain, const float* sh, const float* sc, bf16_t* hout, unsigned char* h8out = nullptr) {
    LAS float* la = (LAS float*)C.lds; LAS float* lb = la + D;
    for (int i = C.tid; i < D / 4; i += NTHREADS) { const f32x4 g4 = *(const f32x4*)(gain + 4 * i), s4 = *(const f32x4*)(sc + 4 * i), h4 = *(const f32x4*)(sh + 4 * i);
        *(LAS f32x4*)(la + 4 * i) = g4 * (s4 + 1.f); *(LAS f32x4*)(lb + 4 * i) = h4; }
    __syncthreads();
    const int rstep = gridDim.x * 8;
    int row = blockIdx.x * 8 + C.wave;
    f32x4 v[16], vn[16];
    if (row < T) {
#pragma unroll
        for (int i = 0; i < 16; ++i) v[i] = ((const f32x4*)(xin + (size_t)row * D))[C.lane + 64 * i]; }
#pragma unroll 1
    for (; row < T; row += rstep) {
        const int nrow = row + rstep;
        if (nrow < T) {
#pragma unroll
            for (int i = 0; i < 16; ++i) vn[i] = ((const f32x4*)(xin + (size_t)nrow * D))[C.lane + 64 * i]; }
        float ss = 0.f;
#pragma unroll
        for (int i = 0; i < 16; ++i) ss += v[i][0] * v[i][0] + v[i][1] * v[i][1] + v[i][2] * v[i][2] + v[i][3] * v[i][3];
        ss = wave_sum(ss);
        const float rstd = rsqrtf(ss * (1.f / 4096.f) + EPS);
#pragma unroll
        for (int i = 0; i < 16; ++i) { const int col = 4 * (C.lane + 64 * i);
            const f32x4 a4 = *(LAS const f32x4*)(la + col), b4 = *(LAS const f32x4*)(lb + col);
            float y[4];
#pragma unroll
            for (int j = 0; j < 4; ++j) y[j] = v[i][j] * rstd * a4[j] + b4[j];
            u32x2 w; w.x = cvt_pk_bf16(y[0], y[1]); w.y = cvt_pk_bf16(y[2], y[3]);
            *(u32x2*)(hout + (size_t)row * D + col) = w;
            if (h8out) { int p = __builtin_amdgcn_cvt_pk_fp8_f32(y[0], y[1], 0, false); p = __builtin_amdgcn_cvt_pk_fp8_f32(y[2], y[3], p, true); *(unsigned*)(h8out + (size_t)row * D + col) = (unsigned)p; } }
#pragma unroll
        for (int i = 0; i < 16; ++i) v[i] = vn[i];
    }
    __syncthreads();
}

__device__ __forceinline__ void p3_post(const Ctx& C) {
    bf16_t* proj = (bf16_t*)(C.ws + WS_PROJ);
    const int tid = C.tid;
    const float qscale = 0.08838834764831845f;
    if (blockIdx.x == 0) { float a = 0.f; const float* part = (const float*)(C.ws + WS_B1P) + (size_t)(tid >> 8) * 32 * 256 + (tid & 255);
        for (int sl = 0; sl < 32; ++sl) a += part[sl * 256]; ((float*)(C.ws + WS_B1))[tid] = a; }
    for (int item = blockIdx.x; item < T / 64; item += gridDim.x) {
        const int t0 = item * 64;
#pragma unroll 1
        for (int hb = tid >> 4; hb < 64 * 44; hb += 128) {
            const int l16 = tid & 15;
            u32x4 raw[4]; bf16_t* dstp[4]; const float* gain[4]; float scl[4]; bool isk8[4];
#pragma unroll
            for (int u = 0; u < 4; ++u) { const int hr = hb + 32 * u; const int tok = hr / 44, hh = hr % 44; int col; isk8[u] = (hh >= 16 && hh < 20);
                if (hh < 16) { col = P_QA + 128 * hh; gain[u] = C.in[I_GQA]; scl[u] = qscale; dstp[u] = proj + (size_t)(t0 + tok) * NP + col; }
                else if (hh < 20) { col = P_KA + 128 * (hh - 16); gain[u] = C.in[I_GKA]; scl[u] = 1.f; dstp[u] = (bf16_t*)(C.ws + WS_KA + (size_t)(t0 + tok) * 512 + 128 * (hh - 16)); }
                else if (hh < 36) { col = P_QB + 128 * (hh - 20); gain[u] = C.in[I_GQB]; scl[u] = qscale * 1.4426950408889634f; dstp[u] = proj + (size_t)(t0 + tok) * NP + col; }
                else if (hh < 40) { col = P_KS + 128 * (hh - 36); gain[u] = C.in[I_GKSLC]; scl[u] = 1.f; dstp[u] = (bf16_t*)(C.ws + WS_KSC) + ((size_t)(hh - 36) * T + t0 + tok) * 128; }
                else { col = P_KW + 128 * (hh - 40); gain[u] = C.in[I_GKWIN]; scl[u] = 1.f; dstp[u] = (bf16_t*)(C.ws + WS_KWC) + ((size_t)(hh - 40) * T + t0 + tok) * 128; }
                raw[u] = *(const u32x4*)(proj + (size_t)(t0 + tok) * NP + col + 8 * l16); }
#pragma unroll
            for (int u = 0; u < 4; ++u) {
                float v[8] = {bflo(raw[u].x), bfhi(raw[u].x), bflo(raw[u].y), bfhi(raw[u].y), bflo(raw[u].z), bfhi(raw[u].z), bflo(raw[u].w), bfhi(raw[u].w)};
                float ss = 0.f;
#pragma unroll
                for (int j = 0; j < 8; ++j) ss += v[j] * v[j];
                ss += dppf<0xB1>(ss); ss += dppf<0x4E>(ss); ss += dppf<0x141>(ss); ss += dppf<0x140>(ss);
                const float rstd = rsqrtf(ss * (1.f / 128.f) + EPS) * scl[u];
                const f32x4 g0 = *(const f32x4*)(gain[u] + 8 * l16), g1 = *(const f32x4*)(gain[u] + 8 * l16 + 4);
                if (isk8[u]) {
                    const float r8 = rstd * 64.f;
                    int p0 = __builtin_amdgcn_cvt_pk_fp8_f32(v[0] * r8 * g0[0], v[1] * r8 * g0[1], 0, false); p0 = __builtin_amdgcn_cvt_pk_fp8_f32(v[2] * r8 * g0[2], v[3] * r8 * g0[3], p0, true);
                    int p1 = __builtin_amdgcn_cvt_pk_fp8_f32(v[4] * r8 * g1[0], v[5] * r8 * g1[1], 0, false); p1 = __builtin_amdgcn_cvt_pk_fp8_f32(v[6] * r8 * g1[2], v[7] * r8 * g1[3], p1, true);
                    *(u32x2*)((unsigned char*)dstp[u] + 8 * l16) = (u32x2){(unsigned)p0, (unsigned)p1};
                } else {
                u32x4 w; w.x = cvt_pk_bf16(v[0] * rstd * g0[0], v[1] * rstd * g0[1]); w.y = cvt_pk_bf16(v[2] * rstd * g0[2], v[3] * rstd * g0[3]);
                w.z = cvt_pk_bf16(v[4] * rstd * g1[0], v[5] * rstd * g1[1]); w.w = cvt_pk_bf16(v[6] * rstd * g1[2], v[7] * rstd * g1[3]);
                *(u32x4*)(dstp[u] + 8 * l16) = w; } }
        }
        bf16_t* Kc = (bf16_t*)(C.ws + WS_KC); bf16_t* Vc = Kc + (size_t)4 * T * 128;
#pragma unroll
        for (int i = 0; i < 8; ++i) { const int idx = tid + 512 * i, tok = idx >> 6, c16 = idx & 63, g = c16 >> 4, d8 = c16 & 15;
            const bf16_t* src = proj + (size_t)(t0 + tok) * NP + 8 * c16;
            const size_t dof = ((size_t)g * T + t0 + tok) * 128 + 8 * d8;
            *(u32x4*)(Kc + dof) = *(const u32x4*)(src + P_KC);
            *(u32x4*)(Vc + dof) = *(const u32x4*)(src + P_VC);
            { const u32x4 rv = *(const u32x4*)(src + P_VA);
              float v[8] = {bflo(rv.x), bfhi(rv.x), bflo(rv.y), bfhi(rv.y), bflo(rv.z), bfhi(rv.z), bflo(rv.w), bfhi(rv.w)};
              float am = 0.f;
#pragma unroll
              for (int j = 0; j < 8; ++j) am = fmaxf(am, fabsf(v[j]));
              am = fmax_fast(am, dppf<0xB1>(am)); am = fmax_fast(am, dppf<0x4E>(am)); am = fmax_fast(am, dppf<0x141>(am)); am = fmax_fast(am, dppf<0x140>(am));
              const float sc = am > 0.f ? am * (1.f / 448.f) : 1.f, inv = 1.f / sc;
              int p0 = __builtin_amdgcn_cvt_pk_fp8_f32(v[0] * inv, v[1] * inv, 0, false); p0 = __builtin_amdgcn_cvt_pk_fp8_f32(v[2] * inv, v[3] * inv, p0, true);
              int p1 = __builtin_amdgcn_cvt_pk_fp8_f32(v[4] * inv, v[5] * inv, 0, false); p1 = __builtin_amdgcn_cvt_pk_fp8_f32(v[6] * inv, v[7] * inv, p1, true);
              *(u32x2*)(C.ws + WS_VA + (size_t)(t0 + tok) * 512 + 8 * c16) = (u32x2){(unsigned)p0, (unsigned)p1};
              if (d8 == 0) ((float*)(C.ws + WS_VA + 8 * MB))[(size_t)(t0 + tok) * 4 + g] = sc; } }
        { const int tok = tid >> 3, c8 = tid & 7;
          *(u32x4*)((bf16_t*)(C.ws + WS_KIC) + (size_t)(t0 + tok) * 64 + 8 * c8) = *(const u32x4*)(proj + (size_t)(t0 + tok) * NP + P_KI + 8 * c8); }
#pragma unroll 1
        for (int which = 0; which < 2; ++which) {
            const int pcol = which ? P_VW : P_VS; bf16_t* dstT = (bf16_t*)(C.ws + (which ? WS_VWT : WS_VST));
            LAS unsigned* tl = (LAS unsigned*)C.lds;
#pragma unroll
            for (int i = 0; i < 8; ++i) { const int idx = tid + 512 * i, tok = idx >> 6, c16 = idx & 63;
                const u32x4 v = *(const u32x4*)(proj + (size_t)(t0 + tok) * NP + pcol + 8 * c16);
                LAS unsigned* q = tl + tok * 257 + 4 * c16; q[0] = v.x; q[1] = v.y; q[2] = v.z; q[3] = v.w; }
            __syncthreads();
#pragma unroll
            for (int i = 0; i < 8; ++i) { const int task = tid + 512 * i, col = task >> 3, tc = task & 7;
                unsigned short e[8];
#pragma unroll
                for (int j = 0; j < 8; ++j) { const unsigned dw = tl[(8 * tc + j) * 257 + (col >> 1)]; e[j] = (col & 1) ? (unsigned short)(dw >> 16) : (unsigned short)(dw & 0xFFFFu); }
                u32x4 w; w.x = e[0] | ((unsigned)e[1] << 16); w.y = e[2] | ((unsigned)e[3] << 16); w.z = e[4] | ((unsigned)e[5] << 16); w.w = e[6] | ((unsigned)e[7] << 16);
                *(u32x4*)(dstT + (size_t)col * T + t0 + 8 * tc) = w; }
            __syncthreads();
        }
    }
}

__device__ __forceinline__ void p5_cmp_out(const Ctx& C) {
    const float* part = (const float*)(C.ws + WS_HIDP); const float* b1 = (const float*)(C.ws + WS_B1);
    bf16_t* kcmp = (bf16_t*)(C.ws + WS_KCMP); bf16_t* vcT = (bf16_t*)(C.ws + WS_VCMPT);
    LAS float* hl = (LAS float*)(C.lds) + C.wave * 1024;
    const int lane = C.lane;
    for (int grp = blockIdx.x * 8 + C.wave; grp < 2048; grp += gridDim.x * 8) {
        const int R0 = grp * 4; const bool isv = R0 >= 4096;
        lds_sync();
        const f32x4 bb = *(const f32x4*)(b1 + (isv ? 256 : 0) + 4 * lane);
#pragma unroll
        for (int r = 0; r < 4; ++r) { f32x4 a = bb;
#pragma unroll
            for (int ks = 0; ks < 8; ++ks) a += *(const f32x4*)(part + ((size_t)ks * 8192 + R0 + r) * 256 + 4 * lane);
            f32x4 hg; hg[0] = gelu_tanh(a[0]); hg[1] = gelu_tanh(a[1]); hg[2] = gelu_tanh(a[2]); hg[3] = gelu_tanh(a[3]);
            *(LAS f32x4*)(hl + r * 256 + 4 * lane) = hg; }
        lds_sync();
        const float* w2 = C.in[isv ? I_W2V : I_W2K];
        float acc[4][2];
#pragma unroll
        for (int r = 0; r < 4; ++r) { acc[r][0] = 0.f; acc[r][1] = 0.f; }
#pragma unroll 8
        for (int e = 0; e < 256; ++e) { const float2 wv = *(const float2*)(w2 + e * 128 + 2 * lane);
#pragma unroll
            for (int r = 0; r < 4; ++r) { const float hv = hl[r * 256 + e]; acc[r][0] += hv * wv.x; acc[r][1] += hv * wv.y; } }
#pragma unroll
        for (int r = 0; r < 4; ++r) { const int R = R0 + r, Rl = R & 4095, g = Rl >> 10, n = Rl & 1023;
            const float a0 = (n < NCMP) ? acc[r][0] : 0.f, a1 = (n < NCMP) ? acc[r][1] : 0.f;
            if (!isv) { const float ss = wave_sum(a0 * a0 + a1 * a1); const float rstd = rsqrtf(ss * (1.f / 128.f) + EPS);
                const float2 gg = *(const float2*)(C.in[I_GKCMP] + 2 * lane);
                *(unsigned*)(kcmp + (size_t)Rl * 128 + 2 * lane) = (n < NCMP) ? cvt_pk_bf16(a0 * rstd * gg.x, a1 * rstd * gg.y) : 0u; }
            else { vcT[((size_t)g * 128 + 2 * lane) * 1024 + n] = f2bf(a0); vcT[((size_t)g * 128 + 2 * lane + 1) * 1024 + n] = f2bf(a1); } }
    }
}

constexpr int P6_WAVE_LDS = 18432, P6_SHARED = 8192;
__device__ __forceinline__ f32x16 mfma32(bf16x8 a, bf16x8 b, f32x16 c) { return __builtin_amdgcn_mfma_f32_32x32x16_bf16(a, b, c, 0, 0, 0); }
__device__ __forceinline__ int swap23(int r) { return (r & 0x13) | ((r & 4) << 1) | ((r & 8) >> 1); }

__device__ __forceinline__ void topk_prune(LAS u64* buf, int& cnt, u64& tau, LAS unsigned* hist, int lane) {
    u64 e[8];
#pragma unroll
    for (int i = 0; i < 8; ++i) { const int idx = lane + 64 * i; e[i] = idx < cnt ? buf[idx] : 0ull; }
    u64 prefix = 0ull; unsigned need = 256u;
    const u64 lt = (1ull << lane) - 1ull;
#pragma unroll 1
    for (int p = 0; p < 6; ++p) {
        const int shift = 40 - 8 * p;
        *(LAS u32x4*)(hist + 4 * lane) = (u32x4){0u, 0u, 0u, 0u};
        lds_sync();
#pragma unroll
        for (int i = 0; i < 8; ++i) { const bool m = (e[i] != 0ull) && ((e[i] >> (shift + 8)) == (prefix >> (shift + 8)));
            if (m) __hip_atomic_fetch_add(hist + (unsigned)((e[i] >> shift) & 255ull), 1u, __ATOMIC_RELAXED, __HIP_MEMORY_SCOPE_WORKGROUP); }
        lds_sync();
        const u32x4 c = *(LAS u32x4*)(hist + 4 * lane);
        const unsigned tot = c.x + c.y + c.z + c.w;
        unsigned pre = tot;
        pre += (unsigned)__builtin_amdgcn_update_dpp(0, (int)pre, 0x111, 0xF, 0xF, true); pre += (unsigned)__builtin_amdgcn_update_dpp(0, (int)pre, 0x112, 0xF, 0xF, true);
        pre += (unsigned)__builtin_amdgcn_update_dpp(0, (int)pre, 0x114, 0xF, 0xF, true); pre += (unsigned)__builtin_amdgcn_update_dpp(0, (int)pre, 0x118, 0xF, 0xF, true);
        const unsigned r0 = (unsigned)__builtin_amdgcn_readlane((int)pre, 15), r1 = (unsigned)__builtin_amdgcn_readlane((int)pre, 31), r2 = (unsigned)__builtin_amdgcn_readlane((int)pre, 47), r3 = (unsigned)__builtin_amdgcn_readlane((int)pre, 63);
        const int row = lane >> 4;
        pre += (row == 1) ? r0 : (row == 2) ? (r0 + r1) : (row == 3) ? (r0 + r1 + r2) : 0u;
        const unsigned a3 = (r0 + r1 + r2 + r3) - pre, a2 = a3 + c.w, a1 = a2 + c.z, a0 = a1 + c.y;
        int found = -1; unsigned above = 0u;
        if (a3 < need && need <= a3 + c.w) { found = 3; above = a3; }
        else if (a2 < need && need <= a2 + c.z) { found = 2; above = a2; }
        else if (a1 < need && need <= a1 + c.y) { found = 1; above = a1; }
        else if (a0 < need && need <= a0 + c.x) { found = 0; above = a0; }
        const u64 bm = __ballot(found >= 0);
        const int src = bm ? (__ffsll((long long)bm) - 1) : 0;
        const int bin = __builtin_amdgcn_readlane(4 * lane + found, src); const unsigned ab = (unsigned)__builtin_amdgcn_readlane((int)above, src);
        prefix |= ((u64)(unsigned)bin) << shift; need -= ab;
        lds_sync();
    }
    tau = prefix;
    int base = 0;
#pragma unroll
    for (int i = 0; i < 8; ++i) { const bool keep = (e[i] >= tau) && (e[i] != 0ull); const u64 m = __ballot(keep);
        if (keep) buf[base + __popcll(m & lt)] = e[i]; base += __popcll(m); }
    cnt = base;
    lds_sync();
}

#ifndef DSA_PROBE_MODE
#define DSA_PROBE_MODE 0
#endif
__device__ __forceinline__ void dsa_item(const Ctx& C, int qp, LAS unsigned char* wl, LAS const unsigned char* bkt, LAS const float* tbl, int pmode = 0) {
    const int lane = C.lane, r = lane & 31, h = lane >> 5;
    const bf16_t* proj = (const bf16_t*)(C.ws + WS_PROJ); const bf16_t* kic = (const bf16_t*)(C.ws + WS_KIC);
    unsigned char* ya = C.ws + WS_YA;
    const int t0 = 2 * qp;
    LAS u64* buf0 = (LAS u64*)wl; LAS u64* buf1 = (LAS u64*)(wl + 4096);
    LAS unsigned* hist = (LAS unsigned*)(wl + 8192);
    LAS unsigned char* qst = wl + 9216;
    LAS float* pl = (LAS float*)(wl + 10240);
    LAS unsigned* idxs = (LAS unsigned*)(wl + 14336);
    const u64 lt = (1ull << lane) - 1ull;
    {
    bf16x8 A[2][4]; unsigned wp[2][8];
#pragma unroll
    for (int q = 0; q < 2; ++q) {
        const bf16_t* pr = proj + (size_t)(t0 + q) * NP;
#pragma unroll
        for (int kk = 0; kk < 4; ++kk) A[q][kk] = *(const bf16x8*)(pr + P_QI + 64 * r + 32 * h + 8 * kk);
#pragma unroll
        for (int k2 = 0; k2 < 8; ++k2) { const int reg = 2 * k2; wp[q][k2] = *(const unsigned*)(pr + P_WI + (reg & 3) + 8 * (reg >> 2) + 4 * h); }
    }
    int cnt0 = 0, cnt1 = 0; u64 tau0 = 0ull, tau1 = 0ull;
    const int nkeys = (pmode == 2) ? 0 : t0 + 2;
    LAS unsigned char* stg = wl + 9216;
    const unsigned ixo0 = (unsigned)(((lane >> 3) * 64 + 8 * ((lane & 7) ^ ((lane >> 4) & 7))) * 2), ixo1 = (unsigned)(((lane >> 3) * 64 + 8 * ((lane & 7) ^ ((4 + (lane >> 4)) & 7))) * 2);
#define IX_STAGE(j0_) do { const char* _tb = (const char*)kic + (size_t)(j0_) * 128; _Pragma("unroll") for (int _i = 0; _i < 8; ++_i) \
        __builtin_amdgcn_global_load_lds((const unsigned*)(_tb + _i * 1024 + ((_i & 1) ? ixo1 : ixo0)), (LAS unsigned*)(stg + _i * 1024), 16, 0, 0); } while (0)
    if (nkeys > 0) IX_STAGE(0);
#pragma unroll 1
    for (int j0 = 0; j0 < nkeys; j0 += 64) {
        bf16x8 BA[4], BB[4];
        asm volatile("s_waitcnt vmcnt(0)" ::: "memory");
#pragma unroll
        for (int kk = 0; kk < 4; ++kk) { const int sw = (r >> 1) & 7;
            BA[kk] = *(LAS const bf16x8*)(stg + r * 128 + 16 * ((4 * h + kk) ^ sw));
            BB[kk] = *(LAS const bf16x8*)(stg + (32 + r) * 128 + 16 * ((4 * h + kk) ^ sw)); }
        asm volatile("s_waitcnt lgkmcnt(0)" ::: "memory");
        if (j0 + 64 < nkeys) IX_STAGE(j0 + 64);
        const int kidx = j0 + lane;
        f32x16 accA0, accB0, accA1, accB1;
#pragma unroll
        for (int i = 0; i < 16; ++i) { accA0[i] = 0.f; accB0[i] = 0.f; accA1[i] = 0.f; accB1[i] = 0.f; }
#pragma unroll
        for (int kk = 0; kk < 4; ++kk) { accA0 = mfma32(A[0][kk], BA[kk], accA0); accB0 = mfma32(A[0][kk], BB[kk], accB0); }
#pragma unroll
        for (int kk = 0; kk < 4; ++kk) { accA1 = mfma32(A[1][kk], BA[kk], accA1); accB1 = mfma32(A[1][kk], BB[kk], accB1); }
        float sc[2];
        { float pA = 0.f, pB = 0.f;
#pragma unroll
          for (int i = 0; i < 16; ++i) { const float wv = (i & 1) ? bfhi(wp[0][i >> 1]) : bflo(wp[0][i >> 1]);
              const float ta = __int_as_float(max(__float_as_int(accA0[i]), 0)), tb = __int_as_float(max(__float_as_int(accB0[i]), 0));
              pA = __builtin_fmaf(ta, wv, pA); pB = __builtin_fmaf(tb, wv, pB); }
          swap32f(pA, pB); sc[0] = pA + pB; }
        __builtin_amdgcn_sched_group_barrier(0x008, 8, 0);
#pragma unroll
        for (int i = 0; i < 8; ++i) { __builtin_amdgcn_sched_group_barrier(0x008, 1, 0); __builtin_amdgcn_sched_group_barrier(0x002, 9, 0); }
        { float pA = 0.f, pB = 0.f;
#pragma unroll
          for (int i = 0; i < 16; ++i) { const float wv = (i & 1) ? bfhi(wp[1][i >> 1]) : bflo(wp[1][i >> 1]);
              const float ta = __int_as_float(max(__float_as_int(accA1[i]), 0)), tb = __int_as_float(max(__float_as_int(accB1[i]), 0));
              pA = __builtin_fmaf(ta, wv, pA); pB = __builtin_fmaf(tb, wv, pB); }
          swap32f(pA, pB); sc[1] = pA + pB; }
#pragma unroll
        for (int q = 0; q < 2; ++q) {
            const float s = sc[q];
            const bool valid = kidx <= t0 + q;
            const u64 key = ((u64)sortable(s) << 14) | (u64)(unsigned)(16383 - kidx);
            const u64 tau = q ? tau1 : tau0;
            const bool pass = valid && key > tau && (pmode != 3);
            const u64 mask = __ballot(pass);
            if (mask) {
                LAS u64* buf = q ? buf1 : buf0; int& cnt = q ? cnt1 : cnt0;
                if (pass) buf[cnt + __popcll(mask & lt)] = key;
                cnt += __popcll(mask);
                if (cnt > 512 - 64) { lds_sync(); topk_prune(buf, cnt, q ? tau1 : tau0, hist, lane); }
            }
        }
    }
#undef IX_STAGE
    lds_sync();
    if (cnt0 > 256) topk_prune(buf0, cnt0, tau0, hist, lane);
    if (cnt1 > 256) topk_prune(buf1, cnt1, tau1, hist, lane);
    if (pmode == 2) { cnt0 = min(t0 + 1, 256); cnt1 = min(t0 + 2, 256);
#pragma unroll
        for (int i = 0; i < 4; ++i) { const int j = lane + 64 * i; buf0[j] = (u64)(unsigned)(16383 - ((j * 61) % (t0 + 1))); buf1[j] = (u64)(unsigned)(16383 - ((j * 59) % (t0 + 2))); } }
    if (lane == 0) { hist[0] = (unsigned)cnt0; hist[1] = (unsigned)cnt1; }
    lds_sync();
    }
    __builtin_amdgcn_s_setprio(0);
    if (pmode == 1 || pmode == 3) return;
    const int kq = lane >> 4, l16 = lane & 15;
    LAS float* plq = (LAS float*)wl;
    LAS unsigned short* idx2 = (LAS unsigned short*)(wl + 16384);
    LAS float* invl = (LAS float*)(wl + 17408);
    const int nsel0 = (int)hist[0], nsel1 = (int)hist[1];
    { unsigned iv0[4], iv1[4];
#pragma unroll
      for (int i = 0; i < 4; ++i) { const int j = lane + 64 * i; iv0[i] = (j < nsel0) ? (16383u - (unsigned)(buf0[j] & 0x3FFFull)) : 0u; iv1[i] = (j < nsel1) ? (16383u - (unsigned)(buf1[j] & 0x3FFFull)) : 0u; }
      lds_sync();
#pragma unroll
      for (int i = 0; i < 4; ++i) { const int j = lane + 64 * i; idx2[j] = (unsigned short)iv0[i]; idx2[256 + j] = (unsigned short)iv1[i]; }
      lds_sync(); }
    const unsigned char* KAp = (const unsigned char*)(C.ws + WS_KA) + 32 * kq;
    const float lsc = 1.f / (64.f * 512.f);
#pragma unroll 1
    for (int q = 0; q < 2; ++q) {
        const int t = t0 + q; const int nsel = q ? nsel1 : nsel0; LAS const unsigned short* idxs = idx2 + 256 * q;
        const bf16_t* prq = proj + (size_t)t * NP;
        lds_sync();
        {
            long Bz[4][4];
#pragma unroll
            for (int g = 0; g < 4; ++g)
#pragma unroll
                for (int sI = 0; sI < 4; ++sI) { long z = 0;
                    if ((l16 >> 2) == g) { const u32x4 raw = *(const u32x4*)(prq + P_QA + l16 * 128 + 32 * kq + 8 * sI);
                        int p0 = __builtin_amdgcn_cvt_pk_fp8_f32(bflo(raw.x) * 512.f, bfhi(raw.x) * 512.f, 0, false); p0 = __builtin_amdgcn_cvt_pk_fp8_f32(bflo(raw.y) * 512.f, bfhi(raw.y) * 512.f, p0, true);
                        int p1 = __builtin_amdgcn_cvt_pk_fp8_f32(bflo(raw.z) * 512.f, bfhi(raw.z) * 512.f, 0, false); p1 = __builtin_amdgcn_cvt_pk_fp8_f32(bflo(raw.w) * 512.f, bfhi(raw.w) * 512.f, p1, true);
                        z = (long)(((unsigned long long)(unsigned)p1 << 32) | (unsigned long long)(unsigned)p0); }
                    Bz[g][sI] = z; }
            u32x4 A0[2][2], A1[2][2];
            { const unsigned char* kr = KAp + (size_t)idxs[l16] * 512;
#pragma unroll
              for (int g = 0; g < 2; ++g) { A0[g][0] = *(const u32x4*)(kr + g * 128); A0[g][1] = *(const u32x4*)(kr + g * 128 + 16); } }
#pragma unroll 1
            for (int tile = 0; tile < 16; ++tile) {
                { const unsigned char* kr = KAp + (size_t)idxs[16 * tile + l16] * 512 + 256;
#pragma unroll
                  for (int g = 0; g < 2; ++g) { A1[g][0] = *(const u32x4*)(kr + g * 128); A1[g][1] = *(const u32x4*)(kr + g * 128 + 16); } }
                f32x4 acc = {0.f, 0.f, 0.f, 0.f};
#pragma unroll
                for (int g = 0; g < 2; ++g)
#pragma unroll
                    for (int sI = 0; sI < 4; ++sI) { const u32x4 v = A0[g][sI >> 1]; const long a = (sI & 1) ? (long)(((unsigned long long)v.w << 32) | v.z) : (long)(((unsigned long long)v.y << 32) | v.x);
                        acc = __builtin_amdgcn_mfma_f32_16x16x32_fp8_fp8(a, Bz[g][sI], acc, 0, 0, 0); }
                asm volatile("" ::: "memory");
                if (tile < 15) { const unsigned char* kr = KAp + (size_t)idxs[16 * (tile + 1) + l16] * 512;
#pragma unroll
                    for (int g = 0; g < 2; ++g) { A0[g][0] = *(const u32x4*)(kr + g * 128); A0[g][1] = *(const u32x4*)(kr + g * 128 + 16); } }
#pragma unroll
                for (int g = 0; g < 2; ++g)
#pragma unroll
                    for (int sI = 0; sI < 4; ++sI) { const u32x4 v = A1[g][sI >> 1]; const long a = (sI & 1) ? (long)(((unsigned long long)v.w << 32) | v.z) : (long)(((unsigned long long)v.y << 32) | v.x);
                        acc = __builtin_amdgcn_mfma_f32_16x16x32_fp8_fp8(a, Bz[2 + g][sI], acc, 0, 0, 0); }
#pragma unroll
                for (int r = 0; r < 4; ++r) { const int j = 16 * tile + 4 * kq + r; const int idx = (int)idxs[j]; const bool valid = j < nsel;
                    const int b = bkt[min(max(t - idx, 0), 2048)];
                    plq[j * 16 + l16] = valid ? (acc[r] * lsc + tbl[b * 32 + l16]) : -1e30f; }
            }
        }
        lds_sync();
        {
            float mx[16];
#pragma unroll
            for (int hh = 0; hh < 16; ++hh) mx[hh] = -1e30f;
#pragma unroll 1
            for (int ps = 0; ps < 4; ++ps) { const int j = ps * 64 + lane;
#pragma unroll
                for (int c4 = 0; c4 < 4; ++c4) { const f32x4 lv = *(LAS f32x4*)(plq + 16 * j + 4 * c4);
#pragma unroll
                    for (int e = 0; e < 4; ++e) mx[4 * c4 + e] = fmaxf(mx[4 * c4 + e], lv[e]); } }
#pragma unroll
            for (int hh = 0; hh < 16; ++hh) mx[hh] = wave_max(mx[hh]);
            float zs[16];
#pragma unroll
            for (int hh = 0; hh < 16; ++hh) zs[hh] = 0.f;
#pragma unroll 1
            for (int ps = 0; ps < 4; ++ps) { const int j = ps * 64 + lane; const bool valid = j < nsel;
                const f32x4 vsc = *(const f32x4*)((const float*)(C.ws + WS_VA + 8 * MB) + (size_t)idxs[j] * 4);
#pragma unroll
                for (int c4 = 0; c4 < 4; ++c4) { f32x4 lv = *(LAS f32x4*)(plq + 16 * j + 4 * c4);
#pragma unroll
                    for (int e = 0; e < 4; ++e) { const float p = valid ? __expf(lv[e] - mx[4 * c4 + e]) : 0.f; lv[e] = p * vsc[c4]; zs[4 * c4 + e] += p; }
                    *(LAS f32x4*)(plq + 16 * j + 4 * c4) = lv; } }
#pragma unroll
            for (int hh = 0; hh < 16; ++hh) { const float z = wave_sum(zs[hh]); if (lane == 0) invl[hh] = 1.f / fmaxf(z, 1e-30f); }
        }
        lds_sync();
#pragma unroll 1
        for (int g = 0; g < 4; ++g) {
            const f32x4 inv4 = *(LAS f32x4*)(invl + 4 * g);
            f32x2 o2[4][4];
#pragma unroll
            for (int rr = 0; rr < 4; ++rr)
#pragma unroll
                for (int d = 0; d < 4; ++d) o2[rr][d] = (f32x2){0.f, 0.f};
            const unsigned char* vbase = C.ws + WS_VA + 128 * g + 8 * l16;
            const int nb = (nsel + 31) >> 5;
            u32x2 vc[8], vn[8];
#pragma unroll
            for (int u = 0; u < 8; ++u) { const int idx = (int)idxs[4 * u + kq]; vc[u] = *(const u32x2*)(vbase + (size_t)idx * 512); }
#pragma unroll 1
            for (int bb = 0; bb < nb; ++bb) {
                if (bb + 1 < nb) {
#pragma unroll
                    for (int u = 0; u < 8; ++u) { const int idx = (int)idxs[32 * (bb + 1) + 4 * u + kq]; vn[u] = *(const u32x2*)(vbase + (size_t)idx * 512); } }
#pragma unroll
                for (int u = 0; u < 8; ++u) { const f32x4 p4 = *(LAS f32x4*)(plq + 16 * (32 * bb + 4 * u + kq) + 4 * g);
                    const f32x2 va = __builtin_amdgcn_cvt_pk_f32_fp8((int)vc[u].x, false), vb = __builtin_amdgcn_cvt_pk_f32_fp8((int)vc[u].x, true),
                                vcc = __builtin_amdgcn_cvt_pk_f32_fp8((int)vc[u].y, false), vd = __builtin_amdgcn_cvt_pk_f32_fp8((int)vc[u].y, true);
#pragma unroll
                    for (int rr = 0; rr < 4; ++rr) { const f32x2 pp = {p4[rr], p4[rr]};
                        o2[rr][0] = pp * va + o2[rr][0]; o2[rr][1] = pp * vb + o2[rr][1]; o2[rr][2] = pp * vcc + o2[rr][2]; o2[rr][3] = pp * vd + o2[rr][3]; } }
#pragma unroll
                for (int u = 0; u < 8; ++u) vc[u] = vn[u];
            }
            float o[4][8];
#pragma unroll
            for (int rr = 0; rr < 4; ++rr)
#pragma unroll
                for (int d = 0; d < 4; ++d) { o[rr][2 * d] = xsum16(xsum32(o2[rr][d].x)) * inv4[rr]; o[rr][2 * d + 1] = xsum16(xsum32(o2[rr][d].y)) * inv4[rr]; }
            if (kq == 0) {
#pragma unroll
                for (int rr = 0; rr < 4; ++rr) { int p0 = __builtin_amdgcn_cvt_pk_fp8_f32(o[rr][0] * 16.f, o[rr][1] * 16.f, 0, false); p0 = __builtin_amdgcn_cvt_pk_fp8_f32(o[rr][2] * 16.f, o[rr][3] * 16.f, p0, true);
                    int p1 = __builtin_amdgcn_cvt_pk_fp8_f32(o[rr][4] * 16.f, o[rr][5] * 16.f, 0, false); p1 = __builtin_amdgcn_cvt_pk_fp8_f32(o[rr][6] * 16.f, o[rr][7] * 16.f, p1, true);
                    *(u32x2*)(ya + (size_t)t * 2048 + (4 * g + rr) * 128 + 8 * l16) = (u32x2){(unsigned)p0, (unsigned)p1}; } }
        }
    }
}

constexpr int N2_KS = 0, N2_VS = 32768, N2_LUT = 65536, N2_IMP = 81920, N2_SEL = N2_IMP + 64 * 260 * 4, N2_UNI = N2_SEL + 2048, N2_LIST = N2_UNI + 64, N2_BKT = N2_LIST + 3 * 512, N2_TBL = N2_BKT + 2304, N2_END = N2_TBL + 4096;
static_assert(N2_END <= LDS_BYTES - 16, "NSA LDS map");
struct N2Src { const bf16_t* kbase; size_t kld; int krmax; const bf16_t* vT; size_t vld; };
__device__ __forceinline__ void n2_stage(const N2Src& s, int m, bool withV, LAS unsigned char* kbuf, LAS unsigned char* vbuf, int wave, int lane) {
#pragma unroll
    for (int j = 0; j < 2; ++j) { const int slot = (wave * 2 + j) * 64 + lane; const int row = slot >> 4, ch = (slot & 15) ^ (row & 15);
        __builtin_amdgcn_global_load_lds((const unsigned*)(s.kbase + (size_t)min(64 * m + row, s.krmax) * s.kld + 8 * ch), (LAS unsigned*)(kbuf + (wave * 2 + j) * 1024), 16, 0, 0); }
    if (withV) {
#pragma unroll
        for (int j = 0; j < 2; ++j) { const int slot = (wave * 2 + j) * 64 + lane; const int row = slot >> 3, ch = (slot & 7) ^ ((row >> 1) & 7);
            __builtin_amdgcn_global_load_lds((const unsigned*)(s.vT + (size_t)row * s.vld + 64 * m + 8 * ch), (LAS unsigned*)(vbuf + (wave * 2 + j) * 1024), 16, 0, 0); } }
}
__device__ __forceinline__ f32x16 n2_qk(const bf16x8 (&Bq)[8], LAS const unsigned char* kbuf, int hf, int rho, int h) {
    const int kr = 32 * hf + rho;
    f32x16 S;
#pragma unroll
    for (int i = 0; i < 16; ++i) S[i] = 0.f;
#pragma unroll
    for (int kk = 0; kk < 8; ++kk) { const int ch = 8 * h + kk; const bf16x8 a = *(LAS const bf16x8*)(kbuf + kr * 256 + 16 * (ch ^ (rho & 15))); S = mfma32(a, Bq[kk], S); }
    return S;
}
__device__ __forceinline__ void n2_pv(f32x16 (&O)[4], const float (&p)[16], LAS const unsigned char* vbuf, int hf, int lane) {
    bf16x8 pk[2];
#pragma unroll
    for (int s = 0; s < 2; ++s) { u32x4 w; w.x = cvt_pk_bf16(p[8 * s + 0], p[8 * s + 1]); w.y = cvt_pk_bf16(p[8 * s + 2], p[8 * s + 3]); w.z = cvt_pk_bf16(p[8 * s + 4], p[8 * s + 5]); w.w = cvt_pk_bf16(p[8 * s + 6], p[8 * s + 7]);
        pk[s] = __builtin_bit_cast(bf16x8, w); }
    const int r = lane & 31, h = lane >> 5;
#pragma unroll
    for (int dt = 0; dt < 4; ++dt)
#pragma unroll
        for (int s = 0; s < 2; ++s) { const int row = dt * 32 + r, ch = 4 * hf + 2 * s + h;
            const bf16x8 a = *(LAS const bf16x8*)(vbuf + row * 128 + 16 * (ch ^ ((r >> 1) & 7))); O[dt] = mfma32(a, pk[s], O[dt]); }
}
constexpr float N2_MASKED = -3.0e38f, N2_MINIT = -1.0e30f, LOG2E = 1.4426950408889634f;
template <int MODE, bool DEFER = false>
__device__ __forceinline__ float n2_bias_mask(f32x16& S, int posbase, int t, int t0w, int h, int ncv, int ncv0, unsigned sb, bool before_cur, float b31, LAS const bf16_t* lutr, LAS const unsigned char* bkt, LAS const float* tblh) {
    bool farT, fullT;
    if (MODE == 0) { farT = (t0w - (16 * (posbase + 31) + 31)) >= 1513; fullT = (posbase + 31) < ncv0; }
    else if (MODE == 1) { farT = (t0w - (posbase + 31)) >= 1513; fullT = before_cur; }
    else { farT = false; fullT = (posbase + 31 <= t0w) && ((t0w + 7 - posbase) < 512); }
    float cbu = b31;
    if (MODE != 0 && fullT && !farT) { const int b0 = (int)bkt[min(t0w - (posbase + 31), 2048)], b1 = (int)bkt[min(t0w + 7 - posbase, 2048)];
        if (b0 == b1) { farT = true; cbu = tblh[b0 * 32] * LOG2E; } }
    if (farT && fullT) {
        if (MODE == 1 && sb == 0u) {
#pragma unroll
            for (int reg = 0; reg < 16; ++reg) S[reg] = N2_MASKED;
            return 0.f; }
        if (DEFER) return cbu;
#pragma unroll
        for (int reg = 0; reg < 16; ++reg) S[reg] = S[reg] + cbu;
    } else {
#pragma unroll
        for (int reg = 0; reg < 16; ++reg) { const int pos = posbase + (reg & 7) + 8 * h + 16 * (reg >> 3);
            const int dist = (MODE == 0) ? (t - (16 * pos + 31)) : (t - pos);
            bool v;
            if (MODE == 0) v = pos < ncv; else if (MODE == 1) v = (sb != 0u) && (pos <= t); else v = (pos <= t) && (dist < 512);
            const float bias = bf2f(lutr[min(max(dist, 0), 2047)]);
            S[reg] = v ? (S[reg] + bias) : N2_MASKED; }
    }
    return 0.f;
}
__device__ __forceinline__ float n2_tilemax(const f32x16& S) {
    float a = fmax_fast(S[0], S[1]), b = fmax_fast(S[2], S[3]), c = fmax_fast(S[4], S[5]), d = fmax_fast(S[6], S[7]);
    float e = fmax_fast(S[8], S[9]), f = fmax_fast(S[10], S[11]), g = fmax_fast(S[12], S[13]), hh = fmax_fast(S[14], S[15]);
    a = fmax_fast(a, b); c = fmax_fast(c, d); e = fmax_fast(e, f); g = fmax_fast(g, hh); a = fmax_fast(a, c); e = fmax_fast(e, g); return fmax_fast(a, e);
}
__device__ __forceinline__ void n2_stat(const f32x16& S, float& m, float& Z) {
    const float mn = fmax_fast(m, n2_tilemax(S));
    float z = 0.f;
#pragma unroll
    for (int i = 0; i < 16; ++i) z += __builtin_amdgcn_exp2f(S[i] - mn);
    Z = Z * __builtin_amdgcn_exp2f(m - mn) + z; m = mn;
}
__device__ __forceinline__ void n2_combine(float& m, float& Z) {
    float ma = m, mb = m; swap32f(ma, mb); const float M = fmax_fast(ma, mb);
    Z = xsum32(Z * __builtin_amdgcn_exp2f(m - M)); m = M;
}
enum { N2_STATS = 0, N2_IMPP = 1, N2_PV = 2, N2_ONLINE = 3, N2_IMPV = 4 };
struct N2Lane { int t, t0w, h, rho, qq, rr, lane, ncv, ncv0, ncv7, cur; float b31; LAS const bf16_t* lutr; LAS const unsigned char* bkt; LAS const float* tblh; };
template <int MODE, int PASS>
__device__ __forceinline__ void n2_branch(const Ctx& C, int g, LAS const unsigned short* list, int n, const N2Lane& L, const bf16x8 (&Bq)[8], f32x16 (&O)[4],
                                          float& m, float& Z, float scale, LAS const unsigned* selq, LAS float* impw, float scale2 = 1.f) {
    if (n <= 0) return;
    constexpr bool withV = (PASS == N2_PV || PASS == N2_ONLINE || PASS == N2_IMPV);
    constexpr int NSL = (PASS == N2_IMPV) ? 2 : 4, LA = NSL - 1;
    N2Src src;
    if (MODE == 0) { src.kbase = (const bf16_t*)(C.ws + WS_KCMP) + (size_t)g * 1024 * 128; src.kld = 128; src.krmax = 1023; src.vT = (const bf16_t*)(C.ws + WS_VCMPT) + (size_t)g * 128 * 1024; src.vld = 1024; }
    else if (MODE == 1) { src.kbase = (const bf16_t*)(C.ws + WS_KSC) + (size_t)g * T * 128; src.kld = 128; src.krmax = T - 1; src.vT = (const bf16_t*)(C.ws + WS_VST) + (size_t)g * 128 * T; src.vld = (size_t)T; }
    else { src.kbase = (const bf16_t*)(C.ws + WS_KWC) + (size_t)g * T * 128; src.kld = 128; src.krmax = T - 1; src.vT = (const bf16_t*)(C.ws + WS_VWT) + (size_t)g * 128 * T; src.vld = (size_t)T; }
    LAS unsigned char* lds = C.lds;
#define N2_KSLOT(s_) (withV ? (((s_) < 2) ? (N2_KS + (s_) * 16384) : (N2_IMP + ((s_) - 2) * 32768)) : (N2_KS + (s_) * 16384))
#define N2_VSLOT(s_) (((s_) < 2) ? (N2_VS + (s_) * 16384) : (N2_IMP + ((s_) - 2) * 32768 + 16384))
#define N2_RAW_BARRIER() do { asm volatile("s_waitcnt lgkmcnt(0)" ::: "memory"); __builtin_amdgcn_s_barrier(); asm volatile("" ::: "memory"); } while (0)
#define N2_WAIT_LANDED() do { if (LA == 1) asm volatile("s_waitcnt vmcnt(0)" ::: "memory"); else if (withV) asm volatile("s_waitcnt vmcnt(8)" ::: "memory"); else asm volatile("s_waitcnt vmcnt(4)" ::: "memory"); } while (0)
#pragma unroll
    for (int j = 0; j < LA; ++j) if (j < n) n2_stage(src, (int)list[j], withV, lds + N2_KSLOT(j), lds + N2_VSLOT(j), C.wave, C.lane);
    if (n >= LA) N2_WAIT_LANDED(); else asm volatile("s_waitcnt vmcnt(0)" ::: "memory");
    N2_RAW_BARRIER();
#pragma unroll 1
    for (int i = 0; i < n; ++i) {
        const int mb = (int)list[i];
        if (i + LA < n) { const int sl = (i + LA) & (NSL - 1); n2_stage(src, (int)list[i + LA], withV, lds + N2_KSLOT(sl), lds + N2_VSLOT(sl), C.wave, C.lane); }
        LAS const unsigned char* kbuf = lds + N2_KSLOT(i & (NSL - 1)); LAS const unsigned char* vbuf = lds + N2_VSLOT(i & (NSL - 1));
        bool need; unsigned sb = 1u;
        if (MODE == 0) need = (64 * mb) < L.ncv7;
        else if (MODE == 1) { const unsigned sw = selq[mb >> 5]; sb = (sw >> (mb & 31)) & 1u; need = __ballot(sb != 0u) != 0ull; }
        else need = (64 * mb + 63 >= L.t0w - 511) && (64 * mb <= L.t0w + 7);
        if (need) {
#pragma unroll 1
            for (int hf = 0; hf < 2; ++hf) {
                const int posbase = 64 * mb + 32 * hf;
                f32x16 S = n2_qk(Bq, kbuf, hf, L.rho, L.h);
                const float cbd = n2_bias_mask<MODE, PASS == N2_ONLINE>(S, posbase, L.t, L.t0w, L.h, L.ncv, L.ncv0, sb, mb < L.cur, L.b31, L.lutr, L.bkt, L.tblh);
                if (PASS == N2_STATS) { n2_stat(S, m, Z); }
                else if (PASS == N2_IMPP || PASS == N2_IMPV) {
                    float p[16];
#pragma unroll
                    for (int r = 0; r < 16; ++r) p[r] = __builtin_amdgcn_exp2f(S[r] - m) * scale;
#pragma unroll
                    for (int G = 0; G < 4; ++G) { float q4 = p[4 * G] + p[4 * G + 1] + p[4 * G + 2] + p[4 * G + 3], e = p[4 * G + 3];
                        q4 += dppf<0xB1>(q4); q4 += dppf<0x4E>(q4); e += dppf<0xB1>(e); e += dppf<0x4E>(e);
                        const int nb = posbase + ((4 * G) & 7) + 8 * L.h + 16 * ((4 * G) >> 3); const int mq = nb >> 2;
                        if (L.rr == 0) { __hip_atomic_fetch_add(impw + L.qq * 260 + mq, q4, __ATOMIC_RELAXED, __HIP_MEMORY_SCOPE_WORKGROUP);
                                         __hip_atomic_fetch_add(impw + L.qq * 260 + mq + 1, e, __ATOMIC_RELAXED, __HIP_MEMORY_SCOPE_WORKGROUP); } }
                    if (PASS == N2_IMPV) {
#pragma unroll
                        for (int r = 0; r < 16; ++r) p[r] *= scale2;
                        n2_pv(O, p, vbuf, hf, L.lane); }
                } else if (PASS == N2_PV) {
                    float p[16];
#pragma unroll
                    for (int r = 0; r < 16; ++r) p[r] = __builtin_amdgcn_exp2f(S[r] - m) * scale;
                    n2_pv(O, p, vbuf, hf, L.lane);
                } else {
                    const float tm = xmax32(n2_tilemax(S) + cbd);
                    const float mn = fmax_fast(m, tm);
                    if (__ballot(mn > m + 8.f)) { const float al = __builtin_amdgcn_exp2f(m - mn); Z *= al;
#pragma unroll
                        for (int dt = 0; dt < 4; ++dt)
#pragma unroll
                            for (int r = 0; r < 16; ++r) O[dt][r] *= al;
                        m = mn; }
                    float p[16]; float zs = 0.f;
                    const float c2 = cbd - m;
#pragma unroll
                    for (int r = 0; r < 16; ++r) { p[r] = __builtin_amdgcn_exp2f(S[r] + c2); zs += p[r]; }
                    Z += zs;
                    n2_pv(O, p, vbuf, hf, L.lane);
                }
            }
        }
        if (i + LA < n) N2_WAIT_LANDED(); else asm volatile("s_waitcnt vmcnt(0)" ::: "memory");
        N2_RAW_BARRIER();
    }
#undef N2_WAIT_LANDED
#undef N2_RAW_BARRIER
#undef N2_KSLOT
#undef N2_VSLOT
}

__device__ __forceinline__ void nsa2_item(const Ctx& C, int QB, int g) {
    LAS unsigned char* lds = C.lds;
    const int tid = C.tid, lane = C.lane, wave = C.wave;
    const int c = lane & 31, h = lane >> 5, qq = c >> 2, rr = c & 3;
    const int t0 = 64 * QB, t0w = t0 + 8 * wave, t = t0w + qq, head = 4 * g + rr;
    const bf16_t* proj = (const bf16_t*)(C.ws + WS_PROJ);
    LAS bf16_t* lut = (LAS bf16_t*)(lds + N2_LUT);
    LAS float* imp = (LAS float*)(lds + N2_IMP);
    LAS unsigned* selw = (LAS unsigned*)(lds + N2_SEL);
    LAS unsigned* uni = (LAS unsigned*)(lds + N2_UNI);
    LAS unsigned short* listC = (LAS unsigned short*)(lds + N2_LIST); LAS unsigned short* listS = listC + 256; LAS unsigned short* listW = listC + 512;
    LAS const unsigned char* bkt = lds + N2_BKT; LAS const float* tbl = (LAS const float*)(lds + N2_TBL);
    __syncthreads();
    for (int i = tid; i < 8192; i += NTHREADS) { const int r4 = i >> 11, d = i & 2047; lut[i] = f2bf(tbl[(int)bkt[d] * 32 + 16 + 4 * g + r4] * LOG2E); }
    for (int i = tid; i < 64 * 260; i += NTHREADS) imp[i] = 0.f;
    const int ncv_wg = (t0 + 63 >= 31) ? ((t0 + 63 - 31) >> 4) + 1 : 0; const int nC = (ncv_wg + 63) >> 6;
    const int wlo = max(t0 - 511, 0) >> 6; const int nW = QB - wlo + 1;
    if (tid < nC) listC[tid] = (unsigned short)tid;
    if (tid < nW) listW[tid] = (unsigned short)(wlo + tid);
    bf16x8 Bq[8];
#pragma unroll
    for (int kk = 0; kk < 8; ++kk) Bq[kk] = *(const bf16x8*)(proj + (size_t)t * NP + P_QB + 128 * head + 64 * h + 8 * kk);
    const float g0 = sigmoidf_(bf2f(proj[(size_t)t * NP + P_GB + 3 * head + 0]));
    const float g1 = sigmoidf_(bf2f(proj[(size_t)t * NP + P_GB + 3 * head + 1]));
    const float g2 = sigmoidf_(bf2f(proj[(size_t)t * NP + P_GB + 3 * head + 2]));
    f32x16 O[4];
#pragma unroll
    for (int dt = 0; dt < 4; ++dt)
#pragma unroll
        for (int i = 0; i < 16; ++i) O[dt][i] = 0.f;
    N2Lane L; L.t = t; L.t0w = t0w; L.h = h; L.rho = swap23(c); L.qq = qq; L.rr = rr; L.lane = lane;
    L.ncv = t >= 31 ? ((t - 31) >> 4) + 1 : 0; L.ncv0 = t0w >= 31 ? ((t0w - 31) >> 4) + 1 : 0; L.ncv7 = (t0w + 7 >= 31) ? ((t0w + 7 - 31) >> 4) + 1 : 0; L.cur = QB;
    L.b31 = tbl[31 * 32 + 16 + head] * LOG2E; L.lutr = lut + rr * 2048; L.bkt = bkt; L.tblh = tbl + 16 + head;
    LAS const unsigned* selq = selw + (wave * 8 + qq) * 8;
    LAS float* impw = imp + wave * 8 * 260;
    __syncthreads();
    float mC = N2_MINIT, ZC = 0.f;
    n2_branch<0, N2_STATS>(C, g, listC, nC, L, Bq, O, mC, ZC, 0.f, selq, impw);
    n2_combine(mC, ZC);
    const float invZC = 1.f / fmaxf(ZC, 1e-30f);
    n2_branch<0, N2_IMPV>(C, g, listC, nC, L, Bq, O, mC, ZC, invZC, selq, impw, g0);
#define N2_OACC() ({ unsigned to_ = (unsigned)tid; asm volatile("" : "+v"(to_)); (f32x4*)(C.ws + WS_OACC) + (size_t)blockIdx.x * 16 * 512 + to_; })
    f32x4* oacc = N2_OACC();
#pragma unroll
    for (int dt = 0; dt < 4; ++dt)
#pragma unroll
        for (int G = 0; G < 4; ++G) { oacc[(dt * 4 + G) * 512] = (f32x4){O[dt][4 * G], O[dt][4 * G + 1], O[dt][4 * G + 2], O[dt][4 * G + 3]}; O[dt][4 * G] = 0.f; O[dt][4 * G + 1] = 0.f; O[dt][4 * G + 2] = 0.f; O[dt][4 * G + 3] = 0.f; }
    lds_sync();
#pragma unroll 1
    for (int q8 = 0; q8 < 8; ++q8) {
        const int cur = QB;
        unsigned word = 0u;
        if (cur + 1 <= 16) { if (lane == 0) word = (1u << (cur + 1)) - 1u; }
        else {
            unsigned key[4];
#pragma unroll
            for (int i = 0; i < 4; ++i) { const int mblk = lane + 64 * i; const bool ok = mblk >= 1 && mblk <= cur - 2;
                key[i] = ok ? ((__float_as_uint(impw[q8 * 260 + mblk]) & 0xFFFFFF00u) | (unsigned)(255 - mblk)) : 0u; }
#pragma unroll 1
            for (int round = 0; round < 13; ++round) {
                unsigned lm = key[0] > key[1] ? key[0] : key[1]; const unsigned lm2 = key[2] > key[3] ? key[2] : key[3]; lm = lm > lm2 ? lm : lm2;
                const unsigned W = wave_maxu(lm);
#pragma unroll
                for (int i = 0; i < 4; ++i) if (key[i] == W) key[i] = 0u;
                const int mw = 255 - (int)(W & 0xFFu);
                if (W != 0u && lane == (mw >> 5)) word |= 1u << (mw & 31);
            }
            if (lane == 0) word |= 1u;
            if (lane == (cur >> 5)) word |= 1u << (cur & 31);
            if (lane == ((cur - 1) >> 5)) word |= 1u << ((cur - 1) & 31);
        }
        if (lane < 8) selw[(wave * 8 + q8) * 8 + lane] = word;
    }
    __syncthreads();
    if (tid < 8) { unsigned u = 0u; for (int q = 0; q < 64; ++q) u |= selw[q * 8 + tid]; uni[tid] = u; }
    __syncthreads();
    if (tid == 0) { int n = 0; for (int mblk = 0; mblk <= QB; ++mblk) if ((uni[mblk >> 5] >> (mblk & 31)) & 1u) listS[n++] = (unsigned short)mblk; uni[8] = (unsigned)n; }
    __syncthreads();
    const int nS = (int)uni[8];
    float mS = N2_MINIT, ZS = 0.f;
    n2_branch<1, N2_ONLINE>(C, g, listS, nS, L, Bq, O, mS, ZS, 0.f, selq, impw);
    { ZS = xsum32(ZS); const float sc = g1 / fmaxf(ZS, 1e-30f);
#pragma unroll
      for (int dt = 0; dt < 4; ++dt)
#pragma unroll
          for (int r = 0; r < 16; ++r) O[dt][r] *= sc; }
    oacc = N2_OACC();
#pragma unroll
    for (int dt = 0; dt < 4; ++dt)
#pragma unroll
        for (int G = 0; G < 4; ++G) { const f32x4 a = oacc[(dt * 4 + G) * 512];
            oacc[(dt * 4 + G) * 512] = (f32x4){O[dt][4 * G] + a[0], O[dt][4 * G + 1] + a[1], O[dt][4 * G + 2] + a[2], O[dt][4 * G + 3] + a[3]};
            O[dt][4 * G] = 0.f; O[dt][4 * G + 1] = 0.f; O[dt][4 * G + 2] = 0.f; O[dt][4 * G + 3] = 0.f; }
    float mW = N2_MINIT, ZW = 0.f;
    n2_branch<2, N2_ONLINE>(C, g, listW, nW, L, Bq, O, mW, ZW, 0.f, selq, impw);
    oacc = N2_OACC();
    { ZW = xsum32(ZW); const float sc = g2 / fmaxf(ZW, 1e-30f);
#pragma unroll
      for (int dt = 0; dt < 4; ++dt)
#pragma unroll
          for (int G = 0; G < 4; ++G) { const f32x4 a = oacc[(dt * 4 + G) * 512];
              O[dt][4 * G] = O[dt][4 * G] * sc + a[0]; O[dt][4 * G + 1] = O[dt][4 * G + 1] * sc + a[1]; O[dt][4 * G + 2] = O[dt][4 * G + 2] * sc + a[2]; O[dt][4 * G + 3] = O[dt][4 * G + 3] * sc + a[3]; } }
    unsigned char* yb = C.ws + WS_YB + (size_t)t * 2048 + head * 128;
#pragma unroll
    for (int dt = 0; dt < 4; ++dt)
#pragma unroll
        for (int G = 0; G < 4; ++G) { int p = __builtin_amdgcn_cvt_pk_fp8_f32(O[dt][4 * G] * 16.f, O[dt][4 * G + 1] * 16.f, 0, false); p = __builtin_amdgcn_cvt_pk_fp8_f32(O[dt][4 * G + 2] * 16.f, O[dt][4 * G + 3] * 16.f, p, true);
            *(unsigned*)(yb + dt * 32 + 8 * G + 4 * h) = (unsigned)p; }
}

#ifndef NREP_DSA
#define NREP_DSA 1
#endif
#ifndef NREP_NSA
#define NREP_NSA 1
#endif
__device__ __forceinline__ void p6_mixers(const Ctx& C, int which  , int crep = 0) {
    const Ctx& C0_ = C;
    unsigned* counter = (unsigned*)(C.ws + WS_CTL + CTL_CNT) + 128 * crep;
    static_assert(8 * P6_WAVE_LDS <= N2_BKT, "DSA per-wave LDS vs the shared bias tables");
    LAS unsigned char* bkt = C.lds + N2_BKT; LAS float* tbl = (LAS float*)(C.lds + N2_TBL);
    for (int d = C.tid; d <= 2048; d += NTHREADS) { int b;
        if (d < 16) b = d; else { b = 16 + (int)(logf((float)d / 16.f) / logf(128.f) * 16.f); b = b < 31 ? b : 31; }
        bkt[d] = (unsigned char)b; }
    for (int i = C.tid; i < 1024; i += NTHREADS) tbl[i] = C.in[I_RELB][i];
    __syncthreads();
    if (which != 2) {
        LAS unsigned char* wl = C.lds + C.wave * P6_WAVE_LDS;
#pragma unroll 1
        for (int rep = 0; rep < NREP_DSA; ++rep)
        for (;;) {
            int it = 0;
            if (C.lane == 0) it = (int)atomicAdd(counter + 128 * rep, 1u);
            it = __builtin_amdgcn_readfirstlane(it);
            if (it >= 8192) break;
            if (C.wave >= 4) __builtin_amdgcn_s_setprio(2);
            dsa_item(C, 8191 - it, wl, bkt, tbl, (rep < NREP_DSA - 1) ? DSA_PROBE_MODE : 0);
#pragma unroll 1
            for (int rr = 0; rr < 4; ++rr) peer_row_convert(C, 4 * it + rr, C.lane);
        }
        __builtin_amdgcn_s_setprio(0);
        __syncthreads();
    }
    if (which != 1) {
        LAS int* slot = (LAS int*)(C.lds + N2_UNI + 48);
#pragma unroll 1
        for (int rep = 0; rep < NREP_NSA; ++rep)
        for (;;) {
            __syncthreads();
            if (C.tid == 0) *slot = (int)atomicAdd(counter + 64 + 128 * rep, 1u);
            __syncthreads();
            const int it = *slot;
            if (it >= 1024) break;
            nsa2_item(C, 255 - (it >> 2), it & 3);
#pragma unroll 1
            for (int c = 0; c < 3; ++c) { const int j = it + 1024 * c; if (j >= 2560) break;
                __syncthreads();
                Ctx C = C0_; { int t_ = threadIdx.x; asm volatile("" : "+v"(t_)); C.tid = t_; C.lane = t_ & 63; C.wave = __builtin_amdgcn_readfirstlane(t_ >> 6); }
                if (j < 512) tconv_tile_f8<false>(C, C.in[I_WBA], 4096, C.ws + WS_WBA, 2048, (j / 16) * 128, (j % 16) * 128);
                else if (j < 1024) { const int i = j - 512; tconv_tile_f8<false>(C, C.in[I_WBB], 4096, C.ws + WS_WBB, 2048, (i / 16) * 128, (i % 16) * 128); }
                else if (j < 2048) { const int i = j - 1024; tconv_tile_f8<false>(C, C.in[I_WOUT], 4096, C.ws + WS_WOUT, 4096, (i / 32) * 128, (i % 32) * 128); }
                else { const int i = j - 2048; wq_subkey_tile(C, i >> 5, (i & 31) * 128); } }
        }
        __syncthreads();
    }
}

static __device__ const unsigned P12_IJ4[16] = {
    0xE0331000u, 0xF0401101u, 0xFF411202u, 0xFF421303u, 0xFF501404u, 0xFF511505u, 0xFF601606u, 0xFF611707u, 0xFF702008u, 0xFF712109u, 0xFF80220Au, 0xFF90230Bu, 0xFFA0240Cu, 0xFFB0300Du, 0xFFC0310Eu, 0xFFD0320Fu };
typedef __bf16 bf16x32_t __attribute__((ext_vector_type(32)));
typedef unsigned u32x16 __attribute__((ext_vector_type(16)));
typedef _Float16 h2_t __attribute__((ext_vector_type(2)));
typedef _Float16 h32_t __attribute__((ext_vector_type(32)));
__device__ __forceinline__ unsigned rowmax_u(unsigned v) { v = umaxu(v, dppu<0xB1>(v)); v = umaxu(v, dppu<0x4E>(v)); v = umaxu(v, dppu<0x141>(v)); v = umaxu(v, dppu<0x140>(v)); return v; }
__device__ __forceinline__ float rowmax_f(float v) { v = fmax_fast(v, dppf<0xB1>(v)); v = fmax_fast(v, dppf<0x4E>(v)); v = fmax_fast(v, dppf<0x141>(v)); v = fmax_fast(v, dppf<0x140>(v)); return v; }
__device__ __forceinline__ float rowsum_f(float v) { v += dppf<0xB1>(v); v += dppf<0x4E>(v); v += dppf<0x141>(v); v += dppf<0x140>(v); return v; }
#define P12_CE(a_, b_) do { const unsigned hi_ = umaxu(a_, b_), lo_ = (a_) < (b_) ? (a_) : (b_); a_ = hi_; b_ = lo_; } while (0)
__device__ __forceinline__ void p12_route(const bf16_t* srow, LAS float* tops, LAS int* topi, LAS unsigned short* exl, LAS float* gtl, int lane, unsigned ij4) {
    const int row = lane >> 4, l16 = lane & 15;
#pragma unroll 1
    for (int q = 0; q < 4; ++q) {
        const int p = 4 * q + row;
        const u32x4 raw = *(const u32x4*)(srow + p * 128 + 8 * l16);
        unsigned k[8];
#pragma unroll
        for (int e = 0; e < 8; ++e) { const unsigned bits = (e & 1) ? (raw[e >> 1] & 0xFFFF0000u) : (raw[e >> 1] << 16);
            k[e] = ((bits ^ ((bits >> 31) ? 0xFFFFFFFFu : 0x80000000u)) & 0xFFFFFF80u) | (unsigned)(127 - (8 * l16 + e)); }
        P12_CE(k[0], k[2]); P12_CE(k[1], k[3]); P12_CE(k[4], k[6]); P12_CE(k[5], k[7]);
        P12_CE(k[0], k[4]); P12_CE(k[1], k[5]); P12_CE(k[2], k[6]); P12_CE(k[3], k[7]);
        P12_CE(k[0], k[1]); P12_CE(k[2], k[3]); P12_CE(k[4], k[5]); P12_CE(k[6], k[7]);
        P12_CE(k[2], k[4]); P12_CE(k[3], k[5]);
        P12_CE(k[1], k[4]); P12_CE(k[3], k[6]);
        P12_CE(k[1], k[2]); P12_CE(k[3], k[4]); P12_CE(k[5], k[6]);
        unsigned myW = 0u;
#pragma unroll
        for (int r = 0; r < 16; ++r) {
            const unsigned W = rowmax_u(k[0]);
            const bool pop = k[0] == W;
#pragma unroll
            for (int e = 0; e < 7; ++e) k[e] = pop ? k[e + 1] : k[e];
            k[7] = pop ? 0u : k[7];
            myW = (l16 == r) ? W : myW;
        }
        const unsigned sb = myW & 0xFFFFFF80u;
        const unsigned bits = (sb & 0x80000000u) ? (sb ^ 0x80000000u) : ((~sb) & 0xFFFF0000u);
        tops[p * 16 + l16] = __uint_as_float(bits); topi[p * 16 + l16] = 127 - (int)(myW & 0x7Fu);
    }
    lds_sync();
#pragma unroll 1
    for (int q2 = 0; q2 < 2; ++q2) {
        const int hh = 4 * q2 + row;
        LAS const float* t1 = tops + (2 * hh) * 16; LAS const float* t2 = t1 + 16;
        unsigned k[4];
#pragma unroll
        for (int c = 0; c < 4; ++c) { const unsigned ij = (ij4 >> (8 * c)) & 0xFFu; const float cv = t1[ij >> 4] + t2[ij & 15u];
            k[c] = (ij != 0xFFu) ? ((sortable(cv) & 0xFFFFFF00u) | (255u - ij)) : 0u; }
        P12_CE(k[0], k[1]); P12_CE(k[2], k[3]); P12_CE(k[0], k[2]); P12_CE(k[1], k[3]); P12_CE(k[1], k[2]);
        unsigned myW = 0u;
#pragma unroll
        for (int r = 0; r < 16; ++r) {
            const unsigned W = rowmax_u(k[0]);
            const bool pop = k[0] == W;
            k[0] = pop ? k[1] : k[0]; k[1] = pop ? k[2] : k[1]; k[2] = pop ? k[3] : k[2]; k[3] = pop ? 0u : k[3];
            myW = (l16 == r) ? W : myW;
        }
        const unsigned flat = 255u - (myW & 0xFFu); const int ci = (int)(flat >> 4), cj = (int)(flat & 15u);
        const float cv = t1[ci] + t2[cj];
        const float ev = __expf(cv - rowmax_f(cv));
        const float es = rowsum_f(ev);
        exl[hh * 16 + l16] = (unsigned short)(topi[(2 * hh) * 16 + ci] * 128 + topi[(2 * hh + 1) * 16 + cj]);
        gtl[hh * 16 + l16] = ev * __builtin_amdgcn_rcpf(es);
    }
    lds_sync();
}
#undef P12_CE
__device__ __forceinline__ float gelu_fast(float x) { const float u = 0.7978845608028654f * (x + 0.044715f * x * x * x); const float e = __expf(2.f * u); return x - x * __builtin_amdgcn_rcpf(e + 1.f); }

#ifndef P12_HI
#define P12_HI 2
#endif
__device__ __forceinline__ void p12_peer(const Ctx& C, float* dst) {
    const bf16_t* pq = (const bf16_t*)(C.ws + WS_PQ);
    const bf16_t* h2 = (const bf16_t*)(C.ws + WS_H2);
    const float* gt2 = (const float*)(C.ws + WS_MOD) + 5 * D;
    const int lane = C.lane;
    LAS unsigned char* wl = C.lds + C.wave * 8192;
    LAS unsigned short* exl = (LAS unsigned short*)wl;
    LAS float* gtl = (LAS float*)(wl + 2048);
    LAS float* tops = (LAS float*)(wl + 6144);
    LAS int* topi = (LAS int*)(wl + 7168);
    const unsigned ij4 = P12_IJ4[lane & 15];
    const unsigned lo16 = 16u * (unsigned)lane; const unsigned char* pu6 = C.ws + WS_PU; const unsigned char* pv6 = C.ws + WS_PV;
    const float* su = (const float*)(C.ws + WS_PU + 96 * MB); const float* sv = (const float*)(C.ws + WS_PV + 96 * MB);
    const unsigned char* pu4 = C.ws + WS_PU4; const unsigned char* pv4 = C.ws + WS_PV4;
    const int tstride = gridDim.x * 8;
    for (int tb = blockIdx.x * 8 + C.wave; tb < T; tb += 8 * tstride) {
        int nb = 0;
#pragma unroll 1
        for (int s = 0; s < 8; ++s) { const int t = tb + s * tstride; if (t >= T) break;
            p12_route(pq + (size_t)t * 2048, tops, topi, exl + s * 128, gtl + s * 128, lane, ij4); ++nb; }
        const int nflat = nb * 128;
        u32x4 UA[3], VA[3], UB[3], VB[3], UC[3], VC[3], UD[3], VD[3]; float suA, svA, suB, svB, suC, svC, suD, svD;
#define P12_FMT(idx_) ((((idx_) & 15) < P12_HI) ? 6 : 4)
#define P12_LOAD(S, idx_, fmt_) do { const int e_ = __builtin_amdgcn_readfirstlane((int)exl[(idx_) < nflat ? (idx_) : nflat - 1]); \
        if ((fmt_) == 6) { const unsigned char* pu_ = pu6 + (size_t)e_ * 3072 + lo16; const unsigned char* pv_ = pv6 + (size_t)e_ * 3072 + lo16; \
            U##S[0] = *(const u32x4*)pu_; U##S[1] = *(const u32x4*)(pu_ + 1024); U##S[2] = *(const u32x4*)(pu_ + 2048); \
            V##S[0] = *(const u32x4*)pv_; V##S[1] = *(const u32x4*)(pv_ + 1024); V##S[2] = *(const u32x4*)(pv_ + 2048); su##S = su[e_]; sv##S = sv[e_]; } \
        else { const unsigned char* pu_ = pu4 + (size_t)e_ * 2176; const unsigned char* pv_ = pv4 + (size_t)e_ * 2176; \
            U##S[0] = *(const u32x4*)(pu_ + lo16); U##S[1] = *(const u32x4*)(pu_ + 1024 + lo16); su##S = bf2f(*(const bf16_t*)(pu_ + 2048 + 2 * lane)); \
            V##S[0] = *(const u32x4*)(pv_ + lo16); V##S[1] = *(const u32x4*)(pv_ + 1024 + lo16); sv##S = bf2f(*(const bf16_t*)(pv_ + 2048 + 2 * lane)); } } while (0)
#define P12_V4(w_, oo_, j_) do { \
        oo_[(j_)] = act2_ * __builtin_amdgcn_cvt_scalef32_pk_f16_fp4((w_), 1.0f, 0) + oo_[(j_)]; oo_[(j_) + 1] = act2_ * __builtin_amdgcn_cvt_scalef32_pk_f16_fp4((w_), 1.0f, 1) + oo_[(j_) + 1]; \
        oo_[(j_) + 2] = act2_ * __builtin_amdgcn_cvt_scalef32_pk_f16_fp4((w_), 1.0f, 2) + oo_[(j_) + 2]; oo_[(j_) + 3] = act2_ * __builtin_amdgcn_cvt_scalef32_pk_f16_fp4((w_), 1.0f, 3) + oo_[(j_) + 3]; } while (0)
#define P12_COMPUTE(S, idx_, fmt_) do { float a0_ = 0.f, a1_ = 0.f, a2_ = 0.f, a3_ = 0.f; \
        if ((fmt_) == 6) { \
            const u32x16 ua_ = __builtin_bit_cast(u32x16, __builtin_amdgcn_cvt_scalef32_pk32_bf16_fp6((u32x6){U##S[0].x, U##S[0].y, U##S[0].z, U##S[0].w, U##S[1].x, U##S[1].y}, 1.0f)); \
            const u32x16 ub_ = __builtin_bit_cast(u32x16, __builtin_amdgcn_cvt_scalef32_pk32_bf16_fp6((u32x6){U##S[1].z, U##S[1].w, U##S[2].x, U##S[2].y, U##S[2].z, U##S[2].w}, 1.0f)); \
            _Pragma("unroll") for (int j = 0; j < 16; j += 4) { a0_ = dot2bf(ua_[j], hA[j], a0_); a1_ = dot2bf(ua_[j + 1], hA[j + 1], a1_); a2_ = dot2bf(ua_[j + 2], hA[j + 2], a2_); a3_ = dot2bf(ua_[j + 3], hA[j + 3], a3_); } \
            _Pragma("unroll") for (int j = 0; j < 16; j += 4) { a0_ = dot2bf(ub_[j], hB[j], a0_); a1_ = dot2bf(ub_[j + 1], hB[j + 1], a1_); a2_ = dot2bf(ub_[j + 2], hB[j + 2], a2_); a3_ = dot2bf(ub_[j + 3], hB[j + 3], a3_); } \
            const float a_ = wave_sum((a0_ + a1_) + (a2_ + a3_)) * su##S; \
            const float act_ = gelu_fast(a_) * gtl[idx_] * sv##S; const h2_t act2_ = {(_Float16)act_, (_Float16)act_}; \
            const h32_t va_ = __builtin_amdgcn_cvt_scalef32_pk32_f16_fp6((u32x6){V##S[0].x, V##S[0].y, V##S[0].z, V##S[0].w, V##S[1].x, V##S[1].y}, 1.0f); \
            _Pragma("unroll") for (int j = 0; j < 16; ++j) oA[j] = act2_ * (h2_t){va_[2 * j], va_[2 * j + 1]} + oA[j]; \
            const h32_t vb_ = __builtin_amdgcn_cvt_scalef32_pk32_f16_fp6((u32x6){V##S[1].z, V##S[1].w, V##S[2].x, V##S[2].y, V##S[2].z, V##S[2].w}, 1.0f); \
            _Pragma("unroll") for (int j = 0; j < 16; ++j) oB[j] = act2_ * (h2_t){vb_[2 * j], vb_[2 * j + 1]} + oB[j]; \
        } else { \
            int i1_ = 0, i2_ = 0; \
            i1_ = __builtin_amdgcn_sdot8((int)U##S[0].x, hq1[0], i1_, false); i2_ = __builtin_amdgcn_sdot8((int)U##S[0].x, hq2[0], i2_, false); i1_ = __builtin_amdgcn_sdot8((int)U##S[0].y, hq1[1], i1_, false); i2_ = __builtin_amdgcn_sdot8((int)U##S[0].y, hq2[1], i2_, false); \
            i1_ = __builtin_amdgcn_sdot8((int)U##S[0].z, hq1[2], i1_, false); i2_ = __builtin_amdgcn_sdot8((int)U##S[0].z, hq2[2], i2_, false); i1_ = __builtin_amdgcn_sdot8((int)U##S[0].w, hq1[3], i1_, false); i2_ = __builtin_amdgcn_sdot8((int)U##S[0].w, hq2[3], i2_, false); \
            i1_ = __builtin_amdgcn_sdot8((int)U##S[1].x, hq1[4], i1_, false); i2_ = __builtin_amdgcn_sdot8((int)U##S[1].x, hq2[4], i2_, false); i1_ = __builtin_amdgcn_sdot8((int)U##S[1].y, hq1[5], i1_, false); i2_ = __builtin_amdgcn_sdot8((int)U##S[1].y, hq2[5], i2_, false); \
            i1_ = __builtin_amdgcn_sdot8((int)U##S[1].z, hq1[6], i1_, false); i2_ = __builtin_amdgcn_sdot8((int)U##S[1].z, hq2[6], i2_, false); i1_ = __builtin_amdgcn_sdot8((int)U##S[1].w, hq1[7], i1_, false); i2_ = __builtin_amdgcn_sdot8((int)U##S[1].w, hq2[7], i2_, false); \
            const float a_ = wave_sum(((float)i1_ * hs1 + (float)i2_ * hs2) * su##S); \
            const float act_ = gelu_fast(a_) * gtl[idx_] * sv##S; const h2_t act2_ = {(_Float16)act_, (_Float16)act_}; \
            P12_V4(V##S[0].x, oA, 0); P12_V4(V##S[0].y, oA, 4); P12_V4(V##S[0].z, oA, 8); P12_V4(V##S[0].w, oA, 12); \
            P12_V4(V##S[1].x, oB, 0); P12_V4(V##S[1].y, oB, 4); P12_V4(V##S[1].z, oB, 8); P12_V4(V##S[1].w, oB, 12); } } while (0)
        P12_LOAD(A, 0, P12_FMT(0)); P12_LOAD(B, 1, P12_FMT(1)); P12_LOAD(C, 2, P12_FMT(2)); P12_LOAD(D, 3, P12_FMT(3));
#pragma unroll 1
        for (int s = 0; s < nb; ++s) {
            const int t = tb + s * tstride;
            unsigned hA[16], hB[16];
            { u32x4 ra[4], rb[4];
#pragma unroll
              for (int i = 0; i < 4; ++i) { ra[i] = *(const u32x4*)(h2 + (size_t)t * D + 16 * lane + 1024 * i); rb[i] = *(const u32x4*)(h2 + (size_t)t * D + 16 * lane + 1024 * i + 8); }
#pragma unroll
              for (int q = 0; q < 4; ++q) {
                  hA[2 * q] = __builtin_amdgcn_perm(ra[1][q], ra[0][q], 0x05040100u); hA[2 * q + 1] = __builtin_amdgcn_perm(ra[1][q], ra[0][q], 0x07060302u);
                  hA[8 + 2 * q] = __builtin_amdgcn_perm(rb[1][q], rb[0][q], 0x05040100u); hA[8 + 2 * q + 1] = __builtin_amdgcn_perm(rb[1][q], rb[0][q], 0x07060302u);
                  hB[2 * q] = __builtin_amdgcn_perm(ra[3][q], ra[2][q], 0x05040100u); hB[2 * q + 1] = __builtin_amdgcn_perm(ra[3][q], ra[2][q], 0x07060302u);
                  hB[8 + 2 * q] = __builtin_amdgcn_perm(rb[3][q], rb[2][q], 0x05040100u); hB[8 + 2 * q + 1] = __builtin_amdgcn_perm(rb[3][q], rb[2][q], 0x07060302u); } }
            int hq1[8], hq2[8]; float hs1, hs2;
            { float hv[64];
#pragma unroll
              for (int j = 0; j < 16; ++j) { hv[j] = bflo(hA[j]); hv[16 + j] = bfhi(hA[j]); hv[32 + j] = bflo(hB[j]); hv[48 + j] = bfhi(hB[j]); }
              float am1 = 0.f;
#pragma unroll
              for (int e = 0; e < 64; ++e) am1 = fmaxf(am1, fabsf(hv[e]));
              hs1 = am1 > 0.f ? am1 * (1.f / 7.f) : 1.f; const float iv1 = 1.f / hs1;
              float am2 = 0.f;
#pragma unroll
              for (int d = 0; d < 8; ++d) { unsigned w = 0u;
#pragma unroll
                  for (int e = 0; e < 8; ++e) { const float q = __builtin_rintf(hv[8 * d + e] * iv1); hv[8 * d + e] -= q * hs1; am2 = fmaxf(am2, fabsf(hv[8 * d + e])); w |= ((unsigned)(int)q & 0xFu) << (4 * e); }
                  hq1[d] = (int)w; }
              hs2 = am2 > 0.f ? am2 * (1.f / 7.f) : 1.f; const float iv2 = 1.f / hs2;
#pragma unroll
              for (int d = 0; d < 8; ++d) { unsigned w = 0u;
#pragma unroll
                  for (int e = 0; e < 8; ++e) { const float q = __builtin_rintf(hv[8 * d + e] * iv2); w |= ((unsigned)(int)q & 0xFu) << (4 * e); }
                  hq2[d] = (int)w; } }
            h2_t oA[16], oB[16];
#pragma unroll
            for (int j = 0; j < 16; ++j) { oA[j] = (h2_t){(_Float16)0.f, (_Float16)0.f}; oB[j] = (h2_t){(_Float16)0.f, (_Float16)0.f}; }
#pragma unroll 1
            for (int hh = 0; hh < 8; ++hh) {
                const int f0 = s * 128 + hh * 16;
#pragma unroll
                for (int k = 0; k < 16; k += 4) {
                    P12_COMPUTE(A, f0 + k, P12_FMT(k)); P12_LOAD(A, f0 + k + 4, P12_FMT(k + 4));
                    P12_COMPUTE(B, f0 + k + 1, P12_FMT(k + 1)); P12_LOAD(B, f0 + k + 5, P12_FMT(k + 5));
                    P12_COMPUTE(C, f0 + k + 2, P12_FMT(k + 2)); P12_LOAD(C, f0 + k + 6, P12_FMT(k + 6));
                    P12_COMPUTE(D, f0 + k + 3, P12_FMT(k + 3)); P12_LOAD(D, f0 + k + 7, P12_FMT(k + 7));
                }
            }
#pragma unroll
            for (int i = 0; i < 4; ++i) { const int d0 = 16 * lane + 1024 * i; const float* op = C.out + (size_t)t * D + d0; float* dp = dst + (size_t)t * D + d0;
#pragma unroll
                for (int q = 0; q < 4; ++q) { const f32x4 xv = *(const f32x4*)(op + 4 * q); const f32x4 gv = *(const f32x4*)(gt2 + d0 + 4 * q); f32x4 r;
#pragma unroll
                    for (int j = 0; j < 4; ++j) { const h2_t ov = (i < 2) ? oA[4 * q + j] : oB[4 * q + j]; r[j] = xv[j] + gv[j] * ((i & 1) ? (float)ov.y : (float)ov.x); }
                    __builtin_nontemporal_store(r, (f32x4*)(dp + 4 * q)); } }
        }
#undef P12_V4
#undef P12_FMT
#undef P12_LOAD
#undef P12_COMPUTE
        lds_sync();
    }
}

constexpr int N_PHASES = 13;
#ifndef DBG_MIX
#define DBG_MIX 0
#endif
__global__ void __launch_bounds__(NTHREADS, 2) fwd(Args args) {
    extern __shared__ __attribute__((aligned(16))) unsigned char lds_raw[];
    Ctx C0; C0.in = args.in; C0.out = args.out; C0.ws = args.ws; C0.lds = (LAS unsigned char*)lds_raw;
    C0.tid = threadIdx.x; C0.lane = C0.tid & 63; C0.wave = __builtin_amdgcn_readfirstlane(C0.tid >> 6);
#define PHASE_CTX() Ctx C = C0; { int t_ = threadIdx.x; asm volatile("" : "+v"(t_)); C.tid = t_; C.lane = t_ & 63; C.wave = __builtin_amdgcn_readfirstlane(t_ >> 6); }
    const Ctx& C = C0;
    const int lo = args.ph_lo, hi = args.ph_hi;
    const bool fused = (hi - lo) > 1;
    volatile LAS unsigned* bst = (volatile LAS unsigned*)(C.lds + LDS_BYTES - 16);
    XcdBarrier bar; bar.bar = (unsigned*)(C.ws + WS_CTL + CTL_BAR); bar.x = 0; bar.st = bst;
    if (fused) { if (C.tid == 0) { bst[0] = 0u; bst[1] = 0u; bst[2] = 0u; bst[3] = 0u; } __syncthreads(); bar = xcd_barrier_post((unsigned*)(C.ws + WS_CTL + CTL_BAR), bst); }
#ifndef ONLY_PHASE
#define ONLY_PHASE -1
#endif
#define IN(k) (lo <= (k) && (k) < hi && (ONLY_PHASE < 0 || ONLY_PHASE == (k)))
#ifndef REP_PHASE
#define REP_PHASE -1
#endif
#define REP(k, ...) if (REP_PHASE == (k)) { __VA_ARGS__ }
#define SEAM(k) do { if (IN(k) && IN((k) + 1)) xcd_barrier(bar); } while (0)
    const float* mod = (const float*)(C.ws + WS_MOD);
    bf16_t* proj = (bf16_t*)(C.ws + WS_PROJ);
    if (IN(0)) { PHASE_CTX(); REP(0, p0_prologue(C); __syncthreads();) p0_prologue(C); } SEAM(0);
    if (IN(1)) { PHASE_CTX(); norm_mod_phase(C, C.in[I_X], C.in[I_GMIX], mod + 0 * D, mod + 1 * D, (bf16_t*)(C.ws + WS_H), C.ws + WS_H8); } SEAM(1);
    if (IN(2)) { PHASE_CTX(); pg8::Gemm g{(const bf16_t*)(C.ws + WS_H), (const bf16_t*)(C.ws + WS_WIN), T, NP_BF, D, D, D}; pg8::StaticOrder S; S.init(T, NP_BF, gridDim.x, blockIdx.x);
                 pg8::EpiPlain E{proj, NP, 1.f}; pg8::gemm_phase(C.lds, g, S, E);
                 pg8::Gemm g8{(const bf16_t*)(C.ws + WS_H8), (const bf16_t*)(C.ws + WS_WIN8), T, NP_F8, D / 2, D / 2, D / 2}; pg8::Fp8Order S8{(int)blockIdx.x};
                 pg8::EpiSigU8 E8{(unsigned char*)(proj + P_GM), NP * 2, 1.f / 64.f}; pg8::gemm_phase<pg8::EpiSigU8, pg8::Fp8Order, true>(C.lds, g8, S8, E8); } SEAM(2);
    if (IN(3)) { PHASE_CTX(); p3_post(C); } SEAM(3);
    if (IN(4)) { PHASE_CTX(); pg8::Gemm g{(const bf16_t*)(C.ws + WS_KC), (const bf16_t*)(C.ws + WS_W1T), 8192, 512, 512, 2048, D}; pg8::CmpOrder S{(int)gridDim.x, (int)blockIdx.x};
                 pg8::EpiSlab E{(float*)(C.ws + WS_HIDP)}; pg8::gemm_phase(C.lds, g, S, E); } SEAM(4);
    if (IN(5)) { PHASE_CTX(); p5_cmp_out(C); } SEAM(5);
    if (IN(6)) { PHASE_CTX(); p6_mixers(C, DBG_MIX); } SEAM(6);
    if (IN(7)) { PHASE_CTX(); pg8::Gemm g{(const bf16_t*)(C.ws + WS_YA), (const bf16_t*)(C.ws + WS_WBA), T, D, 1024, 1024, 1024};   pg8::StaticOrder S; S.init(T, D, gridDim.x, blockIdx.x);
                 pg8::EpiGate<0> E{(bf16_t*)(C.ws + WS_MERGED), D, (const unsigned char*)(proj + P_GM), NP * 2, 1.f / (16.f * 64.f * 255.f), nullptr}; pg8::gemm_phase<pg8::EpiGate<0>, pg8::StaticOrder, true>(C.lds, g, S, E); } if (IN(7) && IN(8)) __syncthreads();
    if (IN(8)) { PHASE_CTX(); pg8::Gemm g{(const bf16_t*)(C.ws + WS_YB), (const bf16_t*)(C.ws + WS_WBB), T, D, 1024, 1024, 1024}; pg8::StaticOrder S; S.init(T, D, gridDim.x, blockIdx.x);
                 pg8::EpiGate<1> E{(bf16_t*)(C.ws + WS_MERGED), D, (const unsigned char*)(proj + P_GM) + 4096, NP * 2, 1.f / (16.f * 64.f * 255.f), C.ws + WS_H8}; pg8::gemm_phase<pg8::EpiGate<1>, pg8::StaticOrder, true>(C.lds, g, S, E); } SEAM(8);
    if (IN(9)) { PHASE_CTX(); pg8::Gemm g{(const bf16_t*)(C.ws + WS_H8), (const bf16_t*)(C.ws + WS_WOUT), T, D, D / 2, D / 2, D / 2};   pg8::StaticOrder S; S.init(T, D, gridDim.x, blockIdx.x);
                 pg8::EpiResid E{C.out, C.in[I_X], mod + 2 * D, D, 1.f / (32.f * 64.f)}; pg8::gemm_phase<pg8::EpiResid, pg8::StaticOrder, true>(C.lds, g, S, E); } SEAM(9);
    if (IN(10)) { PHASE_CTX(); norm_mod_phase(C, C.out, C.in[I_GFFN], mod + 3 * D, mod + 4 * D, (bf16_t*)(C.ws + WS_H2)); } SEAM(10);
    if (IN(11)) { PHASE_CTX(); pg8::Gemm g{(const bf16_t*)(C.ws + WS_H2), (const bf16_t*)(C.ws + WS_WQ), T, 2048, D, D, D}; pg8::StaticOrder S; S.init(T, 2048, gridDim.x, blockIdx.x);
                  pg8::EpiPlain E{(bf16_t*)(C.ws + WS_PQ), 2048, 1.f}; pg8::gemm_phase(C.lds, g, S, E); } SEAM(11);
    if (IN(12)) { PHASE_CTX(); REP(12, p12_peer(C, (float*)(C.ws + WS_PROJ)); __syncthreads();) p12_peer(C, C.out); }
#undef IN
#undef SEAM
}

#ifndef N_LAUNCH_MODE
#define N_LAUNCH_MODE 1
#endif
extern "C" void kernel_launch(void* const* d_in, const int* in_sizes, int n_in, void* d_out, int out_size, void* d_ws, size_t ws_size, hipStream_t stream) {
    static int grid = 0;
    if (grid == 0) {
        if (n_in != 27 || out_size != T * D || ws_size < WS_END) { fprintf(stderr, "kernel_launch: unexpected shapes (n_in %d out %d ws %zu need %zu)\n", n_in, out_size, ws_size, (size_t)WS_END); grid = -1; return; }
        int dev = 0, cus = 0;
        if (hipGetDevice(&dev) != hipSuccess || hipDeviceGetAttribute(&cus, hipDeviceAttributeMultiprocessorCount, dev) != hipSuccess) { grid = -1; return; }
        if (hipFuncSetAttribute((const void*)fwd, hipFuncAttributeMaxDynamicSharedMemorySize, LDS_BYTES) != hipSuccess) { fprintf(stderr, "kernel_launch: hipFuncSetAttribute failed\n"); grid = -1; return; }
        int per_cu = 0;
        if (hipOccupancyMaxActiveBlocksPerMultiprocessor(&per_cu, (const void*)fwd, NTHREADS, LDS_BYTES) != hipSuccess || per_cu < 1) { fprintf(stderr, "kernel_launch: occupancy query says %d\n", per_cu); }
        (void)hipGetLastError();
        grid = cus;
    }
    if (grid < 0) return;
    (void)hipMemsetAsync((char*)d_ws + WS_CTL, 0, 64 * 1024, stream);
    Args a{};
    for (int i = 0; i < 27; ++i) a.in[i] = (const float*)d_in[i];
    a.out = (float*)d_out; a.ws = (unsigned char*)d_ws;
#if N_LAUNCH_MODE == 1
    a.ph_lo = 0; a.ph_hi = N_PHASES;
    hipLaunchKernelGGL(fwd, dim3(grid), dim3(NTHREADS), LDS_BYTES, stream, a);
#else
    for (int p = 0; p < N_PHASES; ++p) { a.ph_lo = p; a.ph_hi = p + 1; hipLaunchKernelGGL(fwd, dim3(grid), dim3(NTHREADS), LDS_BYTES, stream, a); }
#endif
}
```

```cpp
#include <hip/hip_runtime.h>
#include <cstdio>
#include <cstdint>

#define LAS __attribute__((address_space(3)))
typedef unsigned short bf16_t;
typedef unsigned long long u64;
typedef short bf16x8 __attribute__((ext_vector_type(8)));
typedef float f32x4 __attribute__((ext_vector_type(4)));
typedef float f32x16 __attribute__((ext_vector_type(16)));
typedef unsigned u32x4 __attribute__((ext_vector_type(4)));
typedef unsigned u32x2 __attribute__((ext_vector_type(2)));
typedef __bf16 bf2_t __attribute__((ext_vector_type(2)));
typedef float f32x2 __attribute__((ext_vector_type(2)));
typedef float f32x32 __attribute__((ext_vector_type(32)));
typedef unsigned u32x6 __attribute__((ext_vector_type(6)));

constexpr int T = 16384, D = 4096, NP = 18688;
constexpr int P_QA = 0, P_KA = 2048, P_VA = 2560, P_QI = 3072, P_QB = 5120, P_KC = 7168, P_VC = 7680, P_KS = 8192, P_VS = 8704,
              P_KW = 9216, P_VW = 9728, P_KI = 10240, P_WI = 10304, P_GB = 10336, P_GM = 10496;
constexpr int NP_BF = 10496, NP_F8 = 8192;
constexpr int NCMP = 1023;
constexpr float EPS = 1e-6f;
constexpr int NTHREADS = 512;
constexpr int LDS_BYTES = 160 * 1024;

constexpr size_t MB = 1024ull * 1024ull;
constexpr size_t WS_CTL = 0;
constexpr size_t WS_MOD = 64 * 1024;
constexpr size_t WS_B1 = 192 * 1024;
constexpr size_t WS_B1P = 196 * 1024;
constexpr size_t WS_W1T = 512 * 1024;
constexpr size_t WS_SUBK = WS_W1T + 4 * MB;
constexpr size_t WS_HID = WS_SUBK + 512 * 1024;
constexpr size_t WS_KCMP = WS_HID + 8 * MB;
constexpr size_t WS_VCMPT = WS_KCMP + 1 * MB;
constexpr size_t WS_KIC = WS_VCMPT + 1 * MB;
constexpr size_t WS_KC = WS_KIC + 2 * MB;
constexpr size_t WS_VST = WS_KC + 32 * MB + 64 * 1024;
constexpr size_t WS_VWT = WS_VST + 16 * MB;
constexpr size_t WS_WBA = WS_VWT + 16 * MB;
constexpr size_t WS_WBB = WS_WBA + 16 * MB;
constexpr size_t WS_WOUT = WS_WBB + 16 * MB;
constexpr size_t WS_WQ = WS_WOUT + 32 * MB;
constexpr size_t WS_PU = WS_WQ + 16 * MB;
constexpr size_t WS_PV = WS_PU + 128 * MB;
constexpr size_t WS_PU4 = WS_PU + 56 * MB, WS_PV4 = WS_PV + 56 * MB;
constexpr size_t WS_PROJ = WS_PV + 128 * MB;
constexpr size_t WS_WIN = WS_PROJ + (size_t)T * NP * 2;
constexpr size_t WS_H = WS_WIN + (size_t)NP * D * 2;
constexpr size_t WS_KA = WS_H + 128 * MB;
constexpr size_t WS_VA = WS_KA + 16 * MB;
constexpr size_t WS_KSC = WS_VA + 16 * MB;
constexpr size_t WS_KWC = WS_KSC + 16 * MB;
constexpr size_t WS_HIDP = WS_KWC + 16 * MB;
constexpr size_t WS_OACC = WS_HIDP + 64 * MB;
constexpr size_t WS_H8 = WS_OACC + 32 * MB;
constexpr size_t WS_END = WS_H8 + 64 * MB;
constexpr size_t WS_WIN8 = WS_WIN + (size_t)NP_BF * D * 2;
constexpr size_t WS_YA = WS_WIN, WS_YB = WS_WIN + 64 * MB, WS_H2 = WS_WIN;
constexpr size_t WS_MERGED = WS_H, WS_PQ = WS_H;
constexpr size_t CTL_BAR = 0, CTL_CNT = 16384;

__device__ __forceinline__ float bf2f(bf16_t b) { return __uint_as_float(((unsigned)b) << 16); }
__device__ __forceinline__ float bflo(unsigned u) { return __uint_as_float(u << 16); }
__device__ __forceinline__ float bfhi(unsigned u) { return __uint_as_float(u & 0xFFFF0000u); }
__device__ __forceinline__ unsigned cvt_pk_bf16(float lo, float hi) { unsigned r; asm volatile("v_cvt_pk_bf16_f32 %0, %1, %2" : "=v"(r) : "v"(lo), "v"(hi)); return r; }
__device__ __forceinline__ bf16_t f2bf(float f) { return (bf16_t)(cvt_pk_bf16(f, 0.f) & 0xFFFFu); }
__device__ __forceinline__ float dot2bf(unsigned a, unsigned b, float c) { return __builtin_amdgcn_fdot2_f32_bf16(__builtin_bit_cast(bf2_t, a), __builtin_bit_cast(bf2_t, b), c, false); }
template <int CTRL> __device__ __forceinline__ float dppf(float v) { return __builtin_bit_cast(float, __builtin_amdgcn_update_dpp(0, __builtin_bit_cast(int, v), CTRL, 0xF, 0xF, true)); }
template <int CTRL> __device__ __forceinline__ unsigned dppu(unsigned v) { return (unsigned)__builtin_amdgcn_update_dpp(0, (int)v, CTRL, 0xF, 0xF, true); }
__device__ __forceinline__ void swap32f(float& a, float& b) { asm volatile("s_nop 1\n\tv_permlane32_swap_b32 %0, %1" : "+v"(a), "+v"(b)); }
__device__ __forceinline__ void swap16f(float& a, float& b) { asm volatile("s_nop 1\n\tv_permlane16_swap_b32 %0, %1" : "+v"(a), "+v"(b)); }
__device__ __forceinline__ void swap32u(unsigned& a, unsigned& b) { asm volatile("s_nop 1\n\tv_permlane32_swap_b32 %0, %1" : "+v"(a), "+v"(b)); }
__device__ __forceinline__ void swap16u(unsigned& a, unsigned& b) { asm volatile("s_nop 1\n\tv_permlane16_swap_b32 %0, %1" : "+v"(a), "+v"(b)); }
__device__ __forceinline__ float fmax_fast(float a, float b) { float r; asm("v_max_f32 %0, %1, %2" : "=v"(r) : "v"(a), "v"(b)); return r; }
__device__ __forceinline__ float xsum32(float v) { float a = v, b = v; swap32f(a, b); return a + b; }
__device__ __forceinline__ float xsum16(float v) { float a = v, b = v; swap16f(a, b); return a + b; }
__device__ __forceinline__ float xmax32(float v) { float a = v, b = v; swap32f(a, b); return fmax_fast(a, b); }
__device__ __forceinline__ float xmax16(float v) { float a = v, b = v; swap16f(a, b); return fmax_fast(a, b); }
__device__ __forceinline__ float xor32f(float v, int h) { float a = v, b = v; swap32f(a, b); return h ? a : b; }
__device__ __forceinline__ float wave_sum(float v) { v += dppf<0xB1>(v); v += dppf<0x4E>(v); v += dppf<0x141>(v); v += dppf<0x140>(v); return xsum16(xsum32(v)); }
__device__ __forceinline__ float wave_max(float v) { v = fmax_fast(v, dppf<0xB1>(v)); v = fmax_fast(v, dppf<0x4E>(v)); v = fmax_fast(v, dppf<0x141>(v)); v = fmax_fast(v, dppf<0x140>(v)); return xmax16(xmax32(v)); }
__device__ __forceinline__ unsigned umaxu(unsigned a, unsigned b) { return a > b ? a : b; }
__device__ __forceinline__ unsigned wave_maxu(unsigned v) { v = umaxu(v, dppu<0xB1>(v)); v = umaxu(v, dppu<0x4E>(v)); v = umaxu(v, dppu<0x141>(v)); v = umaxu(v, dppu<0x140>(v));
    unsigned a = v, b = v; swap32u(a, b); v = umaxu(a, b); a = v; b = v; swap16u(a, b); return umaxu(a, b); }
__device__ __forceinline__ void lds_sync() { asm volatile("s_waitcnt lgkmcnt(0)" ::: "memory"); __builtin_amdgcn_wave_barrier(); }
__device__ __forceinline__ float gelu_tanh(float x) { const float u = 0.7978845608028654f * (x + 0.044715f * x * x * x); const float e = __expf(2.f * u); return 0.5f * x * (2.f - 2.f / (e + 1.f)); }
__device__ __forceinline__ float sigmoidf_(float x) { return __builtin_amdgcn_rcpf(1.f + __expf(-x)); }
__device__ __forceinline__ unsigned sortable(float s) { unsigned b = __float_as_uint(s); return b ^ ((b >> 31) ? 0xFFFFFFFFu : 0x80000000u); }

#define XB_TMO      128
#define XB_XCNT(j)  (256  + 64 * (j))
#define XB_XSUB(j)  (1280 + 64 * (j))
#define XB_XGEN(j)  (2304 + 64 * (j))
#define XB_TOP      3328
#define XB_TOPGEN   3392
#define XCD_BAR_WORDS 3456
#define XB_SPIN_CAP (1u << 24)
__device__ __forceinline__ unsigned xb_ld(unsigned* p)              { return __hip_atomic_load(p, __ATOMIC_RELAXED, __HIP_MEMORY_SCOPE_AGENT); }
__device__ __forceinline__ unsigned xb_add(unsigned* p, unsigned v) { return __hip_atomic_fetch_add(p, v, __ATOMIC_RELAXED, __HIP_MEMORY_SCOPE_AGENT); }
__device__ __forceinline__ unsigned xb_xcc_id() { return (unsigned)__builtin_amdgcn_s_getreg((3 << 11) | 20) & 0xFu; }
#define XB_SPIN(cond, bar) do { unsigned _sp = 0; while (cond) { __builtin_amdgcn_s_sleep(1); \
    if ((++_sp & 255u) == 0u) { if (xb_ld(&(bar)[XB_TMO])) break; if (_sp > XB_SPIN_CAP) { atomicAdd(&(bar)[XB_TMO], 1u); break; } } } } while (0)
struct XcdBarrier { unsigned* bar; unsigned x; volatile LAS unsigned* st; };
__device__ __forceinline__ XcdBarrier xcd_barrier_post(unsigned* bar, volatile LAS unsigned* st) {
    XcdBarrier b; b.bar = bar; b.x = xb_xcc_id(); b.st = st;
    if (threadIdx.x == 0) (void)xb_add(&bar[XB_XCNT(b.x)], 1u);
    return b;
}
__device__ __forceinline__ void xcd_barrier_complete(unsigned* bar, unsigned x, unsigned& nloc, unsigned& nx) {
    const unsigned G = gridDim.x * gridDim.y * gridDim.z;
    unsigned sum, cnt, mine, sp = 0u;
    for (;;) {
        sum = 0u; cnt = 0u; mine = 0u;
#pragma unroll
        for (unsigned j = 0; j < 16; ++j) { const unsigned c = xb_ld(&bar[XB_XCNT(j)]); sum += c; cnt += (c > 0u) ? 1u : 0u; mine = (j == x) ? c : mine; }
        if (sum == G) break;
        __builtin_amdgcn_s_sleep(1);
        if ((++sp & 255u) == 0u) { if (xb_ld(&bar[XB_TMO])) break; if (sp > XB_SPIN_CAP) { atomicAdd(&bar[XB_TMO], 1u); break; } }
    }
    nloc = mine > 0u ? mine : 1u; nx = cnt > 0u ? cnt : 1u;
}
__device__ __forceinline__ void xcd_barrier(const XcdBarrier& b) {
    asm volatile("s_waitcnt vmcnt(0)" ::: "memory");
    __syncthreads();
    if (threadIdx.x == 0) {
        unsigned* bar = b.bar;
        __builtin_amdgcn_s_waitcnt(0);
        unsigned nloc = b.st[0], nx = b.st[1];
        if (nloc == 0u) { xcd_barrier_complete(bar, b.x, nloc, nx); b.st[0] = nloc; b.st[1] = nx; }
        const unsigned old = xb_add(&bar[XB_XSUB(b.x)], 1u);
        const unsigned gen = old / nloc;
        if (old + 1u == (gen + 1u) * nloc) {
            __builtin_amdgcn_fence(__ATOMIC_RELEASE, "agent");
            asm volatile("s_waitcnt vmcnt(0)" ::: "memory");
            const unsigned og = xb_add(&bar[XB_TOP], 1u);
            const unsigned tg = og / nx;
            if (og + 1u == (tg + 1u) * nx) xb_add(&bar[XB_TOPGEN], 1u);
            else XB_SPIN(xb_ld(&bar[XB_TOPGEN]) == tg, bar);
            __builtin_amdgcn_fence(__ATOMIC_ACQUIRE, "agent");
            xb_add(&bar[XB_XGEN(b.x)], 1u);
            asm volatile("s_waitcnt vmcnt(0)" ::: "memory");
        } else {
            XB_SPIN(xb_ld(&bar[XB_XGEN(b.x)]) == gen, bar);
            __builtin_amdgcn_fence(__ATOMIC_ACQUIRE, "agent");
            asm volatile("s_waitcnt vmcnt(0)" ::: "memory");
        }
    }
    __syncthreads();
}

namespace pg8 {
constexpr int BM = 256, BK = 64, HALF = 128, HTB = HALF * BK * 2, STAGE_BYTES = 8 * HTB, NXCD = 8, WGM = 8;
__host__ __device__ __forceinline__ int lds_byte(int r, int c) { const int st = (r >> 4) * 2 + (c >> 5), rr = r & 15, cc = c & 31, ob = rr * 64 + cc * 2; return st * 1024 + (ob ^ (((ob >> 9) & 1) << 5)); }
__host__ __device__ __forceinline__ void stage_rc(int b, int& R, int& C) { const int st = b / 1024, sb = b % 1024, swz = sb ^ (((sb >> 9) & 1) << 5); R = (st >> 1) * 16 + swz / 64; C = (st & 1) * 32 + (swz % 64) / 2; }
__host__ __device__ __forceinline__ int perm32(int rho) { const int n = rho >> 4, i = rho & 15; return 8 * (i >> 2) + 4 * n + (i & 3); }
struct Unit { int pm, pn, kofs; };
struct Gemm { const bf16_t* A; const bf16_t* Bt; int M, N, K, lda, ldb; };
struct StaticOrder {
    int nM, nN, nwg, G, c;
    __host__ __device__ void init(int M, int N, int G_, int c_) { nM = M / BM; nN = N / BM; nwg = nM * nN; G = G_; c = c_; }
    __host__ __device__ bool next(int i, Unit& u) const {
        const long L = (long)i * G + c; if (L >= nwg) return false;
        int wgid = (int)L; { const int q = nwg / NXCD, r = nwg % NXCD, xcd = wgid % NXCD, off = wgid / NXCD; wgid = (xcd < r ? xcd * (q + 1) : r * (q + 1) + (xcd - r) * q) + off; }
        const int nig = WGM * nN, gid = wgid / nig, fm = gid * WGM, gsz = (nM - fm) < WGM ? (nM - fm) : WGM;
        u.pm = fm + ((wgid % nig) % gsz); u.pn = (wgid % nig) / gsz; u.kofs = 0; return true;
    }
};
struct Fp8Order {
    int c;
    __host__ __device__ bool next(int i, Unit& u) const {
        const int cnt = c < 64 ? 6 : (c < 192 ? 9 : 8); if (i >= cnt) return false;
        const int off = c < 64 ? 6 * c : (c < 192 ? 384 + 9 * (c - 64) : 1536 + 8 * (c - 192));
        const int L = off + i; u.pm = L & 63; u.pn = L >> 6; u.kofs = 0; return true; }
};
struct CmpOrder {
    int G, c;
    __host__ __device__ bool next(int i, Unit& u) const { const long L = (long)i * G + c; if (L >= 256) return false; u.pm = (int)(L & 31); u.pn = u.pm >> 4; u.kofs = (int)(L >> 5) * 512; return true; }
};

struct EpiPlain {
    static constexpr bool PERM = true;
    bf16_t* O; int ldc; float scale;
    __device__ __forceinline__ void operator()(const f32x4 (&acc)[2][2][4][2], const Unit& u, int wr, int wc, int fr, int fq) const {
        const int row0 = u.pm * BM + wr * 64 + fr, col0 = u.pn * BM + wc * 32 + 8 * fq;
#pragma unroll
        for (int ai = 0; ai < 2; ++ai)
#pragma unroll
            for (int m = 0; m < 4; ++m) { bf16_t* rowp = O + (size_t)(row0 + ai * HALF + m * 16) * ldc + col0;
#pragma unroll
                for (int bj = 0; bj < 2; ++bj) { const f32x4 v0 = acc[ai][bj][m][0] * scale, v1 = acc[ai][bj][m][1] * scale;
                    u32x4 w; w.x = cvt_pk_bf16(v0[0], v0[1]); w.y = cvt_pk_bf16(v0[2], v0[3]); w.z = cvt_pk_bf16(v1[0], v1[1]); w.w = cvt_pk_bf16(v1[2], v1[3]);
                    *(u32x4*)(rowp + bj * HALF) = w; } }
    }
};
struct EpiSigU8 {
    static constexpr bool PERM = true;
    unsigned char* O; int ldb; float scale;
    __device__ __forceinline__ void operator()(const f32x4 (&acc)[2][2][4][2], const Unit& u, int wr, int wc, int fr, int fq) const {
        const int row0 = u.pm * BM + wr * 64 + fr, col0 = u.pn * BM + wc * 32 + 8 * fq;
#pragma unroll
        for (int ai = 0; ai < 2; ++ai)
#pragma unroll
            for (int m = 0; m < 4; ++m) { unsigned char* rowp = O + (size_t)(row0 + ai * HALF + m * 16) * ldb + col0;
#pragma unroll
                for (int bj = 0; bj < 2; ++bj) { const f32x4 v0 = acc[ai][bj][m][0] * scale, v1 = acc[ai][bj][m][1] * scale;
                    unsigned w0 = 0u, w1 = 0u;
                    w0 = __builtin_amdgcn_cvt_pk_u8_f32(255.f * sigmoidf_(v0[0]), 0, w0); w0 = __builtin_amdgcn_cvt_pk_u8_f32(255.f * sigmoidf_(v0[1]), 1, w0);
                    w0 = __builtin_amdgcn_cvt_pk_u8_f32(255.f * sigmoidf_(v0[2]), 2, w0); w0 = __builtin_amdgcn_cvt_pk_u8_f32(255.f * sigmoidf_(v0[3]), 3, w0);
                    w1 = __builtin_amdgcn_cvt_pk_u8_f32(255.f * sigmoidf_(v1[0]), 0, w1); w1 = __builtin_amdgcn_cvt_pk_u8_f32(255.f * sigmoidf_(v1[1]), 1, w1);
                    w1 = __builtin_amdgcn_cvt_pk_u8_f32(255.f * sigmoidf_(v1[2]), 2, w1); w1 = __builtin_amdgcn_cvt_pk_u8_f32(255.f * sigmoidf_(v1[3]), 3, w1);
                    *(u32x2*)(rowp + bj * HALF) = (u32x2){w0, w1}; } }
    }
};
template <int SECOND> struct EpiGate {
    static constexpr bool PERM = true;
    bf16_t* O; int ldc; const unsigned char* gate; int ldg; float scale; unsigned char* O8;
    __device__ __forceinline__ void operator()(const f32x4 (&acc)[2][2][4][2], const Unit& u, int wr, int wc, int fr, int fq) const {
        const int row0 = u.pm * BM + wr * 64 + fr, col0 = u.pn * BM + wc * 32 + 8 * fq;
#pragma unroll
        for (int ai = 0; ai < 2; ++ai)
#pragma unroll
            for (int m = 0; m < 4; ++m) { const size_t row = (size_t)(row0 + ai * HALF + m * 16); bf16_t* rowp = O + row * ldc + col0; const unsigned char* gp = gate + row * ldg + col0;
#pragma unroll
                for (int bj = 0; bj < 2; ++bj) { const f32x4 v0 = acc[ai][bj][m][0] * scale, v1 = acc[ai][bj][m][1] * scale;
                    const u32x2 gv = *(const u32x2*)(gp + bj * HALF);
                    float r[8];
#pragma unroll
                    for (int e = 0; e < 4; ++e) { r[e] = (float)((gv.x >> (8 * e)) & 0xFFu) * v0[e]; r[4 + e] = (float)((gv.y >> (8 * e)) & 0xFFu) * v1[e]; }
                    if (SECOND) { const u32x4 pv = *(const u32x4*)(rowp + bj * HALF);
                        r[0] += bflo(pv.x); r[1] += bfhi(pv.x); r[2] += bflo(pv.y); r[3] += bfhi(pv.y); r[4] += bflo(pv.z); r[5] += bfhi(pv.z); r[6] += bflo(pv.w); r[7] += bfhi(pv.w);
                        int p0 = __builtin_amdgcn_cvt_pk_fp8_f32(r[0] * 32.f, r[1] * 32.f, 0, false); p0 = __builtin_amdgcn_cvt_pk_fp8_f32(r[2] * 32.f, r[3] * 32.f, p0, true);
                        int p1 = __builtin_amdgcn_cvt_pk_fp8_f32(r[4] * 32.f, r[5] * 32.f, 0, false); p1 = __builtin_amdgcn_cvt_pk_fp8_f32(r[6] * 32.f, r[7] * 32.f, p1, true);
                        *(u32x2*)(O8 + row * ldc + col0 + bj * HALF) = (u32x2){(unsigned)p0, (unsigned)p1};
                    } else {
                    u32x4 w; w.x = cvt_pk_bf16(r[0], r[1]); w.y = cvt_pk_bf16(r[2], r[3]); w.z = cvt_pk_bf16(r[4], r[5]); w.w = cvt_pk_bf16(r[6], r[7]);
                    *(u32x4*)(rowp + bj * HALF) = w; } } }
    }
};
struct EpiResid {
    static constexpr bool PERM = false;
    float* C; const float* X; const float* gt; int ldc; float scale;
    __device__ __forceinline__ void operator()(const f32x4 (&acc)[2][2][4][2], const Unit& u, int wr, int wc, int fr, int fq) const {
        const int row0 = u.pm * BM + wr * 64 + fr, col0 = u.pn * BM + wc * 32 + 4 * fq;
        f32x4 gv[2][2];
#pragma unroll
        for (int bj = 0; bj < 2; ++bj)
#pragma unroll
            for (int n = 0; n < 2; ++n) gv[bj][n] = *(const f32x4*)(gt + col0 + bj * HALF + n * 16) * scale;
#pragma unroll
        for (int ai = 0; ai < 2; ++ai)
#pragma unroll
            for (int m = 0; m < 4; ++m) { const size_t off = (size_t)(row0 + ai * HALF + m * 16) * ldc + col0;
#pragma unroll
                for (int bj = 0; bj < 2; ++bj)
#pragma unroll
                    for (int n = 0; n < 2; ++n) { const f32x4 xv = *(const f32x4*)(X + off + bj * HALF + n * 16);
                        *(f32x4*)(C + off + bj * HALF + n * 16) = xv + gv[bj][n] * acc[ai][bj][m][n]; } }
    }
};
struct EpiSlab {
    static constexpr bool PERM = false;
    float* C;
    __device__ __forceinline__ void operator()(const f32x4 (&acc)[2][2][4][2], const Unit& u, int wr, int wc, int fr, int fq) const {
        const int row0 = u.pm * BM + wr * 64 + fr, col0 = wc * 32 + 4 * fq;
        float* base = C + (size_t)(u.kofs >> 9) * 8192 * 256;
#pragma unroll
        for (int ai = 0; ai < 2; ++ai)
#pragma unroll
            for (int m = 0; m < 4; ++m) { float* rowp = base + (size_t)(row0 + ai * HALF + m * 16) * 256 + col0;
#pragma unroll
                for (int bj = 0; bj < 2; ++bj)
#pragma unroll
                    for (int n = 0; n < 2; ++n) *(f32x4*)(rowp + bj * HALF + n * 16) = acc[ai][bj][m][n]; }
    }
};

typedef int i32x8 __attribute__((ext_vector_type(8)));
template <class Epi, class Sched, bool FP8 = false>
__device__ __forceinline__ void gemm_phase(LAS unsigned char* lds, const Gemm g, const Sched& S, const Epi& E) {
    const int tid = threadIdx.x, wid = __builtin_amdgcn_readfirstlane(tid >> 6), lane = tid & 63, wr = wid >> 2, wc = wid & 3, fr = lane & 15, fq = lane >> 4;
    const int K = g.K, nt = K / BK, lda = g.lda, ldb = g.ldb;
    unsigned voffA[2], voffB[2];
#pragma unroll
    for (int i = 0; i < 2; ++i) { int R, C; stage_rc(tid * 16 + i * 8192, R, C); const int Rb = Epi::PERM ? ((R & ~31) + perm32(R & 31)) : R;
        voffA[i] = (unsigned)(R * lda + C) * 2u; voffB[i] = (unsigned)(Rb * ldb + C) * 2u; }
    const size_t kstep = (size_t)(BK * 2);
    const size_t hstepA = (size_t)HALF * lda * 2, hstepB = (size_t)HALF * ldb * 2;
    const size_t tstepA = 2 * hstepA, tstepB = 2 * hstepB;
    const unsigned ldsw = (unsigned)wid * 1024u;
    const int aoff = lds_byte(wr * 64 + fr, fq * 8), boff = lds_byte(wc * 32 + fr, fq * 8);
#define PG8_SA(b, h) (((b) * 2 + (h)) * HTB)
#define PG8_SB(b, h) ((4 + (b) * 2 + (h)) * HTB)
#define PG8_STAGE(bufoff, gbase, voff) do { _Pragma("unroll") for (int _i = 0; _i < 2; ++_i) \
        __builtin_amdgcn_global_load_lds((const unsigned*)((const char*)(gbase) + (voff)[_i]), (LAS unsigned*)(lds + (bufoff) + ldsw + _i * 8192), 16, 0, 0); } while (0)
#define PG8_LDA(dst, b, h) do { _Pragma("unroll") for (int m = 0; m < 4; ++m) { if constexpr (FP8) dst##8[m] = __builtin_shufflevector(*(const LAS i32x4_*)(lds + PG8_SA(b, h) + aoff + m * 2048), *(const LAS i32x4_*)(lds + PG8_SA(b, h) + aoff + m * 2048 + 1024), 0, 1, 2, 3, 4, 5, 6, 7); \
        else { _Pragma("unroll") for (int k = 0; k < 2; ++k) dst[m][k] = *(const LAS bf16x8*)(lds + PG8_SA(b, h) + aoff + m * 2048 + k * 1024); } } } while (0)
#define PG8_LDB(dst, b, h) do { _Pragma("unroll") for (int n = 0; n < 2; ++n) { if constexpr (FP8) dst##8[n] = __builtin_shufflevector(*(const LAS i32x4_*)(lds + PG8_SB(b, h) + boff + n * 2048), *(const LAS i32x4_*)(lds + PG8_SB(b, h) + boff + n * 2048 + 1024), 0, 1, 2, 3, 4, 5, 6, 7); \
        else { _Pragma("unroll") for (int k = 0; k < 2; ++k) dst[n][k] = *(const LAS bf16x8*)(lds + PG8_SB(b, h) + boff + n * 2048 + k * 1024); } } } while (0)
typedef int i32x4_ __attribute__((ext_vector_type(4)));
#define PG8_MMA(ai, bj, At, Bt) do { __builtin_amdgcn_s_setprio(1); _Pragma("unroll") for (int m = 0; m < 4; ++m) _Pragma("unroll") for (int n = 0; n < 2; ++n) { \
        if constexpr (FP8) asm volatile("v_mfma_scale_f32_16x16x128_f8f6f4 %0, %1, %2, %0, %3, %3 op_sel_hi:[0,0,0]" : "+v"(acc[ai][bj][m][n]) : "v"(Bt##8[n]), "v"(At##8[m]), "v"(one_scale)); \
        else { _Pragma("unroll") for (int k = 0; k < 2; ++k) acc[ai][bj][m][n] = __builtin_amdgcn_mfma_f32_16x16x32_bf16(Bt[n][k], At[m][k], acc[ai][bj][m][n], 0, 0, 0); } } \
        __builtin_amdgcn_s_setprio(0); } while (0)
#define PG8_WAIT_V(n) asm volatile("s_waitcnt vmcnt(" #n ")" ::: "memory")
#define PG8_WAIT_L(n) asm volatile("s_waitcnt lgkmcnt(" #n ")" ::: "memory")
#define PG8_BAR __builtin_amdgcn_s_barrier()
#define PG8_SCHED __builtin_amdgcn_sched_barrier(0)
    Unit cur, nxt; int ui = 0;
    if (!S.next(0, cur)) return;
    f32x4 acc[2][2][4][2];
#pragma unroll
    for (int a = 0; a < 2; ++a)
#pragma unroll
        for (int b = 0; b < 2; ++b)
#pragma unroll
            for (int m = 0; m < 4; ++m)
#pragma unroll
                for (int n = 0; n < 2; ++n) acc[a][b][m][n] = (f32x4){0.f, 0.f, 0.f, 0.f};
    bf16x8 At[4][2], B0[2][2], B1[2][2];
    i32x8 At8[4], B08[2], B18[2];
    const int one_scale = 0x7F7F7F7F;
    const char* cA = (const char*)g.A + (size_t)cur.pm * tstepA + (size_t)cur.kofs * 2; const char* cB = (const char*)g.Bt + (size_t)cur.pn * tstepB + (size_t)cur.kofs * 2;
    PG8_STAGE(PG8_SB(0, 0), cB, voffB); PG8_STAGE(PG8_SB(0, 1), cB + hstepB, voffB); PG8_STAGE(PG8_SA(0, 0), cA, voffA); PG8_STAGE(PG8_SA(0, 1), cA + hstepA, voffA);
    if (wr == 1) PG8_BAR;
    PG8_WAIT_V(2); PG8_BAR;
    PG8_STAGE(PG8_SB(1, 0), cB + kstep, voffB); PG8_STAGE(PG8_SA(1, 0), cA + kstep, voffA); PG8_STAGE(PG8_SB(1, 1), cB + hstepB + kstep, voffB);
    PG8_WAIT_V(6); PG8_BAR;
    for (;;) {
        const bool has_next = S.next(ui + 1, nxt);
        const char* nA = has_next ? (const char*)g.A + (size_t)nxt.pm * tstepA + (size_t)nxt.kofs * 2 : cA; const char* nB = has_next ? (const char*)g.Bt + (size_t)nxt.pn * tstepB + (size_t)nxt.kofs * 2 : cB;
        for (int t = 0; t < nt; t += 2) {
            const bool last = (t == nt - 2);
            const char* a1 = cA + (size_t)(t + 1) * kstep;
            const char* a2 = last ? nA : cA + (size_t)(t + 2) * kstep; const char* b2 = last ? nB : cB + (size_t)(t + 2) * kstep;
            const char* a3 = a2 + kstep; const char* b3 = b2 + kstep;
            PG8_LDB(B0, 0, 0); PG8_LDB(B1, 0, 1); PG8_SCHED; PG8_LDA(At, 0, 0); PG8_STAGE(PG8_SA(1, 1), a1 + hstepA, voffA);
            PG8_WAIT_V(8); PG8_WAIT_L(0); PG8_BAR; PG8_MMA(0, 0, At, B0); PG8_MMA(0, 1, At, B1); PG8_BAR; PG8_SCHED;
            PG8_LDA(At, 0, 1); PG8_STAGE(PG8_SB(0, 0), b2, voffB); PG8_STAGE(PG8_SB(0, 1), b2 + hstepB, voffB); PG8_STAGE(PG8_SA(0, 0), a2, voffA);
            PG8_WAIT_V(8); PG8_WAIT_L(0); PG8_BAR; PG8_MMA(1, 0, At, B0); PG8_MMA(1, 1, At, B1); PG8_BAR; PG8_SCHED;
            PG8_LDB(B0, 1, 0); PG8_LDB(B1, 1, 1); PG8_SCHED; PG8_LDA(At, 1, 0); PG8_STAGE(PG8_SA(0, 1), a2 + hstepA, voffA);
            PG8_WAIT_V(8); PG8_WAIT_L(0); PG8_BAR; PG8_MMA(0, 0, At, B0); PG8_MMA(0, 1, At, B1); PG8_BAR; PG8_SCHED;
            PG8_LDA(At, 1, 1); PG8_STAGE(PG8_SB(1, 0), b3, voffB); PG8_STAGE(PG8_SB(1, 1), b3 + hstepB, voffB); PG8_STAGE(PG8_SA(1, 0), a3, voffA);
            PG8_WAIT_V(8); PG8_WAIT_L(0); PG8_BAR; PG8_MMA(1, 0, At, B0); PG8_MMA(1, 1, At, B1); PG8_BAR; PG8_SCHED;
        }
        if (wr == 0) PG8_BAR;
        if constexpr (FP8) asm volatile("s_nop 15\n\ts_nop 15\n\ts_nop 15" ::: "memory");
        E(acc, cur, wr, wc, fr, fq);
        if (!has_next) break;
#pragma unroll
        for (int a = 0; a < 2; ++a)
#pragma unroll
            for (int b = 0; b < 2; ++b)
#pragma unroll
                for (int m = 0; m < 4; ++m)
#pragma unroll
                    for (int n = 0; n < 2; ++n) acc[a][b][m][n] = (f32x4){0.f, 0.f, 0.f, 0.f};
        cur = nxt; cA = nA; cB = nB; ++ui;
        if (wr == 1) PG8_BAR;
    }
    PG8_WAIT_V(0);
    PG8_BAR;
#undef PG8_SA
#undef PG8_SB
#undef PG8_STAGE
#undef PG8_LDA
#undef PG8_LDB
#undef PG8_MMA
#undef PG8_WAIT_V
#undef PG8_WAIT_L
#undef PG8_BAR
#undef PG8_SCHED
}
}

struct Args { const float* in[27]; float* out; unsigned char* ws; int ph_lo, ph_hi; };
struct Ctx { const float* const* in; float* out; unsigned char* ws; LAS unsigned char* lds; int tid, lane, wave; };

enum { I_X = 0, I_C, I_RELB, I_WADA, I_BADA, I_GMIX, I_WIN, I_GQA, I_GKA, I_GQB, I_GKCMP, I_GKSLC, I_GKWIN, I_PEK, I_W1K, I_W2K, I_PEV, I_W1V, I_W2V,
       I_WBA, I_WBB, I_WOUT, I_GFFN, I_WPQ, I_SUBK, I_PU, I_PV };

__device__ __forceinline__ int map_col(int c) {
    if (c < 5120) return c; if (c < 10240) return c + 96; if (c < 10336) return c - 5120; if (c < 10384) return c; if (c < 10496) return -1; return c - 112;
}

template <bool REMAP>
__device__ __forceinline__ void tconv_tile(const Ctx& C, const float* src, int srcN, bf16_t* dst, int dstK, int n0, int k0) {
    LAS float* tile = (LAS float*)C.lds;
    const int tx = C.tid & 31, ty = C.tid >> 5;
    const int nn = n0 + 4 * tx; const int sc = REMAP ? map_col(nn) : nn;
    f32x4 v[8];
#pragma unroll
    for (int i = 0; i < 8; ++i) { const int k = ty + 16 * i; v[i] = (sc >= 0) ? *(const f32x4*)(src + (size_t)(k0 + k) * srcN + sc) : (f32x4){0.f, 0.f, 0.f, 0.f}; }
#pragma unroll
    for (int i = 0; i < 8; ++i) { const int k = ty + 16 * i; LAS float* q = tile + k * 129 + 4 * tx; q[0] = v[i][0]; q[1] = v[i][1]; q[2] = v[i][2]; q[3] = v[i][3]; }
    __syncthreads();
#pragma unroll
    for (int i = 0; i < 4; ++i) { const int task = C.tid + 512 * i; const int nl = task >> 4, kc = task & 15;
        float e[8];
#pragma unroll
        for (int j = 0; j < 8; ++j) e[j] = tile[(kc * 8 + j) * 129 + nl];
        u32x4 w; w.x = cvt_pk_bf16(e[0], e[1]); w.y = cvt_pk_bf16(e[2], e[3]); w.z = cvt_pk_bf16(e[4], e[5]); w.w = cvt_pk_bf16(e[6], e[7]);
        *(u32x4*)(dst + (size_t)(n0 + nl) * dstK + k0 + kc * 8) = w; }
    __syncthreads();
}

template <bool REMAP>
__device__ __forceinline__ void tconv_tile_f8(const Ctx& C, const float* src, int srcN, unsigned char* dst, int dstK, int n0, int k0) {
    LAS float* tile = (LAS float*)C.lds;
    const int tx = C.tid & 31, ty = C.tid >> 5;
    const int nn = n0 + 4 * tx; const int sc = REMAP ? map_col(nn) : nn;
    f32x4 v[8];
#pragma unroll
    for (int i = 0; i < 8; ++i) { const int k = ty + 16 * i; v[i] = (sc >= 0) ? *(const f32x4*)(src + (size_t)(k0 + k) * srcN + sc) : (f32x4){0.f, 0.f, 0.f, 0.f}; }
#pragma unroll
    for (int i = 0; i < 8; ++i) { const int k = ty + 16 * i; LAS float* q = tile + k * 129 + 4 * tx; q[0] = v[i][0]; q[1] = v[i][1]; q[2] = v[i][2]; q[3] = v[i][3]; }
    __syncthreads();
#pragma unroll
    for (int i = 0; i < 2; ++i) { const int task = C.tid + 512 * i; const int nl = task >> 3, kc = task & 7;
        float e[16];
#pragma unroll
        for (int j = 0; j < 16; ++j) e[j] = tile[(kc * 16 + j) * 129 + nl] * 64.f;
        u32x4 w;
#pragma unroll
        for (int q4 = 0; q4 < 4; ++q4) { int p = __builtin_amdgcn_cvt_pk_fp8_f32(e[4 * q4], e[4 * q4 + 1], 0, false); p = __builtin_amdgcn_cvt_pk_fp8_f32(e[4 * q4 + 2], e[4 * q4 + 3], p, true); w[q4] = (unsigned)p; }
        *(u32x4*)(dst + (size_t)(n0 + nl) * dstK + k0 + kc * 16) = w; }
    __syncthreads();
}

__device__ __forceinline__ void wq_subkey_tile(const Ctx& C, int blk, int k0) {
    LAS float* As = (LAS float*)C.lds;
    LAS float* Bs = As + 128 * 132;
    const int tid = C.tid;
    const float* sk = C.in[I_SUBK] + (size_t)blk * 128 * 128; const float* wq = C.in[I_WPQ] + (size_t)k0 * 2048 + blk * 128;
#pragma unroll
    for (int i = 0; i < 8; ++i) { const int idx = tid + 512 * i, r = idx >> 5, c4 = idx & 31;
        const f32x4 a = *(const f32x4*)(sk + (size_t)r * 128 + 4 * c4), b = *(const f32x4*)(wq + (size_t)r * 2048 + 4 * c4);
        *(LAS f32x4*)(As + r * 132 + 4 * c4) = a; *(LAS f32x4*)(Bs + r * 132 + 4 * c4) = b; }
    __syncthreads();
    const int tn = tid >> 4, tk = tid & 15;
    float acc[4][8];
#pragma unroll
    for (int i = 0; i < 4; ++i)
#pragma unroll
        for (int j = 0; j < 8; ++j) acc[i][j] = 0.f;
#pragma unroll 2
    for (int d4 = 0; d4 < 32; ++d4) {
        f32x4 a[4], b[8];
#pragma unroll
        for (int i = 0; i < 4; ++i) a[i] = *(LAS const f32x4*)(As + (4 * tn + i) * 132 + 4 * d4);
#pragma unroll
        for (int j = 0; j < 8; ++j) b[j] = *(LAS const f32x4*)(Bs + (2 * tk + 32 * (j >> 1) + (j & 1)) * 132 + 4 * d4);
#pragma unroll
        for (int i = 0; i < 4; ++i)
#pragma unroll
            for (int j = 0; j < 8; ++j) acc[i][j] += a[i][0] * b[j][0] + a[i][1] * b[j][1] + a[i][2] * b[j][2] + a[i][3] * b[j][3];
    }
    bf16_t* dst = (bf16_t*)(C.ws + WS_WQ) + (size_t)(blk * 128 + 4 * tn) * 4096 + k0 + 2 * tk;
#pragma unroll
    for (int i = 0; i < 4; ++i)
#pragma unroll
        for (int j = 0; j < 4; ++j) *(unsigned*)(dst + (size_t)i * 4096 + 32 * j) = cvt_pk_bf16(acc[i][2 * j], acc[i][2 * j + 1]);
    __syncthreads();
}

__device__ __forceinline__ void peer_row_convert(const Ctx& C, int grow, int lane) {
            const bool second = grow >= 16384; const int row = grow & 16383;
            const float* src = C.in[second ? I_PV : I_PU] + (size_t)row * 4096;
            unsigned char* dst6 = C.ws + (second ? WS_PV : WS_PU) + (size_t)row * 3072;
            f32x16 v[4]; float am = 0.f;
#pragma unroll
            for (int i4 = 0; i4 < 4; ++i4)
#pragma unroll
                for (int q = 0; q < 4; ++q) { const f32x4 t4 = *(const f32x4*)(src + 16 * (lane + 64 * i4) + 4 * q);
                    v[i4][4 * q] = t4[0]; v[i4][4 * q + 1] = t4[1]; v[i4][4 * q + 2] = t4[2]; v[i4][4 * q + 3] = t4[3];
                    am = fmaxf(am, fmaxf(fmaxf(fabsf(t4[0]), fabsf(t4[1])), fmaxf(fabsf(t4[2]), fabsf(t4[3])))); }
            am = wave_max(am);
            const float sc = am > 0.f ? am * (1.f / 7.f) : 1.f, inv = 1.f / sc;
#pragma unroll
            for (int i4 = 0; i4 < 4; ++i4) v[i4] *= inv;
            const u32x6 pa = __builtin_amdgcn_cvt_scalef32_2xpk16_fp6_f32(v[0], v[1], 1.0f), pb = __builtin_amdgcn_cvt_scalef32_2xpk16_fp6_f32(v[2], v[3], 1.0f);
            *(u32x4*)(dst6 + 16 * lane) = (u32x4){pa[0], pa[1], pa[2], pa[3]};
            *(u32x4*)(dst6 + 1024 + 16 * lane) = (u32x4){pa[4], pa[5], pb[0], pb[1]};
            *(u32x4*)(dst6 + 2048 + 16 * lane) = (u32x4){pb[2], pb[3], pb[4], pb[5]};
            ((float*)(C.ws + (second ? WS_PV : WS_PU) + 96 * MB))[row] = sc;
            { float al = 0.f;
#pragma unroll
              for (int i4 = 0; i4 < 4; ++i4)
#pragma unroll
                  for (int j = 0; j < 16; ++j) al = fmaxf(al, fabsf(v[i4][j]));
              const float s4 = al > 0.f ? al * (1.f / 6.f) : 1.f, inv4 = 1.f / s4;
              unsigned wa[4] = {0u, 0u, 0u, 0u}, wb[4] = {0u, 0u, 0u, 0u};
#define PK4(d_) do { wa[d_] = __builtin_amdgcn_cvt_scalef32_pk_fp4_f32(wa[d_], v[0][4 * (d_)] * inv4, v[1][4 * (d_)] * inv4, 1.0f, 0); wa[d_] = __builtin_amdgcn_cvt_scalef32_pk_fp4_f32(wa[d_], v[0][4 * (d_) + 1] * inv4, v[1][4 * (d_) + 1] * inv4, 1.0f, 1); \
                     wa[d_] = __builtin_amdgcn_cvt_scalef32_pk_fp4_f32(wa[d_], v[0][4 * (d_) + 2] * inv4, v[1][4 * (d_) + 2] * inv4, 1.0f, 2); wa[d_] = __builtin_amdgcn_cvt_scalef32_pk_fp4_f32(wa[d_], v[0][4 * (d_) + 3] * inv4, v[1][4 * (d_) + 3] * inv4, 1.0f, 3); \
                     wb[d_] = __builtin_amdgcn_cvt_scalef32_pk_fp4_f32(wb[d_], v[2][4 * (d_)] * inv4, v[3][4 * (d_)] * inv4, 1.0f, 0); wb[d_] = __builtin_amdgcn_cvt_scalef32_pk_fp4_f32(wb[d_], v[2][4 * (d_) + 1] * inv4, v[3][4 * (d_) + 1] * inv4, 1.0f, 1); \
                     wb[d_] = __builtin_amdgcn_cvt_scalef32_pk_fp4_f32(wb[d_], v[2][4 * (d_) + 2] * inv4, v[3][4 * (d_) + 2] * inv4, 1.0f, 2); wb[d_] = __builtin_amdgcn_cvt_scalef32_pk_fp4_f32(wb[d_], v[2][4 * (d_) + 3] * inv4, v[3][4 * (d_) + 3] * inv4, 1.0f, 3); } while (0)
              PK4(0); PK4(1); PK4(2); PK4(3);
#undef PK4
              unsigned char* dst4 = C.ws + (second ? WS_PV4 : WS_PU4) + (size_t)row * 2176;
              *(u32x4*)(dst4 + 16 * lane) = (u32x4){wa[0], wa[1], wa[2], wa[3]};
              *(u32x4*)(dst4 + 1024 + 16 * lane) = (u32x4){wb[0], wb[1], wb[2], wb[3]};
              *(bf16_t*)(dst4 + 2048 + 2 * lane) = f2bf(sc * s4); }

}

__device__ __forceinline__ void p0_prologue(const Ctx& C) {
    constexpr int N_MOD = 256, N_WIN = (NP / 128) * (D / 128), N_W1 = 2 * 32, N_B1 = 64;
    constexpr int E0 = N_MOD, E1 = E0 + N_B1, E2 = E1 + N_WIN, E7 = E2 + N_W1, E8 = E7 + N_W1, E11 = E8;
    const int tid = C.tid;
    for (int it = blockIdx.x; it < E11; it += gridDim.x) {
        if (it < E0) {
            const int b = it; LAS float* red = (LAS float*)C.lds;
            const float* cvec = C.in[I_C]; const float* w = C.in[I_WADA];
            if (tid < 504) { const int cg = tid % 24, rs = tid / 24;
                f32x4 acc = {0.f, 0.f, 0.f, 0.f};
                const float* wp = w + 96 * b + 4 * cg;
#pragma unroll 4
                for (int k = rs; k < D; k += 21) { const float cv = cvec[k]; const f32x4 wv = *(const f32x4*)(wp + (size_t)k * 24576); acc += cv * wv; }
                *(LAS f32x4*)(red + (rs * 24 + cg) * 4) = acc; }
            __syncthreads();
            if (tid < 24) { f32x4 s = *(const f32x4*)(C.in[I_BADA] + 96 * b + 4 * tid);
                for (int rs = 0; rs < 21; ++rs) s += *(LAS f32x4*)(red + (rs * 24 + tid) * 4);
                *(f32x4*)((float*)(C.ws + WS_MOD) + 96 * b + 4 * tid) = s; }
            __syncthreads();
        } else if (it < E1) {
            const int s = (it - E0) >> 5, sl = (it - E0) & 31; const float* pe = C.in[s ? I_PEV : I_PEK]; const float* w1 = C.in[s ? I_W1V : I_W1K];
            const int e = tid & 255, half = tid >> 8; float a = 0.f;
            const int kb = sl * 128 + half * 64;
#pragma unroll 16
            for (int k = kb; k < kb + 64; ++k) a += pe[k] * w1[(size_t)k * 256 + e];
            LAS float* red = (LAS float*)C.lds; red[tid] = a; __syncthreads();
            if (tid < 256) ((float*)(C.ws + WS_B1P))[(s * 32 + sl) * 256 + tid] = red[tid] + red[tid + 256];
            __syncthreads();
        } else if (it < E2) { const int i = it - E1; const int n0 = (i / 32) * 128, k0 = (i % 32) * 128;
            if (n0 < NP_BF) tconv_tile<true>(C, C.in[I_WIN], 18576, (bf16_t*)(C.ws + WS_WIN), D, n0, k0);
            else tconv_tile_f8<true>(C, C.in[I_WIN], 18576, C.ws + WS_WIN8 - (size_t)NP_BF * D, D, n0, k0);
        } else if (it < E7) { const int i = it - E2; tconv_tile<false>(C, C.in[I_W1K], 256, (bf16_t*)(C.ws + WS_W1T), 4096, (i / 32) * 128, (i % 32) * 128);
        } else if (it < E8) { const int i = it - E7; tconv_tile<false>(C, C.in[I_W1V], 256, (bf16_t*)(C.ws + WS_W1T) + (size_t)256 * 4096, 4096, (i / 32) * 128, (i % 32) * 128);
        }
    }
}

__device__ __forceinline__ void norm_mod_phase(const Ctx& C, const float* xin, const float* gain, const float* sh, const float* sc, bf16_t* hout, unsigned char* h8out = nullptr) {
    LAS float* la = (LAS float*)C.lds; LAS float* lb = la + D;
    for (int i = C.tid; i < D / 4; i += NTHREADS) { const f32x4 g4 = *(const f32x4*)(gain + 4 * i), s4 = *(const f32x4*)(sc + 4 * i), h4 = *(const f32x4*)(sh + 4 * i);
        *(LAS f32x4*)(la + 4 * i) = g4 * (s4 + 1.f); *(LAS f32x4*)(lb + 4 * i) = h4; }
    __syncthreads();
    const int rstep = gridDim.x * 8;
    int row = blockIdx.x * 8 + C.wave;
    f32x4 v[16], vn[16];
    if (row < T) {
#pragma unroll
        for (int i = 0; i < 16; ++i) v[i] = ((const f32x4*)(xin + (size_t)row * D))[C.lane + 64 * i]; }
#pragma unroll 1
    for (; row < T; row += rstep) {
        const int nrow = row + rstep;
        if (nrow < T) {
#pragma unroll
            for (int i = 0; i < 16; ++i) vn[i] = ((const f32x4*)(xin + (size_t)nrow * D))[C.lane + 64 * i]; }
        float ss = 0.f;
#pragma unroll
        for (int i = 0; i < 16; ++i) ss += v[i][0] * v[i][0] + v[i][1] * v[i][1] + v[i][2] * v[i][2] + v[i][3] * v[i][3];
        ss = wave_sum(ss);
        const float rstd = rsqrtf(ss * (1.f / 4096.f) + EPS);
#pragma unroll
        for (int i = 0; i < 16; ++i) { const int col = 4 * (C.lane + 64 * i);
            const f32x4 a4 = *(LAS const f32x4*)(la + col), b4 = *(LAS const f32x4*)(lb + col);
            float y[4];
#pragma unroll
            for (int j = 0; j < 4; ++j) y[j] = v[i][j] * rstd * a4[j] + b4[j];
            u32x2 w; w.x = cvt_pk_bf16(y[0], y[1]); w.y = cvt_pk_bf16(y[2], y[3]);
            *(u32x2*)(hout + (size_t)row * D + col) = w;
            if (h8out) { int p = __builtin_amdgcn_cvt_pk_fp8_f32(y[0], y[1], 0, false); p = __builtin_amdgcn_cvt_pk_fp8_f32(y[2], y[3], p, true); *(unsigned*)(h8out + (size_t)row * D + col) = (unsigned)p; } }
#pragma unroll
        for (int i = 0; i < 16; ++i) v[i] = vn[i];
    }
    __syncthreads();
}

__device__ __forceinline__ void p3_post(const Ctx& C) {
    bf16_t* proj = (bf16_t*)(C.ws + WS_PROJ);
    const int tid = C.tid;
    const float qscale = 0.08838834764831845f;
    if (blockIdx.x == 0) { float a = 0.f; const float* part = (const float*)(C.ws + WS_B1P) + (size_t)(tid >> 8) * 32 * 256 + (tid & 255);
        for (int sl = 0; sl < 32; ++sl) a += part[sl * 256]; ((float*)(C.ws + WS_B1))[tid] = a; }
    for (int item = blockIdx.x; item < T / 64; item += gridDim.x) {
        const int t0 = item * 64;
#pragma unroll 1
        for (int hb = tid >> 4; hb < 64 * 44; hb += 128) {
            const int l16 = tid & 15;
            u32x4 raw[4]; bf16_t* dstp[4]; const float* gain[4]; float scl[4]; bool isk8[4];
#pragma unroll
            for (int u = 0; u < 4; ++u) { const int hr = hb + 32 * u; const int tok = hr / 44, hh = hr % 44; int col; isk8[u] = (hh >= 16 && hh < 20);
                if (hh < 16) { col = P_QA + 128 * hh; gain[u] = C.in[I_GQA]; scl[u] = qscale; dstp[u] = proj + (size_t)(t0 + tok) * NP + col; }
                else if (hh < 20) { col = P_KA + 128 * (hh - 16); gain[u] = C.in[I_GKA]; scl[u] = 1.f; dstp[u] = (bf16_t*)(C.ws + WS_KA + (size_t)(t0 + tok) * 512 + 128 * (hh - 16)); }
                else if (hh < 36) { col = P_QB + 128 * (hh - 20); gain[u] = C.in[I_GQB]; scl[u] = qscale * 1.4426950408889634f; dstp[u] = proj + (size_t)(t0 + tok) * NP + col; }
                else if (hh < 40) { col = P_KS + 128 * (hh - 36); gain[u] = C.in[I_GKSLC]; scl[u] = 1.f; dstp[u] = (bf16_t*)(C.ws + WS_KSC) + ((size_t)(hh - 36) * T + t0 + tok) * 128; }
                else { col = P_KW + 128 * (hh - 40); gain[u] = C.in[I_GKWIN]; scl[u] = 1.f; dstp[u] = (bf16_t*)(C.ws + WS_KWC) + ((size_t)(hh - 40) * T + t0 + tok) * 128; }
                raw[u] = *(const u32x4*)(proj + (size_t)(t0 + tok) * NP + col + 8 * l16); }
#pragma unroll
            for (int u = 0; u < 4; ++u) {
                float v[8] = {bflo(raw[u].x), bfhi(raw[u].x), bflo(raw[u].y), bfhi(raw[u].y), bflo(raw[u].z), bfhi(raw[u].z), bflo(raw[u].w), bfhi(raw[u].w)};
                float ss = 0.f;
#pragma unroll
                for (int j = 0; j < 8; ++j) ss += v[j] * v[j];
                ss += dppf<0xB1>(ss); ss += dppf<0x4E>(ss); ss += dppf<0x141>(ss); ss += dppf<0x140>(ss);
                const float rstd = rsqrtf(ss * (1.f / 128.f) + EPS) * scl[u];
                const f32x4 g0 = *(const f32x4*)(gain[u] + 8 * l16), g1 = *(const f32x4*)(gain[u] + 8 * l16 + 4);
                if (isk8[u]) {
                    const float r8 = rstd * 64.f;
                    int p0 = __builtin_amdgcn_cvt_pk_fp8_f32(v[0] * r8 * g0[0], v[1] * r8 * g0[1], 0, false); p0 = __builtin_amdgcn_cvt_pk_fp8_f32(v[2] * r8 * g0[2], v[3] * r8 * g0[3], p0, true);
                    int p1 = __builtin_amdgcn_cvt_pk_fp8_f32(v[4] * r8 * g1[0], v[5] * r8 * g1[1], 0, false); p1 = __builtin_amdgcn_cvt_pk_fp8_f32(v[6] * r8 * g1[2], v[7] * r8 * g1[3], p1, true);
                    *(u32x2*)((unsigned char*)dstp[u] + 8 * l16) = (u32x2){(unsigned)p0, (unsigned)p1};
                } else {
                u32x4 w; w.x = cvt_pk_bf16(v[0] * rstd * g0[0], v[1] * rstd * g0[1]); w.y = cvt_pk_bf16(v[2] * rstd * g0[2], v[3] * rstd * g0[3]);
                w.z = cvt_pk_bf16(v[4] * rstd * g1[0], v[5] * rstd * g1[1]); w.w = cvt_pk_bf16(v[6] * rstd * g1[2], v[7] * rstd * g1[3]);
                *(u32x4*)(dstp[u] + 8 * l16) = w; } }
        }
        bf16_t* Kc = (bf16_t*)(C.ws + WS_KC); bf16_t* Vc = Kc + (size_t)4 * T * 128;
#pragma unroll
        for (int i = 0; i < 8; ++i) { const int idx = tid + 512 * i, tok = idx >> 6, c16 = idx & 63, g = c16 >> 4, d8 = c16 & 15;
            const bf16_t* src = proj + (size_t)(t0 + tok) * NP + 8 * c16;
            const size_t dof = ((size_t)g * T + t0 + tok) * 128 + 8 * d8;
            *(u32x4*)(Kc + dof) = *(const u32x4*)(src + P_KC);
            *(u32x4*)(Vc + dof) = *(const u32x4*)(src + P_VC);
            { const u32x4 rv = *(const u32x4*)(src + P_VA);
              float v[8] = {bflo(rv.x), bfhi(rv.x), bflo(rv.y), bfhi(rv.y), bflo(rv.z), bfhi(rv.z), bflo(rv.w), bfhi(rv.w)};
              float am = 0.f;
#pragma unroll
              for (int j = 0; j < 8; ++j) am = fmaxf(am, fabsf(v[j]));
              am = fmax_fast(am, dppf<0xB1>(am)); am = fmax_fast(am, dppf<0x4E>(am)); am = fmax_fast(am, dppf<0x141>(am)); am = fmax_fast(am, dppf<0x140>(am));
              const float sc = am > 0.f ? am * (1.f / 448.f) : 1.f, inv = 1.f / sc;
              int p0 = __builtin_amdgcn_cvt_pk_fp8_f32(v[0] * inv, v[1] * inv, 0, false); p0 = __builtin_amdgcn_cvt_pk_fp8_f32(v[2] * inv, v[3] * inv, p0, true);
              int p1 = __builtin_amdgcn_cvt_pk_fp8_f32(v[4] * inv, v[5] * inv, 0, false); p1 = __builtin_amdgcn_cvt_pk_fp8_f32(v[6] * inv, v[7] * inv, p1, true);
              *(u32x2*)(C.ws + WS_VA + (size_t)(t0 + tok) * 512 + 8 * c16) = (u32x2){(unsigned)p0, (unsigned)p1};
              if (d8 == 0) ((float*)(C.ws + WS_VA + 8 * MB))[(size_t)(t0 + tok) * 4 + g] = sc; } }
        { const int tok = tid >> 3, c8 = tid & 7;
          *(u32x4*)((bf16_t*)(C.ws + WS_KIC) + (size_t)(t0 + tok) * 64 + 8 * c8) = *(const u32x4*)(proj + (size_t)(t0 + tok) * NP + P_KI + 8 * c8); }
#pragma unroll 1
        for (int which = 0; which < 2; ++which) {
            const int pcol = which ? P_VW : P_VS; bf16_t* dstT = (bf16_t*)(C.ws + (which ? WS_VWT : WS_VST));
            LAS unsigned* tl = (LAS unsigned*)C.lds;
#pragma unroll
            for (int i = 0; i < 8; ++i) { const int idx = tid + 512 * i, tok = idx >> 6, c16 = idx & 63;
                const u32x4 v = *(const u32x4*)(proj + (size_t)(t0 + tok) * NP + pcol + 8 * c16);
                LAS unsigned* q = tl + tok * 257 + 4 * c16; q[0] = v.x; q[1] = v.y; q[2] = v.z; q[3] = v.w; }
            __syncthreads();
#pragma unroll
            for (int i = 0; i < 8; ++i) { const int task = tid + 512 * i, col = task >> 3, tc = task & 7;
                unsigned short e[8];
#pragma unroll
                for (int j = 0; j < 8; ++j) { const unsigned dw = tl[(8 * tc + j) * 257 + (col >> 1)]; e[j] = (col & 1) ? (unsigned short)(dw >> 16) : (unsigned short)(dw & 0xFFFFu); }
                u32x4 w; w.x = e[0] | ((unsigned)e[1] << 16); w.y = e[2] | ((unsigned)e[3] << 16); w.z = e[4] | ((unsigned)e[5] << 16); w.w = e[6] | ((unsigned)e[7] << 16);
                *(u32x4*)(dstT + (size_t)col * T + t0 + 8 * tc) = w; }
            __syncthreads();
        }
    }
}

__device__ __forceinline__ void p5_cmp_out(const Ctx& C) {
    const float* part = (const float*)(C.ws + WS_HIDP); const float* b1 = (const float*)(C.ws + WS_B1);
    bf16_t* kcmp = (bf16_t*)(C.ws + WS_KCMP); bf16_t* vcT = (bf16_t*)(C.ws + WS_VCMPT);
    LAS float* hl = (LAS float*)(C.lds) + C.wave * 1024;
    const int lane = C.lane;
    for (int grp = blockIdx.x * 8 + C.wave; grp < 2048; grp += gridDim.x * 8) {
        const int R0 = grp * 4; const bool isv = R0 >= 4096;
        lds_sync();
        const f32x4 bb = *(const f32x4*)(b1 + (isv ? 256 : 0) + 4 * lane);
#pragma unroll
        for (int r = 0; r < 4; ++r) { f32x4 a = bb;
#pragma unroll
            for (int ks = 0; ks < 8; ++ks) a += *(const f32x4*)(part + ((size_t)ks * 8192 + R0 + r) * 256 + 4 * lane);
            f32x4 hg; hg[0] = gelu_tanh(a[0]); hg[1] = gelu_tanh(a[1]); hg[2] = gelu_tanh(a[2]); hg[3] = gelu_tanh(a[3]);
            *(LAS f32x4*)(hl + r * 256 + 4 * lane) = hg; }
        lds_sync();
        const float* w2 = C.in[isv ? I_W2V : I_W2K];
        float acc[4][2];
#pragma unroll
        for (int r = 0; r < 4; ++r) { acc[r][0] = 0.f; acc[r][1] = 0.f; }
#pragma unroll 8
        for (int e = 0; e < 256; ++e) { const float2 wv = *(const float2*)(w2 + e * 128 + 2 * lane);
#pragma unroll
            for (int r = 0; r < 4; ++r) { const float hv = hl[r * 256 + e]; acc[r][0] += hv * wv.x; acc[r][1] += hv * wv.y; } }
#pragma unroll
        for (int r = 0; r < 4; ++r) { const int R = R0 + r, Rl = R & 4095, g = Rl >> 10, n = Rl & 1023;
            const float a0 = (n < NCMP) ? acc[r][0] : 0.f, a1 = (n < NCMP) ? acc[r][1] : 0.f;
            if (!isv) { const float ss = wave_sum(a0 * a0 + a1 * a1); const float rstd = rsqrtf(ss * (1.f / 128.f) + EPS);
                const float2 gg = *(const float2*)(C.in[I_GKCMP] + 2 * lane);
                *(unsigned*)(kcmp + (size_t)Rl * 128 + 2 * lane) = (n < NCMP) ? cvt_pk_bf16(a0 * rstd * gg.x, a1 * rstd * gg.y) : 0u; }
            else { vcT[((size_t)g * 128 + 2 * lane) * 1024 + n] = f2bf(a0); vcT[((size_t)g * 128 + 2 * lane + 1) * 1024 + n] = f2bf(a1); } }
    }
}

constexpr int P6_WAVE_LDS = 18432, P6_SHARED = 8192;
__device__ __forceinline__ f32x16 mfma32(bf16x8 a, bf16x8 b, f32x16 c) { return __builtin_amdgcn_mfma_f32_32x32x16_bf16(a, b, c, 0, 0, 0); }
__device__ __forceinline__ int swap23(int r) { return (r & 0x13) | ((r & 4) << 1) | ((r & 8) >> 1); }

__device__ __forceinline__ void topk_prune(LAS u64* buf, int& cnt, u64& tau, LAS unsigned* hist, int lane) {
    u64 e[8];
#pragma unroll
    for (int i = 0; i < 8; ++i) { const int idx = lane + 64 * i; e[i] = idx < cnt ? buf[idx] : 0ull; }
    u64 prefix = 0ull; unsigned need = 256u;
    const u64 lt = (1ull << lane) - 1ull;
#pragma unroll 1
    for (int p = 0; p < 6; ++p) {
        const int shift = 40 - 8 * p;
        *(LAS u32x4*)(hist + 4 * lane) = (u32x4){0u, 0u, 0u, 0u};
        lds_sync();
#pragma unroll
        for (int i = 0; i < 8; ++i) { const bool m = (e[i] != 0ull) && ((e[i] >> (shift + 8)) == (prefix >> (shift + 8)));
            if (m) __hip_atomic_fetch_add(hist + (unsigned)((e[i] >> shift) & 255ull), 1u, __ATOMIC_RELAXED, __HIP_MEMORY_SCOPE_WORKGROUP); }
        lds_sync();
        const u32x4 c = *(LAS u32x4*)(hist + 4 * lane);
        const unsigned tot = c.x + c.y + c.z + c.w;
        unsigned pre = tot;
        pre += (unsigned)__builtin_amdgcn_update_dpp(0, (int)pre, 0x111, 0xF, 0xF, true); pre += (unsigned)__builtin_amdgcn_update_dpp(0, (int)pre, 0x112, 0xF, 0xF, true);
        pre += (unsigned)__builtin_amdgcn_update_dpp(0, (int)pre, 0x114, 0xF, 0xF, true); pre += (unsigned)__builtin_amdgcn_update_dpp(0, (int)pre, 0x118, 0xF, 0xF, true);
        const unsigned r0 = (unsigned)__builtin_amdgcn_readlane((int)pre, 15), r1 = (unsigned)__builtin_amdgcn_readlane((int)pre, 31), r2 = (unsigned)__builtin_amdgcn_readlane((int)pre, 47), r3 = (unsigned)__builtin_amdgcn_readlane((int)pre, 63);
        const int row = lane >> 4;
        pre += (row == 1) ? r0 : (row == 2) ? (r0 + r1) : (row == 3) ? (r0 + r1 + r2) : 0u;
        const unsigned a3 = (r0 + r1 + r2 + r3) - pre, a2 = a3 + c.w, a1 = a2 + c.z, a0 = a1 + c.y;
        int found = -1; unsigned above = 0u;
        if (a3 < need && need <= a3 + c.w) { found = 3; above = a3; }
        else if (a2 < need && need <= a2 + c.z) { found = 2; above = a2; }
        else if (a1 < need && need <= a1 + c.y) { found = 1; above = a1; }
        else if (a0 < need && need <= a0 + c.x) { found = 0; above = a0; }
        const u64 bm = __ballot(found >= 0);
        const int src = bm ? (__ffsll((long long)bm) - 1) : 0;
        const int bin = __builtin_amdgcn_readlane(4 * lane + found, src); const unsigned ab = (unsigned)__builtin_amdgcn_readlane((int)above, src);
        prefix |= ((u64)(unsigned)bin) << shift; need -= ab;
        lds_sync();
    }
    tau = prefix;
    int base = 0;
#pragma unroll
    for (int i = 0; i < 8; ++i) { const bool keep = (e[i] >= tau) && (e[i] != 0ull); const u64 m = __ballot(keep);
        if (keep) buf[base + __popcll(m & lt)] = e[i]; base += __popcll(m); }
    cnt = base;
    lds_sync();
}

#ifndef DSA_PROBE_MODE
#define DSA_PROBE_MODE 0
#endif
__device__ __forceinline__ void dsa_item(const Ctx& C, int qp, LAS unsigned char* wl, LAS const unsigned char* bkt, LAS const float* tbl, int pmode = 0) {
    const int lane = C.lane, r = lane & 31, h = lane >> 5;
    const bf16_t* proj = (const bf16_t*)(C.ws + WS_PROJ); const bf16_t* kic = (const bf16_t*)(C.ws + WS_KIC);
    unsigned char* ya = C.ws + WS_YA;
    const int t0 = 2 * qp;
    LAS u64* buf0 = (LAS u64*)wl; LAS u64* buf1 = (LAS u64*)(wl + 4096);
    LAS unsigned* hist = (LAS unsigned*)(wl + 8192);
    LAS unsigned char* qst = wl + 9216;
    LAS float* pl = (LAS float*)(wl + 10240);
    LAS unsigned* idxs = (LAS unsigned*)(wl + 14336);
    const u64 lt = (1ull << lane) - 1ull;
    {
    bf16x8 A[2][4]; unsigned wp[2][8];
#pragma unroll
    for (int q = 0; q < 2; ++q) {
        const bf16_t* pr = proj + (size_t)(t0 + q) * NP;
#pragma unroll
        for (int kk = 0; kk < 4; ++kk) A[q][kk] = *(const bf16x8*)(pr + P_QI + 64 * r + 32 * h + 8 * kk);
#pragma unroll
        for (int k2 = 0; k2 < 8; ++k2) { const int reg = 2 * k2; wp[q][k2] = *(const unsigned*)(pr + P_WI + (reg & 3) + 8 * (reg >> 2) + 4 * h); }
    }
    int cnt0 = 0, cnt1 = 0; u64 tau0 = 0ull, tau1 = 0ull;
    const int nkeys = (pmode == 2) ? 0 : t0 + 2;
    LAS unsigned char* stg = wl + 9216;
    const unsigned ixo0 = (unsigned)(((lane >> 3) * 64 + 8 * ((lane & 7) ^ ((lane >> 4) & 7))) * 2), ixo1 = (unsigned)(((lane >> 3) * 64 + 8 * ((lane & 7) ^ ((4 + (lane >> 4)) & 7))) * 2);
#define IX_STAGE(j0_) do { const char* _tb = (const char*)kic + (size_t)(j0_) * 128; _Pragma("unroll") for (int _i = 0; _i < 8; ++_i) \
        __builtin_amdgcn_global_load_lds((const unsigned*)(_tb + _i * 1024 + ((_i & 1) ? ixo1 : ixo0)), (LAS unsigned*)(stg + _i * 1024), 16, 0, 0); } while (0)
    if (nkeys > 0) IX_STAGE(0);
#pragma unroll 1
    for (int j0 = 0; j0 < nkeys; j0 += 64) {
        bf16x8 BA[4], BB[4];
        asm volatile("s_waitcnt vmcnt(0)" ::: "memory");
#pragma unroll
        for (int kk = 0; kk < 4; ++kk) { const int sw = (r >> 1) & 7;
            BA[kk] = *(LAS const bf16x8*)(stg + r * 128 + 16 * ((4 * h + kk) ^ sw));
            BB[kk] = *(LAS const bf16x8*)(stg + (32 + r) * 128 + 16 * ((4 * h + kk) ^ sw)); }
        asm volatile("s_waitcnt lgkmcnt(0)" ::: "memory");
        if (j0 + 64 < nkeys) IX_STAGE(j0 + 64);
        const int kidx = j0 + lane;
        f32x16 accA0, accB0, accA1, accB1;
#pragma unroll
        for (int i = 0; i < 16; ++i) { accA0[i] = 0.f; accB0[i] = 0.f; accA1[i] = 0.f; accB1[i] = 0.f; }
#pragma unroll
        for (int kk = 0; kk < 4; ++kk) { accA0 = mfma32(A[0][kk], BA[kk], accA0); accB0 = mfma32(A[0][kk], BB[kk], accB0); }
#pragma unroll
        for (int kk = 0; kk < 4; ++kk) { accA1 = mfma32(A[1][kk], BA[kk], accA1); accB1 = mfma32(A[1][kk], BB[kk], accB1); }
        float sc[2];
        { float pA = 0.f, pB = 0.f;
#pragma unroll
          for (int i = 0; i < 16; ++i) { const float wv = (i & 1) ? bfhi(wp[0][i >> 1]) : bflo(wp[0][i >> 1]);
              const float ta = __int_as_float(max(__float_as_int(accA0[i]), 0)), tb = __int_as_float(max(__float_as_int(accB0[i]), 0));
              pA = __builtin_fmaf(ta, wv, pA); pB = __builtin_fmaf(tb, wv, pB); }
          swap32f(pA, pB); sc[0] = pA + pB; }
        __builtin_amdgcn_sched_group_barrier(0x008, 8, 0);
#pragma unroll
        for (int i = 0; i < 8; ++i) { __builtin_amdgcn_sched_group_barrier(0x008, 1, 0); __builtin_amdgcn_sched_group_barrier(0x002, 9, 0); }
        { float pA = 0.f, pB = 0.f;
#pragma unroll
          for (int i = 0; i < 16; ++i) { const float wv = (i & 1) ? bfhi(wp[1][i >> 1]) : bflo(wp[1][i >> 1]);
              const float ta = __int_as_float(max(__float_as_int(accA1[i]), 0)), tb = __int_as_float(max(__float_as_int(accB1[i]), 0));
              pA = __builtin_fmaf(ta, wv, pA); pB = __builtin_fmaf(tb, wv, pB); }
          swap32f(pA, pB); sc[1] = pA + pB; }
#pragma unroll
        for (int q = 0; q < 2; ++q) {
            const float s = sc[q];
            const bool valid = kidx <= t0 + q;
            const u64 key = ((u64)sortable(s) << 14) | (u64)(unsigned)(16383 - kidx);
            const u64 tau = q ? tau1 : tau0;
            const bool pass = valid && key > tau && (pmode != 3);
            const u64 mask = __ballot(pass);
            if (mask) {
                LAS u64* buf = q ? buf1 : buf0; int& cnt = q ? cnt1 : cnt0;
                if (pass) buf[cnt + __popcll(mask & lt)] = key;
                cnt += __popcll(mask);
                if (cnt > 512 - 64) { lds_sync(); topk_prune(buf, cnt, q ? tau1 : tau0, hist, lane); }
            }
        }
    }
#undef IX_STAGE
    lds_sync();
    if (cnt0 > 256) topk_prune(buf0, cnt0, tau0, hist, lane);
    if (cnt1 > 256) topk_prune(buf1, cnt1, tau1, hist, lane);
    if (pmode == 2) { cnt0 = min(t0 + 1, 256); cnt1 = min(t0 + 2, 256);
#pragma unroll
        for (int i = 0; i < 4; ++i) { const int j = lane + 64 * i; buf0[j] = (u64)(unsigned)(16383 - ((j * 61) % (t0 + 1))); buf1[j] = (u64)(unsigned)(16383 - ((j * 59) % (t0 + 2))); } }
    if (lane == 0) { hist[0] = (unsigned)cnt0; hist[1] = (unsigned)cnt1; }
    lds_sync();
    }
    __builtin_amdgcn_s_setprio(0);
    if (pmode == 1 || pmode == 3) return;
    const int kq = lane >> 4, l16 = lane & 15;
    LAS float* plq = (LAS float*)wl;
    LAS unsigned short* idx2 = (LAS unsigned short*)(wl + 16384);
    LAS float* invl = (LAS float*)(wl + 17408);
    const int nsel0 = (int)hist[0], nsel1 = (int)hist[1];
    { unsigned iv0[4], iv1[4];
#pragma unroll
      for (int i = 0; i < 4; ++i) { const int j = lane + 64 * i; iv0[i] = (j < nsel0) ? (16383u - (unsigned)(buf0[j] & 0x3FFFull)) : 0u; iv1[i] = (j < nsel1) ? (16383u - (unsigned)(buf1[j] & 0x3FFFull)) : 0u; }
      lds_sync();
#pragma unroll
      for (int i = 0; i < 4; ++i) { const int j = lane + 64 * i; idx2[j] = (unsigned short)iv0[i]; idx2[256 + j] = (unsigned short)iv1[i]; }
      lds_sync(); }
    const unsigned char* KAp = (const unsigned char*)(C.ws + WS_KA) + 32 * kq;
    const float lsc = 1.f / (64.f * 512.f);
#pragma unroll 1
    for (int q = 0; q < 2; ++q) {
        const int t = t0 + q; const int nsel = q ? nsel1 : nsel0; LAS const unsigned short* idxs = idx2 + 256 * q;
        const bf16_t* prq = proj + (size_t)t * NP;
        lds_sync();
        {
            long Bz[4][4];
#pragma unroll
            for (int g = 0; g < 4; ++g)
#pragma unroll
                for (int sI = 0; sI < 4; ++sI) { long z = 0;
                    if ((l16 >> 2) == g) { const u32x4 raw = *(const u32x4*)(prq + P_QA + l16 * 128 + 32 * kq + 8 * sI);
                        int p0 = __builtin_amdgcn_cvt_pk_fp8_f32(bflo(raw.x) * 512.f, bfhi(raw.x) * 512.f, 0, false); p0 = __builtin_amdgcn_cvt_pk_fp8_f32(bflo(raw.y) * 512.f, bfhi(raw.y) * 512.f, p0, true);
                        int p1 = __builtin_amdgcn_cvt_pk_fp8_f32(bflo(raw.z) * 512.f, bfhi(raw.z) * 512.f, 0, false); p1 = __builtin_amdgcn_cvt_pk_fp8_f32(bflo(raw.w) * 512.f, bfhi(raw.w) * 512.f, p1, true);
                        z = (long)(((unsigned long long)(unsigned)p1 << 32) | (unsigned long long)(unsigned)p0); }
                    Bz[g][sI] = z; }
            u32x4 A0[2][2], A1[2][2];
            { const unsigned char* kr = KAp + (size_t)idxs[l16] * 512;
#pragma unroll
              for (int g = 0; g < 2; ++g) { A0[g][0] = *(const u32x4*)(kr + g * 128); A0[g][1] = *(const u32x4*)(kr + g * 128 + 16); } }
#pragma unroll 1
            for (int tile = 0; tile < 16; ++tile) {
                { const unsigned char* kr = KAp + (size_t)idxs[16 * tile + l16] * 512 + 256;
#pragma unroll
                  for (int g = 0; g < 2; ++g) { A1[g][0] = *(const u32x4*)(kr + g * 128); A1[g][1] = *(const u32x4*)(kr + g * 128 + 16); } }
                f32x4 acc = {0.f, 0.f, 0.f, 0.f};
#pragma unroll
                for (int g = 0; g < 2; ++g)
#pragma unroll
                    for (int sI = 0; sI < 4; ++sI) { const u32x4 v = A0[g][sI >> 1]; const long a = (sI & 1) ? (long)(((unsigned long long)v.w << 32) | v.z) : (long)(((unsigned long long)v.y << 32) | v.x);
                        acc = __builtin_amdgcn_mfma_f32_16x16x32_fp8_fp8(a, Bz[g][sI], acc, 0, 0, 0); }
                asm volatile("" ::: "memory");
                if (tile < 15) { const unsigned char* kr = KAp + (size_t)idxs[16 * (tile + 1) + l16] * 512;
#pragma unroll
                    for (int g = 0; g < 2; ++g) { A0[g][0] = *(const u32x4*)(kr + g * 128); A0[g][1] = *(const u32x4*)(kr + g * 128 + 16); } }
#pragma unroll
                for (int g = 0; g < 2; ++g)
#pragma unroll
                    for (int sI = 0; sI < 4; ++sI) { const u32x4 v = A1[g][sI >> 1]; const long a = (sI & 1) ? (long)(((unsigned long long)v.w << 32) | v.z) : (long)(((unsigned long long)v.y << 32) | v.x);
                        acc = __builtin_amdgcn_mfma_f32_16x16x32_fp8_fp8(a, Bz[2 + g][sI], acc, 0, 0, 0); }
#pragma unroll
                for (int r = 0; r < 4; ++r) { const int j = 16 * tile + 4 * kq + r; const int idx = (int)idxs[j]; const bool valid = j < nsel;
                    const int b = bkt[min(max(t - idx, 0), 2048)];
                    plq[j * 16 + l16] = valid ? (acc[r] * lsc + tbl[b * 32 + l16]) : -1e30f; }
            }
        }
        lds_sync();
        {
            float mx[16];
#pragma unroll
            for (int hh = 0; hh < 16; ++hh) mx[hh] = -1e30f;
#pragma unroll 1
            for (int ps = 0; ps < 4; ++ps) { const int j = ps * 64 + lane;
#pragma unroll
                for (int c4 = 0; c4 < 4; ++c4) { const f32x4 lv = *(LAS f32x4*)(plq + 16 * j + 4 * c4);
#pragma unroll
                    for (int e = 0; e < 4; ++e) mx[4 * c4 + e] = fmaxf(mx[4 * c4 + e], lv[e]); } }
#pragma unroll
            for (int hh = 0; hh < 16; ++hh) mx[hh] = wave_max(mx[hh]);
            float zs[16];
#pragma unroll
            for (int hh = 0; hh < 16; ++hh) zs[hh] = 0.f;
#pragma unroll 1
            for (int ps = 0; ps < 4; ++ps) { const int j = ps * 64 + lane; const bool valid = j < nsel;
                const f32x4 vsc = *(const f32x4*)((const float*)(C.ws + WS_VA + 8 * MB) + (size_t)idxs[j] * 4);
#pragma unroll
                for (int c4 = 0; c4 < 4; ++c4) { f32x4 lv = *(LAS f32x4*)(plq + 16 * j + 4 * c4);
#pragma unroll
                    for (int e = 0; e < 4; ++e) { const float p = valid ? __expf(lv[e] - mx[4 * c4 + e]) : 0.f; lv[e] = p * vsc[c4]; zs[4 * c4 + e] += p; }
                    *(LAS f32x4*)(plq + 16 * j + 4 * c4) = lv; } }
#pragma unroll
            for (int hh = 0; hh < 16; ++hh) { const float z = wave_sum(zs[hh]); if (lane == 0) invl[hh] = 1.f / fmaxf(z, 1e-30f); }
        }
        lds_sync();
#pragma unroll 1
        for (int g = 0; g < 4; ++g) {
            const f32x4 inv4 = *(LAS f32x4*)(invl + 4 * g);
            f32x2 o2[4][4];
#pragma unroll
            for (int rr = 0; rr < 4; ++rr)
#pragma unroll
                for (int d = 0; d < 4; ++d) o2[rr][d] = (f32x2){0.f, 0.f};
            const unsigned char* vbase = C.ws + WS_VA + 128 * g + 8 * l16;
            const int nb = (nsel + 31) >> 5;
            u32x2 vc[8], vn[8];
#pragma unroll
            for (int u = 0; u < 8; ++u) { const int idx = (int)idxs[4 * u + kq]; vc[u] = *(const u32x2*)(vbase + (size_t)idx * 512); }
#pragma unroll 1
            for (int bb = 0; bb < nb; ++bb) {
                if (bb + 1 < nb) {
#pragma unroll
                    for (int u = 0; u < 8; ++u) { const int idx = (int)idxs[32 * (bb + 1) + 4 * u + kq]; vn[u] = *(const u32x2*)(vbase + (size_t)idx * 512); } }
#pragma unroll
                for (int u = 0; u < 8; ++u) { const f32x4 p4 = *(LAS f32x4*)(plq + 16 * (32 * bb + 4 * u + kq) + 4 * g);
                    const f32x2 va = __builtin_amdgcn_cvt_pk_f32_fp8((int)vc[u].x, false), vb = __builtin_amdgcn_cvt_pk_f32_fp8((int)vc[u].x, true),
                                vcc = __builtin_amdgcn_cvt_pk_f32_fp8((int)vc[u].y, false), vd = __builtin_amdgcn_cvt_pk_f32_fp8((int)vc[u].y, true);
#pragma unroll
                    for (int rr = 0; rr < 4; ++rr) { const f32x2 pp = {p4[rr], p4[rr]};
                        o2[rr][0] = pp * va + o2[rr][0]; o2[rr][1] = pp * vb + o2[rr][1]; o2[rr][2] = pp * vcc + o2[rr][2]; o2[rr][3] = pp * vd + o2[rr][3]; } }
#pragma unroll
                for (int u = 0; u < 8; ++u) vc[u] = vn[u];
            }
            float o[4][8];
#pragma unroll
            for (int rr = 0; rr < 4; ++rr)
#pragma unroll
                for (int d = 0; d < 4; ++d) { o[rr][2 * d] = xsum16(xsum32(o2[rr][d].x)) * inv4[rr]; o[rr][2 * d + 1] = xsum16(xsum32(o2[rr][d].y)) * inv4[rr]; }
            if (kq == 0) {
#pragma unroll
                for (int rr = 0; rr < 4; ++rr) { int p0 = __builtin_amdgcn_cvt_pk_fp8_f32(o[rr][0] * 16.f, o[rr][1] * 16.f, 0, false); p0 = __builtin_amdgcn_cvt_pk_fp8_f32(o[rr][2] * 16.f, o[rr][3] * 16.f, p0, true);
                    int p1 = __builtin_amdgcn_cvt_pk_fp8_f32(o[rr][4] * 16.f, o[rr][5] * 16.f, 0, false); p1 = __builtin_amdgcn_cvt_pk_fp8_f32(o[rr][6] * 16.f, o[rr][7] * 16.f, p1, true);
                    *(u32x2*)(ya + (size_t)t * 2048 + (4 * g + rr) * 128 + 8 * l16) = (u32x2){(unsigned)p0, (unsigned)p1}; } }
        }
    }
}

constexpr int N2_KS = 0, N2_VS = 32768, N2_LUT = 65536, N2_IMP = 81920, N2_SEL = N2_IMP + 64 * 260 * 4, N2_UNI = N2_SEL + 2048, N2_LIST = N2_UNI + 64, N2_BKT = N2_LIST + 3 * 512, N2_TBL = N2_BKT + 2304, N2_END = N2_TBL + 4096;
static_assert(N2_END <= LDS_BYTES - 16, "NSA LDS map");
struct N2Src { const bf16_t* kbase; size_t kld; int krmax; const bf16_t* vT; size_t vld; };
__device__ __forceinline__ void n2_stage(const N2Src& s, int m, bool withV, LAS unsigned char* kbuf, LAS unsigned char* vbuf, int wave, int lane) {
#pragma unroll
    for (int j = 0; j < 2; ++j) { const int slot = (wave * 2 + j) * 64 + lane; const int row = slot >> 4, ch = (slot & 15) ^ (row & 15);
        __builtin_amdgcn_global_load_lds((const unsigned*)(s.kbase + (size_t)min(64 * m + row, s.krmax) * s.kld + 8 * ch), (LAS unsigned*)(kbuf + (wave * 2 + j) * 1024), 16, 0, 0); }
    if (withV) {
#pragma unroll
        for (int j = 0; j < 2; ++j) { const int slot = (wave * 2 + j) * 64 + lane; const int row = slot >> 3, ch = (slot & 7) ^ ((row >> 1) & 7);
            __builtin_amdgcn_global_load_lds((const unsigned*)(s.vT + (size_t)row * s.vld + 64 * m + 8 * ch), (LAS unsigned*)(vbuf + (wave * 2 + j) * 1024), 16, 0, 0); } }
}
__device__ __forceinline__ f32x16 n2_qk(const bf16x8 (&Bq)[8], LAS const unsigned char* kbuf, int hf, int rho, int h) {
    const int kr = 32 * hf + rho;
    f32x16 S;
#pragma unroll
    for (int i = 0; i < 16; ++i) S[i] = 0.f;
#pragma unroll
    for (int kk = 0; kk < 8; ++kk) { const int ch = 8 * h + kk; const bf16x8 a = *(LAS const bf16x8*)(kbuf + kr * 256 + 16 * (ch ^ (rho & 15))); S = mfma32(a, Bq[kk], S); }
    return S;
}
__device__ __forceinline__ void n2_pv(f32x16 (&O)[4], const float (&p)[16], LAS const unsigned char* vbuf, int hf, int lane) {
    bf16x8 pk[2];
#pragma unroll
    for (int s = 0; s < 2; ++s) { u32x4 w; w.x = cvt_pk_bf16(p[8 * s + 0], p[8 * s + 1]); w.y = cvt_pk_bf16(p[8 * s + 2], p[8 * s + 3]); w.z = cvt_pk_bf16(p[8 * s + 4], p[8 * s + 5]); w.w = cvt_pk_bf16(p[8 * s + 6], p[8 * s + 7]);
        pk[s] = __builtin_bit_cast(bf16x8, w); }
    const int r = lane & 31, h = lane >> 5;
#pragma unroll
    for (int dt = 0; dt < 4; ++dt)
#pragma unroll
        for (int s = 0; s < 2; ++s) { const int row = dt * 32 + r, ch = 4 * hf + 2 * s + h;
            const bf16x8 a = *(LAS const bf16x8*)(vbuf + row * 128 + 16 * (ch ^ ((r >> 1) & 7))); O[dt] = mfma32(a, pk[s], O[dt]); }
}
constexpr float N2_MASKED = -3.0e38f, N2_MINIT = -1.0e30f, LOG2E = 1.4426950408889634f;
template <int MODE, bool DEFER = false>
__device__ __forceinline__ float n2_bias_mask(f32x16& S, int posbase, int t, int t0w, int h, int ncv, int ncv0, unsigned sb, bool before_cur, float b31, LAS const bf16_t* lutr, LAS const unsigned char* bkt, LAS const float* tblh) {
    bool farT, fullT;
    if (MODE == 0) { farT = (t0w - (16 * (posbase + 31) + 31)) >= 1513; fullT = (posbase + 31) < ncv0; }
    else if (MODE == 1) { farT = (t0w - (posbase + 31)) >= 1513; fullT = before_cur; }
    else { farT = false; fullT = (posbase + 31 <= t0w) && ((t0w + 7 - posbase) < 512); }
    float cbu = b31;
    if (MODE != 0 && fullT && !farT) { const int b0 = (int)bkt[min(t0w - (posbase + 31), 2048)], b1 = (int)bkt[min(t0w + 7 - posbase, 2048)];
        if (b0 == b1) { farT = true; cbu = tblh[b0 * 32] * LOG2E; } }
    if (farT && fullT) {
        if (MODE == 1 && sb == 0u) {
#pragma unroll
            for (int reg = 0; reg < 16; ++reg) S[reg] = N2_MASKED;
            return 0.f; }
        if (DEFER) return cbu;
#pragma unroll
        for (int reg = 0; reg < 16; ++reg) S[reg] = S[reg] + cbu;
    } else {
#pragma unroll
        for (int reg = 0; reg < 16; ++reg) { const int pos = posbase + (reg & 7) + 8 * h + 16 * (reg >> 3);
            const int dist = (MODE == 0) ? (t - (16 * pos + 31)) : (t - pos);
            bool v;
            if (MODE == 0) v = pos < ncv; else if (MODE == 1) v = (sb != 0u) && (pos <= t); else v = (pos <= t) && (dist < 512);
            const float bias = bf2f(lutr[min(max(dist, 0), 2047)]);
            S[reg] = v ? (S[reg] + bias) : N2_MASKED; }
    }
    return 0.f;
}
__device__ __forceinline__ float n2_tilemax(const f32x16& S) {
    float a = fmax_fast(S[0], S[1]), b = fmax_fast(S[2], S[3]), c = fmax_fast(S[4], S[5]), d = fmax_fast(S[6], S[7]);
    float e = fmax_fast(S[8], S[9]), f = fmax_fast(S[10], S[11]), g = fmax_fast(S[12], S[13]), hh = fmax_fast(S[14], S[15]);
    a = fmax_fast(a, b); c = fmax_fast(c, d); e = fmax_fast(e, f); g = fmax_fast(g, hh); a = fmax_fast(a, c); e = fmax_fast(e, g); return fmax_fast(a, e);
}
__device__ __forceinline__ void n2_stat(const f32x16& S, float& m, float& Z) {
    const float mn = fmax_fast(m, n2_tilemax(S));
    float z = 0.f;
#pragma unroll
    for (int i = 0; i < 16; ++i) z += __builtin_amdgcn_exp2f(S[i] - mn);
    Z = Z * __builtin_amdgcn_exp2f(m - mn) + z; m = mn;
}
__device__ __forceinline__ void n2_combine(float& m, float& Z) {
    float ma = m, mb = m; swap32f(ma, mb); const float M = fmax_fast(ma, mb);
    Z = xsum32(Z * __builtin_amdgcn_exp2f(m - M)); m = M;
}
enum { N2_STATS = 0, N2_IMPP = 1, N2_PV = 2, N2_ONLINE = 3, N2_IMPV = 4 };
struct N2Lane { int t, t0w, h, rho, qq, rr, lane, ncv, ncv0, ncv7, cur; float b31; LAS const bf16_t* lutr; LAS const unsigned char* bkt; LAS const float* tblh; };
template <int MODE, int PASS>
__device__ __forceinline__ void n2_branch(const Ctx& C, int g, LAS const unsigned short* list, int n, const N2Lane& L, const bf16x8 (&Bq)[8], f32x16 (&O)[4],
                                          float& m, float& Z, float scale, LAS const unsigned* selq, LAS float* impw, float scale2 = 1.f) {
    if (n <= 0) return;
    constexpr bool withV = (PASS == N2_PV || PASS == N2_ONLINE || PASS == N2_IMPV);
    constexpr int NSL = (PASS == N2_IMPV) ? 2 : 4, LA = NSL - 1;
    N2Src src;
    if (MODE == 0) { src.kbase = (const bf16_t*)(C.ws + WS_KCMP) + (size_t)g * 1024 * 128; src.kld = 128; src.krmax = 1023; src.vT = (const bf16_t*)(C.ws + WS_VCMPT) + (size_t)g * 128 * 1024; src.vld = 1024; }
    else if (MODE == 1) { src.kbase = (const bf16_t*)(C.ws + WS_KSC) + (size_t)g * T * 128; src.kld = 128; src.krmax = T - 1; src.vT = (const bf16_t*)(C.ws + WS_VST) + (size_t)g * 128 * T; src.vld = (size_t)T; }
    else { src.kbase = (const bf16_t*)(C.ws + WS_KWC) + (size_t)g * T * 128; src.kld = 128; src.krmax = T - 1; src.vT = (const bf16_t*)(C.ws + WS_VWT) + (size_t)g * 128 * T; src.vld = (size_t)T; }
    LAS unsigned char* lds = C.lds;
#define N2_KSLOT(s_) (withV ? (((s_) < 2) ? (N2_KS + (s_) * 16384) : (N2_IMP + ((s_) - 2) * 32768)) : (N2_KS + (s_) * 16384))
#define N2_VSLOT(s_) (((s_) < 2) ? (N2_VS + (s_) * 16384) : (N2_IMP + ((s_) - 2) * 32768 + 16384))
#define N2_RAW_BARRIER() do { asm volatile("s_waitcnt lgkmcnt(0)" ::: "memory"); __builtin_amdgcn_s_barrier(); asm volatile("" ::: "memory"); } while (0)
#define N2_WAIT_LANDED() do { if (LA == 1) asm volatile("s_waitcnt vmcnt(0)" ::: "memory"); else if (withV) asm volatile("s_waitcnt vmcnt(8)" ::: "memory"); else asm volatile("s_waitcnt vmcnt(4)" ::: "memory"); } while (0)
#pragma unroll
    for (int j = 0; j < LA; ++j) if (j < n) n2_stage(src, (int)list[j], withV, lds + N2_KSLOT(j), lds + N2_VSLOT(j), C.wave, C.lane);
    if (n >= LA) N2_WAIT_LANDED(); else asm volatile("s_waitcnt vmcnt(0)" ::: "memory");
    N2_RAW_BARRIER();
#pragma unroll 1
    for (int i = 0; i < n; ++i) {
        const int mb = (int)list[i];
        if (i + LA < n) { const int sl = (i + LA) & (NSL - 1); n2_stage(src, (int)list[i + LA], withV, lds + N2_KSLOT(sl), lds + N2_VSLOT(sl), C.wave, C.lane); }
        LAS const unsigned char* kbuf = lds + N2_KSLOT(i & (NSL - 1)); LAS const unsigned char* vbuf = lds + N2_VSLOT(i & (NSL - 1));
        bool need; unsigned sb = 1u;
        if (MODE == 0) need = (64 * mb) < L.ncv7;
        else if (MODE == 1) { const unsigned sw = selq[mb >> 5]; sb = (sw >> (mb & 31)) & 1u; need = __ballot(sb != 0u) != 0ull; }
        else need = (64 * mb + 63 >= L.t0w - 511) && (64 * mb <= L.t0w + 7);
        if (need) {
#pragma unroll 1
            for (int hf = 0; hf < 2; ++hf) {
                const int posbase = 64 * mb + 32 * hf;
                f32x16 S = n2_qk(Bq, kbuf, hf, L.rho, L.h);
                const float cbd = n2_bias_mask<MODE, PASS == N2_ONLINE>(S, posbase, L.t, L.t0w, L.h, L.ncv, L.ncv0, sb, mb < L.cur, L.b31, L.lutr, L.bkt, L.tblh);
                if (PASS == N2_STATS) { n2_stat(S, m, Z); }
                else if (PASS == N2_IMPP || PASS == N2_IMPV) {
                    float p[16];
#pragma unroll
                    for (int r = 0; r < 16; ++r) p[r] = __builtin_amdgcn_exp2f(S[r] - m) * scale;
#pragma unroll
                    for (int G = 0; G < 4; ++G) { float q4 = p[4 * G] + p[4 * G + 1] + p[4 * G + 2] + p[4 * G + 3], e = p[4 * G + 3];
                        q4 += dppf<0xB1>(q4); q4 += dppf<0x4E>(q4); e += dppf<0xB1>(e); e += dppf<0x4E>(e);
                        const int nb = posbase + ((4 * G) & 7) + 8 * L.h + 16 * ((4 * G) >> 3); const int mq = nb >> 2;
                        if (L.rr == 0) { __hip_atomic_fetch_add(impw + L.qq * 260 + mq, q4, __ATOMIC_RELAXED, __HIP_MEMORY_SCOPE_WORKGROUP);
                                         __hip_atomic_fetch_add(impw + L.qq * 260 + mq + 1, e, __ATOMIC_RELAXED, __HIP_MEMORY_SCOPE_WORKGROUP); } }
                    if (PASS == N2_IMPV) {
#pragma unroll
                        for (int r = 0; r < 16; ++r) p[r] *= scale2;
                        n2_pv(O, p, vbuf, hf, L.lane); }
                } else if (PASS == N2_PV) {
                    float p[16];
#pragma unroll
                    for (int r = 0; r < 16; ++r) p[r] = __builtin_amdgcn_exp2f(S[r] - m) * scale;
                    n2_pv(O, p, vbuf, hf, L.lane);
                } else {
                    const float tm = xmax32(n2_tilemax(S) + cbd);
                    const float mn = fmax_fast(m, tm);
                    if (__ballot(mn > m + 8.f)) { const float al = __builtin_amdgcn_exp2f(m - mn); Z *= al;
#pragma unroll
                        for (int dt = 0; dt < 4; ++dt)
#pragma unroll
                            for (int r = 0; r < 16; ++r) O[dt][r] *= al;
                        m = mn; }
                    float p[16]; float zs = 0.f;
                    const float c2 = cbd - m;
#pragma unroll
                    for (int r = 0; r < 16; ++r) { p[r] = __builtin_amdgcn_exp2f(S[r] + c2); zs += p[r]; }
                    Z += zs;
                    n2_pv(O, p, vbuf, hf, L.lane);
                }
            }
        }
        if (i + LA < n) N2_WAIT_LANDED(); else asm volatile("s_waitcnt vmcnt(0)" ::: "memory");
        N2_RAW_BARRIER();
    }
#undef N2_WAIT_LANDED
#undef N2_RAW_BARRIER
#undef N2_KSLOT
#undef N2_VSLOT
}

__device__ __forceinline__ void nsa2_item(const Ctx& C, int QB, int g) {
    LAS unsigned char* lds = C.lds;
    const int tid = C.tid, lane = C.lane, wave = C.wave;
    const int c = lane & 31, h = lane >> 5, qq = c >> 2, rr = c & 3;
    const int t0 = 64 * QB, t0w = t0 + 8 * wave, t = t0w + qq, head = 4 * g + rr;
    const bf16_t* proj = (const bf16_t*)(C.ws + WS_PROJ);
    LAS bf16_t* lut = (LAS bf16_t*)(lds + N2_LUT);
    LAS float* imp = (LAS float*)(lds + N2_IMP);
    LAS unsigned* selw = (LAS unsigned*)(lds + N2_SEL);
    LAS unsigned* uni = (LAS unsigned*)(lds + N2_UNI);
    LAS unsigned short* listC = (LAS unsigned short*)(lds + N2_LIST); LAS unsigned short* listS = listC + 256; LAS unsigned short* listW = listC + 512;
    LAS const unsigned char* bkt = lds + N2_BKT; LAS const float* tbl = (LAS const float*)(lds + N2_TBL);
    __syncthreads();
    for (int i = tid; i < 8192; i += NTHREADS) { const int r4 = i >> 11, d = i & 2047; lut[i] = f2bf(tbl[(int)bkt[d] * 32 + 16 + 4 * g + r4] * LOG2E); }
    for (int i = tid; i < 64 * 260; i += NTHREADS) imp[i] = 0.f;
    const int ncv_wg = (t0 + 63 >= 31) ? ((t0 + 63 - 31) >> 4) + 1 : 0; const int nC = (ncv_wg + 63) >> 6;
    const int wlo = max(t0 - 511, 0) >> 6; const int nW = QB - wlo + 1;
    if (tid < nC) listC[tid] = (unsigned short)tid;
    if (tid < nW) listW[tid] = (unsigned short)(wlo + tid);
    bf16x8 Bq[8];
#pragma unroll
    for (int kk = 0; kk < 8; ++kk) Bq[kk] = *(const bf16x8*)(proj + (size_t)t * NP + P_QB + 128 * head + 64 * h + 8 * kk);
    const float g0 = sigmoidf_(bf2f(proj[(size_t)t * NP + P_GB + 3 * head + 0]));
    const float g1 = sigmoidf_(bf2f(proj[(size_t)t * NP + P_GB + 3 * head + 1]));
    const float g2 = sigmoidf_(bf2f(proj[(size_t)t * NP + P_GB + 3 * head + 2]));
    f32x16 O[4];
#pragma unroll
    for (int dt = 0; dt < 4; ++dt)
#pragma unroll
        for (int i = 0; i < 16; ++i) O[dt][i] = 0.f;
    N2Lane L; L.t = t; L.t0w = t0w; L.h = h; L.rho = swap23(c); L.qq = qq; L.rr = rr; L.lane = lane;
    L.ncv = t >= 31 ? ((t - 31) >> 4) + 1 : 0; L.ncv0 = t0w >= 31 ? ((t0w - 31) >> 4) + 1 : 0; L.ncv7 = (t0w + 7 >= 31) ? ((t0w + 7 - 31) >> 4) + 1 : 0; L.cur = QB;
    L.b31 = tbl[31 * 32 + 16 + head] * LOG2E; L.lutr = lut + rr * 2048; L.bkt = bkt; L.tblh = tbl + 16 + head;
    LAS const unsigned* selq = selw + (wave * 8 + qq) * 8;
    LAS float* impw = imp + wave * 8 * 260;
    __syncthreads();
    float mC = N2_MINIT, ZC = 0.f;
    n2_branch<0, N2_STATS>(C, g, listC, nC, L, Bq, O, mC, ZC, 0.f, selq, impw);
    n2_combine(mC, ZC);
    const float invZC = 1.f / fmaxf(ZC, 1e-30f);
    n2_branch<0, N2_IMPV>(C, g, listC, nC, L, Bq, O, mC, ZC, invZC, selq, impw, g0);
#define N2_OACC() ({ unsigned to_ = (unsigned)tid; asm volatile("" : "+v"(to_)); (f32x4*)(C.ws + WS_OACC) + (size_t)blockIdx.x * 16 * 512 + to_; })
    f32x4* oacc = N2_OACC();
#pragma unroll
    for (int dt = 0; dt < 4; ++dt)
#pragma unroll
        for (int G = 0; G < 4; ++G) { oacc[(dt * 4 + G) * 512] = (f32x4){O[dt][4 * G], O[dt][4 * G + 1], O[dt][4 * G + 2], O[dt][4 * G + 3]}; O[dt][4 * G] = 0.f; O[dt][4 * G + 1] = 0.f; O[dt][4 * G + 2] = 0.f; O[dt][4 * G + 3] = 0.f; }
    lds_sync();
#pragma unroll 1
    for (int q8 = 0; q8 < 8; ++q8) {
        const int cur = QB;
        unsigned word = 0u;
        if (cur + 1 <= 16) { if (lane == 0) word = (1u << (cur + 1)) - 1u; }
        else {
            unsigned key[4];
#pragma unroll
            for (int i = 0; i < 4; ++i) { const int mblk = lane + 64 * i; const bool ok = mblk >= 1 && mblk <= cur - 2;
                key[i] = ok ? ((__float_as_uint(impw[q8 * 260 + mblk]) & 0xFFFFFF00u) | (unsigned)(255 - mblk)) : 0u; }
#pragma unroll 1
            for (int round = 0; round < 13; ++round) {
                unsigned lm = key[0] > key[1] ? key[0] : key[1]; const unsigned lm2 = key[2] > key[3] ? key[2] : key[3]; lm = lm > lm2 ? lm : lm2;
                const unsigned W = wave_maxu(lm);
#pragma unroll
                for (int i = 0; i < 4; ++i) if (key[i] == W) key[i] = 0u;
                const int mw = 255 - (int)(W & 0xFFu);
                if (W != 0u && lane == (mw >> 5)) word |= 1u << (mw & 31);
            }
            if (lane == 0) word |= 1u;
            if (lane == (cur >> 5)) word |= 1u << (cur & 31);
            if (lane == ((cur - 1) >> 5)) word |= 1u << ((cur - 1) & 31);
        }
        if (lane < 8) selw[(wave * 8 + q8) * 8 + lane] = word;
    }
    __syncthreads();
    if (tid < 8) { unsigned u = 0u; for (int q = 0; q < 64; ++q) u |= selw[q * 8 + tid]; uni[tid] = u; }
    __syncthreads();
    if (tid == 0) { int n = 0; for (int mblk = 0; mblk <= QB; ++mblk) if ((uni[mblk >> 5] >> (mblk & 31)) & 1u) listS[n++] = (unsigned short)mblk; uni[8] = (unsigned)n; }
    __syncthreads();
    const int nS = (int)uni[8];
    float mS = N2_MINIT, ZS = 0.f;
    n2_branch<1, N2_ONLINE>(C, g, listS, nS, L, Bq, O, mS, ZS, 0.f, selq, impw);
    { ZS = xsum32(ZS); const float sc = g1 / fmaxf(ZS, 1e-30f);
#pragma unroll
      for (int dt = 0; dt < 4; ++dt)
#pragma unroll
          for (int r = 0; r < 16; ++r) O[dt][r] *= sc; }
    oacc = N2_OACC();
#pragma unroll
    for (int dt = 0; dt < 4; ++dt)
#pragma unroll
        for (int G = 0; G < 4; ++G) { const f32x4 a = oacc[(dt * 4 + G) * 512];
            oacc[(dt * 4 + G) * 512] = (f32x4){O[dt][4 * G] + a[0], O[dt][4 * G + 1] + a[1], O[dt][4 * G + 2] + a[2], O[dt][4 * G + 3] + a[3]};
            O[dt][4 * G] = 0.f; O[dt][4 * G + 1] = 0.f; O[dt][4 * G + 2] = 0.f; O[dt][4 * G + 3] = 0.f; }
    float mW = N2_MINIT, ZW = 0.f;
    n2_branch<2, N2_ONLINE>(C, g, listW, nW, L, Bq, O, mW, ZW, 0.f, selq, impw);
    oacc = N2_OACC();
    { ZW = xsum32(ZW); const float sc = g2 / fmaxf(ZW, 1e-30f);
#pragma unroll
      for (int dt = 0; dt < 4; ++dt)
#pragma unroll
          for (int G = 0; G < 4; ++G) { const f32x4 a = oacc[(dt * 4 + G) * 512];
              O[dt][4 * G] = O[dt][4 * G] * sc + a[0]; O[dt][4 * G + 1] = O[dt][4 * G + 1] * sc + a[1]; O[dt][4 * G + 2] = O[dt][4 * G + 2] * sc + a[2]; O[dt][4 * G + 3] = O[dt][4 * G + 3] * sc + a[3]; } }
    unsigned char* yb = C.ws + WS_YB + (size_t)t * 2048 + head * 128;
#pragma unroll
    for (int dt = 0; dt < 4; ++dt)
#pragma unroll
        for (int G = 0; G < 4; ++G) { int p = __builtin_amdgcn_cvt_pk_fp8_f32(O[dt][4 * G] * 16.f, O[dt][4 * G + 1] * 16.f, 0, false); p = __builtin_amdgcn_cvt_pk_fp8_f32(O[dt][4 * G + 2] * 16.f, O[dt][4 * G + 3] * 16.f, p, true);
            *(unsigned*)(yb + dt * 32 + 8 * G + 4 * h) = (unsigned)p; }
}

#ifndef NREP_DSA
#define NREP_DSA 1
#endif
#ifndef NREP_NSA
#define NREP_NSA 1
#endif
__device__ __forceinline__ void p6_mixers(const Ctx& C, int which  , int crep = 0) {
    const Ctx& C0_ = C;
    unsigned* counter = (unsigned*)(C.ws + WS_CTL + CTL_CNT) + 128 * crep;
    static_assert(8 * P6_WAVE_LDS <= N2_BKT, "DSA per-wave LDS vs the shared bias tables");
    LAS unsigned char* bkt = C.lds + N2_BKT; LAS float* tbl = (LAS float*)(C.lds + N2_TBL);
    for (int d = C.tid; d <= 2048; d += NTHREADS) { int b;
        if (d < 16) b = d; else { b = 16 + (int)(logf((float)d / 16.f) / logf(128.f) * 16.f); b = b < 31 ? b : 31; }
        bkt[d] = (unsigned char)b; }
    for (int i = C.tid; i < 1024; i += NTHREADS) tbl[i] = C.in[I_RELB][i];
    __syncthreads();
    if (which != 1) {
        LAS int* slot = (LAS int*)(C.lds + N2_UNI + 48);
#pragma unroll 1
        for (int rep = 0; rep < NREP_NSA; ++rep)
        for (;;) {
            __syncthreads();
            if (C.tid == 0) *slot = (int)atomicAdd(counter + 64 + 128 * rep, 1u);
            __syncthreads();
            const int it = *slot;
            if (it >= 1024) break;
            nsa2_item(C, 255 - (it >> 2), it & 3);
#pragma unroll 1
            for (int c = 0; c < 3; ++c) { const int j = it + 1024 * c; if (j >= 2560) break;
                __syncthreads();
                Ctx C = C0_; { int t_ = threadIdx.x; asm volatile("" : "+v"(t_)); C.tid = t_; C.lane = t_ & 63; C.wave = __builtin_amdgcn_readfirstlane(t_ >> 6); }
                if (j < 512) tconv_tile_f8<false>(C, C.in[I_WBA], 4096, C.ws + WS_WBA, 2048, (j / 16) * 128, (j % 16) * 128);
                else if (j < 1024) { const int i = j - 512; tconv_tile_f8<false>(C, C.in[I_WBB], 4096, C.ws + WS_WBB, 2048, (i / 16) * 128, (i % 16) * 128); }
                else if (j < 2048) { const int i = j - 1024; tconv_tile_f8<false>(C, C.in[I_WOUT], 4096, C.ws + WS_WOUT, 4096, (i / 32) * 128, (i % 32) * 128); }
                else { const int i = j - 2048; wq_subkey_tile(C, i >> 5, (i & 31) * 128); } }
        }
        __syncthreads();
    }
    if (which != 2) {
        LAS unsigned char* wl = C.lds + C.wave * P6_WAVE_LDS;
#pragma unroll 1
        for (int rep = 0; rep < NREP_DSA; ++rep)
        for (;;) {
            int it = 0;
            if (C.lane == 0) it = (int)atomicAdd(counter + 128 * rep, 1u);
            it = __builtin_amdgcn_readfirstlane(it);
            if (it >= 8192) break;
            if (C.wave >= 4) __builtin_amdgcn_s_setprio(2);
            dsa_item(C, 8191 - it, wl, bkt, tbl, (rep < NREP_DSA - 1) ? DSA_PROBE_MODE : 0);
#pragma unroll 1
            for (int rr = 0; rr < 4; ++rr) peer_row_convert(C, 4 * it + rr, C.lane);
        }
        __builtin_amdgcn_s_setprio(0);
        __syncthreads();
    }
}

static __device__ const unsigned P12_IJ4[16] = {
    0xE0331000u, 0xF0401101u, 0xFF411202u, 0xFF421303u, 0xFF501404u, 0xFF511505u, 0xFF601606u, 0xFF611707u, 0xFF702008u, 0xFF712109u, 0xFF80220Au, 0xFF90230Bu, 0xFFA0240Cu, 0xFFB0300Du, 0xFFC0310Eu, 0xFFD0320Fu };
typedef __bf16 bf16x32_t __attribute__((ext_vector_type(32)));
typedef unsigned u32x16 __attribute__((ext_vector_type(16)));
typedef _Float16 h2_t __attribute__((ext_vector_type(2)));
typedef _Float16 h32_t __attribute__((ext_vector_type(32)));
__device__ __forceinline__ unsigned rowmax_u(unsigned v) { v = umaxu(v, dppu<0xB1>(v)); v = umaxu(v, dppu<0x4E>(v)); v = umaxu(v, dppu<0x141>(v)); v = umaxu(v, dppu<0x140>(v)); return v; }
__device__ __forceinline__ float rowmax_f(float v) { v = fmax_fast(v, dppf<0xB1>(v)); v = fmax_fast(v, dppf<0x4E>(v)); v = fmax_fast(v, dppf<0x141>(v)); v = fmax_fast(v, dppf<0x140>(v)); return v; }
__device__ __forceinline__ float rowsum_f(float v) { v += dppf<0xB1>(v); v += dppf<0x4E>(v); v += dppf<0x141>(v); v += dppf<0x140>(v); return v; }
#define P12_CE(a_, b_) do { const unsigned hi_ = umaxu(a_, b_), lo_ = (a_) < (b_) ? (a_) : (b_); a_ = hi_; b_ = lo_; } while (0)
__device__ __forceinline__ void p12_route(const bf16_t* srow, LAS float* tops, LAS int* topi, LAS unsigned short* exl, LAS float* gtl, int lane, unsigned ij4) {
    const int row = lane >> 4, l16 = lane & 15;
#pragma unroll 1
    for (int q = 0; q < 4; ++q) {
        const int p = 4 * q + row;
        const u32x4 raw = *(const u32x4*)(srow + p * 128 + 8 * l16);
        unsigned k[8];
#pragma unroll
        for (int e = 0; e < 8; ++e) { const unsigned bits = (e & 1) ? (raw[e >> 1] & 0xFFFF0000u) : (raw[e >> 1] << 16);
            k[e] = ((bits ^ ((bits >> 31) ? 0xFFFFFFFFu : 0x80000000u)) & 0xFFFFFF80u) | (unsigned)(127 - (8 * l16 + e)); }
        P12_CE(k[0], k[2]); P12_CE(k[1], k[3]); P12_CE(k[4], k[6]); P12_CE(k[5], k[7]);
        P12_CE(k[0], k[4]); P12_CE(k[1], k[5]); P12_CE(k[2], k[6]); P12_CE(k[3], k[7]);
        P12_CE(k[0], k[1]); P12_CE(k[2], k[3]); P12_CE(k[4], k[5]); P12_CE(k[6], k[7]);
        P12_CE(k[2], k[4]); P12_CE(k[3], k[5]);
        P12_CE(k[1], k[4]); P12_CE(k[3], k[6]);
        P12_CE(k[1], k[2]); P12_CE(k[3], k[4]); P12_CE(k[5], k[6]);
        unsigned myW = 0u;
#pragma unroll
        for (int r = 0; r < 16; ++r) {
            const unsigned W = rowmax_u(k[0]);
            const bool pop = k[0] == W;
#pragma unroll
            for (int e = 0; e < 7; ++e) k[e] = pop ? k[e + 1] : k[e];
            k[7] = pop ? 0u : k[7];
            myW = (l16 == r) ? W : myW;
        }
        const unsigned sb = myW & 0xFFFFFF80u;
        const unsigned bits = (sb & 0x80000000u) ? (sb ^ 0x80000000u) : ((~sb) & 0xFFFF0000u);
        tops[p * 16 + l16] = __uint_as_float(bits); topi[p * 16 + l16] = 127 - (int)(myW & 0x7Fu);
    }
    lds_sync();
#pragma unroll 1
    for (int q2 = 0; q2 < 2; ++q2) {
        const int hh = 4 * q2 + row;
        LAS const float* t1 = tops + (2 * hh) * 16; LAS const float* t2 = t1 + 16;
        unsigned k[4];
#pragma unroll
        for (int c = 0; c < 4; ++c) { const unsigned ij = (ij4 >> (8 * c)) & 0xFFu; const float cv = t1[ij >> 4] + t2[ij & 15u];
            k[c] = (ij != 0xFFu) ? ((sortable(cv) & 0xFFFFFF00u) | (255u - ij)) : 0u; }
        P12_CE(k[0], k[1]); P12_CE(k[2], k[3]); P12_CE(k[0], k[2]); P12_CE(k[1], k[3]); P12_CE(k[1], k[2]);
        unsigned myW = 0u;
#pragma unroll
        for (int r = 0; r < 16; ++r) {
            const unsigned W = rowmax_u(k[0]);
            const bool pop = k[0] == W;
            k[0] = pop ? k[1] : k[0]; k[1] = pop ? k[2] : k[1]; k[2] = pop ? k[3] : k[2]; k[3] = pop ? 0u : k[3];
            myW = (l16 == r) ? W : myW;
        }
        const unsigned flat = 255u - (myW & 0xFFu); const int ci = (int)(flat >> 4), cj = (int)(flat & 15u);
        const float cv = t1[ci] + t2[cj];
        const float ev = __expf(cv - rowmax_f(cv));
        const float es = rowsum_f(ev);
        exl[hh * 16 + l16] = (unsigned short)(topi[(2 * hh) * 16 + ci] * 128 + topi[(2 * hh + 1) * 16 + cj]);
        gtl[hh * 16 + l16] = ev * __builtin_amdgcn_rcpf(es);
    }
    lds_sync();
}
#undef P12_CE
__device__ __forceinline__ float gelu_fast(float x) { const float u = 0.7978845608028654f * (x + 0.044715f * x * x * x); const float e = __expf(2.f * u); return x - x * __builtin_amdgcn_rcpf(e + 1.f); }

#ifndef P12_HI
#define P12_HI 4
#endif
__device__ __forceinline__ void p12_peer(const Ctx& C, float* dst) {
    const bf16_t* pq = (const bf16_t*)(C.ws + WS_PQ);
    const bf16_t* h2 = (const bf16_t*)(C.ws + WS_H2);
    const float* gt2 = (const float*)(C.ws + WS_MOD) + 5 * D;
    const int lane = C.lane;
    LAS unsigned char* wl = C.lds + C.wave * 8192;
    LAS unsigned short* exl = (LAS unsigned short*)wl;
    LAS float* gtl = (LAS float*)(wl + 2048);
    LAS float* tops = (LAS float*)(wl + 6144);
    LAS int* topi = (LAS int*)(wl + 7168);
    const unsigned ij4 = P12_IJ4[lane & 15];
    const unsigned lo16 = 16u * (unsigned)lane; const unsigned char* pu6 = C.ws + WS_PU; const unsigned char* pv6 = C.ws + WS_PV;
    const float* su = (const float*)(C.ws + WS_PU + 96 * MB); const float* sv = (const float*)(C.ws + WS_PV + 96 * MB);
    const unsigned char* pu4 = C.ws + WS_PU4; const unsigned char* pv4 = C.ws + WS_PV4;
    const int tstride = gridDim.x * 8;
    for (int tb = blockIdx.x * 8 + C.wave; tb < T; tb += 8 * tstride) {
        int nb = 0;
#pragma unroll 1
        for (int s = 0; s < 8; ++s) { const int t = tb + s * tstride; if (t >= T) break;
            p12_route(pq + (size_t)t * 2048, tops, topi, exl + s * 128, gtl + s * 128, lane, ij4); ++nb; }
        const int nflat = nb * 128;
        u32x4 UA[3], VA[3], UB[3], VB[3], UC[3], VC[3], UD[3], VD[3]; float suA, svA, suB, svB, suC, svC, suD, svD;
#define P12_FMT(idx_) ((((idx_) & 15) < P12_HI) ? 6 : 4)
#define P12_LOAD(S, idx_, fmt_) do { const int e_ = __builtin_amdgcn_readfirstlane((int)exl[(idx_) < nflat ? (idx_) : nflat - 1]); \
        if ((fmt_) == 6) { const unsigned char* pu_ = pu6 + (size_t)e_ * 3072 + lo16; const unsigned char* pv_ = pv6 + (size_t)e_ * 3072 + lo16; \
            U##S[0] = *(const u32x4*)pu_; U##S[1] = *(const u32x4*)(pu_ + 1024); U##S[2] = *(const u32x4*)(pu_ + 2048); \
            V##S[0] = *(const u32x4*)pv_; V##S[1] = *(const u32x4*)(pv_ + 1024); V##S[2] = *(const u32x4*)(pv_ + 2048); su##S = su[e_]; sv##S = sv[e_]; } \
        else { const unsigned char* pu_ = pu4 + (size_t)e_ * 2176; const unsigned char* pv_ = pv4 + (size_t)e_ * 2176; \
            U##S[0] = *(const u32x4*)(pu_ + lo16); U##S[1] = *(const u32x4*)(pu_ + 1024 + lo16); su##S = bf2f(*(const bf16_t*)(pu_ + 2048 + 2 * lane)); \
            V##S[0] = *(const u32x4*)(pv_ + lo16); V##S[1] = *(const u32x4*)(pv_ + 1024 + lo16); sv##S = bf2f(*(const bf16_t*)(pv_ + 2048 + 2 * lane)); } } while (0)
#define P12_U4(w_, hh_, j_) do { \
        a0_ = dot2bf(__builtin_bit_cast(unsigned, __builtin_amdgcn_cvt_scalef32_pk_bf16_fp4((w_), 1.0f, 0)), hh_[(j_)], a0_); a1_ = dot2bf(__builtin_bit_cast(unsigned, __builtin_amdgcn_cvt_scalef32_pk_bf16_fp4((w_), 1.0f, 1)), hh_[(j_) + 1], a1_); \
        a2_ = dot2bf(__builtin_bit_cast(unsigned, __builtin_amdgcn_cvt_scalef32_pk_bf16_fp4((w_), 1.0f, 2)), hh_[(j_) + 2], a2_); a3_ = dot2bf(__builtin_bit_cast(unsigned, __builtin_amdgcn_cvt_scalef32_pk_bf16_fp4((w_), 1.0f, 3)), hh_[(j_) + 3], a3_); } while (0)
#define P12_V4(w_, oo_, j_) do { \
        oo_[(j_)] = act2_ * __builtin_amdgcn_cvt_scalef32_pk_f16_fp4((w_), 1.0f, 0) + oo_[(j_)]; oo_[(j_) + 1] = act2_ * __builtin_amdgcn_cvt_scalef32_pk_f16_fp4((w_), 1.0f, 1) + oo_[(j_) + 1]; \
        oo_[(j_) + 2] = act2_ * __builtin_amdgcn_cvt_scalef32_pk_f16_fp4((w_), 1.0f, 2) + oo_[(j_) + 2]; oo_[(j_) + 3] = act2_ * __builtin_amdgcn_cvt_scalef32_pk_f16_fp4((w_), 1.0f, 3) + oo_[(j_) + 3]; } while (0)
#define P12_COMPUTE(S, idx_, fmt_) do { float a0_ = 0.f, a1_ = 0.f, a2_ = 0.f, a3_ = 0.f; \
        if ((fmt_) == 6) { \
            const u32x16 ua_ = __builtin_bit_cast(u32x16, __builtin_amdgcn_cvt_scalef32_pk32_bf16_fp6((u32x6){U##S[0].x, U##S[0].y, U##S[0].z, U##S[0].w, U##S[1].x, U##S[1].y}, 1.0f)); \
            const u32x16 ub_ = __builtin_bit_cast(u32x16, __builtin_amdgcn_cvt_scalef32_pk32_bf16_fp6((u32x6){U##S[1].z, U##S[1].w, U##S[2].x, U##S[2].y, U##S[2].z, U##S[2].w}, 1.0f)); \
            _Pragma("unroll") for (int j = 0; j < 16; j += 4) { a0_ = dot2bf(ua_[j], hA[j], a0_); a1_ = dot2bf(ua_[j + 1], hA[j + 1], a1_); a2_ = dot2bf(ua_[j + 2], hA[j + 2], a2_); a3_ = dot2bf(ua_[j + 3], hA[j + 3], a3_); } \
            _Pragma("unroll") for (int j = 0; j < 16; j += 4) { a0_ = dot2bf(ub_[j], hB[j], a0_); a1_ = dot2bf(ub_[j + 1], hB[j + 1], a1_); a2_ = dot2bf(ub_[j + 2], hB[j + 2], a2_); a3_ = dot2bf(ub_[j + 3], hB[j + 3], a3_); } \
            const float a_ = wave_sum((a0_ + a1_) + (a2_ + a3_)) * su##S; \
            const float act_ = gelu_fast(a_) * gtl[idx_] * sv##S; const h2_t act2_ = {(_Float16)act_, (_Float16)act_}; \
            const h32_t va_ = __builtin_amdgcn_cvt_scalef32_pk32_f16_fp6((u32x6){V##S[0].x, V##S[0].y, V##S[0].z, V##S[0].w, V##S[1].x, V##S[1].y}, 1.0f); \
            _Pragma("unroll") for (int j = 0; j < 16; ++j) oA[j] = act2_ * (h2_t){va_[2 * j], va_[2 * j + 1]} + oA[j]; \
            const h32_t vb_ = __builtin_amdgcn_cvt_scalef32_pk32_f16_fp6((u32x6){V##S[1].z, V##S[1].w, V##S[2].x, V##S[2].y, V##S[2].z, V##S[2].w}, 1.0f); \
            _Pragma("unroll") for (int j = 0; j < 16; ++j) oB[j] = act2_ * (h2_t){vb_[2 * j], vb_[2 * j + 1]} + oB[j]; \
        } else { \
            P12_U4(U##S[0].x, hA, 0); P12_U4(U##S[0].y, hA, 4); P12_U4(U##S[0].z, hA, 8); P12_U4(U##S[0].w, hA, 12); \
            P12_U4(U##S[1].x, hB, 0); P12_U4(U##S[1].y, hB, 4); P12_U4(U##S[1].z, hB, 8); P12_U4(U##S[1].w, hB, 12); \
            const float a_ = wave_sum(((a0_ + a1_) + (a2_ + a3_)) * su##S); \
            const float act_ = gelu_fast(a_) * gtl[idx_] * sv##S; const h2_t act2_ = {(_Float16)act_, (_Float16)act_}; \
            P12_V4(V##S[0].x, oA, 0); P12_V4(V##S[0].y, oA, 4); P12_V4(V##S[0].z, oA, 8); P12_V4(V##S[0].w, oA, 12); \
            P12_V4(V##S[1].x, oB, 0); P12_V4(V##S[1].y, oB, 4); P12_V4(V##S[1].z, oB, 8); P12_V4(V##S[1].w, oB, 12); } } while (0)
        P12_LOAD(A, 0, P12_FMT(0)); P12_LOAD(B, 1, P12_FMT(1)); P12_LOAD(C, 2, P12_FMT(2)); P12_LOAD(D, 3, P12_FMT(3));
#pragma unroll 1
        for (int s = 0; s < nb; ++s) {
            const int t = tb + s * tstride;
            unsigned hA[16], hB[16];
            { u32x4 ra[4], rb[4];
#pragma unroll
              for (int i = 0; i < 4; ++i) { ra[i] = *(const u32x4*)(h2 + (size_t)t * D + 16 * lane + 1024 * i); rb[i] = *(const u32x4*)(h2 + (size_t)t * D + 16 * lane + 1024 * i + 8); }
#pragma unroll
              for (int q = 0; q < 4; ++q) {
                  hA[2 * q] = __builtin_amdgcn_perm(ra[1][q], ra[0][q], 0x05040100u); hA[2 * q + 1] = __builtin_amdgcn_perm(ra[1][q], ra[0][q], 0x07060302u);
                  hA[8 + 2 * q] = __builtin_amdgcn_perm(rb[1][q], rb[0][q], 0x05040100u); hA[8 + 2 * q + 1] = __builtin_amdgcn_perm(rb[1][q], rb[0][q], 0x07060302u);
                  hB[2 * q] = __builtin_amdgcn_perm(ra[3][q], ra[2][q], 0x05040100u); hB[2 * q + 1] = __builtin_amdgcn_perm(ra[3][q], ra[2][q], 0x07060302u);
                  hB[8 + 2 * q] = __builtin_amdgcn_perm(rb[3][q], rb[2][q], 0x05040100u); hB[8 + 2 * q + 1] = __builtin_amdgcn_perm(rb[3][q], rb[2][q], 0x07060302u); } }
            h2_t oA[16], oB[16];
#pragma unroll
            for (int j = 0; j < 16; ++j) { oA[j] = (h2_t){(_Float16)0.f, (_Float16)0.f}; oB[j] = (h2_t){(_Float16)0.f, (_Float16)0.f}; }
#pragma unroll 1
            for (int hh = 0; hh < 8; ++hh) {
                const int f0 = s * 128 + hh * 16;
#pragma unroll
                for (int k = 0; k < 16; k += 4) {
                    P12_COMPUTE(A, f0 + k, P12_FMT(k)); P12_LOAD(A, f0 + k + 4, P12_FMT(k + 4));
                    P12_COMPUTE(B, f0 + k + 1, P12_FMT(k + 1)); P12_LOAD(B, f0 + k + 5, P12_FMT(k + 5));
                    P12_COMPUTE(C, f0 + k + 2, P12_FMT(k + 2)); P12_LOAD(C, f0 + k + 6, P12_FMT(k + 6));
                    P12_COMPUTE(D, f0 + k + 3, P12_FMT(k + 3)); P12_LOAD(D, f0 + k + 7, P12_FMT(k + 7));
                }
            }
#pragma unroll
            for (int i = 0; i < 4; ++i) { const int d0 = 16 * lane + 1024 * i; const float* op = C.out + (size_t)t * D + d0; float* dp = dst + (size_t)t * D + d0;
#pragma unroll
                for (int q = 0; q < 4; ++q) { const f32x4 xv = *(const f32x4*)(op + 4 * q); const f32x4 gv = *(const f32x4*)(gt2 + d0 + 4 * q); f32x4 r;
#pragma unroll
                    for (int j = 0; j < 4; ++j) { const h2_t ov = (i < 2) ? oA[4 * q + j] : oB[4 * q + j]; r[j] = xv[j] + gv[j] * ((i & 1) ? (float)ov.y : (float)ov.x); }
                    __builtin_nontemporal_store(r, (f32x4*)(dp + 4 * q)); } }
        }
#undef P12_U4
#undef P12_V4
#undef P12_FMT
#undef P12_LOAD
#undef P12_COMPUTE
        lds_sync();
    }
}

constexpr int N_PHASES = 13;
#ifndef DBG_MIX
#define DBG_MIX 0
#endif
__global__ void __launch_bounds__(NTHREADS, 2) fwd(Args args) {
    extern __shared__ __attribute__((aligned(16))) unsigned char lds_raw[];
    Ctx C0; C0.in = args.in; C0.out = args.out; C0.ws = args.ws; C0.lds = (LAS unsigned char*)lds_raw;
    C0.tid = threadIdx.x; C0.lane = C0.tid & 63; C0.wave = __builtin_amdgcn_readfirstlane(C0.tid >> 6);
#define PHASE_CTX() Ctx C = C0; { int t_ = threadIdx.x; asm volatile("" : "+v"(t_)); C.tid = t_; C.lane = t_ & 63; C.wave = __builtin_amdgcn_readfirstlane(t_ >> 6); }
    const Ctx& C = C0;
    const int lo = args.ph_lo, hi = args.ph_hi;
    const bool fused = (hi - lo) > 1;
    volatile LAS unsigned* bst = (volatile LAS unsigned*)(C.lds + LDS_BYTES - 16);
    XcdBarrier bar; bar.bar = (unsigned*)(C.ws + WS_CTL + CTL_BAR); bar.x = 0; bar.st = bst;
    if (fused) { if (C.tid == 0) { bst[0] = 0u; bst[1] = 0u; bst[2] = 0u; bst[3] = 0u; } __syncthreads(); bar = xcd_barrier_post((unsigned*)(C.ws + WS_CTL + CTL_BAR), bst); }
#ifndef ONLY_PHASE
#define ONLY_PHASE -1
#endif
#define IN(k) (lo <= (k) && (k) < hi && (ONLY_PHASE < 0 || ONLY_PHASE == (k)))
#ifndef REP_PHASE
#define REP_PHASE -1
#endif
#define REP(k, ...) if (REP_PHASE == (k)) { __VA_ARGS__ }
#define SEAM(k) do { if (IN(k) && IN((k) + 1)) xcd_barrier(bar); } while (0)
    const float* mod = (const float*)(C.ws + WS_MOD);
    bf16_t* proj = (bf16_t*)(C.ws + WS_PROJ);
    if (IN(0)) { PHASE_CTX(); REP(0, p0_prologue(C); __syncthreads();) p0_prologue(C); } SEAM(0);
    if (IN(1)) { PHASE_CTX(); norm_mod_phase(C, C.in[I_X], C.in[I_GMIX], mod + 0 * D, mod + 1 * D, (bf16_t*)(C.ws + WS_H), C.ws + WS_H8); } SEAM(1);
    if (IN(2)) { PHASE_CTX(); pg8::Gemm g{(const bf16_t*)(C.ws + WS_H), (const bf16_t*)(C.ws + WS_WIN), T, NP_BF, D, D, D}; pg8::StaticOrder S; S.init(T, NP_BF, gridDim.x, blockIdx.x);
                 pg8::EpiPlain E{proj, NP, 1.f}; pg8::gemm_phase(C.lds, g, S, E);
                 pg8::Gemm g8{(const bf16_t*)(C.ws + WS_H8), (const bf16_t*)(C.ws + WS_WIN8), T, NP_F8, D / 2, D / 2, D / 2}; pg8::Fp8Order S8{(int)blockIdx.x};
                 pg8::EpiSigU8 E8{(unsigned char*)(proj + P_GM), NP * 2, 1.f / 64.f}; pg8::gemm_phase<pg8::EpiSigU8, pg8::Fp8Order, true>(C.lds, g8, S8, E8); } SEAM(2);
    if (IN(3)) { PHASE_CTX(); p3_post(C); } SEAM(3);
    if (IN(4)) { PHASE_CTX(); pg8::Gemm g{(const bf16_t*)(C.ws + WS_KC), (const bf16_t*)(C.ws + WS_W1T), 8192, 512, 512, 2048, D}; pg8::CmpOrder S{(int)gridDim.x, (int)blockIdx.x};
                 pg8::EpiSlab E{(float*)(C.ws + WS_HIDP)}; pg8::gemm_phase(C.lds, g, S, E); } SEAM(4);
    if (IN(5)) { PHASE_CTX(); p5_cmp_out(C); } SEAM(5);
    if (IN(6)) { PHASE_CTX(); p6_mixers(C, DBG_MIX); } SEAM(6);
    if (IN(7)) { PHASE_CTX(); pg8::Gemm g{(const bf16_t*)(C.ws + WS_YA), (const bf16_t*)(C.ws + WS_WBA), T, D, 1024, 1024, 1024};   pg8::StaticOrder S; S.init(T, D, gridDim.x, blockIdx.x);
                 pg8::EpiGate<0> E{(bf16_t*)(C.ws + WS_MERGED), D, (const unsigned char*)(proj + P_GM), NP * 2, 1.f / (16.f * 64.f * 255.f), nullptr}; pg8::gemm_phase<pg8::EpiGate<0>, pg8::StaticOrder, true>(C.lds, g, S, E); } if (IN(7) && IN(8)) __syncthreads();
    if (IN(8)) { PHASE_CTX(); pg8::Gemm g{(const bf16_t*)(C.ws + WS_YB), (const bf16_t*)(C.ws + WS_WBB), T, D, 1024, 1024, 1024}; pg8::StaticOrder S; S.init(T, D, gridDim.x, blockIdx.x);
                 pg8::EpiGate<1> E{(bf16_t*)(C.ws + WS_MERGED), D, (const unsigned char*)(proj + P_GM) + 4096, NP * 2, 1.f / (16.f * 64.f * 255.f), C.ws + WS_H8}; pg8::gemm_phase<pg8::EpiGate<1>, pg8::StaticOrder, true>(C.lds, g, S, E); } SEAM(8);
    if (IN(9)) { PHASE_CTX(); pg8::Gemm g{(const bf16_t*)(C.ws + WS_H8), (const bf16_t*)(C.ws + WS_WOUT), T, D, D / 2, D / 2, D / 2};   pg8::StaticOrder S; S.init(T, D, gridDim.x, blockIdx.x);
                 pg8::EpiResid E{C.out, C.in[I_X], mod + 2 * D, D, 1.f / (32.f * 64.f)}; pg8::gemm_phase<pg8::EpiResid, pg8::StaticOrder, true>(C.lds, g, S, E); } SEAM(9);
    if (IN(10)) { PHASE_CTX(); norm_mod_phase(C, C.out, C.in[I_GFFN], mod + 3 * D, mod + 4 * D, (bf16_t*)(C.ws + WS_H2)); } SEAM(10);
    if (IN(11)) { PHASE_CTX(); pg8::Gemm g{(const bf16_t*)(C.ws + WS_H2), (const bf16_t*)(C.ws + WS_WQ), T, 2048, D, D, D}; pg8::StaticOrder S; S.init(T, 2048, gridDim.x, blockIdx.x);
                  pg8::EpiPlain E{(bf16_t*)(C.ws + WS_PQ), 2048, 1.f}; pg8::gemm_phase(C.lds, g, S, E); } SEAM(11);
    if (IN(12)) { PHASE_CTX(); REP(12, p12_peer(C, (float*)(C.ws + WS_PROJ)); __syncthreads();) p12_peer(C, C.out); }
#undef IN
#undef SEAM
}

#ifndef N_LAUNCH_MODE
#define N_LAUNCH_MODE 1
#endif
extern "C" void kernel_launch(void* const* d_in, const int* in_sizes, int n_in, void* d_out, int out_size, void* d_ws, size_t ws_size, hipStream_t stream) {
    static int grid = 0;
    if (grid == 0) {
        if (n_in != 27 || out_size != T * D || ws_size < WS_END) { fprintf(stderr, "kernel_launch: unexpected shapes (n_in %d out %d ws %zu need %zu)\n", n_in, out_size, ws_size, (size_t)WS_END); grid = -1; return; }
        int dev = 0, cus = 0;
        if (hipGetDevice(&dev) != hipSuccess || hipDeviceGetAttribute(&cus, hipDeviceAttributeMultiprocessorCount, dev) != hipSuccess) { grid = -1; return; }
        if (hipFuncSetAttribute((const void*)fwd, hipFuncAttributeMaxDynamicSharedMemorySize, LDS_BYTES) != hipSuccess) { fprintf(stderr, "kernel_launch: hipFuncSetAttribute failed\n"); grid = -1; return; }
        int per_cu = 0;
        if (hipOccupancyMaxActiveBlocksPerMultiprocessor(&per_cu, (const void*)fwd, NTHREADS, LDS_BYTES) != hipSuccess || per_cu < 1) { fprintf(stderr, "kernel_launch: occupancy query says %d\n", per_cu); }
        (void)hipGetLastError();
        grid = cus;
    }
    if (grid < 0) return;
    (void)hipMemsetAsync((char*)d_ws + WS_CTL, 0, 64 * 1024, stream);
    Args a{};
    for (int i = 0; i < 27; ++i) a.in[i] = (const float*)d_in[i];
    a.out = (float*)d_out; a.ws = (unsigned char*)d_ws;
#if N_LAUNCH_MODE == 1
    a.ph_lo = 0; a.ph_hi = N_PHASES;
    hipLaunchKernelGGL(fwd, dim3(grid), dim3(NTHREADS), LDS_BYTES, stream, a);
#else
    for (int p = 0; p < N_PHASES; ++p) { a.ph_lo = p; a.ph_hi = p + 1; hipLaunchKernelGGL(fwd, dim3(grid), dim3(NTHREADS), LDS_BYTES, stream, a); }
#endif
}
```

```cpp
#include <hip/hip_runtime.h>
#include <cstdio>
#include <cstdint>

#define LAS __attribute__((address_space(3)))
typedef unsigned short bf16_t;
typedef unsigned long long u64;
typedef short bf16x8 __attribute__((ext_vector_type(8)));
typedef float f32x4 __attribute__((ext_vector_type(4)));
typedef float f32x16 __attribute__((ext_vector_type(16)));
typedef unsigned u32x4 __attribute__((ext_vector_type(4)));
typedef unsigned u32x2 __attribute__((ext_vector_type(2)));
typedef __bf16 bf2_t __attribute__((ext_vector_type(2)));
typedef float f32x2 __attribute__((ext_vector_type(2)));
typedef float f32x32 __attribute__((ext_vector_type(32)));
typedef unsigned u32x6 __attribute__((ext_vector_type(6)));

constexpr int T = 16384, D = 4096, NP = 18688;
constexpr int P_QA = 0, P_KA = 2048, P_VA = 2560, P_QI = 3072, P_QB = 5120, P_KC = 7168, P_VC = 7680, P_KS = 8192, P_VS = 8704,
              P_KW = 9216, P_VW = 9728, P_KI = 10240, P_WI = 10304, P_GB = 10336, P_GM = 10496;
constexpr int NP_BF = 10496, NP_F8 = 8192;
constexpr int NCMP = 1023;
constexpr float EPS = 1e-6f;
constexpr int NTHREADS = 512;
constexpr int LDS_BYTES = 160 * 1024;

constexpr size_t MB = 1024ull * 1024ull;
constexpr size_t WS_CTL = 0;
constexpr size_t WS_MOD = 64 * 1024;
constexpr size_t WS_B1 = 192 * 1024;
constexpr size_t WS_B1P = 196 * 1024;
constexpr size_t WS_W1T = 512 * 1024;
constexpr size_t WS_SUBK = WS_W1T + 4 * MB;
constexpr size_t WS_HID = WS_SUBK + 512 * 1024;
constexpr size_t WS_KCMP = WS_HID + 8 * MB;
constexpr size_t WS_VCMPT = WS_KCMP + 1 * MB;
constexpr size_t WS_KIC = WS_VCMPT + 1 * MB;
constexpr size_t WS_KC = WS_KIC + 2 * MB;
constexpr size_t WS_VST = WS_KC + 32 * MB + 64 * 1024;
constexpr size_t WS_VWT = WS_VST + 16 * MB;
constexpr size_t WS_WBA = WS_VWT + 16 * MB;
constexpr size_t WS_WBB = WS_WBA + 16 * MB;
constexpr size_t WS_WOUT = WS_WBB + 16 * MB;
constexpr size_t WS_WQ = WS_WOUT + 32 * MB;
constexpr size_t WS_PU = WS_WQ + 16 * MB;
constexpr size_t WS_PV = WS_PU + 128 * MB;
constexpr size_t WS_PU4 = WS_PU + 56 * MB, WS_PV4 = WS_PV + 56 * MB;
constexpr size_t WS_PROJ = WS_PV + 128 * MB;
constexpr size_t WS_WIN = WS_PROJ + (size_t)T * NP * 2;
constexpr size_t WS_H = WS_WIN + (size_t)NP * D * 2;
constexpr size_t WS_KA = WS_H + 128 * MB;
constexpr size_t WS_VA = WS_KA + 16 * MB;
constexpr size_t WS_KSC = WS_VA + 16 * MB;
constexpr size_t WS_KWC = WS_KSC + 16 * MB;
constexpr size_t WS_HIDP = WS_KWC + 16 * MB;
constexpr size_t WS_OACC = WS_HIDP + 64 * MB;
constexpr size_t WS_H8 = WS_OACC + 32 * MB;
constexpr size_t WS_END = WS_H8 + 64 * MB;
constexpr size_t WS_WIN8 = WS_WIN + (size_t)NP_BF * D * 2;
constexpr size_t WS_YA = WS_WIN, WS_YB = WS_WIN + 64 * MB, WS_H2 = WS_WIN;
constexpr size_t WS_MERGED = WS_H, WS_PQ = WS_H;
constexpr size_t CTL_BAR = 0, CTL_CNT = 16384;

__device__ __forceinline__ float bf2f(bf16_t b) { return __uint_as_float(((unsigned)b) << 16); }
__device__ __forceinline__ float bflo(unsigned u) { return __uint_as_float(u << 16); }
__device__ __forceinline__ float bfhi(unsigned u) { return __uint_as_float(u & 0xFFFF0000u); }
__device__ __forceinline__ unsigned cvt_pk_bf16(float lo, float hi) { unsigned r; asm volatile("v_cvt_pk_bf16_f32 %0, %1, %2" : "=v"(r) : "v"(lo), "v"(hi)); return r; }
__device__ __forceinline__ bf16_t f2bf(float f) { return (bf16_t)(cvt_pk_bf16(f, 0.f) & 0xFFFFu); }
__device__ __forceinline__ float dot2bf(unsigned a, unsigned b, float c) { return __builtin_amdgcn_fdot2_f32_bf16(__builtin_bit_cast(bf2_t, a), __builtin_bit_cast(bf2_t, b), c, false); }
template <int CTRL> __device__ __forceinline__ float dppf(float v) { return __builtin_bit_cast(float, __builtin_amdgcn_update_dpp(0, __builtin_bit_cast(int, v), CTRL, 0xF, 0xF, true)); }
template <int CTRL> __device__ __forceinline__ unsigned dppu(unsigned v) { return (unsigned)__builtin_amdgcn_update_dpp(0, (int)v, CTRL, 0xF, 0xF, true); }
__device__ __forceinline__ void swap32f(float& a, float& b) { asm volatile("s_nop 1\n\tv_permlane32_swap_b32 %0, %1" : "+v"(a), "+v"(b)); }
__device__ __forceinline__ void swap16f(float& a, float& b) { asm volatile("s_nop 1\n\tv_permlane16_swap_b32 %0, %1" : "+v"(a), "+v"(b)); }
__device__ __forceinline__ void swap32u(unsigned& a, unsigned& b) { asm volatile("s_nop 1\n\tv_permlane32_swap_b32 %0, %1" : "+v"(a), "+v"(b)); }
__device__ __forceinline__ void swap16u(unsigned& a, unsigned& b) { asm volatile("s_nop 1\n\tv_permlane16_swap_b32 %0, %1" : "+v"(a), "+v"(b)); }
__device__ __forceinline__ float fmax_fast(float a, float b) { float r; asm("v_max_f32 %0, %1, %2" : "=v"(r) : "v"(a), "v"(b)); return r; }
__device__ __forceinline__ float xsum32(float v) { float a = v, b = v; swap32f(a, b); return a + b; }
__device__ __forceinline__ float xsum16(float v) { float a = v, b = v; swap16f(a, b); return a + b; }
__device__ __forceinline__ float xmax32(float v) { float a = v, b = v; swap32f(a, b); return fmax_fast(a, b); }
__device__ __forceinline__ float xmax16(float v) { float a = v, b = v; swap16f(a, b); return fmax_fast(a, b); }
__device__ __forceinline__ float xor32f(float v, int h) { float a = v, b = v; swap32f(a, b); return h ? a : b; }
__device__ __forceinline__ float wave_sum(float v) { v += dppf<0xB1>(v); v += dppf<0x4E>(v); v += dppf<0x141>(v); v += dppf<0x140>(v); return xsum16(xsum32(v)); }
__device__ __forceinline__ float wave_max(float v) { v = fmax_fast(v, dppf<0xB1>(v)); v = fmax_fast(v, dppf<0x4E>(v)); v = fmax_fast(v, dppf<0x141>(v)); v = fmax_fast(v, dppf<0x140>(v)); return xmax16(xmax32(v)); }
__device__ __forceinline__ unsigned umaxu(unsigned a, unsigned b) { return a > b ? a : b; }
__device__ __forceinline__ unsigned wave_maxu(unsigned v) { v = umaxu(v, dppu<0xB1>(v)); v = umaxu(v, dppu<0x4E>(v)); v = umaxu(v, dppu<0x141>(v)); v = umaxu(v, dppu<0x140>(v));
    unsigned a = v, b = v; swap32u(a, b); v = umaxu(a, b); a = v; b = v; swap16u(a, b); return umaxu(a, b); }
__device__ __forceinline__ void lds_sync() { asm volatile("s_waitcnt lgkmcnt(0)" ::: "memory"); __builtin_amdgcn_wave_barrier(); }
__device__ __forceinline__ float gelu_tanh(float x) { const float u = 0.7978845608028654f * (x + 0.044715f * x * x * x); const float e = __expf(2.f * u); return 0.5f * x * (2.f - 2.f / (e + 1.f)); }
__device__ __forceinline__ float sigmoidf_(float x) { return __builtin_amdgcn_rcpf(1.f + __expf(-x)); }
__device__ __forceinline__ unsigned sortable(float s) { unsigned b = __float_as_uint(s); return b ^ ((b >> 31) ? 0xFFFFFFFFu : 0x80000000u); }

#define XB_TMO      128
#define XB_XCNT(j)  (256  + 64 * (j))
#define XB_XSUB(j)  (1280 + 64 * (j))
#define XB_XGEN(j)  (2304 + 64 * (j))
#define XB_TOP      3328
#define XB_TOPGEN   3392
#define XCD_BAR_WORDS 3456
#define XB_SPIN_CAP (1u << 24)
__device__ __forceinline__ unsigned xb_ld(unsigned* p)              { return __hip_atomic_load(p, __ATOMIC_RELAXED, __HIP_MEMORY_SCOPE_AGENT); }
__device__ __forceinline__ unsigned xb_add(unsigned* p, unsigned v) { return __hip_atomic_fetch_add(p, v, __ATOMIC_RELAXED, __HIP_MEMORY_SCOPE_AGENT); }
__device__ __forceinline__ unsigned xb_xcc_id() { return (unsigned)__builtin_amdgcn_s_getreg((3 << 11) | 20) & 0xFu; }
#define XB_SPIN(cond, bar) do { unsigned _sp = 0; while (cond) { __builtin_amdgcn_s_sleep(1); \
    if ((++_sp & 255u) == 0u) { if (xb_ld(&(bar)[XB_TMO])) break; if (_sp > XB_SPIN_CAP) { atomicAdd(&(bar)[XB_TMO], 1u); break; } } } } while (0)
struct XcdBarrier { unsigned* bar; unsigned x; volatile LAS unsigned* st; };
__device__ __forceinline__ XcdBarrier xcd_barrier_post(unsigned* bar, volatile LAS unsigned* st) {
    XcdBarrier b; b.bar = bar; b.x = xb_xcc_id(); b.st = st;
    if (threadIdx.x == 0) (void)xb_add(&bar[XB_XCNT(b.x)], 1u);
    return b;
}
__device__ __forceinline__ void xcd_barrier_complete(unsigned* bar, unsigned x, unsigned& nloc, unsigned& nx) {
    const unsigned G = gridDim.x * gridDim.y * gridDim.z;
    unsigned sum, cnt, mine, sp = 0u;
    for (;;) {
        sum = 0u; cnt = 0u; mine = 0u;
#pragma unroll
        for (unsigned j = 0; j < 16; ++j) { const unsigned c = xb_ld(&bar[XB_XCNT(j)]); sum += c; cnt += (c > 0u) ? 1u : 0u; mine = (j == x) ? c : mine; }
        if (sum == G) break;
        __builtin_amdgcn_s_sleep(1);
        if ((++sp & 255u) == 0u) { if (xb_ld(&bar[XB_TMO])) break; if (sp > XB_SPIN_CAP) { atomicAdd(&bar[XB_TMO], 1u); break; } }
    }
    nloc = mine > 0u ? mine : 1u; nx = cnt > 0u ? cnt : 1u;
}
__device__ __forceinline__ void xcd_barrier(const XcdBarrier& b) {
    asm volatile("s_waitcnt vmcnt(0)" ::: "memory");
    __syncthreads();
    if (threadIdx.x == 0) {
        unsigned* bar = b.bar;
        __builtin_amdgcn_s_waitcnt(0);
        unsigned nloc = b.st[0], nx = b.st[1];
        if (nloc == 0u) { xcd_barrier_complete(bar, b.x, nloc, nx); b.st[0] = nloc; b.st[1] = nx; }
        const unsigned old = xb_add(&bar[XB_XSUB(b.x)], 1u);
        const unsigned gen = old / nloc;
        if (old + 1u == (gen + 1u) * nloc) {
            __builtin_amdgcn_fence(__ATOMIC_RELEASE, "agent");
            asm volatile("s_waitcnt vmcnt(0)" ::: "memory");
            const unsigned og = xb_add(&bar[XB_TOP], 1u);
            const unsigned tg = og / nx;
            if (og + 1u == (tg + 1u) * nx) xb_add(&bar[XB_TOPGEN], 1u);
            else XB_SPIN(xb_ld(&bar[XB_TOPGEN]) == tg, bar);
            __builtin_amdgcn_fence(__ATOMIC_ACQUIRE, "agent");
            xb_add(&bar[XB_XGEN(b.x)], 1u);
            asm volatile("s_waitcnt vmcnt(0)" ::: "memory");
        } else {
            XB_SPIN(xb_ld(&bar[XB_XGEN(b.x)]) == gen, bar);
            __builtin_amdgcn_fence(__ATOMIC_ACQUIRE, "agent");
            asm volatile("s_waitcnt vmcnt(0)" ::: "memory");
        }
    }
    __syncthreads();
}

namespace pg8 {
constexpr int BM = 256, BK = 64, HALF = 128, HTB = HALF * BK * 2, STAGE_BYTES = 8 * HTB, NXCD = 8, WGM = 8;
__host__ __device__ __forceinline__ int lds_byte(int r, int c) { const int st = (r >> 4) * 2 + (c >> 5), rr = r & 15, cc = c & 31, ob = rr * 64 + cc * 2; return st * 1024 + (ob ^ (((ob >> 9) & 1) << 5)); }
__host__ __device__ __forceinline__ void stage_rc(int b, int& R, int& C) { const int st = b / 1024, sb = b % 1024, swz = sb ^ (((sb >> 9) & 1) << 5); R = (st >> 1) * 16 + swz / 64; C = (st & 1) * 32 + (swz % 64) / 2; }
__host__ __device__ __forceinline__ int perm32(int rho) { const int n = rho >> 4, i = rho & 15; return 8 * (i >> 2) + 4 * n + (i & 3); }
struct Unit { int pm, pn, kofs; };
struct Gemm { const bf16_t* A; const bf16_t* Bt; int M, N, K, lda, ldb; };
struct StaticOrder {
    int nM, nN, nwg, G, c;
    __host__ __device__ void init(int M, int N, int G_, int c_) { nM = M / BM; nN = N / BM; nwg = nM * nN; G = G_; c = c_; }
    __host__ __device__ bool next(int i, Unit& u) const {
        const long L = (long)i * G + c; if (L >= nwg) return false;
        int wgid = (int)L; { const int q = nwg / NXCD, r = nwg % NXCD, xcd = wgid % NXCD, off = wgid / NXCD; wgid = (xcd < r ? xcd * (q + 1) : r * (q + 1) + (xcd - r) * q) + off; }
        const int nig = WGM * nN, gid = wgid / nig, fm = gid * WGM, gsz = (nM - fm) < WGM ? (nM - fm) : WGM;
        u.pm = fm + ((wgid % nig) % gsz); u.pn = (wgid % nig) / gsz; u.kofs = 0; return true;
    }
};
struct Fp8Order {
    int c;
    __host__ __device__ bool next(int i, Unit& u) const {
        const int cnt = c < 64 ? 6 : (c < 192 ? 9 : 8); if (i >= cnt) return false;
        const int off = c < 64 ? 6 * c : (c < 192 ? 384 + 9 * (c - 64) : 1536 + 8 * (c - 192));
        const int L = off + i; u.pm = L & 63; u.pn = L >> 6; u.kofs = 0; return true; }
};
struct CmpOrder {
    int G, c;
    __host__ __device__ bool next(int i, Unit& u) const { const long L = (long)i * G + c; if (L >= 256) return false; u.pm = (int)(L & 31); u.pn = u.pm >> 4; u.kofs = (int)(L >> 5) * 512; return true; }
};

struct EpiPlain {
    static constexpr bool PERM = true;
    bf16_t* O; int ldc; float scale;
    __device__ __forceinline__ void operator()(const f32x4 (&acc)[2][2][4][2], const Unit& u, int wr, int wc, int fr, int fq) const {
        const int row0 = u.pm * BM + wr * 64 + fr, col0 = u.pn * BM + wc * 32 + 8 * fq;
#pragma unroll
        for (int ai = 0; ai < 2; ++ai)
#pragma unroll
            for (int m = 0; m < 4; ++m) { bf16_t* rowp = O + (size_t)(row0 + ai * HALF + m * 16) * ldc + col0;
#pragma unroll
                for (int bj = 0; bj < 2; ++bj) { const f32x4 v0 = acc[ai][bj][m][0] * scale, v1 = acc[ai][bj][m][1] * scale;
                    u32x4 w; w.x = cvt_pk_bf16(v0[0], v0[1]); w.y = cvt_pk_bf16(v0[2], v0[3]); w.z = cvt_pk_bf16(v1[0], v1[1]); w.w = cvt_pk_bf16(v1[2], v1[3]);
                    *(u32x4*)(rowp + bj * HALF) = w; } }
    }
};
struct EpiSigU8 {
    static constexpr bool PERM = true;
    unsigned char* O; int ldb; float scale;
    __device__ __forceinline__ void operator()(const f32x4 (&acc)[2][2][4][2], const Unit& u, int wr, int wc, int fr, int fq) const {
        const int row0 = u.pm * BM + wr * 64 + fr, col0 = u.pn * BM + wc * 32 + 8 * fq;
#pragma unroll
        for (int ai = 0; ai < 2; ++ai)
#pragma unroll
            for (int m = 0; m < 4; ++m) { unsigned char* rowp = O + (size_t)(row0 + ai * HALF + m * 16) * ldb + col0;
#pragma unroll
                for (int bj = 0; bj < 2; ++bj) { const f32x4 v0 = acc[ai][bj][m][0] * scale, v1 = acc[ai][bj][m][1] * scale;
                    unsigned w0 = 0u, w1 = 0u;
                    w0 = __builtin_amdgcn_cvt_pk_u8_f32(255.f * sigmoidf_(v0[0]), 0, w0); w0 = __builtin_amdgcn_cvt_pk_u8_f32(255.f * sigmoidf_(v0[1]), 1, w0);
                    w0 = __builtin_amdgcn_cvt_pk_u8_f32(255.f * sigmoidf_(v0[2]), 2, w0); w0 = __builtin_amdgcn_cvt_pk_u8_f32(255.f * sigmoidf_(v0[3]), 3, w0);
                    w1 = __builtin_amdgcn_cvt_pk_u8_f32(255.f * sigmoidf_(v1[0]), 0, w1); w1 = __builtin_amdgcn_cvt_pk_u8_f32(255.f * sigmoidf_(v1[1]), 1, w1);
                    w1 = __builtin_amdgcn_cvt_pk_u8_f32(255.f * sigmoidf_(v1[2]), 2, w1); w1 = __builtin_amdgcn_cvt_pk_u8_f32(255.f * sigmoidf_(v1[3]), 3, w1);
                    *(u32x2*)(rowp + bj * HALF) = (u32x2){w0, w1}; } }
    }
};
template <int SECOND> struct EpiGate {
    static constexpr bool PERM = true;
    bf16_t* O; int ldc; const unsigned char* gate; int ldg; float scale; unsigned char* O8;
    __device__ __forceinline__ void operator()(const f32x4 (&acc)[2][2][4][2], const Unit& u, int wr, int wc, int fr, int fq) const {
        const int row0 = u.pm * BM + wr * 64 + fr, col0 = u.pn * BM + wc * 32 + 8 * fq;
#pragma unroll
        for (int ai = 0; ai < 2; ++ai)
#pragma unroll
            for (int m = 0; m < 4; ++m) { const size_t row = (size_t)(row0 + ai * HALF + m * 16); bf16_t* rowp = O + row * ldc + col0; const unsigned char* gp = gate + row * ldg + col0;
#pragma unroll
                for (int bj = 0; bj < 2; ++bj) { const f32x4 v0 = acc[ai][bj][m][0] * scale, v1 = acc[ai][bj][m][1] * scale;
                    const u32x2 gv = *(const u32x2*)(gp + bj * HALF);
                    float r[8];
#pragma unroll
                    for (int e = 0; e < 4; ++e) { r[e] = (float)((gv.x >> (8 * e)) & 0xFFu) * v0[e]; r[4 + e] = (float)((gv.y >> (8 * e)) & 0xFFu) * v1[e]; }
                    if (SECOND) { const u32x4 pv = *(const u32x4*)(rowp + bj * HALF);
                        r[0] += bflo(pv.x); r[1] += bfhi(pv.x); r[2] += bflo(pv.y); r[3] += bfhi(pv.y); r[4] += bflo(pv.z); r[5] += bfhi(pv.z); r[6] += bflo(pv.w); r[7] += bfhi(pv.w);
                        int p0 = __builtin_amdgcn_cvt_pk_fp8_f32(r[0] * 32.f, r[1] * 32.f, 0, false); p0 = __builtin_amdgcn_cvt_pk_fp8_f32(r[2] * 32.f, r[3] * 32.f, p0, true);
                        int p1 = __builtin_amdgcn_cvt_pk_fp8_f32(r[4] * 32.f, r[5] * 32.f, 0, false); p1 = __builtin_amdgcn_cvt_pk_fp8_f32(r[6] * 32.f, r[7] * 32.f, p1, true);
                        *(u32x2*)(O8 + row * ldc + col0 + bj * HALF) = (u32x2){(unsigned)p0, (unsigned)p1};
                    } else {
                    u32x4 w; w.x = cvt_pk_bf16(r[0], r[1]); w.y = cvt_pk_bf16(r[2], r[3]); w.z = cvt_pk_bf16(r[4], r[5]); w.w = cvt_pk_bf16(r[6], r[7]);
                    *(u32x4*)(rowp + bj * HALF) = w; } } }
    }
};
struct EpiResid {
    static constexpr bool PERM = false;
    float* C; const float* X; const float* gt; int ldc; float scale;
    __device__ __forceinline__ void operator()(const f32x4 (&acc)[2][2][4][2], const Unit& u, int wr, int wc, int fr, int fq) const {
        const int row0 = u.pm * BM + wr * 64 + fr, col0 = u.pn * BM + wc * 32 + 4 * fq;
        f32x4 gv[2][2];
#pragma unroll
        for (int bj = 0; bj < 2; ++bj)
#pragma unroll
            for (int n = 0; n < 2; ++n) gv[bj][n] = *(const f32x4*)(gt + col0 + bj * HALF + n * 16) * scale;
#pragma unroll
        for (int ai = 0; ai < 2; ++ai)
#pragma unroll
            for (int m = 0; m < 4; ++m) { const size_t off = (size_t)(row0 + ai * HALF + m * 16) * ldc + col0;
#pragma unroll
                for (int bj = 0; bj < 2; ++bj)
#pragma unroll
                    for (int n = 0; n < 2; ++n) { const f32x4 xv = *(const f32x4*)(X + off + bj * HALF + n * 16);
                        *(f32x4*)(C + off + bj * HALF + n * 16) = xv + gv[bj][n] * acc[ai][bj][m][n]; } }
    }
};
struct EpiSlab {
    static constexpr bool PERM = false;
    float* C;
    __device__ __forceinline__ void operator()(const f32x4 (&acc)[2][2][4][2], const Unit& u, int wr, int wc, int fr, int fq) const {
        const int row0 = u.pm * BM + wr * 64 + fr, col0 = wc * 32 + 4 * fq;
        float* base = C + (size_t)(u.kofs >> 9) * 8192 * 256;
#pragma unroll
        for (int ai = 0; ai < 2; ++ai)
#pragma unroll
            for (int m = 0; m < 4; ++m) { float* rowp = base + (size_t)(row0 + ai * HALF + m * 16) * 256 + col0;
#pragma unroll
                for (int bj = 0; bj < 2; ++bj)
#pragma unroll
                    for (int n = 0; n < 2; ++n) *(f32x4*)(rowp + bj * HALF + n * 16) = acc[ai][bj][m][n]; }
    }
};

typedef int i32x8 __attribute__((ext_vector_type(8)));
template <class Epi, class Sched, bool FP8 = false>
__device__ __forceinline__ void gemm_phase(LAS unsigned char* lds, const Gemm g, const Sched& S, const Epi& E) {
    const int tid = threadIdx.x, wid = __builtin_amdgcn_readfirstlane(tid >> 6), lane = tid & 63, wr = wid >> 2, wc = wid & 3, fr = lane & 15, fq = lane >> 4;
    const int K = g.K, nt = K / BK, lda = g.lda, ldb = g.ldb;
    unsigned voffA[2], voffB[2];
#pragma unroll
    for (int i = 0; i < 2; ++i) { int R, C; stage_rc(tid * 16 + i * 8192, R, C); const int Rb = Epi::PERM ? ((R & ~31) + perm32(R & 31)) : R;
        voffA[i] = (unsigned)(R * lda + C) * 2u; voffB[i] = (unsigned)(Rb * ldb + C) * 2u; }
    const size_t kstep = (size_t)(BK * 2);
    const size_t hstepA = (size_t)HALF * lda * 2, hstepB = (size_t)HALF * ldb * 2;
    const size_t tstepA = 2 * hstepA, tstepB = 2 * hstepB;
    const unsigned ldsw = (unsigned)wid * 1024u;
    const int aoff = lds_byte(wr * 64 + fr, fq * 8), boff = lds_byte(wc * 32 + fr, fq * 8);
#define PG8_SA(b, h) (((b) * 2 + (h)) * HTB)
#define PG8_SB(b, h) ((4 + (b) * 2 + (h)) * HTB)
#define PG8_STAGE(bufoff, gbase, voff) do { _Pragma("unroll") for (int _i = 0; _i < 2; ++_i) \
        __builtin_amdgcn_global_load_lds((const unsigned*)((const char*)(gbase) + (voff)[_i]), (LAS unsigned*)(lds + (bufoff) + ldsw + _i * 8192), 16, 0, 0); } while (0)
#define PG8_LDA(dst, b, h) do { _Pragma("unroll") for (int m = 0; m < 4; ++m) { if constexpr (FP8) dst##8[m] = __builtin_shufflevector(*(const LAS i32x4_*)(lds + PG8_SA(b, h) + aoff + m * 2048), *(const LAS i32x4_*)(lds + PG8_SA(b, h) + aoff + m * 2048 + 1024), 0, 1, 2, 3, 4, 5, 6, 7); \
        else { _Pragma("unroll") for (int k = 0; k < 2; ++k) dst[m][k] = *(const LAS bf16x8*)(lds + PG8_SA(b, h) + aoff + m * 2048 + k * 1024); } } } while (0)
#define PG8_LDB(dst, b, h) do { _Pragma("unroll") for (int n = 0; n < 2; ++n) { if constexpr (FP8) dst##8[n] = __builtin_shufflevector(*(const LAS i32x4_*)(lds + PG8_SB(b, h) + boff + n * 2048), *(const LAS i32x4_*)(lds + PG8_SB(b, h) + boff + n * 2048 + 1024), 0, 1, 2, 3, 4, 5, 6, 7); \
        else { _Pragma("unroll") for (int k = 0; k < 2; ++k) dst[n][k] = *(const LAS bf16x8*)(lds + PG8_SB(b, h) + boff + n * 2048 + k * 1024); } } } while (0)
typedef int i32x4_ __attribute__((ext_vector_type(4)));
#define PG8_MMA(ai, bj, At, Bt) do { __builtin_amdgcn_s_setprio(1); _Pragma("unroll") for (int m = 0; m < 4; ++m) _Pragma("unroll") for (int n = 0; n < 2; ++n) { \
        if constexpr (FP8) asm volatile("v_mfma_scale_f32_16x16x128_f8f6f4 %0, %1, %2, %0, %3, %3 op_sel_hi:[0,0,0]" : "+v"(acc[ai][bj][m][n]) : "v"(Bt##8[n]), "v"(At##8[m]), "v"(one_scale)); \
        else { _Pragma("unroll") for (int k = 0; k < 2; ++k) acc[ai][bj][m][n] = __builtin_amdgcn_mfma_f32_16x16x32_bf16(Bt[n][k], At[m][k], acc[ai][bj][m][n], 0, 0, 0); } } \
        __builtin_amdgcn_s_setprio(0); } while (0)
#define PG8_WAIT_V(n) asm volatile("s_waitcnt vmcnt(" #n ")" ::: "memory")
#define PG8_WAIT_L(n) asm volatile("s_waitcnt lgkmcnt(" #n ")" ::: "memory")
#define PG8_BAR __builtin_amdgcn_s_barrier()
#define PG8_SCHED __builtin_amdgcn_sched_barrier(0)
    Unit cur, nxt; int ui = 0;
    if (!S.next(0, cur)) return;
    f32x4 acc[2][2][4][2];
#pragma unroll
    for (int a = 0; a < 2; ++a)
#pragma unroll
        for (int b = 0; b < 2; ++b)
#pragma unroll
            for (int m = 0; m < 4; ++m)
#pragma unroll
                for (int n = 0; n < 2; ++n) acc[a][b][m][n] = (f32x4){0.f, 0.f, 0.f, 0.f};
    bf16x8 At[4][2], B0[2][2], B1[2][2];
    i32x8 At8[4], B08[2], B18[2];
    const int one_scale = 0x7F7F7F7F;
    const char* cA = (const char*)g.A + (size_t)cur.pm * tstepA + (size_t)cur.kofs * 2; const char* cB = (const char*)g.Bt + (size_t)cur.pn * tstepB + (size_t)cur.kofs * 2;
    PG8_STAGE(PG8_SB(0, 0), cB, voffB); PG8_STAGE(PG8_SB(0, 1), cB + hstepB, voffB); PG8_STAGE(PG8_SA(0, 0), cA, voffA); PG8_STAGE(PG8_SA(0, 1), cA + hstepA, voffA);
    if (wr == 1) PG8_BAR;
    PG8_WAIT_V(2); PG8_BAR;
    PG8_STAGE(PG8_SB(1, 0), cB + kstep, voffB); PG8_STAGE(PG8_SA(1, 0), cA + kstep, voffA); PG8_STAGE(PG8_SB(1, 1), cB + hstepB + kstep, voffB);
    PG8_WAIT_V(6); PG8_BAR;
    for (;;) {
        const bool has_next = S.next(ui + 1, nxt);
        const char* nA = has_next ? (const char*)g.A + (size_t)nxt.pm * tstepA + (size_t)nxt.kofs * 2 : cA; const char* nB = has_next ? (const char*)g.Bt + (size_t)nxt.pn * tstepB + (size_t)nxt.kofs * 2 : cB;
        for (int t = 0; t < nt; t += 2) {
            const bool last = (t == nt - 2);
            const char* a1 = cA + (size_t)(t + 1) * kstep;
            const char* a2 = last ? nA : cA + (size_t)(t + 2) * kstep; const char* b2 = last ? nB : cB + (size_t)(t + 2) * kstep;
            const char* a3 = a2 + kstep; const char* b3 = b2 + kstep;
            PG8_LDB(B0, 0, 0); PG8_LDB(B1, 0, 1); PG8_SCHED; PG8_LDA(At, 0, 0); PG8_STAGE(PG8_SA(1, 1), a1 + hstepA, voffA);
            PG8_WAIT_V(8); PG8_WAIT_L(0); PG8_BAR; PG8_MMA(0, 0, At, B0); PG8_MMA(0, 1, At, B1); PG8_BAR; PG8_SCHED;
            PG8_LDA(At, 0, 1); PG8_STAGE(PG8_SB(0, 0), b2, voffB); PG8_STAGE(PG8_SB(0, 1), b2 + hstepB, voffB); PG8_STAGE(PG8_SA(0, 0), a2, voffA);
            PG8_WAIT_V(8); PG8_WAIT_L(0); PG8_BAR; PG8_MMA(1, 0, At, B0); PG8_MMA(1, 1, At, B1); PG8_BAR; PG8_SCHED;
            PG8_LDB(B0, 1, 0); PG8_LDB(B1, 1, 1); PG8_SCHED; PG8_LDA(At, 1, 0); PG8_STAGE(PG8_SA(0, 1), a2 + hstepA, voffA);
            PG8_WAIT_V(8); PG8_WAIT_L(0); PG8_BAR; PG8_MMA(0, 0, At, B0); PG8_MMA(0, 1, At, B1); PG8_BAR; PG8_SCHED;
            PG8_LDA(At, 1, 1); PG8_STAGE(PG8_SB(1, 0), b3, voffB); PG8_STAGE(PG8_SB(1, 1), b3 + hstepB, voffB); PG8_STAGE(PG8_SA(1, 0), a3, voffA);
            PG8_WAIT_V(8); PG8_WAIT_L(0); PG8_BAR; PG8_MMA(1, 0, At, B0); PG8_MMA(1, 1, At, B1); PG8_BAR; PG8_SCHED;
        }
        if (wr == 0) PG8_BAR;
        if constexpr (FP8) asm volatile("s_nop 15\n\ts_nop 15\n\ts_nop 15" ::: "memory");
        E(acc, cur, wr, wc, fr, fq);
        if (!has_next) break;
#pragma unroll
        for (int a = 0; a < 2; ++a)
#pragma unroll
            for (int b = 0; b < 2; ++b)
#pragma unroll
                for (int m = 0; m < 4; ++m)
#pragma unroll
                    for (int n = 0; n < 2; ++n) acc[a][b][m][n] = (f32x4){0.f, 0.f, 0.f, 0.f};
        cur = nxt; cA = nA; cB = nB; ++ui;
        if (wr == 1) PG8_BAR;
    }
    PG8_WAIT_V(0);
    PG8_BAR;
#undef PG8_SA
#undef PG8_SB
#undef PG8_STAGE
#undef PG8_LDA
#undef PG8_LDB
#undef PG8_MMA
#undef PG8_WAIT_V
#undef PG8_WAIT_L
#undef PG8_BAR
#undef PG8_SCHED
}
}

struct Args { const float* in[27]; float* out; unsigned char* ws; int ph_lo, ph_hi; };
struct Ctx { const float* const* in; float* out; unsigned char* ws; LAS unsigned char* lds; int tid, lane, wave; };

enum { I_X = 0, I_C, I_RELB, I_WADA, I_BADA, I_GMIX, I_WIN, I_GQA, I_GKA, I_GQB, I_GKCMP, I_GKSLC, I_GKWIN, I_PEK, I_W1K, I_W2K, I_PEV, I_W1V, I_W2V,
       I_WBA, I_WBB, I_WOUT, I_GFFN, I_WPQ, I_SUBK, I_PU, I_PV };

__device__ __forceinline__ int map_col(int c) {
    if (c < 5120) return c; if (c < 10240) return c + 96; if (c < 10336) return c - 5120; if (c < 10384) return c; if (c < 10496) return -1; return c - 112;
}

template <bool REMAP>
__device__ __forceinline__ void tconv_tile(const Ctx& C, const float* src, int srcN, bf16_t* dst, int dstK, int n0, int k0) {
    LAS float* tile = (LAS float*)C.lds;
    const int tx = C.tid & 31, ty = C.tid >> 5;
    const int nn = n0 + 4 * tx; const int sc = REMAP ? map_col(nn) : nn;
    f32x4 v[8];
#pragma unroll
    for (int i = 0; i < 8; ++i) { const int k = ty + 16 * i; v[i] = (sc >= 0) ? *(const f32x4*)(src + (size_t)(k0 + k) * srcN + sc) : (f32x4){0.f, 0.f, 0.f, 0.f}; }
#pragma unroll
    for (int i = 0; i < 8; ++i) { const int k = ty + 16 * i; LAS float* q = tile + k * 129 + 4 * tx; q[0] = v[i][0]; q[1] = v[i][1]; q[2] = v[i][2]; q[3] = v[i][3]; }
    __syncthreads();
#pragma unroll
    for (int i = 0; i < 4; ++i) { const int task = C.tid + 512 * i; const int nl = task >> 4, kc = task & 15;
        float e[8];
#pragma unroll
        for (int j = 0; j < 8; ++j) e[j] = tile[(kc * 8 + j) * 129 + nl];
        u32x4 w; w.x = cvt_pk_bf16(e[0], e[1]); w.y = cvt_pk_bf16(e[2], e[3]); w.z = cvt_pk_bf16(e[4], e[5]); w.w = cvt_pk_bf16(e[6], e[7]);
        *(u32x4*)(dst + (size_t)(n0 + nl) * dstK + k0 + kc * 8) = w; }
    __syncthreads();
}

template <bool REMAP>
__device__ __forceinline__ void tconv_tile_f8(const Ctx& C, const float* src, int srcN, unsigned char* dst, int dstK, int n0, int k0) {
    LAS float* tile = (LAS float*)C.lds;
    const int tx = C.tid & 31, ty = C.tid >> 5;
    const int nn = n0 + 4 * tx; const int sc = REMAP ? map_col(nn) : nn;
    f32x4 v[8];
#pragma unroll
    for (int i = 0; i < 8; ++i) { const int k = ty + 16 * i; v[i] = (sc >= 0) ? *(const f32x4*)(src + (size_t)(k0 + k) * srcN + sc) : (f32x4){0.f, 0.f, 0.f, 0.f}; }
#pragma unroll
    for (int i = 0; i < 8; ++i) { const int k = ty + 16 * i; LAS float* q = tile + k * 129 + 4 * tx; q[0] = v[i][0]; q[1] = v[i][1]; q[2] = v[i][2]; q[3] = v[i][3]; }
    __syncthreads();
#pragma unroll
    for (int i = 0; i < 2; ++i) { const int task = C.tid + 512 * i; const int nl = task >> 3, kc = task & 7;
        float e[16];
#pragma unroll
        for (int j = 0; j < 16; ++j) e[j] = tile[(kc * 16 + j) * 129 + nl] * 64.f;
        u32x4 w;
#pragma unroll
        for (int q4 = 0; q4 < 4; ++q4) { int p = __builtin_amdgcn_cvt_pk_fp8_f32(e[4 * q4], e[4 * q4 + 1], 0, false); p = __builtin_amdgcn_cvt_pk_fp8_f32(e[4 * q4 + 2], e[4 * q4 + 3], p, true); w[q4] = (unsigned)p; }
        *(u32x4*)(dst + (size_t)(n0 + nl) * dstK + k0 + kc * 16) = w; }
    __syncthreads();
}

__device__ __forceinline__ void wq_subkey_tile(const Ctx& C, int blk, int k0) {
    LAS float* As = (LAS float*)C.lds;
    LAS float* Bs = As + 128 * 132;
    const int tid = C.tid;
    const float* sk = C.in[I_SUBK] + (size_t)blk * 128 * 128; const float* wq = C.in[I_WPQ] + (size_t)k0 * 2048 + blk * 128;
#pragma unroll
    for (int i = 0; i < 8; ++i) { const int idx = tid + 512 * i, r = idx >> 5, c4 = idx & 31;
        const f32x4 a = *(const f32x4*)(sk + (size_t)r * 128 + 4 * c4), b = *(const f32x4*)(wq + (size_t)r * 2048 + 4 * c4);
        *(LAS f32x4*)(As + r * 132 + 4 * c4) = a; *(LAS f32x4*)(Bs + r * 132 + 4 * c4) = b; }
    __syncthreads();
    const int tn = tid >> 4, tk = tid & 15;
    float acc[4][8];
#pragma unroll
    for (int i = 0; i < 4; ++i)
#pragma unroll
        for (int j = 0; j < 8; ++j) acc[i][j] = 0.f;
#pragma unroll 2
    for (int d4 = 0; d4 < 32; ++d4) {
        f32x4 a[4], b[8];
#pragma unroll
        for (int i = 0; i < 4; ++i) a[i] = *(LAS const f32x4*)(As + (4 * tn + i) * 132 + 4 * d4);
#pragma unroll
        for (int j = 0; j < 8; ++j) b[j] = *(LAS const f32x4*)(Bs + (2 * tk + 32 * (j >> 1) + (j & 1)) * 132 + 4 * d4);
#pragma unroll
        for (int i = 0; i < 4; ++i)
#pragma unroll
            for (int j = 0; j < 8; ++j) acc[i][j] += a[i][0] * b[j][0] + a[i][1] * b[j][1] + a[i][2] * b[j][2] + a[i][3] * b[j][3];
    }
    bf16_t* dst = (bf16_t*)(C.ws + WS_WQ) + (size_t)(blk * 128 + 4 * tn) * 4096 + k0 + 2 * tk;
#pragma unroll
    for (int i = 0; i < 4; ++i)
#pragma unroll
        for (int j = 0; j < 4; ++j) *(unsigned*)(dst + (size_t)i * 4096 + 32 * j) = cvt_pk_bf16(acc[i][2 * j], acc[i][2 * j + 1]);
    __syncthreads();
}

__device__ __forceinline__ void peer_row_convert(const Ctx& C, int grow, int lane) {
            const bool second = grow >= 16384; const int row = grow & 16383;
            const float* src = C.in[second ? I_PV : I_PU] + (size_t)row * 4096;
            unsigned char* dst6 = C.ws + (second ? WS_PV : WS_PU) + (size_t)row * 3072;
            f32x16 v[4]; float am = 0.f;
#pragma unroll
            for (int i4 = 0; i4 < 4; ++i4)
#pragma unroll
                for (int q = 0; q < 4; ++q) { const f32x4 t4 = *(const f32x4*)(src + 16 * (lane + 64 * i4) + 4 * q);
                    v[i4][4 * q] = t4[0]; v[i4][4 * q + 1] = t4[1]; v[i4][4 * q + 2] = t4[2]; v[i4][4 * q + 3] = t4[3];
                    am = fmaxf(am, fmaxf(fmaxf(fabsf(t4[0]), fabsf(t4[1])), fmaxf(fabsf(t4[2]), fabsf(t4[3])))); }
            am = wave_max(am);
            const float sc = am > 0.f ? am * (1.f / 7.f) : 1.f, inv = 1.f / sc;
#pragma unroll
            for (int i4 = 0; i4 < 4; ++i4) v[i4] *= inv;
            const u32x6 pa = __builtin_amdgcn_cvt_scalef32_2xpk16_fp6_f32(v[0], v[1], 1.0f), pb = __builtin_amdgcn_cvt_scalef32_2xpk16_fp6_f32(v[2], v[3], 1.0f);
            *(u32x4*)(dst6 + 16 * lane) = (u32x4){pa[0], pa[1], pa[2], pa[3]};
            *(u32x4*)(dst6 + 1024 + 16 * lane) = (u32x4){pa[4], pa[5], pb[0], pb[1]};
            *(u32x4*)(dst6 + 2048 + 16 * lane) = (u32x4){pb[2], pb[3], pb[4], pb[5]};
            ((float*)(C.ws + (second ? WS_PV : WS_PU) + 96 * MB))[row] = sc;
            { float al = 0.f;
#pragma unroll
              for (int i4 = 0; i4 < 4; ++i4)
#pragma unroll
                  for (int j = 0; j < 16; ++j) al = fmaxf(al, fabsf(v[i4][j]));
              const float s4 = al > 0.f ? al * (1.f / 6.f) : 1.f, inv4 = 1.f / s4;
              unsigned wa[4] = {0u, 0u, 0u, 0u}, wb[4] = {0u, 0u, 0u, 0u};
#define PK4(d_) do { wa[d_] = __builtin_amdgcn_cvt_scalef32_pk_fp4_f32(wa[d_], v[0][4 * (d_)] * inv4, v[1][4 * (d_)] * inv4, 1.0f, 0); wa[d_] = __builtin_amdgcn_cvt_scalef32_pk_fp4_f32(wa[d_], v[0][4 * (d_) + 1] * inv4, v[1][4 * (d_) + 1] * inv4, 1.0f, 1); \
                     wa[d_] = __builtin_amdgcn_cvt_scalef32_pk_fp4_f32(wa[d_], v[0][4 * (d_) + 2] * inv4, v[1][4 * (d_) + 2] * inv4, 1.0f, 2); wa[d_] = __builtin_amdgcn_cvt_scalef32_pk_fp4_f32(wa[d_], v[0][4 * (d_) + 3] * inv4, v[1][4 * (d_) + 3] * inv4, 1.0f, 3); \
                     wb[d_] = __builtin_amdgcn_cvt_scalef32_pk_fp4_f32(wb[d_], v[2][4 * (d_)] * inv4, v[3][4 * (d_)] * inv4, 1.0f, 0); wb[d_] = __builtin_amdgcn_cvt_scalef32_pk_fp4_f32(wb[d_], v[2][4 * (d_) + 1] * inv4, v[3][4 * (d_) + 1] * inv4, 1.0f, 1); \
                     wb[d_] = __builtin_amdgcn_cvt_scalef32_pk_fp4_f32(wb[d_], v[2][4 * (d_) + 2] * inv4, v[3][4 * (d_) + 2] * inv4, 1.0f, 2); wb[d_] = __builtin_amdgcn_cvt_scalef32_pk_fp4_f32(wb[d_], v[2][4 * (d_) + 3] * inv4, v[3][4 * (d_) + 3] * inv4, 1.0f, 3); } while (0)
              PK4(0); PK4(1); PK4(2); PK4(3);
#undef PK4
              unsigned char* dst4 = C.ws + (second ? WS_PV4 : WS_PU4) + (size_t)row * 2176;
              *(u32x4*)(dst4 + 16 * lane) = (u32x4){wa[0], wa[1], wa[2], wa[3]};
              *(u32x4*)(dst4 + 1024 + 16 * lane) = (u32x4){wb[0], wb[1], wb[2], wb[3]};
              *(bf16_t*)(dst4 + 2048 + 2 * lane) = f2bf(sc * s4); }

}

__device__ __forceinline__ void p0_prologue(const Ctx& C) {
    constexpr int N_MOD = 256, N_WIN = (NP / 128) * (D / 128), N_W1 = 2 * 32, N_B1 = 64;
    constexpr int E0 = N_MOD, E1 = E0 + N_B1, E2 = E1 + N_WIN, E7 = E2 + N_W1, E8 = E7 + N_W1, E11 = E8;
    const int tid = C.tid;
    for (int it = blockIdx.x; it < E11; it += gridDim.x) {
        if (it < E0) {
            const int b = it; LAS float* red = (LAS float*)C.lds;
            const float* cvec = C.in[I_C]; const float* w = C.in[I_WADA];
            if (tid < 504) { const int cg = tid % 24, rs = tid / 24;
                f32x4 acc = {0.f, 0.f, 0.f, 0.f};
                const float* wp = w + 96 * b + 4 * cg;
#pragma unroll 4
                for (int k = rs; k < D; k += 21) { const float cv = cvec[k]; const f32x4 wv = *(const f32x4*)(wp + (size_t)k * 24576); acc += cv * wv; }
                *(LAS f32x4*)(red + (rs * 24 + cg) * 4) = acc; }
            __syncthreads();
            if (tid < 24) { f32x4 s = *(const f32x4*)(C.in[I_BADA] + 96 * b + 4 * tid);
                for (int rs = 0; rs < 21; ++rs) s += *(LAS f32x4*)(red + (rs * 24 + tid) * 4);
                *(f32x4*)((float*)(C.ws + WS_MOD) + 96 * b + 4 * tid) = s; }
            __syncthreads();
        } else if (it < E1) {
            const int s = (it - E0) >> 5, sl = (it - E0) & 31; const float* pe = C.in[s ? I_PEV : I_PEK]; const float* w1 = C.in[s ? I_W1V : I_W1K];
            const int e = tid & 255, half = tid >> 8; float a = 0.f;
            const int kb = sl * 128 + half * 64;
#pragma unroll 16
            for (int k = kb; k < kb + 64; ++k) a += pe[k] * w1[(size_t)k * 256 + e];
            LAS float* red = (LAS float*)C.lds; red[tid] = a; __syncthreads();
            if (tid < 256) ((float*)(C.ws + WS_B1P))[(s * 32 + sl) * 256 + tid] = red[tid] + red[tid + 256];
            __syncthreads();
        } else if (it < E2) { const int i = it - E1; const int n0 = (i / 32) * 128, k0 = (i % 32) * 128;
            if (n0 < NP_BF) tconv_tile<true>(C, C.in[I_WIN], 18576, (bf16_t*)(C.ws + WS_WIN), D, n0, k0);
            else tconv_tile_f8<true>(C, C.in[I_WIN], 18576, C.ws + WS_WIN8 - (size_t)NP_BF * D, D, n0, k0);
        } else if (it < E7) { const int i = it - E2; tconv_tile<false>(C, C.in[I_W1K], 256, (bf16_t*)(C.ws + WS_W1T), 4096, (i / 32) * 128, (i % 32) * 128);
        } else if (it < E8) { const int i = it - E7; tconv_tile<false>(C, C.in[I_W1V], 256, (bf16_t*)(C.ws + WS_W1T) + (size_t)256 * 4096, 4096, (i / 32) * 128, (i % 32) * 128);
        }
    }
}

__device__ __forceinline__ void norm_mod_phase(const Ctx& C, const float* xin, const float* gain, const float* sh, const float* sc, bf16_t* hout, unsigned char* h8out = nullptr) {
    LAS float* la = (LAS float*)C.lds; LAS float* lb = la + D;
    for (int i = C.tid; i < D / 4; i += NTHREADS) { const f32x4 g4 = *(const f32x4*)(gain + 4 * i), s4 = *(const f32x4*)(sc + 4 * i), h4 = *(const f32x4*)(sh + 4 * i);
        *(LAS f32x4*)(la + 4 * i) = g4 * (s4 + 1.f); *(LAS f32x4*)(lb + 4 * i) = h4; }
    __syncthreads();
    const int rstep = gridDim.x * 8;
    int row = blockIdx.x * 8 + C.wave;
    f32x4 v[16], vn[16];
    if (row < T) {
#pragma unroll
        for (int i = 0; i < 16; ++i) v[i] = ((const f32x4*)(xin + (size_t)row * D))[C.lane + 64 * i]; }
#pragma unroll 1
    for (; row < T; row += rstep) {
        const int nrow = row + rstep;
        if (nrow < T) {
#pragma unroll
            for (int i = 0; i < 16; ++i) vn[i] = ((const f32x4*)(xin + (size_t)nrow * D))[C.lane + 64 * i]; }
        float ss = 0.f;
#pragma unroll
        for (int i = 0; i < 16; ++i) ss += v[i][0] * v[i][0] + v[i][1] * v[i][1] + v[i][2] * v[i][2] + v[i][3] * v[i][3];
        ss = wave_sum(ss);
        const float rstd = rsqrtf(ss * (1.f / 4096.f) + EPS);
#pragma unroll
        for (int i = 0; i < 16; ++i) { const int col = 4 * (C.lane + 64 * i);
            const f32x4 a4 = *(LAS const f32x4*)(la + col), b4 = *(LAS const f32x4*)(lb + col);
            float y[4];
#pragma unroll
            for (int j = 0; j < 4; ++j) y[j] = v[i][j] * rstd * a4[j] + b4[j];
            u32x2 w; w.x = cvt_pk_bf16(y[0], y[1]); w.y = cvt_pk_bf16(y[2], y[3]);
            *(u32x2*)(hout + (size_t)row * D + col) = w;
            if (h8out) { int p = __builtin_amdgcn_cvt_pk_fp8_f32(y[0], y[1], 0, false); p = __builtin_amdgcn_cvt_pk_fp8_f32(y[2], y[3], p, true); *(unsigned*)(h8out + (size_t)row * D + col) = (unsigned)p; } }
#pragma unroll
        for (int i = 0; i < 16; ++i) v[i] = vn[i];
    }
    __syncthreads();
}

__device__ __forceinline__ void p3_post(const Ctx& C) {
    bf16_t* proj = (bf16_t*)(C.ws + WS_PROJ);
    const int tid = C.tid;
    const float qscale = 0.08838834764831845f;
    if (blockIdx.x == 0) { float a = 0.f; const float* part = (const float*)(C.ws + WS_B1P) + (size_t)(tid >> 8) * 32 * 256 + (tid & 255);
        for (int sl = 0; sl < 32; ++sl) a += part[sl * 256]; ((float*)(C.ws + WS_B1))[tid] = a; }
    for (int item = blockIdx.x; item < T / 64; item += gridDim.x) {
        const int t0 = item * 64;
#pragma unroll 1
        for (int hb = tid >> 4; hb < 64 * 44; hb += 128) {
            const int l16 = tid & 15;
            u32x4 raw[4]; bf16_t* dstp[4]; const float* gain[4]; float scl[4]; bool isk8[4];
#pragma unroll
            for (int u = 0; u < 4; ++u) { const int hr = hb + 32 * u; const int tok = hr / 44, hh = hr % 44; int col; isk8[u] = (hh >= 16 && hh < 20);
                if (hh < 16) { col = P_QA + 128 * hh; gain[u] = C.in[I_GQA]; scl[u] = qscale; dstp[u] = proj + (size_t)(t0 + tok) * NP + col; }
                else if (hh < 20) { col = P_KA + 128 * (hh - 16); gain[u] = C.in[I_GKA]; scl[u] = 1.f; dstp[u] = (bf16_t*)(C.ws + WS_KA + (size_t)(t0 + tok) * 512 + 128 * (hh - 16)); }
                else if (hh < 36) { col = P_QB + 128 * (hh - 20); gain[u] = C.in[I_GQB]; scl[u] = qscale * 1.4426950408889634f; dstp[u] = proj + (size_t)(t0 + tok) * NP + col; }
                else if (hh < 40) { col = P_KS + 128 * (hh - 36); gain[u] = C.in[I_GKSLC]; scl[u] = 1.f; dstp[u] = (bf16_t*)(C.ws + WS_KSC) + ((size_t)(hh - 36) * T + t0 + tok) * 128; }
                else { col = P_KW + 128 * (hh - 40); gain[u] = C.in[I_GKWIN]; scl[u] = 1.f; dstp[u] = (bf16_t*)(C.ws + WS_KWC) + ((size_t)(hh - 40) * T + t0 + tok) * 128; }
                raw[u] = *(const u32x4*)(proj + (size_t)(t0 + tok) * NP + col + 8 * l16); }
#pragma unroll
            for (int u = 0; u < 4; ++u) {
                float v[8] = {bflo(raw[u].x), bfhi(raw[u].x), bflo(raw[u].y), bfhi(raw[u].y), bflo(raw[u].z), bfhi(raw[u].z), bflo(raw[u].w), bfhi(raw[u].w)};
                float ss = 0.f;
#pragma unroll
                for (int j = 0; j < 8; ++j) ss += v[j] * v[j];
                ss += dppf<0xB1>(ss); ss += dppf<0x4E>(ss); ss += dppf<0x141>(ss); ss += dppf<0x140>(ss);
                const float rstd = rsqrtf(ss * (1.f / 128.f) + EPS) * scl[u];
                const f32x4 g0 = *(const f32x4*)(gain[u] + 8 * l16), g1 = *(const f32x4*)(gain[u] + 8 * l16 + 4);
                if (isk8[u]) {
                    const float r8 = rstd * 64.f;
                    int p0 = __builtin_amdgcn_cvt_pk_fp8_f32(v[0] * r8 * g0[0], v[1] * r8 * g0[1], 0, false); p0 = __builtin_amdgcn_cvt_pk_fp8_f32(v[2] * r8 * g0[2], v[3] * r8 * g0[3], p0, true);
                    int p1 = __builtin_amdgcn_cvt_pk_fp8_f32(v[4] * r8 * g1[0], v[5] * r8 * g1[1], 0, false); p1 = __builtin_amdgcn_cvt_pk_fp8_f32(v[6] * r8 * g1[2], v[7] * r8 * g1[3], p1, true);
                    *(u32x2*)((unsigned char*)dstp[u] + 8 * l16) = (u32x2){(unsigned)p0, (unsigned)p1};
                } else {
                u32x4 w; w.x = cvt_pk_bf16(v[0] * rstd * g0[0], v[1] * rstd * g0[1]); w.y = cvt_pk_bf16(v[2] * rstd * g0[2], v[3] * rstd * g0[3]);
                w.z = cvt_pk_bf16(v[4] * rstd * g1[0], v[5] * rstd * g1[1]); w.w = cvt_pk_bf16(v[6] * rstd * g1[2], v[7] * rstd * g1[3]);
                *(u32x4*)(dstp[u] + 8 * l16) = w; } }
        }
        bf16_t* Kc = (bf16_t*)(C.ws + WS_KC); bf16_t* Vc = Kc + (size_t)4 * T * 128;
#pragma unroll
        for (int i = 0; i < 8; ++i) { const int idx = tid + 512 * i, tok = idx >> 6, c16 = idx & 63, g = c16 >> 4, d8 = c16 & 15;
            const bf16_t* src = proj + (size_t)(t0 + tok) * NP + 8 * c16;
            const size_t dof = ((size_t)g * T + t0 + tok) * 128 + 8 * d8;
            *(u32x4*)(Kc + dof) = *(const u32x4*)(src + P_KC);
            *(u32x4*)(Vc + dof) = *(const u32x4*)(src + P_VC);
            { const u32x4 rv = *(const u32x4*)(src + P_VA);
              float v[8] = {bflo(rv.x), bfhi(rv.x), bflo(rv.y), bfhi(rv.y), bflo(rv.z), bfhi(rv.z), bflo(rv.w), bfhi(rv.w)};
              float am = 0.f;
#pragma unroll
              for (int j = 0; j < 8; ++j) am = fmaxf(am, fabsf(v[j]));
              am = fmax_fast(am, dppf<0xB1>(am)); am = fmax_fast(am, dppf<0x4E>(am)); am = fmax_fast(am, dppf<0x141>(am)); am = fmax_fast(am, dppf<0x140>(am));
              const float sc = am > 0.f ? am * (1.f / 448.f) : 1.f, inv = 1.f / sc;
              int p0 = __builtin_amdgcn_cvt_pk_fp8_f32(v[0] * inv, v[1] * inv, 0, false); p0 = __builtin_amdgcn_cvt_pk_fp8_f32(v[2] * inv, v[3] * inv, p0, true);
              int p1 = __builtin_amdgcn_cvt_pk_fp8_f32(v[4] * inv, v[5] * inv, 0, false); p1 = __builtin_amdgcn_cvt_pk_fp8_f32(v[6] * inv, v[7] * inv, p1, true);
              *(u32x2*)(C.ws + WS_VA + (size_t)(t0 + tok) * 512 + 8 * c16) = (u32x2){(unsigned)p0, (unsigned)p1};
              if (d8 == 0) ((float*)(C.ws + WS_VA + 8 * MB))[(size_t)(t0 + tok) * 4 + g] = sc; } }
        { const int tok = tid >> 3, c8 = tid & 7;
          *(u32x4*)((bf16_t*)(C.ws + WS_KIC) + (size_t)(t0 + tok) * 64 + 8 * c8) = *(const u32x4*)(proj + (size_t)(t0 + tok) * NP + P_KI + 8 * c8); }
#pragma unroll 1
        for (int which = 0; which < 2; ++which) {
            const int pcol = which ? P_VW : P_VS; bf16_t* dstT = (bf16_t*)(C.ws + (which ? WS_VWT : WS_VST));
            LAS unsigned* tl = (LAS unsigned*)C.lds;
#pragma unroll
            for (int i = 0; i < 8; ++i) { const int idx = tid + 512 * i, tok = idx >> 6, c16 = idx & 63;
                const u32x4 v = *(const u32x4*)(proj + (size_t)(t0 + tok) * NP + pcol + 8 * c16);
                LAS unsigned* q = tl + tok * 257 + 4 * c16; q[0] = v.x; q[1] = v.y; q[2] = v.z; q[3] = v.w; }
            __syncthreads();
#pragma unroll
            for (int i = 0; i < 8; ++i) { const int task = tid + 512 * i, col = task >> 3, tc = task & 7;
                unsigned short e[8];
#pragma unroll
                for (int j = 0; j < 8; ++j) { const unsigned dw = tl[(8 * tc + j) * 257 + (col >> 1)]; e[j] = (col & 1) ? (unsigned short)(dw >> 16) : (unsigned short)(dw & 0xFFFFu); }
                u32x4 w; w.x = e[0] | ((unsigned)e[1] << 16); w.y = e[2] | ((unsigned)e[3] << 16); w.z = e[4] | ((unsigned)e[5] << 16); w.w = e[6] | ((unsigned)e[7] << 16);
                *(u32x4*)(dstT + (size_t)col * T + t0 + 8 * tc) = w; }
            __syncthreads();
        }
    }
}

__device__ __forceinline__ void p5_cmp_out(const Ctx& C) {
    const float* part = (const float*)(C.ws + WS_HIDP); const float* b1 = (const float*)(C.ws + WS_B1);
    bf16_t* kcmp = (bf16_t*)(C.ws + WS_KCMP); bf16_t* vcT = (bf16_t*)(C.ws + WS_VCMPT);
    LAS float* hl = (LAS float*)(C.lds) + C.wave * 1024;
    const int lane = C.lane;
    for (int grp = blockIdx.x * 8 + C.wave; grp < 2048; grp += gridDim.x * 8) {
        const int R0 = grp * 4; const bool isv = R0 >= 4096;
        lds_sync();
        const f32x4 bb = *(const f32x4*)(b1 + (isv ? 256 : 0) + 4 * lane);
#pragma unroll
        for (int r = 0; r < 4; ++r) { f32x4 a = bb;
#pragma unroll
            for (int ks = 0; ks < 8; ++ks) a += *(const f32x4*)(part + ((size_t)ks * 8192 + R0 + r) * 256 + 4 * lane);
            f32x4 hg; hg[0] = gelu_tanh(a[0]); hg[1] = gelu_tanh(a[1]); hg[2] = gelu_tanh(a[2]); hg[3] = gelu_tanh(a[3]);
            *(LAS f32x4*)(hl + r * 256 + 4 * lane) = hg; }
        lds_sync();
        const float* w2 = C.in[isv ? I_W2V : I_W2K];
        float acc[4][2];
#pragma unroll
        for (int r = 0; r < 4; ++r) { acc[r][0] = 0.f; acc[r][1] = 0.f; }
#pragma unroll 8
        for (int e = 0; e < 256; ++e) { const float2 wv = *(const float2*)(w2 + e * 128 + 2 * lane);
#pragma unroll
            for (int r = 0; r < 4; ++r) { const float hv = hl[r * 256 + e]; acc[r][0] += hv * wv.x; acc[r][1] += hv * wv.y; } }
#pragma unroll
        for (int r = 0; r < 4; ++r) { const int R = R0 + r, Rl = R & 4095, g = Rl >> 10, n = Rl & 1023;
            const float a0 = (n < NCMP) ? acc[r][0] : 0.f, a1 = (n < NCMP) ? acc[r][1] : 0.f;
            if (!isv) { const float ss = wave_sum(a0 * a0 + a1 * a1); const float rstd = rsqrtf(ss * (1.f / 128.f) + EPS);
                const float2 gg = *(const float2*)(C.in[I_GKCMP] + 2 * lane);
                *(unsigned*)(kcmp + (size_t)Rl * 128 + 2 * lane) = (n < NCMP) ? cvt_pk_bf16(a0 * rstd * gg.x, a1 * rstd * gg.y) : 0u; }
            else { vcT[((size_t)g * 128 + 2 * lane) * 1024 + n] = f2bf(a0); vcT[((size_t)g * 128 + 2 * lane + 1) * 1024 + n] = f2bf(a1); } }
    }
}

constexpr int P6_WAVE_LDS = 18432, P6_SHARED = 8192;
__device__ __forceinline__ f32x16 mfma32(bf16x8 a, bf16x8 b, f32x16 c) { return __builtin_amdgcn_mfma_f32_32x32x16_bf16(a, b, c, 0, 0, 0); }
__device__ __forceinline__ int swap23(int r) { return (r & 0x13) | ((r & 4) << 1) | ((r & 8) >> 1); }

__device__ __forceinline__ void topk_prune(LAS u64* buf, int& cnt, u64& tau, LAS unsigned* hist, int lane) {
    u64 e[8];
#pragma unroll
    for (int i = 0; i < 8; ++i) { const int idx = lane + 64 * i; e[i] = idx < cnt ? buf[idx] : 0ull; }
    u64 prefix = 0ull; unsigned need = 256u;
    const u64 lt = (1ull << lane) - 1ull;
#pragma unroll 1
    for (int p = 0; p < 6; ++p) {
        const int shift = 40 - 8 * p;
        *(LAS u32x4*)(hist + 4 * lane) = (u32x4){0u, 0u, 0u, 0u};
        lds_sync();
#pragma unroll
        for (int i = 0; i < 8; ++i) { const bool m = (e[i] != 0ull) && ((e[i] >> (shift + 8)) == (prefix >> (shift + 8)));
            if (m) __hip_atomic_fetch_add(hist + (unsigned)((e[i] >> shift) & 255ull), 1u, __ATOMIC_RELAXED, __HIP_MEMORY_SCOPE_WORKGROUP); }
        lds_sync();
        const u32x4 c = *(LAS u32x4*)(hist + 4 * lane);
        const unsigned tot = c.x + c.y + c.z + c.w;
        unsigned pre = tot;
        pre += (unsigned)__builtin_amdgcn_update_dpp(0, (int)pre, 0x111, 0xF, 0xF, true); pre += (unsigned)__builtin_amdgcn_update_dpp(0, (int)pre, 0x112, 0xF, 0xF, true);
        pre += (unsigned)__builtin_amdgcn_update_dpp(0, (int)pre, 0x114, 0xF, 0xF, true); pre += (unsigned)__builtin_amdgcn_update_dpp(0, (int)pre, 0x118, 0xF, 0xF, true);
        const unsigned r0 = (unsigned)__builtin_amdgcn_readlane((int)pre, 15), r1 = (unsigned)__builtin_amdgcn_readlane((int)pre, 31), r2 = (unsigned)__builtin_amdgcn_readlane((int)pre, 47), r3 = (unsigned)__builtin_amdgcn_readlane((int)pre, 63);
        const int row = lane >> 4;
        pre += (row == 1) ? r0 : (row == 2) ? (r0 + r1) : (row == 3) ? (r0 + r1 + r2) : 0u;
        const unsigned a3 = (r0 + r1 + r2 + r3) - pre, a2 = a3 + c.w, a1 = a2 + c.z, a0 = a1 + c.y;
        int found = -1; unsigned above = 0u;
        if (a3 < need && need <= a3 + c.w) { found = 3; above = a3; }
        else if (a2 < need && need <= a2 + c.z) { found = 2; above = a2; }
        else if (a1 < need && need <= a1 + c.y) { found = 1; above = a1; }
        else if (a0 < need && need <= a0 + c.x) { found = 0; above = a0; }
        const u64 bm = __ballot(found >= 0);
        const int src = bm ? (__ffsll((long long)bm) - 1) : 0;
        const int bin = __builtin_amdgcn_readlane(4 * lane + found, src); const unsigned ab = (unsigned)__builtin_amdgcn_readlane((int)above, src);
        prefix |= ((u64)(unsigned)bin) << shift; need -= ab;
        lds_sync();
    }
    tau = prefix;
    int base = 0;
#pragma unroll
    for (int i = 0; i < 8; ++i) { const bool keep = (e[i] >= tau) && (e[i] != 0ull); const u64 m = __ballot(keep);
        if (keep) buf[base + __popcll(m & lt)] = e[i]; base += __popcll(m); }
    cnt = base;
    lds_sync();
}

#ifndef DSA_PROBE_MODE
#define DSA_PROBE_MODE 0
#endif
__device__ __forceinline__ void dsa_item(const Ctx& C, int qp, LAS unsigned char* wl, LAS const unsigned char* bkt, LAS const float* tbl, int pmode = 0) {
    const int lane = C.lane, r = lane & 31, h = lane >> 5;
    const bf16_t* proj = (const bf16_t*)(C.ws + WS_PROJ); const bf16_t* kic = (const bf16_t*)(C.ws + WS_KIC);
    unsigned char* ya = C.ws + WS_YA;
    const int t0 = 2 * qp;
    LAS u64* buf0 = (LAS u64*)wl; LAS u64* buf1 = (LAS u64*)(wl + 4096);
    LAS unsigned* hist = (LAS unsigned*)(wl + 8192);
    LAS unsigned char* qst = wl + 9216;
    LAS float* pl = (LAS float*)(wl + 10240);
    LAS unsigned* idxs = (LAS unsigned*)(wl + 14336);
    const u64 lt = (1ull << lane) - 1ull;
    {
    bf16x8 A[2][4]; unsigned wp[2][8];
#pragma unroll
    for (int q = 0; q < 2; ++q) {
        const bf16_t* pr = proj + (size_t)(t0 + q) * NP;
#pragma unroll
        for (int kk = 0; kk < 4; ++kk) A[q][kk] = *(const bf16x8*)(pr + P_QI + 64 * r + 32 * h + 8 * kk);
#pragma unroll
        for (int k2 = 0; k2 < 8; ++k2) { const int reg = 2 * k2; wp[q][k2] = *(const unsigned*)(pr + P_WI + (reg & 3) + 8 * (reg >> 2) + 4 * h); }
    }
    int cnt0 = 0, cnt1 = 0; u64 tau0 = 0ull, tau1 = 0ull;
    const int nkeys = (pmode == 2) ? 0 : t0 + 2;
    LAS unsigned char* stg = wl + 9216;
    const unsigned ixo0 = (unsigned)(((lane >> 3) * 64 + 8 * ((lane & 7) ^ ((lane >> 4) & 7))) * 2), ixo1 = (unsigned)(((lane >> 3) * 64 + 8 * ((lane & 7) ^ ((4 + (lane >> 4)) & 7))) * 2);
#define IX_STAGE(j0_) do { const char* _tb = (const char*)kic + (size_t)(j0_) * 128; _Pragma("unroll") for (int _i = 0; _i < 8; ++_i) \
        __builtin_amdgcn_global_load_lds((const unsigned*)(_tb + _i * 1024 + ((_i & 1) ? ixo1 : ixo0)), (LAS unsigned*)(stg + _i * 1024), 16, 0, 0); } while (0)
    if (nkeys > 0) IX_STAGE(0);
#pragma unroll 1
    for (int j0 = 0; j0 < nkeys; j0 += 64) {
        bf16x8 BA[4], BB[4];
        asm volatile("s_waitcnt vmcnt(0)" ::: "memory");
#pragma unroll
        for (int kk = 0; kk < 4; ++kk) { const int sw = (r >> 1) & 7;
            BA[kk] = *(LAS const bf16x8*)(stg + r * 128 + 16 * ((4 * h + kk) ^ sw));
            BB[kk] = *(LAS const bf16x8*)(stg + (32 + r) * 128 + 16 * ((4 * h + kk) ^ sw)); }
        asm volatile("s_waitcnt lgkmcnt(0)" ::: "memory");
        if (j0 + 64 < nkeys) IX_STAGE(j0 + 64);
        const int kidx = j0 + lane;
        f32x16 accA0, accB0, accA1, accB1;
#pragma unroll
        for (int i = 0; i < 16; ++i) { accA0[i] = 0.f; accB0[i] = 0.f; accA1[i] = 0.f; accB1[i] = 0.f; }
#pragma unroll
        for (int kk = 0; kk < 4; ++kk) { accA0 = mfma32(A[0][kk], BA[kk], accA0); accB0 = mfma32(A[0][kk], BB[kk], accB0); }
#pragma unroll
        for (int kk = 0; kk < 4; ++kk) { accA1 = mfma32(A[1][kk], BA[kk], accA1); accB1 = mfma32(A[1][kk], BB[kk], accB1); }
        float sc[2];
        { float pA = 0.f, pB = 0.f;
#pragma unroll
          for (int i = 0; i < 16; ++i) { const float wv = (i & 1) ? bfhi(wp[0][i >> 1]) : bflo(wp[0][i >> 1]);
              const float ta = __int_as_float(max(__float_as_int(accA0[i]), 0)), tb = __int_as_float(max(__float_as_int(accB0[i]), 0));
              pA = __builtin_fmaf(ta, wv, pA); pB = __builtin_fmaf(tb, wv, pB); }
          swap32f(pA, pB); sc[0] = pA + pB; }
        __builtin_amdgcn_sched_group_barrier(0x008, 8, 0);
#pragma unroll
        for (int i = 0; i < 8; ++i) { __builtin_amdgcn_sched_group_barrier(0x008, 1, 0); __builtin_amdgcn_sched_group_barrier(0x002, 9, 0); }
        { float pA = 0.f, pB = 0.f;
#pragma unroll
          for (int i = 0; i < 16; ++i) { const float wv = (i & 1) ? bfhi(wp[1][i >> 1]) : bflo(wp[1][i >> 1]);
              const float ta = __int_as_float(max(__float_as_int(accA1[i]), 0)), tb = __int_as_float(max(__float_as_int(accB1[i]), 0));
              pA = __builtin_fmaf(ta, wv, pA); pB = __builtin_fmaf(tb, wv, pB); }
          swap32f(pA, pB); sc[1] = pA + pB; }
#pragma unroll
        for (int q = 0; q < 2; ++q) {
            const float s = sc[q];
            const bool valid = kidx <= t0 + q;
            const u64 key = ((u64)sortable(s) << 14) | (u64)(unsigned)(16383 - kidx);
            const u64 tau = q ? tau1 : tau0;
            const bool pass = valid && key > tau && (pmode != 3);
            const u64 mask = __ballot(pass);
            if (mask) {
                LAS u64* buf = q ? buf1 : buf0; int& cnt = q ? cnt1 : cnt0;
                if (pass) buf[cnt + __popcll(mask & lt)] = key;
                cnt += __popcll(mask);
                if (cnt > 512 - 64) { lds_sync(); topk_prune(buf, cnt, q ? tau1 : tau0, hist, lane); }
            }
        }
    }
#undef IX_STAGE
    lds_sync();
    if (cnt0 > 256) topk_prune(buf0, cnt0, tau0, hist, lane);
    if (cnt1 > 256) topk_prune(buf1, cnt1, tau1, hist, lane);
    if (pmode == 2) { cnt0 = min(t0 + 1, 256); cnt1 = min(t0 + 2, 256);
#pragma unroll
        for (int i = 0; i < 4; ++i) { const int j = lane + 64 * i; buf0[j] = (u64)(unsigned)(16383 - ((j * 61) % (t0 + 1))); buf1[j] = (u64)(unsigned)(16383 - ((j * 59) % (t0 + 2))); } }
    if (lane == 0) { hist[0] = (unsigned)cnt0; hist[1] = (unsigned)cnt1; }
    lds_sync();
    }
    __builtin_amdgcn_s_setprio(0);
    if (pmode == 1 || pmode == 3) return;
    const int kq = lane >> 4, l16 = lane & 15;
    LAS float* plq = (LAS float*)wl;
    LAS unsigned short* idx2 = (LAS unsigned short*)(wl + 16384);
    LAS float* invl = (LAS float*)(wl + 17408);
    const int nsel0 = (int)hist[0], nsel1 = (int)hist[1];
    { unsigned iv0[4], iv1[4];
#pragma unroll
      for (int i = 0; i < 4; ++i) { const int j = lane + 64 * i; iv0[i] = (j < nsel0) ? (16383u - (unsigned)(buf0[j] & 0x3FFFull)) : 0u; iv1[i] = (j < nsel1) ? (16383u - (unsigned)(buf1[j] & 0x3FFFull)) : 0u; }
      lds_sync();
#pragma unroll
      for (int i = 0; i < 4; ++i) { const int j = lane + 64 * i; idx2[j] = (unsigned short)iv0[i]; idx2[256 + j] = (unsigned short)iv1[i]; }
      lds_sync(); }
    const unsigned char* KAp = (const unsigned char*)(C.ws + WS_KA) + 32 * kq;
    const float lsc = 1.f / (64.f * 512.f);
#pragma unroll 1
    for (int q = 0; q < 2; ++q) {
        const int t = t0 + q; const int nsel = q ? nsel1 : nsel0; LAS const unsigned short* idxs = idx2 + 256 * q;
        const bf16_t* prq = proj + (size_t)t * NP;
        lds_sync();
        {
            long Bz[4][4];
#pragma unroll
            for (int g = 0; g < 4; ++g)
#pragma unroll
                for (int sI = 0; sI < 4; ++sI) { long z = 0;
                    if ((l16 >> 2) == g) { const u32x4 raw = *(const u32x4*)(prq + P_QA + l16 * 128 + 32 * kq + 8 * sI);
                        int p0 = __builtin_amdgcn_cvt_pk_fp8_f32(bflo(raw.x) * 512.f, bfhi(raw.x) * 512.f, 0, false); p0 = __builtin_amdgcn_cvt_pk_fp8_f32(bflo(raw.y) * 512.f, bfhi(raw.y) * 512.f, p0, true);
                        int p1 = __builtin_amdgcn_cvt_pk_fp8_f32(bflo(raw.z) * 512.f, bfhi(raw.z) * 512.f, 0, false); p1 = __builtin_amdgcn_cvt_pk_fp8_f32(bflo(raw.w) * 512.f, bfhi(raw.w) * 512.f, p1, true);
                        z = (long)(((unsigned long long)(unsigned)p1 << 32) | (unsigned long long)(unsigned)p0); }
                    Bz[g][sI] = z; }
            u32x4 A0[2][2], A1[2][2];
            { const unsigned char* kr = KAp + (size_t)idxs[l16] * 512;
#pragma unroll
              for (int g = 0; g < 2; ++g) { A0[g][0] = *(const u32x4*)(kr + g * 128); A0[g][1] = *(const u32x4*)(kr + g * 128 + 16); } }
#pragma unroll 1
            for (int tile = 0; tile < 16; ++tile) {
                { const unsigned char* kr = KAp + (size_t)idxs[16 * tile + l16] * 512 + 256;
#pragma unroll
                  for (int g = 0; g < 2; ++g) { A1[g][0] = *(const u32x4*)(kr + g * 128); A1[g][1] = *(const u32x4*)(kr + g * 128 + 16); } }
                f32x4 acc = {0.f, 0.f, 0.f, 0.f};
#pragma unroll
                for (int g = 0; g < 2; ++g)
#pragma unroll
                    for (int sI = 0; sI < 4; ++sI) { const u32x4 v = A0[g][sI >> 1]; const long a = (sI & 1) ? (long)(((unsigned long long)v.w << 32) | v.z) : (long)(((unsigned long long)v.y << 32) | v.x);
                        acc = __builtin_amdgcn_mfma_f32_16x16x32_fp8_fp8(a, Bz[g][sI], acc, 0, 0, 0); }
                asm volatile("" ::: "memory");
                if (tile < 15) { const unsigned char* kr = KAp + (size_t)idxs[16 * (tile + 1) + l16] * 512;
#pragma unroll
                    for (int g = 0; g < 2; ++g) { A0[g][0] = *(const u32x4*)(kr + g * 128); A0[g][1] = *(const u32x4*)(kr + g * 128 + 16); } }
#pragma unroll
                for (int g = 0; g < 2; ++g)
#pragma unroll
                    for (int sI = 0; sI < 4; ++sI) { const u32x4 v = A1[g][sI >> 1]; const long a = (sI & 1) ? (long)(((unsigned long long)v.w << 32) | v.z) : (long)(((unsigned long long)v.y << 32) | v.x);
                        acc = __builtin_amdgcn_mfma_f32_16x16x32_fp8_fp8(a, Bz[2 + g][sI], acc, 0, 0, 0); }
#pragma unroll
                for (int r = 0; r < 4; ++r) { const int j = 16 * tile + 4 * kq + r; const int idx = (int)idxs[j]; const bool valid = j < nsel;
                    const int b = bkt[min(max(t - idx, 0), 2048)];
                    plq[j * 16 + l16] = valid ? (acc[r] * lsc + tbl[b * 32 + l16]) : -1e30f; }
            }
        }
        lds_sync();
        {
            float mx[16];
#pragma unroll
            for (int hh = 0; hh < 16; ++hh) mx[hh] = -1e30f;
#pragma unroll 1
            for (int ps = 0; ps < 4; ++ps) { const int j = ps * 64 + lane;
#pragma unroll
                for (int c4 = 0; c4 < 4; ++c4) { const f32x4 lv = *(LAS f32x4*)(plq + 16 * j + 4 * c4);
#pragma unroll
                    for (int e = 0; e < 4; ++e) mx[4 * c4 + e] = fmaxf(mx[4 * c4 + e], lv[e]); } }
#pragma unroll
            for (int hh = 0; hh < 16; ++hh) mx[hh] = wave_max(mx[hh]);
            float zs[16];
#pragma unroll
            for (int hh = 0; hh < 16; ++hh) zs[hh] = 0.f;
#pragma unroll 1
            for (int ps = 0; ps < 4; ++ps) { const int j = ps * 64 + lane; const bool valid = j < nsel;
                const f32x4 vsc = *(const f32x4*)((const float*)(C.ws + WS_VA + 8 * MB) + (size_t)idxs[j] * 4);
#pragma unroll
                for (int c4 = 0; c4 < 4; ++c4) { f32x4 lv = *(LAS f32x4*)(plq + 16 * j + 4 * c4);
#pragma unroll
                    for (int e = 0; e < 4; ++e) { const float p = valid ? __expf(lv[e] - mx[4 * c4 + e]) : 0.f; lv[e] = p * vsc[c4]; zs[4 * c4 + e] += p; }
                    *(LAS f32x4*)(plq + 16 * j + 4 * c4) = lv; } }
#pragma unroll
            for (int hh = 0; hh < 16; ++hh) { const float z = wave_sum(zs[hh]); if (lane == 0) invl[hh] = 1.f / fmaxf(z, 1e-30f); }
        }
        lds_sync();
#pragma unroll 1
        for (int g = 0; g < 4; ++g) {
            const f32x4 inv4 = *(LAS f32x4*)(invl + 4 * g);
            f32x2 o2[4][4];
#pragma unroll
            for (int rr = 0; rr < 4; ++rr)
#pragma unroll
                for (int d = 0; d < 4; ++d) o2[rr][d] = (f32x2){0.f, 0.f};
            const unsigned char* vbase = C.ws + WS_VA + 128 * g + 8 * l16;
            const int nb = (nsel + 31) >> 5;
            u32x2 vc[8], vn[8];
#pragma unroll
            for (int u = 0; u < 8; ++u) { const int idx = (int)idxs[4 * u + kq]; vc[u] = *(const u32x2*)(vbase + (size_t)idx * 512); }
#pragma unroll 1
            for (int bb = 0; bb < nb; ++bb) {
                if (bb + 1 < nb) {
#pragma unroll
                    for (int u = 0; u < 8; ++u) { const int idx = (int)idxs[32 * (bb + 1) + 4 * u + kq]; vn[u] = *(const u32x2*)(vbase + (size_t)idx * 512); } }
#pragma unroll
                for (int u = 0; u < 8; ++u) { const f32x4 p4 = *(LAS f32x4*)(plq + 16 * (32 * bb + 4 * u + kq) + 4 * g);
                    const f32x2 va = __builtin_amdgcn_cvt_pk_f32_fp8((int)vc[u].x, false), vb = __builtin_amdgcn_cvt_pk_f32_fp8((int)vc[u].x, true),
                                vcc = __builtin_amdgcn_cvt_pk_f32_fp8((int)vc[u].y, false), vd = __builtin_amdgcn_cvt_pk_f32_fp8((int)vc[u].y, true);
#pragma unroll
                    for (int rr = 0; rr < 4; ++rr) { const f32x2 pp = {p4[rr], p4[rr]};
                        o2[rr][0] = pp * va + o2[rr][0]; o2[rr][1] = pp * vb + o2[rr][1]; o2[rr][2] = pp * vcc + o2[rr][2]; o2[rr][3] = pp * vd + o2[rr][3]; } }
#pragma unroll
                for (int u = 0; u < 8; ++u) vc[u] = vn[u];
            }
            float o[4][8];
#pragma unroll
            for (int rr = 0; rr < 4; ++rr)
#pragma unroll
                for (int d = 0; d < 4; ++d) { o[rr][2 * d] = xsum16(xsum32(o2[rr][d].x)) * inv4[rr]; o[rr][2 * d + 1] = xsum16(xsum32(o2[rr][d].y)) * inv4[rr]; }
            if (kq == 0) {
#pragma unroll
                for (int rr = 0; rr < 4; ++rr) { int p0 = __builtin_amdgcn_cvt_pk_fp8_f32(o[rr][0] * 16.f, o[rr][1] * 16.f, 0, false); p0 = __builtin_amdgcn_cvt_pk_fp8_f32(o[rr][2] * 16.f, o[rr][3] * 16.f, p0, true);
                    int p1 = __builtin_amdgcn_cvt_pk_fp8_f32(o[rr][4] * 16.f, o[rr][5] * 16.f, 0, false); p1 = __builtin_amdgcn_cvt_pk_fp8_f32(o[rr][6] * 16.f, o[rr][7] * 16.f, p1, true);
                    *(u32x2*)(ya + (size_t)t * 2048 + (4 * g + rr) * 128 + 8 * l16) = (u32x2){(unsigned)p0, (unsigned)p1}; } }
        }
    }
}

constexpr int N2_KS = 0, N2_VS = 32768, N2_LUT = 65536, N2_IMP = 81920, N2_SEL = N2_IMP + 64 * 260 * 4, N2_UNI = N2_SEL + 2048, N2_LIST = N2_UNI + 64, N2_BKT = N2_LIST + 3 * 512, N2_TBL = N2_BKT + 2304, N2_END = N2_TBL + 4096;
static_assert(N2_END <= LDS_BYTES - 16, "NSA LDS map");
struct N2Src { const bf16_t* kbase; size_t kld; int krmax; const bf16_t* vT; size_t vld; };
__device__ __forceinline__ void n2_stage(const N2Src& s, int m, bool withV, LAS unsigned char* kbuf, LAS unsigned char* vbuf, int wave, int lane) {
#pragma unroll
    for (int j = 0; j < 2; ++j) { const int slot = (wave * 2 + j) * 64 + lane; const int row = slot >> 4, ch = (slot & 15) ^ (row & 15);
        __builtin_amdgcn_global_load_lds((const unsigned*)(s.kbase + (size_t)min(64 * m + row, s.krmax) * s.kld + 8 * ch), (LAS unsigned*)(kbuf + (wave * 2 + j) * 1024), 16, 0, 0); }
    if (withV) {
#pragma unroll
        for (int j = 0; j < 2; ++j) { const int slot = (wave * 2 + j) * 64 + lane; const int row = slot >> 3, ch = (slot & 7) ^ ((row >> 1) & 7);
            __builtin_amdgcn_global_load_lds((const unsigned*)(s.vT + (size_t)row * s.vld + 64 * m + 8 * ch), (LAS unsigned*)(vbuf + (wave * 2 + j) * 1024), 16, 0, 0); } }
}
__device__ __forceinline__ f32x16 n2_qk(const bf16x8 (&Bq)[8], LAS const unsigned char* kbuf, int hf, int rho, int h) {
    const int kr = 32 * hf + rho;
    f32x16 S;
#pragma unroll
    for (int i = 0; i < 16; ++i) S[i] = 0.f;
#pragma unroll
    for (int kk = 0; kk < 8; ++kk) { const int ch = 8 * h + kk; const bf16x8 a = *(LAS const bf16x8*)(kbuf + kr * 256 + 16 * (ch ^ (rho & 15))); S = mfma32(a, Bq[kk], S); }
    return S;
}
__device__ __forceinline__ void n2_pv(f32x16 (&O)[4], const float (&p)[16], LAS const unsigned char* vbuf, int hf, int lane) {
    bf16x8 pk[2];
#pragma unroll
    for (int s = 0; s < 2; ++s) { u32x4 w; w.x = cvt_pk_bf16(p[8 * s + 0], p[8 * s + 1]); w.y = cvt_pk_bf16(p[8 * s + 2], p[8 * s + 3]); w.z = cvt_pk_bf16(p[8 * s + 4], p[8 * s + 5]); w.w = cvt_pk_bf16(p[8 * s + 6], p[8 * s + 7]);
        pk[s] = __builtin_bit_cast(bf16x8, w); }
    const int r = lane & 31, h = lane >> 5;
#pragma unroll
    for (int dt = 0; dt < 4; ++dt)
#pragma unroll
        for (int s = 0; s < 2; ++s) { const int row = dt * 32 + r, ch = 4 * hf + 2 * s + h;
            const bf16x8 a = *(LAS const bf16x8*)(vbuf + row * 128 + 16 * (ch ^ ((r >> 1) & 7))); O[dt] = mfma32(a, pk[s], O[dt]); }
}
constexpr float N2_MASKED = -3.0e38f, N2_MINIT = -1.0e30f, LOG2E = 1.4426950408889634f;
template <int MODE, bool DEFER = false>
__device__ __forceinline__ float n2_bias_mask(f32x16& S, int posbase, int t, int t0w, int h, int ncv, int ncv0, unsigned sb, bool before_cur, float b31, LAS const bf16_t* lutr, LAS const unsigned char* bkt, LAS const float* tblh) {
    bool farT, fullT;
    if (MODE == 0) { farT = (t0w - (16 * (posbase + 31) + 31)) >= 1513; fullT = (posbase + 31) < ncv0; }
    else if (MODE == 1) { farT = (t0w - (posbase + 31)) >= 1513; fullT = before_cur; }
    else { farT = false; fullT = (posbase + 31 <= t0w) && ((t0w + 7 - posbase) < 512); }
    float cbu = b31;
    if (MODE != 0 && fullT && !farT) { const int b0 = (int)bkt[min(t0w - (posbase + 31), 2048)], b1 = (int)bkt[min(t0w + 7 - posbase, 2048)];
        if (b0 == b1) { farT = true; cbu = tblh[b0 * 32] * LOG2E; } }
    if (farT && fullT) {
        if (MODE == 1 && sb == 0u) {
#pragma unroll
            for (int reg = 0; reg < 16; ++reg) S[reg] = N2_MASKED;
            return 0.f; }
        if (DEFER) return cbu;
#pragma unroll
        for (int reg = 0; reg < 16; ++reg) S[reg] = S[reg] + cbu;
    } else {
#pragma unroll
        for (int reg = 0; reg < 16; ++reg) { const int pos = posbase + (reg & 7) + 8 * h + 16 * (reg >> 3);
            const int dist = (MODE == 0) ? (t - (16 * pos + 31)) : (t - pos);
            bool v;
            if (MODE == 0) v = pos < ncv; else if (MODE == 1) v = (sb != 0u) && (pos <= t); else v = (pos <= t) && (dist < 512);
            const float bias = bf2f(lutr[min(max(dist, 0), 2047)]);
            S[reg] = v ? (S[reg] + bias) : N2_MASKED; }
    }
    return 0.f;
}
__device__ __forceinline__ float n2_tilemax(const f32x16& S) {
    float a = fmax_fast(S[0], S[1]), b = fmax_fast(S[2], S[3]), c = fmax_fast(S[4], S[5]), d = fmax_fast(S[6], S[7]);
    float e = fmax_fast(S[8], S[9]), f = fmax_fast(S[10], S[11]), g = fmax_fast(S[12], S[13]), hh = fmax_fast(S[14], S[15]);
    a = fmax_fast(a, b); c = fmax_fast(c, d); e = fmax_fast(e, f); g = fmax_fast(g, hh); a = fmax_fast(a, c); e = fmax_fast(e, g); return fmax_fast(a, e);
}
__device__ __forceinline__ void n2_stat(const f32x16& S, float& m, float& Z) {
    const float mn = fmax_fast(m, n2_tilemax(S));
    float z = 0.f;
#pragma unroll
    for (int i = 0; i < 16; ++i) z += __builtin_amdgcn_exp2f(S[i] - mn);
    Z = Z * __builtin_amdgcn_exp2f(m - mn) + z; m = mn;
}
__device__ __forceinline__ void n2_combine(float& m, float& Z) {
    float ma = m, mb = m; swap32f(ma, mb); const float M = fmax_fast(ma, mb);
    Z = xsum32(Z * __builtin_amdgcn_exp2f(m - M)); m = M;
}
enum { N2_STATS = 0, N2_IMPP = 1, N2_PV = 2, N2_ONLINE = 3, N2_IMPV = 4 };
struct N2Lane { int t, t0w, h, rho, qq, rr, lane, ncv, ncv0, ncv7, cur; float b31; LAS const bf16_t* lutr; LAS const unsigned char* bkt; LAS const float* tblh; };
template <int MODE, int PASS>
__device__ __forceinline__ void n2_branch(const Ctx& C, int g, LAS const unsigned short* list, int n, const N2Lane& L, const bf16x8 (&Bq)[8], f32x16 (&O)[4],
                                          float& m, float& Z, float scale, LAS const unsigned* selq, LAS float* impw, float scale2 = 1.f) {
    if (n <= 0) return;
    constexpr bool withV = (PASS == N2_PV || PASS == N2_ONLINE || PASS == N2_IMPV);
    constexpr int NSL = (PASS == N2_IMPV) ? 2 : 4, LA = NSL - 1;
    N2Src src;
    if (MODE == 0) { src.kbase = (const bf16_t*)(C.ws + WS_KCMP) + (size_t)g * 1024 * 128; src.kld = 128; src.krmax = 1023; src.vT = (const bf16_t*)(C.ws + WS_VCMPT) + (size_t)g * 128 * 1024; src.vld = 1024; }
    else if (MODE == 1) { src.kbase = (const bf16_t*)(C.ws + WS_KSC) + (size_t)g * T * 128; src.kld = 128; src.krmax = T - 1; src.vT = (const bf16_t*)(C.ws + WS_VST) + (size_t)g * 128 * T; src.vld = (size_t)T; }
    else { src.kbase = (const bf16_t*)(C.ws + WS_KWC) + (size_t)g * T * 128; src.kld = 128; src.krmax = T - 1; src.vT = (const bf16_t*)(C.ws + WS_VWT) + (size_t)g * 128 * T; src.vld = (size_t)T; }
    LAS unsigned char* lds = C.lds;
#define N2_KSLOT(s_) (withV ? (((s_) < 2) ? (N2_KS + (s_) * 16384) : (N2_IMP + ((s_) - 2) * 32768)) : (N2_KS + (s_) * 16384))
#define N2_VSLOT(s_) (((s_) < 2) ? (N2_VS + (s_) * 16384) : (N2_IMP + ((s_) - 2) * 32768 + 16384))
#define N2_RAW_BARRIER() do { asm volatile("s_waitcnt lgkmcnt(0)" ::: "memory"); __builtin_amdgcn_s_barrier(); asm volatile("" ::: "memory"); } while (0)
#define N2_WAIT_LANDED() do { if (LA == 1) asm volatile("s_waitcnt vmcnt(0)" ::: "memory"); else if (withV) asm volatile("s_waitcnt vmcnt(8)" ::: "memory"); else asm volatile("s_waitcnt vmcnt(4)" ::: "memory"); } while (0)
#pragma unroll
    for (int j = 0; j < LA; ++j) if (j < n) n2_stage(src, (int)list[j], withV, lds + N2_KSLOT(j), lds + N2_VSLOT(j), C.wave, C.lane);
    if (n >= LA) N2_WAIT_LANDED(); else asm volatile("s_waitcnt vmcnt(0)" ::: "memory");
    N2_RAW_BARRIER();
#pragma unroll 1
    for (int i = 0; i < n; ++i) {
        const int mb = (int)list[i];
        if (i + LA < n) { const int sl = (i + LA) & (NSL - 1); n2_stage(src, (int)list[i + LA], withV, lds + N2_KSLOT(sl), lds + N2_VSLOT(sl), C.wave, C.lane); }
        LAS const unsigned char* kbuf = lds + N2_KSLOT(i & (NSL - 1)); LAS const unsigned char* vbuf = lds + N2_VSLOT(i & (NSL - 1));
        bool need; unsigned sb = 1u;
        if (MODE == 0) need = (64 * mb) < L.ncv7;
        else if (MODE == 1) { const unsigned sw = selq[mb >> 5]; sb = (sw >> (mb & 31)) & 1u; need = __ballot(sb != 0u) != 0ull; }
        else need = (64 * mb + 63 >= L.t0w - 511) && (64 * mb <= L.t0w + 7);
        if (need) {
#pragma unroll 1
            for (int hf = 0; hf < 2; ++hf) {
                const int posbase = 64 * mb + 32 * hf;
                f32x16 S = n2_qk(Bq, kbuf, hf, L.rho, L.h);
                const float cbd = n2_bias_mask<MODE, PASS == N2_ONLINE>(S, posbase, L.t, L.t0w, L.h, L.ncv, L.ncv0, sb, mb < L.cur, L.b31, L.lutr, L.bkt, L.tblh);
                if (PASS == N2_STATS) { n2_stat(S, m, Z); }
                else if (PASS == N2_IMPP || PASS == N2_IMPV) {
                    float p[16];
#pragma unroll
                    for (int r = 0; r < 16; ++r) p[r] = __builtin_amdgcn_exp2f(S[r] - m) * scale;
#pragma unroll
                    for (int G = 0; G < 4; ++G) { float q4 = p[4 * G] + p[4 * G + 1] + p[4 * G + 2] + p[4 * G + 3], e = p[4 * G + 3];
                        q4 += dppf<0xB1>(q4); q4 += dppf<0x4E>(q4); e += dppf<0xB1>(e); e += dppf<0x4E>(e);
                        const int nb = posbase + ((4 * G) & 7) + 8 * L.h + 16 * ((4 * G) >> 3); const int mq = nb >> 2;
                        if (L.rr == 0) { __hip_atomic_fetch_add(impw + L.qq * 260 + mq, q4, __ATOMIC_RELAXED, __HIP_MEMORY_SCOPE_WORKGROUP);
                                         __hip_atomic_fetch_add(impw + L.qq * 260 + mq + 1, e, __ATOMIC_RELAXED, __HIP_MEMORY_SCOPE_WORKGROUP); } }
                    if (PASS == N2_IMPV) {
#pragma unroll
                        for (int r = 0; r < 16; ++r) p[r] *= scale2;
                        n2_pv(O, p, vbuf, hf, L.lane); }
                } else if (PASS == N2_PV) {
                    float p[16];
#pragma unroll
                    for (int r = 0; r < 16; ++r) p[r] = __builtin_amdgcn_exp2f(S[r] - m) * scale;
                    n2_pv(O, p, vbuf, hf, L.lane);
                } else {
                    const float tm = xmax32(n2_tilemax(S) + cbd);
                    const float mn = fmax_fast(m, tm);
                    if (__ballot(mn > m + 8.f)) { const float al = __builtin_amdgcn_exp2f(m - mn); Z *= al;
#pragma unroll
                        for (int dt = 0; dt < 4; ++dt)
#pragma unroll
                            for (int r = 0; r < 16; ++r) O[dt][r] *= al;
                        m = mn; }
                    float p[16]; float zs = 0.f;
                    const float c2 = cbd - m;
#pragma unroll
                    for (int r = 0; r < 16; ++r) { p[r] = __builtin_amdgcn_exp2f(S[r] + c2); zs += p[r]; }
                    Z += zs;
                    n2_pv(O, p, vbuf, hf, L.lane);
                }
            }
        }
        if (i + LA < n) N2_WAIT_LANDED(); else asm volatile("s_waitcnt vmcnt(0)" ::: "memory");
        N2_RAW_BARRIER();
    }
#undef N2_WAIT_LANDED
#undef N2_RAW_BARRIER
#undef N2_KSLOT
#undef N2_VSLOT
}

__device__ __forceinline__ void nsa2_item(const Ctx& C, int QB, int g) {
    LAS unsigned char* lds = C.lds;
    const int tid = C.tid, lane = C.lane, wave = C.wave;
    const int c = lane & 31, h = lane >> 5, qq = c >> 2, rr = c & 3;
    const int t0 = 64 * QB, t0w = t0 + 8 * wave, t = t0w + qq, head = 4 * g + rr;
    const bf16_t* proj = (const bf16_t*)(C.ws + WS_PROJ);
    LAS bf16_t* lut = (LAS bf16_t*)(lds + N2_LUT);
    LAS float* imp = (LAS float*)(lds + N2_IMP);
    LAS unsigned* selw = (LAS unsigned*)(lds + N2_SEL);
    LAS unsigned* uni = (LAS unsigned*)(lds + N2_UNI);
    LAS unsigned short* listC = (LAS unsigned short*)(lds + N2_LIST); LAS unsigned short* listS = listC + 256; LAS unsigned short* listW = listC + 512;
    LAS const unsigned char* bkt = lds + N2_BKT; LAS const float* tbl = (LAS const float*)(lds + N2_TBL);
    __syncthreads();
    for (int i = tid; i < 8192; i += NTHREADS) { const int r4 = i >> 11, d = i & 2047; lut[i] = f2bf(tbl[(int)bkt[d] * 32 + 16 + 4 * g + r4] * LOG2E); }
    for (int i = tid; i < 64 * 260; i += NTHREADS) imp[i] = 0.f;
    const int ncv_wg = (t0 + 63 >= 31) ? ((t0 + 63 - 31) >> 4) + 1 : 0; const int nC = (ncv_wg + 63) >> 6;
    const int wlo = max(t0 - 511, 0) >> 6; const int nW = QB - wlo + 1;
    if (tid < nC) listC[tid] = (unsigned short)tid;
    if (tid < nW) listW[tid] = (unsigned short)(wlo + tid);
    bf16x8 Bq[8];
#pragma unroll
    for (int kk = 0; kk < 8; ++kk) Bq[kk] = *(const bf16x8*)(proj + (size_t)t * NP + P_QB + 128 * head + 64 * h + 8 * kk);
    const float g0 = sigmoidf_(bf2f(proj[(size_t)t * NP + P_GB + 3 * head + 0]));
    const float g1 = sigmoidf_(bf2f(proj[(size_t)t * NP + P_GB + 3 * head + 1]));
    const float g2 = sigmoidf_(bf2f(proj[(size_t)t * NP + P_GB + 3 * head + 2]));
    f32x16 O[4];
#pragma unroll
    for (int dt = 0; dt < 4; ++dt)
#pragma unroll
        for (int i = 0; i < 16; ++i) O[dt][i] = 0.f;
    N2Lane L; L.t = t; L.t0w = t0w; L.h = h; L.rho = swap23(c); L.qq = qq; L.rr = rr; L.lane = lane;
    L.ncv = t >= 31 ? ((t - 31) >> 4) + 1 : 0; L.ncv0 = t0w >= 31 ? ((t0w - 31) >> 4) + 1 : 0; L.ncv7 = (t0w + 7 >= 31) ? ((t0w + 7 - 31) >> 4) + 1 : 0; L.cur = QB;
    L.b31 = tbl[31 * 32 + 16 + head] * LOG2E; L.lutr = lut + rr * 2048; L.bkt = bkt; L.tblh = tbl + 16 + head;
    LAS const unsigned* selq = selw + (wave * 8 + qq) * 8;
    LAS float* impw = imp + wave * 8 * 260;
    __syncthreads();
    float mC = N2_MINIT, ZC = 0.f;
    n2_branch<0, N2_STATS>(C, g, listC, nC, L, Bq, O, mC, ZC, 0.f, selq, impw);
    n2_combine(mC, ZC);
    const float invZC = 1.f / fmaxf(ZC, 1e-30f);
    n2_branch<0, N2_IMPV>(C, g, listC, nC, L, Bq, O, mC, ZC, invZC, selq, impw, g0);
#define N2_OACC() ({ unsigned to_ = (unsigned)tid; asm volatile("" : "+v"(to_)); (f32x4*)(C.ws + WS_OACC) + (size_t)blockIdx.x * 16 * 512 + to_; })
    f32x4* oacc = N2_OACC();
#pragma unroll
    for (int dt = 0; dt < 4; ++dt)
#pragma unroll
        for (int G = 0; G < 4; ++G) { oacc[(dt * 4 + G) * 512] = (f32x4){O[dt][4 * G], O[dt][4 * G + 1], O[dt][4 * G + 2], O[dt][4 * G + 3]}; O[dt][4 * G] = 0.f; O[dt][4 * G + 1] = 0.f; O[dt][4 * G + 2] = 0.f; O[dt][4 * G + 3] = 0.f; }
    lds_sync();
#pragma unroll 1
    for (int q8 = 0; q8 < 8; ++q8) {
        const int cur = QB;
        unsigned word = 0u;
        if (cur + 1 <= 16) { if (lane == 0) word = (1u << (cur + 1)) - 1u; }
        else {
            unsigned key[4];
#pragma unroll
            for (int i = 0; i < 4; ++i) { const int mblk = lane + 64 * i; const bool ok = mblk >= 1 && mblk <= cur - 2;
                key[i] = ok ? ((__float_as_uint(impw[q8 * 260 + mblk]) & 0xFFFFFF00u) | (unsigned)(255 - mblk)) : 0u; }
#pragma unroll 1
            for (int round = 0; round < 13; ++round) {
                unsigned lm = key[0] > key[1] ? key[0] : key[1]; const unsigned lm2 = key[2] > key[3] ? key[2] : key[3]; lm = lm > lm2 ? lm : lm2;
                const unsigned W = wave_maxu(lm);
#pragma unroll
                for (int i = 0; i < 4; ++i) if (key[i] == W) key[i] = 0u;
                const int mw = 255 - (int)(W & 0xFFu);
                if (W != 0u && lane == (mw >> 5)) word |= 1u << (mw & 31);
            }
            if (lane == 0) word |= 1u;
            if (lane == (cur >> 5)) word |= 1u << (cur & 31);
            if (lane == ((cur - 1) >> 5)) word |= 1u << ((cur - 1) & 31);
        }
        if (lane < 8) selw[(wave * 8 + q8) * 8 + lane] = word;
    }
    __syncthreads();
    if (tid < 8) { unsigned u = 0u; for (int q = 0; q < 64; ++q) u |= selw[q * 8 + tid]; uni[tid] = u; }
    __syncthreads();
    if (tid == 0) { int n = 0; for (int mblk = 0; mblk <= QB; ++mblk) if ((uni[mblk >> 5] >> (mblk & 31)) & 1u) listS[n++] = (unsigned short)mblk; uni[8] = (unsigned)n; }
    __syncthreads();
    const int nS = (int)uni[8];
    float mS = N2_MINIT, ZS = 0.f;
    n2_branch<1, N2_ONLINE>(C, g, listS, nS, L, Bq, O, mS, ZS, 0.f, selq, impw);
    { ZS = xsum32(ZS); const float sc = g1 / fmaxf(ZS, 1e-30f);
#pragma unroll
      for (int dt = 0; dt < 4; ++dt)
#pragma unroll
          for (int r = 0; r < 16; ++r) O[dt][r] *= sc; }
    oacc = N2_OACC();
#pragma unroll
    for (int dt = 0; dt < 4; ++dt)
#pragma unroll
        for (int G = 0; G < 4; ++G) { const f32x4 a = oacc[(dt * 4 + G) * 512];
            oacc[(dt * 4 + G) * 512] = (f32x4){O[dt][4 * G] + a[0], O[dt][4 * G + 1] + a[1], O[dt][4 * G + 2] + a[2], O[dt][4 * G + 3] + a[3]};
            O[dt][4 * G] = 0.f; O[dt][4 * G + 1] = 0.f; O[dt][4 * G + 2] = 0.f; O[dt][4 * G + 3] = 0.f; }
    float mW = N2_MINIT, ZW = 0.f;
    n2_branch<2, N2_ONLINE>(C, g, listW, nW, L, Bq, O, mW, ZW, 0.f, selq, impw);
    oacc = N2_OACC();
    { ZW = xsum32(ZW); const float sc = g2 / fmaxf(ZW, 1e-30f);
#pragma unroll
      for (int dt = 0; dt < 4; ++dt)
#pragma unroll
          for (int G = 0; G < 4; ++G) { const f32x4 a = oacc[(dt * 4 + G) * 512];
              O[dt][4 * G] = O[dt][4 * G] * sc + a[0]; O[dt][4 * G + 1] = O[dt][4 * G + 1] * sc + a[1]; O[dt][4 * G + 2] = O[dt][4 * G + 2] * sc + a[2]; O[dt][4 * G + 3] = O[dt][4 * G + 3] * sc + a[3]; } }
    unsigned char* yb = C.ws + WS_YB + (size_t)t * 2048 + head * 128;
#pragma unroll
    for (int dt = 0; dt < 4; ++dt)
#pragma unroll
        for (int G = 0; G < 4; ++G) { int p = __builtin_amdgcn_cvt_pk_fp8_f32(O[dt][4 * G] * 16.f, O[dt][4 * G + 1] * 16.f, 0, false); p = __builtin_amdgcn_cvt_pk_fp8_f32(O[dt][4 * G + 2] * 16.f, O[dt][4 * G + 3] * 16.f, p, true);
            *(unsigned*)(yb + dt * 32 + 8 * G + 4 * h) = (unsigned)p; }
}

#ifndef NREP_DSA
#define NREP_DSA 1
#endif
#ifndef NREP_NSA
#define NREP_NSA 1
#endif
__device__ __forceinline__ void p6_mixers(const Ctx& C, int which  , int crep = 0) {
    const Ctx& C0_ = C;
    unsigned* counter = (unsigned*)(C.ws + WS_CTL + CTL_CNT) + 128 * crep;
    static_assert(8 * P6_WAVE_LDS <= N2_BKT, "DSA per-wave LDS vs the shared bias tables");
    LAS unsigned char* bkt = C.lds + N2_BKT; LAS float* tbl = (LAS float*)(C.lds + N2_TBL);
    for (int d = C.tid; d <= 2048; d += NTHREADS) { int b;
        if (d < 16) b = d; else { b = 16 + (int)(logf((float)d / 16.f) / logf(128.f) * 16.f); b = b < 31 ? b : 31; }
        bkt[d] = (unsigned char)b; }
    for (int i = C.tid; i < 1024; i += NTHREADS) tbl[i] = C.in[I_RELB][i];
    __syncthreads();
    if (which != 1) {
        LAS int* slot = (LAS int*)(C.lds + N2_UNI + 48);
#pragma unroll 1
        for (int rep = 0; rep < NREP_NSA; ++rep)
        for (;;) {
            __syncthreads();
            if (C.tid == 0) *slot = (int)atomicAdd(counter + 64 + 128 * rep, 1u);
            __syncthreads();
            const int it = *slot;
            if (it >= 1024) break;
            nsa2_item(C, 255 - (it >> 2), it & 3);
#pragma unroll 1
            for (int c = 0; c < 3; ++c) { const int j = it + 1024 * c; if (j >= 2560) break;
                __syncthreads();
                Ctx C = C0_; { int t_ = threadIdx.x; asm volatile("" : "+v"(t_)); C.tid = t_; C.lane = t_ & 63; C.wave = __builtin_amdgcn_readfirstlane(t_ >> 6); }
                if (j < 512) tconv_tile_f8<false>(C, C.in[I_WBA], 4096, C.ws + WS_WBA, 2048, (j / 16) * 128, (j % 16) * 128);
                else if (j < 1024) { const int i = j - 512; tconv_tile_f8<false>(C, C.in[I_WBB], 4096, C.ws + WS_WBB, 2048, (i / 16) * 128, (i % 16) * 128); }
                else if (j < 2048) { const int i = j - 1024; tconv_tile_f8<false>(C, C.in[I_WOUT], 4096, C.ws + WS_WOUT, 4096, (i / 32) * 128, (i % 32) * 128); }
                else { const int i = j - 2048; wq_subkey_tile(C, i >> 5, (i & 31) * 128); } }
        }
        __syncthreads();
    }
    if (which != 2) {
        LAS unsigned char* wl = C.lds + C.wave * P6_WAVE_LDS;
#pragma unroll 1
        for (int rep = 0; rep < NREP_DSA; ++rep)
        for (;;) {
            int it = 0;
            if (C.lane == 0) it = (int)atomicAdd(counter + 128 * rep, 1u);
            it = __builtin_amdgcn_readfirstlane(it);
            if (it >= 8192) break;
            if (C.wave >= 4) __builtin_amdgcn_s_setprio(2);
            dsa_item(C, 8191 - it, wl, bkt, tbl, (rep < NREP_DSA - 1) ? DSA_PROBE_MODE : 0);
#pragma unroll 1
            for (int rr = 0; rr < 4; ++rr) peer_row_convert(C, 4 * it + rr, C.lane);
        }
        __builtin_amdgcn_s_setprio(0);
        __syncthreads();
    }
}

static __device__ const unsigned P12_IJ4[16] = {
    0xE0331000u, 0xF0401101u, 0xFF411202u, 0xFF421303u, 0xFF501404u, 0xFF511505u, 0xFF601606u, 0xFF611707u, 0xFF702008u, 0xFF712109u, 0xFF80220Au, 0xFF90230Bu, 0xFFA0240Cu, 0xFFB0300Du, 0xFFC0310Eu, 0xFFD0320Fu };
typedef __bf16 bf16x32_t __attribute__((ext_vector_type(32)));
typedef unsigned u32x16 __attribute__((ext_vector_type(16)));
typedef _Float16 h2_t __attribute__((ext_vector_type(2)));
typedef _Float16 h32_t __attribute__((ext_vector_type(32)));
__device__ __forceinline__ unsigned rowmax_u(unsigned v) { v = umaxu(v, dppu<0xB1>(v)); v = umaxu(v, dppu<0x4E>(v)); v = umaxu(v, dppu<0x141>(v)); v = umaxu(v, dppu<0x140>(v)); return v; }
__device__ __forceinline__ float rowmax_f(float v) { v = fmax_fast(v, dppf<0xB1>(v)); v = fmax_fast(v, dppf<0x4E>(v)); v = fmax_fast(v, dppf<0x141>(v)); v = fmax_fast(v, dppf<0x140>(v)); return v; }
__device__ __forceinline__ float rowsum_f(float v) { v += dppf<0xB1>(v); v += dppf<0x4E>(v); v += dppf<0x141>(v); v += dppf<0x140>(v); return v; }
#define P12_CE(a_, b_) do { const unsigned hi_ = umaxu(a_, b_), lo_ = (a_) < (b_) ? (a_) : (b_); a_ = hi_; b_ = lo_; } while (0)
__device__ __forceinline__ void p12_route(const bf16_t* srow, LAS float* tops, LAS int* topi, LAS unsigned short* exl, LAS float* gtl, int lane, unsigned ij4) {
    const int row = lane >> 4, l16 = lane & 15;
#pragma unroll 1
    for (int q = 0; q < 4; ++q) {
        const int p = 4 * q + row;
        const u32x4 raw = *(const u32x4*)(srow + p * 128 + 8 * l16);
        unsigned k[8];
#pragma unroll
        for (int e = 0; e < 8; ++e) { const unsigned bits = (e & 1) ? (raw[e >> 1] & 0xFFFF0000u) : (raw[e >> 1] << 16);
            k[e] = ((bits ^ ((bits >> 31) ? 0xFFFFFFFFu : 0x80000000u)) & 0xFFFFFF80u) | (unsigned)(127 - (8 * l16 + e)); }
        P12_CE(k[0], k[2]); P12_CE(k[1], k[3]); P12_CE(k[4], k[6]); P12_CE(k[5], k[7]);
        P12_CE(k[0], k[4]); P12_CE(k[1], k[5]); P12_CE(k[2], k[6]); P12_CE(k[3], k[7]);
        P12_CE(k[0], k[1]); P12_CE(k[2], k[3]); P12_CE(k[4], k[5]); P12_CE(k[6], k[7]);
        P12_CE(k[2], k[4]); P12_CE(k[3], k[5]);
        P12_CE(k[1], k[4]); P12_CE(k[3], k[6]);
        P12_CE(k[1], k[2]); P12_CE(k[3], k[4]); P12_CE(k[5], k[6]);
        unsigned myW = 0u;
#pragma unroll
        for (int r = 0; r < 16; ++r) {
            const unsigned W = rowmax_u(k[0]);
            const bool pop = k[0] == W;
#pragma unroll
            for (int e = 0; e < 7; ++e) k[e] = pop ? k[e + 1] : k[e];
            k[7] = pop ? 0u : k[7];
            myW = (l16 == r) ? W : myW;
        }
        const unsigned sb = myW & 0xFFFFFF80u;
        const unsigned bits = (sb & 0x80000000u) ? (sb ^ 0x80000000u) : ((~sb) & 0xFFFF0000u);
        tops[p * 16 + l16] = __uint_as_float(bits); topi[p * 16 + l16] = 127 - (int)(myW & 0x7Fu);
    }
    lds_sync();
#pragma unroll 1
    for (int q2 = 0; q2 < 2; ++q2) {
        const int hh = 4 * q2 + row;
        LAS const float* t1 = tops + (2 * hh) * 16; LAS const float* t2 = t1 + 16;
        unsigned k[4];
#pragma unroll
        for (int c = 0; c < 4; ++c) { const unsigned ij = (ij4 >> (8 * c)) & 0xFFu; const float cv = t1[ij >> 4] + t2[ij & 15u];
            k[c] = (ij != 0xFFu) ? ((sortable(cv) & 0xFFFFFF00u) | (255u - ij)) : 0u; }
        P12_CE(k[0], k[1]); P12_CE(k[2], k[3]); P12_CE(k[0], k[2]); P12_CE(k[1], k[3]); P12_CE(k[1], k[2]);
        unsigned myW = 0u;
#pragma unroll
        for (int r = 0; r < 16; ++r) {
            const unsigned W = rowmax_u(k[0]);
            const bool pop = k[0] == W;
            k[0] = pop ? k[1] : k[0]; k[1] = pop ? k[2] : k[1]; k[2] = pop ? k[3] : k[2]; k[3] = pop ? 0u : k[3];
            myW = (l16 == r) ? W : myW;
        }
        const unsigned flat = 255u - (myW & 0xFFu); const int ci = (int)(flat >> 4), cj = (int)(flat & 15u);
        const float cv = t1[ci] + t2[cj];
        const float ev = __expf(cv - rowmax_f(cv));
        const float es = rowsum_f(ev);
        exl[hh * 16 + l16] = (unsigned short)(topi[(2 * hh) * 16 + ci] * 128 + topi[(2 * hh + 1) * 16 + cj]);
        gtl[hh * 16 + l16] = ev * __builtin_amdgcn_rcpf(es);
    }
    lds_sync();
}
#undef P12_CE
__device__ __forceinline__ float gelu_fast(float x) { const float u = 0.7978845608028654f * (x + 0.044715f * x * x * x); const float e = __expf(2.f * u); return x - x * __builtin_amdgcn_rcpf(e + 1.f); }

#ifndef P12_HI
#define P12_HI 4
#endif
__device__ __forceinline__ void p12_peer(const Ctx& C, float* dst) {
    const bf16_t* pq = (const bf16_t*)(C.ws + WS_PQ);
    const bf16_t* h2 = (const bf16_t*)(C.ws + WS_H2);
    const float* gt2 = (const float*)(C.ws + WS_MOD) + 5 * D;
    const int lane = C.lane;
    LAS unsigned char* wl = C.lds + C.wave * 8192;
    LAS unsigned short* exl = (LAS unsigned short*)wl;
    LAS float* gtl = (LAS float*)(wl + 2048);
    LAS float* tops = (LAS float*)(wl + 6144);
    LAS int* topi = (LAS int*)(wl + 7168);
    const unsigned ij4 = P12_IJ4[lane & 15];
    const unsigned lo16 = 16u * (unsigned)lane; const unsigned char* pu6 = C.ws + WS_PU; const unsigned char* pv6 = C.ws + WS_PV;
    const float* su = (const float*)(C.ws + WS_PU + 96 * MB); const float* sv = (const float*)(C.ws + WS_PV + 96 * MB);
    const unsigned char* pu4 = C.ws + WS_PU4; const unsigned char* pv4 = C.ws + WS_PV4;
    const int tstride = gridDim.x * 8;
    for (int tb = blockIdx.x * 8 + C.wave; tb < T; tb += 8 * tstride) {
        int nb = 0;
#pragma unroll 1
        for (int s = 0; s < 8; ++s) { if (tb + s * tstride >= T) break; ++nb; }
        p12_route(pq + (size_t)tb * 2048, tops, topi, exl, gtl, lane, ij4);
        const int nflat = nb * 128;
        u32x4 UA[3], VA[3], UB[3], VB[3], UC[3], VC[3], UD[3], VD[3]; float suA, svA, suB, svB, suC, svC, suD, svD;
#define P12_FMT(idx_) ((((idx_) & 15) < P12_HI) ? 6 : 4)
#define P12_LOAD(S, idx_, fmt_) do { const int e_ = __builtin_amdgcn_readfirstlane((int)exl[(idx_) < nflat ? (idx_) : nflat - 1]); \
        if ((fmt_) == 6) { const unsigned char* pu_ = pu6 + (size_t)e_ * 3072 + lo16; const unsigned char* pv_ = pv6 + (size_t)e_ * 3072 + lo16; \
            U##S[0] = *(const u32x4*)pu_; U##S[1] = *(const u32x4*)(pu_ + 1024); U##S[2] = *(const u32x4*)(pu_ + 2048); \
            V##S[0] = *(const u32x4*)pv_; V##S[1] = *(const u32x4*)(pv_ + 1024); V##S[2] = *(const u32x4*)(pv_ + 2048); su##S = su[e_]; sv##S = sv[e_]; } \
        else { const unsigned char* pu_ = pu4 + (size_t)e_ * 2176; const unsigned char* pv_ = pv4 + (size_t)e_ * 2176; \
            U##S[0] = *(const u32x4*)(pu_ + lo16); U##S[1] = *(const u32x4*)(pu_ + 1024 + lo16); su##S = bf2f(*(const bf16_t*)(pu_ + 2048 + 2 * lane)); \
            V##S[0] = *(const u32x4*)(pv_ + lo16); V##S[1] = *(const u32x4*)(pv_ + 1024 + lo16); sv##S = bf2f(*(const bf16_t*)(pv_ + 2048 + 2 * lane)); } } while (0)
#define P12_U4(w_, hh_, j_) do { \
        a0_ = dot2bf(__builtin_bit_cast(unsigned, __builtin_amdgcn_cvt_scalef32_pk_bf16_fp4((w_), 1.0f, 0)), hh_[(j_)], a0_); a1_ = dot2bf(__builtin_bit_cast(unsigned, __builtin_amdgcn_cvt_scalef32_pk_bf16_fp4((w_), 1.0f, 1)), hh_[(j_) + 1], a1_); \
        a2_ = dot2bf(__builtin_bit_cast(unsigned, __builtin_amdgcn_cvt_scalef32_pk_bf16_fp4((w_), 1.0f, 2)), hh_[(j_) + 2], a2_); a3_ = dot2bf(__builtin_bit_cast(unsigned, __builtin_amdgcn_cvt_scalef32_pk_bf16_fp4((w_), 1.0f, 3)), hh_[(j_) + 3], a3_); } while (0)
#define P12_V4(w_, oo_, j_) do { \
        oo_[(j_)] = act2_ * __builtin_amdgcn_cvt_scalef32_pk_f16_fp4((w_), 1.0f, 0) + oo_[(j_)]; oo_[(j_) + 1] = act2_ * __builtin_amdgcn_cvt_scalef32_pk_f16_fp4((w_), 1.0f, 1) + oo_[(j_) + 1]; \
        oo_[(j_) + 2] = act2_ * __builtin_amdgcn_cvt_scalef32_pk_f16_fp4((w_), 1.0f, 2) + oo_[(j_) + 2]; oo_[(j_) + 3] = act2_ * __builtin_amdgcn_cvt_scalef32_pk_f16_fp4((w_), 1.0f, 3) + oo_[(j_) + 3]; } while (0)
#define P12_COMPUTE(S, idx_, fmt_) do { float a0_ = 0.f, a1_ = 0.f, a2_ = 0.f, a3_ = 0.f; \
        if ((fmt_) == 6) { \
            const u32x16 ua_ = __builtin_bit_cast(u32x16, __builtin_amdgcn_cvt_scalef32_pk32_bf16_fp6((u32x6){U##S[0].x, U##S[0].y, U##S[0].z, U##S[0].w, U##S[1].x, U##S[1].y}, 1.0f)); \
            const u32x16 ub_ = __builtin_bit_cast(u32x16, __builtin_amdgcn_cvt_scalef32_pk32_bf16_fp6((u32x6){U##S[1].z, U##S[1].w, U##S[2].x, U##S[2].y, U##S[2].z, U##S[2].w}, 1.0f)); \
            _Pragma("unroll") for (int j = 0; j < 16; j += 4) { a0_ = dot2bf(ua_[j], hA[j], a0_); a1_ = dot2bf(ua_[j + 1], hA[j + 1], a1_); a2_ = dot2bf(ua_[j + 2], hA[j + 2], a2_); a3_ = dot2bf(ua_[j + 3], hA[j + 3], a3_); } \
            _Pragma("unroll") for (int j = 0; j < 16; j += 4) { a0_ = dot2bf(ub_[j], hB[j], a0_); a1_ = dot2bf(ub_[j + 1], hB[j + 1], a1_); a2_ = dot2bf(ub_[j + 2], hB[j + 2], a2_); a3_ = dot2bf(ub_[j + 3], hB[j + 3], a3_); } \
            const float a_ = wave_sum((a0_ + a1_) + (a2_ + a3_)) * su##S; \
            const float act_ = gelu_fast(a_) * gtl[idx_] * sv##S; const h2_t act2_ = {(_Float16)act_, (_Float16)act_}; \
            const h32_t va_ = __builtin_amdgcn_cvt_scalef32_pk32_f16_fp6((u32x6){V##S[0].x, V##S[0].y, V##S[0].z, V##S[0].w, V##S[1].x, V##S[1].y}, 1.0f); \
            _Pragma("unroll") for (int j = 0; j < 16; ++j) oA[j] = act2_ * (h2_t){va_[2 * j], va_[2 * j + 1]} + oA[j]; \
            const h32_t vb_ = __builtin_amdgcn_cvt_scalef32_pk32_f16_fp6((u32x6){V##S[1].z, V##S[1].w, V##S[2].x, V##S[2].y, V##S[2].z, V##S[2].w}, 1.0f); \
            _Pragma("unroll") for (int j = 0; j < 16; ++j) oB[j] = act2_ * (h2_t){vb_[2 * j], vb_[2 * j + 1]} + oB[j]; \
        } else { \
            P12_U4(U##S[0].x, hA, 0); P12_U4(U##S[0].y, hA, 4); P12_U4(U##S[0].z, hA, 8); P12_U4(U##S[0].w, hA, 12); \
            P12_U4(U##S[1].x, hB, 0); P12_U4(U##S[1].y, hB, 4); P12_U4(U##S[1].z, hB, 8); P12_U4(U##S[1].w, hB, 12); \
            const float a_ = wave_sum(((a0_ + a1_) + (a2_ + a3_)) * su##S); \
            const float act_ = gelu_fast(a_) * gtl[idx_] * sv##S; const h2_t act2_ = {(_Float16)act_, (_Float16)act_}; \
            P12_V4(V##S[0].x, oA, 0); P12_V4(V##S[0].y, oA, 4); P12_V4(V##S[0].z, oA, 8); P12_V4(V##S[0].w, oA, 12); \
            P12_V4(V##S[1].x, oB, 0); P12_V4(V##S[1].y, oB, 4); P12_V4(V##S[1].z, oB, 8); P12_V4(V##S[1].w, oB, 12); } } while (0)
        P12_LOAD(A, 0, P12_FMT(0)); P12_LOAD(B, 1, P12_FMT(1)); P12_LOAD(C, 2, P12_FMT(2)); P12_LOAD(D, 3, P12_FMT(3));
#pragma unroll 1
        for (int s = 0; s < nb; ++s) {
            const int t = tb + s * tstride;
            if (s + 1 < nb) p12_route(pq + (size_t)(t + tstride) * 2048, tops, topi, exl + (s + 1) * 128, gtl + (s + 1) * 128, lane, ij4);
            unsigned hA[16], hB[16];
            { u32x4 ra[4], rb[4];
#pragma unroll
              for (int i = 0; i < 4; ++i) { ra[i] = *(const u32x4*)(h2 + (size_t)t * D + 16 * lane + 1024 * i); rb[i] = *(const u32x4*)(h2 + (size_t)t * D + 16 * lane + 1024 * i + 8); }
#pragma unroll
              for (int q = 0; q < 4; ++q) {
                  hA[2 * q] = __builtin_amdgcn_perm(ra[1][q], ra[0][q], 0x05040100u); hA[2 * q + 1] = __builtin_amdgcn_perm(ra[1][q], ra[0][q], 0x07060302u);
                  hA[8 + 2 * q] = __builtin_amdgcn_perm(rb[1][q], rb[0][q], 0x05040100u); hA[8 + 2 * q + 1] = __builtin_amdgcn_perm(rb[1][q], rb[0][q], 0x07060302u);
                  hB[2 * q] = __builtin_amdgcn_perm(ra[3][q], ra[2][q], 0x05040100u); hB[2 * q + 1] = __builtin_amdgcn_perm(ra[3][q], ra[2][q], 0x07060302u);
                  hB[8 + 2 * q] = __builtin_amdgcn_perm(rb[3][q], rb[2][q], 0x05040100u); hB[8 + 2 * q + 1] = __builtin_amdgcn_perm(rb[3][q], rb[2][q], 0x07060302u); } }
            h2_t oA[16], oB[16];
#pragma unroll
            for (int j = 0; j < 16; ++j) { oA[j] = (h2_t){(_Float16)0.f, (_Float16)0.f}; oB[j] = (h2_t){(_Float16)0.f, (_Float16)0.f}; }
#pragma unroll 1
            for (int hh = 0; hh < 8; ++hh) {
                const int f0 = s * 128 + hh * 16;
#pragma unroll
                for (int k = 0; k < 16; k += 4) {
                    P12_COMPUTE(A, f0 + k, P12_FMT(k)); P12_LOAD(A, f0 + k + 4, P12_FMT(k + 4));
                    P12_COMPUTE(B, f0 + k + 1, P12_FMT(k + 1)); P12_LOAD(B, f0 + k + 5, P12_FMT(k + 5));
                    P12_COMPUTE(C, f0 + k + 2, P12_FMT(k + 2)); P12_LOAD(C, f0 + k + 6, P12_FMT(k + 6));
                    P12_COMPUTE(D, f0 + k + 3, P12_FMT(k + 3)); P12_LOAD(D, f0 + k + 7, P12_FMT(k + 7));
                }
            }
#pragma unroll
            for (int i = 0; i < 4; ++i) { const int d0 = 16 * lane + 1024 * i; const float* op = C.out + (size_t)t * D + d0; float* dp = dst + (size_t)t * D + d0;
#pragma unroll
                for (int q = 0; q < 4; ++q) { const f32x4 xv = *(const f32x4*)(op + 4 * q); const f32x4 gv = *(const f32x4*)(gt2 + d0 + 4 * q); f32x4 r;
#pragma unroll
                    for (int j = 0; j < 4; ++j) { const h2_t ov = (i < 2) ? oA[4 * q + j] : oB[4 * q + j]; r[j] = xv[j] + gv[j] * ((i & 1) ? (float)ov.y : (float)ov.x); }
                    __builtin_nontemporal_store(r, (f32x4*)(dp + 4 * q)); } }
        }
#undef P12_U4
#undef P12_V4
#undef P12_FMT
#undef P12_LOAD
#undef P12_COMPUTE
        lds_sync();
    }
}

constexpr int N_PHASES = 13;
#ifndef DBG_MIX
#define DBG_MIX 0
#endif
__global__ void __launch_bounds__(NTHREADS, 2) fwd(Args args) {
    extern __shared__ __attribute__((aligned(16))) unsigned char lds_raw[];
    Ctx C0; C0.in = args.in; C0.out = args.out; C0.ws = args.ws; C0.lds = (LAS unsigned char*)lds_raw;
    C0.tid = threadIdx.x; C0.lane = C0.tid & 63; C0.wave = __builtin_amdgcn_readfirstlane(C0.tid >> 6);
#define PHASE_CTX() Ctx C = C0; { int t_ = threadIdx.x; asm volatile("" : "+v"(t_)); C.tid = t_; C.lane = t_ & 63; C.wave = __builtin_amdgcn_readfirstlane(t_ >> 6); }
    const Ctx& C = C0;
    const int lo = args.ph_lo, hi = args.ph_hi;
    const bool fused = (hi - lo) > 1;
    volatile LAS unsigned* bst = (volatile LAS unsigned*)(C.lds + LDS_BYTES - 16);
    XcdBarrier bar; bar.bar = (unsigned*)(C.ws + WS_CTL + CTL_BAR); bar.x = 0; bar.st = bst;
    if (fused) { if (C.tid == 0) { bst[0] = 0u; bst[1] = 0u; bst[2] = 0u; bst[3] = 0u; } __syncthreads(); bar = xcd_barrier_post((unsigned*)(C.ws + WS_CTL + CTL_BAR), bst); }
#ifndef ONLY_PHASE
#define ONLY_PHASE -1
#endif
#define IN(k) (lo <= (k) && (k) < hi && (ONLY_PHASE < 0 || ONLY_PHASE == (k)))
#ifndef REP_PHASE
#define REP_PHASE -1
#endif
#define REP(k, ...) if (REP_PHASE == (k)) { __VA_ARGS__ }
#define SEAM(k) do { if (IN(k) && IN((k) + 1)) xcd_barrier(bar); } while (0)
    const float* mod = (const float*)(C.ws + WS_MOD);
    bf16_t* proj = (bf16_t*)(C.ws + WS_PROJ);
    if (IN(0)) { PHASE_CTX(); REP(0, p0_prologue(C); __syncthreads();) p0_prologue(C); } SEAM(0);
    if (IN(1)) { PHASE_CTX(); norm_mod_phase(C, C.in[I_X], C.in[I_GMIX], mod + 0 * D, mod + 1 * D, (bf16_t*)(C.ws + WS_H), C.ws + WS_H8); } SEAM(1);
    if (IN(2)) { PHASE_CTX(); pg8::Gemm g{(const bf16_t*)(C.ws + WS_H), (const bf16_t*)(C.ws + WS_WIN), T, NP_BF, D, D, D}; pg8::StaticOrder S; S.init(T, NP_BF, gridDim.x, blockIdx.x);
                 pg8::EpiPlain E{proj, NP, 1.f}; pg8::gemm_phase(C.lds, g, S, E);
                 pg8::Gemm g8{(const bf16_t*)(C.ws + WS_H8), (const bf16_t*)(C.ws + WS_WIN8), T, NP_F8, D / 2, D / 2, D / 2}; pg8::Fp8Order S8{(int)blockIdx.x};
                 pg8::EpiSigU8 E8{(unsigned char*)(proj + P_GM), NP * 2, 1.f / 64.f}; pg8::gemm_phase<pg8::EpiSigU8, pg8::Fp8Order, true>(C.lds, g8, S8, E8); } SEAM(2);
    if (IN(3)) { PHASE_CTX(); p3_post(C); } SEAM(3);
    if (IN(4)) { PHASE_CTX(); pg8::Gemm g{(const bf16_t*)(C.ws + WS_KC), (const bf16_t*)(C.ws + WS_W1T), 8192, 512, 512, 2048, D}; pg8::CmpOrder S{(int)gridDim.x, (int)blockIdx.x};
                 pg8::EpiSlab E{(float*)(C.ws + WS_HIDP)}; pg8::gemm_phase(C.lds, g, S, E); } SEAM(4);
    if (IN(5)) { PHASE_CTX(); p5_cmp_out(C); } SEAM(5);
    if (IN(6)) { PHASE_CTX(); p6_mixers(C, DBG_MIX); } SEAM(6);
    if (IN(7)) { PHASE_CTX(); pg8::Gemm g{(const bf16_t*)(C.ws + WS_YA), (const bf16_t*)(C.ws + WS_WBA), T, D, 1024, 1024, 1024};   pg8::StaticOrder S; S.init(T, D, gridDim.x, blockIdx.x);
                 pg8::EpiGate<0> E{(bf16_t*)(C.ws + WS_MERGED), D, (const unsigned char*)(proj + P_GM), NP * 2, 1.f / (16.f * 64.f * 255.f), nullptr}; pg8::gemm_phase<pg8::EpiGate<0>, pg8::StaticOrder, true>(C.lds, g, S, E); } if (IN(7) && IN(8)) __syncthreads();
    if (IN(8)) { PHASE_CTX(); pg8::Gemm g{(const bf16_t*)(C.ws + WS_YB), (const bf16_t*)(C.ws + WS_WBB), T, D, 1024, 1024, 1024}; pg8::StaticOrder S; S.init(T, D, gridDim.x, blockIdx.x);
                 pg8::EpiGate<1> E{(bf16_t*)(C.ws + WS_MERGED), D, (const unsigned char*)(proj + P_GM) + 4096, NP * 2, 1.f / (16.f * 64.f * 255.f), C.ws + WS_H8}; pg8::gemm_phase<pg8::EpiGate<1>, pg8::StaticOrder, true>(C.lds, g, S, E); } SEAM(8);
    if (IN(9)) { PHASE_CTX(); pg8::Gemm g{(const bf16_t*)(C.ws + WS_H8), (const bf16_t*)(C.ws + WS_WOUT), T, D, D / 2, D / 2, D / 2};   pg8::StaticOrder S; S.init(T, D, gridDim.x, blockIdx.x);
                 pg8::EpiResid E{C.out, C.in[I_X], mod + 2 * D, D, 1.f / (32.f * 64.f)}; pg8::gemm_phase<pg8::EpiResid, pg8::StaticOrder, true>(C.lds, g, S, E); } SEAM(9);
    if (IN(10)) { PHASE_CTX(); norm_mod_phase(C, C.out, C.in[I_GFFN], mod + 3 * D, mod + 4 * D, (bf16_t*)(C.ws + WS_H2)); } SEAM(10);
    if (IN(11)) { PHASE_CTX(); pg8::Gemm g{(const bf16_t*)(C.ws + WS_H2), (const bf16_t*)(C.ws + WS_WQ), T, 2048, D, D, D}; pg8::StaticOrder S; S.init(T, 2048, gridDim.x, blockIdx.x);
                  pg8::EpiPlain E{(bf16_t*)(C.ws + WS_PQ), 2048, 1.f}; pg8::gemm_phase(C.lds, g, S, E); } SEAM(11);
    if (IN(12)) { PHASE_CTX(); REP(12, p12_peer(C, (float*)(C.ws + WS_PROJ)); __syncthreads();) p12_peer(C, C.out); }
#undef IN
#undef SEAM
}

#ifndef N_LAUNCH_MODE
#define N_LAUNCH_MODE 1
#endif
extern "C" void kernel_launch(void* const* d_in, const int* in_sizes, int n_in, void* d_out, int out_size, void* d_ws, size_t ws_size, hipStream_t stream) {
    static int grid = 0;
    if (grid == 0) {
        if (n_in != 27 || out_size != T * D || ws_size < WS_END) { fprintf(stderr, "kernel_launch: unexpected shapes (n_in %d out %d ws %zu need %zu)\n", n_in, out_size, ws_size, (size_t)WS_END); grid = -1; return; }
        int dev = 0, cus = 0;
        if (hipGetDevice(&dev) != hipSuccess || hipDeviceGetAttribute(&cus, hipDeviceAttributeMultiprocessorCount, dev) != hipSuccess) { grid = -1; return; }
        if (hipFuncSetAttribute((const void*)fwd, hipFuncAttributeMaxDynamicSharedMemorySize, LDS_BYTES) != hipSuccess) { fprintf(stderr, "kernel_launch: hipFuncSetAttribute failed\n"); grid = -1; return; }
        int per_cu = 0;
        if (hipOccupancyMaxActiveBlocksPerMultiprocessor(&per_cu, (const void*)fwd, NTHREADS, LDS_BYTES) != hipSuccess || per_cu < 1) { fprintf(stderr, "kernel_launch: occupancy query says %d\n", per_cu); }
        (void)hipGetLastError();
        grid = cus;
    }
    if (grid < 0) return;
    (void)hipMemsetAsync((char*)d_ws + WS_CTL, 0, 64 * 1024, stream);
    Args a{};
    for (int i = 0; i < 27; ++i) a.in[i] = (const float*)d_in[i];
    a.out = (float*)d_out; a.ws = (unsigned char*)d_ws;
#if N_LAUNCH_MODE == 1
    a.ph_lo = 0; a.ph_hi = N_PHASES;
    hipLaunchKernelGGL(fwd, dim3(grid), dim3(NTHREADS), LDS_BYTES, stream, a);
#else
    for (int p = 0; p < N_PHASES; ++p) { a.ph_lo = p; a.ph_hi = p + 1; hipLaunchKernelGGL(fwd, dim3(grid), dim3(NTHREADS), LDS_BYTES, stream, a); }
#endif
}
```

```cpp
#include <hip/hip_runtime.h>
#include <cstdio>
#include <cstdint>

#define LAS __attribute__((address_space(3)))
typedef unsigned short bf16_t;
typedef unsigned long long u64;
typedef short bf16x8 __attribute__((ext_vector_type(8)));
typedef float f32x4 __attribute__((ext_vector_type(4)));
typedef float f32x16 __attribute__((ext_vector_type(16)));
typedef unsigned u32x4 __attribute__((ext_vector_type(4)));
typedef unsigned u32x2 __attribute__((ext_vector_type(2)));
typedef __bf16 bf2_t __attribute__((ext_vector_type(2)));
typedef float f32x2 __attribute__((ext_vector_type(2)));
typedef float f32x32 __attribute__((ext_vector_type(32)));
typedef unsigned u32x6 __attribute__((ext_vector_type(6)));
typedef _Float16 hx2_t __attribute__((ext_vector_type(2)));

constexpr int T = 16384, D = 4096, NP = 18688;
constexpr int P_QA = 0, P_KA = 2048, P_VA = 2560, P_QI = 3072, P_QB = 5120, P_KC = 7168, P_VC = 7680, P_KS = 8192, P_VS = 8704,
              P_KW = 9216, P_VW = 9728, P_KI = 10240, P_WI = 10304, P_GB = 10336, P_GM = 10496;
constexpr int NP_BF = 10496, NP_F8 = 8192;
constexpr int NCMP = 1023;
constexpr float EPS = 1e-6f;
constexpr int NTHREADS = 512;
constexpr int LDS_BYTES = 160 * 1024;

constexpr size_t MB = 1024ull * 1024ull;
constexpr size_t WS_CTL = 0;
constexpr size_t WS_MOD = 64 * 1024;
constexpr size_t WS_B1 = 192 * 1024;
constexpr size_t WS_B1P = 196 * 1024;
constexpr size_t WS_W1T = 512 * 1024;
constexpr size_t WS_SUBK = WS_W1T + 4 * MB;
constexpr size_t WS_HID = WS_SUBK + 512 * 1024;
constexpr size_t WS_KCMP = WS_HID + 8 * MB;
constexpr size_t WS_VCMPT = WS_KCMP + 1 * MB;
constexpr size_t WS_KIC = WS_VCMPT + 1 * MB;
constexpr size_t WS_KC = WS_KIC + 2 * MB;
constexpr size_t WS_VST = WS_KC + 32 * MB + 64 * 1024;
constexpr size_t WS_VWT = WS_VST + 16 * MB;
constexpr size_t WS_WBA = WS_VWT + 16 * MB;
constexpr size_t WS_WBB = WS_WBA + 16 * MB;
constexpr size_t WS_WOUT = WS_WBB + 16 * MB;
constexpr size_t WS_WQ = WS_WOUT + 32 * MB;
constexpr size_t WS_PU = WS_WQ + 16 * MB;
constexpr size_t WS_PV = WS_PU + 128 * MB;
constexpr size_t WS_PU4 = WS_PU + 56 * MB, WS_PV4 = WS_PV + 56 * MB;
constexpr size_t WS_PROJ = WS_PV + 128 * MB;
constexpr size_t WS_WIN = WS_PROJ + (size_t)T * NP * 2;
constexpr size_t WS_H = WS_WIN + (size_t)NP * D * 2;
constexpr size_t WS_KA = WS_H + 128 * MB;
constexpr size_t WS_VA = WS_KA + 16 * MB;
constexpr size_t WS_KSC = WS_VA + 16 * MB;
constexpr size_t WS_KWC = WS_KSC + 16 * MB;
constexpr size_t WS_HIDP = WS_KWC + 16 * MB;
constexpr size_t WS_OACC = WS_HIDP + 64 * MB;
constexpr size_t WS_H8 = WS_OACC + 32 * MB;
constexpr size_t WS_END = WS_H8 + 64 * MB;
constexpr size_t WS_WIN8 = WS_WIN + (size_t)NP_BF * D * 2;
constexpr size_t WS_YA = WS_WIN, WS_YB = WS_WIN + 64 * MB, WS_H2 = WS_WIN;
constexpr size_t WS_MERGED = WS_H, WS_PQ = WS_H;
constexpr size_t CTL_BAR = 0, CTL_CNT = 16384;

__device__ __forceinline__ float bf2f(bf16_t b) { return __uint_as_float(((unsigned)b) << 16); }
__device__ __forceinline__ float bflo(unsigned u) { return __uint_as_float(u << 16); }
__device__ __forceinline__ float bfhi(unsigned u) { return __uint_as_float(u & 0xFFFF0000u); }
__device__ __forceinline__ unsigned cvt_pk_bf16(float lo, float hi) { unsigned r; asm volatile("v_cvt_pk_bf16_f32 %0, %1, %2" : "=v"(r) : "v"(lo), "v"(hi)); return r; }
__device__ __forceinline__ bf16_t f2bf(float f) { return (bf16_t)(cvt_pk_bf16(f, 0.f) & 0xFFFFu); }
__device__ __forceinline__ float dot2bf(unsigned a, unsigned b, float c) { return __builtin_amdgcn_fdot2_f32_bf16(__builtin_bit_cast(bf2_t, a), __builtin_bit_cast(bf2_t, b), c, false); }
template <int CTRL> __device__ __forceinline__ float dppf(float v) { return __builtin_bit_cast(float, __builtin_amdgcn_update_dpp(0, __builtin_bit_cast(int, v), CTRL, 0xF, 0xF, true)); }
template <int CTRL> __device__ __forceinline__ unsigned dppu(unsigned v) { return (unsigned)__builtin_amdgcn_update_dpp(0, (int)v, CTRL, 0xF, 0xF, true); }
__device__ __forceinline__ void swap32f(float& a, float& b) { asm volatile("s_nop 1\n\tv_permlane32_swap_b32 %0, %1" : "+v"(a), "+v"(b)); }
__device__ __forceinline__ void swap16f(float& a, float& b) { asm volatile("s_nop 1\n\tv_permlane16_swap_b32 %0, %1" : "+v"(a), "+v"(b)); }
__device__ __forceinline__ void swap32u(unsigned& a, unsigned& b) { asm volatile("s_nop 1\n\tv_permlane32_swap_b32 %0, %1" : "+v"(a), "+v"(b)); }
__device__ __forceinline__ void swap16u(unsigned& a, unsigned& b) { asm volatile("s_nop 1\n\tv_permlane16_swap_b32 %0, %1" : "+v"(a), "+v"(b)); }
__device__ __forceinline__ float fmax_fast(float a, float b) { float r; asm("v_max_f32 %0, %1, %2" : "=v"(r) : "v"(a), "v"(b)); return r; }
__device__ __forceinline__ float xsum32(float v) { float a = v, b = v; swap32f(a, b); return a + b; }
__device__ __forceinline__ float xsum16(float v) { float a = v, b = v; swap16f(a, b); return a + b; }
__device__ __forceinline__ float xmax32(float v) { float a = v, b = v; swap32f(a, b); return fmax_fast(a, b); }
__device__ __forceinline__ float xmax16(float v) { float a = v, b = v; swap16f(a, b); return fmax_fast(a, b); }
__device__ __forceinline__ float xor32f(float v, int h) { float a = v, b = v; swap32f(a, b); return h ? a : b; }
__device__ __forceinline__ float wave_sum(float v) { v += dppf<0xB1>(v); v += dppf<0x4E>(v); v += dppf<0x141>(v); v += dppf<0x140>(v); return xsum16(xsum32(v)); }
__device__ __forceinline__ float wave_max(float v) { v = fmax_fast(v, dppf<0xB1>(v)); v = fmax_fast(v, dppf<0x4E>(v)); v = fmax_fast(v, dppf<0x141>(v)); v = fmax_fast(v, dppf<0x140>(v)); return xmax16(xmax32(v)); }
__device__ __forceinline__ unsigned umaxu(unsigned a, unsigned b) { return a > b ? a : b; }
__device__ __forceinline__ unsigned wave_maxu(unsigned v) { v = umaxu(v, dppu<0xB1>(v)); v = umaxu(v, dppu<0x4E>(v)); v = umaxu(v, dppu<0x141>(v)); v = umaxu(v, dppu<0x140>(v));
    unsigned a = v, b = v; swap32u(a, b); v = umaxu(a, b); a = v; b = v; swap16u(a, b); return umaxu(a, b); }
__device__ __forceinline__ void lds_sync() { asm volatile("s_waitcnt lgkmcnt(0)" ::: "memory"); __builtin_amdgcn_wave_barrier(); }
__device__ __forceinline__ float gelu_tanh(float x) { const float u = 0.7978845608028654f * (x + 0.044715f * x * x * x); const float e = __expf(2.f * u); return 0.5f * x * (2.f - 2.f / (e + 1.f)); }
__device__ __forceinline__ float sigmoidf_(float x) { return __builtin_amdgcn_rcpf(1.f + __expf(-x)); }
__device__ __forceinline__ unsigned sortable(float s) { unsigned b = __float_as_uint(s); return b ^ ((b >> 31) ? 0xFFFFFFFFu : 0x80000000u); }

#define XB_TMO      128
#define XB_XCNT(j)  (256  + 64 * (j))
#define XB_XSUB(j)  (1280 + 64 * (j))
#define XB_XGEN(j)  (2304 + 64 * (j))
#define XB_TOP      3328
#define XB_TOPGEN   3392
#define XCD_BAR_WORDS 3456
#define XB_SPIN_CAP (1u << 24)
__device__ __forceinline__ unsigned xb_ld(unsigned* p)              { return __hip_atomic_load(p, __ATOMIC_RELAXED, __HIP_MEMORY_SCOPE_AGENT); }
__device__ __forceinline__ unsigned xb_add(unsigned* p, unsigned v) { return __hip_atomic_fetch_add(p, v, __ATOMIC_RELAXED, __HIP_MEMORY_SCOPE_AGENT); }
__device__ __forceinline__ unsigned xb_xcc_id() { return (unsigned)__builtin_amdgcn_s_getreg((3 << 11) | 20) & 0xFu; }
#define XB_SPIN(cond, bar) do { unsigned _sp = 0; while (cond) { __builtin_amdgcn_s_sleep(1); \
    if ((++_sp & 255u) == 0u) { if (xb_ld(&(bar)[XB_TMO])) break; if (_sp > XB_SPIN_CAP) { atomicAdd(&(bar)[XB_TMO], 1u); break; } } } } while (0)
struct XcdBarrier { unsigned* bar; unsigned x; volatile LAS unsigned* st; };
__device__ __forceinline__ XcdBarrier xcd_barrier_post(unsigned* bar, volatile LAS unsigned* st) {
    XcdBarrier b; b.bar = bar; b.x = xb_xcc_id(); b.st = st;
    if (threadIdx.x == 0) (void)xb_add(&bar[XB_XCNT(b.x)], 1u);
    return b;
}
__device__ __forceinline__ void xcd_barrier_complete(unsigned* bar, unsigned x, unsigned& nloc, unsigned& nx) {
    const unsigned G = gridDim.x * gridDim.y * gridDim.z;
    unsigned sum, cnt, mine, sp = 0u;
    for (;;) {
        sum = 0u; cnt = 0u; mine = 0u;
#pragma unroll
        for (unsigned j = 0; j < 16; ++j) { const unsigned c = xb_ld(&bar[XB_XCNT(j)]); sum += c; cnt += (c > 0u) ? 1u : 0u; mine = (j == x) ? c : mine; }
        if (sum == G) break;
        __builtin_amdgcn_s_sleep(1);
        if ((++sp & 255u) == 0u) { if (xb_ld(&bar[XB_TMO])) break; if (sp > XB_SPIN_CAP) { atomicAdd(&bar[XB_TMO], 1u); break; } }
    }
    nloc = mine > 0u ? mine : 1u; nx = cnt > 0u ? cnt : 1u;
}
__device__ __forceinline__ void xcd_barrier(const XcdBarrier& b) {
    asm volatile("s_waitcnt vmcnt(0)" ::: "memory");
    __syncthreads();
    if (threadIdx.x == 0) {
        unsigned* bar = b.bar;
        __builtin_amdgcn_s_waitcnt(0);
        unsigned nloc = b.st[0], nx = b.st[1];
        if (nloc == 0u) { xcd_barrier_complete(bar, b.x, nloc, nx); b.st[0] = nloc; b.st[1] = nx; }
        const unsigned old = xb_add(&bar[XB_XSUB(b.x)], 1u);
        const unsigned gen = old / nloc;
        if (old + 1u == (gen + 1u) * nloc) {
            __builtin_amdgcn_fence(__ATOMIC_RELEASE, "agent");
            asm volatile("s_waitcnt vmcnt(0)" ::: "memory");
            const unsigned og = xb_add(&bar[XB_TOP], 1u);
            const unsigned tg = og / nx;
            if (og + 1u == (tg + 1u) * nx) xb_add(&bar[XB_TOPGEN], 1u);
            else XB_SPIN(xb_ld(&bar[XB_TOPGEN]) == tg, bar);
            __builtin_amdgcn_fence(__ATOMIC_ACQUIRE, "agent");
            xb_add(&bar[XB_XGEN(b.x)], 1u);
            asm volatile("s_waitcnt vmcnt(0)" ::: "memory");
        } else {
            XB_SPIN(xb_ld(&bar[XB_XGEN(b.x)]) == gen, bar);
            __builtin_amdgcn_fence(__ATOMIC_ACQUIRE, "agent");
            asm volatile("s_waitcnt vmcnt(0)" ::: "memory");
        }
    }
    __syncthreads();
}

namespace pg8 {
constexpr int BM = 256, BK = 64, HALF = 128, HTB = HALF * BK * 2, STAGE_BYTES = 8 * HTB, NXCD = 8, WGM = 8;
__host__ __device__ __forceinline__ int lds_byte(int r, int c) { const int st = (r >> 4) * 2 + (c >> 5), rr = r & 15, cc = c & 31, ob = rr * 64 + cc * 2; return st * 1024 + (ob ^ (((ob >> 9) & 1) << 5)); }
__host__ __device__ __forceinline__ void stage_rc(int b, int& R, int& C) { const int st = b / 1024, sb = b % 1024, swz = sb ^ (((sb >> 9) & 1) << 5); R = (st >> 1) * 16 + swz / 64; C = (st & 1) * 32 + (swz % 64) / 2; }
__host__ __device__ __forceinline__ int perm32(int rho) { const int n = rho >> 4, i = rho & 15; return 8 * (i >> 2) + 4 * n + (i & 3); }
struct Unit { int pm, pn, kofs; };
struct Gemm { const bf16_t* A; const bf16_t* Bt; int M, N, K, lda, ldb; };
struct StaticOrder {
    int nM, nN, nwg, G, c;
    __host__ __device__ void init(int M, int N, int G_, int c_) { nM = M / BM; nN = N / BM; nwg = nM * nN; G = G_; c = c_; }
    __host__ __device__ bool next(int i, Unit& u) const {
        const long L = (long)i * G + c; if (L >= nwg) return false;
        int wgid = (int)L; { const int q = nwg / NXCD, r = nwg % NXCD, xcd = wgid % NXCD, off = wgid / NXCD; wgid = (xcd < r ? xcd * (q + 1) : r * (q + 1) + (xcd - r) * q) + off; }
        const int nig = WGM * nN, gid = wgid / nig, fm = gid * WGM, gsz = (nM - fm) < WGM ? (nM - fm) : WGM;
        u.pm = fm + ((wgid % nig) % gsz); u.pn = (wgid % nig) / gsz; u.kofs = 0; return true;
    }
};
struct Fp8Order {
    int c;
    __host__ __device__ bool next(int i, Unit& u) const {
        const int cnt = c < 64 ? 6 : (c < 192 ? 9 : 8); if (i >= cnt) return false;
        const int off = c < 64 ? 6 * c : (c < 192 ? 384 + 9 * (c - 64) : 1536 + 8 * (c - 192));
        const int L = off + i; u.pm = L & 63; u.pn = L >> 6; u.kofs = 0; return true; }
};
struct CmpOrder {
    int G, c;
    __host__ __device__ bool next(int i, Unit& u) const { const long L = (long)i * G + c; if (L >= 256) return false; u.pm = (int)(L & 31); u.pn = u.pm >> 4; u.kofs = (int)(L >> 5) * 512; return true; }
};

struct EpiPlain {
    static constexpr bool PERM = true;
    bf16_t* O; int ldc; float scale;
    __device__ __forceinline__ void operator()(const f32x4 (&acc)[2][2][4][2], const Unit& u, int wr, int wc, int fr, int fq) const {
        const int row0 = u.pm * BM + wr * 64 + fr, col0 = u.pn * BM + wc * 32 + 8 * fq;
#pragma unroll
        for (int ai = 0; ai < 2; ++ai)
#pragma unroll
            for (int m = 0; m < 4; ++m) { bf16_t* rowp = O + (size_t)(row0 + ai * HALF + m * 16) * ldc + col0;
#pragma unroll
                for (int bj = 0; bj < 2; ++bj) { const f32x4 v0 = acc[ai][bj][m][0] * scale, v1 = acc[ai][bj][m][1] * scale;
                    u32x4 w; w.x = cvt_pk_bf16(v0[0], v0[1]); w.y = cvt_pk_bf16(v0[2], v0[3]); w.z = cvt_pk_bf16(v1[0], v1[1]); w.w = cvt_pk_bf16(v1[2], v1[3]);
                    *(u32x4*)(rowp + bj * HALF) = w; } }
    }
};
struct EpiSigU8 {
    static constexpr bool PERM = true;
    unsigned char* O; int ldb; float scale;
    __device__ __forceinline__ void operator()(const f32x4 (&acc)[2][2][4][2], const Unit& u, int wr, int wc, int fr, int fq) const {
        const int row0 = u.pm * BM + wr * 64 + fr, col0 = u.pn * BM + wc * 32 + 8 * fq;
#pragma unroll
        for (int ai = 0; ai < 2; ++ai)
#pragma unroll
            for (int m = 0; m < 4; ++m) { unsigned char* rowp = O + (size_t)(row0 + ai * HALF + m * 16) * ldb + col0;
#pragma unroll
                for (int bj = 0; bj < 2; ++bj) { const f32x4 v0 = acc[ai][bj][m][0] * scale, v1 = acc[ai][bj][m][1] * scale;
                    unsigned w0 = 0u, w1 = 0u;
                    w0 = __builtin_amdgcn_cvt_pk_u8_f32(255.f * sigmoidf_(v0[0]), 0, w0); w0 = __builtin_amdgcn_cvt_pk_u8_f32(255.f * sigmoidf_(v0[1]), 1, w0);
                    w0 = __builtin_amdgcn_cvt_pk_u8_f32(255.f * sigmoidf_(v0[2]), 2, w0); w0 = __builtin_amdgcn_cvt_pk_u8_f32(255.f * sigmoidf_(v0[3]), 3, w0);
                    w1 = __builtin_amdgcn_cvt_pk_u8_f32(255.f * sigmoidf_(v1[0]), 0, w1); w1 = __builtin_amdgcn_cvt_pk_u8_f32(255.f * sigmoidf_(v1[1]), 1, w1);
                    w1 = __builtin_amdgcn_cvt_pk_u8_f32(255.f * sigmoidf_(v1[2]), 2, w1); w1 = __builtin_amdgcn_cvt_pk_u8_f32(255.f * sigmoidf_(v1[3]), 3, w1);
                    *(u32x2*)(rowp + bj * HALF) = (u32x2){w0, w1}; } }
    }
};
template <int SECOND> struct EpiGate {
    static constexpr bool PERM = true;
    bf16_t* O; int ldc; const unsigned char* gate; int ldg; float scale; unsigned char* O8;
    __device__ __forceinline__ void operator()(const f32x4 (&acc)[2][2][4][2], const Unit& u, int wr, int wc, int fr, int fq) const {
        const int row0 = u.pm * BM + wr * 64 + fr, col0 = u.pn * BM + wc * 32 + 8 * fq;
#pragma unroll
        for (int ai = 0; ai < 2; ++ai)
#pragma unroll
            for (int m = 0; m < 4; ++m) { const size_t row = (size_t)(row0 + ai * HALF + m * 16); bf16_t* rowp = O + row * ldc + col0; const unsigned char* gp = gate + row * ldg + col0;
#pragma unroll
                for (int bj = 0; bj < 2; ++bj) { const f32x4 v0 = acc[ai][bj][m][0] * scale, v1 = acc[ai][bj][m][1] * scale;
                    const u32x2 gv = *(const u32x2*)(gp + bj * HALF);
                    float r[8];
#pragma unroll
                    for (int e = 0; e < 4; ++e) { r[e] = (float)((gv.x >> (8 * e)) & 0xFFu) * v0[e]; r[4 + e] = (float)((gv.y >> (8 * e)) & 0xFFu) * v1[e]; }
                    if (SECOND) { const u32x4 pv = *(const u32x4*)(rowp + bj * HALF);
                        r[0] += bflo(pv.x); r[1] += bfhi(pv.x); r[2] += bflo(pv.y); r[3] += bfhi(pv.y); r[4] += bflo(pv.z); r[5] += bfhi(pv.z); r[6] += bflo(pv.w); r[7] += bfhi(pv.w);
                        int p0 = __builtin_amdgcn_cvt_pk_fp8_f32(r[0] * 32.f, r[1] * 32.f, 0, false); p0 = __builtin_amdgcn_cvt_pk_fp8_f32(r[2] * 32.f, r[3] * 32.f, p0, true);
                        int p1 = __builtin_amdgcn_cvt_pk_fp8_f32(r[4] * 32.f, r[5] * 32.f, 0, false); p1 = __builtin_amdgcn_cvt_pk_fp8_f32(r[6] * 32.f, r[7] * 32.f, p1, true);
                        *(u32x2*)(O8 + row * ldc + col0 + bj * HALF) = (u32x2){(unsigned)p0, (unsigned)p1};
                    } else {
                    u32x4 w; w.x = cvt_pk_bf16(r[0], r[1]); w.y = cvt_pk_bf16(r[2], r[3]); w.z = cvt_pk_bf16(r[4], r[5]); w.w = cvt_pk_bf16(r[6], r[7]);
                    *(u32x4*)(rowp + bj * HALF) = w; } } }
    }
};
struct EpiResid {
    static constexpr bool PERM = false;
    float* C; const float* X; const float* gt; int ldc; float scale;
    __device__ __forceinline__ void operator()(const f32x4 (&acc)[2][2][4][2], const Unit& u, int wr, int wc, int fr, int fq) const {
        const int row0 = u.pm * BM + wr * 64 + fr, col0 = u.pn * BM + wc * 32 + 4 * fq;
        f32x4 gv[2][2];
#pragma unroll
        for (int bj = 0; bj < 2; ++bj)
#pragma unroll
            for (int n = 0; n < 2; ++n) gv[bj][n] = *(const f32x4*)(gt + col0 + bj * HALF + n * 16) * scale;
#pragma unroll
        for (int ai = 0; ai < 2; ++ai)
#pragma unroll
            for (int m = 0; m < 4; ++m) { const size_t off = (size_t)(row0 + ai * HALF + m * 16) * ldc + col0;
#pragma unroll
                for (int bj = 0; bj < 2; ++bj)
#pragma unroll
                    for (int n = 0; n < 2; ++n) { const f32x4 xv = *(const f32x4*)(X + off + bj * HALF + n * 16);
                        *(f32x4*)(C + off + bj * HALF + n * 16) = xv + gv[bj][n] * acc[ai][bj][m][n]; } }
    }
};
struct EpiSlab {
    static constexpr bool PERM = false;
    float* C;
    __device__ __forceinline__ void operator()(const f32x4 (&acc)[2][2][4][2], const Unit& u, int wr, int wc, int fr, int fq) const {
        const int row0 = u.pm * BM + wr * 64 + fr, col0 = wc * 32 + 4 * fq;
        float* base = C + (size_t)(u.kofs >> 9) * 8192 * 256;
#pragma unroll
        for (int ai = 0; ai < 2; ++ai)
#pragma unroll
            for (int m = 0; m < 4; ++m) { float* rowp = base + (size_t)(row0 + ai * HALF + m * 16) * 256 + col0;
#pragma unroll
                for (int bj = 0; bj < 2; ++bj)
#pragma unroll
                    for (int n = 0; n < 2; ++n) *(f32x4*)(rowp + bj * HALF + n * 16) = acc[ai][bj][m][n]; }
    }
};

typedef int i32x8 __attribute__((ext_vector_type(8)));
template <class Epi, class Sched, bool FP8 = false>
__device__ __forceinline__ void gemm_phase(LAS unsigned char* lds, const Gemm g, const Sched& S, const Epi& E) {
    const int tid = threadIdx.x, wid = __builtin_amdgcn_readfirstlane(tid >> 6), lane = tid & 63, wr = wid >> 2, wc = wid & 3, fr = lane & 15, fq = lane >> 4;
    const int K = g.K, nt = K / BK, lda = g.lda, ldb = g.ldb;
    unsigned voffA[2], voffB[2];
#pragma unroll
    for (int i = 0; i < 2; ++i) { int R, C; stage_rc(tid * 16 + i * 8192, R, C); const int Rb = Epi::PERM ? ((R & ~31) + perm32(R & 31)) : R;
        voffA[i] = (unsigned)(R * lda + C) * 2u; voffB[i] = (unsigned)(Rb * ldb + C) * 2u; }
    const size_t kstep = (size_t)(BK * 2);
    const size_t hstepA = (size_t)HALF * lda * 2, hstepB = (size_t)HALF * ldb * 2;
    const size_t tstepA = 2 * hstepA, tstepB = 2 * hstepB;
    const unsigned ldsw = (unsigned)wid * 1024u;
    const int aoff = lds_byte(wr * 64 + fr, fq * 8), boff = lds_byte(wc * 32 + fr, fq * 8);
#define PG8_SA(b, h) (((b) * 2 + (h)) * HTB)
#define PG8_SB(b, h) ((4 + (b) * 2 + (h)) * HTB)
#define PG8_STAGE(bufoff, gbase, voff) do { _Pragma("unroll") for (int _i = 0; _i < 2; ++_i) \
        __builtin_amdgcn_global_load_lds((const unsigned*)((const char*)(gbase) + (voff)[_i]), (LAS unsigned*)(lds + (bufoff) + ldsw + _i * 8192), 16, 0, 0); } while (0)
#define PG8_LDA(dst, b, h) do { _Pragma("unroll") for (int m = 0; m < 4; ++m) { if constexpr (FP8) dst##8[m] = __builtin_shufflevector(*(const LAS i32x4_*)(lds + PG8_SA(b, h) + aoff + m * 2048), *(const LAS i32x4_*)(lds + PG8_SA(b, h) + aoff + m * 2048 + 1024), 0, 1, 2, 3, 4, 5, 6, 7); \
        else { _Pragma("unroll") for (int k = 0; k < 2; ++k) dst[m][k] = *(const LAS bf16x8*)(lds + PG8_SA(b, h) + aoff + m * 2048 + k * 1024); } } } while (0)
#define PG8_LDB(dst, b, h) do { _Pragma("unroll") for (int n = 0; n < 2; ++n) { if constexpr (FP8) dst##8[n] = __builtin_shufflevector(*(const LAS i32x4_*)(lds + PG8_SB(b, h) + boff + n * 2048), *(const LAS i32x4_*)(lds + PG8_SB(b, h) + boff + n * 2048 + 1024), 0, 1, 2, 3, 4, 5, 6, 7); \
        else { _Pragma("unroll") for (int k = 0; k < 2; ++k) dst[n][k] = *(const LAS bf16x8*)(lds + PG8_SB(b, h) + boff + n * 2048 + k * 1024); } } } while (0)
typedef int i32x4_ __attribute__((ext_vector_type(4)));
#define PG8_MMA(ai, bj, At, Bt) do { __builtin_amdgcn_s_setprio(1); _Pragma("unroll") for (int m = 0; m < 4; ++m) _Pragma("unroll") for (int n = 0; n < 2; ++n) { \
        if constexpr (FP8) asm volatile("v_mfma_scale_f32_16x16x128_f8f6f4 %0, %1, %2, %0, %3, %3 op_sel_hi:[0,0,0]" : "+v"(acc[ai][bj][m][n]) : "v"(Bt##8[n]), "v"(At##8[m]), "v"(one_scale)); \
        else { _Pragma("unroll") for (int k = 0; k < 2; ++k) acc[ai][bj][m][n] = __builtin_amdgcn_mfma_f32_16x16x32_bf16(Bt[n][k], At[m][k], acc[ai][bj][m][n], 0, 0, 0); } } \
        __builtin_amdgcn_s_setprio(0); } while (0)
#define PG8_WAIT_V(n) asm volatile("s_waitcnt vmcnt(" #n ")" ::: "memory")
#define PG8_WAIT_L(n) asm volatile("s_waitcnt lgkmcnt(" #n ")" ::: "memory")
#define PG8_BAR __builtin_amdgcn_s_barrier()
#define PG8_SCHED __builtin_amdgcn_sched_barrier(0)
    Unit cur, nxt; int ui = 0;
    if (!S.next(0, cur)) return;
    f32x4 acc[2][2][4][2];
#pragma unroll
    for (int a = 0; a < 2; ++a)
#pragma unroll
        for (int b = 0; b < 2; ++b)
#pragma unroll
            for (int m = 0; m < 4; ++m)
#pragma unroll
                for (int n = 0; n < 2; ++n) acc[a][b][m][n] = (f32x4){0.f, 0.f, 0.f, 0.f};
    bf16x8 At[4][2], B0[2][2], B1[2][2];
    i32x8 At8[4], B08[2], B18[2];
    const int one_scale = 0x7F7F7F7F;
    const char* cA = (const char*)g.A + (size_t)cur.pm * tstepA + (size_t)cur.kofs * 2; const char* cB = (const char*)g.Bt + (size_t)cur.pn * tstepB + (size_t)cur.kofs * 2;
    PG8_STAGE(PG8_SB(0, 0), cB, voffB); PG8_STAGE(PG8_SB(0, 1), cB + hstepB, voffB); PG8_STAGE(PG8_SA(0, 0), cA, voffA); PG8_STAGE(PG8_SA(0, 1), cA + hstepA, voffA);
    if (wr == 1) PG8_BAR;
    PG8_WAIT_V(2); PG8_BAR;
    PG8_STAGE(PG8_SB(1, 0), cB + kstep, voffB); PG8_STAGE(PG8_SA(1, 0), cA + kstep, voffA); PG8_STAGE(PG8_SB(1, 1), cB + hstepB + kstep, voffB);
    PG8_WAIT_V(6); PG8_BAR;
    for (;;) {
        const bool has_next = S.next(ui + 1, nxt);
        const char* nA = has_next ? (const char*)g.A + (size_t)nxt.pm * tstepA + (size_t)nxt.kofs * 2 : cA; const char* nB = has_next ? (const char*)g.Bt + (size_t)nxt.pn * tstepB + (size_t)nxt.kofs * 2 : cB;
        for (int t = 0; t < nt; t += 2) {
            const bool last = (t == nt - 2);
            const char* a1 = cA + (size_t)(t + 1) * kstep;
            const char* a2 = last ? nA : cA + (size_t)(t + 2) * kstep; const char* b2 = last ? nB : cB + (size_t)(t + 2) * kstep;
            const char* a3 = a2 + kstep; const char* b3 = b2 + kstep;
            PG8_LDB(B0, 0, 0); PG8_LDB(B1, 0, 1); PG8_SCHED; PG8_LDA(At, 0, 0); PG8_STAGE(PG8_SA(1, 1), a1 + hstepA, voffA);
            PG8_WAIT_V(8); PG8_WAIT_L(0); PG8_BAR; PG8_MMA(0, 0, At, B0); PG8_MMA(0, 1, At, B1); PG8_BAR; PG8_SCHED;
            PG8_LDA(At, 0, 1); PG8_STAGE(PG8_SB(0, 0), b2, voffB); PG8_STAGE(PG8_SB(0, 1), b2 + hstepB, voffB); PG8_STAGE(PG8_SA(0, 0), a2, voffA);
            PG8_WAIT_V(8); PG8_WAIT_L(0); PG8_BAR; PG8_MMA(1, 0, At, B0); PG8_MMA(1, 1, At, B1); PG8_BAR; PG8_SCHED;
            PG8_LDB(B0, 1, 0); PG8_LDB(B1, 1, 1); PG8_SCHED; PG8_LDA(At, 1, 0); PG8_STAGE(PG8_SA(0, 1), a2 + hstepA, voffA);
            PG8_WAIT_V(8); PG8_WAIT_L(0); PG8_BAR; PG8_MMA(0, 0, At, B0); PG8_MMA(0, 1, At, B1); PG8_BAR; PG8_SCHED;
            PG8_LDA(At, 1, 1); PG8_STAGE(PG8_SB(1, 0), b3, voffB); PG8_STAGE(PG8_SB(1, 1), b3 + hstepB, voffB); PG8_STAGE(PG8_SA(1, 0), a3, voffA);
            PG8_WAIT_V(8); PG8_WAIT_L(0); PG8_BAR; PG8_MMA(1, 0, At, B0); PG8_MMA(1, 1, At, B1); PG8_BAR; PG8_SCHED;
        }
        if (wr == 0) PG8_BAR;
        if constexpr (FP8) asm volatile("s_nop 15\n\ts_nop 15\n\ts_nop 15" ::: "memory");
        E(acc, cur, wr, wc, fr, fq);
        if (!has_next) break;
#pragma unroll
        for (int a = 0; a < 2; ++a)
#pragma unroll
            for (int b = 0; b < 2; ++b)
#pragma unroll
                for (int m = 0; m < 4; ++m)
#pragma unroll
                    for (int n = 0; n < 2; ++n) acc[a][b][m][n] = (f32x4){0.f, 0.f, 0.f, 0.f};
        cur = nxt; cA = nA; cB = nB; ++ui;
        if (wr == 1) PG8_BAR;
    }
    PG8_WAIT_V(0);
    PG8_BAR;
#undef PG8_SA
#undef PG8_SB
#undef PG8_STAGE
#undef PG8_LDA
#undef PG8_LDB
#undef PG8_MMA
#undef PG8_WAIT_V
#undef PG8_WAIT_L
#undef PG8_BAR
#undef PG8_SCHED
}
}

struct Args { const float* in[27]; float* out; unsigned char* ws; int ph_lo, ph_hi; };
struct Ctx { const float* const* in; float* out; unsigned char* ws; LAS unsigned char* lds; int tid, lane, wave; };

enum { I_X = 0, I_C, I_RELB, I_WADA, I_BADA, I_GMIX, I_WIN, I_GQA, I_GKA, I_GQB, I_GKCMP, I_GKSLC, I_GKWIN, I_PEK, I_W1K, I_W2K, I_PEV, I_W1V, I_W2V,
       I_WBA, I_WBB, I_WOUT, I_GFFN, I_WPQ, I_SUBK, I_PU, I_PV };

__device__ __forceinline__ int map_col(int c) {
    if (c < 5120) return c; if (c < 10240) return c + 96; if (c < 10336) return c - 5120; if (c < 10384) return c; if (c < 10496) return -1; return c - 112;
}

template <bool REMAP>
__device__ __forceinline__ void tconv_tile(const Ctx& C, const float* src, int srcN, bf16_t* dst, int dstK, int n0, int k0) {
    LAS float* tile = (LAS float*)C.lds;
    const int tx = C.tid & 31, ty = C.tid >> 5;
    const int nn = n0 + 4 * tx; const int sc = REMAP ? map_col(nn) : nn;
    f32x4 v[8];
#pragma unroll
    for (int i = 0; i < 8; ++i) { const int k = ty + 16 * i; v[i] = (sc >= 0) ? *(const f32x4*)(src + (size_t)(k0 + k) * srcN + sc) : (f32x4){0.f, 0.f, 0.f, 0.f}; }
#pragma unroll
    for (int i = 0; i < 8; ++i) { const int k = ty + 16 * i; LAS float* q = tile + k * 129 + 4 * tx; q[0] = v[i][0]; q[1] = v[i][1]; q[2] = v[i][2]; q[3] = v[i][3]; }
    __syncthreads();
#pragma unroll
    for (int i = 0; i < 4; ++i) { const int task = C.tid + 512 * i; const int nl = task >> 4, kc = task & 15;
        float e[8];
#pragma unroll
        for (int j = 0; j < 8; ++j) e[j] = tile[(kc * 8 + j) * 129 + nl];
        u32x4 w; w.x = cvt_pk_bf16(e[0], e[1]); w.y = cvt_pk_bf16(e[2], e[3]); w.z = cvt_pk_bf16(e[4], e[5]); w.w = cvt_pk_bf16(e[6], e[7]);
        *(u32x4*)(dst + (size_t)(n0 + nl) * dstK + k0 + kc * 8) = w; }
    __syncthreads();
}

template <bool REMAP>
__device__ __forceinline__ void tconv_tile_f8(const Ctx& C, const float* src, int srcN, unsigned char* dst, int dstK, int n0, int k0) {
    LAS float* tile = (LAS float*)C.lds;
    const int tx = C.tid & 31, ty = C.tid >> 5;
    const int nn = n0 + 4 * tx; const int sc = REMAP ? map_col(nn) : nn;
    f32x4 v[8];
#pragma unroll
    for (int i = 0; i < 8; ++i) { const int k = ty + 16 * i; v[i] = (sc >= 0) ? *(const f32x4*)(src + (size_t)(k0 + k) * srcN + sc) : (f32x4){0.f, 0.f, 0.f, 0.f}; }
#pragma unroll
    for (int i = 0; i < 8; ++i) { const int k = ty + 16 * i; LAS float* q = tile + k * 129 + 4 * tx; q[0] = v[i][0]; q[1] = v[i][1]; q[2] = v[i][2]; q[3] = v[i][3]; }
    __syncthreads();
#pragma unroll
    for (int i = 0; i < 2; ++i) { const int task = C.tid + 512 * i; const int nl = task >> 3, kc = task & 7;
        float e[16];
#pragma unroll
        for (int j = 0; j < 16; ++j) e[j] = tile[(kc * 16 + j) * 129 + nl] * 64.f;
        u32x4 w;
#pragma unroll
        for (int q4 = 0; q4 < 4; ++q4) { int p = __builtin_amdgcn_cvt_pk_fp8_f32(e[4 * q4], e[4 * q4 + 1], 0, false); p = __builtin_amdgcn_cvt_pk_fp8_f32(e[4 * q4 + 2], e[4 * q4 + 3], p, true); w[q4] = (unsigned)p; }
        *(u32x4*)(dst + (size_t)(n0 + nl) * dstK + k0 + kc * 16) = w; }
    __syncthreads();
}

__device__ __forceinline__ void wq_subkey_tile(const Ctx& C, int blk, int k0) {
    LAS float* As = (LAS float*)C.lds;
    LAS float* Bs = As + 128 * 132;
    const int tid = C.tid;
    const float* sk = C.in[I_SUBK] + (size_t)blk * 128 * 128; const float* wq = C.in[I_WPQ] + (size_t)k0 * 2048 + blk * 128;
#pragma unroll
    for (int i = 0; i < 8; ++i) { const int idx = tid + 512 * i, r = idx >> 5, c4 = idx & 31;
        const f32x4 a = *(const f32x4*)(sk + (size_t)r * 128 + 4 * c4), b = *(const f32x4*)(wq + (size_t)r * 2048 + 4 * c4);
        *(LAS f32x4*)(As + r * 132 + 4 * c4) = a; *(LAS f32x4*)(Bs + r * 132 + 4 * c4) = b; }
    __syncthreads();
    const int tn = tid >> 4, tk = tid & 15;
    float acc[4][8];
#pragma unroll
    for (int i = 0; i < 4; ++i)
#pragma unroll
        for (int j = 0; j < 8; ++j) acc[i][j] = 0.f;
#pragma unroll 2
    for (int d4 = 0; d4 < 32; ++d4) {
        f32x4 a[4], b[8];
#pragma unroll
        for (int i = 0; i < 4; ++i) a[i] = *(LAS const f32x4*)(As + (4 * tn + i) * 132 + 4 * d4);
#pragma unroll
        for (int j = 0; j < 8; ++j) b[j] = *(LAS const f32x4*)(Bs + (2 * tk + 32 * (j >> 1) + (j & 1)) * 132 + 4 * d4);
#pragma unroll
        for (int i = 0; i < 4; ++i)
#pragma unroll
            for (int j = 0; j < 8; ++j) acc[i][j] += a[i][0] * b[j][0] + a[i][1] * b[j][1] + a[i][2] * b[j][2] + a[i][3] * b[j][3];
    }
    bf16_t* dst = (bf16_t*)(C.ws + WS_WQ) + (size_t)(blk * 128 + 4 * tn) * 4096 + k0 + 2 * tk;
#pragma unroll
    for (int i = 0; i < 4; ++i)
#pragma unroll
        for (int j = 0; j < 4; ++j) *(unsigned*)(dst + (size_t)i * 4096 + 32 * j) = cvt_pk_bf16(acc[i][2 * j], acc[i][2 * j + 1]);
    __syncthreads();
}

__device__ __forceinline__ void peer_row_convert(const Ctx& C, int grow, int lane) {
            const bool second = grow >= 16384; const int row = grow & 16383;
            const float* src = C.in[second ? I_PV : I_PU] + (size_t)row * 4096;
            unsigned char* dst6 = C.ws + (second ? WS_PV : WS_PU) + (size_t)row * 3072;
            f32x16 v[4]; float am = 0.f;
#pragma unroll
            for (int i4 = 0; i4 < 4; ++i4)
#pragma unroll
                for (int q = 0; q < 4; ++q) { const f32x4 t4 = *(const f32x4*)(src + 16 * (lane + 64 * i4) + 4 * q);
                    v[i4][4 * q] = t4[0]; v[i4][4 * q + 1] = t4[1]; v[i4][4 * q + 2] = t4[2]; v[i4][4 * q + 3] = t4[3];
                    am = fmaxf(am, fmaxf(fmaxf(fabsf(t4[0]), fabsf(t4[1])), fmaxf(fabsf(t4[2]), fabsf(t4[3])))); }
            am = wave_max(am);
            const float sc = am > 0.f ? am * (1.f / 7.f) : 1.f, inv = 1.f / sc;
#pragma unroll
            for (int i4 = 0; i4 < 4; ++i4) v[i4] *= inv;
            const u32x6 pa = __builtin_amdgcn_cvt_scalef32_2xpk16_fp6_f32(v[0], v[1], 1.0f), pb = __builtin_amdgcn_cvt_scalef32_2xpk16_fp6_f32(v[2], v[3], 1.0f);
            *(u32x4*)(dst6 + 16 * lane) = (u32x4){pa[0], pa[1], pa[2], pa[3]};
            *(u32x4*)(dst6 + 1024 + 16 * lane) = (u32x4){pa[4], pa[5], pb[0], pb[1]};
            *(u32x4*)(dst6 + 2048 + 16 * lane) = (u32x4){pb[2], pb[3], pb[4], pb[5]};
            ((float*)(C.ws + (second ? WS_PV : WS_PU) + 96 * MB))[row] = sc;
            { float al = 0.f;
#pragma unroll
              for (int i4 = 0; i4 < 4; ++i4)
#pragma unroll
                  for (int j = 0; j < 16; ++j) al = fmaxf(al, fabsf(v[i4][j]));
              const float s4 = al > 0.f ? al * (1.f / 6.f) : 1.f, inv4 = 1.f / s4;
              unsigned wa[4] = {0u, 0u, 0u, 0u}, wb[4] = {0u, 0u, 0u, 0u};
#define PK4(d_) do { wa[d_] = __builtin_amdgcn_cvt_scalef32_pk_fp4_f32(wa[d_], v[0][4 * (d_)] * inv4, v[1][4 * (d_)] * inv4, 1.0f, 0); wa[d_] = __builtin_amdgcn_cvt_scalef32_pk_fp4_f32(wa[d_], v[0][4 * (d_) + 1] * inv4, v[1][4 * (d_) + 1] * inv4, 1.0f, 1); \
                     wa[d_] = __builtin_amdgcn_cvt_scalef32_pk_fp4_f32(wa[d_], v[0][4 * (d_) + 2] * inv4, v[1][4 * (d_) + 2] * inv4, 1.0f, 2); wa[d_] = __builtin_amdgcn_cvt_scalef32_pk_fp4_f32(wa[d_], v[0][4 * (d_) + 3] * inv4, v[1][4 * (d_) + 3] * inv4, 1.0f, 3); \
                     wb[d_] = __builtin_amdgcn_cvt_scalef32_pk_fp4_f32(wb[d_], v[2][4 * (d_)] * inv4, v[3][4 * (d_)] * inv4, 1.0f, 0); wb[d_] = __builtin_amdgcn_cvt_scalef32_pk_fp4_f32(wb[d_], v[2][4 * (d_) + 1] * inv4, v[3][4 * (d_) + 1] * inv4, 1.0f, 1); \
                     wb[d_] = __builtin_amdgcn_cvt_scalef32_pk_fp4_f32(wb[d_], v[2][4 * (d_) + 2] * inv4, v[3][4 * (d_) + 2] * inv4, 1.0f, 2); wb[d_] = __builtin_amdgcn_cvt_scalef32_pk_fp4_f32(wb[d_], v[2][4 * (d_) + 3] * inv4, v[3][4 * (d_) + 3] * inv4, 1.0f, 3); } while (0)
              PK4(0); PK4(1); PK4(2); PK4(3);
#undef PK4
              unsigned char* dst4 = C.ws + (second ? WS_PV4 : WS_PU4) + (size_t)row * 2176;
              *(u32x4*)(dst4 + 16 * lane) = (u32x4){wa[0], wa[1], wa[2], wa[3]};
              *(u32x4*)(dst4 + 1024 + 16 * lane) = (u32x4){wb[0], wb[1], wb[2], wb[3]};
              *(bf16_t*)(dst4 + 2048 + 2 * lane) = f2bf(sc * s4); }

}

__device__ __forceinline__ void p0_prologue(const Ctx& C) {
    constexpr int N_MOD = 256, N_WIN = (NP / 128) * (D / 128), N_W1 = 2 * 32, N_B1 = 64;
    constexpr int E0 = N_MOD, E1 = E0 + N_B1, E2 = E1 + N_WIN, E7 = E2 + N_W1, E8 = E7 + N_W1, E11 = E8;
    const int tid = C.tid;
    for (int it = blockIdx.x; it < E11; it += gridDim.x) {
        if (it < E0) {
            const int b = it; LAS float* red = (LAS float*)C.lds;
            const float* cvec = C.in[I_C]; const float* w = C.in[I_WADA];
            if (tid < 504) { const int cg = tid % 24, rs = tid / 24;
                f32x4 acc = {0.f, 0.f, 0.f, 0.f};
                const float* wp = w + 96 * b + 4 * cg;
#pragma unroll 4
                for (int k = rs; k < D; k += 21) { const float cv = cvec[k]; const f32x4 wv = *(const f32x4*)(wp + (size_t)k * 24576); acc += cv * wv; }
                *(LAS f32x4*)(red + (rs * 24 + cg) * 4) = acc; }
            __syncthreads();
            if (tid < 24) { f32x4 s = *(const f32x4*)(C.in[I_BADA] + 96 * b + 4 * tid);
                for (int rs = 0; rs < 21; ++rs) s += *(LAS f32x4*)(red + (rs * 24 + tid) * 4);
                *(f32x4*)((float*)(C.ws + WS_MOD) + 96 * b + 4 * tid) = s; }
            __syncthreads();
        } else if (it < E1) {
            const int s = (it - E0) >> 5, sl = (it - E0) & 31; const float* pe = C.in[s ? I_PEV : I_PEK]; const float* w1 = C.in[s ? I_W1V : I_W1K];
            const int e = tid & 255, half = tid >> 8; float a = 0.f;
            const int kb = sl * 128 + half * 64;
#pragma unroll 16
            for (int k = kb; k < kb + 64; ++k) a += pe[k] * w1[(size_t)k * 256 + e];
            LAS float* red = (LAS float*)C.lds; red[tid] = a; __syncthreads();
            if (tid < 256) ((float*)(C.ws + WS_B1P))[(s * 32 + sl) * 256 + tid] = red[tid] + red[tid + 256];
            __syncthreads();
        } else if (it < E2) { const int i = it - E1; const int n0 = (i / 32) * 128, k0 = (i % 32) * 128;
            if (n0 < NP_BF) tconv_tile<true>(C, C.in[I_WIN], 18576, (bf16_t*)(C.ws + WS_WIN), D, n0, k0);
            else tconv_tile_f8<true>(C, C.in[I_WIN], 18576, C.ws + WS_WIN8 - (size_t)NP_BF * D, D, n0, k0);
        } else if (it < E7) { const int i = it - E2; tconv_tile<false>(C, C.in[I_W1K], 256, (bf16_t*)(C.ws + WS_W1T), 4096, (i / 32) * 128, (i % 32) * 128);
        } else if (it < E8) { const int i = it - E7; tconv_tile<false>(C, C.in[I_W1V], 256, (bf16_t*)(C.ws + WS_W1T) + (size_t)256 * 4096, 4096, (i / 32) * 128, (i % 32) * 128);
        }
    }
}

__device__ __forceinline__ void norm_mod_phase(const Ctx& C, const float* xin, const float* gain, const float* sh, const float* sc, bf16_t* hout, unsigned char* h8out = nullptr) {
    LAS float* la = (LAS float*)C.lds; LAS float* lb = la + D;
    for (int i = C.tid; i < D / 4; i += NTHREADS) { const f32x4 g4 = *(const f32x4*)(gain + 4 * i), s4 = *(const f32x4*)(sc + 4 * i), h4 = *(const f32x4*)(sh + 4 * i);
        *(LAS f32x4*)(la + 4 * i) = g4 * (s4 + 1.f); *(LAS f32x4*)(lb + 4 * i) = h4; }
    __syncthreads();
    const int rstep = gridDim.x * 8;
    int row = blockIdx.x * 8 + C.wave;
    f32x4 v[16], vn[16];
    if (row < T) {
#pragma unroll
        for (int i = 0; i < 16; ++i) v[i] = ((const f32x4*)(xin + (size_t)row * D))[C.lane + 64 * i]; }
#pragma unroll 1
    for (; row < T; row += rstep) {
        const int nrow = row + rstep;
        if (nrow < T) {
#pragma unroll
            for (int i = 0; i < 16; ++i) vn[i] = ((const f32x4*)(xin + (size_t)nrow * D))[C.lane + 64 * i]; }
        float ss = 0.f;
#pragma unroll
        for (int i = 0; i < 16; ++i) ss += v[i][0] * v[i][0] + v[i][1] * v[i][1] + v[i][2] * v[i][2] + v[i][3] * v[i][3];
        ss = wave_sum(ss);
        const float rstd = rsqrtf(ss * (1.f / 4096.f) + EPS);
#pragma unroll
        for (int i = 0; i < 16; ++i) { const int col = 4 * (C.lane + 64 * i);
            const f32x4 a4 = *(LAS const f32x4*)(la + col), b4 = *(LAS const f32x4*)(lb + col);
            float y[4];
#pragma unroll
            for (int j = 0; j < 4; ++j) y[j] = v[i][j] * rstd * a4[j] + b4[j];
            u32x2 w; w.x = cvt_pk_bf16(y[0], y[1]); w.y = cvt_pk_bf16(y[2], y[3]);
            *(u32x2*)(hout + (size_t)row * D + col) = w;
            if (h8out) { int p = __builtin_amdgcn_cvt_pk_fp8_f32(y[0], y[1], 0, false); p = __builtin_amdgcn_cvt_pk_fp8_f32(y[2], y[3], p, true); *(unsigned*)(h8out + (size_t)row * D + col) = (unsigned)p; } }
#pragma unroll
        for (int i = 0; i < 16; ++i) v[i] = vn[i];
    }
    __syncthreads();
}

__device__ __forceinline__ void p3_post(const Ctx& C) {
    bf16_t* proj = (bf16_t*)(C.ws + WS_PROJ);
    const int tid = C.tid;
    const float qscale = 0.08838834764831845f;
    if (blockIdx.x == 0) { float a = 0.f; const float* part = (const float*)(C.ws + WS_B1P) + (size_t)(tid >> 8) * 32 * 256 + (tid & 255);
        for (int sl = 0; sl < 32; ++sl) a += part[sl * 256]; ((float*)(C.ws + WS_B1))[tid] = a; }
    for (int item = blockIdx.x; item < T / 64; item += gridDim.x) {
        const int t0 = item * 64;
#pragma unroll 1
        for (int hb = tid >> 4; hb < 64 * 44; hb += 128) {
            const int l16 = tid & 15;
            u32x4 raw[4]; bf16_t* dstp[4]; const float* gain[4]; float scl[4]; bool isk8[4];
#pragma unroll
            for (int u = 0; u < 4; ++u) { const int hr = hb + 32 * u; const int tok = hr / 44, hh = hr % 44; int col; isk8[u] = (hh >= 16 && hh < 20);
                if (hh < 16) { col = P_QA + 128 * hh; gain[u] = C.in[I_GQA]; scl[u] = qscale; dstp[u] = proj + (size_t)(t0 + tok) * NP + col; }
                else if (hh < 20) { col = P_KA + 128 * (hh - 16); gain[u] = C.in[I_GKA]; scl[u] = 1.f; dstp[u] = (bf16_t*)(C.ws + WS_KA + (size_t)(t0 + tok) * 512 + 128 * (hh - 16)); }
                else if (hh < 36) { col = P_QB + 128 * (hh - 20); gain[u] = C.in[I_GQB]; scl[u] = qscale * 1.4426950408889634f; dstp[u] = proj + (size_t)(t0 + tok) * NP + col; }
                else if (hh < 40) { col = P_KS + 128 * (hh - 36); gain[u] = C.in[I_GKSLC]; scl[u] = 1.f; dstp[u] = (bf16_t*)(C.ws + WS_KSC) + ((size_t)(hh - 36) * T + t0 + tok) * 128; }
                else { col = P_KW + 128 * (hh - 40); gain[u] = C.in[I_GKWIN]; scl[u] = 1.f; dstp[u] = (bf16_t*)(C.ws + WS_KWC) + ((size_t)(hh - 40) * T + t0 + tok) * 128; }
                raw[u] = *(const u32x4*)(proj + (size_t)(t0 + tok) * NP + col + 8 * l16); }
#pragma unroll
            for (int u = 0; u < 4; ++u) {
                float v[8] = {bflo(raw[u].x), bfhi(raw[u].x), bflo(raw[u].y), bfhi(raw[u].y), bflo(raw[u].z), bfhi(raw[u].z), bflo(raw[u].w), bfhi(raw[u].w)};
                float ss = 0.f;
#pragma unroll
                for (int j = 0; j < 8; ++j) ss += v[j] * v[j];
                ss += dppf<0xB1>(ss); ss += dppf<0x4E>(ss); ss += dppf<0x141>(ss); ss += dppf<0x140>(ss);
                const float rstd = rsqrtf(ss * (1.f / 128.f) + EPS) * scl[u];
                const f32x4 g0 = *(const f32x4*)(gain[u] + 8 * l16), g1 = *(const f32x4*)(gain[u] + 8 * l16 + 4);
                if (isk8[u]) {
                    const float r8 = rstd * 64.f;
                    int p0 = __builtin_amdgcn_cvt_pk_fp8_f32(v[0] * r8 * g0[0], v[1] * r8 * g0[1], 0, false); p0 = __builtin_amdgcn_cvt_pk_fp8_f32(v[2] * r8 * g0[2], v[3] * r8 * g0[3], p0, true);
                    int p1 = __builtin_amdgcn_cvt_pk_fp8_f32(v[4] * r8 * g1[0], v[5] * r8 * g1[1], 0, false); p1 = __builtin_amdgcn_cvt_pk_fp8_f32(v[6] * r8 * g1[2], v[7] * r8 * g1[3], p1, true);
                    *(u32x2*)((unsigned char*)dstp[u] + 8 * l16) = (u32x2){(unsigned)p0, (unsigned)p1};
                } else {
                u32x4 w; w.x = cvt_pk_bf16(v[0] * rstd * g0[0], v[1] * rstd * g0[1]); w.y = cvt_pk_bf16(v[2] * rstd * g0[2], v[3] * rstd * g0[3]);
                w.z = cvt_pk_bf16(v[4] * rstd * g1[0], v[5] * rstd * g1[1]); w.w = cvt_pk_bf16(v[6] * rstd * g1[2], v[7] * rstd * g1[3]);
                *(u32x4*)(dstp[u] + 8 * l16) = w; } }
        }
        bf16_t* Kc = (bf16_t*)(C.ws + WS_KC); bf16_t* Vc = Kc + (size_t)4 * T * 128;
#pragma unroll
        for (int i = 0; i < 8; ++i) { const int idx = tid + 512 * i, tok = idx >> 6, c16 = idx & 63, g = c16 >> 4, d8 = c16 & 15;
            const bf16_t* src = proj + (size_t)(t0 + tok) * NP + 8 * c16;
            const size_t dof = ((size_t)g * T + t0 + tok) * 128 + 8 * d8;
            *(u32x4*)(Kc + dof) = *(const u32x4*)(src + P_KC);
            *(u32x4*)(Vc + dof) = *(const u32x4*)(src + P_VC);
            { const u32x4 rv = *(const u32x4*)(src + P_VA);
              u32x4 w;
              w.x = __builtin_bit_cast(unsigned, __builtin_amdgcn_cvt_pkrtz(bflo(rv.x), bfhi(rv.x))); w.y = __builtin_bit_cast(unsigned, __builtin_amdgcn_cvt_pkrtz(bflo(rv.y), bfhi(rv.y)));
              w.z = __builtin_bit_cast(unsigned, __builtin_amdgcn_cvt_pkrtz(bflo(rv.z), bfhi(rv.z))); w.w = __builtin_bit_cast(unsigned, __builtin_amdgcn_cvt_pkrtz(bflo(rv.w), bfhi(rv.w)));
              *(u32x4*)(C.ws + WS_VA + ((size_t)(t0 + tok) * 512 + 8 * c16) * 2) = w; } }
        { const int tok = tid >> 3, c8 = tid & 7;
          *(u32x4*)((bf16_t*)(C.ws + WS_KIC) + (size_t)(t0 + tok) * 64 + 8 * c8) = *(const u32x4*)(proj + (size_t)(t0 + tok) * NP + P_KI + 8 * c8); }
#pragma unroll 1
        for (int which = 0; which < 2; ++which) {
            const int pcol = which ? P_VW : P_VS; bf16_t* dstT = (bf16_t*)(C.ws + (which ? WS_VWT : WS_VST));
            LAS unsigned* tl = (LAS unsigned*)C.lds;
#pragma unroll
            for (int i = 0; i < 8; ++i) { const int idx = tid + 512 * i, tok = idx >> 6, c16 = idx & 63;
                const u32x4 v = *(const u32x4*)(proj + (size_t)(t0 + tok) * NP + pcol + 8 * c16);
                LAS unsigned* q = tl + tok * 257 + 4 * c16; q[0] = v.x; q[1] = v.y; q[2] = v.z; q[3] = v.w; }
            __syncthreads();
#pragma unroll
            for (int i = 0; i < 8; ++i) { const int task = tid + 512 * i, col = task >> 3, tc = task & 7;
                unsigned short e[8];
#pragma unroll
                for (int j = 0; j < 8; ++j) { const unsigned dw = tl[(8 * tc + j) * 257 + (col >> 1)]; e[j] = (col & 1) ? (unsigned short)(dw >> 16) : (unsigned short)(dw & 0xFFFFu); }
                u32x4 w; w.x = e[0] | ((unsigned)e[1] << 16); w.y = e[2] | ((unsigned)e[3] << 16); w.z = e[4] | ((unsigned)e[5] << 16); w.w = e[6] | ((unsigned)e[7] << 16);
                *(u32x4*)(dstT + (size_t)col * T + t0 + 8 * tc) = w; }
            __syncthreads();
        }
    }
}

__device__ __forceinline__ void p5_cmp_out(const Ctx& C) {
    const float* part = (const float*)(C.ws + WS_HIDP); const float* b1 = (const float*)(C.ws + WS_B1);
    bf16_t* kcmp = (bf16_t*)(C.ws + WS_KCMP); bf16_t* vcT = (bf16_t*)(C.ws + WS_VCMPT);
    LAS float* hl = (LAS float*)(C.lds) + C.wave * 1024;
    const int lane = C.lane;
    for (int grp = blockIdx.x * 8 + C.wave; grp < 2048; grp += gridDim.x * 8) {
        const int R0 = grp * 4; const bool isv = R0 >= 4096;
        lds_sync();
        const f32x4 bb = *(const f32x4*)(b1 + (isv ? 256 : 0) + 4 * lane);
#pragma unroll
        for (int r = 0; r < 4; ++r) { f32x4 a = bb;
#pragma unroll
            for (int ks = 0; ks < 8; ++ks) a += *(const f32x4*)(part + ((size_t)ks * 8192 + R0 + r) * 256 + 4 * lane);
            f32x4 hg; hg[0] = gelu_tanh(a[0]); hg[1] = gelu_tanh(a[1]); hg[2] = gelu_tanh(a[2]); hg[3] = gelu_tanh(a[3]);
            *(LAS f32x4*)(hl + r * 256 + 4 * lane) = hg; }
        lds_sync();
        const float* w2 = C.in[isv ? I_W2V : I_W2K];
        float acc[4][2];
#pragma unroll
        for (int r = 0; r < 4; ++r) { acc[r][0] = 0.f; acc[r][1] = 0.f; }
#pragma unroll 8
        for (int e = 0; e < 256; ++e) { const float2 wv = *(const float2*)(w2 + e * 128 + 2 * lane);
#pragma unroll
            for (int r = 0; r < 4; ++r) { const float hv = hl[r * 256 + e]; acc[r][0] += hv * wv.x; acc[r][1] += hv * wv.y; } }
#pragma unroll
        for (int r = 0; r < 4; ++r) { const int R = R0 + r, Rl = R & 4095, g = Rl >> 10, n = Rl & 1023;
            const float a0 = (n < NCMP) ? acc[r][0] : 0.f, a1 = (n < NCMP) ? acc[r][1] : 0.f;
            if (!isv) { const float ss = wave_sum(a0 * a0 + a1 * a1); const float rstd = rsqrtf(ss * (1.f / 128.f) + EPS);
                const float2 gg = *(const float2*)(C.in[I_GKCMP] + 2 * lane);
                *(unsigned*)(kcmp + (size_t)Rl * 128 + 2 * lane) = (n < NCMP) ? cvt_pk_bf16(a0 * rstd * gg.x, a1 * rstd * gg.y) : 0u; }
            else { vcT[((size_t)g * 128 + 2 * lane) * 1024 + n] = f2bf(a0); vcT[((size_t)g * 128 + 2 * lane + 1) * 1024 + n] = f2bf(a1); } }
    }
}

constexpr int P6_WAVE_LDS = 18432, P6_SHARED = 8192;
__device__ __forceinline__ f32x16 mfma32(bf16x8 a, bf16x8 b, f32x16 c) { return __builtin_amdgcn_mfma_f32_32x32x16_bf16(a, b, c, 0, 0, 0); }
__device__ __forceinline__ int swap23(int r) { return (r & 0x13) | ((r & 4) << 1) | ((r & 8) >> 1); }

__device__ __forceinline__ void topk_prune(LAS u64* buf, int& cnt, u64& tau, LAS unsigned* hist, int lane) {
    u64 e[8];
#pragma unroll
    for (int i = 0; i < 8; ++i) { const int idx = lane + 64 * i; e[i] = idx < cnt ? buf[idx] : 0ull; }
    u64 prefix = 0ull; unsigned need = 256u;
    const u64 lt = (1ull << lane) - 1ull;
#pragma unroll 1
    for (int p = 0; p < 6; ++p) {
        const int shift = 40 - 8 * p;
        *(LAS u32x4*)(hist + 4 * lane) = (u32x4){0u, 0u, 0u, 0u};
        lds_sync();
#pragma unroll
        for (int i = 0; i < 8; ++i) { const bool m = (e[i] != 0ull) && ((e[i] >> (shift + 8)) == (prefix >> (shift + 8)));
            if (m) __hip_atomic_fetch_add(hist + (unsigned)((e[i] >> shift) & 255ull), 1u, __ATOMIC_RELAXED, __HIP_MEMORY_SCOPE_WORKGROUP); }
        lds_sync();
        const u32x4 c = *(LAS u32x4*)(hist + 4 * lane);
        const unsigned tot = c.x + c.y + c.z + c.w;
        unsigned pre = tot;
        pre += (unsigned)__builtin_amdgcn_update_dpp(0, (int)pre, 0x111, 0xF, 0xF, true); pre += (unsigned)__builtin_amdgcn_update_dpp(0, (int)pre, 0x112, 0xF, 0xF, true);
        pre += (unsigned)__builtin_amdgcn_update_dpp(0, (int)pre, 0x114, 0xF, 0xF, true); pre += (unsigned)__builtin_amdgcn_update_dpp(0, (int)pre, 0x118, 0xF, 0xF, true);
        const unsigned r0 = (unsigned)__builtin_amdgcn_readlane((int)pre, 15), r1 = (unsigned)__builtin_amdgcn_readlane((int)pre, 31), r2 = (unsigned)__builtin_amdgcn_readlane((int)pre, 47), r3 = (unsigned)__builtin_amdgcn_readlane((int)pre, 63);
        const int row = lane >> 4;
        pre += (row == 1) ? r0 : (row == 2) ? (r0 + r1) : (row == 3) ? (r0 + r1 + r2) : 0u;
        const unsigned a3 = (r0 + r1 + r2 + r3) - pre, a2 = a3 + c.w, a1 = a2 + c.z, a0 = a1 + c.y;
        int found = -1; unsigned above = 0u;
        if (a3 < need && need <= a3 + c.w) { found = 3; above = a3; }
        else if (a2 < need && need <= a2 + c.z) { found = 2; above = a2; }
        else if (a1 < need && need <= a1 + c.y) { found = 1; above = a1; }
        else if (a0 < need && need <= a0 + c.x) { found = 0; above = a0; }
        const u64 bm = __ballot(found >= 0);
        const int src = bm ? (__ffsll((long long)bm) - 1) : 0;
        const int bin = __builtin_amdgcn_readlane(4 * lane + found, src); const unsigned ab = (unsigned)__builtin_amdgcn_readlane((int)above, src);
        prefix |= ((u64)(unsigned)bin) << shift; need -= ab;
        lds_sync();
    }
    tau = prefix;
    int base = 0;
#pragma unroll
    for (int i = 0; i < 8; ++i) { const bool keep = (e[i] >= tau) && (e[i] != 0ull); const u64 m = __ballot(keep);
        if (keep) buf[base + __popcll(m & lt)] = e[i]; base += __popcll(m); }
    cnt = base;
    lds_sync();
}

#ifndef DSA_PROBE_MODE
#define DSA_PROBE_MODE 0
#endif
__device__ __forceinline__ void dsa_item(const Ctx& C, int qp, LAS unsigned char* wl, LAS const unsigned char* bkt, LAS const float* tbl, int pmode = 0) {
    const int lane = C.lane, r = lane & 31, h = lane >> 5;
    const bf16_t* proj = (const bf16_t*)(C.ws + WS_PROJ); const bf16_t* kic = (const bf16_t*)(C.ws + WS_KIC);
    unsigned char* ya = C.ws + WS_YA;
    const int t0 = 2 * qp;
    LAS u64* buf0 = (LAS u64*)wl; LAS u64* buf1 = (LAS u64*)(wl + 4096);
    LAS unsigned* hist = (LAS unsigned*)(wl + 8192);
    LAS unsigned char* qst = wl + 9216;
    LAS float* pl = (LAS float*)(wl + 10240);
    LAS unsigned* idxs = (LAS unsigned*)(wl + 14336);
    const u64 lt = (1ull << lane) - 1ull;
    {
    bf16x8 A[2][4]; unsigned wp[2][8];
#pragma unroll
    for (int q = 0; q < 2; ++q) {
        const bf16_t* pr = proj + (size_t)(t0 + q) * NP;
#pragma unroll
        for (int kk = 0; kk < 4; ++kk) A[q][kk] = *(const bf16x8*)(pr + P_QI + 64 * r + 32 * h + 8 * kk);
#pragma unroll
        for (int k2 = 0; k2 < 8; ++k2) { const int reg = 2 * k2; wp[q][k2] = *(const unsigned*)(pr + P_WI + (reg & 3) + 8 * (reg >> 2) + 4 * h); }
    }
    int cnt0 = 0, cnt1 = 0; u64 tau0 = 0ull, tau1 = 0ull;
    const int nkeys = (pmode == 2) ? 0 : t0 + 2;
    LAS unsigned char* stg = wl + 9216;
    const unsigned ixo0 = (unsigned)(((lane >> 3) * 64 + 8 * ((lane & 7) ^ ((lane >> 4) & 7))) * 2), ixo1 = (unsigned)(((lane >> 3) * 64 + 8 * ((lane & 7) ^ ((4 + (lane >> 4)) & 7))) * 2);
#define IX_STAGE(j0_) do { const char* _tb = (const char*)kic + (size_t)(j0_) * 128; _Pragma("unroll") for (int _i = 0; _i < 8; ++_i) \
        __builtin_amdgcn_global_load_lds((const unsigned*)(_tb + _i * 1024 + ((_i & 1) ? ixo1 : ixo0)), (LAS unsigned*)(stg + _i * 1024), 16, 0, 0); } while (0)
    if (nkeys > 0) IX_STAGE(0);
#pragma unroll 1
    for (int j0 = 0; j0 < nkeys; j0 += 64) {
        bf16x8 BA[4], BB[4];
        asm volatile("s_waitcnt vmcnt(0)" ::: "memory");
#pragma unroll
        for (int kk = 0; kk < 4; ++kk) { const int sw = (r >> 1) & 7;
            BA[kk] = *(LAS const bf16x8*)(stg + r * 128 + 16 * ((4 * h + kk) ^ sw));
            BB[kk] = *(LAS const bf16x8*)(stg + (32 + r) * 128 + 16 * ((4 * h + kk) ^ sw)); }
        asm volatile("s_waitcnt lgkmcnt(0)" ::: "memory");
        if (j0 + 64 < nkeys) IX_STAGE(j0 + 64);
        const int kidx = j0 + lane;
        f32x16 accA0, accB0, accA1, accB1;
#pragma unroll
        for (int i = 0; i < 16; ++i) { accA0[i] = 0.f; accB0[i] = 0.f; accA1[i] = 0.f; accB1[i] = 0.f; }
#pragma unroll
        for (int kk = 0; kk < 4; ++kk) { accA0 = mfma32(A[0][kk], BA[kk], accA0); accB0 = mfma32(A[0][kk], BB[kk], accB0); }
#pragma unroll
        for (int kk = 0; kk < 4; ++kk) { accA1 = mfma32(A[1][kk], BA[kk], accA1); accB1 = mfma32(A[1][kk], BB[kk], accB1); }
        float sc[2];
        { float pA = 0.f, pB = 0.f;
#pragma unroll
          for (int i = 0; i < 16; ++i) { const float wv = (i & 1) ? bfhi(wp[0][i >> 1]) : bflo(wp[0][i >> 1]);
              const float ta = __int_as_float(max(__float_as_int(accA0[i]), 0)), tb = __int_as_float(max(__float_as_int(accB0[i]), 0));
              pA = __builtin_fmaf(ta, wv, pA); pB = __builtin_fmaf(tb, wv, pB); }
          swap32f(pA, pB); sc[0] = pA + pB; }
        __builtin_amdgcn_sched_group_barrier(0x008, 8, 0);
#pragma unroll
        for (int i = 0; i < 8; ++i) { __builtin_amdgcn_sched_group_barrier(0x008, 1, 0); __builtin_amdgcn_sched_group_barrier(0x002, 9, 0); }
        { float pA = 0.f, pB = 0.f;
#pragma unroll
          for (int i = 0; i < 16; ++i) { const float wv = (i & 1) ? bfhi(wp[1][i >> 1]) : bflo(wp[1][i >> 1]);
              const float ta = __int_as_float(max(__float_as_int(accA1[i]), 0)), tb = __int_as_float(max(__float_as_int(accB1[i]), 0));
              pA = __builtin_fmaf(ta, wv, pA); pB = __builtin_fmaf(tb, wv, pB); }
          swap32f(pA, pB); sc[1] = pA + pB; }
#pragma unroll
        for (int q = 0; q < 2; ++q) {
            const float s = sc[q];
            const bool valid = kidx <= t0 + q;
            const u64 key = ((u64)sortable(s) << 14) | (u64)(unsigned)(16383 - kidx);
            const u64 tau = q ? tau1 : tau0;
            const bool pass = valid && key > tau && (pmode != 3);
            const u64 mask = __ballot(pass);
            if (mask) {
                LAS u64* buf = q ? buf1 : buf0; int& cnt = q ? cnt1 : cnt0;
                if (pass) buf[cnt + __popcll(mask & lt)] = key;
                cnt += __popcll(mask);
                if (cnt > 512 - 64) { lds_sync(); topk_prune(buf, cnt, q ? tau1 : tau0, hist, lane); }
            }
        }
    }
#undef IX_STAGE
    lds_sync();
    if (cnt0 > 256) topk_prune(buf0, cnt0, tau0, hist, lane);
    if (cnt1 > 256) topk_prune(buf1, cnt1, tau1, hist, lane);
    if (pmode == 2) { cnt0 = min(t0 + 1, 256); cnt1 = min(t0 + 2, 256);
#pragma unroll
        for (int i = 0; i < 4; ++i) { const int j = lane + 64 * i; buf0[j] = (u64)(unsigned)(16383 - ((j * 61) % (t0 + 1))); buf1[j] = (u64)(unsigned)(16383 - ((j * 59) % (t0 + 2))); } }
    if (lane == 0) { hist[0] = (unsigned)cnt0; hist[1] = (unsigned)cnt1; }
    lds_sync();
    }
    __builtin_amdgcn_s_setprio(0);
    if (pmode == 1 || pmode == 3) return;
    const int kq = lane >> 4, l16 = lane & 15;
    LAS float* plq = (LAS float*)wl;
    LAS unsigned short* idx2 = (LAS unsigned short*)(wl + 16384);
    LAS float* invl = (LAS float*)(wl + 17408);
    const int nsel0 = (int)hist[0], nsel1 = (int)hist[1];
    { unsigned iv0[4], iv1[4];
#pragma unroll
      for (int i = 0; i < 4; ++i) { const int j = lane + 64 * i; iv0[i] = (j < nsel0) ? (16383u - (unsigned)(buf0[j] & 0x3FFFull)) : 0u; iv1[i] = (j < nsel1) ? (16383u - (unsigned)(buf1[j] & 0x3FFFull)) : 0u; }
      lds_sync();
#pragma unroll
      for (int i = 0; i < 4; ++i) { const int j = lane + 64 * i; idx2[j] = (unsigned short)iv0[i]; idx2[256 + j] = (unsigned short)iv1[i]; }
      lds_sync(); }
    const unsigned char* KAp = (const unsigned char*)(C.ws + WS_KA) + 32 * kq;
    const float lsc = 1.f / (64.f * 512.f);
#pragma unroll 1
    for (int q = 0; q < 2; ++q) {
        const int t = t0 + q; const int nsel = q ? nsel1 : nsel0; LAS const unsigned short* idxs = idx2 + 256 * q;
        const bf16_t* prq = proj + (size_t)t * NP;
        lds_sync();
        {
            long Bz[4][4];
#pragma unroll
            for (int g = 0; g < 4; ++g)
#pragma unroll
                for (int sI = 0; sI < 4; ++sI) { long z = 0;
                    if ((l16 >> 2) == g) { const u32x4 raw = *(const u32x4*)(prq + P_QA + l16 * 128 + 32 * kq + 8 * sI);
                        int p0 = __builtin_amdgcn_cvt_pk_fp8_f32(bflo(raw.x) * 512.f, bfhi(raw.x) * 512.f, 0, false); p0 = __builtin_amdgcn_cvt_pk_fp8_f32(bflo(raw.y) * 512.f, bfhi(raw.y) * 512.f, p0, true);
                        int p1 = __builtin_amdgcn_cvt_pk_fp8_f32(bflo(raw.z) * 512.f, bfhi(raw.z) * 512.f, 0, false); p1 = __builtin_amdgcn_cvt_pk_fp8_f32(bflo(raw.w) * 512.f, bfhi(raw.w) * 512.f, p1, true);
                        z = (long)(((unsigned long long)(unsigned)p1 << 32) | (unsigned long long)(unsigned)p0); }
                    Bz[g][sI] = z; }
            u32x4 A0[2][2], A1[2][2];
            { const unsigned char* kr = KAp + (size_t)idxs[l16] * 512;
#pragma unroll
              for (int g = 0; g < 2; ++g) { A0[g][0] = *(const u32x4*)(kr + g * 128); A0[g][1] = *(const u32x4*)(kr + g * 128 + 16); } }
#pragma unroll 1
            for (int tile = 0; tile < 16; ++tile) {
                { const unsigned char* kr = KAp + (size_t)idxs[16 * tile + l16] * 512 + 256;
#pragma unroll
                  for (int g = 0; g < 2; ++g) { A1[g][0] = *(const u32x4*)(kr + g * 128); A1[g][1] = *(const u32x4*)(kr + g * 128 + 16); } }
                f32x4 acc = {0.f, 0.f, 0.f, 0.f};
#pragma unroll
                for (int g = 0; g < 2; ++g)
#pragma unroll
                    for (int sI = 0; sI < 4; ++sI) { const u32x4 v = A0[g][sI >> 1]; const long a = (sI & 1) ? (long)(((unsigned long long)v.w << 32) | v.z) : (long)(((unsigned long long)v.y << 32) | v.x);
                        acc = __builtin_amdgcn_mfma_f32_16x16x32_fp8_fp8(a, Bz[g][sI], acc, 0, 0, 0); }
                asm volatile("" ::: "memory");
                if (tile < 15) { const unsigned char* kr = KAp + (size_t)idxs[16 * (tile + 1) + l16] * 512;
#pragma unroll
                    for (int g = 0; g < 2; ++g) { A0[g][0] = *(const u32x4*)(kr + g * 128); A0[g][1] = *(const u32x4*)(kr + g * 128 + 16); } }
#pragma unroll
                for (int g = 0; g < 2; ++g)
#pragma unroll
                    for (int sI = 0; sI < 4; ++sI) { const u32x4 v = A1[g][sI >> 1]; const long a = (sI & 1) ? (long)(((unsigned long long)v.w << 32) | v.z) : (long)(((unsigned long long)v.y << 32) | v.x);
                        acc = __builtin_amdgcn_mfma_f32_16x16x32_fp8_fp8(a, Bz[2 + g][sI], acc, 0, 0, 0); }
#pragma unroll
                for (int r = 0; r < 4; ++r) { const int j = 16 * tile + 4 * kq + r; const int idx = (int)idxs[j]; const bool valid = j < nsel;
                    const int b = bkt[min(max(t - idx, 0), 2048)];
                    plq[j * 16 + l16] = valid ? (acc[r] * lsc + tbl[b * 32 + l16]) : -1e30f; }
            }
        }
        lds_sync();
        {
            float mx[16];
#pragma unroll
            for (int hh = 0; hh < 16; ++hh) mx[hh] = -1e30f;
#pragma unroll 1
            for (int ps = 0; ps < 4; ++ps) { const int j = ps * 64 + lane;
#pragma unroll
                for (int c4 = 0; c4 < 4; ++c4) { const f32x4 lv = *(LAS f32x4*)(plq + 16 * j + 4 * c4);
#pragma unroll
                    for (int e = 0; e < 4; ++e) mx[4 * c4 + e] = fmaxf(mx[4 * c4 + e], lv[e]); } }
#pragma unroll
            for (int hh = 0; hh < 16; ++hh) mx[hh] = wave_max(mx[hh]);
            float zs[16];
#pragma unroll
            for (int hh = 0; hh < 16; ++hh) zs[hh] = 0.f;
#pragma unroll 1
            for (int ps = 0; ps < 4; ++ps) { const int j = ps * 64 + lane; const bool valid = j < nsel;
#pragma unroll
                for (int c4 = 0; c4 < 4; ++c4) { f32x4 lv = *(LAS f32x4*)(plq + 16 * j + 4 * c4);
#pragma unroll
                    for (int e = 0; e < 4; ++e) { const float p = valid ? __expf(lv[e] - mx[4 * c4 + e]) : 0.f; lv[e] = __builtin_bit_cast(float, __builtin_amdgcn_cvt_pkrtz(p, p)); zs[4 * c4 + e] += p; }
                    *(LAS f32x4*)(plq + 16 * j + 4 * c4) = lv; } }
#pragma unroll
            for (int hh = 0; hh < 16; ++hh) { const float z = wave_sum(zs[hh]); if (lane == 0) invl[hh] = 1.f / fmaxf(z, 1e-30f); }
        }
        lds_sync();
#pragma unroll 1
        for (int g = 0; g < 4; ++g) {
            const f32x4 inv4 = *(LAS f32x4*)(invl + 4 * g);
            hx2_t o2[4][4];
#pragma unroll
            for (int rr = 0; rr < 4; ++rr)
#pragma unroll
                for (int d = 0; d < 4; ++d) o2[rr][d] = (hx2_t){(_Float16)0.f, (_Float16)0.f};
            const unsigned char* vbase = C.ws + WS_VA + (128 * g + 8 * l16) * 2;
            const int nb = (nsel + 31) >> 5;
            u32x4 vc[8], vn[8];
#pragma unroll
            for (int u = 0; u < 8; ++u) { const int idx = (int)idxs[4 * u + kq]; vc[u] = *(const u32x4*)(vbase + (size_t)idx * 1024); }
#pragma unroll 1
            for (int bb = 0; bb < nb; ++bb) {
                { const int bn = (bb + 1 < nb) ? bb + 1 : bb;
#pragma unroll
                    for (int u = 0; u < 8; ++u) { const int idx = (int)idxs[32 * bn + 4 * u + kq]; vn[u] = *(const u32x4*)(vbase + (size_t)idx * 1024); } }
#pragma unroll
                for (int u = 0; u < 8; ++u) { const u32x4 pw = *(LAS u32x4*)(plq + 16 * (32 * bb + 4 * u + kq) + 4 * g);
#pragma unroll
                    for (int rr = 0; rr < 4; ++rr) { const unsigned pwr = pw[rr]; const hx2_t pp = __builtin_bit_cast(hx2_t, pwr);
#pragma unroll
                        for (int d = 0; d < 4; ++d) { const unsigned vd = vc[u][d]; o2[rr][d] = pp * __builtin_bit_cast(hx2_t, vd) + o2[rr][d]; } } }
#pragma unroll
                for (int u = 0; u < 8; ++u) vc[u] = vn[u];
            }
            float o[4][8];
#pragma unroll
            for (int rr = 0; rr < 4; ++rr)
#pragma unroll
                for (int d = 0; d < 4; ++d) { o[rr][2 * d] = xsum16(xsum32((float)o2[rr][d].x)) * inv4[rr]; o[rr][2 * d + 1] = xsum16(xsum32((float)o2[rr][d].y)) * inv4[rr]; }
            if (kq == 0) {
#pragma unroll
                for (int rr = 0; rr < 4; ++rr) { int p0 = __builtin_amdgcn_cvt_pk_fp8_f32(o[rr][0] * 16.f, o[rr][1] * 16.f, 0, false); p0 = __builtin_amdgcn_cvt_pk_fp8_f32(o[rr][2] * 16.f, o[rr][3] * 16.f, p0, true);
                    int p1 = __builtin_amdgcn_cvt_pk_fp8_f32(o[rr][4] * 16.f, o[rr][5] * 16.f, 0, false); p1 = __builtin_amdgcn_cvt_pk_fp8_f32(o[rr][6] * 16.f, o[rr][7] * 16.f, p1, true);
                    *(u32x2*)(ya + (size_t)t * 2048 + (4 * g + rr) * 128 + 8 * l16) = (u32x2){(unsigned)p0, (unsigned)p1}; } }
        }
    }
}

constexpr int N2_KS = 0, N2_VS = 32768, N2_LUT = 65536, N2_IMP = 81920, N2_SEL = N2_IMP + 64 * 260 * 4, N2_UNI = N2_SEL + 2048, N2_LIST = N2_UNI + 64, N2_BKT = N2_LIST + 3 * 512, N2_TBL = N2_BKT + 2304, N2_END = N2_TBL + 4096;
static_assert(N2_END <= LDS_BYTES - 16, "NSA LDS map");
struct N2Src { const bf16_t* kbase; size_t kld; int krmax; const bf16_t* vT; size_t vld; };
__device__ __forceinline__ void n2_stage(const N2Src& s, int m, bool withV, LAS unsigned char* kbuf, LAS unsigned char* vbuf, int wave, int lane) {
#pragma unroll
    for (int j = 0; j < 2; ++j) { const int slot = (wave * 2 + j) * 64 + lane; const int row = slot >> 4, ch = (slot & 15) ^ (row & 15);
        __builtin_amdgcn_global_load_lds((const unsigned*)(s.kbase + (size_t)min(64 * m + row, s.krmax) * s.kld + 8 * ch), (LAS unsigned*)(kbuf + (wave * 2 + j) * 1024), 16, 0, 0); }
    if (withV) {
#pragma unroll
        for (int j = 0; j < 2; ++j) { const int slot = (wave * 2 + j) * 64 + lane; const int row = slot >> 3, ch = (slot & 7) ^ ((row >> 1) & 7);
            __builtin_amdgcn_global_load_lds((const unsigned*)(s.vT + (size_t)row * s.vld + 64 * m + 8 * ch), (LAS unsigned*)(vbuf + (wave * 2 + j) * 1024), 16, 0, 0); } }
}
__device__ __forceinline__ f32x16 n2_qk(const bf16x8 (&Bq)[8], LAS const unsigned char* kbuf, int hf, int rho, int h) {
    const int kr = 32 * hf + rho;
    f32x16 S;
#pragma unroll
    for (int i = 0; i < 16; ++i) S[i] = 0.f;
#pragma unroll
    for (int kk = 0; kk < 8; ++kk) { const int ch = 8 * h + kk; const bf16x8 a = *(LAS const bf16x8*)(kbuf + kr * 256 + 16 * (ch ^ (rho & 15))); S = mfma32(a, Bq[kk], S); }
    return S;
}
__device__ __forceinline__ void n2_pv(f32x16 (&O)[4], const float (&p)[16], LAS const unsigned char* vbuf, int hf, int lane) {
    bf16x8 pk[2];
#pragma unroll
    for (int s = 0; s < 2; ++s) { u32x4 w; w.x = cvt_pk_bf16(p[8 * s + 0], p[8 * s + 1]); w.y = cvt_pk_bf16(p[8 * s + 2], p[8 * s + 3]); w.z = cvt_pk_bf16(p[8 * s + 4], p[8 * s + 5]); w.w = cvt_pk_bf16(p[8 * s + 6], p[8 * s + 7]);
        pk[s] = __builtin_bit_cast(bf16x8, w); }
    const int r = lane & 31, h = lane >> 5;
#pragma unroll
    for (int dt = 0; dt < 4; ++dt)
#pragma unroll
        for (int s = 0; s < 2; ++s) { const int row = dt * 32 + r, ch = 4 * hf + 2 * s + h;
            const bf16x8 a = *(LAS const bf16x8*)(vbuf + row * 128 + 16 * (ch ^ ((r >> 1) & 7))); O[dt] = mfma32(a, pk[s], O[dt]); }
}
constexpr float N2_MASKED = -3.0e38f, N2_MINIT = -1.0e30f, LOG2E = 1.4426950408889634f;
template <int MODE, bool DEFER = false>
__device__ __forceinline__ float n2_bias_mask(f32x16& S, int posbase, int t, int t0w, int h, int ncv, int ncv0, unsigned sb, bool before_cur, float b31, LAS const bf16_t* lutr, LAS const unsigned char* bkt, LAS const float* tblh) {
    bool farT, fullT;
    if (MODE == 0) { farT = (t0w - (16 * (posbase + 31) + 31)) >= 1513; fullT = (posbase + 31) < ncv0; }
    else if (MODE == 1) { farT = (t0w - (posbase + 31)) >= 1513; fullT = before_cur; }
    else { farT = false; fullT = (posbase + 31 <= t0w) && ((t0w + 7 - posbase) < 512); }
    float cbu = b31;
    if (MODE != 0 && fullT && !farT) { const int b0 = (int)bkt[min(t0w - (posbase + 31), 2048)], b1 = (int)bkt[min(t0w + 7 - posbase, 2048)];
        if (b0 == b1) { farT = true; cbu = tblh[b0 * 32] * LOG2E; } }
    if (farT && fullT) {
        if (MODE == 1 && sb == 0u) {
#pragma unroll
            for (int reg = 0; reg < 16; ++reg) S[reg] = N2_MASKED;
            return 0.f; }
        if (DEFER) return cbu;
#pragma unroll
        for (int reg = 0; reg < 16; ++reg) S[reg] = S[reg] + cbu;
    } else {
#pragma unroll
        for (int reg = 0; reg < 16; ++reg) { const int pos = posbase + (reg & 7) + 8 * h + 16 * (reg >> 3);
            const int dist = (MODE == 0) ? (t - (16 * pos + 31)) : (t - pos);
            bool v;
            if (MODE == 0) v = pos < ncv; else if (MODE == 1) v = (sb != 0u) && (pos <= t); else v = (pos <= t) && (dist < 512);
            const float bias = bf2f(lutr[min(max(dist, 0), 2047)]);
            S[reg] = v ? (S[reg] + bias) : N2_MASKED; }
    }
    return 0.f;
}
__device__ __forceinline__ float n2_tilemax(const f32x16& S) {
    float a = fmax_fast(S[0], S[1]), b = fmax_fast(S[2], S[3]), c = fmax_fast(S[4], S[5]), d = fmax_fast(S[6], S[7]);
    float e = fmax_fast(S[8], S[9]), f = fmax_fast(S[10], S[11]), g = fmax_fast(S[12], S[13]), hh = fmax_fast(S[14], S[15]);
    a = fmax_fast(a, b); c = fmax_fast(c, d); e = fmax_fast(e, f); g = fmax_fast(g, hh); a = fmax_fast(a, c); e = fmax_fast(e, g); return fmax_fast(a, e);
}
__device__ __forceinline__ void n2_stat(const f32x16& S, float& m, float& Z) {
    const float mn = fmax_fast(m, n2_tilemax(S));
    float z = 0.f;
#pragma unroll
    for (int i = 0; i < 16; ++i) z += __builtin_amdgcn_exp2f(S[i] - mn);
    Z = Z * __builtin_amdgcn_exp2f(m - mn) + z; m = mn;
}
__device__ __forceinline__ void n2_combine(float& m, float& Z) {
    float ma = m, mb = m; swap32f(ma, mb); const float M = fmax_fast(ma, mb);
    Z = xsum32(Z * __builtin_amdgcn_exp2f(m - M)); m = M;
}
enum { N2_STATS = 0, N2_IMPP = 1, N2_PV = 2, N2_ONLINE = 3, N2_IMPV = 4 };
struct N2Lane { int t, t0w, h, rho, qq, rr, lane, ncv, ncv0, ncv7, cur; float b31; LAS const bf16_t* lutr; LAS const unsigned char* bkt; LAS const float* tblh; };
template <int MODE, int PASS>
__device__ __forceinline__ void n2_branch(const Ctx& C, int g, LAS const unsigned short* list, int n, const N2Lane& L, const bf16x8 (&Bq)[8], f32x16 (&O)[4],
                                          float& m, float& Z, float scale, LAS const unsigned* selq, LAS float* impw, float scale2 = 1.f) {
    if (n <= 0) return;
    constexpr bool withV = (PASS == N2_PV || PASS == N2_ONLINE || PASS == N2_IMPV);
    constexpr int NSL = (PASS == N2_IMPV) ? 2 : 4, LA = NSL - 1;
    N2Src src;
    if (MODE == 0) { src.kbase = (const bf16_t*)(C.ws + WS_KCMP) + (size_t)g * 1024 * 128; src.kld = 128; src.krmax = 1023; src.vT = (const bf16_t*)(C.ws + WS_VCMPT) + (size_t)g * 128 * 1024; src.vld = 1024; }
    else if (MODE == 1) { src.kbase = (const bf16_t*)(C.ws + WS_KSC) + (size_t)g * T * 128; src.kld = 128; src.krmax = T - 1; src.vT = (const bf16_t*)(C.ws + WS_VST) + (size_t)g * 128 * T; src.vld = (size_t)T; }
    else { src.kbase = (const bf16_t*)(C.ws + WS_KWC) + (size_t)g * T * 128; src.kld = 128; src.krmax = T - 1; src.vT = (const bf16_t*)(C.ws + WS_VWT) + (size_t)g * 128 * T; src.vld = (size_t)T; }
    LAS unsigned char* lds = C.lds;
#define N2_KSLOT(s_) (withV ? (((s_) < 2) ? (N2_KS + (s_) * 16384) : (N2_IMP + ((s_) - 2) * 32768)) : (N2_KS + (s_) * 16384))
#define N2_VSLOT(s_) (((s_) < 2) ? (N2_VS + (s_) * 16384) : (N2_IMP + ((s_) - 2) * 32768 + 16384))
#define N2_RAW_BARRIER() do { asm volatile("s_waitcnt lgkmcnt(0)" ::: "memory"); __builtin_amdgcn_s_barrier(); asm volatile("" ::: "memory"); } while (0)
#define N2_WAIT_LANDED() do { if (LA == 1) asm volatile("s_waitcnt vmcnt(0)" ::: "memory"); else if (withV) asm volatile("s_waitcnt vmcnt(8)" ::: "memory"); else asm volatile("s_waitcnt vmcnt(4)" ::: "memory"); } while (0)
#pragma unroll
    for (int j = 0; j < LA; ++j) if (j < n) n2_stage(src, (int)list[j], withV, lds + N2_KSLOT(j), lds + N2_VSLOT(j), C.wave, C.lane);
    if (n >= LA) N2_WAIT_LANDED(); else asm volatile("s_waitcnt vmcnt(0)" ::: "memory");
    N2_RAW_BARRIER();
#pragma unroll 1
    for (int i = 0; i < n; ++i) {
        const int mb = (int)list[i];
        if (i + LA < n) { const int sl = (i + LA) & (NSL - 1); n2_stage(src, (int)list[i + LA], withV, lds + N2_KSLOT(sl), lds + N2_VSLOT(sl), C.wave, C.lane); }
        LAS const unsigned char* kbuf = lds + N2_KSLOT(i & (NSL - 1)); LAS const unsigned char* vbuf = lds + N2_VSLOT(i & (NSL - 1));
        bool need; unsigned sb = 1u;
        if (MODE == 0) need = (64 * mb) < L.ncv7;
        else if (MODE == 1) { const unsigned sw = selq[mb >> 5]; sb = (sw >> (mb & 31)) & 1u; need = __ballot(sb != 0u) != 0ull; }
        else need = (64 * mb + 63 >= L.t0w - 511) && (64 * mb <= L.t0w + 7);
        if (need) {
#pragma unroll 1
            for (int hf = 0; hf < 2; ++hf) {
                const int posbase = 64 * mb + 32 * hf;
                f32x16 S = n2_qk(Bq, kbuf, hf, L.rho, L.h);
                const float cbd = n2_bias_mask<MODE, PASS == N2_ONLINE>(S, posbase, L.t, L.t0w, L.h, L.ncv, L.ncv0, sb, mb < L.cur, L.b31, L.lutr, L.bkt, L.tblh);
                if (PASS == N2_STATS) { n2_stat(S, m, Z); }
                else if (PASS == N2_IMPP || PASS == N2_IMPV) {
                    float p[16];
#pragma unroll
                    for (int r = 0; r < 16; ++r) p[r] = __builtin_amdgcn_exp2f(S[r] - m) * scale;
#pragma unroll
                    for (int G = 0; G < 4; ++G) { float q4 = p[4 * G] + p[4 * G + 1] + p[4 * G + 2] + p[4 * G + 3], e = p[4 * G + 3];
                        q4 += dppf<0xB1>(q4); q4 += dppf<0x4E>(q4); e += dppf<0xB1>(e); e += dppf<0x4E>(e);
                        const int nb = posbase + ((4 * G) & 7) + 8 * L.h + 16 * ((4 * G) >> 3); const int mq = nb >> 2;
                        if (L.rr == 0) { __hip_atomic_fetch_add(impw + L.qq * 260 + mq, q4, __ATOMIC_RELAXED, __HIP_MEMORY_SCOPE_WORKGROUP);
                                         __hip_atomic_fetch_add(impw + L.qq * 260 + mq + 1, e, __ATOMIC_RELAXED, __HIP_MEMORY_SCOPE_WORKGROUP); } }
                    if (PASS == N2_IMPV) {
#pragma unroll
                        for (int r = 0; r < 16; ++r) p[r] *= scale2;
                        n2_pv(O, p, vbuf, hf, L.lane); }
                } else if (PASS == N2_PV) {
                    float p[16];
#pragma unroll
                    for (int r = 0; r < 16; ++r) p[r] = __builtin_amdgcn_exp2f(S[r] - m) * scale;
                    n2_pv(O, p, vbuf, hf, L.lane);
                } else {
                    const float tm = xmax32(n2_tilemax(S) + cbd);
                    const float mn = fmax_fast(m, tm);
                    if (__ballot(mn > m + 8.f)) { const float al = __builtin_amdgcn_exp2f(m - mn); Z *= al;
#pragma unroll
                        for (int dt = 0; dt < 4; ++dt)
#pragma unroll
                            for (int r = 0; r < 16; ++r) O[dt][r] *= al;
                        m = mn; }
                    float p[16]; float zs = 0.f;
                    const float c2 = cbd - m;
#pragma unroll
                    for (int r = 0; r < 16; ++r) { p[r] = __builtin_amdgcn_exp2f(S[r] + c2); zs += p[r]; }
                    Z += zs;
                    n2_pv(O, p, vbuf, hf, L.lane);
                }
            }
        }
        if (i + LA < n) N2_WAIT_LANDED(); else asm volatile("s_waitcnt vmcnt(0)" ::: "memory");
        N2_RAW_BARRIER();
    }
#undef N2_WAIT_LANDED
#undef N2_RAW_BARRIER
#undef N2_KSLOT
#undef N2_VSLOT
}

__device__ __forceinline__ void nsa2_item(const Ctx& C, int QB, int g) {
    LAS unsigned char* lds = C.lds;
    const int tid = C.tid, lane = C.lane, wave = C.wave;
    const int c = lane & 31, h = lane >> 5, qq = c >> 2, rr = c & 3;
    const int t0 = 64 * QB, t0w = t0 + 8 * wave, t = t0w + qq, head = 4 * g + rr;
    const bf16_t* proj = (const bf16_t*)(C.ws + WS_PROJ);
    LAS bf16_t* lut = (LAS bf16_t*)(lds + N2_LUT);
    LAS float* imp = (LAS float*)(lds + N2_IMP);
    LAS unsigned* selw = (LAS unsigned*)(lds + N2_SEL);
    LAS unsigned* uni = (LAS unsigned*)(lds + N2_UNI);
    LAS unsigned short* listC = (LAS unsigned short*)(lds + N2_LIST); LAS unsigned short* listS = listC + 256; LAS unsigned short* listW = listC + 512;
    LAS const unsigned char* bkt = lds + N2_BKT; LAS const float* tbl = (LAS const float*)(lds + N2_TBL);
    __syncthreads();
    for (int i = tid; i < 8192; i += NTHREADS) { const int r4 = i >> 11, d = i & 2047; lut[i] = f2bf(tbl[(int)bkt[d] * 32 + 16 + 4 * g + r4] * LOG2E); }
    for (int i = tid; i < 64 * 260; i += NTHREADS) imp[i] = 0.f;
    const int ncv_wg = (t0 + 63 >= 31) ? ((t0 + 63 - 31) >> 4) + 1 : 0; const int nC = (ncv_wg + 63) >> 6;
    const int wlo = max(t0 - 511, 0) >> 6; const int nW = QB - wlo + 1;
    if (tid < nC) listC[tid] = (unsigned short)tid;
    if (tid < nW) listW[tid] = (unsigned short)(wlo + tid);
    bf16x8 Bq[8];
#pragma unroll
    for (int kk = 0; kk < 8; ++kk) Bq[kk] = *(const bf16x8*)(proj + (size_t)t * NP + P_QB + 128 * head + 64 * h + 8 * kk);
    const float g0 = sigmoidf_(bf2f(proj[(size_t)t * NP + P_GB + 3 * head + 0]));
    const float g1 = sigmoidf_(bf2f(proj[(size_t)t * NP + P_GB + 3 * head + 1]));
    const float g2 = sigmoidf_(bf2f(proj[(size_t)t * NP + P_GB + 3 * head + 2]));
    f32x16 O[4];
#pragma unroll
    for (int dt = 0; dt < 4; ++dt)
#pragma unroll
        for (int i = 0; i < 16; ++i) O[dt][i] = 0.f;
    N2Lane L; L.t = t; L.t0w = t0w; L.h = h; L.rho = swap23(c); L.qq = qq; L.rr = rr; L.lane = lane;
    L.ncv = t >= 31 ? ((t - 31) >> 4) + 1 : 0; L.ncv0 = t0w >= 31 ? ((t0w - 31) >> 4) + 1 : 0; L.ncv7 = (t0w + 7 >= 31) ? ((t0w + 7 - 31) >> 4) + 1 : 0; L.cur = QB;
    L.b31 = tbl[31 * 32 + 16 + head] * LOG2E; L.lutr = lut + rr * 2048; L.bkt = bkt; L.tblh = tbl + 16 + head;
    LAS const unsigned* selq = selw + (wave * 8 + qq) * 8;
    LAS float* impw = imp + wave * 8 * 260;
    __syncthreads();
    float mC = N2_MINIT, ZC = 0.f;
    n2_branch<0, N2_STATS>(C, g, listC, nC, L, Bq, O, mC, ZC, 0.f, selq, impw);
    n2_combine(mC, ZC);
    const float invZC = 1.f / fmaxf(ZC, 1e-30f);
    n2_branch<0, N2_IMPV>(C, g, listC, nC, L, Bq, O, mC, ZC, invZC, selq, impw, g0);
#define N2_OACC() ({ unsigned to_ = (unsigned)tid; asm volatile("" : "+v"(to_)); (f32x4*)(C.ws + WS_OACC) + (size_t)blockIdx.x * 16 * 512 + to_; })
    f32x4* oacc = N2_OACC();
#pragma unroll
    for (int dt = 0; dt < 4; ++dt)
#pragma unroll
        for (int G = 0; G < 4; ++G) { oacc[(dt * 4 + G) * 512] = (f32x4){O[dt][4 * G], O[dt][4 * G + 1], O[dt][4 * G + 2], O[dt][4 * G + 3]}; O[dt][4 * G] = 0.f; O[dt][4 * G + 1] = 0.f; O[dt][4 * G + 2] = 0.f; O[dt][4 * G + 3] = 0.f; }
    lds_sync();
#pragma unroll 1
    for (int q8 = 0; q8 < 8; ++q8) {
        const int cur = QB;
        unsigned word = 0u;
        if (cur + 1 <= 16) { if (lane == 0) word = (1u << (cur + 1)) - 1u; }
        else {
            unsigned key[4];
#pragma unroll
            for (int i = 0; i < 4; ++i) { const int mblk = lane + 64 * i; const bool ok = mblk >= 1 && mblk <= cur - 2;
                key[i] = ok ? ((__float_as_uint(impw[q8 * 260 + mblk]) & 0xFFFFFF00u) | (unsigned)(255 - mblk)) : 0u; }
#pragma unroll 1
            for (int round = 0; round < 13; ++round) {
                unsigned lm = key[0] > key[1] ? key[0] : key[1]; const unsigned lm2 = key[2] > key[3] ? key[2] : key[3]; lm = lm > lm2 ? lm : lm2;
                const unsigned W = wave_maxu(lm);
#pragma unroll
                for (int i = 0; i < 4; ++i) if (key[i] == W) key[i] = 0u;
                const int mw = 255 - (int)(W & 0xFFu);
                if (W != 0u && lane == (mw >> 5)) word |= 1u << (mw & 31);
            }
            if (lane == 0) word |= 1u;
            if (lane == (cur >> 5)) word |= 1u << (cur & 31);
            if (lane == ((cur - 1) >> 5)) word |= 1u << ((cur - 1) & 31);
        }
        if (lane < 8) selw[(wave * 8 + q8) * 8 + lane] = word;
    }
    __syncthreads();
    if (tid < 8) { unsigned u = 0u; for (int q = 0; q < 64; ++q) u |= selw[q * 8 + tid]; uni[tid] = u; }
    __syncthreads();
    if (tid == 0) { int n = 0; for (int mblk = 0; mblk <= QB; ++mblk) if ((uni[mblk >> 5] >> (mblk & 31)) & 1u) listS[n++] = (unsigned short)mblk; uni[8] = (unsigned)n; }
    __syncthreads();
    const int nS = (int)uni[8];
    float mS = N2_MINIT, ZS = 0.f;
    n2_branch<1, N2_ONLINE>(C, g, listS, nS, L, Bq, O, mS, ZS, 0.f, selq, impw);
    { ZS = xsum32(ZS); const float sc = g1 / fmaxf(ZS, 1e-30f);
#pragma unroll
      for (int dt = 0; dt < 4; ++dt)
#pragma unroll
          for (int r = 0; r < 16; ++r) O[dt][r] *= sc; }
    oacc = N2_OACC();
#pragma unroll
    for (int dt = 0; dt < 4; ++dt)
#pragma unroll
        for (int G = 0; G < 4; ++G) { const f32x4 a = oacc[(dt * 4 + G) * 512];
            oacc[(dt * 4 + G) * 512] = (f32x4){O[dt][4 * G] + a[0], O[dt][4 * G + 1] + a[1], O[dt][4 * G + 2] + a[2], O[dt][4 * G + 3] + a[3]};
            O[dt][4 * G] = 0.f; O[dt][4 * G + 1] = 0.f; O[dt][4 * G + 2] = 0.f; O[dt][4 * G + 3] = 0.f; }
    float mW = N2_MINIT, ZW = 0.f;
    n2_branch<2, N2_ONLINE>(C, g, listW, nW, L, Bq, O, mW, ZW, 0.f, selq, impw);
    oacc = N2_OACC();
    { ZW = xsum32(ZW); const float sc = g2 / fmaxf(ZW, 1e-30f);
#pragma unroll
      for (int dt = 0; dt < 4; ++dt)
#pragma unroll
          for (int G = 0; G < 4; ++G) { const f32x4 a = oacc[(dt * 4 + G) * 512];
              O[dt][4 * G] = O[dt][4 * G] * sc + a[0]; O[dt][4 * G + 1] = O[dt][4 * G + 1] * sc + a[1]; O[dt][4 * G + 2] = O[dt][4 * G + 2] * sc + a[2]; O[dt][4 * G + 3] = O[dt][4 * G + 3] * sc + a[3]; } }
    unsigned char* yb = C.ws + WS_YB + (size_t)t * 2048 + head * 128;
#pragma unroll
    for (int dt = 0; dt < 4; ++dt)
#pragma unroll
        for (int G = 0; G < 4; ++G) { int p = __builtin_amdgcn_cvt_pk_fp8_f32(O[dt][4 * G] * 16.f, O[dt][4 * G + 1] * 16.f, 0, false); p = __builtin_amdgcn_cvt_pk_fp8_f32(O[dt][4 * G + 2] * 16.f, O[dt][4 * G + 3] * 16.f, p, true);
            *(unsigned*)(yb + dt * 32 + 8 * G + 4 * h) = (unsigned)p; }
}

#ifndef NREP_DSA
#define NREP_DSA 1
#endif
#ifndef NREP_NSA
#define NREP_NSA 1
#endif
__device__ __forceinline__ void p6_mixers(const Ctx& C, int which  , int crep = 0) {
    const Ctx& C0_ = C;
    unsigned* counter = (unsigned*)(C.ws + WS_CTL + CTL_CNT) + 128 * crep;
    static_assert(8 * P6_WAVE_LDS <= N2_BKT, "DSA per-wave LDS vs the shared bias tables");
    LAS unsigned char* bkt = C.lds + N2_BKT; LAS float* tbl = (LAS float*)(C.lds + N2_TBL);
    for (int d = C.tid; d <= 2048; d += NTHREADS) { int b;
        if (d < 16) b = d; else { b = 16 + (int)(logf((float)d / 16.f) / logf(128.f) * 16.f); b = b < 31 ? b : 31; }
        bkt[d] = (unsigned char)b; }
    for (int i = C.tid; i < 1024; i += NTHREADS) tbl[i] = C.in[I_RELB][i];
    __syncthreads();
    if (which != 1) {
        LAS int* slot = (LAS int*)(C.lds + N2_UNI + 48);
#pragma unroll 1
        for (int rep = 0; rep < NREP_NSA; ++rep)
        for (;;) {
            __syncthreads();
            if (C.tid == 0) *slot = (int)atomicAdd(counter + 64 + 128 * rep, 1u);
            __syncthreads();
            const int it = *slot;
            if (it >= 1024) break;
            nsa2_item(C, 255 - (it >> 2), it & 3);
#pragma unroll 1
            for (int c = 0; c < 3; ++c) { const int j = it + 1024 * c; if (j >= 2560) break;
                __syncthreads();
                Ctx C = C0_; { int t_ = threadIdx.x; asm volatile("" : "+v"(t_)); C.tid = t_; C.lane = t_ & 63; C.wave = __builtin_amdgcn_readfirstlane(t_ >> 6); }
                if (j < 512) tconv_tile_f8<false>(C, C.in[I_WBA], 4096, C.ws + WS_WBA, 2048, (j / 16) * 128, (j % 16) * 128);
                else if (j < 1024) { const int i = j - 512; tconv_tile_f8<false>(C, C.in[I_WBB], 4096, C.ws + WS_WBB, 2048, (i / 16) * 128, (i % 16) * 128); }
                else if (j < 2048) { const int i = j - 1024; tconv_tile_f8<false>(C, C.in[I_WOUT], 4096, C.ws + WS_WOUT, 4096, (i / 32) * 128, (i % 32) * 128); }
                else { const int i = j - 2048; wq_subkey_tile(C, i >> 5, (i & 31) * 128); } }
        }
        __syncthreads();
    }
    if (which != 2) {
        LAS unsigned char* wl = C.lds + C.wave * P6_WAVE_LDS;
#pragma unroll 1
        for (int rep = 0; rep < NREP_DSA; ++rep)
        for (;;) {
            int it = 0;
            if (C.lane == 0) it = (int)atomicAdd(counter + 128 * rep, 1u);
            it = __builtin_amdgcn_readfirstlane(it);
            if (it >= 8192) break;
            if (C.wave >= 4) __builtin_amdgcn_s_setprio(2);
            dsa_item(C, 8191 - it, wl, bkt, tbl, (rep < NREP_DSA - 1) ? DSA_PROBE_MODE : 0);
#pragma unroll 1
            for (int rr = 0; rr < 4; ++rr) peer_row_convert(C, 4 * it + rr, C.lane);
        }
        __builtin_amdgcn_s_setprio(0);
        __syncthreads();
    }
}

static __device__ const unsigned P12_IJ4[16] = {
    0xE0331000u, 0xF0401101u, 0xFF411202u, 0xFF421303u, 0xFF501404u, 0xFF511505u, 0xFF601606u, 0xFF611707u, 0xFF702008u, 0xFF712109u, 0xFF80220Au, 0xFF90230Bu, 0xFFA0240Cu, 0xFFB0300Du, 0xFFC0310Eu, 0xFFD0320Fu };
typedef __bf16 bf16x32_t __attribute__((ext_vector_type(32)));
typedef unsigned u32x16 __attribute__((ext_vector_type(16)));
typedef _Float16 h2_t __attribute__((ext_vector_type(2)));
typedef _Float16 h32_t __attribute__((ext_vector_type(32)));
__device__ __forceinline__ unsigned rowmax_u(unsigned v) { v = umaxu(v, dppu<0xB1>(v)); v = umaxu(v, dppu<0x4E>(v)); v = umaxu(v, dppu<0x141>(v)); v = umaxu(v, dppu<0x140>(v)); return v; }
__device__ __forceinline__ float rowmax_f(float v) { v = fmax_fast(v, dppf<0xB1>(v)); v = fmax_fast(v, dppf<0x4E>(v)); v = fmax_fast(v, dppf<0x141>(v)); v = fmax_fast(v, dppf<0x140>(v)); return v; }
__device__ __forceinline__ float rowsum_f(float v) { v += dppf<0xB1>(v); v += dppf<0x4E>(v); v += dppf<0x141>(v); v += dppf<0x140>(v); return v; }
#define P12_CE(a_, b_) do { const unsigned hi_ = umaxu(a_, b_), lo_ = (a_) < (b_) ? (a_) : (b_); a_ = hi_; b_ = lo_; } while (0)
__device__ __forceinline__ void p12_route(const bf16_t* srow, LAS float* tops, LAS int* topi, LAS unsigned short* exl, LAS float* gtl, int lane, unsigned ij4) {
    const int row = lane >> 4, l16 = lane & 15;
#pragma unroll 1
    for (int q = 0; q < 4; ++q) {
        const int p = 4 * q + row;
        const u32x4 raw = *(const u32x4*)(srow + p * 128 + 8 * l16);
        unsigned k[8];
#pragma unroll
        for (int e = 0; e < 8; ++e) { const unsigned bits = (e & 1) ? (raw[e >> 1] & 0xFFFF0000u) : (raw[e >> 1] << 16);
            k[e] = ((bits ^ ((bits >> 31) ? 0xFFFFFFFFu : 0x80000000u)) & 0xFFFFFF80u) | (unsigned)(127 - (8 * l16 + e)); }
        P12_CE(k[0], k[2]); P12_CE(k[1], k[3]); P12_CE(k[4], k[6]); P12_CE(k[5], k[7]);
        P12_CE(k[0], k[4]); P12_CE(k[1], k[5]); P12_CE(k[2], k[6]); P12_CE(k[3], k[7]);
        P12_CE(k[0], k[1]); P12_CE(k[2], k[3]); P12_CE(k[4], k[5]); P12_CE(k[6], k[7]);
        P12_CE(k[2], k[4]); P12_CE(k[3], k[5]);
        P12_CE(k[1], k[4]); P12_CE(k[3], k[6]);
        P12_CE(k[1], k[2]); P12_CE(k[3], k[4]); P12_CE(k[5], k[6]);
        unsigned myW = 0u;
#pragma unroll
        for (int r = 0; r < 16; ++r) {
            const unsigned W = rowmax_u(k[0]);
            const bool pop = k[0] == W;
#pragma unroll
            for (int e = 0; e < 7; ++e) k[e] = pop ? k[e + 1] : k[e];
            k[7] = pop ? 0u : k[7];
            myW = (l16 == r) ? W : myW;
        }
        const unsigned sb = myW & 0xFFFFFF80u;
        const unsigned bits = (sb & 0x80000000u) ? (sb ^ 0x80000000u) : ((~sb) & 0xFFFF0000u);
        tops[p * 16 + l16] = __uint_as_float(bits); topi[p * 16 + l16] = 127 - (int)(myW & 0x7Fu);
    }
    lds_sync();
#pragma unroll 1
    for (int q2 = 0; q2 < 2; ++q2) {
        const int hh = 4 * q2 + row;
        LAS const float* t1 = tops + (2 * hh) * 16; LAS const float* t2 = t1 + 16;
        unsigned k[4];
#pragma unroll
        for (int c = 0; c < 4; ++c) { const unsigned ij = (ij4 >> (8 * c)) & 0xFFu; const float cv = t1[ij >> 4] + t2[ij & 15u];
            k[c] = (ij != 0xFFu) ? ((sortable(cv) & 0xFFFFFF00u) | (255u - ij)) : 0u; }
        P12_CE(k[0], k[1]); P12_CE(k[2], k[3]); P12_CE(k[0], k[2]); P12_CE(k[1], k[3]); P12_CE(k[1], k[2]);
        unsigned myW = 0u;
#pragma unroll
        for (int r = 0; r < 16; ++r) {
            const unsigned W = rowmax_u(k[0]);
            const bool pop = k[0] == W;
            k[0] = pop ? k[1] : k[0]; k[1] = pop ? k[2] : k[1]; k[2] = pop ? k[3] : k[2]; k[3] = pop ? 0u : k[3];
            myW = (l16 == r) ? W : myW;
        }
        const unsigned flat = 255u - (myW & 0xFFu); const int ci = (int)(flat >> 4), cj = (int)(flat & 15u);
        const float cv = t1[ci] + t2[cj];
        const float ev = __expf(cv - rowmax_f(cv));
        const float es = rowsum_f(ev);
        exl[hh * 16 + l16] = (unsigned short)(topi[(2 * hh) * 16 + ci] * 128 + topi[(2 * hh + 1) * 16 + cj]);
        gtl[hh * 16 + l16] = ev * __builtin_amdgcn_rcpf(es);
    }
    lds_sync();
}
#undef P12_CE
__device__ __forceinline__ float gelu_fast(float x) { const float u = 0.7978845608028654f * (x + 0.044715f * x * x * x); const float e = __expf(2.f * u); return x - x * __builtin_amdgcn_rcpf(e + 1.f); }

#ifndef P12_HI
#define P12_HI 4
#endif
__device__ __forceinline__ void p12_peer(const Ctx& C, float* dst) {
    const bf16_t* pq = (const bf16_t*)(C.ws + WS_PQ);
    const bf16_t* h2 = (const bf16_t*)(C.ws + WS_H2);
    const float* gt2 = (const float*)(C.ws + WS_MOD) + 5 * D;
    const int lane = C.lane;
    LAS unsigned char* wl = C.lds + C.wave * 8192;
    LAS unsigned short* exl = (LAS unsigned short*)wl;
    LAS float* gtl = (LAS float*)(wl + 2048);
    LAS float* tops = (LAS float*)(wl + 6144);
    LAS int* topi = (LAS int*)(wl + 7168);
    const unsigned ij4 = P12_IJ4[lane & 15];
    const unsigned lo16 = 16u * (unsigned)lane; const unsigned char* pu6 = C.ws + WS_PU; const unsigned char* pv6 = C.ws + WS_PV;
    const float* su = (const float*)(C.ws + WS_PU + 96 * MB); const float* sv = (const float*)(C.ws + WS_PV + 96 * MB);
    const unsigned char* pu4 = C.ws + WS_PU4; const unsigned char* pv4 = C.ws + WS_PV4;
    const int tstride = gridDim.x * 8;
    for (int tb = blockIdx.x * 8 + C.wave; tb < T; tb += 8 * tstride) {
        int nb = 0;
#pragma unroll 1
        for (int s = 0; s < 8; ++s) { if (tb + s * tstride >= T) break; ++nb; }
        p12_route(pq + (size_t)tb * 2048, tops, topi, exl, gtl, lane, ij4);
        const int nflat = nb * 128;
        u32x4 UA[3], VA[3], UB[3], VB[3], UC[3], VC[3], UD[3], VD[3]; float suA, svA, suB, svB, suC, svC, suD, svD;
#define P12_FMT(idx_) ((((idx_) & 15) < P12_HI) ? 6 : 4)
#define P12_LOAD(S, idx_, fmt_) do { const int e_ = __builtin_amdgcn_readfirstlane((int)exl[(idx_) < nflat ? (idx_) : nflat - 1]); \
        if ((fmt_) == 6) { const unsigned char* pu_ = pu6 + (size_t)e_ * 3072 + lo16; const unsigned char* pv_ = pv6 + (size_t)e_ * 3072 + lo16; \
            U##S[0] = *(const u32x4*)pu_; U##S[1] = *(const u32x4*)(pu_ + 1024); U##S[2] = *(const u32x4*)(pu_ + 2048); \
            V##S[0] = *(const u32x4*)pv_; V##S[1] = *(const u32x4*)(pv_ + 1024); V##S[2] = *(const u32x4*)(pv_ + 2048); su##S = su[e_]; sv##S = sv[e_]; } \
        else { const unsigned char* pu_ = pu4 + (size_t)e_ * 2176; const unsigned char* pv_ = pv4 + (size_t)e_ * 2176; \
            U##S[0] = *(const u32x4*)(pu_ + lo16); U##S[1] = *(const u32x4*)(pu_ + 1024 + lo16); su##S = bf2f(*(const bf16_t*)(pu_ + 2048 + 2 * lane)); \
            V##S[0] = *(const u32x4*)(pv_ + lo16); V##S[1] = *(const u32x4*)(pv_ + 1024 + lo16); sv##S = bf2f(*(const bf16_t*)(pv_ + 2048 + 2 * lane)); } } while (0)
#define P12_U4(w_, hh_, j_) do { \
        a0_ = dot2bf(__builtin_bit_cast(unsigned, __builtin_amdgcn_cvt_scalef32_pk_bf16_fp4((w_), 1.0f, 0)), hh_[(j_)], a0_); a1_ = dot2bf(__builtin_bit_cast(unsigned, __builtin_amdgcn_cvt_scalef32_pk_bf16_fp4((w_), 1.0f, 1)), hh_[(j_) + 1], a1_); \
        a2_ = dot2bf(__builtin_bit_cast(unsigned, __builtin_amdgcn_cvt_scalef32_pk_bf16_fp4((w_), 1.0f, 2)), hh_[(j_) + 2], a2_); a3_ = dot2bf(__builtin_bit_cast(unsigned, __builtin_amdgcn_cvt_scalef32_pk_bf16_fp4((w_), 1.0f, 3)), hh_[(j_) + 3], a3_); } while (0)
#define P12_V4(w_, oo_, j_) do { \
        oo_[(j_)] = act2_ * __builtin_amdgcn_cvt_scalef32_pk_f16_fp4((w_), 1.0f, 0) + oo_[(j_)]; oo_[(j_) + 1] = act2_ * __builtin_amdgcn_cvt_scalef32_pk_f16_fp4((w_), 1.0f, 1) + oo_[(j_) + 1]; \
        oo_[(j_) + 2] = act2_ * __builtin_amdgcn_cvt_scalef32_pk_f16_fp4((w_), 1.0f, 2) + oo_[(j_) + 2]; oo_[(j_) + 3] = act2_ * __builtin_amdgcn_cvt_scalef32_pk_f16_fp4((w_), 1.0f, 3) + oo_[(j_) + 3]; } while (0)
#define P12_COMPUTE(S, idx_, fmt_) do { float a0_ = 0.f, a1_ = 0.f, a2_ = 0.f, a3_ = 0.f; \
        if ((fmt_) == 6) { \
            const u32x16 ua_ = __builtin_bit_cast(u32x16, __builtin_amdgcn_cvt_scalef32_pk32_bf16_fp6((u32x6){U##S[0].x, U##S[0].y, U##S[0].z, U##S[0].w, U##S[1].x, U##S[1].y}, 1.0f)); \
            const u32x16 ub_ = __builtin_bit_cast(u32x16, __builtin_amdgcn_cvt_scalef32_pk32_bf16_fp6((u32x6){U##S[1].z, U##S[1].w, U##S[2].x, U##S[2].y, U##S[2].z, U##S[2].w}, 1.0f)); \
            _Pragma("unroll") for (int j = 0; j < 16; j += 4) { a0_ = dot2bf(ua_[j], hA[j], a0_); a1_ = dot2bf(ua_[j + 1], hA[j + 1], a1_); a2_ = dot2bf(ua_[j + 2], hA[j + 2], a2_); a3_ = dot2bf(ua_[j + 3], hA[j + 3], a3_); } \
            _Pragma("unroll") for (int j = 0; j < 16; j += 4) { a0_ = dot2bf(ub_[j], hB[j], a0_); a1_ = dot2bf(ub_[j + 1], hB[j + 1], a1_); a2_ = dot2bf(ub_[j + 2], hB[j + 2], a2_); a3_ = dot2bf(ub_[j + 3], hB[j + 3], a3_); } \
            const float a_ = wave_sum((a0_ + a1_) + (a2_ + a3_)) * su##S; \
            const float act_ = gelu_fast(a_) * gtl[idx_] * sv##S; const h2_t act2_ = {(_Float16)act_, (_Float16)act_}; \
            const h32_t va_ = __builtin_amdgcn_cvt_scalef32_pk32_f16_fp6((u32x6){V##S[0].x, V##S[0].y, V##S[0].z, V##S[0].w, V##S[1].x, V##S[1].y}, 1.0f); \
            _Pragma("unroll") for (int j = 0; j < 16; ++j) oA[j] = act2_ * (h2_t){va_[2 * j], va_[2 * j + 1]} + oA[j]; \
            const h32_t vb_ = __builtin_amdgcn_cvt_scalef32_pk32_f16_fp6((u32x6){V##S[1].z, V##S[1].w, V##S[2].x, V##S[2].y, V##S[2].z, V##S[2].w}, 1.0f); \
            _Pragma("unroll") for (int j = 0; j < 16; ++j) oB[j] = act2_ * (h2_t){vb_[2 * j], vb_[2 * j + 1]} + oB[j]; \
        } else { \
            P12_U4(U##S[0].x, hA, 0); P12_U4(U##S[0].y, hA, 4); P12_U4(U##S[0].z, hA, 8); P12_U4(U##S[0].w, hA, 12); \
            P12_U4(U##S[1].x, hB, 0); P12_U4(U##S[1].y, hB, 4); P12_U4(U##S[1].z, hB, 8); P12_U4(U##S[1].w, hB, 12); \
            const float a_ = wave_sum(((a0_ + a1_) + (a2_ + a3_)) * su##S); \
            const float act_ = gelu_fast(a_) * gtl[idx_] * sv##S; const h2_t act2_ = {(_Float16)act_, (_Float16)act_}; \
            P12_V4(V##S[0].x, oA, 0); P12_V4(V##S[0].y, oA, 4); P12_V4(V##S[0].z, oA, 8); P12_V4(V##S[0].w, oA, 12); \
            P12_V4(V##S[1].x, oB, 0); P12_V4(V##S[1].y, oB, 4); P12_V4(V##S[1].z, oB, 8); P12_V4(V##S[1].w, oB, 12); } } while (0)
        P12_LOAD(A, 0, P12_FMT(0)); P12_LOAD(B, 1, P12_FMT(1)); P12_LOAD(C, 2, P12_FMT(2)); P12_LOAD(D, 3, P12_FMT(3));
#pragma unroll 1
        for (int s = 0; s < nb; ++s) {
            const int t = tb + s * tstride;
            if (s + 1 < nb) p12_route(pq + (size_t)(t + tstride) * 2048, tops, topi, exl + (s + 1) * 128, gtl + (s + 1) * 128, lane, ij4);
            unsigned hA[16], hB[16];
            { u32x4 ra[4], rb[4];
#pragma unroll
              for (int i = 0; i < 4; ++i) { ra[i] = *(const u32x4*)(h2 + (size_t)t * D + 16 * lane + 1024 * i); rb[i] = *(const u32x4*)(h2 + (size_t)t * D + 16 * lane + 1024 * i + 8); }
#pragma unroll
              for (int q = 0; q < 4; ++q) {
                  hA[2 * q] = __builtin_amdgcn_perm(ra[1][q], ra[0][q], 0x05040100u); hA[2 * q + 1] = __builtin_amdgcn_perm(ra[1][q], ra[0][q], 0x07060302u);
                  hA[8 + 2 * q] = __builtin_amdgcn_perm(rb[1][q], rb[0][q], 0x05040100u); hA[8 + 2 * q + 1] = __builtin_amdgcn_perm(rb[1][q], rb[0][q], 0x07060302u);
                  hB[2 * q] = __builtin_amdgcn_perm(ra[3][q], ra[2][q], 0x05040100u); hB[2 * q + 1] = __builtin_amdgcn_perm(ra[3][q], ra[2][q], 0x07060302u);
                  hB[8 + 2 * q] = __builtin_amdgcn_perm(rb[3][q], rb[2][q], 0x05040100u); hB[8 + 2 * q + 1] = __builtin_amdgcn_perm(rb[3][q], rb[2][q], 0x07060302u); } }
            h2_t oA[16], oB[16];
#pragma unroll
            for (int j = 0; j < 16; ++j) { oA[j] = (h2_t){(_Float16)0.f, (_Float16)0.f}; oB[j] = (h2_t){(_Float16)0.f, (_Float16)0.f}; }
#pragma unroll 1
            for (int hh = 0; hh < 8; ++hh) {
                const int f0 = s * 128 + hh * 16;
#pragma unroll
                for (int k = 0; k < 16; k += 4) {
                    P12_COMPUTE(A, f0 + k, P12_FMT(k)); P12_LOAD(A, f0 + k + 4, P12_FMT(k + 4));
                    P12_COMPUTE(B, f0 + k + 1, P12_FMT(k + 1)); P12_LOAD(B, f0 + k + 5, P12_FMT(k + 5));
                    P12_COMPUTE(C, f0 + k + 2, P12_FMT(k + 2)); P12_LOAD(C, f0 + k + 6, P12_FMT(k + 6));
                    P12_COMPUTE(D, f0 + k + 3, P12_FMT(k + 3)); P12_LOAD(D, f0 + k + 7, P12_FMT(k + 7));
                }
            }
#pragma unroll
            for (int i = 0; i < 4; ++i) { const int d0 = 16 * lane + 1024 * i; const float* op = C.out + (size_t)t * D + d0; float* dp = dst + (size_t)t * D + d0;
#pragma unroll
                for (int q = 0; q < 4; ++q) { const f32x4 xv = *(const f32x4*)(op + 4 * q); const f32x4 gv = *(const f32x4*)(gt2 + d0 + 4 * q); f32x4 r;
#pragma unroll
                    for (int j = 0; j < 4; ++j) { const h2_t ov = (i < 2) ? oA[4 * q + j] : oB[4 * q + j]; r[j] = xv[j] + gv[j] * ((i & 1) ? (float)ov.y : (float)ov.x); }
                    __builtin_nontemporal_store(r, (f32x4*)(dp + 4 * q)); } }
        }
#undef P12_U4
#undef P12_V4
#undef P12_FMT
#undef P12_LOAD
#undef P12_COMPUTE
        lds_sync();
    }
}

constexpr int N_PHASES = 13;
#ifndef DBG_MIX
#define DBG_MIX 0
#endif
__global__ void __launch_bounds__(NTHREADS, 2) fwd(Args args) {
    extern __shared__ __attribute__((aligned(16))) unsigned char lds_raw[];
    Ctx C0; C0.in = args.in; C0.out = args.out; C0.ws = args.ws; C0.lds = (LAS unsigned char*)lds_raw;
    C0.tid = threadIdx.x; C0.lane = C0.tid & 63; C0.wave = __builtin_amdgcn_readfirstlane(C0.tid >> 6);
#define PHASE_CTX() Ctx C = C0; { int t_ = threadIdx.x; asm volatile("" : "+v"(t_)); C.tid = t_; C.lane = t_ & 63; C.wave = __builtin_amdgcn_readfirstlane(t_ >> 6); }
    const Ctx& C = C0;
    const int lo = args.ph_lo, hi = args.ph_hi;
    const bool fused = (hi - lo) > 1;
    volatile LAS unsigned* bst = (volatile LAS unsigned*)(C.lds + LDS_BYTES - 16);
    XcdBarrier bar; bar.bar = (unsigned*)(C.ws + WS_CTL + CTL_BAR); bar.x = 0; bar.st = bst;
    if (fused) { if (C.tid == 0) { bst[0] = 0u; bst[1] = 0u; bst[2] = 0u; bst[3] = 0u; } __syncthreads(); bar = xcd_barrier_post((unsigned*)(C.ws + WS_CTL + CTL_BAR), bst); }
#ifndef ONLY_PHASE
#define ONLY_PHASE -1
#endif
#define IN(k) (lo <= (k) && (k) < hi && (ONLY_PHASE < 0 || ONLY_PHASE == (k)))
#ifndef REP_PHASE
#define REP_PHASE -1
#endif
#define REP(k, ...) if (REP_PHASE == (k)) { __VA_ARGS__ }
#define SEAM(k) do { if (IN(k) && IN((k) + 1)) xcd_barrier(bar); } while (0)
    const float* mod = (const float*)(C.ws + WS_MOD);
    bf16_t* proj = (bf16_t*)(C.ws + WS_PROJ);
    if (IN(0)) { PHASE_CTX(); REP(0, p0_prologue(C); __syncthreads();) p0_prologue(C); } SEAM(0);
    if (IN(1)) { PHASE_CTX(); norm_mod_phase(C, C.in[I_X], C.in[I_GMIX], mod + 0 * D, mod + 1 * D, (bf16_t*)(C.ws + WS_H), C.ws + WS_H8); } SEAM(1);
    if (IN(2)) { PHASE_CTX(); pg8::Gemm g{(const bf16_t*)(C.ws + WS_H), (const bf16_t*)(C.ws + WS_WIN), T, NP_BF, D, D, D}; pg8::StaticOrder S; S.init(T, NP_BF, gridDim.x, blockIdx.x);
                 pg8::EpiPlain E{proj, NP, 1.f}; pg8::gemm_phase(C.lds, g, S, E);
                 pg8::Gemm g8{(const bf16_t*)(C.ws + WS_H8), (const bf16_t*)(C.ws + WS_WIN8), T, NP_F8, D / 2, D / 2, D / 2}; pg8::Fp8Order S8{(int)blockIdx.x};
                 pg8::EpiSigU8 E8{(unsigned char*)(proj + P_GM), NP * 2, 1.f / 64.f}; pg8::gemm_phase<pg8::EpiSigU8, pg8::Fp8Order, true>(C.lds, g8, S8, E8); } SEAM(2);
    if (IN(3)) { PHASE_CTX(); p3_post(C); } SEAM(3);
    if (IN(4)) { PHASE_CTX(); pg8::Gemm g{(const bf16_t*)(C.ws + WS_KC), (const bf16_t*)(C.ws + WS_W1T), 8192, 512, 512, 2048, D}; pg8::CmpOrder S{(int)gridDim.x, (int)blockIdx.x};
                 pg8::EpiSlab E{(float*)(C.ws + WS_HIDP)}; pg8::gemm_phase(C.lds, g, S, E); } SEAM(4);
    if (IN(5)) { PHASE_CTX(); p5_cmp_out(C); } SEAM(5);
    if (IN(6)) { PHASE_CTX(); p6_mixers(C, DBG_MIX); } SEAM(6);
    if (IN(7)) { PHASE_CTX(); pg8::Gemm g{(const bf16_t*)(C.ws + WS_YA), (const bf16_t*)(C.ws + WS_WBA), T, D, 1024, 1024, 1024};   pg8::StaticOrder S; S.init(T, D, gridDim.x, blockIdx.x);
                 pg8::EpiGate<0> E{(bf16_t*)(C.ws + WS_MERGED), D, (const unsigned char*)(proj + P_GM), NP * 2, 1.f / (16.f * 64.f * 255.f), nullptr}; pg8::gemm_phase<pg8::EpiGate<0>, pg8::StaticOrder, true>(C.lds, g, S, E); } if (IN(7) && IN(8)) __syncthreads();
    if (IN(8)) { PHASE_CTX(); pg8::Gemm g{(const bf16_t*)(C.ws + WS_YB), (const bf16_t*)(C.ws + WS_WBB), T, D, 1024, 1024, 1024}; pg8::StaticOrder S; S.init(T, D, gridDim.x, blockIdx.x);
                 pg8::EpiGate<1> E{(bf16_t*)(C.ws + WS_MERGED), D, (const unsigned char*)(proj + P_GM) + 4096, NP * 2, 1.f / (16.f * 64.f * 255.f), C.ws + WS_H8}; pg8::gemm_phase<pg8::EpiGate<1>, pg8::StaticOrder, true>(C.lds, g, S, E); } SEAM(8);
    if (IN(9)) { PHASE_CTX(); pg8::Gemm g{(const bf16_t*)(C.ws + WS_H8), (const bf16_t*)(C.ws + WS_WOUT), T, D, D / 2, D / 2, D / 2};   pg8::StaticOrder S; S.init(T, D, gridDim.x, blockIdx.x);
                 pg8::EpiResid E{C.out, C.in[I_X], mod + 2 * D, D, 1.f / (32.f * 64.f)}; pg8::gemm_phase<pg8::EpiResid, pg8::StaticOrder, true>(C.lds, g, S, E); } SEAM(9);
    if (IN(10)) { PHASE_CTX(); norm_mod_phase(C, C.out, C.in[I_GFFN], mod + 3 * D, mod + 4 * D, (bf16_t*)(C.ws + WS_H2)); } SEAM(10);
    if (IN(11)) { PHASE_CTX(); pg8::Gemm g{(const bf16_t*)(C.ws + WS_H2), (const bf16_t*)(C.ws + WS_WQ), T, 2048, D, D, D}; pg8::StaticOrder S; S.init(T, 2048, gridDim.x, blockIdx.x);
                  pg8::EpiPlain E{(bf16_t*)(C.ws + WS_PQ), 2048, 1.f}; pg8::gemm_phase(C.lds, g, S, E); } SEAM(11);
    if (IN(12)) { PHASE_CTX(); REP(12, p12_peer(C, (float*)(C.ws + WS_PROJ)); __syncthreads();) p12_peer(C, C.out); }
#undef IN
#undef SEAM
}

#ifndef N_LAUNCH_MODE
#define N_LAUNCH_MODE 1
#endif
extern "C" void kernel_launch(void* const* d_in, const int* in_sizes, int n_in, void* d_out, int out_size, void* d_ws, size_t ws_size, hipStream_t stream) {
    static int grid = 0;
    if (grid == 0) {
        if (n_in != 27 || out_size != T * D || ws_size < WS_END) { fprintf(stderr, "kernel_launch: unexpected shapes (n_in %d out %d ws %zu need %zu)\n", n_in, out_size, ws_size, (size_t)WS_END); grid = -1; return; }
        int dev = 0, cus = 0;
        if (hipGetDevice(&dev) != hipSuccess || hipDeviceGetAttribute(&cus, hipDeviceAttributeMultiprocessorCount, dev) != hipSuccess) { grid = -1; return; }
        if (hipFuncSetAttribute((const void*)fwd, hipFuncAttributeMaxDynamicSharedMemorySize, LDS_BYTES) != hipSuccess) { fprintf(stderr, "kernel_launch: hipFuncSetAttribute failed\n"); grid = -1; return; }
        int per_cu = 0;
        if (hipOccupancyMaxActiveBlocksPerMultiprocessor(&per_cu, (const void*)fwd, NTHREADS, LDS_BYTES) != hipSuccess || per_cu < 1) { fprintf(stderr, "kernel_launch: occupancy query says %d\n", per_cu); }
        (void)hipGetLastError();
        grid = cus;
    }
    if (grid < 0) return;
    (void)hipMemsetAsync((char*)d_ws + WS_CTL, 0, 64 * 1024, stream);
    Args a{};
    for (int i = 0; i < 27; ++i) a.in[i] = (const float*)d_in[i];
    a.out = (float*)d_out; a.ws = (unsigned char*)d_ws;
#if N_LAUNCH_MODE == 1
    a.ph_lo = 0; a.ph_hi = N_PHASES;
    hipLaunchKernelGGL(fwd, dim3(grid), dim3(NTHREADS), LDS_BYTES, stream, a);
#else
    for (int p = 0; p < N_PHASES; ++p) { a.ph_lo = p; a.ph_hi = p + 1; hipLaunchKernelGGL(fwd, dim3(grid), dim3(NTHREADS), LDS_BYTES, stream, a); }
#endif
}
```

```cpp
#include <hip/hip_runtime.h>
#include <cstdio>
#include <cstdint>

#define LAS __attribute__((address_space(3)))
typedef unsigned short bf16_t;
typedef unsigned long long u64;
typedef short bf16x8 __attribute__((ext_vector_type(8)));
typedef float f32x4 __attribute__((ext_vector_type(4)));
typedef float f32x16 __attribute__((ext_vector_type(16)));
typedef unsigned u32x4 __attribute__((ext_vector_type(4)));
typedef unsigned u32x2 __attribute__((ext_vector_type(2)));
typedef __bf16 bf2_t __attribute__((ext_vector_type(2)));
typedef float f32x2 __attribute__((ext_vector_type(2)));
typedef float f32x32 __attribute__((ext_vector_type(32)));
typedef unsigned u32x6 __attribute__((ext_vector_type(6)));
typedef _Float16 hx2_t __attribute__((ext_vector_type(2)));

constexpr int T = 16384, D = 4096, NP = 18688;
constexpr int P_QA = 0, P_KA = 2048, P_VA = 2560, P_QI = 3072, P_QB = 5120, P_KC = 7168, P_VC = 7680, P_KS = 8192, P_VS = 8704,
              P_KW = 9216, P_VW = 9728, P_KI = 10240, P_WI = 10304, P_GB = 10336, P_GM = 10496;
constexpr int NP_BF = 10496, NP_F8 = 8192;
constexpr int NCMP = 1023;
constexpr float EPS = 1e-6f;
constexpr int NTHREADS = 512;
constexpr int LDS_BYTES = 160 * 1024;

constexpr size_t MB = 1024ull * 1024ull;
constexpr size_t WS_CTL = 0;
constexpr size_t WS_MOD = 64 * 1024;
constexpr size_t WS_B1 = 192 * 1024;
constexpr size_t WS_B1P = 196 * 1024;
constexpr size_t WS_W1T = 512 * 1024;
constexpr size_t WS_SUBK = WS_W1T + 4 * MB;
constexpr size_t WS_HID = WS_SUBK + 512 * 1024;
constexpr size_t WS_KCMP = WS_HID + 8 * MB;
constexpr size_t WS_VCMPT = WS_KCMP + 1 * MB;
constexpr size_t WS_KIC = WS_VCMPT + 1 * MB;
constexpr size_t WS_KC = WS_KIC + 2 * MB;
constexpr size_t WS_VST = WS_KC + 32 * MB + 64 * 1024;
constexpr size_t WS_VWT = WS_VST + 16 * MB;
constexpr size_t WS_WBA = WS_VWT + 16 * MB;
constexpr size_t WS_WBB = WS_WBA + 16 * MB;
constexpr size_t WS_WOUT = WS_WBB + 16 * MB;
constexpr size_t WS_WQ = WS_WOUT + 32 * MB;
constexpr size_t WS_PU = WS_WQ + 16 * MB;
constexpr size_t WS_PV = WS_PU + 128 * MB;
constexpr size_t WS_PU4 = WS_PU + 56 * MB, WS_PV4 = WS_PV + 56 * MB;
constexpr size_t WS_PROJ = WS_PV + 128 * MB;
constexpr size_t WS_WIN = WS_PROJ + (size_t)T * NP * 2;
constexpr size_t WS_H = WS_WIN + (size_t)NP * D * 2;
constexpr size_t WS_KA = WS_H + 128 * MB;
constexpr size_t WS_VA = WS_KA + 16 * MB;
constexpr size_t WS_KSC = WS_VA + 16 * MB;
constexpr size_t WS_KWC = WS_KSC + 16 * MB;
constexpr size_t WS_HIDP = WS_KWC + 16 * MB;
constexpr size_t WS_OACC = WS_HIDP + 64 * MB;
constexpr size_t WS_H8 = WS_OACC + 32 * MB;
constexpr size_t WS_END = WS_H8 + 64 * MB;
constexpr size_t WS_WIN8 = WS_WIN + (size_t)NP_BF * D * 2;
constexpr size_t WS_YA = WS_WIN, WS_YB = WS_WIN + 64 * MB, WS_H2 = WS_WIN;
constexpr size_t WS_MERGED = WS_H, WS_PQ = WS_H;
constexpr size_t CTL_BAR = 0, CTL_CNT = 16384;

__device__ __forceinline__ float bf2f(bf16_t b) { return __uint_as_float(((unsigned)b) << 16); }
__device__ __forceinline__ float bflo(unsigned u) { return __uint_as_float(u << 16); }
__device__ __forceinline__ float bfhi(unsigned u) { return __uint_as_float(u & 0xFFFF0000u); }
__device__ __forceinline__ unsigned cvt_pk_bf16(float lo, float hi) { unsigned r; asm volatile("v_cvt_pk_bf16_f32 %0, %1, %2" : "=v"(r) : "v"(lo), "v"(hi)); return r; }
__device__ __forceinline__ bf16_t f2bf(float f) { return (bf16_t)(cvt_pk_bf16(f, 0.f) & 0xFFFFu); }
__device__ __forceinline__ float dot2bf(unsigned a, unsigned b, float c) { return __builtin_amdgcn_fdot2_f32_bf16(__builtin_bit_cast(bf2_t, a), __builtin_bit_cast(bf2_t, b), c, false); }
template <int CTRL> __device__ __forceinline__ float dppf(float v) { return __builtin_bit_cast(float, __builtin_amdgcn_update_dpp(0, __builtin_bit_cast(int, v), CTRL, 0xF, 0xF, true)); }
template <int CTRL> __device__ __forceinline__ unsigned dppu(unsigned v) { return (unsigned)__builtin_amdgcn_update_dpp(0, (int)v, CTRL, 0xF, 0xF, true); }
__device__ __forceinline__ void swap32f(float& a, float& b) { asm volatile("s_nop 1\n\tv_permlane32_swap_b32 %0, %1" : "+v"(a), "+v"(b)); }
__device__ __forceinline__ void swap16f(float& a, float& b) { asm volatile("s_nop 1\n\tv_permlane16_swap_b32 %0, %1" : "+v"(a), "+v"(b)); }
__device__ __forceinline__ void swap32u(unsigned& a, unsigned& b) { asm volatile("s_nop 1\n\tv_permlane32_swap_b32 %0, %1" : "+v"(a), "+v"(b)); }
__device__ __forceinline__ void swap16u(unsigned& a, unsigned& b) { asm volatile("s_nop 1\n\tv_permlane16_swap_b32 %0, %1" : "+v"(a), "+v"(b)); }
__device__ __forceinline__ float fmax_fast(float a, float b) { float r; asm("v_max_f32 %0, %1, %2" : "=v"(r) : "v"(a), "v"(b)); return r; }
__device__ __forceinline__ float xsum32(float v) { float a = v, b = v; swap32f(a, b); return a + b; }
__device__ __forceinline__ float xsum16(float v) { float a = v, b = v; swap16f(a, b); return a + b; }
__device__ __forceinline__ float xmax32(float v) { float a = v, b = v; swap32f(a, b); return fmax_fast(a, b); }
__device__ __forceinline__ float xmax16(float v) { float a = v, b = v; swap16f(a, b); return fmax_fast(a, b); }
__device__ __forceinline__ float xor32f(float v, int h) { float a = v, b = v; swap32f(a, b); return h ? a : b; }
__device__ __forceinline__ float wave_sum(float v) { v += dppf<0xB1>(v); v += dppf<0x4E>(v); v += dppf<0x141>(v); v += dppf<0x140>(v); return xsum16(xsum32(v)); }
__device__ __forceinline__ float wave_max(float v) { v = fmax_fast(v, dppf<0xB1>(v)); v = fmax_fast(v, dppf<0x4E>(v)); v = fmax_fast(v, dppf<0x141>(v)); v = fmax_fast(v, dppf<0x140>(v)); return xmax16(xmax32(v)); }
__device__ __forceinline__ unsigned umaxu(unsigned a, unsigned b) { return a > b ? a : b; }
__device__ __forceinline__ unsigned wave_maxu(unsigned v) { v = umaxu(v, dppu<0xB1>(v)); v = umaxu(v, dppu<0x4E>(v)); v = umaxu(v, dppu<0x141>(v)); v = umaxu(v, dppu<0x140>(v));
    unsigned a = v, b = v; swap32u(a, b); v = umaxu(a, b); a = v; b = v; swap16u(a, b); return umaxu(a, b); }
__device__ __forceinline__ void lds_sync() { asm volatile("s_waitcnt lgkmcnt(0)" ::: "memory"); __builtin_amdgcn_wave_barrier(); }
__device__ __forceinline__ float gelu_tanh(float x) { const float u = 0.7978845608028654f * (x + 0.044715f * x * x * x); const float e = __expf(2.f * u); return 0.5f * x * (2.f - 2.f / (e + 1.f)); }
__device__ __forceinline__ float sigmoidf_(float x) { return __builtin_amdgcn_rcpf(1.f + __expf(-x)); }
__device__ __forceinline__ unsigned sortable(float s) { unsigned b = __float_as_uint(s); return b ^ ((b >> 31) ? 0xFFFFFFFFu : 0x80000000u); }

#define XB_TMO      128
#define XB_XCNT(j)  (256  + 64 * (j))
#define XB_XSUB(j)  (1280 + 64 * (j))
#define XB_XGEN(j)  (2304 + 64 * (j))
#define XB_TOP      3328
#define XB_TOPGEN   3392
#define XCD_BAR_WORDS 3456
#define XB_SPIN_CAP (1u << 24)
__device__ __forceinline__ unsigned xb_ld(unsigned* p)              { return __hip_atomic_load(p, __ATOMIC_RELAXED, __HIP_MEMORY_SCOPE_AGENT); }
__device__ __forceinline__ unsigned xb_add(unsigned* p, unsigned v) { return __hip_atomic_fetch_add(p, v, __ATOMIC_RELAXED, __HIP_MEMORY_SCOPE_AGENT); }
__device__ __forceinline__ unsigned xb_xcc_id() { return (unsigned)__builtin_amdgcn_s_getreg((3 << 11) | 20) & 0xFu; }
#define XB_SPIN(cond, bar) do { unsigned _sp = 0; while (cond) { __builtin_amdgcn_s_sleep(1); \
    if ((++_sp & 255u) == 0u) { if (xb_ld(&(bar)[XB_TMO])) break; if (_sp > XB_SPIN_CAP) { atomicAdd(&(bar)[XB_TMO], 1u); break; } } } } while (0)
struct XcdBarrier { unsigned* bar; unsigned x; volatile LAS unsigned* st; };
__device__ __forceinline__ XcdBarrier xcd_barrier_post(unsigned* bar, volatile LAS unsigned* st) {
    XcdBarrier b; b.bar = bar; b.x = xb_xcc_id(); b.st = st;
    if (threadIdx.x == 0) (void)xb_add(&bar[XB_XCNT(b.x)], 1u);
    return b;
}
__device__ __forceinline__ void xcd_barrier_complete(unsigned* bar, unsigned x, unsigned& nloc, unsigned& nx) {
    const unsigned G = gridDim.x * gridDim.y * gridDim.z;
    unsigned sum, cnt, mine, sp = 0u;
    for (;;) {
        sum = 0u; cnt = 0u; mine = 0u;
#pragma unroll
        for (unsigned j = 0; j < 16; ++j) { const unsigned c = xb_ld(&bar[XB_XCNT(j)]); sum += c; cnt += (c > 0u) ? 1u : 0u; mine = (j == x) ? c : mine; }
        if (sum == G) break;
        __builtin_amdgcn_s_sleep(1);
        if ((++sp & 255u) == 0u) { if (xb_ld(&bar[XB_TMO])) break; if (sp > XB_SPIN_CAP) { atomicAdd(&bar[XB_TMO], 1u); break; } }
    }
    nloc = mine > 0u ? mine : 1u; nx = cnt > 0u ? cnt : 1u;
}
__device__ __forceinline__ void xcd_barrier(const XcdBarrier& b) {
    asm volatile("s_waitcnt vmcnt(0)" ::: "memory");
    __syncthreads();
    if (threadIdx.x == 0) {
        unsigned* bar = b.bar;
        __builtin_amdgcn_s_waitcnt(0);
        unsigned nloc = b.st[0], nx = b.st[1];
        if (nloc == 0u) { xcd_barrier_complete(bar, b.x, nloc, nx); b.st[0] = nloc; b.st[1] = nx; }
        const unsigned old = xb_add(&bar[XB_XSUB(b.x)], 1u);
        const unsigned gen = old / nloc;
        if (old + 1u == (gen + 1u) * nloc) {
            __builtin_amdgcn_fence(__ATOMIC_RELEASE, "agent");
            asm volatile("s_waitcnt vmcnt(0)" ::: "memory");
            const unsigned og = xb_add(&bar[XB_TOP], 1u);
            const unsigned tg = og / nx;
            if (og + 1u == (tg + 1u) * nx) xb_add(&bar[XB_TOPGEN], 1u);
            else XB_SPIN(xb_ld(&bar[XB_TOPGEN]) == tg, bar);
            __builtin_amdgcn_fence(__ATOMIC_ACQUIRE, "agent");
            xb_add(&bar[XB_XGEN(b.x)], 1u);
            asm volatile("s_waitcnt vmcnt(0)" ::: "memory");
        } else {
            XB_SPIN(xb_ld(&bar[XB_XGEN(b.x)]) == gen, bar);
            __builtin_amdgcn_fence(__ATOMIC_ACQUIRE, "agent");
            asm volatile("s_waitcnt vmcnt(0)" ::: "memory");
        }
    }
    __syncthreads();
}

namespace pg8 {
constexpr int BM = 256, BK = 64, HALF = 128, HTB = HALF * BK * 2, STAGE_BYTES = 8 * HTB, NXCD = 8, WGM = 8;
__host__ __device__ __forceinline__ int lds_byte(int r, int c) { const int st = (r >> 4) * 2 + (c >> 5), rr = r & 15, cc = c & 31, ob = rr * 64 + cc * 2; return st * 1024 + (ob ^ (((ob >> 9) & 1) << 5)); }
__host__ __device__ __forceinline__ void stage_rc(int b, int& R, int& C) { const int st = b / 1024, sb = b % 1024, swz = sb ^ (((sb >> 9) & 1) << 5); R = (st >> 1) * 16 + swz / 64; C = (st & 1) * 32 + (swz % 64) / 2; }
__host__ __device__ __forceinline__ int perm32(int rho) { const int n = rho >> 4, i = rho & 15; return 8 * (i >> 2) + 4 * n + (i & 3); }
struct Unit { int pm, pn, kofs; };
struct Gemm { const bf16_t* A; const bf16_t* Bt; int M, N, K, lda, ldb; };
struct StaticOrder {
    int nM, nN, nwg, G, c;
    __host__ __device__ void init(int M, int N, int G_, int c_) { nM = M / BM; nN = N / BM; nwg = nM * nN; G = G_; c = c_; }
    __host__ __device__ bool next(int i, Unit& u) const {
        const long L = (long)i * G + c; if (L >= nwg) return false;
        int wgid = (int)L; { const int q = nwg / NXCD, r = nwg % NXCD, xcd = wgid % NXCD, off = wgid / NXCD; wgid = (xcd < r ? xcd * (q + 1) : r * (q + 1) + (xcd - r) * q) + off; }
        const int nig = WGM * nN, gid = wgid / nig, fm = gid * WGM, gsz = (nM - fm) < WGM ? (nM - fm) : WGM;
        u.pm = fm + ((wgid % nig) % gsz); u.pn = (wgid % nig) / gsz; u.kofs = 0; return true;
    }
};
struct Fp8Order {
    int c;
    __host__ __device__ bool next(int i, Unit& u) const {
        const int cnt = c < 64 ? 6 : (c < 192 ? 9 : 8); if (i >= cnt) return false;
        const int off = c < 64 ? 6 * c : (c < 192 ? 384 + 9 * (c - 64) : 1536 + 8 * (c - 192));
        const int L = off + i; u.pm = L & 63; u.pn = L >> 6; u.kofs = 0; return true; }
};
struct CmpOrder {
    int G, c;
    __host__ __device__ bool next(int i, Unit& u) const { const long L = (long)i * G + c; if (L >= 256) return false; u.pm = (int)(L & 31); u.pn = u.pm >> 4; u.kofs = (int)(L >> 5) * 512; return true; }
};

struct EpiPlain {
    static constexpr bool PERM = true;
    bf16_t* O; int ldc; float scale;
    __device__ __forceinline__ void operator()(const f32x4 (&acc)[2][2][4][2], const Unit& u, int wr, int wc, int fr, int fq) const {
        const int row0 = u.pm * BM + wr * 64 + fr, col0 = u.pn * BM + wc * 32 + 8 * fq;
#pragma unroll
        for (int ai = 0; ai < 2; ++ai)
#pragma unroll
            for (int m = 0; m < 4; ++m) { bf16_t* rowp = O + (size_t)(row0 + ai * HALF + m * 16) * ldc + col0;
#pragma unroll
                for (int bj = 0; bj < 2; ++bj) { const f32x4 v0 = acc[ai][bj][m][0] * scale, v1 = acc[ai][bj][m][1] * scale;
                    u32x4 w; w.x = cvt_pk_bf16(v0[0], v0[1]); w.y = cvt_pk_bf16(v0[2], v0[3]); w.z = cvt_pk_bf16(v1[0], v1[1]); w.w = cvt_pk_bf16(v1[2], v1[3]);
                    *(u32x4*)(rowp + bj * HALF) = w; } }
    }
};
struct EpiSigU8 {
    static constexpr bool PERM = true;
    unsigned char* O; int ldb; float scale;
    __device__ __forceinline__ void operator()(const f32x4 (&acc)[2][2][4][2], const Unit& u, int wr, int wc, int fr, int fq) const {
        const int row0 = u.pm * BM + wr * 64 + fr, col0 = u.pn * BM + wc * 32 + 8 * fq;
#pragma unroll
        for (int ai = 0; ai < 2; ++ai)
#pragma unroll
            for (int m = 0; m < 4; ++m) { unsigned char* rowp = O + (size_t)(row0 + ai * HALF + m * 16) * ldb + col0;
#pragma unroll
                for (int bj = 0; bj < 2; ++bj) { const f32x4 v0 = acc[ai][bj][m][0] * scale, v1 = acc[ai][bj][m][1] * scale;
                    unsigned w0 = 0u, w1 = 0u;
                    w0 = __builtin_amdgcn_cvt_pk_u8_f32(255.f * sigmoidf_(v0[0]), 0, w0); w0 = __builtin_amdgcn_cvt_pk_u8_f32(255.f * sigmoidf_(v0[1]), 1, w0);
                    w0 = __builtin_amdgcn_cvt_pk_u8_f32(255.f * sigmoidf_(v0[2]), 2, w0); w0 = __builtin_amdgcn_cvt_pk_u8_f32(255.f * sigmoidf_(v0[3]), 3, w0);
                    w1 = __builtin_amdgcn_cvt_pk_u8_f32(255.f * sigmoidf_(v1[0]), 0, w1); w1 = __builtin_amdgcn_cvt_pk_u8_f32(255.f * sigmoidf_(v1[1]), 1, w1);
                    w1 = __builtin_amdgcn_cvt_pk_u8_f32(255.f * sigmoidf_(v1[2]), 2, w1); w1 = __builtin_amdgcn_cvt_pk_u8_f32(255.f * sigmoidf_(v1[3]), 3, w1);
                    *(u32x2*)(rowp + bj * HALF) = (u32x2){w0, w1}; } }
    }
};
template <int SECOND> struct EpiGate {
    static constexpr bool PERM = true;
    bf16_t* O; int ldc; const unsigned char* gate; int ldg; float scale; unsigned char* O8;
    __device__ __forceinline__ void operator()(const f32x4 (&acc)[2][2][4][2], const Unit& u, int wr, int wc, int fr, int fq) const {
        const int row0 = u.pm * BM + wr * 64 + fr, col0 = u.pn * BM + wc * 32 + 8 * fq;
#pragma unroll
        for (int ai = 0; ai < 2; ++ai)
#pragma unroll
            for (int m = 0; m < 4; ++m) { const size_t row = (size_t)(row0 + ai * HALF + m * 16); bf16_t* rowp = O + row * ldc + col0; const unsigned char* gp = gate + row * ldg + col0;
#pragma unroll
                for (int bj = 0; bj < 2; ++bj) { const f32x4 v0 = acc[ai][bj][m][0] * scale, v1 = acc[ai][bj][m][1] * scale;
                    const u32x2 gv = *(const u32x2*)(gp + bj * HALF);
                    float r[8];
#pragma unroll
                    for (int e = 0; e < 4; ++e) { r[e] = (float)((gv.x >> (8 * e)) & 0xFFu) * v0[e]; r[4 + e] = (float)((gv.y >> (8 * e)) & 0xFFu) * v1[e]; }
                    if (SECOND) { const u32x4 pv = *(const u32x4*)(rowp + bj * HALF);
                        r[0] += bflo(pv.x); r[1] += bfhi(pv.x); r[2] += bflo(pv.y); r[3] += bfhi(pv.y); r[4] += bflo(pv.z); r[5] += bfhi(pv.z); r[6] += bflo(pv.w); r[7] += bfhi(pv.w);
                        int p0 = __builtin_amdgcn_cvt_pk_fp8_f32(r[0] * 32.f, r[1] * 32.f, 0, false); p0 = __builtin_amdgcn_cvt_pk_fp8_f32(r[2] * 32.f, r[3] * 32.f, p0, true);
                        int p1 = __builtin_amdgcn_cvt_pk_fp8_f32(r[4] * 32.f, r[5] * 32.f, 0, false); p1 = __builtin_amdgcn_cvt_pk_fp8_f32(r[6] * 32.f, r[7] * 32.f, p1, true);
                        *(u32x2*)(O8 + row * ldc + col0 + bj * HALF) = (u32x2){(unsigned)p0, (unsigned)p1};
                    } else {
                    u32x4 w; w.x = cvt_pk_bf16(r[0], r[1]); w.y = cvt_pk_bf16(r[2], r[3]); w.z = cvt_pk_bf16(r[4], r[5]); w.w = cvt_pk_bf16(r[6], r[7]);
                    *(u32x4*)(rowp + bj * HALF) = w; } } }
    }
};
struct EpiResid {
    static constexpr bool PERM = false;
    float* C; const float* X; const float* gt; int ldc; float scale;
    __device__ __forceinline__ void operator()(const f32x4 (&acc)[2][2][4][2], const Unit& u, int wr, int wc, int fr, int fq) const {
        const int row0 = u.pm * BM + wr * 64 + fr, col0 = u.pn * BM + wc * 32 + 4 * fq;
        f32x4 gv[2][2];
#pragma unroll
        for (int bj = 0; bj < 2; ++bj)
#pragma unroll
            for (int n = 0; n < 2; ++n) gv[bj][n] = *(const f32x4*)(gt + col0 + bj * HALF + n * 16) * scale;
#pragma unroll
        for (int ai = 0; ai < 2; ++ai)
#pragma unroll
            for (int m = 0; m < 4; ++m) { const size_t off = (size_t)(row0 + ai * HALF + m * 16) * ldc + col0;
#pragma unroll
                for (int bj = 0; bj < 2; ++bj)
#pragma unroll
                    for (int n = 0; n < 2; ++n) { const f32x4 xv = *(const f32x4*)(X + off + bj * HALF + n * 16);
                        *(f32x4*)(C + off + bj * HALF + n * 16) = xv + gv[bj][n] * acc[ai][bj][m][n]; } }
    }
};
struct EpiSlab {
    static constexpr bool PERM = false;
    float* C;
    __device__ __forceinline__ void operator()(const f32x4 (&acc)[2][2][4][2], const Unit& u, int wr, int wc, int fr, int fq) const {
        const int row0 = u.pm * BM + wr * 64 + fr, col0 = wc * 32 + 4 * fq;
        float* base = C + (size_t)(u.kofs >> 9) * 8192 * 256;
#pragma unroll
        for (int ai = 0; ai < 2; ++ai)
#pragma unroll
            for (int m = 0; m < 4; ++m) { float* rowp = base + (size_t)(row0 + ai * HALF + m * 16) * 256 + col0;
#pragma unroll
                for (int bj = 0; bj < 2; ++bj)
#pragma unroll
                    for (int n = 0; n < 2; ++n) *(f32x4*)(rowp + bj * HALF + n * 16) = acc[ai][bj][m][n]; }
    }
};

typedef int i32x8 __attribute__((ext_vector_type(8)));
template <class Epi, class Sched, bool FP8 = false>
__device__ __forceinline__ void gemm_phase(LAS unsigned char* lds, const Gemm g, const Sched& S, const Epi& E) {
    const int tid = threadIdx.x, wid = __builtin_amdgcn_readfirstlane(tid >> 6), lane = tid & 63, wr = wid >> 2, wc = wid & 3, fr = lane & 15, fq = lane >> 4;
    const int K = g.K, nt = K / BK, lda = g.lda, ldb = g.ldb;
    unsigned voffA[2], voffB[2];
#pragma unroll
    for (int i = 0; i < 2; ++i) { int R, C; stage_rc(tid * 16 + i * 8192, R, C); const int Rb = Epi::PERM ? ((R & ~31) + perm32(R & 31)) : R;
        voffA[i] = (unsigned)(R * lda + C) * 2u; voffB[i] = (unsigned)(Rb * ldb + C) * 2u; }
    const size_t kstep = (size_t)(BK * 2);
    const size_t hstepA = (size_t)HALF * lda * 2, hstepB = (size_t)HALF * ldb * 2;
    const size_t tstepA = 2 * hstepA, tstepB = 2 * hstepB;
    const unsigned ldsw = (unsigned)wid * 1024u;
    const int aoff = lds_byte(wr * 64 + fr, fq * 8), boff = lds_byte(wc * 32 + fr, fq * 8);
#define PG8_SA(b, h) (((b) * 2 + (h)) * HTB)
#define PG8_SB(b, h) ((4 + (b) * 2 + (h)) * HTB)
#define PG8_STAGE(bufoff, gbase, voff) do { _Pragma("unroll") for (int _i = 0; _i < 2; ++_i) \
        __builtin_amdgcn_global_load_lds((const unsigned*)((const char*)(gbase) + (voff)[_i]), (LAS unsigned*)(lds + (bufoff) + ldsw + _i * 8192), 16, 0, 0); } while (0)
#define PG8_LDA(dst, b, h) do { _Pragma("unroll") for (int m = 0; m < 4; ++m) { if constexpr (FP8) dst##8[m] = __builtin_shufflevector(*(const LAS i32x4_*)(lds + PG8_SA(b, h) + aoff + m * 2048), *(const LAS i32x4_*)(lds + PG8_SA(b, h) + aoff + m * 2048 + 1024), 0, 1, 2, 3, 4, 5, 6, 7); \
        else { _Pragma("unroll") for (int k = 0; k < 2; ++k) dst[m][k] = *(const LAS bf16x8*)(lds + PG8_SA(b, h) + aoff + m * 2048 + k * 1024); } } } while (0)
#define PG8_LDB(dst, b, h) do { _Pragma("unroll") for (int n = 0; n < 2; ++n) { if constexpr (FP8) dst##8[n] = __builtin_shufflevector(*(const LAS i32x4_*)(lds + PG8_SB(b, h) + boff + n * 2048), *(const LAS i32x4_*)(lds + PG8_SB(b, h) + boff + n * 2048 + 1024), 0, 1, 2, 3, 4, 5, 6, 7); \
        else { _Pragma("unroll") for (int k = 0; k < 2; ++k) dst[n][k] = *(const LAS bf16x8*)(lds + PG8_SB(b, h) + boff + n * 2048 + k * 1024); } } } while (0)
typedef int i32x4_ __attribute__((ext_vector_type(4)));
#define PG8_MMA(ai, bj, At, Bt) do { __builtin_amdgcn_s_setprio(1); _Pragma("unroll") for (int m = 0; m < 4; ++m) _Pragma("unroll") for (int n = 0; n < 2; ++n) { \
        if constexpr (FP8) asm volatile("v_mfma_scale_f32_16x16x128_f8f6f4 %0, %1, %2, %0, %3, %3 op_sel_hi:[0,0,0]" : "+v"(acc[ai][bj][m][n]) : "v"(Bt##8[n]), "v"(At##8[m]), "v"(one_scale)); \
        else { _Pragma("unroll") for (int k = 0; k < 2; ++k) acc[ai][bj][m][n] = __builtin_amdgcn_mfma_f32_16x16x32_bf16(Bt[n][k], At[m][k], acc[ai][bj][m][n], 0, 0, 0); } } \
        __builtin_amdgcn_s_setprio(0); } while (0)
#define PG8_WAIT_V(n) asm volatile("s_waitcnt vmcnt(" #n ")" ::: "memory")
#define PG8_WAIT_L(n) asm volatile("s_waitcnt lgkmcnt(" #n ")" ::: "memory")
#define PG8_BAR __builtin_amdgcn_s_barrier()
#define PG8_SCHED __builtin_amdgcn_sched_barrier(0)
    Unit cur, nxt; int ui = 0;
    if (!S.next(0, cur)) return;
    f32x4 acc[2][2][4][2];
#pragma unroll
    for (int a = 0; a < 2; ++a)
#pragma unroll
        for (int b = 0; b < 2; ++b)
#pragma unroll
            for (int m = 0; m < 4; ++m)
#pragma unroll
                for (int n = 0; n < 2; ++n) acc[a][b][m][n] = (f32x4){0.f, 0.f, 0.f, 0.f};
    bf16x8 At[4][2], B0[2][2], B1[2][2];
    i32x8 At8[4], B08[2], B18[2];
    const int one_scale = 0x7F7F7F7F;
    const char* cA = (const char*)g.A + (size_t)cur.pm * tstepA + (size_t)cur.kofs * 2; const char* cB = (const char*)g.Bt + (size_t)cur.pn * tstepB + (size_t)cur.kofs * 2;
    PG8_STAGE(PG8_SB(0, 0), cB, voffB); PG8_STAGE(PG8_SB(0, 1), cB + hstepB, voffB); PG8_STAGE(PG8_SA(0, 0), cA, voffA); PG8_STAGE(PG8_SA(0, 1), cA + hstepA, voffA);
    if (wr == 1) PG8_BAR;
    PG8_WAIT_V(2); PG8_BAR;
    PG8_STAGE(PG8_SB(1, 0), cB + kstep, voffB); PG8_STAGE(PG8_SA(1, 0), cA + kstep, voffA); PG8_STAGE(PG8_SB(1, 1), cB + hstepB + kstep, voffB);
    PG8_WAIT_V(6); PG8_BAR;
    for (;;) {
        const bool has_next = S.next(ui + 1, nxt);
        const char* nA = has_next ? (const char*)g.A + (size_t)nxt.pm * tstepA + (size_t)nxt.kofs * 2 : cA; const char* nB = has_next ? (const char*)g.Bt + (size_t)nxt.pn * tstepB + (size_t)nxt.kofs * 2 : cB;
        for (int t = 0; t < nt; t += 2) {
            const bool last = (t == nt - 2);
            const char* a1 = cA + (size_t)(t + 1) * kstep;
            const char* a2 = last ? nA : cA + (size_t)(t + 2) * kstep; const char* b2 = last ? nB : cB + (size_t)(t + 2) * kstep;
            const char* a3 = a2 + kstep; const char* b3 = b2 + kstep;
            PG8_LDB(B0, 0, 0); PG8_LDB(B1, 0, 1); PG8_SCHED; PG8_LDA(At, 0, 0); PG8_STAGE(PG8_SA(1, 1), a1 + hstepA, voffA);
            PG8_WAIT_V(8); PG8_WAIT_L(0); PG8_BAR; PG8_MMA(0, 0, At, B0); PG8_MMA(0, 1, At, B1); PG8_BAR; PG8_SCHED;
            PG8_LDA(At, 0, 1); PG8_STAGE(PG8_SB(0, 0), b2, voffB); PG8_STAGE(PG8_SB(0, 1), b2 + hstepB, voffB); PG8_STAGE(PG8_SA(0, 0), a2, voffA);
            PG8_WAIT_V(8); PG8_WAIT_L(0); PG8_BAR; PG8_MMA(1, 0, At, B0); PG8_MMA(1, 1, At, B1); PG8_BAR; PG8_SCHED;
            PG8_LDB(B0, 1, 0); PG8_LDB(B1, 1, 1); PG8_SCHED; PG8_LDA(At, 1, 0); PG8_STAGE(PG8_SA(0, 1), a2 + hstepA, voffA);
            PG8_WAIT_V(8); PG8_WAIT_L(0); PG8_BAR; PG8_MMA(0, 0, At, B0); PG8_MMA(0, 1, At, B1); PG8_BAR; PG8_SCHED;
            PG8_LDA(At, 1, 1); PG8_STAGE(PG8_SB(1, 0), b3, voffB); PG8_STAGE(PG8_SB(1, 1), b3 + hstepB, voffB); PG8_STAGE(PG8_SA(1, 0), a3, voffA);
            PG8_WAIT_V(8); PG8_WAIT_L(0); PG8_BAR; PG8_MMA(1, 0, At, B0); PG8_MMA(1, 1, At, B1); PG8_BAR; PG8_SCHED;
        }
        if (wr == 0) PG8_BAR;
        if constexpr (FP8) asm volatile("s_nop 15\n\ts_nop 15\n\ts_nop 15" ::: "memory");
        E(acc, cur, wr, wc, fr, fq);
        if (!has_next) break;
#pragma unroll
        for (int a = 0; a < 2; ++a)
#pragma unroll
            for (int b = 0; b < 2; ++b)
#pragma unroll
                for (int m = 0; m < 4; ++m)
#pragma unroll
                    for (int n = 0; n < 2; ++n) acc[a][b][m][n] = (f32x4){0.f, 0.f, 0.f, 0.f};
        cur = nxt; cA = nA; cB = nB; ++ui;
        if (wr == 1) PG8_BAR;
    }
    PG8_WAIT_V(0);
    PG8_BAR;
#undef PG8_SA
#undef PG8_SB
#undef PG8_STAGE
#undef PG8_LDA
#undef PG8_LDB
#undef PG8_MMA
#undef PG8_WAIT_V
#undef PG8_WAIT_L
#undef PG8_BAR
#undef PG8_SCHED
}
}

struct Args { const float* in[27]; float* out; unsigned char* ws; int ph_lo, ph_hi; };
struct Ctx { const float* const* in; float* out; unsigned char* ws; LAS unsigned char* lds; int tid, lane, wave; };

enum { I_X = 0, I_C, I_RELB, I_WADA, I_BADA, I_GMIX, I_WIN, I_GQA, I_GKA, I_GQB, I_GKCMP, I_GKSLC, I_GKWIN, I_PEK, I_W1K, I_W2K, I_PEV, I_W1V, I_W2V,
       I_WBA, I_WBB, I_WOUT, I_GFFN, I_WPQ, I_SUBK, I_PU, I_PV };

__device__ __forceinline__ int map_col(int c) {
    if (c < 5120) return c; if (c < 10240) return c + 96; if (c < 10336) return c - 5120; if (c < 10384) return c; if (c < 10496) return -1; return c - 112;
}

template <bool REMAP>
__device__ __forceinline__ void tconv_tile(const Ctx& C, const float* src, int srcN, bf16_t* dst, int dstK, int n0, int k0) {
    LAS float* tile = (LAS float*)C.lds;
    const int tx = C.tid & 31, ty = C.tid >> 5;
    const int nn = n0 + 4 * tx; const int sc = REMAP ? map_col(nn) : nn;
    f32x4 v[8];
#pragma unroll
    for (int i = 0; i < 8; ++i) { const int k = ty + 16 * i; v[i] = (sc >= 0) ? *(const f32x4*)(src + (size_t)(k0 + k) * srcN + sc) : (f32x4){0.f, 0.f, 0.f, 0.f}; }
#pragma unroll
    for (int i = 0; i < 8; ++i) { const int k = ty + 16 * i; LAS float* q = tile + k * 129 + 4 * tx; q[0] = v[i][0]; q[1] = v[i][1]; q[2] = v[i][2]; q[3] = v[i][3]; }
    __syncthreads();
#pragma unroll
    for (int i = 0; i < 4; ++i) { const int task = C.tid + 512 * i; const int nl = task >> 4, kc = task & 15;
        float e[8];
#pragma unroll
        for (int j = 0; j < 8; ++j) e[j] = tile[(kc * 8 + j) * 129 + nl];
        u32x4 w; w.x = cvt_pk_bf16(e[0], e[1]); w.y = cvt_pk_bf16(e[2], e[3]); w.z = cvt_pk_bf16(e[4], e[5]); w.w = cvt_pk_bf16(e[6], e[7]);
        *(u32x4*)(dst + (size_t)(n0 + nl) * dstK + k0 + kc * 8) = w; }
    __syncthreads();
}

template <bool REMAP>
__device__ __forceinline__ void tconv_tile_f8(const Ctx& C, const float* src, int srcN, unsigned char* dst, int dstK, int n0, int k0) {
    LAS float* tile = (LAS float*)C.lds;
    const int tx = C.tid & 31, ty = C.tid >> 5;
    const int nn = n0 + 4 * tx; const int sc = REMAP ? map_col(nn) : nn;
    f32x4 v[8];
#pragma unroll
    for (int i = 0; i < 8; ++i) { const int k = ty + 16 * i; v[i] = (sc >= 0) ? *(const f32x4*)(src + (size_t)(k0 + k) * srcN + sc) : (f32x4){0.f, 0.f, 0.f, 0.f}; }
#pragma unroll
    for (int i = 0; i < 8; ++i) { const int k = ty + 16 * i; LAS float* q = tile + k * 129 + 4 * tx; q[0] = v[i][0]; q[1] = v[i][1]; q[2] = v[i][2]; q[3] = v[i][3]; }
    __syncthreads();
#pragma unroll
    for (int i = 0; i < 2; ++i) { const int task = C.tid + 512 * i; const int nl = task >> 3, kc = task & 7;
        float e[16];
#pragma unroll
        for (int j = 0; j < 16; ++j) e[j] = tile[(kc * 16 + j) * 129 + nl] * 64.f;
        u32x4 w;
#pragma unroll
        for (int q4 = 0; q4 < 4; ++q4) { int p = __builtin_amdgcn_cvt_pk_fp8_f32(e[4 * q4], e[4 * q4 + 1], 0, false); p = __builtin_amdgcn_cvt_pk_fp8_f32(e[4 * q4 + 2], e[4 * q4 + 3], p, true); w[q4] = (unsigned)p; }
        *(u32x4*)(dst + (size_t)(n0 + nl) * dstK + k0 + kc * 16) = w; }
    __syncthreads();
}

__device__ __forceinline__ void wq_subkey_tile(const Ctx& C, int blk, int k0) {
    LAS float* As = (LAS float*)C.lds;
    LAS float* Bs = As + 128 * 132;
    const int tid = C.tid;
    const float* sk = C.in[I_SUBK] + (size_t)blk * 128 * 128; const float* wq = C.in[I_WPQ] + (size_t)k0 * 2048 + blk * 128;
#pragma unroll
    for (int i = 0; i < 8; ++i) { const int idx = tid + 512 * i, r = idx >> 5, c4 = idx & 31;
        const f32x4 a = *(const f32x4*)(sk + (size_t)r * 128 + 4 * c4), b = *(const f32x4*)(wq + (size_t)r * 2048 + 4 * c4);
        *(LAS f32x4*)(As + r * 132 + 4 * c4) = a; *(LAS f32x4*)(Bs + r * 132 + 4 * c4) = b; }
    __syncthreads();
    const int tn = tid >> 4, tk = tid & 15;
    float acc[4][8];
#pragma unroll
    for (int i = 0; i < 4; ++i)
#pragma unroll
        for (int j = 0; j < 8; ++j) acc[i][j] = 0.f;
#pragma unroll 2
    for (int d4 = 0; d4 < 32; ++d4) {
        f32x4 a[4], b[8];
#pragma unroll
        for (int i = 0; i < 4; ++i) a[i] = *(LAS const f32x4*)(As + (4 * tn + i) * 132 + 4 * d4);
#pragma unroll
        for (int j = 0; j < 8; ++j) b[j] = *(LAS const f32x4*)(Bs + (2 * tk + 32 * (j >> 1) + (j & 1)) * 132 + 4 * d4);
#pragma unroll
        for (int i = 0; i < 4; ++i)
#pragma unroll
            for (int j = 0; j < 8; ++j) acc[i][j] += a[i][0] * b[j][0] + a[i][1] * b[j][1] + a[i][2] * b[j][2] + a[i][3] * b[j][3];
    }
    bf16_t* dst = (bf16_t*)(C.ws + WS_WQ) + (size_t)(blk * 128 + 4 * tn) * 4096 + k0 + 2 * tk;
#pragma unroll
    for (int i = 0; i < 4; ++i)
#pragma unroll
        for (int j = 0; j < 4; ++j) *(unsigned*)(dst + (size_t)i * 4096 + 32 * j) = cvt_pk_bf16(acc[i][2 * j], acc[i][2 * j + 1]);
    __syncthreads();
}

__device__ __forceinline__ void peer_row_convert(const Ctx& C, int grow, int lane) {
            const bool second = grow >= 16384; const int row = grow & 16383;
            const float* src = C.in[second ? I_PV : I_PU] + (size_t)row * 4096;
            unsigned char* dst6 = C.ws + (second ? WS_PV : WS_PU) + (size_t)row * 3072;
            f32x16 v[4]; float am = 0.f;
#pragma unroll
            for (int i4 = 0; i4 < 4; ++i4)
#pragma unroll
                for (int q = 0; q < 4; ++q) { const f32x4 t4 = *(const f32x4*)(src + 16 * (lane + 64 * i4) + 4 * q);
                    v[i4][4 * q] = t4[0]; v[i4][4 * q + 1] = t4[1]; v[i4][4 * q + 2] = t4[2]; v[i4][4 * q + 3] = t4[3];
                    am = fmaxf(am, fmaxf(fmaxf(fabsf(t4[0]), fabsf(t4[1])), fmaxf(fabsf(t4[2]), fabsf(t4[3])))); }
            am = wave_max(am);
            const float sc = am > 0.f ? am * (1.f / 7.f) : 1.f, inv = 1.f / sc;
#pragma unroll
            for (int i4 = 0; i4 < 4; ++i4) v[i4] *= inv;
            const u32x6 pa = __builtin_amdgcn_cvt_scalef32_2xpk16_fp6_f32(v[0], v[1], 1.0f), pb = __builtin_amdgcn_cvt_scalef32_2xpk16_fp6_f32(v[2], v[3], 1.0f);
            *(u32x4*)(dst6 + 16 * lane) = (u32x4){pa[0], pa[1], pa[2], pa[3]};
            *(u32x4*)(dst6 + 1024 + 16 * lane) = (u32x4){pa[4], pa[5], pb[0], pb[1]};
            *(u32x4*)(dst6 + 2048 + 16 * lane) = (u32x4){pb[2], pb[3], pb[4], pb[5]};
            ((float*)(C.ws + (second ? WS_PV : WS_PU) + 96 * MB))[row] = sc;
            { float al = 0.f;
#pragma unroll
              for (int i4 = 0; i4 < 4; ++i4)
#pragma unroll
                  for (int j = 0; j < 16; ++j) al = fmaxf(al, fabsf(v[i4][j]));
              const float s4 = al > 0.f ? al * (1.f / 6.f) : 1.f, inv4 = 1.f / s4;
              unsigned wa[4] = {0u, 0u, 0u, 0u}, wb[4] = {0u, 0u, 0u, 0u};
#define PK4(d_) do { wa[d_] = __builtin_amdgcn_cvt_scalef32_pk_fp4_f32(wa[d_], v[0][4 * (d_)] * inv4, v[1][4 * (d_)] * inv4, 1.0f, 0); wa[d_] = __builtin_amdgcn_cvt_scalef32_pk_fp4_f32(wa[d_], v[0][4 * (d_) + 1] * inv4, v[1][4 * (d_) + 1] * inv4, 1.0f, 1); \
                     wa[d_] = __builtin_amdgcn_cvt_scalef32_pk_fp4_f32(wa[d_], v[0][4 * (d_) + 2] * inv4, v[1][4 * (d_) + 2] * inv4, 1.0f, 2); wa[d_] = __builtin_amdgcn_cvt_scalef32_pk_fp4_f32(wa[d_], v[0][4 * (d_) + 3] * inv4, v[1][4 * (d_) + 3] * inv4, 1.0f, 3); \
                     wb[d_] = __builtin_amdgcn_cvt_scalef32_pk_fp4_f32(wb[d_], v[2][4 * (d_)] * inv4, v[3][4 * (d_)] * inv4, 1.0f, 0); wb[d_] = __builtin_amdgcn_cvt_scalef32_pk_fp4_f32(wb[d_], v[2][4 * (d_) + 1] * inv4, v[3][4 * (d_) + 1] * inv4, 1.0f, 1); \
                     wb[d_] = __builtin_amdgcn_cvt_scalef32_pk_fp4_f32(wb[d_], v[2][4 * (d_) + 2] * inv4, v[3][4 * (d_) + 2] * inv4, 1.0f, 2); wb[d_] = __builtin_amdgcn_cvt_scalef32_pk_fp4_f32(wb[d_], v[2][4 * (d_) + 3] * inv4, v[3][4 * (d_) + 3] * inv4, 1.0f, 3); } while (0)
              PK4(0); PK4(1); PK4(2); PK4(3);
#undef PK4
              unsigned char* dst4 = C.ws + (second ? WS_PV4 : WS_PU4) + (size_t)row * 2176;
              *(u32x4*)(dst4 + 16 * lane) = (u32x4){wa[0], wa[1], wa[2], wa[3]};
              *(u32x4*)(dst4 + 1024 + 16 * lane) = (u32x4){wb[0], wb[1], wb[2], wb[3]};
              *(bf16_t*)(dst4 + 2048 + 2 * lane) = f2bf(sc * s4); }

}

__device__ __forceinline__ void p0_prologue(const Ctx& C) {
    constexpr int N_MOD = 256, N_WIN = (NP / 128) * (D / 128), N_W1 = 2 * 32, N_B1 = 64;
    constexpr int E0 = N_MOD, E1 = E0 + N_B1, E2 = E1 + N_WIN, E7 = E2 + N_W1, E8 = E7 + N_W1, E11 = E8;
    const int tid = C.tid;
    for (int it = blockIdx.x; it < E11; it += gridDim.x) {
        if (it < E0) {
            const int b = it; LAS float* red = (LAS float*)C.lds;
            const float* cvec = C.in[I_C]; const float* w = C.in[I_WADA];
            if (tid < 504) { const int cg = tid % 24, rs = tid / 24;
                f32x4 acc = {0.f, 0.f, 0.f, 0.f};
                const float* wp = w + 96 * b + 4 * cg;
#pragma unroll 4
                for (int k = rs; k < D; k += 21) { const float cv = cvec[k]; const f32x4 wv = *(const f32x4*)(wp + (size_t)k * 24576); acc += cv * wv; }
                *(LAS f32x4*)(red + (rs * 24 + cg) * 4) = acc; }
            __syncthreads();
            if (tid < 24) { f32x4 s = *(const f32x4*)(C.in[I_BADA] + 96 * b + 4 * tid);
                for (int rs = 0; rs < 21; ++rs) s += *(LAS f32x4*)(red + (rs * 24 + tid) * 4);
                *(f32x4*)((float*)(C.ws + WS_MOD) + 96 * b + 4 * tid) = s; }
            __syncthreads();
        } else if (it < E1) {
            const int s = (it - E0) >> 5, sl = (it - E0) & 31; const float* pe = C.in[s ? I_PEV : I_PEK]; const float* w1 = C.in[s ? I_W1V : I_W1K];
            const int e = tid & 255, half = tid >> 8; float a = 0.f;
            const int kb = sl * 128 + half * 64;
#pragma unroll 16
            for (int k = kb; k < kb + 64; ++k) a += pe[k] * w1[(size_t)k * 256 + e];
            LAS float* red = (LAS float*)C.lds; red[tid] = a; __syncthreads();
            if (tid < 256) ((float*)(C.ws + WS_B1P))[(s * 32 + sl) * 256 + tid] = red[tid] + red[tid + 256];
            __syncthreads();
        } else if (it < E2) { const int i = it - E1; const int n0 = (i / 32) * 128, k0 = (i % 32) * 128;
            if (n0 < NP_BF) tconv_tile<true>(C, C.in[I_WIN], 18576, (bf16_t*)(C.ws + WS_WIN), D, n0, k0);
            else tconv_tile_f8<true>(C, C.in[I_WIN], 18576, C.ws + WS_WIN8 - (size_t)NP_BF * D, D, n0, k0);
        } else if (it < E7) { const int i = it - E2; tconv_tile<false>(C, C.in[I_W1K], 256, (bf16_t*)(C.ws + WS_W1T), 4096, (i / 32) * 128, (i % 32) * 128);
        } else if (it < E8) { const int i = it - E7; tconv_tile<false>(C, C.in[I_W1V], 256, (bf16_t*)(C.ws + WS_W1T) + (size_t)256 * 4096, 4096, (i / 32) * 128, (i % 32) * 128);
        }
    }
}

__device__ __forceinline__ void norm_mod_phase(const Ctx& C, const float* xin, const float* gain, const float* sh, const float* sc, bf16_t* hout, unsigned char* h8out = nullptr) {
    LAS float* la = (LAS float*)C.lds; LAS float* lb = la + D;
    for (int i = C.tid; i < D / 4; i += NTHREADS) { const f32x4 g4 = *(const f32x4*)(gain + 4 * i), s4 = *(const f32x4*)(sc + 4 * i), h4 = *(const f32x4*)(sh + 4 * i);
        *(LAS f32x4*)(la + 4 * i) = g4 * (s4 + 1.f); *(LAS f32x4*)(lb + 4 * i) = h4; }
    __syncthreads();
    const int rstep = gridDim.x * 8;
    int row = blockIdx.x * 8 + C.wave;
    f32x4 v[16], vn[16];
    if (row < T) {
#pragma unroll
        for (int i = 0; i < 16; ++i) v[i] = ((const f32x4*)(xin + (size_t)row * D))[C.lane + 64 * i]; }
#pragma unroll 1
    for (; row < T; row += rstep) {
        const int nrow = row + rstep;
        if (nrow < T) {
#pragma unroll
            for (int i = 0; i < 16; ++i) vn[i] = ((const f32x4*)(xin + (size_t)nrow * D))[C.lane + 64 * i]; }
        float ss = 0.f;
#pragma unroll
        for (int i = 0; i < 16; ++i) ss += v[i][0] * v[i][0] + v[i][1] * v[i][1] + v[i][2] * v[i][2] + v[i][3] * v[i][3];
        ss = wave_sum(ss);
        const float rstd = rsqrtf(ss * (1.f / 4096.f) + EPS);
#pragma unroll
        for (int i = 0; i < 16; ++i) { const int col = 4 * (C.lane + 64 * i);
            const f32x4 a4 = *(LAS const f32x4*)(la + col), b4 = *(LAS const f32x4*)(lb + col);
            float y[4];
#pragma unroll
            for (int j = 0; j < 4; ++j) y[j] = v[i][j] * rstd * a4[j] + b4[j];
            u32x2 w; w.x = cvt_pk_bf16(y[0], y[1]); w.y = cvt_pk_bf16(y[2], y[3]);
            *(u32x2*)(hout + (size_t)row * D + col) = w;
            if (h8out) { int p = __builtin_amdgcn_cvt_pk_fp8_f32(y[0], y[1], 0, false); p = __builtin_amdgcn_cvt_pk_fp8_f32(y[2], y[3], p, true); *(unsigned*)(h8out + (size_t)row * D + col) = (unsigned)p; } }
#pragma unroll
        for (int i = 0; i < 16; ++i) v[i] = vn[i];
    }
    __syncthreads();
}

__device__ __forceinline__ void p3_post(const Ctx& C) {
    bf16_t* proj = (bf16_t*)(C.ws + WS_PROJ);
    const int tid = C.tid;
    const float qscale = 0.08838834764831845f;
    if (blockIdx.x == 0) { float a = 0.f; const float* part = (const float*)(C.ws + WS_B1P) + (size_t)(tid >> 8) * 32 * 256 + (tid & 255);
        for (int sl = 0; sl < 32; ++sl) a += part[sl * 256]; ((float*)(C.ws + WS_B1))[tid] = a; }
    for (int item = blockIdx.x; item < T / 64; item += gridDim.x) {
        const int t0 = item * 64;
#pragma unroll 1
        for (int hb = tid >> 4; hb < 64 * 44; hb += 128) {
            const int l16 = tid & 15;
            u32x4 raw[4]; bf16_t* dstp[4]; const float* gain[4]; float scl[4]; bool isk8[4];
#pragma unroll
            for (int u = 0; u < 4; ++u) { const int hr = hb + 32 * u; const int tok = hr / 44, hh = hr % 44; int col; isk8[u] = (hh >= 16 && hh < 20);
                if (hh < 16) { col = P_QA + 128 * hh; gain[u] = C.in[I_GQA]; scl[u] = qscale; dstp[u] = proj + (size_t)(t0 + tok) * NP + col; }
                else if (hh < 20) { col = P_KA + 128 * (hh - 16); gain[u] = C.in[I_GKA]; scl[u] = 1.f; dstp[u] = (bf16_t*)(C.ws + WS_KA + (size_t)(t0 + tok) * 512 + 128 * (hh - 16)); }
                else if (hh < 36) { col = P_QB + 128 * (hh - 20); gain[u] = C.in[I_GQB]; scl[u] = qscale * 1.4426950408889634f; dstp[u] = proj + (size_t)(t0 + tok) * NP + col; }
                else if (hh < 40) { col = P_KS + 128 * (hh - 36); gain[u] = C.in[I_GKSLC]; scl[u] = 1.f; dstp[u] = (bf16_t*)(C.ws + WS_KSC) + ((size_t)(hh - 36) * T + t0 + tok) * 128; }
                else { col = P_KW + 128 * (hh - 40); gain[u] = C.in[I_GKWIN]; scl[u] = 1.f; dstp[u] = (bf16_t*)(C.ws + WS_KWC) + ((size_t)(hh - 40) * T + t0 + tok) * 128; }
                raw[u] = *(const u32x4*)(proj + (size_t)(t0 + tok) * NP + col + 8 * l16); }
#pragma unroll
            for (int u = 0; u < 4; ++u) {
                float v[8] = {bflo(raw[u].x), bfhi(raw[u].x), bflo(raw[u].y), bfhi(raw[u].y), bflo(raw[u].z), bfhi(raw[u].z), bflo(raw[u].w), bfhi(raw[u].w)};
                float ss = 0.f;
#pragma unroll
                for (int j = 0; j < 8; ++j) ss += v[j] * v[j];
                ss += dppf<0xB1>(ss); ss += dppf<0x4E>(ss); ss += dppf<0x141>(ss); ss += dppf<0x140>(ss);
                const float rstd = rsqrtf(ss * (1.f / 128.f) + EPS) * scl[u];
                const f32x4 g0 = *(const f32x4*)(gain[u] + 8 * l16), g1 = *(const f32x4*)(gain[u] + 8 * l16 + 4);
                if (isk8[u]) {
                    const float r8 = rstd * 64.f;
                    int p0 = __builtin_amdgcn_cvt_pk_fp8_f32(v[0] * r8 * g0[0], v[1] * r8 * g0[1], 0, false); p0 = __builtin_amdgcn_cvt_pk_fp8_f32(v[2] * r8 * g0[2], v[3] * r8 * g0[3], p0, true);
                    int p1 = __builtin_amdgcn_cvt_pk_fp8_f32(v[4] * r8 * g1[0], v[5] * r8 * g1[1], 0, false); p1 = __builtin_amdgcn_cvt_pk_fp8_f32(v[6] * r8 * g1[2], v[7] * r8 * g1[3], p1, true);
                    *(u32x2*)((unsigned char*)dstp[u] + 8 * l16) = (u32x2){(unsigned)p0, (unsigned)p1};
                } else {
                u32x4 w; w.x = cvt_pk_bf16(v[0] * rstd * g0[0], v[1] * rstd * g0[1]); w.y = cvt_pk_bf16(v[2] * rstd * g0[2], v[3] * rstd * g0[3]);
                w.z = cvt_pk_bf16(v[4] * rstd * g1[0], v[5] * rstd * g1[1]); w.w = cvt_pk_bf16(v[6] * rstd * g1[2], v[7] * rstd * g1[3]);
                *(u32x4*)(dstp[u] + 8 * l16) = w; } }
        }
        bf16_t* Kc = (bf16_t*)(C.ws + WS_KC); bf16_t* Vc = Kc + (size_t)4 * T * 128;
#pragma unroll
        for (int i = 0; i < 8; ++i) { const int idx = tid + 512 * i, tok = idx >> 6, c16 = idx & 63, g = c16 >> 4, d8 = c16 & 15;
            const bf16_t* src = proj + (size_t)(t0 + tok) * NP + 8 * c16;
            const size_t dof = ((size_t)g * T + t0 + tok) * 128 + 8 * d8;
            *(u32x4*)(Kc + dof) = *(const u32x4*)(src + P_KC);
            *(u32x4*)(Vc + dof) = *(const u32x4*)(src + P_VC);
            { const u32x4 rv = *(const u32x4*)(src + P_VA);
              u32x4 w;
              w.x = __builtin_bit_cast(unsigned, __builtin_amdgcn_cvt_pkrtz(bflo(rv.x), bfhi(rv.x))); w.y = __builtin_bit_cast(unsigned, __builtin_amdgcn_cvt_pkrtz(bflo(rv.y), bfhi(rv.y)));
              w.z = __builtin_bit_cast(unsigned, __builtin_amdgcn_cvt_pkrtz(bflo(rv.z), bfhi(rv.z))); w.w = __builtin_bit_cast(unsigned, __builtin_amdgcn_cvt_pkrtz(bflo(rv.w), bfhi(rv.w)));
              *(u32x4*)(C.ws + WS_VA + ((size_t)(t0 + tok) * 512 + 8 * c16) * 2) = w; } }
        { const int tok = tid >> 3, c8 = tid & 7;
          *(u32x4*)((bf16_t*)(C.ws + WS_KIC) + (size_t)(t0 + tok) * 64 + 8 * c8) = *(const u32x4*)(proj + (size_t)(t0 + tok) * NP + P_KI + 8 * c8); }
#pragma unroll 1
        for (int which = 0; which < 2; ++which) {
            const int pcol = which ? P_VW : P_VS; bf16_t* dstT = (bf16_t*)(C.ws + (which ? WS_VWT : WS_VST));
            LAS unsigned* tl = (LAS unsigned*)C.lds;
#pragma unroll
            for (int i = 0; i < 8; ++i) { const int idx = tid + 512 * i, tok = idx >> 6, c16 = idx & 63;
                const u32x4 v = *(const u32x4*)(proj + (size_t)(t0 + tok) * NP + pcol + 8 * c16);
                LAS unsigned* q = tl + tok * 257 + 4 * c16; q[0] = v.x; q[1] = v.y; q[2] = v.z; q[3] = v.w; }
            __syncthreads();
#pragma unroll
            for (int i = 0; i < 8; ++i) { const int task = tid + 512 * i, col = task >> 3, tc = task & 7;
                unsigned short e[8];
#pragma unroll
                for (int j = 0; j < 8; ++j) { const unsigned dw = tl[(8 * tc + j) * 257 + (col >> 1)]; e[j] = (col & 1) ? (unsigned short)(dw >> 16) : (unsigned short)(dw & 0xFFFFu); }
                u32x4 w; w.x = e[0] | ((unsigned)e[1] << 16); w.y = e[2] | ((unsigned)e[3] << 16); w.z = e[4] | ((unsigned)e[5] << 16); w.w = e[6] | ((unsigned)e[7] << 16);
                *(u32x4*)(dstT + (size_t)col * T + t0 + 8 * tc) = w; }
            __syncthreads();
        }
    }
}

__device__ __forceinline__ void p5_cmp_out(const Ctx& C) {
    const float* part = (const float*)(C.ws + WS_HIDP); const float* b1 = (const float*)(C.ws + WS_B1);
    bf16_t* kcmp = (bf16_t*)(C.ws + WS_KCMP); bf16_t* vcT = (bf16_t*)(C.ws + WS_VCMPT);
    LAS float* hl = (LAS float*)(C.lds) + C.wave * 1024;
    const int lane = C.lane;
    for (int grp = blockIdx.x * 8 + C.wave; grp < 2048; grp += gridDim.x * 8) {
        const int R0 = grp * 4; const bool isv = R0 >= 4096;
        lds_sync();
        const f32x4 bb = *(const f32x4*)(b1 + (isv ? 256 : 0) + 4 * lane);
#pragma unroll
        for (int r = 0; r < 4; ++r) { f32x4 a = bb;
#pragma unroll
            for (int ks = 0; ks < 8; ++ks) a += *(const f32x4*)(part + ((size_t)ks * 8192 + R0 + r) * 256 + 4 * lane);
            f32x4 hg; hg[0] = gelu_tanh(a[0]); hg[1] = gelu_tanh(a[1]); hg[2] = gelu_tanh(a[2]); hg[3] = gelu_tanh(a[3]);
            *(LAS f32x4*)(hl + r * 256 + 4 * lane) = hg; }
        lds_sync();
        const float* w2 = C.in[isv ? I_W2V : I_W2K];
        float acc[4][2];
#pragma unroll
        for (int r = 0; r < 4; ++r) { acc[r][0] = 0.f; acc[r][1] = 0.f; }
#pragma unroll 8
        for (int e = 0; e < 256; ++e) { const float2 wv = *(const float2*)(w2 + e * 128 + 2 * lane);
#pragma unroll
            for (int r = 0; r < 4; ++r) { const float hv = hl[r * 256 + e]; acc[r][0] += hv * wv.x; acc[r][1] += hv * wv.y; } }
#pragma unroll
        for (int r = 0; r < 4; ++r) { const int R = R0 + r, Rl = R & 4095, g = Rl >> 10, n = Rl & 1023;
            const float a0 = (n < NCMP) ? acc[r][0] : 0.f, a1 = (n < NCMP) ? acc[r][1] : 0.f;
            if (!isv) { const float ss = wave_sum(a0 * a0 + a1 * a1); const float rstd = rsqrtf(ss * (1.f / 128.f) + EPS);
                const float2 gg = *(const float2*)(C.in[I_GKCMP] + 2 * lane);
                *(unsigned*)(kcmp + (size_t)Rl * 128 + 2 * lane) = (n < NCMP) ? cvt_pk_bf16(a0 * rstd * gg.x, a1 * rstd * gg.y) : 0u; }
            else { vcT[((size_t)g * 128 + 2 * lane) * 1024 + n] = f2bf(a0); vcT[((size_t)g * 128 + 2 * lane + 1) * 1024 + n] = f2bf(a1); } }
    }
}

constexpr int P6_WAVE_LDS = 18432, P6_SHARED = 8192;
__device__ __forceinline__ f32x16 mfma32(bf16x8 a, bf16x8 b, f32x16 c) { return __builtin_amdgcn_mfma_f32_32x32x16_bf16(a, b, c, 0, 0, 0); }
__device__ __forceinline__ int swap23(int r) { return (r & 0x13) | ((r & 4) << 1) | ((r & 8) >> 1); }

__device__ __forceinline__ void topk_prune(LAS u64* buf, int& cnt, u64& tau, LAS unsigned* hist, int lane) {
    u64 e[8];
#pragma unroll
    for (int i = 0; i < 8; ++i) { const int idx = lane + 64 * i; e[i] = idx < cnt ? buf[idx] : 0ull; }
    u64 prefix = 0ull; unsigned need = 256u;
    const u64 lt = (1ull << lane) - 1ull;
#pragma unroll 1
    for (int p = 0; p < 6; ++p) {
        const int shift = 40 - 8 * p;
        *(LAS u32x4*)(hist + 4 * lane) = (u32x4){0u, 0u, 0u, 0u};
        lds_sync();
#pragma unroll
        for (int i = 0; i < 8; ++i) { const bool m = (e[i] != 0ull) && ((e[i] >> (shift + 8)) == (prefix >> (shift + 8)));
            if (m) __hip_atomic_fetch_add(hist + (unsigned)((e[i] >> shift) & 255ull), 1u, __ATOMIC_RELAXED, __HIP_MEMORY_SCOPE_WORKGROUP); }
        lds_sync();
        const u32x4 c = *(LAS u32x4*)(hist + 4 * lane);
        const unsigned tot = c.x + c.y + c.z + c.w;
        unsigned pre = tot;
        pre += (unsigned)__builtin_amdgcn_update_dpp(0, (int)pre, 0x111, 0xF, 0xF, true); pre += (unsigned)__builtin_amdgcn_update_dpp(0, (int)pre, 0x112, 0xF, 0xF, true);
        pre += (unsigned)__builtin_amdgcn_update_dpp(0, (int)pre, 0x114, 0xF, 0xF, true); pre += (unsigned)__builtin_amdgcn_update_dpp(0, (int)pre, 0x118, 0xF, 0xF, true);
        const unsigned r0 = (unsigned)__builtin_amdgcn_readlane((int)pre, 15), r1 = (unsigned)__builtin_amdgcn_readlane((int)pre, 31), r2 = (unsigned)__builtin_amdgcn_readlane((int)pre, 47), r3 = (unsigned)__builtin_amdgcn_readlane((int)pre, 63);
        const int row = lane >> 4;
        pre += (row == 1) ? r0 : (row == 2) ? (r0 + r1) : (row == 3) ? (r0 + r1 + r2) : 0u;
        const unsigned a3 = (r0 + r1 + r2 + r3) - pre, a2 = a3 + c.w, a1 = a2 + c.z, a0 = a1 + c.y;
        int found = -1; unsigned above = 0u;
        if (a3 < need && need <= a3 + c.w) { found = 3; above = a3; }
        else if (a2 < need && need <= a2 + c.z) { found = 2; above = a2; }
        else if (a1 < need && need <= a1 + c.y) { found = 1; above = a1; }
        else if (a0 < need && need <= a0 + c.x) { found = 0; above = a0; }
        const u64 bm = __ballot(found >= 0);
        const int src = bm ? (__ffsll((long long)bm) - 1) : 0;
        const int bin = __builtin_amdgcn_readlane(4 * lane + found, src); const unsigned ab = (unsigned)__builtin_amdgcn_readlane((int)above, src);
        prefix |= ((u64)(unsigned)bin) << shift; need -= ab;
        lds_sync();
    }
    tau = prefix;
    int base = 0;
#pragma unroll
    for (int i = 0; i < 8; ++i) { const bool keep = (e[i] >= tau) && (e[i] != 0ull); const u64 m = __ballot(keep);
        if (keep) buf[base + __popcll(m & lt)] = e[i]; base += __popcll(m); }
    cnt = base;
    lds_sync();
}

#ifndef DSA_PROBE_MODE
#define DSA_PROBE_MODE 0
#endif
__device__ __forceinline__ void dsa_item(const Ctx& C, int qp, LAS unsigned char* wl, LAS const unsigned char* bkt, LAS const float* tbl, int pmode = 0) {
    const int lane = C.lane, r = lane & 31, h = lane >> 5;
    const bf16_t* proj = (const bf16_t*)(C.ws + WS_PROJ); const bf16_t* kic = (const bf16_t*)(C.ws + WS_KIC);
    unsigned char* ya = C.ws + WS_YA;
    const int t0 = 2 * qp;
    LAS u64* buf0 = (LAS u64*)wl; LAS u64* buf1 = (LAS u64*)(wl + 4096);
    LAS unsigned* hist = (LAS unsigned*)(wl + 8192);
    LAS unsigned char* qst = wl + 9216;
    LAS float* pl = (LAS float*)(wl + 10240);
    LAS unsigned* idxs = (LAS unsigned*)(wl + 14336);
    const u64 lt = (1ull << lane) - 1ull;
    {
    bf16x8 A[2][4]; unsigned wp[2][8];
#pragma unroll
    for (int q = 0; q < 2; ++q) {
        const bf16_t* pr = proj + (size_t)(t0 + q) * NP;
#pragma unroll
        for (int kk = 0; kk < 4; ++kk) A[q][kk] = *(const bf16x8*)(pr + P_QI + 64 * r + 32 * h + 8 * kk);
#pragma unroll
        for (int k2 = 0; k2 < 8; ++k2) { const int reg = 2 * k2; wp[q][k2] = *(const unsigned*)(pr + P_WI + (reg & 3) + 8 * (reg >> 2) + 4 * h); }
    }
    int cnt0 = 0, cnt1 = 0; u64 tau0 = 0ull, tau1 = 0ull;
    const int nkeys = (pmode == 2) ? 0 : t0 + 2;
    LAS unsigned char* stg = wl + 9216;
    const unsigned ixo0 = (unsigned)(((lane >> 3) * 64 + 8 * ((lane & 7) ^ ((lane >> 4) & 7))) * 2), ixo1 = (unsigned)(((lane >> 3) * 64 + 8 * ((lane & 7) ^ ((4 + (lane >> 4)) & 7))) * 2);
#define IX_STAGE(j0_) do { const char* _tb = (const char*)kic + (size_t)(j0_) * 128; _Pragma("unroll") for (int _i = 0; _i < 8; ++_i) \
        __builtin_amdgcn_global_load_lds((const unsigned*)(_tb + _i * 1024 + ((_i & 1) ? ixo1 : ixo0)), (LAS unsigned*)(stg + _i * 1024), 16, 0, 0); } while (0)
    if (nkeys > 0) IX_STAGE(0);
#pragma unroll 1
    for (int j0 = 0; j0 < nkeys; j0 += 64) {
        bf16x8 BA[4], BB[4];
        asm volatile("s_waitcnt vmcnt(0)" ::: "memory");
#pragma unroll
        for (int kk = 0; kk < 4; ++kk) { const int sw = (r >> 1) & 7;
            BA[kk] = *(LAS const bf16x8*)(stg + r * 128 + 16 * ((4 * h + kk) ^ sw));
            BB[kk] = *(LAS const bf16x8*)(stg + (32 + r) * 128 + 16 * ((4 * h + kk) ^ sw)); }
        asm volatile("s_waitcnt lgkmcnt(0)" ::: "memory");
        if (j0 + 64 < nkeys) IX_STAGE(j0 + 64);
        const int kidx = j0 + lane;
        f32x16 accA0, accB0, accA1, accB1;
#pragma unroll
        for (int i = 0; i < 16; ++i) { accA0[i] = 0.f; accB0[i] = 0.f; accA1[i] = 0.f; accB1[i] = 0.f; }
#pragma unroll
        for (int kk = 0; kk < 4; ++kk) { accA0 = mfma32(A[0][kk], BA[kk], accA0); accB0 = mfma32(A[0][kk], BB[kk], accB0); }
#pragma unroll
        for (int kk = 0; kk < 4; ++kk) { accA1 = mfma32(A[1][kk], BA[kk], accA1); accB1 = mfma32(A[1][kk], BB[kk], accB1); }
        float sc[2];
        { float pA = 0.f, pB = 0.f;
#pragma unroll
          for (int i = 0; i < 16; ++i) { const float wv = (i & 1) ? bfhi(wp[0][i >> 1]) : bflo(wp[0][i >> 1]);
              const float ta = __int_as_float(max(__float_as_int(accA0[i]), 0)), tb = __int_as_float(max(__float_as_int(accB0[i]), 0));
              pA = __builtin_fmaf(ta, wv, pA); pB = __builtin_fmaf(tb, wv, pB); }
          swap32f(pA, pB); sc[0] = pA + pB; }
        __builtin_amdgcn_sched_group_barrier(0x008, 8, 0);
#pragma unroll
        for (int i = 0; i < 8; ++i) { __builtin_amdgcn_sched_group_barrier(0x008, 1, 0); __builtin_amdgcn_sched_group_barrier(0x002, 9, 0); }
        { float pA = 0.f, pB = 0.f;
#pragma unroll
          for (int i = 0; i < 16; ++i) { const float wv = (i & 1) ? bfhi(wp[1][i >> 1]) : bflo(wp[1][i >> 1]);
              const float ta = __int_as_float(max(__float_as_int(accA1[i]), 0)), tb = __int_as_float(max(__float_as_int(accB1[i]), 0));
              pA = __builtin_fmaf(ta, wv, pA); pB = __builtin_fmaf(tb, wv, pB); }
          swap32f(pA, pB); sc[1] = pA + pB; }
#pragma unroll
        for (int q = 0; q < 2; ++q) {
            const float s = sc[q];
            const bool valid = kidx <= t0 + q;
            const u64 key = ((u64)sortable(s) << 14) | (u64)(unsigned)(16383 - kidx);
            const u64 tau = q ? tau1 : tau0;
            const bool pass = valid && key > tau && (pmode != 3);
            const u64 mask = __ballot(pass);
            if (mask) {
                LAS u64* buf = q ? buf1 : buf0; int& cnt = q ? cnt1 : cnt0;
                if (pass) buf[cnt + __popcll(mask & lt)] = key;
                cnt += __popcll(mask);
                if (cnt > 512 - 64) { lds_sync(); topk_prune(buf, cnt, q ? tau1 : tau0, hist, lane); }
            }
        }
    }
#undef IX_STAGE
    lds_sync();
    if (cnt0 > 256) topk_prune(buf0, cnt0, tau0, hist, lane);
    if (cnt1 > 256) topk_prune(buf1, cnt1, tau1, hist, lane);
    if (pmode == 2) { cnt0 = min(t0 + 1, 256); cnt1 = min(t0 + 2, 256);
#pragma unroll
        for (int i = 0; i < 4; ++i) { const int j = lane + 64 * i; buf0[j] = (u64)(unsigned)(16383 - ((j * 61) % (t0 + 1))); buf1[j] = (u64)(unsigned)(16383 - ((j * 59) % (t0 + 2))); } }
    if (lane == 0) { hist[0] = (unsigned)cnt0; hist[1] = (unsigned)cnt1; }
    lds_sync();
    }
    __builtin_amdgcn_s_setprio(0);
    if (pmode == 1 || pmode == 3) return;
    const int kq = lane >> 4, l16 = lane & 15;
    LAS float* plq = (LAS float*)wl;
    LAS unsigned short* idx2 = (LAS unsigned short*)(wl + 16384);
    LAS float* invl = (LAS float*)(wl + 17408);
    const int nsel0 = (int)hist[0], nsel1 = (int)hist[1];
    { unsigned iv0[4], iv1[4];
#pragma unroll
      for (int i = 0; i < 4; ++i) { const int j = lane + 64 * i; iv0[i] = (j < nsel0) ? (16383u - (unsigned)(buf0[j] & 0x3FFFull)) : 0u; iv1[i] = (j < nsel1) ? (16383u - (unsigned)(buf1[j] & 0x3FFFull)) : 0u; }
      lds_sync();
#pragma unroll
      for (int i = 0; i < 4; ++i) { const int j = lane + 64 * i; idx2[j] = (unsigned short)iv0[i]; idx2[256 + j] = (unsigned short)iv1[i]; }
      lds_sync(); }
    const unsigned char* KAp = (const unsigned char*)(C.ws + WS_KA) + 32 * kq;
    const float lsc = 1.f / (64.f * 512.f);
#pragma unroll 1
    for (int q = 0; q < 2; ++q) {
        const int t = t0 + q; const int nsel = q ? nsel1 : nsel0; LAS const unsigned short* idxs = idx2 + 256 * q;
        const bf16_t* prq = proj + (size_t)t * NP;
        lds_sync();
        {
            long Bz[4][4];
#pragma unroll
            for (int g = 0; g < 4; ++g)
#pragma unroll
                for (int sI = 0; sI < 4; ++sI) { long z = 0;
                    if ((l16 >> 2) == g) { const u32x4 raw = *(const u32x4*)(prq + P_QA + l16 * 128 + 32 * kq + 8 * sI);
                        int p0 = __builtin_amdgcn_cvt_pk_fp8_f32(bflo(raw.x) * 512.f, bfhi(raw.x) * 512.f, 0, false); p0 = __builtin_amdgcn_cvt_pk_fp8_f32(bflo(raw.y) * 512.f, bfhi(raw.y) * 512.f, p0, true);
                        int p1 = __builtin_amdgcn_cvt_pk_fp8_f32(bflo(raw.z) * 512.f, bfhi(raw.z) * 512.f, 0, false); p1 = __builtin_amdgcn_cvt_pk_fp8_f32(bflo(raw.w) * 512.f, bfhi(raw.w) * 512.f, p1, true);
                        z = (long)(((unsigned long long)(unsigned)p1 << 32) | (unsigned long long)(unsigned)p0); }
                    Bz[g][sI] = z; }
            u32x4 A0[2][2], A1[2][2];
            { const unsigned char* kr = KAp + (size_t)idxs[l16] * 512;
#pragma unroll
              for (int g = 0; g < 2; ++g) { A0[g][0] = *(const u32x4*)(kr + g * 128); A0[g][1] = *(const u32x4*)(kr + g * 128 + 16); } }
#pragma unroll 1
            for (int tile = 0; tile < 16; ++tile) {
                { const unsigned char* kr = KAp + (size_t)idxs[16 * tile + l16] * 512 + 256;
#pragma unroll
                  for (int g = 0; g < 2; ++g) { A1[g][0] = *(const u32x4*)(kr + g * 128); A1[g][1] = *(const u32x4*)(kr + g * 128 + 16); } }
                f32x4 acc = {0.f, 0.f, 0.f, 0.f};
#pragma unroll
                for (int g = 0; g < 2; ++g)
#pragma unroll
                    for (int sI = 0; sI < 4; ++sI) { const u32x4 v = A0[g][sI >> 1]; const long a = (sI & 1) ? (long)(((unsigned long long)v.w << 32) | v.z) : (long)(((unsigned long long)v.y << 32) | v.x);
                        acc = __builtin_amdgcn_mfma_f32_16x16x32_fp8_fp8(a, Bz[g][sI], acc, 0, 0, 0); }
                asm volatile("" ::: "memory");
                if (tile < 15) { const unsigned char* kr = KAp + (size_t)idxs[16 * (tile + 1) + l16] * 512;
#pragma unroll
                    for (int g = 0; g < 2; ++g) { A0[g][0] = *(const u32x4*)(kr + g * 128); A0[g][1] = *(const u32x4*)(kr + g * 128 + 16); } }
#pragma unroll
                for (int g = 0; g < 2; ++g)
#pragma unroll
                    for (int sI = 0; sI < 4; ++sI) { const u32x4 v = A1[g][sI >> 1]; const long a = (sI & 1) ? (long)(((unsigned long long)v.w << 32) | v.z) : (long)(((unsigned long long)v.y << 32) | v.x);
                        acc = __builtin_amdgcn_mfma_f32_16x16x32_fp8_fp8(a, Bz[2 + g][sI], acc, 0, 0, 0); }
#pragma unroll
                for (int r = 0; r < 4; ++r) { const int j = 16 * tile + 4 * kq + r; const int idx = (int)idxs[j]; const bool valid = j < nsel;
                    const int b = bkt[min(max(t - idx, 0), 2048)];
                    plq[j * 16 + l16] = valid ? (acc[r] * lsc + tbl[b * 32 + l16]) : -1e30f; }
            }
        }
        lds_sync();
        {
            float mx[16];
#pragma unroll
            for (int hh = 0; hh < 16; ++hh) mx[hh] = -1e30f;
#pragma unroll 1
            for (int ps = 0; ps < 4; ++ps) { const int j = ps * 64 + lane;
#pragma unroll
                for (int c4 = 0; c4 < 4; ++c4) { const f32x4 lv = *(LAS f32x4*)(plq + 16 * j + 4 * c4);
#pragma unroll
                    for (int e = 0; e < 4; ++e) mx[4 * c4 + e] = fmaxf(mx[4 * c4 + e], lv[e]); } }
#pragma unroll
            for (int hh = 0; hh < 16; ++hh) mx[hh] = wave_max(mx[hh]);
            float zs[16];
#pragma unroll
            for (int hh = 0; hh < 16; ++hh) zs[hh] = 0.f;
#pragma unroll 1
            for (int ps = 0; ps < 4; ++ps) { const int j = ps * 64 + lane; const bool valid = j < nsel;
#pragma unroll
                for (int c4 = 0; c4 < 4; ++c4) { f32x4 lv = *(LAS f32x4*)(plq + 16 * j + 4 * c4);
#pragma unroll
                    for (int e = 0; e < 4; ++e) { const float p = valid ? __expf(lv[e] - mx[4 * c4 + e]) : 0.f; lv[e] = __builtin_bit_cast(float, __builtin_amdgcn_cvt_pkrtz(p, p)); zs[4 * c4 + e] += p; }
                    *(LAS f32x4*)(plq + 16 * j + 4 * c4) = lv; } }
#pragma unroll
            for (int hh = 0; hh < 16; ++hh) { const float z = wave_sum(zs[hh]); if (lane == 0) invl[hh] = 1.f / fmaxf(z, 1e-30f); }
        }
        lds_sync();
#pragma unroll 1
        for (int g = 0; g < 4; ++g) {
            const f32x4 inv4 = *(LAS f32x4*)(invl + 4 * g);
            hx2_t o2[4][4];
#pragma unroll
            for (int rr = 0; rr < 4; ++rr)
#pragma unroll
                for (int d = 0; d < 4; ++d) o2[rr][d] = (hx2_t){(_Float16)0.f, (_Float16)0.f};
            const unsigned char* vbase = C.ws + WS_VA + (128 * g + 8 * l16) * 2;
            const int nb = (nsel + 63) >> 6;
            u32x4 vc[16], vn[16];
#pragma unroll
            for (int u = 0; u < 16; ++u) { const int idx = (int)idxs[4 * u + kq]; vc[u] = *(const u32x4*)(vbase + (size_t)idx * 1024); }
#pragma unroll 1
            for (int bb = 0; bb < nb; ++bb) {
                { const int bn = (bb + 1 < nb) ? bb + 1 : bb;
#pragma unroll
                    for (int u = 0; u < 16; ++u) { const int idx = (int)idxs[64 * bn + 4 * u + kq]; vn[u] = *(const u32x4*)(vbase + (size_t)idx * 1024); } }
#pragma unroll
                for (int u = 0; u < 16; ++u) { const u32x4 pw = *(LAS u32x4*)(plq + 16 * (64 * bb + 4 * u + kq) + 4 * g);
#pragma unroll
                    for (int rr = 0; rr < 4; ++rr) { const unsigned pwr = pw[rr]; const hx2_t pp = __builtin_bit_cast(hx2_t, pwr);
#pragma unroll
                        for (int d = 0; d < 4; ++d) { const unsigned vd = vc[u][d]; o2[rr][d] = pp * __builtin_bit_cast(hx2_t, vd) + o2[rr][d]; } } }
#pragma unroll
                for (int u = 0; u < 16; ++u) vc[u] = vn[u];
            }
            float o[4][8];
#pragma unroll
            for (int rr = 0; rr < 4; ++rr)
#pragma unroll
                for (int d = 0; d < 4; ++d) { o[rr][2 * d] = xsum16(xsum32((float)o2[rr][d].x)) * inv4[rr]; o[rr][2 * d + 1] = xsum16(xsum32((float)o2[rr][d].y)) * inv4[rr]; }
            if (kq == 0) {
#pragma unroll
                for (int rr = 0; rr < 4; ++rr) { int p0 = __builtin_amdgcn_cvt_pk_fp8_f32(o[rr][0] * 16.f, o[rr][1] * 16.f, 0, false); p0 = __builtin_amdgcn_cvt_pk_fp8_f32(o[rr][2] * 16.f, o[rr][3] * 16.f, p0, true);
                    int p1 = __builtin_amdgcn_cvt_pk_fp8_f32(o[rr][4] * 16.f, o[rr][5] * 16.f, 0, false); p1 = __builtin_amdgcn_cvt_pk_fp8_f32(o[rr][6] * 16.f, o[rr][7] * 16.f, p1, true);
                    *(u32x2*)(ya + (size_t)t * 2048 + (4 * g + rr) * 128 + 8 * l16) = (u32x2){(unsigned)p0, (unsigned)p1}; } }
        }
    }
}

constexpr int N2_KS = 0, N2_VS = 32768, N2_LUT = 65536, N2_IMP = 81920, N2_SEL = N2_IMP + 64 * 260 * 4, N2_UNI = N2_SEL + 2048, N2_LIST = N2_UNI + 64, N2_BKT = N2_LIST + 3 * 512, N2_TBL = N2_BKT + 2304, N2_END = N2_TBL + 4096;
static_assert(N2_END <= LDS_BYTES - 16, "NSA LDS map");
struct N2Src { const bf16_t* kbase; size_t kld; int krmax; const bf16_t* vT; size_t vld; };
__device__ __forceinline__ void n2_stage(const N2Src& s, int m, bool withV, LAS unsigned char* kbuf, LAS unsigned char* vbuf, int wave, int lane) {
#pragma unroll
    for (int j = 0; j < 2; ++j) { const int slot = (wave * 2 + j) * 64 + lane; const int row = slot >> 4, ch = (slot & 15) ^ (row & 15);
        __builtin_amdgcn_global_load_lds((const unsigned*)(s.kbase + (size_t)min(64 * m + row, s.krmax) * s.kld + 8 * ch), (LAS unsigned*)(kbuf + (wave * 2 + j) * 1024), 16, 0, 0); }
    if (withV) {
#pragma unroll
        for (int j = 0; j < 2; ++j) { const int slot = (wave * 2 + j) * 64 + lane; const int row = slot >> 3, ch = (slot & 7) ^ ((row >> 1) & 7);
            __builtin_amdgcn_global_load_lds((const unsigned*)(s.vT + (size_t)row * s.vld + 64 * m + 8 * ch), (LAS unsigned*)(vbuf + (wave * 2 + j) * 1024), 16, 0, 0); } }
}
__device__ __forceinline__ f32x16 n2_qk(const bf16x8 (&Bq)[8], LAS const unsigned char* kbuf, int hf, int rho, int h) {
    const int kr = 32 * hf + rho;
    f32x16 S;
#pragma unroll
    for (int i = 0; i < 16; ++i) S[i] = 0.f;
#pragma unroll
    for (int kk = 0; kk < 8; ++kk) { const int ch = 8 * h + kk; const bf16x8 a = *(LAS const bf16x8*)(kbuf + kr * 256 + 16 * (ch ^ (rho & 15))); S = mfma32(a, Bq[kk], S); }
    return S;
}
__device__ __forceinline__ void n2_pv(f32x16 (&O)[4], const float (&p)[16], LAS const unsigned char* vbuf, int hf, int lane) {
    bf16x8 pk[2];
#pragma unroll
    for (int s = 0; s < 2; ++s) { u32x4 w; w.x = cvt_pk_bf16(p[8 * s + 0], p[8 * s + 1]); w.y = cvt_pk_bf16(p[8 * s + 2], p[8 * s + 3]); w.z = cvt_pk_bf16(p[8 * s + 4], p[8 * s + 5]); w.w = cvt_pk_bf16(p[8 * s + 6], p[8 * s + 7]);
        pk[s] = __builtin_bit_cast(bf16x8, w); }
    const int r = lane & 31, h = lane >> 5;
#pragma unroll
    for (int dt = 0; dt < 4; ++dt)
#pragma unroll
        for (int s = 0; s < 2; ++s) { const int row = dt * 32 + r, ch = 4 * hf + 2 * s + h;
            const bf16x8 a = *(LAS const bf16x8*)(vbuf + row * 128 + 16 * (ch ^ ((r >> 1) & 7))); O[dt] = mfma32(a, pk[s], O[dt]); }
}
constexpr float N2_MASKED = -3.0e38f, N2_MINIT = -1.0e30f, LOG2E = 1.4426950408889634f;
template <int MODE, bool DEFER = false>
__device__ __forceinline__ float n2_bias_mask(f32x16& S, int posbase, int t, int t0w, int h, int ncv, int ncv0, unsigned sb, bool before_cur, float b31, LAS const bf16_t* lutr, LAS const unsigned char* bkt, LAS const float* tblh) {
    bool farT, fullT;
    if (MODE == 0) { farT = (t0w - (16 * (posbase + 31) + 31)) >= 1513; fullT = (posbase + 31) < ncv0; }
    else if (MODE == 1) { farT = (t0w - (posbase + 31)) >= 1513; fullT = before_cur; }
    else { farT = false; fullT = (posbase + 31 <= t0w) && ((t0w + 7 - posbase) < 512); }
    float cbu = b31;
    if (MODE != 0 && fullT && !farT) { const int b0 = (int)bkt[min(t0w - (posbase + 31), 2048)], b1 = (int)bkt[min(t0w + 7 - posbase, 2048)];
        if (b0 == b1) { farT = true; cbu = tblh[b0 * 32] * LOG2E; } }
    if (farT && fullT) {
        if (MODE == 1 && sb == 0u) {
#pragma unroll
            for (int reg = 0; reg < 16; ++reg) S[reg] = N2_MASKED;
            return 0.f; }
        if (DEFER) return cbu;
#pragma unroll
        for (int reg = 0; reg < 16; ++reg) S[reg] = S[reg] + cbu;
    } else {
#pragma unroll
        for (int reg = 0; reg < 16; ++reg) { const int pos = posbase + (reg & 7) + 8 * h + 16 * (reg >> 3);
            const int dist = (MODE == 0) ? (t - (16 * pos + 31)) : (t - pos);
            bool v;
            if (MODE == 0) v = pos < ncv; else if (MODE == 1) v = (sb != 0u) && (pos <= t); else v = (pos <= t) && (dist < 512);
            const float bias = bf2f(lutr[min(max(dist, 0), 2047)]);
            S[reg] = v ? (S[reg] + bias) : N2_MASKED; }
    }
    return 0.f;
}
__device__ __forceinline__ float n2_tilemax(const f32x16& S) {
    float a = fmax_fast(S[0], S[1]), b = fmax_fast(S[2], S[3]), c = fmax_fast(S[4], S[5]), d = fmax_fast(S[6], S[7]);
    float e = fmax_fast(S[8], S[9]), f = fmax_fast(S[10], S[11]), g = fmax_fast(S[12], S[13]), hh = fmax_fast(S[14], S[15]);
    a = fmax_fast(a, b); c = fmax_fast(c, d); e = fmax_fast(e, f); g = fmax_fast(g, hh); a = fmax_fast(a, c); e = fmax_fast(e, g); return fmax_fast(a, e);
}
__device__ __forceinline__ void n2_stat(const f32x16& S, float& m, float& Z) {
    const float mn = fmax_fast(m, n2_tilemax(S));
    float z = 0.f;
#pragma unroll
    for (int i = 0; i < 16; ++i) z += __builtin_amdgcn_exp2f(S[i] - mn);
    Z = Z * __builtin_amdgcn_exp2f(m - mn) + z; m = mn;
}
__device__ __forceinline__ void n2_combine(float& m, float& Z) {
    float ma = m, mb = m; swap32f(ma, mb); const float M = fmax_fast(ma, mb);
    Z = xsum32(Z * __builtin_amdgcn_exp2f(m - M)); m = M;
}
enum { N2_STATS = 0, N2_IMPP = 1, N2_PV = 2, N2_ONLINE = 3, N2_IMPV = 4 };
struct N2Lane { int t, t0w, h, rho, qq, rr, lane, ncv, ncv0, ncv7, cur; float b31; LAS const bf16_t* lutr; LAS const unsigned char* bkt; LAS const float* tblh; };
template <int MODE, int PASS>
__device__ __forceinline__ void n2_branch(const Ctx& C, int g, LAS const unsigned short* list, int n, const N2Lane& L, const bf16x8 (&Bq)[8], f32x16 (&O)[4],
                                          float& m, float& Z, float scale, LAS const unsigned* selq, LAS float* impw, float scale2 = 1.f) {
    if (n <= 0) return;
    constexpr bool withV = (PASS == N2_PV || PASS == N2_ONLINE || PASS == N2_IMPV);
    constexpr int NSL = (PASS == N2_IMPV) ? 2 : 4, LA = NSL - 1;
    N2Src src;
    if (MODE == 0) { src.kbase = (const bf16_t*)(C.ws + WS_KCMP) + (size_t)g * 1024 * 128; src.kld = 128; src.krmax = 1023; src.vT = (const bf16_t*)(C.ws + WS_VCMPT) + (size_t)g * 128 * 1024; src.vld = 1024; }
    else if (MODE == 1) { src.kbase = (const bf16_t*)(C.ws + WS_KSC) + (size_t)g * T * 128; src.kld = 128; src.krmax = T - 1; src.vT = (const bf16_t*)(C.ws + WS_VST) + (size_t)g * 128 * T; src.vld = (size_t)T; }
    else { src.kbase = (const bf16_t*)(C.ws + WS_KWC) + (size_t)g * T * 128; src.kld = 128; src.krmax = T - 1; src.vT = (const bf16_t*)(C.ws + WS_VWT) + (size_t)g * 128 * T; src.vld = (size_t)T; }
    LAS unsigned char* lds = C.lds;
#define N2_KSLOT(s_) (withV ? (((s_) < 2) ? (N2_KS + (s_) * 16384) : (N2_IMP + ((s_) - 2) * 32768)) : (N2_KS + (s_) * 16384))
#define N2_VSLOT(s_) (((s_) < 2) ? (N2_VS + (s_) * 16384) : (N2_IMP + ((s_) - 2) * 32768 + 16384))
#define N2_RAW_BARRIER() do { asm volatile("s_waitcnt lgkmcnt(0)" ::: "memory"); __builtin_amdgcn_s_barrier(); asm volatile("" ::: "memory"); } while (0)
#define N2_WAIT_LANDED() do { if (LA == 1) asm volatile("s_waitcnt vmcnt(0)" ::: "memory"); else if (withV) asm volatile("s_waitcnt vmcnt(8)" ::: "memory"); else asm volatile("s_waitcnt vmcnt(4)" ::: "memory"); } while (0)
#pragma unroll
    for (int j = 0; j < LA; ++j) if (j < n) n2_stage(src, (int)list[j], withV, lds + N2_KSLOT(j), lds + N2_VSLOT(j), C.wave, C.lane);
    if (n >= LA) N2_WAIT_LANDED(); else asm volatile("s_waitcnt vmcnt(0)" ::: "memory");
    N2_RAW_BARRIER();
#pragma unroll 1
    for (int i = 0; i < n; ++i) {
        const int mb = (int)list[i];
        if (i + LA < n) { const int sl = (i + LA) & (NSL - 1); n2_stage(src, (int)list[i + LA], withV, lds + N2_KSLOT(sl), lds + N2_VSLOT(sl), C.wave, C.lane); }
        LAS const unsigned char* kbuf = lds + N2_KSLOT(i & (NSL - 1)); LAS const unsigned char* vbuf = lds + N2_VSLOT(i & (NSL - 1));
        bool need; unsigned sb = 1u;
        if (MODE == 0) need = (64 * mb) < L.ncv7;
        else if (MODE == 1) { const unsigned sw = selq[mb >> 5]; sb = (sw >> (mb & 31)) & 1u; need = __ballot(sb != 0u) != 0ull; }
        else need = (64 * mb + 63 >= L.t0w - 511) && (64 * mb <= L.t0w + 7);
        if (need) {
#pragma unroll 1
            for (int hf = 0; hf < 2; ++hf) {
                const int posbase = 64 * mb + 32 * hf;
                f32x16 S = n2_qk(Bq, kbuf, hf, L.rho, L.h);
                const float cbd = n2_bias_mask<MODE, PASS == N2_ONLINE>(S, posbase, L.t, L.t0w, L.h, L.ncv, L.ncv0, sb, mb < L.cur, L.b31, L.lutr, L.bkt, L.tblh);
                if (PASS == N2_STATS) { n2_stat(S, m, Z); }
                else if (PASS == N2_IMPP || PASS == N2_IMPV) {
                    float p[16];
#pragma unroll
                    for (int r = 0; r < 16; ++r) p[r] = __builtin_amdgcn_exp2f(S[r] - m) * scale;
#pragma unroll
                    for (int G = 0; G < 4; ++G) { float q4 = p[4 * G] + p[4 * G + 1] + p[4 * G + 2] + p[4 * G + 3], e = p[4 * G + 3];
                        q4 += dppf<0xB1>(q4); q4 += dppf<0x4E>(q4); e += dppf<0xB1>(e); e += dppf<0x4E>(e);
                        const int nb = posbase + ((4 * G) & 7) + 8 * L.h + 16 * ((4 * G) >> 3); const int mq = nb >> 2;
                        if (L.rr == 0) { __hip_atomic_fetch_add(impw + L.qq * 260 + mq, q4, __ATOMIC_RELAXED, __HIP_MEMORY_SCOPE_WORKGROUP);
                                         __hip_atomic_fetch_add(impw + L.qq * 260 + mq + 1, e, __ATOMIC_RELAXED, __HIP_MEMORY_SCOPE_WORKGROUP); } }
                    if (PASS == N2_IMPV) {
#pragma unroll
                        for (int r = 0; r < 16; ++r) p[r] *= scale2;
                        n2_pv(O, p, vbuf, hf, L.lane); }
                } else if (PASS == N2_PV) {
                    float p[16];
#pragma unroll
                    for (int r = 0; r < 16; ++r) p[r] = __builtin_amdgcn_exp2f(S[r] - m) * scale;
                    n2_pv(O, p, vbuf, hf, L.lane);
                } else {
                    const float tm = xmax32(n2_tilemax(S) + cbd);
                    const float mn = fmax_fast(m, tm);
                    if (__ballot(mn > m + 8.f)) { const float al = __builtin_amdgcn_exp2f(m - mn); Z *= al;
#pragma unroll
                        for (int dt = 0; dt < 4; ++dt)
#pragma unroll
                            for (int r = 0; r < 16; ++r) O[dt][r] *= al;
                        m = mn; }
                    float p[16]; float zs = 0.f;
                    const float c2 = cbd - m;
#pragma unroll
                    for (int r = 0; r < 16; ++r) { p[r] = __builtin_amdgcn_exp2f(S[r] + c2); zs += p[r]; }
                    Z += zs;
                    n2_pv(O, p, vbuf, hf, L.lane);
                }
            }
        }
        if (i + LA < n) N2_WAIT_LANDED(); else asm volatile("s_waitcnt vmcnt(0)" ::: "memory");
        N2_RAW_BARRIER();
    }
#undef N2_WAIT_LANDED
#undef N2_RAW_BARRIER
#undef N2_KSLOT
#undef N2_VSLOT
}

__device__ __forceinline__ void nsa2_item(const Ctx& C, int QB, int g) {
    LAS unsigned char* lds = C.lds;
    const int tid = C.tid, lane = C.lane, wave = C.wave;
    const int c = lane & 31, h = lane >> 5, qq = c >> 2, rr = c & 3;
    const int t0 = 64 * QB, t0w = t0 + 8 * wave, t = t0w + qq, head = 4 * g + rr;
    const bf16_t* proj = (const bf16_t*)(C.ws + WS_PROJ);
    LAS bf16_t* lut = (LAS bf16_t*)(lds + N2_LUT);
    LAS float* imp = (LAS float*)(lds + N2_IMP);
    LAS unsigned* selw = (LAS unsigned*)(lds + N2_SEL);
    LAS unsigned* uni = (LAS unsigned*)(lds + N2_UNI);
    LAS unsigned short* listC = (LAS unsigned short*)(lds + N2_LIST); LAS unsigned short* listS = listC + 256; LAS unsigned short* listW = listC + 512;
    LAS const unsigned char* bkt = lds + N2_BKT; LAS const float* tbl = (LAS const float*)(lds + N2_TBL);
    __syncthreads();
    for (int i = tid; i < 8192; i += NTHREADS) { const int r4 = i >> 11, d = i & 2047; lut[i] = f2bf(tbl[(int)bkt[d] * 32 + 16 + 4 * g + r4] * LOG2E); }
    for (int i = tid; i < 64 * 260; i += NTHREADS) imp[i] = 0.f;
    const int ncv_wg = (t0 + 63 >= 31) ? ((t0 + 63 - 31) >> 4) + 1 : 0; const int nC = (ncv_wg + 63) >> 6;
    const int wlo = max(t0 - 511, 0) >> 6; const int nW = QB - wlo + 1;
    if (tid < nC) listC[tid] = (unsigned short)tid;
    if (tid < nW) listW[tid] = (unsigned short)(wlo + tid);
    bf16x8 Bq[8];
#pragma unroll
    for (int kk = 0; kk < 8; ++kk) Bq[kk] = *(const bf16x8*)(proj + (size_t)t * NP + P_QB + 128 * head + 64 * h + 8 * kk);
    const float g0 = sigmoidf_(bf2f(proj[(size_t)t * NP + P_GB + 3 * head + 0]));
    const float g1 = sigmoidf_(bf2f(proj[(size_t)t * NP + P_GB + 3 * head + 1]));
    const float g2 = sigmoidf_(bf2f(proj[(size_t)t * NP + P_GB + 3 * head + 2]));
    f32x16 O[4];
#pragma unroll
    for (int dt = 0; dt < 4; ++dt)
#pragma unroll
        for (int i = 0; i < 16; ++i) O[dt][i] = 0.f;
    N2Lane L; L.t = t; L.t0w = t0w; L.h = h; L.rho = swap23(c); L.qq = qq; L.rr = rr; L.lane = lane;
    L.ncv = t >= 31 ? ((t - 31) >> 4) + 1 : 0; L.ncv0 = t0w >= 31 ? ((t0w - 31) >> 4) + 1 : 0; L.ncv7 = (t0w + 7 >= 31) ? ((t0w + 7 - 31) >> 4) + 1 : 0; L.cur = QB;
    L.b31 = tbl[31 * 32 + 16 + head] * LOG2E; L.lutr = lut + rr * 2048; L.bkt = bkt; L.tblh = tbl + 16 + head;
    LAS const unsigned* selq = selw + (wave * 8 + qq) * 8;
    LAS float* impw = imp + wave * 8 * 260;
    __syncthreads();
    float mC = N2_MINIT, ZC = 0.f;
    n2_branch<0, N2_STATS>(C, g, listC, nC, L, Bq, O, mC, ZC, 0.f, selq, impw);
    n2_combine(mC, ZC);
    const float invZC = 1.f / fmaxf(ZC, 1e-30f);
    n2_branch<0, N2_IMPV>(C, g, listC, nC, L, Bq, O, mC, ZC, invZC, selq, impw, g0);
#define N2_OACC() ({ unsigned to_ = (unsigned)tid; asm volatile("" : "+v"(to_)); (f32x4*)(C.ws + WS_OACC) + (size_t)blockIdx.x * 16 * 512 + to_; })
    f32x4* oacc = N2_OACC();
#pragma unroll
    for (int dt = 0; dt < 4; ++dt)
#pragma unroll
        for (int G = 0; G < 4; ++G) { oacc[(dt * 4 + G) * 512] = (f32x4){O[dt][4 * G], O[dt][4 * G + 1], O[dt][4 * G + 2], O[dt][4 * G + 3]}; O[dt][4 * G] = 0.f; O[dt][4 * G + 1] = 0.f; O[dt][4 * G + 2] = 0.f; O[dt][4 * G + 3] = 0.f; }
    lds_sync();
#pragma unroll 1
    for (int q8 = 0; q8 < 8; ++q8) {
        const int cur = QB;
        unsigned word = 0u;
        if (cur + 1 <= 16) { if (lane == 0) word = (1u << (cur + 1)) - 1u; }
        else {
            unsigned key[4];
#pragma unroll
            for (int i = 0; i < 4; ++i) { const int mblk = lane + 64 * i; const bool ok = mblk >= 1 && mblk <= cur - 2;
                key[i] = ok ? ((__float_as_uint(impw[q8 * 260 + mblk]) & 0xFFFFFF00u) | (unsigned)(255 - mblk)) : 0u; }
#pragma unroll 1
            for (int round = 0; round < 13; ++round) {
                unsigned lm = key[0] > key[1] ? key[0] : key[1]; const unsigned lm2 = key[2] > key[3] ? key[2] : key[3]; lm = lm > lm2 ? lm : lm2;
                const unsigned W = wave_maxu(lm);
#pragma unroll
                for (int i = 0; i < 4; ++i) if (key[i] == W) key[i] = 0u;
                const int mw = 255 - (int)(W & 0xFFu);
                if (W != 0u && lane == (mw >> 5)) word |= 1u << (mw & 31);
            }
            if (lane == 0) word |= 1u;
            if (lane == (cur >> 5)) word |= 1u << (cur & 31);
            if (lane == ((cur - 1) >> 5)) word |= 1u << ((cur - 1) & 31);
        }
        if (lane < 8) selw[(wave * 8 + q8) * 8 + lane] = word;
    }
    __syncthreads();
    if (tid < 8) { unsigned u = 0u; for (int q = 0; q < 64; ++q) u |= selw[q * 8 + tid]; uni[tid] = u; }
    __syncthreads();
    if (tid == 0) { int n = 0; for (int mblk = 0; mblk <= QB; ++mblk) if ((uni[mblk >> 5] >> (mblk & 31)) & 1u) listS[n++] = (unsigned short)mblk; uni[8] = (unsigned)n; }
    __syncthreads();
    const int nS = (int)uni[8];
    float mS = N2_MINIT, ZS = 0.f;
    n2_branch<1, N2_ONLINE>(C, g, listS, nS, L, Bq, O, mS, ZS, 0.f, selq, impw);
    { ZS = xsum32(ZS); const float sc = g1 / fmaxf(ZS, 1e-30f);
#pragma unroll
      for (int dt = 0; dt < 4; ++dt)
#pragma unroll
          for (int r = 0; r < 16; ++r) O[dt][r] *= sc; }
    oacc = N2_OACC();
#pragma unroll
    for (int dt = 0; dt < 4; ++dt)
#pragma unroll
        for (int G = 0; G < 4; ++G) { const f32x4 a = oacc[(dt * 4 + G) * 512];
            oacc[(dt * 4 + G) * 512] = (f32x4){O[dt][4 * G] + a[0], O[dt][4 * G + 1] + a[1], O[dt][4 * G + 2] + a[2], O[dt][4 * G + 3] + a[3]};
            O[dt][4 * G] = 0.f; O[dt][4 * G + 1] = 0.f; O[dt][4 * G + 2] = 0.f; O[dt][4 * G + 3] = 0.f; }
    float mW = N2_MINIT, ZW = 0.f;
    n2_branch<2, N2_ONLINE>(C, g, listW, nW, L, Bq, O, mW, ZW, 0.f, selq, impw);
    oacc = N2_OACC();
    { ZW = xsum32(ZW); const float sc = g2 / fmaxf(ZW, 1e-30f);
#pragma unroll
      for (int dt = 0; dt < 4; ++dt)
#pragma unroll
          for (int G = 0; G < 4; ++G) { const f32x4 a = oacc[(dt * 4 + G) * 512];
              O[dt][4 * G] = O[dt][4 * G] * sc + a[0]; O[dt][4 * G + 1] = O[dt][4 * G + 1] * sc + a[1]; O[dt][4 * G + 2] = O[dt][4 * G + 2] * sc + a[2]; O[dt][4 * G + 3] = O[dt][4 * G + 3] * sc + a[3]; } }
    unsigned char* yb = C.ws + WS_YB + (size_t)t * 2048 + head * 128;
#pragma unroll
    for (int dt = 0; dt < 4; ++dt)
#pragma unroll
        for (int G = 0; G < 4; ++G) { int p = __builtin_amdgcn_cvt_pk_fp8_f32(O[dt][4 * G] * 16.f, O[dt][4 * G + 1] * 16.f, 0, false); p = __builtin_amdgcn_cvt_pk_fp8_f32(O[dt][4 * G + 2] * 16.f, O[dt][4 * G + 3] * 16.f, p, true);
            *(unsigned*)(yb + dt * 32 + 8 * G + 4 * h) = (unsigned)p; }
}

#ifndef NREP_DSA
#define NREP_DSA 1
#endif
#ifndef NREP_NSA
#define NREP_NSA 1
#endif
__device__ __forceinline__ void p6_mixers(const Ctx& C, int which  , int crep = 0) {
    const Ctx& C0_ = C;
    unsigned* counter = (unsigned*)(C.ws + WS_CTL + CTL_CNT) + 128 * crep;
    static_assert(8 * P6_WAVE_LDS <= N2_BKT, "DSA per-wave LDS vs the shared bias tables");
    LAS unsigned char* bkt = C.lds + N2_BKT; LAS float* tbl = (LAS float*)(C.lds + N2_TBL);
    for (int d = C.tid; d <= 2048; d += NTHREADS) { int b;
        if (d < 16) b = d; else { b = 16 + (int)(logf((float)d / 16.f) / logf(128.f) * 16.f); b = b < 31 ? b : 31; }
        bkt[d] = (unsigned char)b; }
    for (int i = C.tid; i < 1024; i += NTHREADS) tbl[i] = C.in[I_RELB][i];
    __syncthreads();
    if (which != 1) {
        LAS int* slot = (LAS int*)(C.lds + N2_UNI + 48);
#pragma unroll 1
        for (int rep = 0; rep < NREP_NSA; ++rep)
        for (;;) {
            __syncthreads();
            if (C.tid == 0) *slot = (int)atomicAdd(counter + 64 + 128 * rep, 1u);
            __syncthreads();
            const int it = *slot;
            if (it >= 1024) break;
            nsa2_item(C, 255 - (it >> 2), it & 3);
#pragma unroll 1
            for (int c = 0; c < 3; ++c) { const int j = it + 1024 * c; if (j >= 2560) break;
                __syncthreads();
                Ctx C = C0_; { int t_ = threadIdx.x; asm volatile("" : "+v"(t_)); C.tid = t_; C.lane = t_ & 63; C.wave = __builtin_amdgcn_readfirstlane(t_ >> 6); }
                if (j < 512) tconv_tile_f8<false>(C, C.in[I_WBA], 4096, C.ws + WS_WBA, 2048, (j / 16) * 128, (j % 16) * 128);
                else if (j < 1024) { const int i = j - 512; tconv_tile_f8<false>(C, C.in[I_WBB], 4096, C.ws + WS_WBB, 2048, (i / 16) * 128, (i % 16) * 128); }
                else if (j < 2048) { const int i = j - 1024; tconv_tile_f8<false>(C, C.in[I_WOUT], 4096, C.ws + WS_WOUT, 4096, (i / 32) * 128, (i % 32) * 128); }
                else { const int i = j - 2048; wq_subkey_tile(C, i >> 5, (i & 31) * 128); } }
        }
        __syncthreads();
    }
    if (which != 2) {
        LAS unsigned char* wl = C.lds + C.wave * P6_WAVE_LDS;
#pragma unroll 1
        for (int rep = 0; rep < NREP_DSA; ++rep)
        for (;;) {
            int it = 0;
            if (C.lane == 0) it = (int)atomicAdd(counter + 128 * rep, 1u);
            it = __builtin_amdgcn_readfirstlane(it);
            if (it >= 8192) break;
            if (C.wave >= 4) __builtin_amdgcn_s_setprio(2);
            dsa_item(C, 8191 - it, wl, bkt, tbl, (rep < NREP_DSA - 1) ? DSA_PROBE_MODE : 0);
#pragma unroll 1
            for (int rr = 0; rr < 4; ++rr) peer_row_convert(C, 4 * it + rr, C.lane);
        }
        __builtin_amdgcn_s_setprio(0);
        __syncthreads();
    }
}

static __device__ const unsigned P12_IJ4[16] = {
    0xE0331000u, 0xF0401101u, 0xFF411202u, 0xFF421303u, 0xFF501404u, 0xFF511505u, 0xFF601606u, 0xFF611707u, 0xFF702008u, 0xFF712109u, 0xFF80220Au, 0xFF90230Bu, 0xFFA0240Cu, 0xFFB0300Du, 0xFFC0310Eu, 0xFFD0320Fu };
typedef __bf16 bf16x32_t __attribute__((ext_vector_type(32)));
typedef unsigned u32x16 __attribute__((ext_vector_type(16)));
typedef _Float16 h2_t __attribute__((ext_vector_type(2)));
typedef _Float16 h32_t __attribute__((ext_vector_type(32)));
__device__ __forceinline__ unsigned rowmax_u(unsigned v) { v = umaxu(v, dppu<0xB1>(v)); v = umaxu(v, dppu<0x4E>(v)); v = umaxu(v, dppu<0x141>(v)); v = umaxu(v, dppu<0x140>(v)); return v; }
__device__ __forceinline__ float rowmax_f(float v) { v = fmax_fast(v, dppf<0xB1>(v)); v = fmax_fast(v, dppf<0x4E>(v)); v = fmax_fast(v, dppf<0x141>(v)); v = fmax_fast(v, dppf<0x140>(v)); return v; }
__device__ __forceinline__ float rowsum_f(float v) { v += dppf<0xB1>(v); v += dppf<0x4E>(v); v += dppf<0x141>(v); v += dppf<0x140>(v); return v; }
#define P12_CE(a_, b_) do { const unsigned hi_ = umaxu(a_, b_), lo_ = (a_) < (b_) ? (a_) : (b_); a_ = hi_; b_ = lo_; } while (0)
__device__ __forceinline__ void p12_route(const bf16_t* srow, LAS float* tops, LAS int* topi, LAS unsigned short* exl, LAS float* gtl, int lane, unsigned ij4) {
    const int row = lane >> 4, l16 = lane & 15;
#pragma unroll 1
    for (int q = 0; q < 4; ++q) {
        const int p = 4 * q + row;
        const u32x4 raw = *(const u32x4*)(srow + p * 128 + 8 * l16);
        unsigned k[8];
#pragma unroll
        for (int e = 0; e < 8; ++e) { const unsigned bits = (e & 1) ? (raw[e >> 1] & 0xFFFF0000u) : (raw[e >> 1] << 16);
            k[e] = ((bits ^ ((bits >> 31) ? 0xFFFFFFFFu : 0x80000000u)) & 0xFFFFFF80u) | (unsigned)(127 - (8 * l16 + e)); }
        P12_CE(k[0], k[2]); P12_CE(k[1], k[3]); P12_CE(k[4], k[6]); P12_CE(k[5], k[7]);
        P12_CE(k[0], k[4]); P12_CE(k[1], k[5]); P12_CE(k[2], k[6]); P12_CE(k[3], k[7]);
        P12_CE(k[0], k[1]); P12_CE(k[2], k[3]); P12_CE(k[4], k[5]); P12_CE(k[6], k[7]);
        P12_CE(k[2], k[4]); P12_CE(k[3], k[5]);
        P12_CE(k[1], k[4]); P12_CE(k[3], k[6]);
        P12_CE(k[1], k[2]); P12_CE(k[3], k[4]); P12_CE(k[5], k[6]);
        unsigned myW = 0u;
#pragma unroll
        for (int r = 0; r < 16; ++r) {
            const unsigned W = rowmax_u(k[0]);
            const bool pop = k[0] == W;
#pragma unroll
            for (int e = 0; e < 7; ++e) k[e] = pop ? k[e + 1] : k[e];
            k[7] = pop ? 0u : k[7];
            myW = (l16 == r) ? W : myW;
        }
        const unsigned sb = myW & 0xFFFFFF80u;
        const unsigned bits = (sb & 0x80000000u) ? (sb ^ 0x80000000u) : ((~sb) & 0xFFFF0000u);
        tops[p * 16 + l16] = __uint_as_float(bits); topi[p * 16 + l16] = 127 - (int)(myW & 0x7Fu);
    }
    lds_sync();
#pragma unroll 1
    for (int q2 = 0; q2 < 2; ++q2) {
        const int hh = 4 * q2 + row;
        LAS const float* t1 = tops + (2 * hh) * 16; LAS const float* t2 = t1 + 16;
        unsigned k[4];
#pragma unroll
        for (int c = 0; c < 4; ++c) { const unsigned ij = (ij4 >> (8 * c)) & 0xFFu; const float cv = t1[ij >> 4] + t2[ij & 15u];
            k[c] = (ij != 0xFFu) ? ((sortable(cv) & 0xFFFFFF00u) | (255u - ij)) : 0u; }
        P12_CE(k[0], k[1]); P12_CE(k[2], k[3]); P12_CE(k[0], k[2]); P12_CE(k[1], k[3]); P12_CE(k[1], k[2]);
        unsigned myW = 0u;
#pragma unroll
        for (int r = 0; r < 16; ++r) {
            const unsigned W = rowmax_u(k[0]);
            const bool pop = k[0] == W;
            k[0] = pop ? k[1] : k[0]; k[1] = pop ? k[2] : k[1]; k[2] = pop ? k[3] : k[2]; k[3] = pop ? 0u : k[3];
            myW = (l16 == r) ? W : myW;
        }
        const unsigned flat = 255u - (myW & 0xFFu); const int ci = (int)(flat >> 4), cj = (int)(flat & 15u);
        const float cv = t1[ci] + t2[cj];
        const float ev = __expf(cv - rowmax_f(cv));
        const float es = rowsum_f(ev);
        exl[hh * 16 + l16] = (unsigned short)(topi[(2 * hh) * 16 + ci] * 128 + topi[(2 * hh + 1) * 16 + cj]);
        gtl[hh * 16 + l16] = ev * __builtin_amdgcn_rcpf(es);
    }
    lds_sync();
}
#undef P12_CE
__device__ __forceinline__ float gelu_fast(float x) { const float u = 0.7978845608028654f * (x + 0.044715f * x * x * x); const float e = __expf(2.f * u); return x - x * __builtin_amdgcn_rcpf(e + 1.f); }

#ifndef P12_HI
#define P12_HI 4
#endif
__device__ __forceinline__ void p12_peer(const Ctx& C, float* dst) {
    const bf16_t* pq = (const bf16_t*)(C.ws + WS_PQ);
    const bf16_t* h2 = (const bf16_t*)(C.ws + WS_H2);
    const float* gt2 = (const float*)(C.ws + WS_MOD) + 5 * D;
    const int lane = C.lane;
    LAS unsigned char* wl = C.lds + C.wave * 8192;
    LAS unsigned short* exl = (LAS unsigned short*)wl;
    LAS float* gtl = (LAS float*)(wl + 2048);
    LAS float* tops = (LAS float*)(wl + 6144);
    LAS int* topi = (LAS int*)(wl + 7168);
    const unsigned ij4 = P12_IJ4[lane & 15];
    const unsigned lo16 = 16u * (unsigned)lane; const unsigned char* pu6 = C.ws + WS_PU; const unsigned char* pv6 = C.ws + WS_PV;
    const float* su = (const float*)(C.ws + WS_PU + 96 * MB); const float* sv = (const float*)(C.ws + WS_PV + 96 * MB);
    const unsigned char* pu4 = C.ws + WS_PU4; const unsigned char* pv4 = C.ws + WS_PV4;
    const int tstride = gridDim.x * 8;
    for (int tb = blockIdx.x * 8 + C.wave; tb < T; tb += 8 * tstride) {
        int nb = 0;
#pragma unroll 1
        for (int s = 0; s < 8; ++s) { if (tb + s * tstride >= T) break; ++nb; }
        p12_route(pq + (size_t)tb * 2048, tops, topi, exl, gtl, lane, ij4);
        const int nflat = nb * 128;
        u32x4 UA[3], VA[3], UB[3], VB[3], UC[3], VC[3], UD[3], VD[3]; float suA, svA, suB, svB, suC, svC, suD, svD;
#define P12_FMT(idx_) ((((idx_) & 15) < P12_HI) ? 6 : 4)
#define P12_LOAD(S, idx_, fmt_) do { const int e_ = __builtin_amdgcn_readfirstlane((int)exl[(idx_) < nflat ? (idx_) : nflat - 1]); \
        if ((fmt_) == 6) { const unsigned char* pu_ = pu6 + (size_t)e_ * 3072 + lo16; const unsigned char* pv_ = pv6 + (size_t)e_ * 3072 + lo16; \
            U##S[0] = *(const u32x4*)pu_; U##S[1] = *(const u32x4*)(pu_ + 1024); U##S[2] = *(const u32x4*)(pu_ + 2048); \
            V##S[0] = *(const u32x4*)pv_; V##S[1] = *(const u32x4*)(pv_ + 1024); V##S[2] = *(const u32x4*)(pv_ + 2048); su##S = su[e_]; sv##S = sv[e_]; } \
        else { const unsigned char* pu_ = pu4 + (size_t)e_ * 2176; const unsigned char* pv_ = pv4 + (size_t)e_ * 2176; \
            U##S[0] = *(const u32x4*)(pu_ + lo16); U##S[1] = *(const u32x4*)(pu_ + 1024 + lo16); su##S = bf2f(*(const bf16_t*)(pu_ + 2048 + 2 * lane)); \
            V##S[0] = *(const u32x4*)(pv_ + lo16); V##S[1] = *(const u32x4*)(pv_ + 1024 + lo16); sv##S = bf2f(*(const bf16_t*)(pv_ + 2048 + 2 * lane)); } } while (0)
#define P12_U4(w_, hh_, j_) do { \
        a0_ = dot2bf(__builtin_bit_cast(unsigned, __builtin_amdgcn_cvt_scalef32_pk_bf16_fp4((w_), 1.0f, 0)), hh_[(j_)], a0_); a1_ = dot2bf(__builtin_bit_cast(unsigned, __builtin_amdgcn_cvt_scalef32_pk_bf16_fp4((w_), 1.0f, 1)), hh_[(j_) + 1], a1_); \
        a2_ = dot2bf(__builtin_bit_cast(unsigned, __builtin_amdgcn_cvt_scalef32_pk_bf16_fp4((w_), 1.0f, 2)), hh_[(j_) + 2], a2_); a3_ = dot2bf(__builtin_bit_cast(unsigned, __builtin_amdgcn_cvt_scalef32_pk_bf16_fp4((w_), 1.0f, 3)), hh_[(j_) + 3], a3_); } while (0)
#define P12_V4(w_, oo_, j_) do { \
        oo_[(j_)] = act2_ * __builtin_amdgcn_cvt_scalef32_pk_f16_fp4((w_), 1.0f, 0) + oo_[(j_)]; oo_[(j_) + 1] = act2_ * __builtin_amdgcn_cvt_scalef32_pk_f16_fp4((w_), 1.0f, 1) + oo_[(j_) + 1]; \
        oo_[(j_) + 2] = act2_ * __builtin_amdgcn_cvt_scalef32_pk_f16_fp4((w_), 1.0f, 2) + oo_[(j_) + 2]; oo_[(j_) + 3] = act2_ * __builtin_amdgcn_cvt_scalef32_pk_f16_fp4((w_), 1.0f, 3) + oo_[(j_) + 3]; } while (0)
#define P12_COMPUTE(S, idx_, fmt_) do { float a0_ = 0.f, a1_ = 0.f, a2_ = 0.f, a3_ = 0.f; \
        if ((fmt_) == 6) { \
            const u32x16 ua_ = __builtin_bit_cast(u32x16, __builtin_amdgcn_cvt_scalef32_pk32_bf16_fp6((u32x6){U##S[0].x, U##S[0].y, U##S[0].z, U##S[0].w, U##S[1].x, U##S[1].y}, 1.0f)); \
            const u32x16 ub_ = __builtin_bit_cast(u32x16, __builtin_amdgcn_cvt_scalef32_pk32_bf16_fp6((u32x6){U##S[1].z, U##S[1].w, U##S[2].x, U##S[2].y, U##S[2].z, U##S[2].w}, 1.0f)); \
            _Pragma("unroll") for (int j = 0; j < 16; j += 4) { a0_ = dot2bf(ua_[j], hA[j], a0_); a1_ = dot2bf(ua_[j + 1], hA[j + 1], a1_); a2_ = dot2bf(ua_[j + 2], hA[j + 2], a2_); a3_ = dot2bf(ua_[j + 3], hA[j + 3], a3_); } \
            _Pragma("unroll") for (int j = 0; j < 16; j += 4) { a0_ = dot2bf(ub_[j], hB[j], a0_); a1_ = dot2bf(ub_[j + 1], hB[j + 1], a1_); a2_ = dot2bf(ub_[j + 2], hB[j + 2], a2_); a3_ = dot2bf(ub_[j + 3], hB[j + 3], a3_); } \
            const float a_ = wave_sum((a0_ + a1_) + (a2_ + a3_)) * su##S; \
            const float act_ = gelu_fast(a_) * gtl[idx_] * sv##S; const h2_t act2_ = {(_Float16)act_, (_Float16)act_}; \
            const h32_t va_ = __builtin_amdgcn_cvt_scalef32_pk32_f16_fp6((u32x6){V##S[0].x, V##S[0].y, V##S[0].z, V##S[0].w, V##S[1].x, V##S[1].y}, 1.0f); \
            _Pragma("unroll") for (int j = 0; j < 16; ++j) oA[j] = act2_ * (h2_t){va_[2 * j], va_[2 * j + 1]} + oA[j]; \
            const h32_t vb_ = __builtin_amdgcn_cvt_scalef32_pk32_f16_fp6((u32x6){V##S[1].z, V##S[1].w, V##S[2].x, V##S[2].y, V##S[2].z, V##S[2].w}, 1.0f); \
            _Pragma("unroll") for (int j = 0; j < 16; ++j) oB[j] = act2_ * (h2_t){vb_[2 * j], vb_[2 * j + 1]} + oB[j]; \
        } else { \
            P12_U4(U##S[0].x, hA, 0); P12_U4(U##S[0].y, hA, 4); P12_U4(U##S[0].z, hA, 8); P12_U4(U##S[0].w, hA, 12); \
            P12_U4(U##S[1].x, hB, 0); P12_U4(U##S[1].y, hB, 4); P12_U4(U##S[1].z, hB, 8); P12_U4(U##S[1].w, hB, 12); \
            const float a_ = wave_sum(((a0_ + a1_) + (a2_ + a3_)) * su##S); \
            const float act_ = gelu_fast(a_) * gtl[idx_] * sv##S; const h2_t act2_ = {(_Float16)act_, (_Float16)act_}; \
            P12_V4(V##S[0].x, oA, 0); P12_V4(V##S[0].y, oA, 4); P12_V4(V##S[0].z, oA, 8); P12_V4(V##S[0].w, oA, 12); \
            P12_V4(V##S[1].x, oB, 0); P12_V4(V##S[1].y, oB, 4); P12_V4(V##S[1].z, oB, 8); P12_V4(V##S[1].w, oB, 12); } } while (0)
        P12_LOAD(A, 0, P12_FMT(0)); P12_LOAD(B, 1, P12_FMT(1)); P12_LOAD(C, 2, P12_FMT(2)); P12_LOAD(D, 3, P12_FMT(3));
#pragma unroll 1
        for (int s = 0; s < nb; ++s) {
            const int t = tb + s * tstride;
            if (s + 1 < nb) p12_route(pq + (size_t)(t + tstride) * 2048, tops, topi, exl + (s + 1) * 128, gtl + (s + 1) * 128, lane, ij4);
            unsigned hA[16], hB[16];
            { u32x4 ra[4], rb[4];
#pragma unroll
              for (int i = 0; i < 4; ++i) { ra[i] = *(const u32x4*)(h2 + (size_t)t * D + 16 * lane + 1024 * i); rb[i] = *(const u32x4*)(h2 + (size_t)t * D + 16 * lane + 1024 * i + 8); }
#pragma unroll
              for (int q = 0; q < 4; ++q) {
                  hA[2 * q] = __builtin_amdgcn_perm(ra[1][q], ra[0][q], 0x05040100u); hA[2 * q + 1] = __builtin_amdgcn_perm(ra[1][q], ra[0][q], 0x07060302u);
                  hA[8 + 2 * q] = __builtin_amdgcn_perm(rb[1][q], rb[0][q], 0x05040100u); hA[8 + 2 * q + 1] = __builtin_amdgcn_perm(rb[1][q], rb[0][q], 0x07060302u);
                  hB[2 * q] = __builtin_amdgcn_perm(ra[3][q], ra[2][q], 0x05040100u); hB[2 * q + 1] = __builtin_amdgcn_perm(ra[3][q], ra[2][q], 0x07060302u);
                  hB[8 + 2 * q] = __builtin_amdgcn_perm(rb[3][q], rb[2][q], 0x05040100u); hB[8 + 2 * q + 1] = __builtin_amdgcn_perm(rb[3][q], rb[2][q], 0x07060302u); } }
            h2_t oA[16], oB[16];
#pragma unroll
            for (int j = 0; j < 16; ++j) { oA[j] = (h2_t){(_Float16)0.f, (_Float16)0.f}; oB[j] = (h2_t){(_Float16)0.f, (_Float16)0.f}; }
#pragma unroll 1
            for (int hh = 0; hh < 8; ++hh) {
                const int f0 = s * 128 + hh * 16;
#pragma unroll
                for (int k = 0; k < 16; k += 4) {
                    P12_COMPUTE(A, f0 + k, P12_FMT(k)); P12_LOAD(A, f0 + k + 4, P12_FMT(k + 4));
                    P12_COMPUTE(B, f0 + k + 1, P12_FMT(k + 1)); P12_LOAD(B, f0 + k + 5, P12_FMT(k + 5));
                    P12_COMPUTE(C, f0 + k + 2, P12_FMT(k + 2)); P12_LOAD(C, f0 + k + 6, P12_FMT(k + 6));
                    P12_COMPUTE(D, f0 + k + 3, P12_FMT(k + 3)); P12_LOAD(D, f0 + k + 7, P12_FMT(k + 7));
                }
            }
#pragma unroll
            for (int i = 0; i < 4; ++i) { const int d0 = 16 * lane + 1024 * i; const float* op = C.out + (size_t)t * D + d0; float* dp = dst + (size_t)t * D + d0;
#pragma unroll
                for (int q = 0; q < 4; ++q) { const f32x4 xv = *(const f32x4*)(op + 4 * q); const f32x4 gv = *(const f32x4*)(gt2 + d0 + 4 * q); f32x4 r;
#pragma unroll
                    for (int j = 0; j < 4; ++j) { const h2_t ov = (i < 2) ? oA[4 * q + j] : oB[4 * q + j]; r[j] = xv[j] + gv[j] * ((i & 1) ? (float)ov.y : (float)ov.x); }
                    __builtin_nontemporal_store(r, (f32x4*)(dp + 4 * q)); } }
        }
#undef P12_U4
#undef P12_V4
#undef P12_FMT
#undef P12_LOAD
#undef P12_COMPUTE
        lds_sync();
    }
}

constexpr int N_PHASES = 13;
#ifndef DBG_MIX
#define DBG_MIX 0
#endif
__global__ void __launch_bounds__(NTHREADS, 2) fwd(Args args) {
    extern __shared__ __attribute__((aligned(16))) unsigned char lds_raw[];
    Ctx C0; C0.in = args.in; C0.out = args.out; C0.ws = args.ws; C0.lds = (LAS unsigned char*)lds_raw;
    C0.tid = threadIdx.x; C0.lane = C0.tid & 63; C0.wave = __builtin_amdgcn_readfirstlane(C0.tid >> 6);
#define PHASE_CTX() Ctx C = C0; { int t_ = threadIdx.x; asm volatile("" : "+v"(t_)); C.tid = t_; C.lane = t_ & 63; C.wave = __builtin_amdgcn_readfirstlane(t_ >> 6); }
    const Ctx& C = C0;
    const int lo = args.ph_lo, hi = args.ph_hi;
    const bool fused = (hi - lo) > 1;
    volatile LAS unsigned* bst = (volatile LAS unsigned*)(C.lds + LDS_BYTES - 16);
    XcdBarrier bar; bar.bar = (unsigned*)(C.ws + WS_CTL + CTL_BAR); bar.x = 0; bar.st = bst;
    if (fused) { if (C.tid == 0) { bst[0] = 0u; bst[1] = 0u; bst[2] = 0u; bst[3] = 0u; } __syncthreads(); bar = xcd_barrier_post((unsigned*)(C.ws + WS_CTL + CTL_BAR), bst); }
#ifndef ONLY_PHASE
#define ONLY_PHASE -1
#endif
#define IN(k) (lo <= (k) && (k) < hi && (ONLY_PHASE < 0 || ONLY_PHASE == (k)))
#ifndef REP_PHASE
#define REP_PHASE -1
#endif
#define REP(k, ...) if (REP_PHASE == (k)) { __VA_ARGS__ }
#define SEAM(k) do { if (IN(k) && IN((k) + 1)) xcd_barrier(bar); } while (0)
    const float* mod = (const float*)(C.ws + WS_MOD);
    bf16_t* proj = (bf16_t*)(C.ws + WS_PROJ);
    if (IN(0)) { PHASE_CTX(); REP(0, p0_prologue(C); __syncthreads();) p0_prologue(C); } SEAM(0);
    if (IN(1)) { PHASE_CTX(); norm_mod_phase(C, C.in[I_X], C.in[I_GMIX], mod + 0 * D, mod + 1 * D, (bf16_t*)(C.ws + WS_H), C.ws + WS_H8); } SEAM(1);
    if (IN(2)) { PHASE_CTX(); pg8::Gemm g{(const bf16_t*)(C.ws + WS_H), (const bf16_t*)(C.ws + WS_WIN), T, NP_BF, D, D, D}; pg8::StaticOrder S; S.init(T, NP_BF, gridDim.x, blockIdx.x);
                 pg8::EpiPlain E{proj, NP, 1.f}; pg8::gemm_phase(C.lds, g, S, E);
                 pg8::Gemm g8{(const bf16_t*)(C.ws + WS_H8), (const bf16_t*)(C.ws + WS_WIN8), T, NP_F8, D / 2, D / 2, D / 2}; pg8::Fp8Order S8{(int)blockIdx.x};
                 pg8::EpiSigU8 E8{(unsigned char*)(proj + P_GM), NP * 2, 1.f / 64.f}; pg8::gemm_phase<pg8::EpiSigU8, pg8::Fp8Order, true>(C.lds, g8, S8, E8); } SEAM(2);
    if (IN(3)) { PHASE_CTX(); p3_post(C); } SEAM(3);
    if (IN(4)) { PHASE_CTX(); pg8::Gemm g{(const bf16_t*)(C.ws + WS_KC), (const bf16_t*)(C.ws + WS_W1T), 8192, 512, 512, 2048, D}; pg8::CmpOrder S{(int)gridDim.x, (int)blockIdx.x};
                 pg8::EpiSlab E{(float*)(C.ws + WS_HIDP)}; pg8::gemm_phase(C.lds, g, S, E); } SEAM(4);
    if (IN(5)) { PHASE_CTX(); p5_cmp_out(C); } SEAM(5);
    if (IN(6)) { PHASE_CTX(); p6_mixers(C, DBG_MIX); } SEAM(6);
    if (IN(7)) { PHASE_CTX(); pg8::Gemm g{(const bf16_t*)(C.ws + WS_YA), (const bf16_t*)(C.ws + WS_WBA), T, D, 1024, 1024, 1024};   pg8::StaticOrder S; S.init(T, D, gridDim.x, blockIdx.x);
                 pg8::EpiGate<0> E{(bf16_t*)(C.ws + WS_MERGED), D, (const unsigned char*)(proj + P_GM), NP * 2, 1.f / (16.f * 64.f * 255.f), nullptr}; pg8::gemm_phase<pg8::EpiGate<0>, pg8::StaticOrder, true>(C.lds, g, S, E); } if (IN(7) && IN(8)) __syncthreads();
    if (IN(8)) { PHASE_CTX(); pg8::Gemm g{(const bf16_t*)(C.ws + WS_YB), (const bf16_t*)(C.ws + WS_WBB), T, D, 1024, 1024, 1024}; pg8::StaticOrder S; S.init(T, D, gridDim.x, blockIdx.x);
                 pg8::EpiGate<1> E{(bf16_t*)(C.ws + WS_MERGED), D, (const unsigned char*)(proj + P_GM) + 4096, NP * 2, 1.f / (16.f * 64.f * 255.f), C.ws + WS_H8}; pg8::gemm_phase<pg8::EpiGate<1>, pg8::StaticOrder, true>(C.lds, g, S, E); } SEAM(8);
    if (IN(9)) { PHASE_CTX(); pg8::Gemm g{(const bf16_t*)(C.ws + WS_H8), (const bf16_t*)(C.ws + WS_WOUT), T, D, D / 2, D / 2, D / 2};   pg8::StaticOrder S; S.init(T, D, gridDim.x, blockIdx.x);
                 pg8::EpiResid E{C.out, C.in[I_X], mod + 2 * D, D, 1.f / (32.f * 64.f)}; pg8::gemm_phase<pg8::EpiResid, pg8::StaticOrder, true>(C.lds, g, S, E); } SEAM(9);
    if (IN(10)) { PHASE_CTX(); norm_mod_phase(C, C.out, C.in[I_GFFN], mod + 3 * D, mod + 4 * D, (bf16_t*)(C.ws + WS_H2)); } SEAM(10);
    if (IN(11)) { PHASE_CTX(); pg8::Gemm g{(const bf16_t*)(C.ws + WS_H2), (const bf16_t*)(C.ws + WS_WQ), T, 2048, D, D, D}; pg8::StaticOrder S; S.init(T, 2048, gridDim.x, blockIdx.x);
                  pg8::EpiPlain E{(bf16_t*)(C.ws + WS_PQ), 2048, 1.f}; pg8::gemm_phase(C.lds, g, S, E); } SEAM(11);
    if (IN(12)) { PHASE_CTX(); REP(12, p12_peer(C, (float*)(C.ws + WS_PROJ)); __syncthreads();) p12_peer(C, C.out); }
#undef IN
#undef SEAM
}

#ifndef N_LAUNCH_MODE
#define N_LAUNCH_MODE 1
#endif
extern "C" void kernel_launch(void* const* d_in, const int* in_sizes, int n_in, void* d_out, int out_size, void* d_ws, size_t ws_size, hipStream_t stream) {
    static int grid = 0;
    if (grid == 0) {
        if (n_in != 27 || out_size != T * D || ws_size < WS_END) { fprintf(stderr, "kernel_launch: unexpected shapes (n_in %d out %d ws %zu need %zu)\n", n_in, out_size, ws_size, (size_t)WS_END); grid = -1; return; }
        int dev = 0, cus = 0;
        if (hipGetDevice(&dev) != hipSuccess || hipDeviceGetAttribute(&cus, hipDeviceAttributeMultiprocessorCount, dev) != hipSuccess) { grid = -1; return; }
        if (hipFuncSetAttribute((const void*)fwd, hipFuncAttributeMaxDynamicSharedMemorySize, LDS_BYTES) != hipSuccess) { fprintf(stderr, "kernel_launch: hipFuncSetAttribute failed\n"); grid = -1; return; }
        int per_cu = 0;
        if (hipOccupancyMaxActiveBlocksPerMultiprocessor(&per_cu, (const void*)fwd, NTHREADS, LDS_BYTES) != hipSuccess || per_cu < 1) { fprintf(stderr, "kernel_launch: occupancy query says %d\n", per_cu); }
        (void)hipGetLastError();
        grid = cus;
    }
    if (grid < 0) return;
    (void)hipMemsetAsync((char*)d_ws + WS_CTL, 0, 64 * 1024, stream);
    Args a{};
    for (int i = 0; i < 27; ++i) a.in[i] = (const float*)d_in[i];
    a.out = (float*)d_out; a.ws = (unsigned char*)d_ws;
#if N_LAUNCH_MODE == 1
    a.ph_lo = 0; a.ph_hi = N_PHASES;
    hipLaunchKernelGGL(fwd, dim3(grid), dim3(NTHREADS), LDS_BYTES, stream, a);
#else
    for (int p = 0; p < N_PHASES; ++p) { a.ph_lo = p; a.ph_hi = p + 1; hipLaunchKernelGGL(fwd, dim3(grid), dim3(NTHREADS), LDS_BYTES, stream, a); }
#endif
}
```

```cpp
#include <hip/hip_runtime.h>
#include <cstdio>
#include <cstdint>

#define LAS __attribute__((address_space(3)))
typedef unsigned short bf16_t;
typedef unsigned long long u64;
typedef short bf16x8 __attribute__((ext_vector_type(8)));
typedef float f32x4 __attribute__((ext_vector_type(4)));
typedef float f32x16 __attribute__((ext_vector_type(16)));
typedef unsigned u32x4 __attribute__((ext_vector_type(4)));
typedef unsigned u32x2 __attribute__((ext_vector_type(2)));
typedef __bf16 bf2_t __attribute__((ext_vector_type(2)));
typedef float f32x2 __attribute__((ext_vector_type(2)));
typedef float f32x32 __attribute__((ext_vector_type(32)));
typedef unsigned u32x6 __attribute__((ext_vector_type(6)));
typedef _Float16 hx2_t __attribute__((ext_vector_type(2)));

constexpr int T = 16384, D = 4096, NP = 18688;
constexpr int P_QA = 0, P_KA = 2048, P_VA = 2560, P_QI = 3072, P_QB = 5120, P_KC = 7168, P_VC = 7680, P_KS = 8192, P_VS = 8704,
              P_KW = 9216, P_VW = 9728, P_KI = 10240, P_WI = 10304, P_GB = 10336, P_GM = 10496;
constexpr int NP_BF = 10496, NP_F8 = 8192;
constexpr int NCMP = 1023;
constexpr float EPS = 1e-6f;
constexpr int NTHREADS = 512;
constexpr int LDS_BYTES = 160 * 1024;

constexpr size_t MB = 1024ull * 1024ull;
constexpr size_t WS_CTL = 0;
constexpr size_t WS_MOD = 64 * 1024;
constexpr size_t WS_B1 = 192 * 1024;
constexpr size_t WS_B1P = 196 * 1024;
constexpr size_t WS_W1T = 512 * 1024;
constexpr size_t WS_SUBK = WS_W1T + 4 * MB;
constexpr size_t WS_HID = WS_SUBK + 512 * 1024;
constexpr size_t WS_KCMP = WS_HID + 8 * MB;
constexpr size_t WS_VCMPT = WS_KCMP + 1 * MB;
constexpr size_t WS_KIC = WS_VCMPT + 1 * MB;
constexpr size_t WS_KC = WS_KIC + 2 * MB;
constexpr size_t WS_VST = WS_KC + 32 * MB + 64 * 1024;
constexpr size_t WS_VWT = WS_VST + 16 * MB;
constexpr size_t WS_WBA = WS_VWT + 16 * MB;
constexpr size_t WS_WBB = WS_WBA + 16 * MB;
constexpr size_t WS_WOUT = WS_WBB + 16 * MB;
constexpr size_t WS_WQ = WS_WOUT + 32 * MB;
constexpr size_t WS_PU = WS_WQ + 16 * MB;
constexpr size_t WS_PV = WS_PU + 128 * MB;
constexpr size_t WS_PU4 = WS_PU + 56 * MB, WS_PV4 = WS_PV + 56 * MB;
constexpr size_t WS_PROJ = WS_PV + 128 * MB;
constexpr size_t WS_WIN = WS_PROJ + (size_t)T * NP * 2;
constexpr size_t WS_H = WS_WIN + (size_t)NP * D * 2;
constexpr size_t WS_KA = WS_H + 128 * MB;
constexpr size_t WS_VA = WS_KA + 16 * MB;
constexpr size_t WS_KSC = WS_VA + 16 * MB;
constexpr size_t WS_KWC = WS_KSC + 16 * MB;
constexpr size_t WS_HIDP = WS_KWC + 16 * MB;
constexpr size_t WS_OACC = WS_HIDP + 64 * MB;
constexpr size_t WS_H8 = WS_OACC + 32 * MB;
constexpr size_t WS_END = WS_H8 + 64 * MB;
constexpr size_t WS_WIN8 = WS_WIN + (size_t)NP_BF * D * 2;
constexpr size_t WS_YA = WS_WIN, WS_YB = WS_WIN + 64 * MB, WS_H2 = WS_WIN;
constexpr size_t WS_MERGED = WS_H, WS_PQ = WS_H;
constexpr size_t CTL_BAR = 0, CTL_CNT = 16384;

__device__ __forceinline__ float bf2f(bf16_t b) { return __uint_as_float(((unsigned)b) << 16); }
__device__ __forceinline__ float bflo(unsigned u) { return __uint_as_float(u << 16); }
__device__ __forceinline__ float bfhi(unsigned u) { return __uint_as_float(u & 0xFFFF0000u); }
__device__ __forceinline__ unsigned cvt_pk_bf16(float lo, float hi) { unsigned r; asm volatile("v_cvt_pk_bf16_f32 %0, %1, %2" : "=v"(r) : "v"(lo), "v"(hi)); return r; }
__device__ __forceinline__ bf16_t f2bf(float f) { return (bf16_t)(cvt_pk_bf16(f, 0.f) & 0xFFFFu); }
__device__ __forceinline__ float dot2bf(unsigned a, unsigned b, float c) { return __builtin_amdgcn_fdot2_f32_bf16(__builtin_bit_cast(bf2_t, a), __builtin_bit_cast(bf2_t, b), c, false); }
template <int CTRL> __device__ __forceinline__ float dppf(float v) { return __builtin_bit_cast(float, __builtin_amdgcn_update_dpp(0, __builtin_bit_cast(int, v), CTRL, 0xF, 0xF, true)); }
template <int CTRL> __device__ __forceinline__ unsigned dppu(unsigned v) { return (unsigned)__builtin_amdgcn_update_dpp(0, (int)v, CTRL, 0xF, 0xF, true); }
__device__ __forceinline__ void swap32f(float& a, float& b) { asm volatile("s_nop 1\n\tv_permlane32_swap_b32 %0, %1" : "+v"(a), "+v"(b)); }
__device__ __forceinline__ void swap16f(float& a, float& b) { asm volatile("s_nop 1\n\tv_permlane16_swap_b32 %0, %1" : "+v"(a), "+v"(b)); }
__device__ __forceinline__ void swap32u(unsigned& a, unsigned& b) { asm volatile("s_nop 1\n\tv_permlane32_swap_b32 %0, %1" : "+v"(a), "+v"(b)); }
__device__ __forceinline__ void swap16u(unsigned& a, unsigned& b) { asm volatile("s_nop 1\n\tv_permlane16_swap_b32 %0, %1" : "+v"(a), "+v"(b)); }
__device__ __forceinline__ float fmax_fast(float a, float b) { float r; asm("v_max_f32 %0, %1, %2" : "=v"(r) : "v"(a), "v"(b)); return r; }
__device__ __forceinline__ float xsum32(float v) { float a = v, b = v; swap32f(a, b); return a + b; }
__device__ __forceinline__ float xsum16(float v) { float a = v, b = v; swap16f(a, b); return a + b; }
__device__ __forceinline__ float xmax32(float v) { float a = v, b = v; swap32f(a, b); return fmax_fast(a, b); }
__device__ __forceinline__ float xmax16(float v) { float a = v, b = v; swap16f(a, b); return fmax_fast(a, b); }
__device__ __forceinline__ float xor32f(float v, int h) { float a = v, b = v; swap32f(a, b); return h ? a : b; }
__device__ __forceinline__ float wave_sum(float v) { v += dppf<0xB1>(v); v += dppf<0x4E>(v); v += dppf<0x141>(v); v += dppf<0x140>(v); return xsum16(xsum32(v)); }
__device__ __forceinline__ float wave_max(float v) { v = fmax_fast(v, dppf<0xB1>(v)); v = fmax_fast(v, dppf<0x4E>(v)); v = fmax_fast(v, dppf<0x141>(v)); v = fmax_fast(v, dppf<0x140>(v)); return xmax16(xmax32(v)); }
__device__ __forceinline__ unsigned umaxu(unsigned a, unsigned b) { return a > b ? a : b; }
__device__ __forceinline__ unsigned wave_maxu(unsigned v) { v = umaxu(v, dppu<0xB1>(v)); v = umaxu(v, dppu<0x4E>(v)); v = umaxu(v, dppu<0x141>(v)); v = umaxu(v, dppu<0x140>(v));
    unsigned a = v, b = v; swap32u(a, b); v = umaxu(a, b); a = v; b = v; swap16u(a, b); return umaxu(a, b); }
__device__ __forceinline__ void lds_sync() { asm volatile("s_waitcnt lgkmcnt(0)" ::: "memory"); __builtin_amdgcn_wave_barrier(); }
__device__ __forceinline__ float gelu_tanh(float x) { const float u = 0.7978845608028654f * (x + 0.044715f * x * x * x); const float e = __expf(2.f * u); return 0.5f * x * (2.f - 2.f / (e + 1.f)); }
__device__ __forceinline__ float sigmoidf_(float x) { return __builtin_amdgcn_rcpf(1.f + __expf(-x)); }
__device__ __forceinline__ unsigned sortable(float s) { unsigned b = __float_as_uint(s); return b ^ ((b >> 31) ? 0xFFFFFFFFu : 0x80000000u); }

#define XB_TMO      128
#define XB_XCNT(j)  (256  + 64 * (j))
#define XB_XSUB(j)  (1280 + 64 * (j))
#define XB_XGEN(j)  (2304 + 64 * (j))
#define XB_TOP      3328
#define XB_TOPGEN   3392
#define XCD_BAR_WORDS 3456
#define XB_SPIN_CAP (1u << 24)
__device__ __forceinline__ unsigned xb_ld(unsigned* p)              { return __hip_atomic_load(p, __ATOMIC_RELAXED, __HIP_MEMORY_SCOPE_AGENT); }
__device__ __forceinline__ unsigned xb_add(unsigned* p, unsigned v) { return __hip_atomic_fetch_add(p, v, __ATOMIC_RELAXED, __HIP_MEMORY_SCOPE_AGENT); }
__device__ __forceinline__ unsigned xb_xcc_id() { return (unsigned)__builtin_amdgcn_s_getreg((3 << 11) | 20) & 0xFu; }
#define XB_SPIN(cond, bar) do { unsigned _sp = 0; while (cond) { __builtin_amdgcn_s_sleep(1); \
    if ((++_sp & 255u) == 0u) { if (xb_ld(&(bar)[XB_TMO])) break; if (_sp > XB_SPIN_CAP) { atomicAdd(&(bar)[XB_TMO], 1u); break; } } } } while (0)
struct XcdBarrier { unsigned* bar; unsigned x; volatile LAS unsigned* st; };
__device__ __forceinline__ XcdBarrier xcd_barrier_post(unsigned* bar, volatile LAS unsigned* st) {
    XcdBarrier b; b.bar = bar; b.x = xb_xcc_id(); b.st = st;
    if (threadIdx.x == 0) (void)xb_add(&bar[XB_XCNT(b.x)], 1u);
    return b;
}
__device__ __forceinline__ void xcd_barrier_complete(unsigned* bar, unsigned x, unsigned& nloc, unsigned& nx) {
    const unsigned G = gridDim.x * gridDim.y * gridDim.z;
    unsigned sum, cnt, mine, sp = 0u;
    for (;;) {
        sum = 0u; cnt = 0u; mine = 0u;
#pragma unroll
        for (unsigned j = 0; j < 16; ++j) { const unsigned c = xb_ld(&bar[XB_XCNT(j)]); sum += c; cnt += (c > 0u) ? 1u : 0u; mine = (j == x) ? c : mine; }
        if (sum == G) break;
        __builtin_amdgcn_s_sleep(1);
        if ((++sp & 255u) == 0u) { if (xb_ld(&bar[XB_TMO])) break; if (sp > XB_SPIN_CAP) { atomicAdd(&bar[XB_TMO], 1u); break; } }
    }
    nloc = mine > 0u ? mine : 1u; nx = cnt > 0u ? cnt : 1u;
}
__device__ __forceinline__ void xcd_barrier(const XcdBarrier& b) {
    asm volatile("s_waitcnt vmcnt(0)" ::: "memory");
    __syncthreads();
    if (threadIdx.x == 0) {
        unsigned* bar = b.bar;
        __builtin_amdgcn_s_waitcnt(0);
        unsigned nloc = b.st[0], nx = b.st[1];
        if (nloc == 0u) { xcd_barrier_complete(bar, b.x, nloc, nx); b.st[0] = nloc; b.st[1] = nx; }
        const unsigned old = xb_add(&bar[XB_XSUB(b.x)], 1u);
        const unsigned gen = old / nloc;
        if (old + 1u == (gen + 1u) * nloc) {
            __builtin_amdgcn_fence(__ATOMIC_RELEASE, "agent");
            asm volatile("s_waitcnt vmcnt(0)" ::: "memory");
            const unsigned og = xb_add(&bar[XB_TOP], 1u);
            const unsigned tg = og / nx;
            if (og + 1u == (tg + 1u) * nx) xb_add(&bar[XB_TOPGEN], 1u);
            else XB_SPIN(xb_ld(&bar[XB_TOPGEN]) == tg, bar);
            __builtin_amdgcn_fence(__ATOMIC_ACQUIRE, "agent");
            xb_add(&bar[XB_XGEN(b.x)], 1u);
            asm volatile("s_waitcnt vmcnt(0)" ::: "memory");
        } else {
            XB_SPIN(xb_ld(&bar[XB_XGEN(b.x)]) == gen, bar);
            __builtin_amdgcn_fence(__ATOMIC_ACQUIRE, "agent");
            asm volatile("s_waitcnt vmcnt(0)" ::: "memory");
        }
    }
    __syncthreads();
}

namespace pg8 {
constexpr int BM = 256, BK = 64, HALF = 128, HTB = HALF * BK * 2, STAGE_BYTES = 8 * HTB, NXCD = 8, WGM = 8;
__host__ __device__ __forceinline__ int lds_byte(int r, int c) { const int st = (r >> 4) * 2 + (c >> 5), rr = r & 15, cc = c & 31, ob = rr * 64 + cc * 2; return st * 1024 + (ob ^ (((ob >> 9) & 1) << 5)); }
__host__ __device__ __forceinline__ void stage_rc(int b, int& R, int& C) { const int st = b / 1024, sb = b % 1024, swz = sb ^ (((sb >> 9) & 1) << 5); R = (st >> 1) * 16 + swz / 64; C = (st & 1) * 32 + (swz % 64) / 2; }
__host__ __device__ __forceinline__ int perm32(int rho) { const int n = rho >> 4, i = rho & 15; return 8 * (i >> 2) + 4 * n + (i & 3); }
struct Unit { int pm, pn, kofs; };
struct Gemm { const bf16_t* A; const bf16_t* Bt; int M, N, K, lda, ldb; };
struct StaticOrder {
    int nM, nN, nwg, G, c;
    __host__ __device__ void init(int M, int N, int G_, int c_) { nM = M / BM; nN = N / BM; nwg = nM * nN; G = G_; c = c_; }
    __host__ __device__ bool next(int i, Unit& u) const {
        const long L = (long)i * G + c; if (L >= nwg) return false;
        int wgid = (int)L; { const int q = nwg / NXCD, r = nwg % NXCD, xcd = wgid % NXCD, off = wgid / NXCD; wgid = (xcd < r ? xcd * (q + 1) : r * (q + 1) + (xcd - r) * q) + off; }
        const int nig = WGM * nN, gid = wgid / nig, fm = gid * WGM, gsz = (nM - fm) < WGM ? (nM - fm) : WGM;
        u.pm = fm + ((wgid % nig) % gsz); u.pn = (wgid % nig) / gsz; u.kofs = 0; return true;
    }
};
struct Fp8Order {
    int c;
    __host__ __device__ bool next(int i, Unit& u) const {
        const int cnt = c < 64 ? 6 : (c < 192 ? 9 : 8); if (i >= cnt) return false;
        const int off = c < 64 ? 6 * c : (c < 192 ? 384 + 9 * (c - 64) : 1536 + 8 * (c - 192));
        const int L = off + i; u.pm = L & 63; u.pn = L >> 6; u.kofs = 0; return true; }
};
struct CmpOrder {
    int G, c;
    __host__ __device__ bool next(int i, Unit& u) const { const long L = (long)i * G + c; if (L >= 256) return false; u.pm = (int)(L & 31); u.pn = u.pm >> 4; u.kofs = (int)(L >> 5) * 512; return true; }
};

struct EpiPlain {
    static constexpr bool PERM = true;
    bf16_t* O; int ldc; float scale;
    __device__ __forceinline__ void operator()(const f32x4 (&acc)[2][2][4][2], const Unit& u, int wr, int wc, int fr, int fq) const {
        const int row0 = u.pm * BM + wr * 64 + fr, col0 = u.pn * BM + wc * 32 + 8 * fq;
#pragma unroll
        for (int ai = 0; ai < 2; ++ai)
#pragma unroll
            for (int m = 0; m < 4; ++m) { bf16_t* rowp = O + (size_t)(row0 + ai * HALF + m * 16) * ldc + col0;
#pragma unroll
                for (int bj = 0; bj < 2; ++bj) { const f32x4 v0 = acc[ai][bj][m][0] * scale, v1 = acc[ai][bj][m][1] * scale;
                    u32x4 w; w.x = cvt_pk_bf16(v0[0], v0[1]); w.y = cvt_pk_bf16(v0[2], v0[3]); w.z = cvt_pk_bf16(v1[0], v1[1]); w.w = cvt_pk_bf16(v1[2], v1[3]);
                    *(u32x4*)(rowp + bj * HALF) = w; } }
    }
};
struct EpiSigU8 {
    static constexpr bool PERM = true;
    unsigned char* O; int ldb; float scale;
    __device__ __forceinline__ void operator()(const f32x4 (&acc)[2][2][4][2], const Unit& u, int wr, int wc, int fr, int fq) const {
        const int row0 = u.pm * BM + wr * 64 + fr, col0 = u.pn * BM + wc * 32 + 8 * fq;
#pragma unroll
        for (int ai = 0; ai < 2; ++ai)
#pragma unroll
            for (int m = 0; m < 4; ++m) { unsigned char* rowp = O + (size_t)(row0 + ai * HALF + m * 16) * ldb + col0;
#pragma unroll
                for (int bj = 0; bj < 2; ++bj) { const f32x4 v0 = acc[ai][bj][m][0] * scale, v1 = acc[ai][bj][m][1] * scale;
                    unsigned w0 = 0u, w1 = 0u;
                    w0 = __builtin_amdgcn_cvt_pk_u8_f32(255.f * sigmoidf_(v0[0]), 0, w0); w0 = __builtin_amdgcn_cvt_pk_u8_f32(255.f * sigmoidf_(v0[1]), 1, w0);
                    w0 = __builtin_amdgcn_cvt_pk_u8_f32(255.f * sigmoidf_(v0[2]), 2, w0); w0 = __builtin_amdgcn_cvt_pk_u8_f32(255.f * sigmoidf_(v0[3]), 3, w0);
                    w1 = __builtin_amdgcn_cvt_pk_u8_f32(255.f * sigmoidf_(v1[0]), 0, w1); w1 = __builtin_amdgcn_cvt_pk_u8_f32(255.f * sigmoidf_(v1[1]), 1, w1);
                    w1 = __builtin_amdgcn_cvt_pk_u8_f32(255.f * sigmoidf_(v1[2]), 2, w1); w1 = __builtin_amdgcn_cvt_pk_u8_f32(255.f * sigmoidf_(v1[3]), 3, w1);
                    *(u32x2*)(rowp + bj * HALF) = (u32x2){w0, w1}; } }
    }
};
template <int SECOND> struct EpiGate {
    static constexpr bool PERM = true;
    bf16_t* O; int ldc; const unsigned char* gate; int ldg; float scale; unsigned char* O8;
    __device__ __forceinline__ void operator()(const f32x4 (&acc)[2][2][4][2], const Unit& u, int wr, int wc, int fr, int fq) const {
        const int row0 = u.pm * BM + wr * 64 + fr, col0 = u.pn * BM + wc * 32 + 8 * fq;
#pragma unroll
        for (int ai = 0; ai < 2; ++ai)
#pragma unroll
            for (int m = 0; m < 4; ++m) { const size_t row = (size_t)(row0 + ai * HALF + m * 16); bf16_t* rowp = O + row * ldc + col0; const unsigned char* gp = gate + row * ldg + col0;
#pragma unroll
                for (int bj = 0; bj < 2; ++bj) { const f32x4 v0 = acc[ai][bj][m][0] * scale, v1 = acc[ai][bj][m][1] * scale;
                    const u32x2 gv = *(const u32x2*)(gp + bj * HALF);
                    float r[8];
#pragma unroll
                    for (int e = 0; e < 4; ++e) { r[e] = (float)((gv.x >> (8 * e)) & 0xFFu) * v0[e]; r[4 + e] = (float)((gv.y >> (8 * e)) & 0xFFu) * v1[e]; }
                    if (SECOND) { const u32x4 pv = *(const u32x4*)(rowp + bj * HALF);
                        r[0] += bflo(pv.x); r[1] += bfhi(pv.x); r[2] += bflo(pv.y); r[3] += bfhi(pv.y); r[4] += bflo(pv.z); r[5] += bfhi(pv.z); r[6] += bflo(pv.w); r[7] += bfhi(pv.w);
                        int p0 = __builtin_amdgcn_cvt_pk_fp8_f32(r[0] * 32.f, r[1] * 32.f, 0, false); p0 = __builtin_amdgcn_cvt_pk_fp8_f32(r[2] * 32.f, r[3] * 32.f, p0, true);
                        int p1 = __builtin_amdgcn_cvt_pk_fp8_f32(r[4] * 32.f, r[5] * 32.f, 0, false); p1 = __builtin_amdgcn_cvt_pk_fp8_f32(r[6] * 32.f, r[7] * 32.f, p1, true);
                        *(u32x2*)(O8 + row * ldc + col0 + bj * HALF) = (u32x2){(unsigned)p0, (unsigned)p1};
                    } else {
                    u32x4 w; w.x = cvt_pk_bf16(r[0], r[1]); w.y = cvt_pk_bf16(r[2], r[3]); w.z = cvt_pk_bf16(r[4], r[5]); w.w = cvt_pk_bf16(r[6], r[7]);
                    *(u32x4*)(rowp + bj * HALF) = w; } } }
    }
};
struct EpiResid {
    static constexpr bool PERM = false;
    float* C; const float* X; const float* gt; int ldc; float scale;
    __device__ __forceinline__ void operator()(const f32x4 (&acc)[2][2][4][2], const Unit& u, int wr, int wc, int fr, int fq) const {
        const int row0 = u.pm * BM + wr * 64 + fr, col0 = u.pn * BM + wc * 32 + 4 * fq;
        f32x4 gv[2][2];
#pragma unroll
        for (int bj = 0; bj < 2; ++bj)
#pragma unroll
            for (int n = 0; n < 2; ++n) gv[bj][n] = *(const f32x4*)(gt + col0 + bj * HALF + n * 16) * scale;
#pragma unroll
        for (int ai = 0; ai < 2; ++ai)
#pragma unroll
            for (int m = 0; m < 4; ++m) { const size_t off = (size_t)(row0 + ai * HALF + m * 16) * ldc + col0;
#pragma unroll
                for (int bj = 0; bj < 2; ++bj)
#pragma unroll
                    for (int n = 0; n < 2; ++n) { const f32x4 xv = *(const f32x4*)(X + off + bj * HALF + n * 16);
                        *(f32x4*)(C + off + bj * HALF + n * 16) = xv + gv[bj][n] * acc[ai][bj][m][n]; } }
    }
};
struct EpiSlab {
    static constexpr bool PERM = false;
    float* C;
    __device__ __forceinline__ void operator()(const f32x4 (&acc)[2][2][4][2], const Unit& u, int wr, int wc, int fr, int fq) const {
        const int row0 = u.pm * BM + wr * 64 + fr, col0 = wc * 32 + 4 * fq;
        float* base = C + (size_t)(u.kofs >> 9) * 8192 * 256;
#pragma unroll
        for (int ai = 0; ai < 2; ++ai)
#pragma unroll
            for (int m = 0; m < 4; ++m) { float* rowp = base + (size_t)(row0 + ai * HALF + m * 16) * 256 + col0;
#pragma unroll
                for (int bj = 0; bj < 2; ++bj)
#pragma unroll
                    for (int n = 0; n < 2; ++n) *(f32x4*)(rowp + bj * HALF + n * 16) = acc[ai][bj][m][n]; }
    }
};

typedef int i32x8 __attribute__((ext_vector_type(8)));
template <class Epi, class Sched, bool FP8 = false>
__device__ __forceinline__ void gemm_phase(LAS unsigned char* lds, const Gemm g, const Sched& S, const Epi& E) {
    const int tid = threadIdx.x, wid = __builtin_amdgcn_readfirstlane(tid >> 6), lane = tid & 63, wr = wid >> 2, wc = wid & 3, fr = lane & 15, fq = lane >> 4;
    const int K = g.K, nt = K / BK, lda = g.lda, ldb = g.ldb;
    unsigned voffA[2], voffB[2];
#pragma unroll
    for (int i = 0; i < 2; ++i) { int R, C; stage_rc(tid * 16 + i * 8192, R, C); const int Rb = Epi::PERM ? ((R & ~31) + perm32(R & 31)) : R;
        voffA[i] = (unsigned)(R * lda + C) * 2u; voffB[i] = (unsigned)(Rb * ldb + C) * 2u; }
    const size_t kstep = (size_t)(BK * 2);
    const size_t hstepA = (size_t)HALF * lda * 2, hstepB = (size_t)HALF * ldb * 2;
    const size_t tstepA = 2 * hstepA, tstepB = 2 * hstepB;
    const unsigned ldsw = (unsigned)wid * 1024u;
    const int aoff = lds_byte(wr * 64 + fr, fq * 8), boff = lds_byte(wc * 32 + fr, fq * 8);
#define PG8_SA(b, h) (((b) * 2 + (h)) * HTB)
#define PG8_SB(b, h) ((4 + (b) * 2 + (h)) * HTB)
#define PG8_STAGE(bufoff, gbase, voff) do { _Pragma("unroll") for (int _i = 0; _i < 2; ++_i) \
        __builtin_amdgcn_global_load_lds((const unsigned*)((const char*)(gbase) + (voff)[_i]), (LAS unsigned*)(lds + (bufoff) + ldsw + _i * 8192), 16, 0, 0); } while (0)
#define PG8_LDA(dst, b, h) do { _Pragma("unroll") for (int m = 0; m < 4; ++m) { if constexpr (FP8) dst##8[m] = __builtin_shufflevector(*(const LAS i32x4_*)(lds + PG8_SA(b, h) + aoff + m * 2048), *(const LAS i32x4_*)(lds + PG8_SA(b, h) + aoff + m * 2048 + 1024), 0, 1, 2, 3, 4, 5, 6, 7); \
        else { _Pragma("unroll") for (int k = 0; k < 2; ++k) dst[m][k] = *(const LAS bf16x8*)(lds + PG8_SA(b, h) + aoff + m * 2048 + k * 1024); } } } while (0)
#define PG8_LDB(dst, b, h) do { _Pragma("unroll") for (int n = 0; n < 2; ++n) { if constexpr (FP8) dst##8[n] = __builtin_shufflevector(*(const LAS i32x4_*)(lds + PG8_SB(b, h) + boff + n * 2048), *(const LAS i32x4_*)(lds + PG8_SB(b, h) + boff + n * 2048 + 1024), 0, 1, 2, 3, 4, 5, 6, 7); \
        else { _Pragma("unroll") for (int k = 0; k < 2; ++k) dst[n][k] = *(const LAS bf16x8*)(lds + PG8_SB(b, h) + boff + n * 2048 + k * 1024); } } } while (0)
typedef int i32x4_ __attribute__((ext_vector_type(4)));
#define PG8_MMA(ai, bj, At, Bt) do { __builtin_amdgcn_s_setprio(1); _Pragma("unroll") for (int m = 0; m < 4; ++m) _Pragma("unroll") for (int n = 0; n < 2; ++n) { \
        if constexpr (FP8) asm volatile("v_mfma_scale_f32_16x16x128_f8f6f4 %0, %1, %2, %0, %3, %3 op_sel_hi:[0,0,0]" : "+v"(acc[ai][bj][m][n]) : "v"(Bt##8[n]), "v"(At##8[m]), "v"(one_scale)); \
        else { _Pragma("unroll") for (int k = 0; k < 2; ++k) acc[ai][bj][m][n] = __builtin_amdgcn_mfma_f32_16x16x32_bf16(Bt[n][k], At[m][k], acc[ai][bj][m][n], 0, 0, 0); } } \
        __builtin_amdgcn_s_setprio(0); } while (0)
#define PG8_WAIT_V(n) asm volatile("s_waitcnt vmcnt(" #n ")" ::: "memory")
#define PG8_WAIT_L(n) asm volatile("s_waitcnt lgkmcnt(" #n ")" ::: "memory")
#define PG8_BAR __builtin_amdgcn_s_barrier()
#define PG8_SCHED __builtin_amdgcn_sched_barrier(0)
    Unit cur, nxt; int ui = 0;
    if (!S.next(0, cur)) return;
    f32x4 acc[2][2][4][2];
#pragma unroll
    for (int a = 0; a < 2; ++a)
#pragma unroll
        for (int b = 0; b < 2; ++b)
#pragma unroll
            for (int m = 0; m < 4; ++m)
#pragma unroll
                for (int n = 0; n < 2; ++n) acc[a][b][m][n] = (f32x4){0.f, 0.f, 0.f, 0.f};
    bf16x8 At[4][2], B0[2][2], B1[2][2];
    i32x8 At8[4], B08[2], B18[2];
    const int one_scale = 0x7F7F7F7F;
    const char* cA = (const char*)g.A + (size_t)cur.pm * tstepA + (size_t)cur.kofs * 2; const char* cB = (const char*)g.Bt + (size_t)cur.pn * tstepB + (size_t)cur.kofs * 2;
    PG8_STAGE(PG8_SB(0, 0), cB, voffB); PG8_STAGE(PG8_SB(0, 1), cB + hstepB, voffB); PG8_STAGE(PG8_SA(0, 0), cA, voffA); PG8_STAGE(PG8_SA(0, 1), cA + hstepA, voffA);
    if (wr == 1) PG8_BAR;
    PG8_WAIT_V(2); PG8_BAR;
    PG8_STAGE(PG8_SB(1, 0), cB + kstep, voffB); PG8_STAGE(PG8_SA(1, 0), cA + kstep, voffA); PG8_STAGE(PG8_SB(1, 1), cB + hstepB + kstep, voffB);
    PG8_WAIT_V(6); PG8_BAR;
    for (;;) {
        const bool has_next = S.next(ui + 1, nxt);
        const char* nA = has_next ? (const char*)g.A + (size_t)nxt.pm * tstepA + (size_t)nxt.kofs * 2 : cA; const char* nB = has_next ? (const char*)g.Bt + (size_t)nxt.pn * tstepB + (size_t)nxt.kofs * 2 : cB;
        for (int t = 0; t < nt; t += 2) {
            const bool last = (t == nt - 2);
            const char* a1 = cA + (size_t)(t + 1) * kstep;
            const char* a2 = last ? nA : cA + (size_t)(t + 2) * kstep; const char* b2 = last ? nB : cB + (size_t)(t + 2) * kstep;
            const char* a3 = a2 + kstep; const char* b3 = b2 + kstep;
            PG8_LDB(B0, 0, 0); PG8_LDB(B1, 0, 1); PG8_SCHED; PG8_LDA(At, 0, 0); PG8_STAGE(PG8_SA(1, 1), a1 + hstepA, voffA);
            PG8_WAIT_V(8); PG8_WAIT_L(0); PG8_BAR; PG8_MMA(0, 0, At, B0); PG8_MMA(0, 1, At, B1); PG8_BAR; PG8_SCHED;
            PG8_LDA(At, 0, 1); PG8_STAGE(PG8_SB(0, 0), b2, voffB); PG8_STAGE(PG8_SB(0, 1), b2 + hstepB, voffB); PG8_STAGE(PG8_SA(0, 0), a2, voffA);
            PG8_WAIT_V(8); PG8_WAIT_L(0); PG8_BAR; PG8_MMA(1, 0, At, B0); PG8_MMA(1, 1, At, B1); PG8_BAR; PG8_SCHED;
            PG8_LDB(B0, 1, 0); PG8_LDB(B1, 1, 1); PG8_SCHED; PG8_LDA(At, 1, 0); PG8_STAGE(PG8_SA(0, 1), a2 + hstepA, voffA);
            PG8_WAIT_V(8); PG8_WAIT_L(0); PG8_BAR; PG8_MMA(0, 0, At, B0); PG8_MMA(0, 1, At, B1); PG8_BAR; PG8_SCHED;
            PG8_LDA(At, 1, 1); PG8_STAGE(PG8_SB(1, 0), b3, voffB); PG8_STAGE(PG8_SB(1, 1), b3 + hstepB, voffB); PG8_STAGE(PG8_SA(1, 0), a3, voffA);
            PG8_WAIT_V(8); PG8_WAIT_L(0); PG8_BAR; PG8_MMA(1, 0, At, B0); PG8_MMA(1, 1, At, B1); PG8_BAR; PG8_SCHED;
        }
        if (wr == 0) PG8_BAR;
        if constexpr (FP8) asm volatile("s_nop 15\n\ts_nop 15\n\ts_nop 15" ::: "memory");
        E(acc, cur, wr, wc, fr, fq);
        if (!has_next) break;
#pragma unroll
        for (int a = 0; a < 2; ++a)
#pragma unroll
            for (int b = 0; b < 2; ++b)
#pragma unroll
                for (int m = 0; m < 4; ++m)
#pragma unroll
                    for (int n = 0; n < 2; ++n) acc[a][b][m][n] = (f32x4){0.f, 0.f, 0.f, 0.f};
        cur = nxt; cA = nA; cB = nB; ++ui;
        if (wr == 1) PG8_BAR;
    }
    PG8_WAIT_V(0);
    PG8_BAR;
#undef PG8_SA
#undef PG8_SB
#undef PG8_STAGE
#undef PG8_LDA
#undef PG8_LDB
#undef PG8_MMA
#undef PG8_WAIT_V
#undef PG8_WAIT_L
#undef PG8_BAR
#undef PG8_SCHED
}
}

struct Args { const float* in[27]; float* out; unsigned char* ws; int ph_lo, ph_hi; };
struct Ctx { const float* const* in; float* out; unsigned char* ws; LAS unsigned char* lds; int tid, lane, wave; };

enum { I_X = 0, I_C, I_RELB, I_WADA, I_BADA, I_GMIX, I_WIN, I_GQA, I_GKA, I_GQB, I_GKCMP, I_GKSLC, I_GKWIN, I_PEK, I_W1K, I_W2K, I_PEV, I_W1V, I_W2V,
       I_WBA, I_WBB, I_WOUT, I_GFFN, I_WPQ, I_SUBK, I_PU, I_PV };

__device__ __forceinline__ int map_col(int c) {
    if (c < 5120) return c; if (c < 10240) return c + 96; if (c < 10336) return c - 5120; if (c < 10384) return c; if (c < 10496) return -1; return c - 112;
}

template <bool REMAP>
__device__ __forceinline__ void tconv_tile(const Ctx& C, const float* src, int srcN, bf16_t* dst, int dstK, int n0, int k0) {
    LAS float* tile = (LAS float*)C.lds;
    const int tx = C.tid & 31, ty = C.tid >> 5;
    const int nn = n0 + 4 * tx; const int sc = REMAP ? map_col(nn) : nn;
    f32x4 v[8];
#pragma unroll
    for (int i = 0; i < 8; ++i) { const int k = ty + 16 * i; v[i] = (sc >= 0) ? *(const f32x4*)(src + (size_t)(k0 + k) * srcN + sc) : (f32x4){0.f, 0.f, 0.f, 0.f}; }
#pragma unroll
    for (int i = 0; i < 8; ++i) { const int k = ty + 16 * i; LAS float* q = tile + k * 129 + 4 * tx; q[0] = v[i][0]; q[1] = v[i][1]; q[2] = v[i][2]; q[3] = v[i][3]; }
    __syncthreads();
#pragma unroll
    for (int i = 0; i < 4; ++i) { const int task = C.tid + 512 * i; const int nl = task >> 4, kc = task & 15;
        float e[8];
#pragma unroll
        for (int j = 0; j < 8; ++j) e[j] = tile[(kc * 8 + j) * 129 + nl];
        u32x4 w; w.x = cvt_pk_bf16(e[0], e[1]); w.y = cvt_pk_bf16(e[2], e[3]); w.z = cvt_pk_bf16(e[4], e[5]); w.w = cvt_pk_bf16(e[6], e[7]);
        *(u32x4*)(dst + (size_t)(n0 + nl) * dstK + k0 + kc * 8) = w; }
    __syncthreads();
}

template <bool REMAP>
__device__ __forceinline__ void tconv_tile_f8(const Ctx& C, const float* src, int srcN, unsigned char* dst, int dstK, int n0, int k0) {
    LAS float* tile = (LAS float*)C.lds;
    const int tx = C.tid & 31, ty = C.tid >> 5;
    const int nn = n0 + 4 * tx; const int sc = REMAP ? map_col(nn) : nn;
    f32x4 v[8];
#pragma unroll
    for (int i = 0; i < 8; ++i) { const int k = ty + 16 * i; v[i] = (sc >= 0) ? *(const f32x4*)(src + (size_t)(k0 + k) * srcN + sc) : (f32x4){0.f, 0.f, 0.f, 0.f}; }
#pragma unroll
    for (int i = 0; i < 8; ++i) { const int k = ty + 16 * i; LAS float* q = tile + k * 129 + 4 * tx; q[0] = v[i][0]; q[1] = v[i][1]; q[2] = v[i][2]; q[3] = v[i][3]; }
    __syncthreads();
#pragma unroll
    for (int i = 0; i < 2; ++i) { const int task = C.tid + 512 * i; const int nl = task >> 3, kc = task & 7;
        float e[16];
#pragma unroll
        for (int j = 0; j < 16; ++j) e[j] = tile[(kc * 16 + j) * 129 + nl] * 64.f;
        u32x4 w;
#pragma unroll
        for (int q4 = 0; q4 < 4; ++q4) { int p = __builtin_amdgcn_cvt_pk_fp8_f32(e[4 * q4], e[4 * q4 + 1], 0, false); p = __builtin_amdgcn_cvt_pk_fp8_f32(e[4 * q4 + 2], e[4 * q4 + 3], p, true); w[q4] = (unsigned)p; }
        *(u32x4*)(dst + (size_t)(n0 + nl) * dstK + k0 + kc * 16) = w; }
    __syncthreads();
}

__device__ __forceinline__ void wq_subkey_tile(const Ctx& C, int blk, int k0) {
    LAS float* As = (LAS float*)C.lds;
    LAS float* Bs = As + 128 * 132;
    const int tid = C.tid;
    const float* sk = C.in[I_SUBK] + (size_t)blk * 128 * 128; const float* wq = C.in[I_WPQ] + (size_t)k0 * 2048 + blk * 128;
#pragma unroll
    for (int i = 0; i < 8; ++i) { const int idx = tid + 512 * i, r = idx >> 5, c4 = idx & 31;
        const f32x4 a = *(const f32x4*)(sk + (size_t)r * 128 + 4 * c4), b = *(const f32x4*)(wq + (size_t)r * 2048 + 4 * c4);
        *(LAS f32x4*)(As + r * 132 + 4 * c4) = a; *(LAS f32x4*)(Bs + r * 132 + 4 * c4) = b; }
    __syncthreads();
    const int tn = tid >> 4, tk = tid & 15;
    float acc[4][8];
#pragma unroll
    for (int i = 0; i < 4; ++i)
#pragma unroll
        for (int j = 0; j < 8; ++j) acc[i][j] = 0.f;
#pragma unroll 2
    for (int d4 = 0; d4 < 32; ++d4) {
        f32x4 a[4], b[8];
#pragma unroll
        for (int i = 0; i < 4; ++i) a[i] = *(LAS const f32x4*)(As + (4 * tn + i) * 132 + 4 * d4);
#pragma unroll
        for (int j = 0; j < 8; ++j) b[j] = *(LAS const f32x4*)(Bs + (2 * tk + 32 * (j >> 1) + (j & 1)) * 132 + 4 * d4);
#pragma unroll
        for (int i = 0; i < 4; ++i)
#pragma unroll
            for (int j = 0; j < 8; ++j) acc[i][j] += a[i][0] * b[j][0] + a[i][1] * b[j][1] + a[i][2] * b[j][2] + a[i][3] * b[j][3];
    }
    bf16_t* dst = (bf16_t*)(C.ws + WS_WQ) + (size_t)(blk * 128 + 4 * tn) * 4096 + k0 + 2 * tk;
#pragma unroll
    for (int i = 0; i < 4; ++i)
#pragma unroll
        for (int j = 0; j < 4; ++j) *(unsigned*)(dst + (size_t)i * 4096 + 32 * j) = cvt_pk_bf16(acc[i][2 * j], acc[i][2 * j + 1]);
    __syncthreads();
}

__device__ __forceinline__ void peer_row_convert(const Ctx& C, int grow, int lane) {
            const bool second = grow >= 16384; const int row = grow & 16383;
            const float* src = C.in[second ? I_PV : I_PU] + (size_t)row * 4096;
            unsigned char* dst6 = C.ws + (second ? WS_PV : WS_PU) + (size_t)row * 3072;
            f32x16 v[4]; float am = 0.f;
#pragma unroll
            for (int i4 = 0; i4 < 4; ++i4)
#pragma unroll
                for (int q = 0; q < 4; ++q) { const f32x4 t4 = *(const f32x4*)(src + 16 * (lane + 64 * i4) + 4 * q);
                    v[i4][4 * q] = t4[0]; v[i4][4 * q + 1] = t4[1]; v[i4][4 * q + 2] = t4[2]; v[i4][4 * q + 3] = t4[3];
                    am = fmaxf(am, fmaxf(fmaxf(fabsf(t4[0]), fabsf(t4[1])), fmaxf(fabsf(t4[2]), fabsf(t4[3])))); }
            am = wave_max(am);
            const float sc = am > 0.f ? am * (1.f / 7.f) : 1.f, inv = 1.f / sc;
#pragma unroll
            for (int i4 = 0; i4 < 4; ++i4) v[i4] *= inv;
            const u32x6 pa = __builtin_amdgcn_cvt_scalef32_2xpk16_fp6_f32(v[0], v[1], 1.0f), pb = __builtin_amdgcn_cvt_scalef32_2xpk16_fp6_f32(v[2], v[3], 1.0f);
            *(u32x4*)(dst6 + 16 * lane) = (u32x4){pa[0], pa[1], pa[2], pa[3]};
            *(u32x4*)(dst6 + 1024 + 16 * lane) = (u32x4){pa[4], pa[5], pb[0], pb[1]};
            *(u32x4*)(dst6 + 2048 + 16 * lane) = (u32x4){pb[2], pb[3], pb[4], pb[5]};
            ((float*)(C.ws + (second ? WS_PV : WS_PU) + 96 * MB))[row] = sc;
            { float al = 0.f;
#pragma unroll
              for (int i4 = 0; i4 < 4; ++i4)
#pragma unroll
                  for (int j = 0; j < 16; ++j) al = fmaxf(al, fabsf(v[i4][j]));
              const float s4 = al > 0.f ? al * (1.f / 6.f) : 1.f, inv4 = 1.f / s4;
              unsigned wa[4] = {0u, 0u, 0u, 0u}, wb[4] = {0u, 0u, 0u, 0u};
#define PK4(d_) do { wa[d_] = __builtin_amdgcn_cvt_scalef32_pk_fp4_f32(wa[d_], v[0][4 * (d_)] * inv4, v[1][4 * (d_)] * inv4, 1.0f, 0); wa[d_] = __builtin_amdgcn_cvt_scalef32_pk_fp4_f32(wa[d_], v[0][4 * (d_) + 1] * inv4, v[1][4 * (d_) + 1] * inv4, 1.0f, 1); \
                     wa[d_] = __builtin_amdgcn_cvt_scalef32_pk_fp4_f32(wa[d_], v[0][4 * (d_) + 2] * inv4, v[1][4 * (d_) + 2] * inv4, 1.0f, 2); wa[d_] = __builtin_amdgcn_cvt_scalef32_pk_fp4_f32(wa[d_], v[0][4 * (d_) + 3] * inv4, v[1][4 * (d_) + 3] * inv4, 1.0f, 3); \
                     wb[d_] = __builtin_amdgcn_cvt_scalef32_pk_fp4_f32(wb[d_], v[2][4 * (d_)] * inv4, v[3][4 * (d_)] * inv4, 1.0f, 0); wb[d_] = __builtin_amdgcn_cvt_scalef32_pk_fp4_f32(wb[d_], v[2][4 * (d_) + 1] * inv4, v[3][4 * (d_) + 1] * inv4, 1.0f, 1); \
                     wb[d_] = __builtin_amdgcn_cvt_scalef32_pk_fp4_f32(wb[d_], v[2][4 * (d_) + 2] * inv4, v[3][4 * (d_) + 2] * inv4, 1.0f, 2); wb[d_] = __builtin_amdgcn_cvt_scalef32_pk_fp4_f32(wb[d_], v[2][4 * (d_) + 3] * inv4, v[3][4 * (d_) + 3] * inv4, 1.0f, 3); } while (0)
              PK4(0); PK4(1); PK4(2); PK4(3);
#undef PK4
              unsigned char* dst4 = C.ws + (second ? WS_PV4 : WS_PU4) + (size_t)row * 2176;
              *(u32x4*)(dst4 + 16 * lane) = (u32x4){wa[0], wa[1], wa[2], wa[3]};
              *(u32x4*)(dst4 + 1024 + 16 * lane) = (u32x4){wb[0], wb[1], wb[2], wb[3]};
              *(bf16_t*)(dst4 + 2048 + 2 * lane) = f2bf(sc * s4); }

}

__device__ __forceinline__ void p0_prologue(const Ctx& C) {
    constexpr int N_MOD = 256, N_WIN = (NP / 128) * (D / 128), N_W1 = 2 * 32, N_B1 = 64;
    constexpr int E0 = N_MOD, E1 = E0 + N_B1, E2 = E1 + N_WIN, E7 = E2 + N_W1, E8 = E7 + N_W1, E11 = E8;
    const int tid = C.tid;
    for (int it = blockIdx.x; it < E11; it += gridDim.x) {
        if (it < E0) {
            const int b = it; LAS float* red = (LAS float*)C.lds;
            const float* cvec = C.in[I_C]; const float* w = C.in[I_WADA];
            if (tid < 504) { const int cg = tid % 24, rs = tid / 24;
                f32x4 acc = {0.f, 0.f, 0.f, 0.f};
                const float* wp = w + 96 * b + 4 * cg;
#pragma unroll 4
                for (int k = rs; k < D; k += 21) { const float cv = cvec[k]; const f32x4 wv = *(const f32x4*)(wp + (size_t)k * 24576); acc += cv * wv; }
                *(LAS f32x4*)(red + (rs * 24 + cg) * 4) = acc; }
            __syncthreads();
            if (tid < 24) { f32x4 s = *(const f32x4*)(C.in[I_BADA] + 96 * b + 4 * tid);
                for (int rs = 0; rs < 21; ++rs) s += *(LAS f32x4*)(red + (rs * 24 + tid) * 4);
                *(f32x4*)((float*)(C.ws + WS_MOD) + 96 * b + 4 * tid) = s; }
            __syncthreads();
        } else if (it < E1) {
            const int s = (it - E0) >> 5, sl = (it - E0) & 31; const float* pe = C.in[s ? I_PEV : I_PEK]; const float* w1 = C.in[s ? I_W1V : I_W1K];
            const int e = tid & 255, half = tid >> 8; float a = 0.f;
            const int kb = sl * 128 + half * 64;
#pragma unroll 16
            for (int k = kb; k < kb + 64; ++k) a += pe[k] * w1[(size_t)k * 256 + e];
            LAS float* red = (LAS float*)C.lds; red[tid] = a; __syncthreads();
            if (tid < 256) ((float*)(C.ws + WS_B1P))[(s * 32 + sl) * 256 + tid] = red[tid] + red[tid + 256];
            __syncthreads();
        } else if (it < E2) { const int i = it - E1; const int n0 = (i / 32) * 128, k0 = (i % 32) * 128;
            if (n0 < NP_BF) tconv_tile<true>(C, C.in[I_WIN], 18576, (bf16_t*)(C.ws + WS_WIN), D, n0, k0);
            else tconv_tile_f8<true>(C, C.in[I_WIN], 18576, C.ws + WS_WIN8 - (size_t)NP_BF * D, D, n0, k0);
        } else if (it < E7) { const int i = it - E2; tconv_tile<false>(C, C.in[I_W1K], 256, (bf16_t*)(C.ws + WS_W1T), 4096, (i / 32) * 128, (i % 32) * 128);
        } else if (it < E8) { const int i = it - E7; tconv_tile<false>(C, C.in[I_W1V], 256, (bf16_t*)(C.ws + WS_W1T) + (size_t)256 * 4096, 4096, (i / 32) * 128, (i % 32) * 128);
        }
    }
}

__device__ __forceinline__ void norm_mod_phase(const Ctx& C, const float* xin, const float* gain, const float* sh, const float* sc, bf16_t* hout, unsigned char* h8out = nullptr) {
    LAS float* la = (LAS float*)C.lds; LAS float* lb = la + D;
    for (int i = C.tid; i < D / 4; i += NTHREADS) { const f32x4 g4 = *(const f32x4*)(gain + 4 * i), s4 = *(const f32x4*)(sc + 4 * i), h4 = *(const f32x4*)(sh + 4 * i);
        *(LAS f32x4*)(la + 4 * i) = g4 * (s4 + 1.f); *(LAS f32x4*)(lb + 4 * i) = h4; }
    __syncthreads();
    const int rstep = gridDim.x * 8;
    int row = blockIdx.x * 8 + C.wave;
    f32x4 v[16], vn[16];
    if (row < T) {
#pragma unroll
        for (int i = 0; i < 16; ++i) v[i] = ((const f32x4*)(xin + (size_t)row * D))[C.lane + 64 * i]; }
#pragma unroll 1
    for (; row < T; row += rstep) {
        const int nrow = row + rstep;
        if (nrow < T) {
#pragma unroll
            for (int i = 0; i < 16; ++i) vn[i] = ((const f32x4*)(xin + (size_t)nrow * D))[C.lane + 64 * i]; }
        float ss = 0.f;
#pragma unroll
        for (int i = 0; i < 16; ++i) ss += v[i][0] * v[i][0] + v[i][1] * v[i][1] + v[i][2] * v[i][2] + v[i][3] * v[i][3];
        ss = wave_sum(ss);
        const float rstd = rsqrtf(ss * (1.f / 4096.f) + EPS);
#pragma unroll
        for (int i = 0; i < 16; ++i) { const int col = 4 * (C.lane + 64 * i);
            const f32x4 a4 = *(LAS const f32x4*)(la + col), b4 = *(LAS const f32x4*)(lb + col);
            float y[4];
#pragma unroll
            for (int j = 0; j < 4; ++j) y[j] = v[i][j] * rstd * a4[j] + b4[j];
            u32x2 w; w.x = cvt_pk_bf16(y[0], y[1]); w.y = cvt_pk_bf16(y[2], y[3]);
            *(u32x2*)(hout + (size_t)row * D + col) = w;
            if (h8out) { int p = __builtin_amdgcn_cvt_pk_fp8_f32(y[0], y[1], 0, false); p = __builtin_amdgcn_cvt_pk_fp8_f32(y[2], y[3], p, true); *(unsigned*)(h8out + (size_t)row * D + col) = (unsigned)p; } }
#pragma unroll
        for (int i = 0; i < 16; ++i) v[i] = vn[i];
    }
    __syncthreads();
}

__device__ __forceinline__ void p3_post(const Ctx& C) {
    bf16_t* proj = (bf16_t*)(C.ws + WS_PROJ);
    const int tid = C.tid;
    const float qscale = 0.08838834764831845f;
    if (blockIdx.x == 0) { float a = 0.f; const float* part = (const float*)(C.ws + WS_B1P) + (size_t)(tid >> 8) * 32 * 256 + (tid & 255);
        for (int sl = 0; sl < 32; ++sl) a += part[sl * 256]; ((float*)(C.ws + WS_B1))[tid] = a; }
    for (int item = blockIdx.x; item < T / 64; item += gridDim.x) {
        const int t0 = item * 64;
#pragma unroll 1
        for (int hb = tid >> 4; hb < 64 * 44; hb += 128) {
            const int l16 = tid & 15;
            u32x4 raw[4]; bf16_t* dstp[4]; const float* gain[4]; float scl[4]; bool isk8[4];
#pragma unroll
            for (int u = 0; u < 4; ++u) { const int hr = hb + 32 * u; const int tok = hr / 44, hh = hr % 44; int col; isk8[u] = (hh >= 16 && hh < 20);
                if (hh < 16) { col = P_QA + 128 * hh; gain[u] = C.in[I_GQA]; scl[u] = qscale; dstp[u] = proj + (size_t)(t0 + tok) * NP + col; }
                else if (hh < 20) { col = P_KA + 128 * (hh - 16); gain[u] = C.in[I_GKA]; scl[u] = 1.f; dstp[u] = (bf16_t*)(C.ws + WS_KA + (size_t)(t0 + tok) * 512 + 128 * (hh - 16)); }
                else if (hh < 36) { col = P_QB + 128 * (hh - 20); gain[u] = C.in[I_GQB]; scl[u] = qscale * 1.4426950408889634f; dstp[u] = proj + (size_t)(t0 + tok) * NP + col; }
                else if (hh < 40) { col = P_KS + 128 * (hh - 36); gain[u] = C.in[I_GKSLC]; scl[u] = 1.f; dstp[u] = (bf16_t*)(C.ws + WS_KSC) + ((size_t)(hh - 36) * T + t0 + tok) * 128; }
                else { col = P_KW + 128 * (hh - 40); gain[u] = C.in[I_GKWIN]; scl[u] = 1.f; dstp[u] = (bf16_t*)(C.ws + WS_KWC) + ((size_t)(hh - 40) * T + t0 + tok) * 128; }
                raw[u] = *(const u32x4*)(proj + (size_t)(t0 + tok) * NP + col + 8 * l16); }
#pragma unroll
            for (int u = 0; u < 4; ++u) {
                float v[8] = {bflo(raw[u].x), bfhi(raw[u].x), bflo(raw[u].y), bfhi(raw[u].y), bflo(raw[u].z), bfhi(raw[u].z), bflo(raw[u].w), bfhi(raw[u].w)};
                float ss = 0.f;
#pragma unroll
                for (int j = 0; j < 8; ++j) ss += v[j] * v[j];
                ss += dppf<0xB1>(ss); ss += dppf<0x4E>(ss); ss += dppf<0x141>(ss); ss += dppf<0x140>(ss);
                const float rstd = rsqrtf(ss * (1.f / 128.f) + EPS) * scl[u];
                const f32x4 g0 = *(const f32x4*)(gain[u] + 8 * l16), g1 = *(const f32x4*)(gain[u] + 8 * l16 + 4);
                if (isk8[u]) {
                    const float r8 = rstd * 64.f;
                    int p0 = __builtin_amdgcn_cvt_pk_fp8_f32(v[0] * r8 * g0[0], v[1] * r8 * g0[1], 0, false); p0 = __builtin_amdgcn_cvt_pk_fp8_f32(v[2] * r8 * g0[2], v[3] * r8 * g0[3], p0, true);
                    int p1 = __builtin_amdgcn_cvt_pk_fp8_f32(v[4] * r8 * g1[0], v[5] * r8 * g1[1], 0, false); p1 = __builtin_amdgcn_cvt_pk_fp8_f32(v[6] * r8 * g1[2], v[7] * r8 * g1[3], p1, true);
                    *(u32x2*)((unsigned char*)dstp[u] + 8 * l16) = (u32x2){(unsigned)p0, (unsigned)p1};
                } else {
                u32x4 w; w.x = cvt_pk_bf16(v[0] * rstd * g0[0], v[1] * rstd * g0[1]); w.y = cvt_pk_bf16(v[2] * rstd * g0[2], v[3] * rstd * g0[3]);
                w.z = cvt_pk_bf16(v[4] * rstd * g1[0], v[5] * rstd * g1[1]); w.w = cvt_pk_bf16(v[6] * rstd * g1[2], v[7] * rstd * g1[3]);
                *(u32x4*)(dstp[u] + 8 * l16) = w; } }
        }
        bf16_t* Kc = (bf16_t*)(C.ws + WS_KC); bf16_t* Vc = Kc + (size_t)4 * T * 128;
#pragma unroll
        for (int i = 0; i < 8; ++i) { const int idx = tid + 512 * i, tok = idx >> 6, c16 = idx & 63, g = c16 >> 4, d8 = c16 & 15;
            const bf16_t* src = proj + (size_t)(t0 + tok) * NP + 8 * c16;
            const size_t dof = ((size_t)g * T + t0 + tok) * 128 + 8 * d8;
            *(u32x4*)(Kc + dof) = *(const u32x4*)(src + P_KC);
            *(u32x4*)(Vc + dof) = *(const u32x4*)(src + P_VC);
            { const u32x4 rv = *(const u32x4*)(src + P_VA);
              u32x4 w;
              w.x = __builtin_bit_cast(unsigned, __builtin_amdgcn_cvt_pkrtz(bflo(rv.x), bfhi(rv.x))); w.y = __builtin_bit_cast(unsigned, __builtin_amdgcn_cvt_pkrtz(bflo(rv.y), bfhi(rv.y)));
              w.z = __builtin_bit_cast(unsigned, __builtin_amdgcn_cvt_pkrtz(bflo(rv.z), bfhi(rv.z))); w.w = __builtin_bit_cast(unsigned, __builtin_amdgcn_cvt_pkrtz(bflo(rv.w), bfhi(rv.w)));
              *(u32x4*)(C.ws + WS_VA + ((size_t)(t0 + tok) * 512 + 8 * c16) * 2) = w; } }
        { const int tok = tid >> 3, c8 = tid & 7;
          *(u32x4*)((bf16_t*)(C.ws + WS_KIC) + (size_t)(t0 + tok) * 64 + 8 * c8) = *(const u32x4*)(proj + (size_t)(t0 + tok) * NP + P_KI + 8 * c8); }
#pragma unroll 1
        for (int which = 0; which < 2; ++which) {
            const int pcol = which ? P_VW : P_VS; bf16_t* dstT = (bf16_t*)(C.ws + (which ? WS_VWT : WS_VST));
            LAS unsigned* tl = (LAS unsigned*)C.lds;
#pragma unroll
            for (int i = 0; i < 8; ++i) { const int idx = tid + 512 * i, tok = idx >> 6, c16 = idx & 63;
                const u32x4 v = *(const u32x4*)(proj + (size_t)(t0 + tok) * NP + pcol + 8 * c16);
                LAS unsigned* q = tl + tok * 257 + 4 * c16; q[0] = v.x; q[1] = v.y; q[2] = v.z; q[3] = v.w; }
            __syncthreads();
#pragma unroll
            for (int i = 0; i < 8; ++i) { const int task = tid + 512 * i, col = task >> 3, tc = task & 7;
                unsigned short e[8];
#pragma unroll
                for (int j = 0; j < 8; ++j) { const unsigned dw = tl[(8 * tc + j) * 257 + (col >> 1)]; e[j] = (col & 1) ? (unsigned short)(dw >> 16) : (unsigned short)(dw & 0xFFFFu); }
                u32x4 w; w.x = e[0] | ((unsigned)e[1] << 16); w.y = e[2] | ((unsigned)e[3] << 16); w.z = e[4] | ((unsigned)e[5] << 16); w.w = e[6] | ((unsigned)e[7] << 16);
                *(u32x4*)(dstT + (size_t)col * T + t0 + 8 * tc) = w; }
            __syncthreads();
        }
    }
}

__device__ __forceinline__ void p5_cmp_out(const Ctx& C) {
    const float* part = (const float*)(C.ws + WS_HIDP); const float* b1 = (const float*)(C.ws + WS_B1);
    bf16_t* kcmp = (bf16_t*)(C.ws + WS_KCMP); bf16_t* vcT = (bf16_t*)(C.ws + WS_VCMPT);
    LAS float* hl = (LAS float*)(C.lds) + C.wave * 1024;
    const int lane = C.lane;
    for (int grp = blockIdx.x * 8 + C.wave; grp < 2048; grp += gridDim.x * 8) {
        const int R0 = grp * 4; const bool isv = R0 >= 4096;
        lds_sync();
        const f32x4 bb = *(const f32x4*)(b1 + (isv ? 256 : 0) + 4 * lane);
#pragma unroll
        for (int r = 0; r < 4; ++r) { f32x4 a = bb;
#pragma unroll
            for (int ks = 0; ks < 8; ++ks) a += *(const f32x4*)(part + ((size_t)ks * 8192 + R0 + r) * 256 + 4 * lane);
            f32x4 hg; hg[0] = gelu_tanh(a[0]); hg[1] = gelu_tanh(a[1]); hg[2] = gelu_tanh(a[2]); hg[3] = gelu_tanh(a[3]);
            *(LAS f32x4*)(hl + r * 256 + 4 * lane) = hg; }
        lds_sync();
        const float* w2 = C.in[isv ? I_W2V : I_W2K];
        float acc[4][2];
#pragma unroll
        for (int r = 0; r < 4; ++r) { acc[r][0] = 0.f; acc[r][1] = 0.f; }
#pragma unroll 8
        for (int e = 0; e < 256; ++e) { const float2 wv = *(const float2*)(w2 + e * 128 + 2 * lane);
#pragma unroll
            for (int r = 0; r < 4; ++r) { const float hv = hl[r * 256 + e]; acc[r][0] += hv * wv.x; acc[r][1] += hv * wv.y; } }
#pragma unroll
        for (int r = 0; r < 4; ++r) { const int R = R0 + r, Rl = R & 4095, g = Rl >> 10, n = Rl & 1023;
            const float a0 = (n < NCMP) ? acc[r][0] : 0.f, a1 = (n < NCMP) ? acc[r][1] : 0.f;
            if (!isv) { const float ss = wave_sum(a0 * a0 + a1 * a1); const float rstd = rsqrtf(ss * (1.f / 128.f) + EPS);
                const float2 gg = *(const float2*)(C.in[I_GKCMP] + 2 * lane);
                *(unsigned*)(kcmp + (size_t)Rl * 128 + 2 * lane) = (n < NCMP) ? cvt_pk_bf16(a0 * rstd * gg.x, a1 * rstd * gg.y) : 0u; }
            else { vcT[((size_t)g * 128 + 2 * lane) * 1024 + n] = f2bf(a0); vcT[((size_t)g * 128 + 2 * lane + 1) * 1024 + n] = f2bf(a1); } }
    }
}

constexpr int P6_WAVE_LDS = 18432, P6_SHARED = 8192;
__device__ __forceinline__ f32x16 mfma32(bf16x8 a, bf16x8 b, f32x16 c) { return __builtin_amdgcn_mfma_f32_32x32x16_bf16(a, b, c, 0, 0, 0); }
__device__ __forceinline__ int swap23(int r) { return (r & 0x13) | ((r & 4) << 1) | ((r & 8) >> 1); }

__device__ __forceinline__ void topk_prune(LAS u64* buf, int& cnt, u64& tau, LAS unsigned* hist, int lane) {
    u64 e[8];
#pragma unroll
    for (int i = 0; i < 8; ++i) { const int idx = lane + 64 * i; e[i] = idx < cnt ? buf[idx] : 0ull; }
    u64 prefix = 0ull; unsigned need = 256u;
    const u64 lt = (1ull << lane) - 1ull;
#pragma unroll 1
    for (int p = 0; p < 6; ++p) {
        const int shift = 40 - 8 * p;
        *(LAS u32x4*)(hist + 4 * lane) = (u32x4){0u, 0u, 0u, 0u};
        lds_sync();
#pragma unroll
        for (int i = 0; i < 8; ++i) { const bool m = (e[i] != 0ull) && ((e[i] >> (shift + 8)) == (prefix >> (shift + 8)));
            if (m) __hip_atomic_fetch_add(hist + (unsigned)((e[i] >> shift) & 255ull), 1u, __ATOMIC_RELAXED, __HIP_MEMORY_SCOPE_WORKGROUP); }
        lds_sync();
        const u32x4 c = *(LAS u32x4*)(hist + 4 * lane);
        const unsigned tot = c.x + c.y + c.z + c.w;
        unsigned pre = tot;
        pre += (unsigned)__builtin_amdgcn_update_dpp(0, (int)pre, 0x111, 0xF, 0xF, true); pre += (unsigned)__builtin_amdgcn_update_dpp(0, (int)pre, 0x112, 0xF, 0xF, true);
        pre += (unsigned)__builtin_amdgcn_update_dpp(0, (int)pre, 0x114, 0xF, 0xF, true); pre += (unsigned)__builtin_amdgcn_update_dpp(0, (int)pre, 0x118, 0xF, 0xF, true);
        const unsigned r0 = (unsigned)__builtin_amdgcn_readlane((int)pre, 15), r1 = (unsigned)__builtin_amdgcn_readlane((int)pre, 31), r2 = (unsigned)__builtin_amdgcn_readlane((int)pre, 47), r3 = (unsigned)__builtin_amdgcn_readlane((int)pre, 63);
        const int row = lane >> 4;
        pre += (row == 1) ? r0 : (row == 2) ? (r0 + r1) : (row == 3) ? (r0 + r1 + r2) : 0u;
        const unsigned a3 = (r0 + r1 + r2 + r3) - pre, a2 = a3 + c.w, a1 = a2 + c.z, a0 = a1 + c.y;
        int found = -1; unsigned above = 0u;
        if (a3 < need && need <= a3 + c.w) { found = 3; above = a3; }
        else if (a2 < need && need <= a2 + c.z) { found = 2; above = a2; }
        else if (a1 < need && need <= a1 + c.y) { found = 1; above = a1; }
        else if (a0 < need && need <= a0 + c.x) { found = 0; above = a0; }
        const u64 bm = __ballot(found >= 0);
        const int src = bm ? (__ffsll((long long)bm) - 1) : 0;
        const int bin = __builtin_amdgcn_readlane(4 * lane + found, src); const unsigned ab = (unsigned)__builtin_amdgcn_readlane((int)above, src);
        prefix |= ((u64)(unsigned)bin) << shift; need -= ab;
        lds_sync();
    }
    tau = prefix;
    int base = 0;
#pragma unroll
    for (int i = 0; i < 8; ++i) { const bool keep = (e[i] >= tau) && (e[i] != 0ull); const u64 m = __ballot(keep);
        if (keep) buf[base + __popcll(m & lt)] = e[i]; base += __popcll(m); }
    cnt = base;
    lds_sync();
}

#ifndef DSA_PROBE_MODE
#define DSA_PROBE_MODE 0
#endif
__device__ __forceinline__ void dsa_item(const Ctx& C, int qp, LAS unsigned char* wl, LAS const unsigned char* bkt, LAS const float* tbl, int pmode = 0) {
    const int lane = C.lane, r = lane & 31, h = lane >> 5;
    const bf16_t* proj = (const bf16_t*)(C.ws + WS_PROJ); const bf16_t* kic = (const bf16_t*)(C.ws + WS_KIC);
    unsigned char* ya = C.ws + WS_YA;
    const int t0 = 2 * qp;
    LAS u64* buf0 = (LAS u64*)wl; LAS u64* buf1 = (LAS u64*)(wl + 4096);
    LAS unsigned* hist = (LAS unsigned*)(wl + 8192);
    LAS unsigned char* qst = wl + 9216;
    LAS float* pl = (LAS float*)(wl + 10240);
    LAS unsigned* idxs = (LAS unsigned*)(wl + 14336);
    const u64 lt = (1ull << lane) - 1ull;
    {
    bf16x8 A[2][4]; unsigned wp[2][8];
#pragma unroll
    for (int q = 0; q < 2; ++q) {
        const bf16_t* pr = proj + (size_t)(t0 + q) * NP;
#pragma unroll
        for (int kk = 0; kk < 4; ++kk) A[q][kk] = *(const bf16x8*)(pr + P_QI + 64 * r + 32 * h + 8 * kk);
#pragma unroll
        for (int k2 = 0; k2 < 8; ++k2) { const int reg = 2 * k2; wp[q][k2] = *(const unsigned*)(pr + P_WI + (reg & 3) + 8 * (reg >> 2) + 4 * h); }
    }
    int cnt0 = 0, cnt1 = 0; u64 tau0 = 0ull, tau1 = 0ull;
    const int nkeys = (pmode == 2) ? 0 : t0 + 2;
    LAS unsigned char* stg = wl + 9216;
    const unsigned ixo0 = (unsigned)(((lane >> 3) * 64 + 8 * ((lane & 7) ^ ((lane >> 4) & 7))) * 2), ixo1 = (unsigned)(((lane >> 3) * 64 + 8 * ((lane & 7) ^ ((4 + (lane >> 4)) & 7))) * 2);
#define IX_STAGE(j0_) do { const char* _tb = (const char*)kic + (size_t)(j0_) * 128; _Pragma("unroll") for (int _i = 0; _i < 8; ++_i) \
        __builtin_amdgcn_global_load_lds((const unsigned*)(_tb + _i * 1024 + ((_i & 1) ? ixo1 : ixo0)), (LAS unsigned*)(stg + _i * 1024), 16, 0, 0); } while (0)
    if (nkeys > 0) IX_STAGE(0);
#pragma unroll 1
    for (int j0 = 0; j0 < nkeys; j0 += 64) {
        bf16x8 BA[4], BB[4];
        asm volatile("s_waitcnt vmcnt(0)" ::: "memory");
#pragma unroll
        for (int kk = 0; kk < 4; ++kk) { const int sw = (r >> 1) & 7;
            BA[kk] = *(LAS const bf16x8*)(stg + r * 128 + 16 * ((4 * h + kk) ^ sw));
            BB[kk] = *(LAS const bf16x8*)(stg + (32 + r) * 128 + 16 * ((4 * h + kk) ^ sw)); }
        asm volatile("s_waitcnt lgkmcnt(0)" ::: "memory");
        if (j0 + 64 < nkeys) IX_STAGE(j0 + 64);
        const int kidx = j0 + lane;
        f32x16 accA0, accB0, accA1, accB1;
#pragma unroll
        for (int i = 0; i < 16; ++i) { accA0[i] = 0.f; accB0[i] = 0.f; accA1[i] = 0.f; accB1[i] = 0.f; }
#pragma unroll
        for (int kk = 0; kk < 4; ++kk) { accA0 = mfma32(A[0][kk], BA[kk], accA0); accB0 = mfma32(A[0][kk], BB[kk], accB0); }
#pragma unroll
        for (int kk = 0; kk < 4; ++kk) { accA1 = mfma32(A[1][kk], BA[kk], accA1); accB1 = mfma32(A[1][kk], BB[kk], accB1); }
        float sc[2];
        { float pA = 0.f, pB = 0.f;
#pragma unroll
          for (int i = 0; i < 16; ++i) { const float wv = (i & 1) ? bfhi(wp[0][i >> 1]) : bflo(wp[0][i >> 1]);
              const float ta = __int_as_float(max(__float_as_int(accA0[i]), 0)), tb = __int_as_float(max(__float_as_int(accB0[i]), 0));
              pA = __builtin_fmaf(ta, wv, pA); pB = __builtin_fmaf(tb, wv, pB); }
          swap32f(pA, pB); sc[0] = pA + pB; }
        __builtin_amdgcn_sched_group_barrier(0x008, 8, 0);
#pragma unroll
        for (int i = 0; i < 8; ++i) { __builtin_amdgcn_sched_group_barrier(0x008, 1, 0); __builtin_amdgcn_sched_group_barrier(0x002, 9, 0); }
        { float pA = 0.f, pB = 0.f;
#pragma unroll
          for (int i = 0; i < 16; ++i) { const float wv = (i & 1) ? bfhi(wp[1][i >> 1]) : bflo(wp[1][i >> 1]);
              const float ta = __int_as_float(max(__float_as_int(accA1[i]), 0)), tb = __int_as_float(max(__float_as_int(accB1[i]), 0));
              pA = __builtin_fmaf(ta, wv, pA); pB = __builtin_fmaf(tb, wv, pB); }
          swap32f(pA, pB); sc[1] = pA + pB; }
#pragma unroll
        for (int q = 0; q < 2; ++q) {
            const float s = sc[q];
            const bool valid = kidx <= t0 + q;
            const u64 key = ((u64)sortable(s) << 14) | (u64)(unsigned)(16383 - kidx);
            const u64 tau = q ? tau1 : tau0;
            const bool pass = valid && key > tau && (pmode != 3);
            const u64 mask = __ballot(pass);
            if (mask) {
                LAS u64* buf = q ? buf1 : buf0; int& cnt = q ? cnt1 : cnt0;
                if (pass) buf[cnt + __popcll(mask & lt)] = key;
                cnt += __popcll(mask);
                if (cnt > 512 - 64) { lds_sync(); topk_prune(buf, cnt, q ? tau1 : tau0, hist, lane); }
            }
        }
    }
#undef IX_STAGE
    lds_sync();
    if (cnt0 > 256) topk_prune(buf0, cnt0, tau0, hist, lane);
    if (cnt1 > 256) topk_prune(buf1, cnt1, tau1, hist, lane);
    if (pmode == 2) { cnt0 = min(t0 + 1, 256); cnt1 = min(t0 + 2, 256);
#pragma unroll
        for (int i = 0; i < 4; ++i) { const int j = lane + 64 * i; buf0[j] = (u64)(unsigned)(16383 - ((j * 61) % (t0 + 1))); buf1[j] = (u64)(unsigned)(16383 - ((j * 59) % (t0 + 2))); } }
    if (lane == 0) { hist[0] = (unsigned)cnt0; hist[1] = (unsigned)cnt1; }
    lds_sync();
    }
    __builtin_amdgcn_s_setprio(0);
    if (pmode == 1 || pmode == 3) return;
    const int kq = lane >> 4, l16 = lane & 15;
    LAS float* plq = (LAS float*)wl;
    LAS unsigned short* idx2 = (LAS unsigned short*)(wl + 16384);
    LAS float* invl = (LAS float*)(wl + 17408);
    const int nsel0 = (int)hist[0], nsel1 = (int)hist[1];
    { unsigned iv0[4], iv1[4];
#pragma unroll
      for (int i = 0; i < 4; ++i) { const int j = lane + 64 * i; iv0[i] = (j < nsel0) ? (16383u - (unsigned)(buf0[j] & 0x3FFFull)) : 0u; iv1[i] = (j < nsel1) ? (16383u - (unsigned)(buf1[j] & 0x3FFFull)) : 0u; }
      lds_sync();
#pragma unroll
      for (int i = 0; i < 4; ++i) { const int j = lane + 64 * i; idx2[j] = (unsigned short)iv0[i]; idx2[256 + j] = (unsigned short)iv1[i]; }
      lds_sync(); }
    const unsigned char* KAp = (const unsigned char*)(C.ws + WS_KA) + 32 * kq;
    const float lsc = 1.f / (64.f * 512.f);
#pragma unroll 1
    for (int q = 0; q < 2; ++q) {
        const int t = t0 + q; const int nsel = q ? nsel1 : nsel0; LAS const unsigned short* idxs = idx2 + 256 * q;
        const bf16_t* prq = proj + (size_t)t * NP;
        lds_sync();
        {
            long Bz[4][4];
#pragma unroll
            for (int g = 0; g < 4; ++g)
#pragma unroll
                for (int sI = 0; sI < 4; ++sI) { long z = 0;
                    if ((l16 >> 2) == g) { const u32x4 raw = *(const u32x4*)(prq + P_QA + l16 * 128 + 32 * kq + 8 * sI);
                        int p0 = __builtin_amdgcn_cvt_pk_fp8_f32(bflo(raw.x) * 512.f, bfhi(raw.x) * 512.f, 0, false); p0 = __builtin_amdgcn_cvt_pk_fp8_f32(bflo(raw.y) * 512.f, bfhi(raw.y) * 512.f, p0, true);
                        int p1 = __builtin_amdgcn_cvt_pk_fp8_f32(bflo(raw.z) * 512.f, bfhi(raw.z) * 512.f, 0, false); p1 = __builtin_amdgcn_cvt_pk_fp8_f32(bflo(raw.w) * 512.f, bfhi(raw.w) * 512.f, p1, true);
                        z = (long)(((unsigned long long)(unsigned)p1 << 32) | (unsigned long long)(unsigned)p0); }
                    Bz[g][sI] = z; }
            u32x4 A0[2][2], A1[2][2];
            { const unsigned char* kr = KAp + (size_t)idxs[l16] * 512;
#pragma unroll
              for (int g = 0; g < 2; ++g) { A0[g][0] = *(const u32x4*)(kr + g * 128); A0[g][1] = *(const u32x4*)(kr + g * 128 + 16); } }
#pragma unroll 1
            for (int tile = 0; tile < 16; ++tile) {
                { const unsigned char* kr = KAp + (size_t)idxs[16 * tile + l16] * 512 + 256;
#pragma unroll
                  for (int g = 0; g < 2; ++g) { A1[g][0] = *(const u32x4*)(kr + g * 128); A1[g][1] = *(const u32x4*)(kr + g * 128 + 16); } }
                f32x4 acc = {0.f, 0.f, 0.f, 0.f};
#pragma unroll
                for (int g = 0; g < 2; ++g)
#pragma unroll
                    for (int sI = 0; sI < 4; ++sI) { const u32x4 v = A0[g][sI >> 1]; const long a = (sI & 1) ? (long)(((unsigned long long)v.w << 32) | v.z) : (long)(((unsigned long long)v.y << 32) | v.x);
                        acc = __builtin_amdgcn_mfma_f32_16x16x32_fp8_fp8(a, Bz[g][sI], acc, 0, 0, 0); }
                asm volatile("" ::: "memory");
                if (tile < 15) { const unsigned char* kr = KAp + (size_t)idxs[16 * (tile + 1) + l16] * 512;
#pragma unroll
                    for (int g = 0; g < 2; ++g) { A0[g][0] = *(const u32x4*)(kr + g * 128); A0[g][1] = *(const u32x4*)(kr + g * 128 + 16); } }
#pragma unroll
                for (int g = 0; g < 2; ++g)
#pragma unroll
                    for (int sI = 0; sI < 4; ++sI) { const u32x4 v = A1[g][sI >> 1]; const long a = (sI & 1) ? (long)(((unsigned long long)v.w << 32) | v.z) : (long)(((unsigned long long)v.y << 32) | v.x);
                        acc = __builtin_amdgcn_mfma_f32_16x16x32_fp8_fp8(a, Bz[2 + g][sI], acc, 0, 0, 0); }
#pragma unroll
                for (int r = 0; r < 4; ++r) { const int j = 16 * tile + 4 * kq + r; const int idx = (int)idxs[j]; const bool valid = j < nsel;
                    const int b = bkt[min(max(t - idx, 0), 2048)];
                    plq[j * 16 + l16] = valid ? (acc[r] * lsc + tbl[b * 32 + l16]) : -1e30f; }
            }
        }
        lds_sync();
        {
            float mx[16];
#pragma unroll
            for (int hh = 0; hh < 16; ++hh) mx[hh] = -1e30f;
#pragma unroll 1
            for (int ps = 0; ps < 4; ++ps) { const int j = ps * 64 + lane;
#pragma unroll
                for (int c4 = 0; c4 < 4; ++c4) { const f32x4 lv = *(LAS f32x4*)(plq + 16 * j + 4 * c4);
#pragma unroll
                    for (int e = 0; e < 4; ++e) mx[4 * c4 + e] = fmaxf(mx[4 * c4 + e], lv[e]); } }
#pragma unroll
            for (int hh = 0; hh < 16; ++hh) mx[hh] = wave_max(mx[hh]);
            float zs[16];
#pragma unroll
            for (int hh = 0; hh < 16; ++hh) zs[hh] = 0.f;
#pragma unroll 1
            for (int ps = 0; ps < 4; ++ps) { const int j = ps * 64 + lane; const bool valid = j < nsel;
#pragma unroll
                for (int c4 = 0; c4 < 4; ++c4) { f32x4 lv = *(LAS f32x4*)(plq + 16 * j + 4 * c4);
#pragma unroll
                    for (int e = 0; e < 4; ++e) { const float p = valid ? __expf(lv[e] - mx[4 * c4 + e]) : 0.f; lv[e] = __builtin_bit_cast(float, __builtin_amdgcn_cvt_pkrtz(p, p)); zs[4 * c4 + e] += p; }
                    *(LAS f32x4*)(plq + 16 * j + 4 * c4) = lv; } }
#pragma unroll
            for (int hh = 0; hh < 16; ++hh) { const float z = wave_sum(zs[hh]); if (lane == 0) invl[hh] = 1.f / fmaxf(z, 1e-30f); }
        }
        lds_sync();
#pragma unroll 1
        for (int g = 0; g < 4; ++g) {
            const f32x4 inv4 = *(LAS f32x4*)(invl + 4 * g);
            hx2_t o2[4][4];
#pragma unroll
            for (int rr = 0; rr < 4; ++rr)
#pragma unroll
                for (int d = 0; d < 4; ++d) o2[rr][d] = (hx2_t){(_Float16)0.f, (_Float16)0.f};
            const unsigned char* vbase = C.ws + WS_VA + (128 * g + 8 * l16) * 2;
            const int nb = (nsel + 63) >> 6;
            u32x4 vc[16], vn[16];
#pragma unroll
            for (int u = 0; u < 16; ++u) { const int idx = (int)idxs[4 * u + kq]; vc[u] = *(const u32x4*)(vbase + (size_t)idx * 1024); }
#pragma unroll 1
            for (int bb = 0; bb < nb; ++bb) {
                { const int bn = (bb + 1 < nb) ? bb + 1 : bb;
#pragma unroll
                    for (int u = 0; u < 16; ++u) { const int idx = (int)idxs[64 * bn + 4 * u + kq]; vn[u] = *(const u32x4*)(vbase + (size_t)idx * 1024); } }
#pragma unroll
                for (int u = 0; u < 16; ++u) { const u32x4 pw = *(LAS u32x4*)(plq + 16 * (64 * bb + 4 * u + kq) + 4 * g);
#pragma unroll
                    for (int rr = 0; rr < 4; ++rr) { const unsigned pwr = pw[rr]; const hx2_t pp = __builtin_bit_cast(hx2_t, pwr);
#pragma unroll
                        for (int d = 0; d < 4; ++d) { const unsigned vd = vc[u][d]; o2[rr][d] = pp * __builtin_bit_cast(hx2_t, vd) + o2[rr][d]; } } }
#pragma unroll
                for (int u = 0; u < 16; ++u) vc[u] = vn[u];
            }
            float o[4][8];
#pragma unroll
            for (int rr = 0; rr < 4; ++rr)
#pragma unroll
                for (int d = 0; d < 4; ++d) { o[rr][2 * d] = xsum16(xsum32((float)o2[rr][d].x)) * inv4[rr]; o[rr][2 * d + 1] = xsum16(xsum32((float)o2[rr][d].y)) * inv4[rr]; }
            if (kq == 0) {
#pragma unroll
                for (int rr = 0; rr < 4; ++rr) { int p0 = __builtin_amdgcn_cvt_pk_fp8_f32(o[rr][0] * 16.f, o[rr][1] * 16.f, 0, false); p0 = __builtin_amdgcn_cvt_pk_fp8_f32(o[rr][2] * 16.f, o[rr][3] * 16.f, p0, true);
                    int p1 = __builtin_amdgcn_cvt_pk_fp8_f32(o[rr][4] * 16.f, o[rr][5] * 16.f, 0, false); p1 = __builtin_amdgcn_cvt_pk_fp8_f32(o[rr][6] * 16.f, o[rr][7] * 16.f, p1, true);
                    *(u32x2*)(ya + (size_t)t * 2048 + (4 * g + rr) * 128 + 8 * l16) = (u32x2){(unsigned)p0, (unsigned)p1}; } }
        }
    }
}

constexpr int N2_KS = 0, N2_VS = 32768, N2_LUT = 65536, N2_IMP = 81920, N2_SEL = N2_IMP + 64 * 260 * 4, N2_UNI = N2_SEL + 2048, N2_LIST = N2_UNI + 64, N2_BKT = N2_LIST + 3 * 512, N2_TBL = N2_BKT + 2304, N2_END = N2_TBL + 4096;
static_assert(N2_END <= LDS_BYTES - 16, "NSA LDS map");
struct N2Src { const bf16_t* kbase; size_t kld; int krmax; const bf16_t* vT; size_t vld; };
__device__ __forceinline__ void n2_stage(const N2Src& s, int m, bool withV, LAS unsigned char* kbuf, LAS unsigned char* vbuf, int wave, int lane) {
#pragma unroll
    for (int j = 0; j < 2; ++j) { const int slot = (wave * 2 + j) * 64 + lane; const int row = slot >> 4, ch = (slot & 15) ^ (row & 15);
        __builtin_amdgcn_global_load_lds((const unsigned*)(s.kbase + (size_t)min(64 * m + row, s.krmax) * s.kld + 8 * ch), (LAS unsigned*)(kbuf + (wave * 2 + j) * 1024), 16, 0, 0); }
    if (withV) {
#pragma unroll
        for (int j = 0; j < 2; ++j) { const int slot = (wave * 2 + j) * 64 + lane; const int row = slot >> 3, ch = (slot & 7) ^ ((row >> 1) & 7);
            __builtin_amdgcn_global_load_lds((const unsigned*)(s.vT + (size_t)row * s.vld + 64 * m + 8 * ch), (LAS unsigned*)(vbuf + (wave * 2 + j) * 1024), 16, 0, 0); } }
}
__device__ __forceinline__ f32x16 n2_qk(const bf16x8 (&Bq)[8], LAS const unsigned char* kbuf, int hf, int rho, int h) {
    const int kr = 32 * hf + rho;
    f32x16 S;
#pragma unroll
    for (int i = 0; i < 16; ++i) S[i] = 0.f;
#pragma unroll
    for (int kk = 0; kk < 8; ++kk) { const int ch = 8 * h + kk; const bf16x8 a = *(LAS const bf16x8*)(kbuf + kr * 256 + 16 * (ch ^ (rho & 15))); S = mfma32(a, Bq[kk], S); }
    return S;
}
__device__ __forceinline__ void n2_pv(f32x16 (&O)[4], const float (&p)[16], LAS const unsigned char* vbuf, int hf, int lane) {
    bf16x8 pk[2];
#pragma unroll
    for (int s = 0; s < 2; ++s) { u32x4 w; w.x = cvt_pk_bf16(p[8 * s + 0], p[8 * s + 1]); w.y = cvt_pk_bf16(p[8 * s + 2], p[8 * s + 3]); w.z = cvt_pk_bf16(p[8 * s + 4], p[8 * s + 5]); w.w = cvt_pk_bf16(p[8 * s + 6], p[8 * s + 7]);
        pk[s] = __builtin_bit_cast(bf16x8, w); }
    const int r = lane & 31, h = lane >> 5;
#pragma unroll
    for (int dt = 0; dt < 4; ++dt)
#pragma unroll
        for (int s = 0; s < 2; ++s) { const int row = dt * 32 + r, ch = 4 * hf + 2 * s + h;
            const bf16x8 a = *(LAS const bf16x8*)(vbuf + row * 128 + 16 * (ch ^ ((r >> 1) & 7))); O[dt] = mfma32(a, pk[s], O[dt]); }
}
constexpr float N2_MASKED = -3.0e38f, N2_MINIT = -1.0e30f, LOG2E = 1.4426950408889634f;
template <int MODE, bool DEFER = false>
__device__ __forceinline__ float n2_bias_mask(f32x16& S, int posbase, int t, int t0w, int h, int ncv, int ncv0, unsigned sb, bool before_cur, float b31, LAS const bf16_t* lutr, LAS const unsigned char* bkt, LAS const float* tblh) {
    bool farT, fullT;
    if (MODE == 0) { farT = (t0w - (16 * (posbase + 31) + 31)) >= 1513; fullT = (posbase + 31) < ncv0; }
    else if (MODE == 1) { farT = (t0w - (posbase + 31)) >= 1513; fullT = before_cur; }
    else { farT = false; fullT = (posbase + 31 <= t0w) && ((t0w + 7 - posbase) < 512); }
    float cbu = b31;
    if (MODE != 0 && fullT && !farT) { const int b0 = (int)bkt[min(t0w - (posbase + 31), 2048)], b1 = (int)bkt[min(t0w + 7 - posbase, 2048)];
        if (b0 == b1) { farT = true; cbu = tblh[b0 * 32] * LOG2E; } }
    if (farT && fullT) {
        if (MODE == 1 && sb == 0u) {
#pragma unroll
            for (int reg = 0; reg < 16; ++reg) S[reg] = N2_MASKED;
            return 0.f; }
        if (DEFER) return cbu;
#pragma unroll
        for (int reg = 0; reg < 16; ++reg) S[reg] = S[reg] + cbu;
    } else {
#pragma unroll
        for (int reg = 0; reg < 16; ++reg) { const int pos = posbase + (reg & 7) + 8 * h + 16 * (reg >> 3);
            const int dist = (MODE == 0) ? (t - (16 * pos + 31)) : (t - pos);
            bool v;
            if (MODE == 0) v = pos < ncv; else if (MODE == 1) v = (sb != 0u) && (pos <= t); else v = (pos <= t) && (dist < 512);
            const float bias = bf2f(lutr[min(max(dist, 0), 2047)]);
            S[reg] = v ? (S[reg] + bias) : N2_MASKED; }
    }
    return 0.f;
}
__device__ __forceinline__ float n2_tilemax(const f32x16& S) {
    float a = fmax_fast(S[0], S[1]), b = fmax_fast(S[2], S[3]), c = fmax_fast(S[4], S[5]), d = fmax_fast(S[6], S[7]);
    float e = fmax_fast(S[8], S[9]), f = fmax_fast(S[10], S[11]), g = fmax_fast(S[12], S[13]), hh = fmax_fast(S[14], S[15]);
    a = fmax_fast(a, b); c = fmax_fast(c, d); e = fmax_fast(e, f); g = fmax_fast(g, hh); a = fmax_fast(a, c); e = fmax_fast(e, g); return fmax_fast(a, e);
}
__device__ __forceinline__ void n2_stat(const f32x16& S, float& m, float& Z) {
    const float mn = fmax_fast(m, n2_tilemax(S));
    float z = 0.f;
#pragma unroll
    for (int i = 0; i < 16; ++i) z += __builtin_amdgcn_exp2f(S[i] - mn);
    Z = Z * __builtin_amdgcn_exp2f(m - mn) + z; m = mn;
}
__device__ __forceinline__ void n2_combine(float& m, float& Z) {
    float ma = m, mb = m; swap32f(ma, mb); const float M = fmax_fast(ma, mb);
    Z = xsum32(Z * __builtin_amdgcn_exp2f(m - M)); m = M;
}
enum { N2_STATS = 0, N2_IMPP = 1, N2_PV = 2, N2_ONLINE = 3, N2_IMPV = 4 };
struct N2Lane { int t, t0w, h, rho, qq, rr, lane, ncv, ncv0, ncv7, cur; float b31; LAS const bf16_t* lutr; LAS const unsigned char* bkt; LAS const float* tblh; };
template <int MODE, int PASS>
__device__ __forceinline__ void n2_branch(const Ctx& C, int g, LAS const unsigned short* list, int n, const N2Lane& L, const bf16x8 (&Bq)[8], f32x16 (&O)[4],
                                          float& m, float& Z, float scale, LAS const unsigned* selq, LAS float* impw, float scale2 = 1.f) {
    if (n <= 0) return;
    constexpr bool withV = (PASS == N2_PV || PASS == N2_ONLINE || PASS == N2_IMPV);
    constexpr int NSL = (PASS == N2_IMPV) ? 2 : 4, LA = NSL - 1;
    N2Src src;
    if (MODE == 0) { src.kbase = (const bf16_t*)(C.ws + WS_KCMP) + (size_t)g * 1024 * 128; src.kld = 128; src.krmax = 1023; src.vT = (const bf16_t*)(C.ws + WS_VCMPT) + (size_t)g * 128 * 1024; src.vld = 1024; }
    else if (MODE == 1) { src.kbase = (const bf16_t*)(C.ws + WS_KSC) + (size_t)g * T * 128; src.kld = 128; src.krmax = T - 1; src.vT = (const bf16_t*)(C.ws + WS_VST) + (size_t)g * 128 * T; src.vld = (size_t)T; }
    else { src.kbase = (const bf16_t*)(C.ws + WS_KWC) + (size_t)g * T * 128; src.kld = 128; src.krmax = T - 1; src.vT = (const bf16_t*)(C.ws + WS_VWT) + (size_t)g * 128 * T; src.vld = (size_t)T; }
    LAS unsigned char* lds = C.lds;
#define N2_KSLOT(s_) (withV ? (((s_) < 2) ? (N2_KS + (s_) * 16384) : (N2_IMP + ((s_) - 2) * 32768)) : (N2_KS + (s_) * 16384))
#define N2_VSLOT(s_) (((s_) < 2) ? (N2_VS + (s_) * 16384) : (N2_IMP + ((s_) - 2) * 32768 + 16384))
#define N2_RAW_BARRIER() do { asm volatile("s_waitcnt lgkmcnt(0)" ::: "memory"); __builtin_amdgcn_s_barrier(); asm volatile("" ::: "memory"); } while (0)
#define N2_WAIT_LANDED() do { if (LA == 1) asm volatile("s_waitcnt vmcnt(0)" ::: "memory"); else if (withV) asm volatile("s_waitcnt vmcnt(8)" ::: "memory"); else asm volatile("s_waitcnt vmcnt(4)" ::: "memory"); } while (0)
#pragma unroll
    for (int j = 0; j < LA; ++j) if (j < n) n2_stage(src, (int)list[j], withV, lds + N2_KSLOT(j), lds + N2_VSLOT(j), C.wave, C.lane);
    if (n >= LA) N2_WAIT_LANDED(); else asm volatile("s_waitcnt vmcnt(0)" ::: "memory");
    N2_RAW_BARRIER();
#pragma unroll 1
    for (int i = 0; i < n; ++i) {
        const int mb = (int)list[i];
        if (i + LA < n) { const int sl = (i + LA) & (NSL - 1); n2_stage(src, (int)list[i + LA], withV, lds + N2_KSLOT(sl), lds + N2_VSLOT(sl), C.wave, C.lane); }
        LAS const unsigned char* kbuf = lds + N2_KSLOT(i & (NSL - 1)); LAS const unsigned char* vbuf = lds + N2_VSLOT(i & (NSL - 1));
        bool need; unsigned sb = 1u;
        if (MODE == 0) need = (64 * mb) < L.ncv7;
        else if (MODE == 1) { const unsigned sw = selq[mb >> 5]; sb = (sw >> (mb & 31)) & 1u; need = __ballot(sb != 0u) != 0ull; }
        else need = (64 * mb + 63 >= L.t0w - 511) && (64 * mb <= L.t0w + 7);
        if (need && PASS == N2_ONLINE) {
            f32x16 S0 = n2_qk(Bq, kbuf, 0, L.rho, L.h), S1 = n2_qk(Bq, kbuf, 1, L.rho, L.h);
            const float cb0 = n2_bias_mask<MODE, true>(S0, 64 * mb, L.t, L.t0w, L.h, L.ncv, L.ncv0, sb, mb < L.cur, L.b31, L.lutr, L.bkt, L.tblh);
            const float cb1 = n2_bias_mask<MODE, true>(S1, 64 * mb + 32, L.t, L.t0w, L.h, L.ncv, L.ncv0, sb, mb < L.cur, L.b31, L.lutr, L.bkt, L.tblh);
            const float tm = xmax32(fmax_fast(n2_tilemax(S0) + cb0, n2_tilemax(S1) + cb1));
            const float mn = fmax_fast(m, tm);
            if (__ballot(mn > m + 8.f)) { const float al = __builtin_amdgcn_exp2f(m - mn); Z *= al;
#pragma unroll
                for (int dt = 0; dt < 4; ++dt)
#pragma unroll
                    for (int r = 0; r < 16; ++r) O[dt][r] *= al;
                m = mn; }
            { float p[16]; float zs = 0.f; const float c2 = cb0 - m;
#pragma unroll
              for (int r = 0; r < 16; ++r) { p[r] = __builtin_amdgcn_exp2f(S0[r] + c2); zs += p[r]; }
              Z += zs; n2_pv(O, p, vbuf, 0, L.lane); }
            { float p[16]; float zs = 0.f; const float c2 = cb1 - m;
#pragma unroll
              for (int r = 0; r < 16; ++r) { p[r] = __builtin_amdgcn_exp2f(S1[r] + c2); zs += p[r]; }
              Z += zs; n2_pv(O, p, vbuf, 1, L.lane); }
        } else if (need) {
#pragma unroll 1
            for (int hf = 0; hf < 2; ++hf) {
                const int posbase = 64 * mb + 32 * hf;
                f32x16 S = n2_qk(Bq, kbuf, hf, L.rho, L.h);
                const float cbd = n2_bias_mask<MODE, PASS == N2_ONLINE>(S, posbase, L.t, L.t0w, L.h, L.ncv, L.ncv0, sb, mb < L.cur, L.b31, L.lutr, L.bkt, L.tblh);
                if (PASS == N2_STATS) { n2_stat(S, m, Z); }
                else if (PASS == N2_IMPP || PASS == N2_IMPV) {
                    float p[16];
#pragma unroll
                    for (int r = 0; r < 16; ++r) p[r] = __builtin_amdgcn_exp2f(S[r] - m) * scale;
#pragma unroll
                    for (int G = 0; G < 4; ++G) { float q4 = p[4 * G] + p[4 * G + 1] + p[4 * G + 2] + p[4 * G + 3], e = p[4 * G + 3];
                        q4 += dppf<0xB1>(q4); q4 += dppf<0x4E>(q4); e += dppf<0xB1>(e); e += dppf<0x4E>(e);
                        const int nb = posbase + ((4 * G) & 7) + 8 * L.h + 16 * ((4 * G) >> 3); const int mq = nb >> 2;
                        if (L.rr == 0) { __hip_atomic_fetch_add(impw + L.qq * 260 + mq, q4, __ATOMIC_RELAXED, __HIP_MEMORY_SCOPE_WORKGROUP);
                                         __hip_atomic_fetch_add(impw + L.qq * 260 + mq + 1, e, __ATOMIC_RELAXED, __HIP_MEMORY_SCOPE_WORKGROUP); } }
                    if (PASS == N2_IMPV) {
#pragma unroll
                        for (int r = 0; r < 16; ++r) p[r] *= scale2;
                        n2_pv(O, p, vbuf, hf, L.lane); }
                } else if (PASS == N2_PV) {
                    float p[16];
#pragma unroll
                    for (int r = 0; r < 16; ++r) p[r] = __builtin_amdgcn_exp2f(S[r] - m) * scale;
                    n2_pv(O, p, vbuf, hf, L.lane);
                } else {
                    const float tm = xmax32(n2_tilemax(S) + cbd);
                    const float mn = fmax_fast(m, tm);
                    if (__ballot(mn > m + 8.f)) { const float al = __builtin_amdgcn_exp2f(m - mn); Z *= al;
#pragma unroll
                        for (int dt = 0; dt < 4; ++dt)
#pragma unroll
                            for (int r = 0; r < 16; ++r) O[dt][r] *= al;
                        m = mn; }
                    float p[16]; float zs = 0.f;
                    const float c2 = cbd - m;
#pragma unroll
                    for (int r = 0; r < 16; ++r) { p[r] = __builtin_amdgcn_exp2f(S[r] + c2); zs += p[r]; }
                    Z += zs;
                    n2_pv(O, p, vbuf, hf, L.lane);
                }
            }
        }
        if (i + LA < n) N2_WAIT_LANDED(); else asm volatile("s_waitcnt vmcnt(0)" ::: "memory");
        N2_RAW_BARRIER();
    }
#undef N2_WAIT_LANDED
#undef N2_RAW_BARRIER
#undef N2_KSLOT
#undef N2_VSLOT
}

__device__ __forceinline__ void nsa2_item(const Ctx& C, int QB, int g) {
    LAS unsigned char* lds = C.lds;
    const int tid = C.tid, lane = C.lane, wave = C.wave;
    const int c = lane & 31, h = lane >> 5, qq = c >> 2, rr = c & 3;
    const int t0 = 64 * QB, t0w = t0 + 8 * wave, t = t0w + qq, head = 4 * g + rr;
    const bf16_t* proj = (const bf16_t*)(C.ws + WS_PROJ);
    LAS bf16_t* lut = (LAS bf16_t*)(lds + N2_LUT);
    LAS float* imp = (LAS float*)(lds + N2_IMP);
    LAS unsigned* selw = (LAS unsigned*)(lds + N2_SEL);
    LAS unsigned* uni = (LAS unsigned*)(lds + N2_UNI);
    LAS unsigned short* listC = (LAS unsigned short*)(lds + N2_LIST); LAS unsigned short* listS = listC + 256; LAS unsigned short* listW = listC + 512;
    LAS const unsigned char* bkt = lds + N2_BKT; LAS const float* tbl = (LAS const float*)(lds + N2_TBL);
    __syncthreads();
    for (int i = tid; i < 8192; i += NTHREADS) { const int r4 = i >> 11, d = i & 2047; lut[i] = f2bf(tbl[(int)bkt[d] * 32 + 16 + 4 * g + r4] * LOG2E); }
    for (int i = tid; i < 64 * 260; i += NTHREADS) imp[i] = 0.f;
    const int ncv_wg = (t0 + 63 >= 31) ? ((t0 + 63 - 31) >> 4) + 1 : 0; const int nC = (ncv_wg + 63) >> 6;
    const int wlo = max(t0 - 511, 0) >> 6; const int nW = QB - wlo + 1;
    if (tid < nC) listC[tid] = (unsigned short)tid;
    if (tid < nW) listW[tid] = (unsigned short)(wlo + tid);
    bf16x8 Bq[8];
#pragma unroll
    for (int kk = 0; kk < 8; ++kk) Bq[kk] = *(const bf16x8*)(proj + (size_t)t * NP + P_QB + 128 * head + 64 * h + 8 * kk);
    const float g0 = sigmoidf_(bf2f(proj[(size_t)t * NP + P_GB + 3 * head + 0]));
    const float g1 = sigmoidf_(bf2f(proj[(size_t)t * NP + P_GB + 3 * head + 1]));
    const float g2 = sigmoidf_(bf2f(proj[(size_t)t * NP + P_GB + 3 * head + 2]));
    f32x16 O[4];
#pragma unroll
    for (int dt = 0; dt < 4; ++dt)
#pragma unroll
        for (int i = 0; i < 16; ++i) O[dt][i] = 0.f;
    N2Lane L; L.t = t; L.t0w = t0w; L.h = h; L.rho = swap23(c); L.qq = qq; L.rr = rr; L.lane = lane;
    L.ncv = t >= 31 ? ((t - 31) >> 4) + 1 : 0; L.ncv0 = t0w >= 31 ? ((t0w - 31) >> 4) + 1 : 0; L.ncv7 = (t0w + 7 >= 31) ? ((t0w + 7 - 31) >> 4) + 1 : 0; L.cur = QB;
    L.b31 = tbl[31 * 32 + 16 + head] * LOG2E; L.lutr = lut + rr * 2048; L.bkt = bkt; L.tblh = tbl + 16 + head;
    LAS const unsigned* selq = selw + (wave * 8 + qq) * 8;
    LAS float* impw = imp + wave * 8 * 260;
    __syncthreads();
    float mC = N2_MINIT, ZC = 0.f;
    n2_branch<0, N2_STATS>(C, g, listC, nC, L, Bq, O, mC, ZC, 0.f, selq, impw);
    n2_combine(mC, ZC);
    const float invZC = 1.f / fmaxf(ZC, 1e-30f);
    n2_branch<0, N2_IMPV>(C, g, listC, nC, L, Bq, O, mC, ZC, invZC, selq, impw, g0);
#define N2_OACC() ({ unsigned to_ = (unsigned)tid; asm volatile("" : "+v"(to_)); (f32x4*)(C.ws + WS_OACC) + (size_t)blockIdx.x * 16 * 512 + to_; })
    f32x4* oacc = N2_OACC();
#pragma unroll
    for (int dt = 0; dt < 4; ++dt)
#pragma unroll
        for (int G = 0; G < 4; ++G) { oacc[(dt * 4 + G) * 512] = (f32x4){O[dt][4 * G], O[dt][4 * G + 1], O[dt][4 * G + 2], O[dt][4 * G + 3]}; O[dt][4 * G] = 0.f; O[dt][4 * G + 1] = 0.f; O[dt][4 * G + 2] = 0.f; O[dt][4 * G + 3] = 0.f; }
    lds_sync();
#pragma unroll 1
    for (int q8 = 0; q8 < 8; ++q8) {
        const int cur = QB;
        unsigned word = 0u;
        if (cur + 1 <= 16) { if (lane == 0) word = (1u << (cur + 1)) - 1u; }
        else {
            unsigned key[4];
#pragma unroll
            for (int i = 0; i < 4; ++i) { const int mblk = lane + 64 * i; const bool ok = mblk >= 1 && mblk <= cur - 2;
                key[i] = ok ? ((__float_as_uint(impw[q8 * 260 + mblk]) & 0xFFFFFF00u) | (unsigned)(255 - mblk)) : 0u; }
#pragma unroll 1
            for (int round = 0; round < 13; ++round) {
                unsigned lm = key[0] > key[1] ? key[0] : key[1]; const unsigned lm2 = key[2] > key[3] ? key[2] : key[3]; lm = lm > lm2 ? lm : lm2;
                const unsigned W = wave_maxu(lm);
#pragma unroll
                for (int i = 0; i < 4; ++i) if (key[i] == W) key[i] = 0u;
                const int mw = 255 - (int)(W & 0xFFu);
                if (W != 0u && lane == (mw >> 5)) word |= 1u << (mw & 31);
            }
            if (lane == 0) word |= 1u;
            if (lane == (cur >> 5)) word |= 1u << (cur & 31);
            if (lane == ((cur - 1) >> 5)) word |= 1u << ((cur - 1) & 31);
        }
        if (lane < 8) selw[(wave * 8 + q8) * 8 + lane] = word;
    }
    __syncthreads();
    if (tid < 8) { unsigned u = 0u; for (int q = 0; q < 64; ++q) u |= selw[q * 8 + tid]; uni[tid] = u; }
    __syncthreads();
    if (tid == 0) { int n = 0; for (int mblk = 0; mblk <= QB; ++mblk) if ((uni[mblk >> 5] >> (mblk & 31)) & 1u) listS[n++] = (unsigned short)mblk; uni[8] = (unsigned)n; }
    __syncthreads();
    const int nS = (int)uni[8];
    float mS = N2_MINIT, ZS = 0.f;
    n2_branch<1, N2_ONLINE>(C, g, listS, nS, L, Bq, O, mS, ZS, 0.f, selq, impw);
    { ZS = xsum32(ZS); const float sc = g1 / fmaxf(ZS, 1e-30f);
#pragma unroll
      for (int dt = 0; dt < 4; ++dt)
#pragma unroll
          for (int r = 0; r < 16; ++r) O[dt][r] *= sc; }
    oacc = N2_OACC();
#pragma unroll
    for (int dt = 0; dt < 4; ++dt)
#pragma unroll
        for (int G = 0; G < 4; ++G) { const f32x4 a = oacc[(dt * 4 + G) * 512];
            oacc[(dt * 4 + G) * 512] = (f32x4){O[dt][4 * G] + a[0], O[dt][4 * G + 1] + a[1], O[dt][4 * G + 2] + a[2], O[dt][4 * G + 3] + a[3]};
            O[dt][4 * G] = 0.f; O[dt][4 * G + 1] = 0.f; O[dt][4 * G + 2] = 0.f; O[dt][4 * G + 3] = 0.f; }
    float mW = N2_MINIT, ZW = 0.f;
    n2_branch<2, N2_ONLINE>(C, g, listW, nW, L, Bq, O, mW, ZW, 0.f, selq, impw);
    oacc = N2_OACC();
    { ZW = xsum32(ZW); const float sc = g2 / fmaxf(ZW, 1e-30f);
#pragma unroll
      for (int dt = 0; dt < 4; ++dt)
#pragma unroll
          for (int G = 0; G < 4; ++G) { const f32x4 a = oacc[(dt * 4 + G) * 512];
              O[dt][4 * G] = O[dt][4 * G] * sc + a[0]; O[dt][4 * G + 1] = O[dt][4 * G + 1] * sc + a[1]; O[dt][4 * G + 2] = O[dt][4 * G + 2] * sc + a[2]; O[dt][4 * G + 3] = O[dt][4 * G + 3] * sc + a[3]; } }
    unsigned char* yb = C.ws + WS_YB + (size_t)t * 2048 + head * 128;
#pragma unroll
    for (int dt = 0; dt < 4; ++dt)
#pragma unroll
        for (int G = 0; G < 4; ++G) { int p = __builtin_amdgcn_cvt_pk_fp8_f32(O[dt][4 * G] * 16.f, O[dt][4 * G + 1] * 16.f, 0, false); p = __builtin_amdgcn_cvt_pk_fp8_f32(O[dt][4 * G + 2] * 16.f, O[dt][4 * G + 3] * 16.f, p, true);
            *(unsigned*)(yb + dt * 32 + 8 * G + 4 * h) = (unsigned)p; }
}

#ifndef NREP_DSA
#define NREP_DSA 1
#endif
#ifndef NREP_NSA
#define NREP_NSA 1
#endif
__device__ __forceinline__ void p6_mixers(const Ctx& C, int which  , int crep = 0) {
    const Ctx& C0_ = C;
    unsigned* counter = (unsigned*)(C.ws + WS_CTL + CTL_CNT) + 128 * crep;
    static_assert(8 * P6_WAVE_LDS <= N2_BKT, "DSA per-wave LDS vs the shared bias tables");
    LAS unsigned char* bkt = C.lds + N2_BKT; LAS float* tbl = (LAS float*)(C.lds + N2_TBL);
    for (int d = C.tid; d <= 2048; d += NTHREADS) { int b;
        if (d < 16) b = d; else { b = 16 + (int)(logf((float)d / 16.f) / logf(128.f) * 16.f); b = b < 31 ? b : 31; }
        bkt[d] = (unsigned char)b; }
    for (int i = C.tid; i < 1024; i += NTHREADS) tbl[i] = C.in[I_RELB][i];
    __syncthreads();
    if (which != 1) {
        LAS int* slot = (LAS int*)(C.lds + N2_UNI + 48);
#pragma unroll 1
        for (int rep = 0; rep < NREP_NSA; ++rep)
        for (;;) {
            __syncthreads();
            if (C.tid == 0) *slot = (int)atomicAdd(counter + 64 + 128 * rep, 1u);
            __syncthreads();
            const int it = *slot;
            if (it >= 1024) break;
            nsa2_item(C, 255 - (it >> 2), it & 3);
#pragma unroll 1
            for (int c = 0; c < 3; ++c) { const int j = it + 1024 * c; if (j >= 2560) break;
                __syncthreads();
                Ctx C = C0_; { int t_ = threadIdx.x; asm volatile("" : "+v"(t_)); C.tid = t_; C.lane = t_ & 63; C.wave = __builtin_amdgcn_readfirstlane(t_ >> 6); }
                if (j < 512) tconv_tile_f8<false>(C, C.in[I_WBA], 4096, C.ws + WS_WBA, 2048, (j / 16) * 128, (j % 16) * 128);
                else if (j < 1024) { const int i = j - 512; tconv_tile_f8<false>(C, C.in[I_WBB], 4096, C.ws + WS_WBB, 2048, (i / 16) * 128, (i % 16) * 128); }
                else if (j < 2048) { const int i = j - 1024; tconv_tile_f8<false>(C, C.in[I_WOUT], 4096, C.ws + WS_WOUT, 4096, (i / 32) * 128, (i % 32) * 128); }
                else { const int i = j - 2048; wq_subkey_tile(C, i >> 5, (i & 31) * 128); } }
        }
        __syncthreads();
    }
    if (which != 2) {
        LAS unsigned char* wl = C.lds + C.wave * P6_WAVE_LDS;
#pragma unroll 1
        for (int rep = 0; rep < NREP_DSA; ++rep)
        for (;;) {
            int it = 0;
            if (C.lane == 0) it = (int)atomicAdd(counter + 128 * rep, 1u);
            it = __builtin_amdgcn_readfirstlane(it);
            if (it >= 8192) break;
            if (C.wave >= 4) __builtin_amdgcn_s_setprio(2);
            dsa_item(C, 8191 - it, wl, bkt, tbl, (rep < NREP_DSA - 1) ? DSA_PROBE_MODE : 0);
#pragma unroll 1
            for (int rr = 0; rr < 4; ++rr) peer_row_convert(C, 4 * it + rr, C.lane);
        }
        __builtin_amdgcn_s_setprio(0);
        __syncthreads();
    }
}

static __device__ const unsigned P12_IJ4[16] = {
    0xE0331000u, 0xF0401101u, 0xFF411202u, 0xFF421303u, 0xFF501404u, 0xFF511505u, 0xFF601606u, 0xFF611707u, 0xFF702008u, 0xFF712109u, 0xFF80220Au, 0xFF90230Bu, 0xFFA0240Cu, 0xFFB0300Du, 0xFFC0310Eu, 0xFFD0320Fu };
typedef __bf16 bf16x32_t __attribute__((ext_vector_type(32)));
typedef unsigned u32x16 __attribute__((ext_vector_type(16)));
typedef _Float16 h2_t __attribute__((ext_vector_type(2)));
typedef _Float16 h32_t __attribute__((ext_vector_type(32)));
__device__ __forceinline__ unsigned rowmax_u(unsigned v) { v = umaxu(v, dppu<0xB1>(v)); v = umaxu(v, dppu<0x4E>(v)); v = umaxu(v, dppu<0x141>(v)); v = umaxu(v, dppu<0x140>(v)); return v; }
__device__ __forceinline__ float rowmax_f(float v) { v = fmax_fast(v, dppf<0xB1>(v)); v = fmax_fast(v, dppf<0x4E>(v)); v = fmax_fast(v, dppf<0x141>(v)); v = fmax_fast(v, dppf<0x140>(v)); return v; }
__device__ __forceinline__ float rowsum_f(float v) { v += dppf<0xB1>(v); v += dppf<0x4E>(v); v += dppf<0x141>(v); v += dppf<0x140>(v); return v; }
#define P12_CE(a_, b_) do { const unsigned hi_ = umaxu(a_, b_), lo_ = (a_) < (b_) ? (a_) : (b_); a_ = hi_; b_ = lo_; } while (0)
__device__ __forceinline__ void p12_route(const bf16_t* srow, LAS float* tops, LAS int* topi, LAS unsigned short* exl, LAS float* gtl, int lane, unsigned ij4) {
    const int row = lane >> 4, l16 = lane & 15;
#pragma unroll 1
    for (int q = 0; q < 4; ++q) {
        const int p = 4 * q + row;
        const u32x4 raw = *(const u32x4*)(srow + p * 128 + 8 * l16);
        unsigned k[8];
#pragma unroll
        for (int e = 0; e < 8; ++e) { const unsigned bits = (e & 1) ? (raw[e >> 1] & 0xFFFF0000u) : (raw[e >> 1] << 16);
            k[e] = ((bits ^ ((bits >> 31) ? 0xFFFFFFFFu : 0x80000000u)) & 0xFFFFFF80u) | (unsigned)(127 - (8 * l16 + e)); }
        P12_CE(k[0], k[2]); P12_CE(k[1], k[3]); P12_CE(k[4], k[6]); P12_CE(k[5], k[7]);
        P12_CE(k[0], k[4]); P12_CE(k[1], k[5]); P12_CE(k[2], k[6]); P12_CE(k[3], k[7]);
        P12_CE(k[0], k[1]); P12_CE(k[2], k[3]); P12_CE(k[4], k[5]); P12_CE(k[6], k[7]);
        P12_CE(k[2], k[4]); P12_CE(k[3], k[5]);
        P12_CE(k[1], k[4]); P12_CE(k[3], k[6]);
        P12_CE(k[1], k[2]); P12_CE(k[3], k[4]); P12_CE(k[5], k[6]);
        unsigned myW = 0u;
#pragma unroll
        for (int r = 0; r < 16; ++r) {
            const unsigned W = rowmax_u(k[0]);
            const bool pop = k[0] == W;
#pragma unroll
            for (int e = 0; e < 7; ++e) k[e] = pop ? k[e + 1] : k[e];
            k[7] = pop ? 0u : k[7];
            myW = (l16 == r) ? W : myW;
        }
        const unsigned sb = myW & 0xFFFFFF80u;
        const unsigned bits = (sb & 0x80000000u) ? (sb ^ 0x80000000u) : ((~sb) & 0xFFFF0000u);
        tops[p * 16 + l16] = __uint_as_float(bits); topi[p * 16 + l16] = 127 - (int)(myW & 0x7Fu);
    }
    lds_sync();
#pragma unroll 1
    for (int q2 = 0; q2 < 2; ++q2) {
        const int hh = 4 * q2 + row;
        LAS const float* t1 = tops + (2 * hh) * 16; LAS const float* t2 = t1 + 16;
        unsigned k[4];
#pragma unroll
        for (int c = 0; c < 4; ++c) { const unsigned ij = (ij4 >> (8 * c)) & 0xFFu; const float cv = t1[ij >> 4] + t2[ij & 15u];
            k[c] = (ij != 0xFFu) ? ((sortable(cv) & 0xFFFFFF00u) | (255u - ij)) : 0u; }
        P12_CE(k[0], k[1]); P12_CE(k[2], k[3]); P12_CE(k[0], k[2]); P12_CE(k[1], k[3]); P12_CE(k[1], k[2]);
        unsigned myW = 0u;
#pragma unroll
        for (int r = 0; r < 16; ++r) {
            const unsigned W = rowmax_u(k[0]);
            const bool pop = k[0] == W;
            k[0] = pop ? k[1] : k[0]; k[1] = pop ? k[2] : k[1]; k[2] = pop ? k[3] : k[2]; k[3] = pop ? 0u : k[3];
            myW = (l16 == r) ? W : myW;
        }
        const unsigned flat = 255u - (myW & 0xFFu); const int ci = (int)(flat >> 4), cj = (int)(flat & 15u);
        const float cv = t1[ci] + t2[cj];
        const float ev = __expf(cv - rowmax_f(cv));
        const float es = rowsum_f(ev);
        exl[hh * 16 + l16] = (unsigned short)(topi[(2 * hh) * 16 + ci] * 128 + topi[(2 * hh + 1) * 16 + cj]);
        gtl[hh * 16 + l16] = ev * __builtin_amdgcn_rcpf(es);
    }
    lds_sync();
}
#undef P12_CE
__device__ __forceinline__ float gelu_fast(float x) { const float u = 0.7978845608028654f * (x + 0.044715f * x * x * x); const float e = __expf(2.f * u); return x - x * __builtin_amdgcn_rcpf(e + 1.f); }

#ifndef P12_HI
#define P12_HI 4
#endif
__device__ __forceinline__ void p12_peer(const Ctx& C, float* dst) {
    const bf16_t* pq = (const bf16_t*)(C.ws + WS_PQ);
    const bf16_t* h2 = (const bf16_t*)(C.ws + WS_H2);
    const float* gt2 = (const float*)(C.ws + WS_MOD) + 5 * D;
    const int lane = C.lane;
    LAS unsigned char* wl = C.lds + C.wave * 8192;
    LAS unsigned short* exl = (LAS unsigned short*)wl;
    LAS float* gtl = (LAS float*)(wl + 2048);
    LAS float* tops = (LAS float*)(wl + 6144);
    LAS int* topi = (LAS int*)(wl + 7168);
    const unsigned ij4 = P12_IJ4[lane & 15];
    const unsigned lo16 = 16u * (unsigned)lane; const unsigned char* pu6 = C.ws + WS_PU; const unsigned char* pv6 = C.ws + WS_PV;
    const float* su = (const float*)(C.ws + WS_PU + 96 * MB); const float* sv = (const float*)(C.ws + WS_PV + 96 * MB);
    const unsigned char* pu4 = C.ws + WS_PU4; const unsigned char* pv4 = C.ws + WS_PV4;
    const int tstride = gridDim.x * 8;
    for (int tb = blockIdx.x * 8 + C.wave; tb < T; tb += 8 * tstride) {
        int nb = 0;
#pragma unroll 1
        for (int s = 0; s < 8; ++s) { if (tb + s * tstride >= T) break; ++nb; }
        p12_route(pq + (size_t)tb * 2048, tops, topi, exl, gtl, lane, ij4);
        const int nflat = nb * 128;
        u32x4 UA[3], VA[3], UB[3], VB[3], UC[3], VC[3], UD[3], VD[3]; float suA, svA, suB, svB, suC, svC, suD, svD;
#define P12_FMT(idx_) ((((idx_) & 15) < P12_HI) ? 6 : 4)
#define P12_LOAD(S, idx_, fmt_) do { const int e_ = __builtin_amdgcn_readfirstlane((int)exl[(idx_) < nflat ? (idx_) : nflat - 1]); \
        if ((fmt_) == 6) { const unsigned char* pu_ = pu6 + (size_t)e_ * 3072 + lo16; const unsigned char* pv_ = pv6 + (size_t)e_ * 3072 + lo16; \
            U##S[0] = *(const u32x4*)pu_; U##S[1] = *(const u32x4*)(pu_ + 1024); U##S[2] = *(const u32x4*)(pu_ + 2048); \
            V##S[0] = *(const u32x4*)pv_; V##S[1] = *(const u32x4*)(pv_ + 1024); V##S[2] = *(const u32x4*)(pv_ + 2048); su##S = su[e_]; sv##S = sv[e_]; } \
        else { const unsigned char* pu_ = pu4 + (size_t)e_ * 2176; const unsigned char* pv_ = pv4 + (size_t)e_ * 2176; \
            U##S[0] = *(const u32x4*)(pu_ + lo16); U##S[1] = *(const u32x4*)(pu_ + 1024 + lo16); su##S = bf2f(*(const bf16_t*)(pu_ + 2048 + 2 * lane)); \
            V##S[0] = *(const u32x4*)(pv_ + lo16); V##S[1] = *(const u32x4*)(pv_ + 1024 + lo16); sv##S = bf2f(*(const bf16_t*)(pv_ + 2048 + 2 * lane)); } } while (0)
#define P12_U4(w_, hh_, j_) do { \
        a0_ = dot2bf(__builtin_bit_cast(unsigned, __builtin_amdgcn_cvt_scalef32_pk_bf16_fp4((w_), 1.0f, 0)), hh_[(j_)], a0_); a1_ = dot2bf(__builtin_bit_cast(unsigned, __builtin_amdgcn_cvt_scalef32_pk_bf16_fp4((w_), 1.0f, 1)), hh_[(j_) + 1], a1_); \
        a2_ = dot2bf(__builtin_bit_cast(unsigned, __builtin_amdgcn_cvt_scalef32_pk_bf16_fp4((w_), 1.0f, 2)), hh_[(j_) + 2], a2_); a3_ = dot2bf(__builtin_bit_cast(unsigned, __builtin_amdgcn_cvt_scalef32_pk_bf16_fp4((w_), 1.0f, 3)), hh_[(j_) + 3], a3_); } while (0)
#define P12_V4(w_, oo_, j_) do { \
        oo_[(j_)] = act2_ * __builtin_amdgcn_cvt_scalef32_pk_f16_fp4((w_), 1.0f, 0) + oo_[(j_)]; oo_[(j_) + 1] = act2_ * __builtin_amdgcn_cvt_scalef32_pk_f16_fp4((w_), 1.0f, 1) + oo_[(j_) + 1]; \
        oo_[(j_) + 2] = act2_ * __builtin_amdgcn_cvt_scalef32_pk_f16_fp4((w_), 1.0f, 2) + oo_[(j_) + 2]; oo_[(j_) + 3] = act2_ * __builtin_amdgcn_cvt_scalef32_pk_f16_fp4((w_), 1.0f, 3) + oo_[(j_) + 3]; } while (0)
#define P12_COMPUTE(S, idx_, fmt_) do { float a0_ = 0.f, a1_ = 0.f, a2_ = 0.f, a3_ = 0.f; \
        if ((fmt_) == 6) { \
            const u32x16 ua_ = __builtin_bit_cast(u32x16, __builtin_amdgcn_cvt_scalef32_pk32_bf16_fp6((u32x6){U##S[0].x, U##S[0].y, U##S[0].z, U##S[0].w, U##S[1].x, U##S[1].y}, 1.0f)); \
            const u32x16 ub_ = __builtin_bit_cast(u32x16, __builtin_amdgcn_cvt_scalef32_pk32_bf16_fp6((u32x6){U##S[1].z, U##S[1].w, U##S[2].x, U##S[2].y, U##S[2].z, U##S[2].w}, 1.0f)); \
            _Pragma("unroll") for (int j = 0; j < 16; j += 4) { a0_ = dot2bf(ua_[j], hA[j], a0_); a1_ = dot2bf(ua_[j + 1], hA[j + 1], a1_); a2_ = dot2bf(ua_[j + 2], hA[j + 2], a2_); a3_ = dot2bf(ua_[j + 3], hA[j + 3], a3_); } \
            _Pragma("unroll") for (int j = 0; j < 16; j += 4) { a0_ = dot2bf(ub_[j], hB[j], a0_); a1_ = dot2bf(ub_[j + 1], hB[j + 1], a1_); a2_ = dot2bf(ub_[j + 2], hB[j + 2], a2_); a3_ = dot2bf(ub_[j + 3], hB[j + 3], a3_); } \
            const float a_ = wave_sum((a0_ + a1_) + (a2_ + a3_)) * su##S; \
            const float act_ = gelu_fast(a_) * gtl[idx_] * sv##S; const h2_t act2_ = {(_Float16)act_, (_Float16)act_}; \
            const h32_t va_ = __builtin_amdgcn_cvt_scalef32_pk32_f16_fp6((u32x6){V##S[0].x, V##S[0].y, V##S[0].z, V##S[0].w, V##S[1].x, V##S[1].y}, 1.0f); \
            _Pragma("unroll") for (int j = 0; j < 16; ++j) oA[j] = act2_ * (h2_t){va_[2 * j], va_[2 * j + 1]} + oA[j]; \
            const h32_t vb_ = __builtin_amdgcn_cvt_scalef32_pk32_f16_fp6((u32x6){V##S[1].z, V##S[1].w, V##S[2].x, V##S[2].y, V##S[2].z, V##S[2].w}, 1.0f); \
            _Pragma("unroll") for (int j = 0; j < 16; ++j) oB[j] = act2_ * (h2_t){vb_[2 * j], vb_[2 * j + 1]} + oB[j]; \
        } else { \
            P12_U4(U##S[0].x, hA, 0); P12_U4(U##S[0].y, hA, 4); P12_U4(U##S[0].z, hA, 8); P12_U4(U##S[0].w, hA, 12); \
            P12_U4(U##S[1].x, hB, 0); P12_U4(U##S[1].y, hB, 4); P12_U4(U##S[1].z, hB, 8); P12_U4(U##S[1].w, hB, 12); \
            const float a_ = wave_sum(((a0_ + a1_) + (a2_ + a3_)) * su##S); \
            const float act_ = gelu_fast(a_) * gtl[idx_] * sv##S; const h2_t act2_ = {(_Float16)act_, (_Float16)act_}; \
            P12_V4(V##S[0].x, oA, 0); P12_V4(V##S[0].y, oA, 4); P12_V4(V##S[0].z, oA, 8); P12_V4(V##S[0].w, oA, 12); \
            P12_V4(V##S[1].x, oB, 0); P12_V4(V##S[1].y, oB, 4); P12_V4(V##S[1].z, oB, 8); P12_V4(V##S[1].w, oB, 12); } } while (0)
        P12_LOAD(A, 0, P12_FMT(0)); P12_LOAD(B, 1, P12_FMT(1)); P12_LOAD(C, 2, P12_FMT(2)); P12_LOAD(D, 3, P12_FMT(3));
#pragma unroll 1
        for (int s = 0; s < nb; ++s) {
            const int t = tb + s * tstride;
            if (s + 1 < nb) p12_route(pq + (size_t)(t + tstride) * 2048, tops, topi, exl + (s + 1) * 128, gtl + (s + 1) * 128, lane, ij4);
            unsigned hA[16], hB[16];
            { u32x4 ra[4], rb[4];
#pragma unroll
              for (int i = 0; i < 4; ++i) { ra[i] = *(const u32x4*)(h2 + (size_t)t * D + 16 * lane + 1024 * i); rb[i] = *(const u32x4*)(h2 + (size_t)t * D + 16 * lane + 1024 * i + 8); }
#pragma unroll
              for (int q = 0; q < 4; ++q) {
                  hA[2 * q] = __builtin_amdgcn_perm(ra[1][q], ra[0][q], 0x05040100u); hA[2 * q + 1] = __builtin_amdgcn_perm(ra[1][q], ra[0][q], 0x07060302u);
                  hA[8 + 2 * q] = __builtin_amdgcn_perm(rb[1][q], rb[0][q], 0x05040100u); hA[8 + 2 * q + 1] = __builtin_amdgcn_perm(rb[1][q], rb[0][q], 0x07060302u);
                  hB[2 * q] = __builtin_amdgcn_perm(ra[3][q], ra[2][q], 0x05040100u); hB[2 * q + 1] = __builtin_amdgcn_perm(ra[3][q], ra[2][q], 0x07060302u);
                  hB[8 + 2 * q] = __builtin_amdgcn_perm(rb[3][q], rb[2][q], 0x05040100u); hB[8 + 2 * q + 1] = __builtin_amdgcn_perm(rb[3][q], rb[2][q], 0x07060302u); } }
            h2_t oA[16], oB[16];
#pragma unroll
            for (int j = 0; j < 16; ++j) { oA[j] = (h2_t){(_Float16)0.f, (_Float16)0.f}; oB[j] = (h2_t){(_Float16)0.f, (_Float16)0.f}; }
#pragma unroll 1
            for (int hh = 0; hh < 8; ++hh) {
                const int f0 = s * 128 + hh * 16;
#pragma unroll
                for (int k = 0; k < 16; k += 4) {
                    P12_COMPUTE(A, f0 + k, P12_FMT(k)); P12_LOAD(A, f0 + k + 4, P12_FMT(k + 4));
                    P12_COMPUTE(B, f0 + k + 1, P12_FMT(k + 1)); P12_LOAD(B, f0 + k + 5, P12_FMT(k + 5));
                    P12_COMPUTE(C, f0 + k + 2, P12_FMT(k + 2)); P12_LOAD(C, f0 + k + 6, P12_FMT(k + 6));
                    P12_COMPUTE(D, f0 + k + 3, P12_FMT(k + 3)); P12_LOAD(D, f0 + k + 7, P12_FMT(k + 7));
                }
            }
#pragma unroll
            for (int i = 0; i < 4; ++i) { const int d0 = 16 * lane + 1024 * i; const float* op = C.out + (size_t)t * D + d0; float* dp = dst + (size_t)t * D + d0;
#pragma unroll
                for (int q = 0; q < 4; ++q) { const f32x4 xv = *(const f32x4*)(op + 4 * q); const f32x4 gv = *(const f32x4*)(gt2 + d0 + 4 * q); f32x4 r;
#pragma unroll
                    for (int j = 0; j < 4; ++j) { const h2_t ov = (i < 2) ? oA[4 * q + j] : oB[4 * q + j]; r[j] = xv[j] + gv[j] * ((i & 1) ? (float)ov.y : (float)ov.x); }
                    __builtin_nontemporal_store(r, (f32x4*)(dp + 4 * q)); } }
        }
#undef P12_U4
#undef P12_V4
#undef P12_FMT
#undef P12_LOAD
#undef P12_COMPUTE
        lds_sync();
    }
}

constexpr int N_PHASES = 13;
#ifndef DBG_MIX
#define DBG_MIX 0
#endif
__global__ void __launch_bounds__(NTHREADS, 2) fwd(Args args) {
    extern __shared__ __attribute__((aligned(16))) unsigned char lds_raw[];
    Ctx C0; C0.in = args.in; C0.out = args.out; C0.ws = args.ws; C0.lds = (LAS unsigned char*)lds_raw;
    C0.tid = threadIdx.x; C0.lane = C0.tid & 63; C0.wave = __builtin_amdgcn_readfirstlane(C0.tid >> 6);
#define PHASE_CTX() Ctx C = C0; { int t_ = threadIdx.x; asm volatile("" : "+v"(t_)); C.tid = t_; C.lane = t_ & 63; C.wave = __builtin_amdgcn_readfirstlane(t_ >> 6); }
    const Ctx& C = C0;
    const int lo = args.ph_lo, hi = args.ph_hi;
    const bool fused = (hi - lo) > 1;
    volatile LAS unsigned* bst = (volatile LAS unsigned*)(C.lds + LDS_BYTES - 16);
    XcdBarrier bar; bar.bar = (unsigned*)(C.ws + WS_CTL + CTL_BAR); bar.x = 0; bar.st = bst;
    if (fused) { if (C.tid == 0) { bst[0] = 0u; bst[1] = 0u; bst[2] = 0u; bst[3] = 0u; } __syncthreads(); bar = xcd_barrier_post((unsigned*)(C.ws + WS_CTL + CTL_BAR), bst); }
#ifndef ONLY_PHASE
#define ONLY_PHASE -1
#endif
#define IN(k) (lo <= (k) && (k) < hi && (ONLY_PHASE < 0 || ONLY_PHASE == (k)))
#ifndef REP_PHASE
#define REP_PHASE -1
#endif
#define REP(k, ...) if (REP_PHASE == (k)) { __VA_ARGS__ }
#define SEAM(k) do { if (IN(k) && IN((k) + 1)) xcd_barrier(bar); } while (0)
    const float* mod = (const float*)(C.ws + WS_MOD);
    bf16_t* proj = (bf16_t*)(C.ws + WS_PROJ);
    if (IN(0)) { PHASE_CTX(); REP(0, p0_prologue(C); __syncthreads();) p0_prologue(C); } SEAM(0);
    if (IN(1)) { PHASE_CTX(); norm_mod_phase(C, C.in[I_X], C.in[I_GMIX], mod + 0 * D, mod + 1 * D, (bf16_t*)(C.ws + WS_H), C.ws + WS_H8); } SEAM(1);
    if (IN(2)) { PHASE_CTX(); pg8::Gemm g{(const bf16_t*)(C.ws + WS_H), (const bf16_t*)(C.ws + WS_WIN), T, NP_BF, D, D, D}; pg8::StaticOrder S; S.init(T, NP_BF, gridDim.x, blockIdx.x);
                 pg8::EpiPlain E{proj, NP, 1.f}; pg8::gemm_phase(C.lds, g, S, E);
                 pg8::Gemm g8{(const bf16_t*)(C.ws + WS_H8), (const bf16_t*)(C.ws + WS_WIN8), T, NP_F8, D / 2, D / 2, D / 2}; pg8::Fp8Order S8{(int)blockIdx.x};
                 pg8::EpiSigU8 E8{(unsigned char*)(proj + P_GM), NP * 2, 1.f / 64.f}; pg8::gemm_phase<pg8::EpiSigU8, pg8::Fp8Order, true>(C.lds, g8, S8, E8); } SEAM(2);
    if (IN(3)) { PHASE_CTX(); p3_post(C); } SEAM(3);
    if (IN(4)) { PHASE_CTX(); pg8::Gemm g{(const bf16_t*)(C.ws + WS_KC), (const bf16_t*)(C.ws + WS_W1T), 8192, 512, 512, 2048, D}; pg8::CmpOrder S{(int)gridDim.x, (int)blockIdx.x};
                 pg8::EpiSlab E{(float*)(C.ws + WS_HIDP)}; pg8::gemm_phase(C.lds, g, S, E); } SEAM(4);
    if (IN(5)) { PHASE_CTX(); p5_cmp_out(C); } SEAM(5);
    if (IN(6)) { PHASE_CTX(); p6_mixers(C, DBG_MIX); } SEAM(6);
    if (IN(7)) { PHASE_CTX(); pg8::Gemm g{(const bf16_t*)(C.ws + WS_YA), (const bf16_t*)(C.ws + WS_WBA), T, D, 1024, 1024, 1024};   pg8::StaticOrder S; S.init(T, D, gridDim.x, blockIdx.x);
                 pg8::EpiGate<0> E{(bf16_t*)(C.ws + WS_MERGED), D, (const unsigned char*)(proj + P_GM), NP * 2, 1.f / (16.f * 64.f * 255.f), nullptr}; pg8::gemm_phase<pg8::EpiGate<0>, pg8::StaticOrder, true>(C.lds, g, S, E); } if (IN(7) && IN(8)) __syncthreads();
    if (IN(8)) { PHASE_CTX(); pg8::Gemm g{(const bf16_t*)(C.ws + WS_YB), (const bf16_t*)(C.ws + WS_WBB), T, D, 1024, 1024, 1024}; pg8::StaticOrder S; S.init(T, D, gridDim.x, blockIdx.x);
                 pg8::EpiGate<1> E{(bf16_t*)(C.ws + WS_MERGED), D, (const unsigned char*)(proj + P_GM) + 4096, NP * 2, 1.f / (16.f * 64.f * 255.f), C.ws + WS_H8}; pg8::gemm_phase<pg8::EpiGate<1>, pg8::StaticOrder, true>(C.lds, g, S, E); } SEAM(8);
    if (IN(9)) { PHASE_CTX(); pg8::Gemm g{(const bf16_t*)(C.ws + WS_H8), (const bf16_t*)(C.ws + WS_WOUT), T, D, D / 2, D / 2, D / 2};   pg8::StaticOrder S; S.init(T, D, gridDim.x, blockIdx.x);
                 pg8::EpiResid E{C.out, C.in[I_X], mod + 2 * D, D, 1.f / (32.f * 64.f)}; pg8::gemm_phase<pg8::EpiResid, pg8::StaticOrder, true>(C.lds, g, S, E); } SEAM(9);
    if (IN(10)) { PHASE_CTX(); norm_mod_phase(C, C.out, C.in[I_GFFN], mod + 3 * D, mod + 4 * D, (bf16_t*)(C.ws + WS_H2)); } SEAM(10);
    if (IN(11)) { PHASE_CTX(); pg8::Gemm g{(const bf16_t*)(C.ws + WS_H2), (const bf16_t*)(C.ws + WS_WQ), T, 2048, D, D, D}; pg8::StaticOrder S; S.init(T, 2048, gridDim.x, blockIdx.x);
                  pg8::EpiPlain E{(bf16_t*)(C.ws + WS_PQ), 2048, 1.f}; pg8::gemm_phase(C.lds, g, S, E); } SEAM(11);
    if (IN(12)) { PHASE_CTX(); REP(12, p12_peer(C, (float*)(C.ws + WS_PROJ)); __syncthreads();) p12_peer(C, C.out); }
#undef IN
#undef SEAM
}

#ifndef N_LAUNCH_MODE
#define N_LAUNCH_MODE 1
#endif
extern "C" void kernel_launch(void* const* d_in, const int* in_sizes, int n_in, void* d_out, int out_size, void* d_ws, size_t ws_size, hipStream_t stream) {
    static int grid = 0;
    if (grid == 0) {
        if (n_in != 27 || out_size != T * D || ws_size < WS_END) { fprintf(stderr, "kernel_launch: unexpected shapes (n_in %d out %d ws %zu need %zu)\n", n_in, out_size, ws_size, (size_t)WS_END); grid = -1; return; }
        int dev = 0, cus = 0;
        if (hipGetDevice(&dev) != hipSuccess || hipDeviceGetAttribute(&cus, hipDeviceAttributeMultiprocessorCount, dev) != hipSuccess) { grid = -1; return; }
        if (hipFuncSetAttribute((const void*)fwd, hipFuncAttributeMaxDynamicSharedMemorySize, LDS_BYTES) != hipSuccess) { fprintf(stderr, "kernel_launch: hipFuncSetAttribute failed\n"); grid = -1; return; }
        int per_cu = 0;
        if (hipOccupancyMaxActiveBlocksPerMultiprocessor(&per_cu, (const void*)fwd, NTHREADS, LDS_BYTES) != hipSuccess || per_cu < 1) { fprintf(stderr, "kernel_launch: occupancy query says %d\n", per_cu); }
        (void)hipGetLastError();
        grid = cus;
    }
    if (grid < 0) return;
    (void)hipMemsetAsync((char*)d_ws + WS_CTL, 0, 64 * 1024, stream);
    Args a{};
    for (int i = 0; i < 27; ++i) a.in[i] = (const float*)d_in[i];
    a.out = (float*)d_out; a.ws = (unsigned char*)d_ws;
#if N_LAUNCH_MODE == 1
    a.ph_lo = 0; a.ph_hi = N_PHASES;
    hipLaunchKernelGGL(fwd, dim3(grid), dim3(NTHREADS), LDS_BYTES, stream, a);
#else
    for (int p = 0; p < N_PHASES; ++p) { a.ph_lo = p; a.ph_hi = p + 1; hipLaunchKernelGGL(fwd, dim3(grid), dim3(NTHREADS), LDS_BYTES, stream, a); }
#endif
}
```

```cpp
#include <hip/hip_runtime.h>
#include <cstdio>
#include <cstdint>

#define LAS __attribute__((address_space(3)))
typedef unsigned short bf16_t;
typedef unsigned long long u64;
typedef short bf16x8 __attribute__((ext_vector_type(8)));
typedef float f32x4 __attribute__((ext_vector_type(4)));
typedef float f32x16 __attribute__((ext_vector_type(16)));
typedef unsigned u32x4 __attribute__((ext_vector_type(4)));
typedef unsigned u32x2 __attribute__((ext_vector_type(2)));
typedef __bf16 bf2_t __attribute__((ext_vector_type(2)));
typedef float f32x2 __attribute__((ext_vector_type(2)));
typedef float f32x32 __attribute__((ext_vector_type(32)));
typedef unsigned u32x6 __attribute__((ext_vector_type(6)));
typedef _Float16 hx2_t __attribute__((ext_vector_type(2)));

constexpr int T = 16384, D = 4096, NP = 18688;
constexpr int P_QA = 0, P_KA = 2048, P_VA = 2560, P_QI = 3072, P_QB = 5120, P_KC = 7168, P_VC = 7680, P_KS = 8192, P_VS = 8704,
              P_KW = 9216, P_VW = 9728, P_KI = 10240, P_WI = 10304, P_GB = 10336, P_GM = 10496;
constexpr int NP_BF = 10496, NP_F8 = 8192;
constexpr int NCMP = 1023;
constexpr float EPS = 1e-6f;
constexpr int NTHREADS = 512;
constexpr int LDS_BYTES = 160 * 1024;

constexpr size_t MB = 1024ull * 1024ull;
constexpr size_t WS_CTL = 0;
constexpr size_t WS_MOD = 64 * 1024;
constexpr size_t WS_B1 = 192 * 1024;
constexpr size_t WS_B1P = 196 * 1024;
constexpr size_t WS_W1T = 512 * 1024;
constexpr size_t WS_SUBK = WS_W1T + 4 * MB;
constexpr size_t WS_HID = WS_SUBK + 512 * 1024;
constexpr size_t WS_KCMP = WS_HID + 8 * MB;
constexpr size_t WS_VCMPT = WS_KCMP + 1 * MB;
constexpr size_t WS_KIC = WS_VCMPT + 1 * MB;
constexpr size_t WS_KC = WS_KIC + 2 * MB;
constexpr size_t WS_VST = WS_KC + 32 * MB + 64 * 1024;
constexpr size_t WS_VWT = WS_VST + 16 * MB;
constexpr size_t WS_WBA = WS_VWT + 16 * MB;
constexpr size_t WS_WBB = WS_WBA + 16 * MB;
constexpr size_t WS_WOUT = WS_WBB + 16 * MB;
constexpr size_t WS_WQ = WS_WOUT + 32 * MB;
constexpr size_t WS_PU = WS_WQ + 16 * MB;
constexpr size_t WS_PV = WS_PU + 128 * MB;
constexpr size_t WS_PU4 = WS_PU + 56 * MB, WS_PV4 = WS_PV + 56 * MB;
constexpr size_t WS_PROJ = WS_PV + 128 * MB;
constexpr size_t WS_WIN = WS_PROJ + (size_t)T * NP * 2;
constexpr size_t WS_H = WS_WIN + (size_t)NP * D * 2;
constexpr size_t WS_KA = WS_H + 128 * MB;
constexpr size_t WS_VA = WS_KA + 16 * MB;
constexpr size_t WS_KSC = WS_VA + 16 * MB;
constexpr size_t WS_KWC = WS_KSC + 16 * MB;
constexpr size_t WS_HIDP = WS_KWC + 16 * MB;
constexpr size_t WS_OACC = WS_HIDP + 64 * MB;
constexpr size_t WS_H8 = WS_OACC + 32 * MB;
constexpr size_t WS_END = WS_H8 + 64 * MB;
constexpr size_t WS_WIN8 = WS_WIN + (size_t)NP_BF * D * 2;
constexpr size_t WS_YA = WS_WIN, WS_YB = WS_WIN + 64 * MB, WS_H2 = WS_WIN;
constexpr size_t WS_MERGED = WS_H, WS_PQ = WS_H;
constexpr size_t CTL_BAR = 0, CTL_CNT = 16384;

__device__ __forceinline__ float bf2f(bf16_t b) { return __uint_as_float(((unsigned)b) << 16); }
__device__ __forceinline__ float bflo(unsigned u) { return __uint_as_float(u << 16); }
__device__ __forceinline__ float bfhi(unsigned u) { return __uint_as_float(u & 0xFFFF0000u); }
__device__ __forceinline__ unsigned cvt_pk_bf16(float lo, float hi) { unsigned r; asm volatile("v_cvt_pk_bf16_f32 %0, %1, %2" : "=v"(r) : "v"(lo), "v"(hi)); return r; }
__device__ __forceinline__ bf16_t f2bf(float f) { return (bf16_t)(cvt_pk_bf16(f, 0.f) & 0xFFFFu); }
__device__ __forceinline__ float dot2bf(unsigned a, unsigned b, float c) { return __builtin_amdgcn_fdot2_f32_bf16(__builtin_bit_cast(bf2_t, a), __builtin_bit_cast(bf2_t, b), c, false); }
template <int CTRL> __device__ __forceinline__ float dppf(float v) { return __builtin_bit_cast(float, __builtin_amdgcn_update_dpp(0, __builtin_bit_cast(int, v), CTRL, 0xF, 0xF, true)); }
template <int CTRL> __device__ __forceinline__ unsigned dppu(unsigned v) { return (unsigned)__builtin_amdgcn_update_dpp(0, (int)v, CTRL, 0xF, 0xF, true); }
__device__ __forceinline__ void swap32f(float& a, float& b) { asm volatile("s_nop 1\n\tv_permlane32_swap_b32 %0, %1" : "+v"(a), "+v"(b)); }
__device__ __forceinline__ void swap16f(float& a, float& b) { asm volatile("s_nop 1\n\tv_permlane16_swap_b32 %0, %1" : "+v"(a), "+v"(b)); }
__device__ __forceinline__ void swap32u(unsigned& a, unsigned& b) { asm volatile("s_nop 1\n\tv_permlane32_swap_b32 %0, %1" : "+v"(a), "+v"(b)); }
__device__ __forceinline__ void swap16u(unsigned& a, unsigned& b) { asm volatile("s_nop 1\n\tv_permlane16_swap_b32 %0, %1" : "+v"(a), "+v"(b)); }
__device__ __forceinline__ float fmax_fast(float a, float b) { float r; asm("v_max_f32 %0, %1, %2" : "=v"(r) : "v"(a), "v"(b)); return r; }
__device__ __forceinline__ float xsum32(float v) { float a = v, b = v; swap32f(a, b); return a + b; }
__device__ __forceinline__ float xsum16(float v) { float a = v, b = v; swap16f(a, b); return a + b; }
__device__ __forceinline__ float xmax32(float v) { float a = v, b = v; swap32f(a, b); return fmax_fast(a, b); }
__device__ __forceinline__ float xmax16(float v) { float a = v, b = v; swap16f(a, b); return fmax_fast(a, b); }
__device__ __forceinline__ float xor32f(float v, int h) { float a = v, b = v; swap32f(a, b); return h ? a : b; }
__device__ __forceinline__ float wave_sum(float v) { v += dppf<0xB1>(v); v += dppf<0x4E>(v); v += dppf<0x141>(v); v += dppf<0x140>(v); return xsum16(xsum32(v)); }
__device__ __forceinline__ float wave_max(float v) { v = fmax_fast(v, dppf<0xB1>(v)); v = fmax_fast(v, dppf<0x4E>(v)); v = fmax_fast(v, dppf<0x141>(v)); v = fmax_fast(v, dppf<0x140>(v)); return xmax16(xmax32(v)); }
__device__ __forceinline__ unsigned umaxu(unsigned a, unsigned b) { return a > b ? a : b; }
__device__ __forceinline__ unsigned wave_maxu(unsigned v) { v = umaxu(v, dppu<0xB1>(v)); v = umaxu(v, dppu<0x4E>(v)); v = umaxu(v, dppu<0x141>(v)); v = umaxu(v, dppu<0x140>(v));
    unsigned a = v, b = v; swap32u(a, b); v = umaxu(a, b); a = v; b = v; swap16u(a, b); return umaxu(a, b); }
__device__ __forceinline__ void lds_sync() { asm volatile("s_waitcnt lgkmcnt(0)" ::: "memory"); __builtin_amdgcn_wave_barrier(); }
__device__ __forceinline__ float gelu_tanh(float x) { const float u = 0.7978845608028654f * (x + 0.044715f * x * x * x); const float e = __expf(2.f * u); return 0.5f * x * (2.f - 2.f / (e + 1.f)); }
__device__ __forceinline__ float sigmoidf_(float x) { return __builtin_amdgcn_rcpf(1.f + __expf(-x)); }
__device__ __forceinline__ unsigned sortable(float s) { unsigned b = __float_as_uint(s); return b ^ ((b >> 31) ? 0xFFFFFFFFu : 0x80000000u); }

#define XB_TMO      128
#define XB_XCNT(j)  (256  + 64 * (j))
#define XB_XSUB(j)  (1280 + 64 * (j))
#define XB_XGEN(j)  (2304 + 64 * (j))
#define XB_TOP      3328
#define XB_TOPGEN   3392
#define XCD_BAR_WORDS 3456
#define XB_SPIN_CAP (1u << 24)
__device__ __forceinline__ unsigned xb_ld(unsigned* p)              { return __hip_atomic_load(p, __ATOMIC_RELAXED, __HIP_MEMORY_SCOPE_AGENT); }
__device__ __forceinline__ unsigned xb_add(unsigned* p, unsigned v) { return __hip_atomic_fetch_add(p, v, __ATOMIC_RELAXED, __HIP_MEMORY_SCOPE_AGENT); }
__device__ __forceinline__ unsigned xb_xcc_id() { return (unsigned)__builtin_amdgcn_s_getreg((3 << 11) | 20) & 0xFu; }
#define XB_SPIN(cond, bar) do { unsigned _sp = 0; while (cond) { __builtin_amdgcn_s_sleep(1); \
    if ((++_sp & 255u) == 0u) { if (xb_ld(&(bar)[XB_TMO])) break; if (_sp > XB_SPIN_CAP) { atomicAdd(&(bar)[XB_TMO], 1u); break; } } } } while (0)
struct XcdBarrier { unsigned* bar; unsigned x; volatile LAS unsigned* st; };
__device__ __forceinline__ XcdBarrier xcd_barrier_post(unsigned* bar, volatile LAS unsigned* st) {
    XcdBarrier b; b.bar = bar; b.x = xb_xcc_id(); b.st = st;
    if (threadIdx.x == 0) (void)xb_add(&bar[XB_XCNT(b.x)], 1u);
    return b;
}
__device__ __forceinline__ void xcd_barrier_complete(unsigned* bar, unsigned x, unsigned& nloc, unsigned& nx) {
    const unsigned G = gridDim.x * gridDim.y * gridDim.z;
    unsigned sum, cnt, mine, sp = 0u;
    for (;;) {
        sum = 0u; cnt = 0u; mine = 0u;
#pragma unroll
        for (unsigned j = 0; j < 16; ++j) { const unsigned c = xb_ld(&bar[XB_XCNT(j)]); sum += c; cnt += (c > 0u) ? 1u : 0u; mine = (j == x) ? c : mine; }
        if (sum == G) break;
        __builtin_amdgcn_s_sleep(1);
        if ((++sp & 255u) == 0u) { if (xb_ld(&bar[XB_TMO])) break; if (sp > XB_SPIN_CAP) { atomicAdd(&bar[XB_TMO], 1u); break; } }
    }
    nloc = mine > 0u ? mine : 1u; nx = cnt > 0u ? cnt : 1u;
}
__device__ __forceinline__ void xcd_barrier(const XcdBarrier& b) {
    asm volatile("s_waitcnt vmcnt(0)" ::: "memory");
    __syncthreads();
    if (threadIdx.x == 0) {
        unsigned* bar = b.bar;
        __builtin_amdgcn_s_waitcnt(0);
        unsigned nloc = b.st[0], nx = b.st[1];
        if (nloc == 0u) { xcd_barrier_complete(bar, b.x, nloc, nx); b.st[0] = nloc; b.st[1] = nx; }
        const unsigned old = xb_add(&bar[XB_XSUB(b.x)], 1u);
        const unsigned gen = old / nloc;
        if (old + 1u == (gen + 1u) * nloc) {
            __builtin_amdgcn_fence(__ATOMIC_RELEASE, "agent");
            asm volatile("s_waitcnt vmcnt(0)" ::: "memory");
            const unsigned og = xb_add(&bar[XB_TOP], 1u);
            const unsigned tg = og / nx;
            if (og + 1u == (tg + 1u) * nx) xb_add(&bar[XB_TOPGEN], 1u);
            else XB_SPIN(xb_ld(&bar[XB_TOPGEN]) == tg, bar);
            __builtin_amdgcn_fence(__ATOMIC_ACQUIRE, "agent");
            xb_add(&bar[XB_XGEN(b.x)], 1u);
            asm volatile("s_waitcnt vmcnt(0)" ::: "memory");
        } else {
            XB_SPIN(xb_ld(&bar[XB_XGEN(b.x)]) == gen, bar);
            __builtin_amdgcn_fence(__ATOMIC_ACQUIRE, "agent");
            asm volatile("s_waitcnt vmcnt(0)" ::: "memory");
        }
    }
    __syncthreads();
}

namespace pg8 {
constexpr int BM = 256, BK = 64, HALF = 128, HTB = HALF * BK * 2, STAGE_BYTES = 8 * HTB, NXCD = 8, WGM = 8;
__host__ __device__ __forceinline__ int lds_byte(int r, int c) { const int st = (r >> 4) * 2 + (c >> 5), rr = r & 15, cc = c & 31, ob = rr * 64 + cc * 2; return st * 1024 + (ob ^ (((ob >> 9) & 1) << 5)); }
__host__ __device__ __forceinline__ void stage_rc(int b, int& R, int& C) { const int st = b / 1024, sb = b % 1024, swz = sb ^ (((sb >> 9) & 1) << 5); R = (st >> 1) * 16 + swz / 64; C = (st & 1) * 32 + (swz % 64) / 2; }
__host__ __device__ __forceinline__ int perm32(int rho) { const int n = rho >> 4, i = rho & 15; return 8 * (i >> 2) + 4 * n + (i & 3); }
struct Unit { int pm, pn, kofs; };
struct Gemm { const bf16_t* A; const bf16_t* Bt; int M, N, K, lda, ldb; };
struct StaticOrder {
    int nM, nN, nwg, G, c;
    __host__ __device__ void init(int M, int N, int G_, int c_) { nM = M / BM; nN = N / BM; nwg = nM * nN; G = G_; c = c_; }
    __host__ __device__ bool next(int i, Unit& u) const {
        const long L = (long)i * G + c; if (L >= nwg) return false;
        int wgid = (int)L; { const int q = nwg / NXCD, r = nwg % NXCD, xcd = wgid % NXCD, off = wgid / NXCD; wgid = (xcd < r ? xcd * (q + 1) : r * (q + 1) + (xcd - r) * q) + off; }
        const int nig = WGM * nN, gid = wgid / nig, fm = gid * WGM, gsz = (nM - fm) < WGM ? (nM - fm) : WGM;
        u.pm = fm + ((wgid % nig) % gsz); u.pn = (wgid % nig) / gsz; u.kofs = 0; return true;
    }
};
struct Fp8Order {
    int c;
    __host__ __device__ bool next(int i, Unit& u) const {
        const int cnt = c < 64 ? 6 : (c < 192 ? 9 : 8); if (i >= cnt) return false;
        const int off = c < 64 ? 6 * c : (c < 192 ? 384 + 9 * (c - 64) : 1536 + 8 * (c - 192));
        const int L = off + i; u.pm = L & 63; u.pn = L >> 6; u.kofs = 0; return true; }
};
struct CmpOrder {
    int G, c;
    __host__ __device__ bool next(int i, Unit& u) const { const long L = (long)i * G + c; if (L >= 256) return false; u.pm = (int)(L & 31); u.pn = u.pm >> 4; u.kofs = (int)(L >> 5) * 512; return true; }
};

struct EpiPlain {
    static constexpr bool PERM = true;
    bf16_t* O; int ldc; float scale;
    __device__ __forceinline__ void operator()(const f32x4 (&acc)[2][2][4][2], const Unit& u, int wr, int wc, int fr, int fq) const {
        const int row0 = u.pm * BM + wr * 64 + fr, col0 = u.pn * BM + wc * 32 + 8 * fq;
#pragma unroll
        for (int ai = 0; ai < 2; ++ai)
#pragma unroll
            for (int m = 0; m < 4; ++m) { bf16_t* rowp = O + (size_t)(row0 + ai * HALF + m * 16) * ldc + col0;
#pragma unroll
                for (int bj = 0; bj < 2; ++bj) { const f32x4 v0 = acc[ai][bj][m][0] * scale, v1 = acc[ai][bj][m][1] * scale;
                    u32x4 w; w.x = cvt_pk_bf16(v0[0], v0[1]); w.y = cvt_pk_bf16(v0[2], v0[3]); w.z = cvt_pk_bf16(v1[0], v1[1]); w.w = cvt_pk_bf16(v1[2], v1[3]);
                    *(u32x4*)(rowp + bj * HALF) = w; } }
    }
};
struct EpiSigU8 {
    static constexpr bool PERM = true;
    unsigned char* O; int ldb; float scale;
    __device__ __forceinline__ void operator()(const f32x4 (&acc)[2][2][4][2], const Unit& u, int wr, int wc, int fr, int fq) const {
        const int row0 = u.pm * BM + wr * 64 + fr, col0 = u.pn * BM + wc * 32 + 8 * fq;
#pragma unroll
        for (int ai = 0; ai < 2; ++ai)
#pragma unroll
            for (int m = 0; m < 4; ++m) { unsigned char* rowp = O + (size_t)(row0 + ai * HALF + m * 16) * ldb + col0;
#pragma unroll
                for (int bj = 0; bj < 2; ++bj) { const f32x4 v0 = acc[ai][bj][m][0] * scale, v1 = acc[ai][bj][m][1] * scale;
                    unsigned w0 = 0u, w1 = 0u;
                    w0 = __builtin_amdgcn_cvt_pk_u8_f32(255.f * sigmoidf_(v0[0]), 0, w0); w0 = __builtin_amdgcn_cvt_pk_u8_f32(255.f * sigmoidf_(v0[1]), 1, w0);
                    w0 = __builtin_amdgcn_cvt_pk_u8_f32(255.f * sigmoidf_(v0[2]), 2, w0); w0 = __builtin_amdgcn_cvt_pk_u8_f32(255.f * sigmoidf_(v0[3]), 3, w0);
                    w1 = __builtin_amdgcn_cvt_pk_u8_f32(255.f * sigmoidf_(v1[0]), 0, w1); w1 = __builtin_amdgcn_cvt_pk_u8_f32(255.f * sigmoidf_(v1[1]), 1, w1);
                    w1 = __builtin_amdgcn_cvt_pk_u8_f32(255.f * sigmoidf_(v1[2]), 2, w1); w1 = __builtin_amdgcn_cvt_pk_u8_f32(255.f * sigmoidf_(v1[3]), 3, w1);
                    *(u32x2*)(rowp + bj * HALF) = (u32x2){w0, w1}; } }
    }
};
template <int SECOND> struct EpiGate {
    static constexpr bool PERM = true;
    bf16_t* O; int ldc; const unsigned char* gate; int ldg; float scale; unsigned char* O8;
    __device__ __forceinline__ void operator()(const f32x4 (&acc)[2][2][4][2], const Unit& u, int wr, int wc, int fr, int fq) const {
        const int row0 = u.pm * BM + wr * 64 + fr, col0 = u.pn * BM + wc * 32 + 8 * fq;
#pragma unroll
        for (int ai = 0; ai < 2; ++ai)
#pragma unroll
            for (int m = 0; m < 4; ++m) { const size_t row = (size_t)(row0 + ai * HALF + m * 16); bf16_t* rowp = O + row * ldc + col0; const unsigned char* gp = gate + row * ldg + col0;
#pragma unroll
                for (int bj = 0; bj < 2; ++bj) { const f32x4 v0 = acc[ai][bj][m][0] * scale, v1 = acc[ai][bj][m][1] * scale;
                    const u32x2 gv = *(const u32x2*)(gp + bj * HALF);
                    float r[8];
#pragma unroll
                    for (int e = 0; e < 4; ++e) { r[e] = (float)((gv.x >> (8 * e)) & 0xFFu) * v0[e]; r[4 + e] = (float)((gv.y >> (8 * e)) & 0xFFu) * v1[e]; }
                    if (SECOND) { const u32x4 pv = *(const u32x4*)(rowp + bj * HALF);
                        r[0] += bflo(pv.x); r[1] += bfhi(pv.x); r[2] += bflo(pv.y); r[3] += bfhi(pv.y); r[4] += bflo(pv.z); r[5] += bfhi(pv.z); r[6] += bflo(pv.w); r[7] += bfhi(pv.w);
                        int p0 = __builtin_amdgcn_cvt_pk_fp8_f32(r[0] * 32.f, r[1] * 32.f, 0, false); p0 = __builtin_amdgcn_cvt_pk_fp8_f32(r[2] * 32.f, r[3] * 32.f, p0, true);
                        int p1 = __builtin_amdgcn_cvt_pk_fp8_f32(r[4] * 32.f, r[5] * 32.f, 0, false); p1 = __builtin_amdgcn_cvt_pk_fp8_f32(r[6] * 32.f, r[7] * 32.f, p1, true);
                        *(u32x2*)(O8 + row * ldc + col0 + bj * HALF) = (u32x2){(unsigned)p0, (unsigned)p1};
                    } else {
                    u32x4 w; w.x = cvt_pk_bf16(r[0], r[1]); w.y = cvt_pk_bf16(r[2], r[3]); w.z = cvt_pk_bf16(r[4], r[5]); w.w = cvt_pk_bf16(r[6], r[7]);
                    *(u32x4*)(rowp + bj * HALF) = w; } } }
    }
};
struct EpiResid {
    static constexpr bool PERM = false;
    float* C; const float* X; const float* gt; int ldc; float scale;
    __device__ __forceinline__ void operator()(const f32x4 (&acc)[2][2][4][2], const Unit& u, int wr, int wc, int fr, int fq) const {
        const int row0 = u.pm * BM + wr * 64 + fr, col0 = u.pn * BM + wc * 32 + 4 * fq;
        f32x4 gv[2][2];
#pragma unroll
        for (int bj = 0; bj < 2; ++bj)
#pragma unroll
            for (int n = 0; n < 2; ++n) gv[bj][n] = *(const f32x4*)(gt + col0 + bj * HALF + n * 16) * scale;
#pragma unroll
        for (int ai = 0; ai < 2; ++ai)
#pragma unroll
            for (int m = 0; m < 4; ++m) { const size_t off = (size_t)(row0 + ai * HALF + m * 16) * ldc + col0;
#pragma unroll
                for (int bj = 0; bj < 2; ++bj)
#pragma unroll
                    for (int n = 0; n < 2; ++n) { const f32x4 xv = *(const f32x4*)(X + off + bj * HALF + n * 16);
                        *(f32x4*)(C + off + bj * HALF + n * 16) = xv + gv[bj][n] * acc[ai][bj][m][n]; } }
    }
};
struct EpiSlab {
    static constexpr bool PERM = false;
    float* C;
    __device__ __forceinline__ void operator()(const f32x4 (&acc)[2][2][4][2], const Unit& u, int wr, int wc, int fr, int fq) const {
        const int row0 = u.pm * BM + wr * 64 + fr, col0 = wc * 32 + 4 * fq;
        float* base = C + (size_t)(u.kofs >> 9) * 8192 * 256;
#pragma unroll
        for (int ai = 0; ai < 2; ++ai)
#pragma unroll
            for (int m = 0; m < 4; ++m) { float* rowp = base + (size_t)(row0 + ai * HALF + m * 16) * 256 + col0;
#pragma unroll
                for (int bj = 0; bj < 2; ++bj)
#pragma unroll
                    for (int n = 0; n < 2; ++n) *(f32x4*)(rowp + bj * HALF + n * 16) = acc[ai][bj][m][n]; }
    }
};

typedef int i32x8 __attribute__((ext_vector_type(8)));
template <class Epi, class Sched, bool FP8 = false>
__device__ __forceinline__ void gemm_phase(LAS unsigned char* lds, const Gemm g, const Sched& S, const Epi& E) {
    const int tid = threadIdx.x, wid = __builtin_amdgcn_readfirstlane(tid >> 6), lane = tid & 63, wr = wid >> 2, wc = wid & 3, fr = lane & 15, fq = lane >> 4;
    const int K = g.K, nt = K / BK, lda = g.lda, ldb = g.ldb;
    unsigned voffA[2], voffB[2];
#pragma unroll
    for (int i = 0; i < 2; ++i) { int R, C; stage_rc(tid * 16 + i * 8192, R, C); const int Rb = Epi::PERM ? ((R & ~31) + perm32(R & 31)) : R;
        voffA[i] = (unsigned)(R * lda + C) * 2u; voffB[i] = (unsigned)(Rb * ldb + C) * 2u; }
    const size_t kstep = (size_t)(BK * 2);
    const size_t hstepA = (size_t)HALF * lda * 2, hstepB = (size_t)HALF * ldb * 2;
    const size_t tstepA = 2 * hstepA, tstepB = 2 * hstepB;
    const unsigned ldsw = (unsigned)wid * 1024u;
    const int aoff = lds_byte(wr * 64 + fr, fq * 8), boff = lds_byte(wc * 32 + fr, fq * 8);
#define PG8_SA(b, h) (((b) * 2 + (h)) * HTB)
#define PG8_SB(b, h) ((4 + (b) * 2 + (h)) * HTB)
#define PG8_STAGE(bufoff, gbase, voff) do { _Pragma("unroll") for (int _i = 0; _i < 2; ++_i) \
        __builtin_amdgcn_global_load_lds((const unsigned*)((const char*)(gbase) + (voff)[_i]), (LAS unsigned*)(lds + (bufoff) + ldsw + _i * 8192), 16, 0, 0); } while (0)
#define PG8_LDA(dst, b, h) do { _Pragma("unroll") for (int m = 0; m < 4; ++m) { if constexpr (FP8) dst##8[m] = __builtin_shufflevector(*(const LAS i32x4_*)(lds + PG8_SA(b, h) + aoff + m * 2048), *(const LAS i32x4_*)(lds + PG8_SA(b, h) + aoff + m * 2048 + 1024), 0, 1, 2, 3, 4, 5, 6, 7); \
        else { _Pragma("unroll") for (int k = 0; k < 2; ++k) dst[m][k] = *(const LAS bf16x8*)(lds + PG8_SA(b, h) + aoff + m * 2048 + k * 1024); } } } while (0)
#define PG8_LDB(dst, b, h) do { _Pragma("unroll") for (int n = 0; n < 2; ++n) { if constexpr (FP8) dst##8[n] = __builtin_shufflevector(*(const LAS i32x4_*)(lds + PG8_SB(b, h) + boff + n * 2048), *(const LAS i32x4_*)(lds + PG8_SB(b, h) + boff + n * 2048 + 1024), 0, 1, 2, 3, 4, 5, 6, 7); \
        else { _Pragma("unroll") for (int k = 0; k < 2; ++k) dst[n][k] = *(const LAS bf16x8*)(lds + PG8_SB(b, h) + boff + n * 2048 + k * 1024); } } } while (0)
typedef int i32x4_ __attribute__((ext_vector_type(4)));
#define PG8_MMA(ai, bj, At, Bt) do { __builtin_amdgcn_s_setprio(1); _Pragma("unroll") for (int m = 0; m < 4; ++m) _Pragma("unroll") for (int n = 0; n < 2; ++n) { \
        if constexpr (FP8) asm volatile("v_mfma_scale_f32_16x16x128_f8f6f4 %0, %1, %2, %0, %3, %3 op_sel_hi:[0,0,0]" : "+v"(acc[ai][bj][m][n]) : "v"(Bt##8[n]), "v"(At##8[m]), "v"(one_scale)); \
        else { _Pragma("unroll") for (int k = 0; k < 2; ++k) acc[ai][bj][m][n] = __builtin_amdgcn_mfma_f32_16x16x32_bf16(Bt[n][k], At[m][k], acc[ai][bj][m][n], 0, 0, 0); } } \
        __builtin_amdgcn_s_setprio(0); } while (0)
#define PG8_WAIT_V(n) asm volatile("s_waitcnt vmcnt(" #n ")" ::: "memory")
#define PG8_WAIT_L(n) asm volatile("s_waitcnt lgkmcnt(" #n ")" ::: "memory")
#define PG8_BAR __builtin_amdgcn_s_barrier()
#define PG8_SCHED __builtin_amdgcn_sched_barrier(0)
    Unit cur, nxt; int ui = 0;
    if (!S.next(0, cur)) return;
    f32x4 acc[2][2][4][2];
#pragma unroll
    for (int a = 0; a < 2; ++a)
#pragma unroll
        for (int b = 0; b < 2; ++b)
#pragma unroll
            for (int m = 0; m < 4; ++m)
#pragma unroll
                for (int n = 0; n < 2; ++n) acc[a][b][m][n] = (f32x4){0.f, 0.f, 0.f, 0.f};
    bf16x8 At[4][2], B0[2][2], B1[2][2];
    i32x8 At8[4], B08[2], B18[2];
    const int one_scale = 0x7F7F7F7F;
    const char* cA = (const char*)g.A + (size_t)cur.pm * tstepA + (size_t)cur.kofs * 2; const char* cB = (const char*)g.Bt + (size_t)cur.pn * tstepB + (size_t)cur.kofs * 2;
    PG8_STAGE(PG8_SB(0, 0), cB, voffB); PG8_STAGE(PG8_SB(0, 1), cB + hstepB, voffB); PG8_STAGE(PG8_SA(0, 0), cA, voffA); PG8_STAGE(PG8_SA(0, 1), cA + hstepA, voffA);
    if (wr == 1) PG8_BAR;
    PG8_WAIT_V(2); PG8_BAR;
    PG8_STAGE(PG8_SB(1, 0), cB + kstep, voffB); PG8_STAGE(PG8_SA(1, 0), cA + kstep, voffA); PG8_STAGE(PG8_SB(1, 1), cB + hstepB + kstep, voffB);
    PG8_WAIT_V(6); PG8_BAR;
    for (;;) {
        const bool has_next = S.next(ui + 1, nxt);
        const char* nA = has_next ? (const char*)g.A + (size_t)nxt.pm * tstepA + (size_t)nxt.kofs * 2 : cA; const char* nB = has_next ? (const char*)g.Bt + (size_t)nxt.pn * tstepB + (size_t)nxt.kofs * 2 : cB;
        for (int t = 0; t < nt; t += 2) {
            const bool last = (t == nt - 2);
            const char* a1 = cA + (size_t)(t + 1) * kstep;
            const char* a2 = last ? nA : cA + (size_t)(t + 2) * kstep; const char* b2 = last ? nB : cB + (size_t)(t + 2) * kstep;
            const char* a3 = a2 + kstep; const char* b3 = b2 + kstep;
            PG8_LDB(B0, 0, 0); PG8_LDB(B1, 0, 1); PG8_SCHED; PG8_LDA(At, 0, 0); PG8_STAGE(PG8_SA(1, 1), a1 + hstepA, voffA);
            PG8_WAIT_V(8); PG8_WAIT_L(0); PG8_BAR; PG8_MMA(0, 0, At, B0); PG8_MMA(0, 1, At, B1); PG8_BAR; PG8_SCHED;
            PG8_LDA(At, 0, 1); PG8_STAGE(PG8_SB(0, 0), b2, voffB); PG8_STAGE(PG8_SB(0, 1), b2 + hstepB, voffB); PG8_STAGE(PG8_SA(0, 0), a2, voffA);
            PG8_WAIT_V(8); PG8_WAIT_L(0); PG8_BAR; PG8_MMA(1, 0, At, B0); PG8_MMA(1, 1, At, B1); PG8_BAR; PG8_SCHED;
            PG8_LDB(B0, 1, 0); PG8_LDB(B1, 1, 1); PG8_SCHED; PG8_LDA(At, 1, 0); PG8_STAGE(PG8_SA(0, 1), a2 + hstepA, voffA);
            PG8_WAIT_V(8); PG8_WAIT_L(0); PG8_BAR; PG8_MMA(0, 0, At, B0); PG8_MMA(0, 1, At, B1); PG8_BAR; PG8_SCHED;
            PG8_LDA(At, 1, 1); PG8_STAGE(PG8_SB(1, 0), b3, voffB); PG8_STAGE(PG8_SB(1, 1), b3 + hstepB, voffB); PG8_STAGE(PG8_SA(1, 0), a3, voffA);
            PG8_WAIT_V(8); PG8_WAIT_L(0); PG8_BAR; PG8_MMA(1, 0, At, B0); PG8_MMA(1, 1, At, B1); PG8_BAR; PG8_SCHED;
        }
        if (wr == 0) PG8_BAR;
        if constexpr (FP8) asm volatile("s_nop 15\n\ts_nop 15\n\ts_nop 15" ::: "memory");
        E(acc, cur, wr, wc, fr, fq);
        if (!has_next) break;
#pragma unroll
        for (int a = 0; a < 2; ++a)
#pragma unroll
            for (int b = 0; b < 2; ++b)
#pragma unroll
                for (int m = 0; m < 4; ++m)
#pragma unroll
                    for (int n = 0; n < 2; ++n) acc[a][b][m][n] = (f32x4){0.f, 0.f, 0.f, 0.f};
        cur = nxt; cA = nA; cB = nB; ++ui;
        if (wr == 1) PG8_BAR;
    }
    PG8_WAIT_V(0);
    PG8_BAR;
#undef PG8_SA
#undef PG8_SB
#undef PG8_STAGE
#undef PG8_LDA
#undef PG8_LDB
#undef PG8_MMA
#undef PG8_WAIT_V
#undef PG8_WAIT_L
#undef PG8_BAR
#undef PG8_SCHED
}
}

struct Args { const float* in[27]; float* out; unsigned char* ws; int ph_lo, ph_hi; };
struct Ctx { const float* const* in; float* out; unsigned char* ws; LAS unsigned char* lds; int tid, lane, wave; };

enum { I_X = 0, I_C, I_RELB, I_WADA, I_BADA, I_GMIX, I_WIN, I_GQA, I_GKA, I_GQB, I_GKCMP, I_GKSLC, I_GKWIN, I_PEK, I_W1K, I_W2K, I_PEV, I_W1V, I_W2V,
       I_WBA, I_WBB, I_WOUT, I_GFFN, I_WPQ, I_SUBK, I_PU, I_PV };

__device__ __forceinline__ int map_col(int c) {
    if (c < 5120) return c; if (c < 10240) return c + 96; if (c < 10336) return c - 5120; if (c < 10384) return c; if (c < 10496) return -1; return c - 112;
}

template <bool REMAP>
__device__ __forceinline__ void tconv_tile(const Ctx& C, const float* src, int srcN, bf16_t* dst, int dstK, int n0, int k0) {
    LAS float* tile = (LAS float*)C.lds;
    const int tx = C.tid & 31, ty = C.tid >> 5;
    const int nn = n0 + 4 * tx; const int sc = REMAP ? map_col(nn) : nn;
    f32x4 v[8];
#pragma unroll
    for (int i = 0; i < 8; ++i) { const int k = ty + 16 * i; v[i] = (sc >= 0) ? *(const f32x4*)(src + (size_t)(k0 + k) * srcN + sc) : (f32x4){0.f, 0.f, 0.f, 0.f}; }
#pragma unroll
    for (int i = 0; i < 8; ++i) { const int k = ty + 16 * i; LAS float* q = tile + k * 129 + 4 * tx; q[0] = v[i][0]; q[1] = v[i][1]; q[2] = v[i][2]; q[3] = v[i][3]; }
    __syncthreads();
#pragma unroll
    for (int i = 0; i < 4; ++i) { const int task = C.tid + 512 * i; const int nl = task >> 4, kc = task & 15;
        float e[8];
#pragma unroll
        for (int j = 0; j < 8; ++j) e[j] = tile[(kc * 8 + j) * 129 + nl];
        u32x4 w; w.x = cvt_pk_bf16(e[0], e[1]); w.y = cvt_pk_bf16(e[2], e[3]); w.z = cvt_pk_bf16(e[4], e[5]); w.w = cvt_pk_bf16(e[6], e[7]);
        *(u32x4*)(dst + (size_t)(n0 + nl) * dstK + k0 + kc * 8) = w; }
    __syncthreads();
}

template <bool REMAP>
__device__ __forceinline__ void tconv_tile_f8(const Ctx& C, const float* src, int srcN, unsigned char* dst, int dstK, int n0, int k0) {
    LAS float* tile = (LAS float*)C.lds;
    const int tx = C.tid & 31, ty = C.tid >> 5;
    const int nn = n0 + 4 * tx; const int sc = REMAP ? map_col(nn) : nn;
    f32x4 v[8];
#pragma unroll
    for (int i = 0; i < 8; ++i) { const int k = ty + 16 * i; v[i] = (sc >= 0) ? *(const f32x4*)(src + (size_t)(k0 + k) * srcN + sc) : (f32x4){0.f, 0.f, 0.f, 0.f}; }
#pragma unroll
    for (int i = 0; i < 8; ++i) { const int k = ty + 16 * i; LAS float* q = tile + k * 129 + 4 * tx; q[0] = v[i][0]; q[1] = v[i][1]; q[2] = v[i][2]; q[3] = v[i][3]; }
    __syncthreads();
#pragma unroll
    for (int i = 0; i < 2; ++i) { const int task = C.tid + 512 * i; const int nl = task >> 3, kc = task & 7;
        float e[16];
#pragma unroll
        for (int j = 0; j < 16; ++j) e[j] = tile[(kc * 16 + j) * 129 + nl] * 64.f;
        u32x4 w;
#pragma unroll
        for (int q4 = 0; q4 < 4; ++q4) { int p = __builtin_amdgcn_cvt_pk_fp8_f32(e[4 * q4], e[4 * q4 + 1], 0, false); p = __builtin_amdgcn_cvt_pk_fp8_f32(e[4 * q4 + 2], e[4 * q4 + 3], p, true); w[q4] = (unsigned)p; }
        *(u32x4*)(dst + (size_t)(n0 + nl) * dstK + k0 + kc * 16) = w; }
    __syncthreads();
}

__device__ __forceinline__ void wq_subkey_tile(const Ctx& C, int blk, int k0) {
    LAS float* As = (LAS float*)C.lds;
    LAS float* Bs = As + 128 * 132;
    const int tid = C.tid;
    const float* sk = C.in[I_SUBK] + (size_t)blk * 128 * 128; const float* wq = C.in[I_WPQ] + (size_t)k0 * 2048 + blk * 128;
#pragma unroll
    for (int i = 0; i < 8; ++i) { const int idx = tid + 512 * i, r = idx >> 5, c4 = idx & 31;
        const f32x4 a = *(const f32x4*)(sk + (size_t)r * 128 + 4 * c4), b = *(const f32x4*)(wq + (size_t)r * 2048 + 4 * c4);
        *(LAS f32x4*)(As + r * 132 + 4 * c4) = a; *(LAS f32x4*)(Bs + r * 132 + 4 * c4) = b; }
    __syncthreads();
    const int tn = tid >> 4, tk = tid & 15;
    float acc[4][8];
#pragma unroll
    for (int i = 0; i < 4; ++i)
#pragma unroll
        for (int j = 0; j < 8; ++j) acc[i][j] = 0.f;
#pragma unroll 2
    for (int d4 = 0; d4 < 32; ++d4) {
        f32x4 a[4], b[8];
#pragma unroll
        for (int i = 0; i < 4; ++i) a[i] = *(LAS const f32x4*)(As + (4 * tn + i) * 132 + 4 * d4);
#pragma unroll
        for (int j = 0; j < 8; ++j) b[j] = *(LAS const f32x4*)(Bs + (2 * tk + 32 * (j >> 1) + (j & 1)) * 132 + 4 * d4);
#pragma unroll
        for (int i = 0; i < 4; ++i)
#pragma unroll
            for (int j = 0; j < 8; ++j) acc[i][j] += a[i][0] * b[j][0] + a[i][1] * b[j][1] + a[i][2] * b[j][2] + a[i][3] * b[j][3];
    }
    bf16_t* dst = (bf16_t*)(C.ws + WS_WQ) + (size_t)(blk * 128 + 4 * tn) * 4096 + k0 + 2 * tk;
#pragma unroll
    for (int i = 0; i < 4; ++i)
#pragma unroll
        for (int j = 0; j < 4; ++j) *(unsigned*)(dst + (size_t)i * 4096 + 32 * j) = cvt_pk_bf16(acc[i][2 * j], acc[i][2 * j + 1]);
    __syncthreads();
}

__device__ __forceinline__ void peer_row_convert(const Ctx& C, int grow, int lane) {
            const bool second = grow >= 16384; const int row = grow & 16383;
            const float* src = C.in[second ? I_PV : I_PU] + (size_t)row * 4096;
            unsigned char* dst6 = C.ws + (second ? WS_PV : WS_PU) + (size_t)row * 3072;
            f32x16 v[4]; float am = 0.f;
#pragma unroll
            for (int i4 = 0; i4 < 4; ++i4)
#pragma unroll
                for (int q = 0; q < 4; ++q) { const f32x4 t4 = *(const f32x4*)(src + 16 * (lane + 64 * i4) + 4 * q);
                    v[i4][4 * q] = t4[0]; v[i4][4 * q + 1] = t4[1]; v[i4][4 * q + 2] = t4[2]; v[i4][4 * q + 3] = t4[3];
                    am = fmaxf(am, fmaxf(fmaxf(fabsf(t4[0]), fabsf(t4[1])), fmaxf(fabsf(t4[2]), fabsf(t4[3])))); }
            am = wave_max(am);
            const float sc = am > 0.f ? am * (1.f / 7.f) : 1.f, inv = 1.f / sc;
#pragma unroll
            for (int i4 = 0; i4 < 4; ++i4) v[i4] *= inv;
            const u32x6 pa = __builtin_amdgcn_cvt_scalef32_2xpk16_fp6_f32(v[0], v[1], 1.0f), pb = __builtin_amdgcn_cvt_scalef32_2xpk16_fp6_f32(v[2], v[3], 1.0f);
            *(u32x4*)(dst6 + 16 * lane) = (u32x4){pa[0], pa[1], pa[2], pa[3]};
            *(u32x4*)(dst6 + 1024 + 16 * lane) = (u32x4){pa[4], pa[5], pb[0], pb[1]};
            *(u32x4*)(dst6 + 2048 + 16 * lane) = (u32x4){pb[2], pb[3], pb[4], pb[5]};
            ((float*)(C.ws + (second ? WS_PV : WS_PU) + 96 * MB))[row] = sc;
            { float al = 0.f;
#pragma unroll
              for (int i4 = 0; i4 < 4; ++i4)
#pragma unroll
                  for (int j = 0; j < 16; ++j) al = fmaxf(al, fabsf(v[i4][j]));
              const float s4 = al > 0.f ? al * (1.f / 6.f) : 1.f, inv4 = 1.f / s4;
              unsigned wa[4] = {0u, 0u, 0u, 0u}, wb[4] = {0u, 0u, 0u, 0u};
#define PK4(d_) do { wa[d_] = __builtin_amdgcn_cvt_scalef32_pk_fp4_f32(wa[d_], v[0][4 * (d_)] * inv4, v[1][4 * (d_)] * inv4, 1.0f, 0); wa[d_] = __builtin_amdgcn_cvt_scalef32_pk_fp4_f32(wa[d_], v[0][4 * (d_) + 1] * inv4, v[1][4 * (d_) + 1] * inv4, 1.0f, 1); \
                     wa[d_] = __builtin_amdgcn_cvt_scalef32_pk_fp4_f32(wa[d_], v[0][4 * (d_) + 2] * inv4, v[1][4 * (d_) + 2] * inv4, 1.0f, 2); wa[d_] = __builtin_amdgcn_cvt_scalef32_pk_fp4_f32(wa[d_], v[0][4 * (d_) + 3] * inv4, v[1][4 * (d_) + 3] * inv4, 1.0f, 3); \
                     wb[d_] = __builtin_amdgcn_cvt_scalef32_pk_fp4_f32(wb[d_], v[2][4 * (d_)] * inv4, v[3][4 * (d_)] * inv4, 1.0f, 0); wb[d_] = __builtin_amdgcn_cvt_scalef32_pk_fp4_f32(wb[d_], v[2][4 * (d_) + 1] * inv4, v[3][4 * (d_) + 1] * inv4, 1.0f, 1); \
                     wb[d_] = __builtin_amdgcn_cvt_scalef32_pk_fp4_f32(wb[d_], v[2][4 * (d_) + 2] * inv4, v[3][4 * (d_) + 2] * inv4, 1.0f, 2); wb[d_] = __builtin_amdgcn_cvt_scalef32_pk_fp4_f32(wb[d_], v[2][4 * (d_) + 3] * inv4, v[3][4 * (d_) + 3] * inv4, 1.0f, 3); } while (0)
              PK4(0); PK4(1); PK4(2); PK4(3);
#undef PK4
              unsigned char* dst4 = C.ws + (second ? WS_PV4 : WS_PU4) + (size_t)row * 2176;
              *(u32x4*)(dst4 + 16 * lane) = (u32x4){wa[0], wa[1], wa[2], wa[3]};
              *(u32x4*)(dst4 + 1024 + 16 * lane) = (u32x4){wb[0], wb[1], wb[2], wb[3]};
              *(bf16_t*)(dst4 + 2048 + 2 * lane) = f2bf(sc * s4); }

}

__device__ __forceinline__ void p0_prologue(const Ctx& C) {
    constexpr int N_MOD = 256, N_WIN = (NP / 128) * (D / 128), N_W1 = 2 * 32, N_B1 = 64;
    constexpr int E0 = N_MOD, E1 = E0 + N_B1, E2 = E1 + N_WIN, E7 = E2 + N_W1, E8 = E7 + N_W1, E11 = E8;
    const int tid = C.tid;
    for (int it = blockIdx.x; it < E11; it += gridDim.x) {
        if (it < E0) {
            const int b = it; LAS float* red = (LAS float*)C.lds;
            const float* cvec = C.in[I_C]; const float* w = C.in[I_WADA];
            if (tid < 504) { const int cg = tid % 24, rs = tid / 24;
                f32x4 acc = {0.f, 0.f, 0.f, 0.f};
                const float* wp = w + 96 * b + 4 * cg;
#pragma unroll 4
                for (int k = rs; k < D; k += 21) { const float cv = cvec[k]; const f32x4 wv = *(const f32x4*)(wp + (size_t)k * 24576); acc += cv * wv; }
                *(LAS f32x4*)(red + (rs * 24 + cg) * 4) = acc; }
            __syncthreads();
            if (tid < 24) { f32x4 s = *(const f32x4*)(C.in[I_BADA] + 96 * b + 4 * tid);
                for (int rs = 0; rs < 21; ++rs) s += *(LAS f32x4*)(red + (rs * 24 + tid) * 4);
                *(f32x4*)((float*)(C.ws + WS_MOD) + 96 * b + 4 * tid) = s; }
            __syncthreads();
        } else if (it < E1) {
            const int s = (it - E0) >> 5, sl = (it - E0) & 31; const float* pe = C.in[s ? I_PEV : I_PEK]; const float* w1 = C.in[s ? I_W1V : I_W1K];
            const int e = tid & 255, half = tid >> 8; float a = 0.f;
            const int kb = sl * 128 + half * 64;
#pragma unroll 16
            for (int k = kb; k < kb + 64; ++k) a += pe[k] * w1[(size_t)k * 256 + e];
            LAS float* red = (LAS float*)C.lds; red[tid] = a; __syncthreads();
            if (tid < 256) ((float*)(C.ws + WS_B1P))[(s * 32 + sl) * 256 + tid] = red[tid] + red[tid + 256];
            __syncthreads();
        } else if (it < E2) { const int i = it - E1; const int n0 = (i / 32) * 128, k0 = (i % 32) * 128;
            if (n0 < NP_BF) tconv_tile<true>(C, C.in[I_WIN], 18576, (bf16_t*)(C.ws + WS_WIN), D, n0, k0);
            else tconv_tile_f8<true>(C, C.in[I_WIN], 18576, C.ws + WS_WIN8 - (size_t)NP_BF * D, D, n0, k0);
        } else if (it < E7) { const int i = it - E2; tconv_tile<false>(C, C.in[I_W1K], 256, (bf16_t*)(C.ws + WS_W1T), 4096, (i / 32) * 128, (i % 32) * 128);
        } else if (it < E8) { const int i = it - E7; tconv_tile<false>(C, C.in[I_W1V], 256, (bf16_t*)(C.ws + WS_W1T) + (size_t)256 * 4096, 4096, (i / 32) * 128, (i % 32) * 128);
        }
    }
}

__device__ __forceinline__ void norm_mod_phase(const Ctx& C, const float* xin, const float* gain, const float* sh, const float* sc, bf16_t* hout, unsigned char* h8out = nullptr) {
    LAS float* la = (LAS float*)C.lds; LAS float* lb = la + D;
    for (int i = C.tid; i < D / 4; i += NTHREADS) { const f32x4 g4 = *(const f32x4*)(gain + 4 * i), s4 = *(const f32x4*)(sc + 4 * i), h4 = *(const f32x4*)(sh + 4 * i);
        *(LAS f32x4*)(la + 4 * i) = g4 * (s4 + 1.f); *(LAS f32x4*)(lb + 4 * i) = h4; }
    __syncthreads();
    const int rstep = gridDim.x * 8;
    int row = blockIdx.x * 8 + C.wave;
    f32x4 v[16], vn[16];
    if (row < T) {
#pragma unroll
        for (int i = 0; i < 16; ++i) v[i] = ((const f32x4*)(xin + (size_t)row * D))[C.lane + 64 * i]; }
#pragma unroll 1
    for (; row < T; row += rstep) {
        const int nrow = row + rstep;
        if (nrow < T) {
#pragma unroll
            for (int i = 0; i < 16; ++i) vn[i] = ((const f32x4*)(xin + (size_t)nrow * D))[C.lane + 64 * i]; }
        float ss = 0.f;
#pragma unroll
        for (int i = 0; i < 16; ++i) ss += v[i][0] * v[i][0] + v[i][1] * v[i][1] + v[i][2] * v[i][2] + v[i][3] * v[i][3];
        ss = wave_sum(ss);
        const float rstd = rsqrtf(ss * (1.f / 4096.f) + EPS);
#pragma unroll
        for (int i = 0; i < 16; ++i) { const int col = 4 * (C.lane + 64 * i);
            const f32x4 a4 = *(LAS const f32x4*)(la + col), b4 = *(LAS const f32x4*)(lb + col);
            float y[4];
#pragma unroll
            for (int j = 0; j < 4; ++j) y[j] = v[i][j] * rstd * a4[j] + b4[j];
            u32x2 w; w.x = cvt_pk_bf16(y[0], y[1]); w.y = cvt_pk_bf16(y[2], y[3]);
            *(u32x2*)(hout + (size_t)row * D + col) = w;
            if (h8out) { int p = __builtin_amdgcn_cvt_pk_fp8_f32(y[0], y[1], 0, false); p = __builtin_amdgcn_cvt_pk_fp8_f32(y[2], y[3], p, true); *(unsigned*)(h8out + (size_t)row * D + col) = (unsigned)p; } }
#pragma unroll
        for (int i = 0; i < 16; ++i) v[i] = vn[i];
    }
    __syncthreads();
}

__device__ __forceinline__ void p3_post(const Ctx& C) {
    bf16_t* proj = (bf16_t*)(C.ws + WS_PROJ);
    const int tid = C.tid;
    const float qscale = 0.08838834764831845f;
    if (blockIdx.x == 0) { float a = 0.f; const float* part = (const float*)(C.ws + WS_B1P) + (size_t)(tid >> 8) * 32 * 256 + (tid & 255);
        for (int sl = 0; sl < 32; ++sl) a += part[sl * 256]; ((float*)(C.ws + WS_B1))[tid] = a; }
    for (int item = blockIdx.x; item < T / 64; item += gridDim.x) {
        const int t0 = item * 64;
#pragma unroll 1
        for (int hb = tid >> 4; hb < 64 * 44; hb += 128) {
            const int l16 = tid & 15;
            u32x4 raw[4]; bf16_t* dstp[4]; const float* gain[4]; float scl[4]; bool isk8[4];
#pragma unroll
            for (int u = 0; u < 4; ++u) { const int hr = hb + 32 * u; const int tok = hr / 44, hh = hr % 44; int col; isk8[u] = (hh >= 16 && hh < 20);
                if (hh < 16) { col = P_QA + 128 * hh; gain[u] = C.in[I_GQA]; scl[u] = qscale; dstp[u] = proj + (size_t)(t0 + tok) * NP + col; }
                else if (hh < 20) { col = P_KA + 128 * (hh - 16); gain[u] = C.in[I_GKA]; scl[u] = 1.f; dstp[u] = (bf16_t*)(C.ws + WS_KA + (size_t)(t0 + tok) * 512 + 128 * (hh - 16)); }
                else if (hh < 36) { col = P_QB + 128 * (hh - 20); gain[u] = C.in[I_GQB]; scl[u] = qscale * 1.4426950408889634f; dstp[u] = proj + (size_t)(t0 + tok) * NP + col; }
                else if (hh < 40) { col = P_KS + 128 * (hh - 36); gain[u] = C.in[I_GKSLC]; scl[u] = 1.f; dstp[u] = (bf16_t*)(C.ws + WS_KSC) + ((size_t)(hh - 36) * T + t0 + tok) * 128; }
                else { col = P_KW + 128 * (hh - 40); gain[u] = C.in[I_GKWIN]; scl[u] = 1.f; dstp[u] = (bf16_t*)(C.ws + WS_KWC) + ((size_t)(hh - 40) * T + t0 + tok) * 128; }
                raw[u] = *(const u32x4*)(proj + (size_t)(t0 + tok) * NP + col + 8 * l16); }
#pragma unroll
            for (int u = 0; u < 4; ++u) {
                float v[8] = {bflo(raw[u].x), bfhi(raw[u].x), bflo(raw[u].y), bfhi(raw[u].y), bflo(raw[u].z), bfhi(raw[u].z), bflo(raw[u].w), bfhi(raw[u].w)};
                float ss = 0.f;
#pragma unroll
                for (int j = 0; j < 8; ++j) ss += v[j] * v[j];
                ss += dppf<0xB1>(ss); ss += dppf<0x4E>(ss); ss += dppf<0x141>(ss); ss += dppf<0x140>(ss);
                const float rstd = rsqrtf(ss * (1.f / 128.f) + EPS) * scl[u];
                const f32x4 g0 = *(const f32x4*)(gain[u] + 8 * l16), g1 = *(const f32x4*)(gain[u] + 8 * l16 + 4);
                if (isk8[u]) {
                    const float r8 = rstd * 64.f;
                    int p0 = __builtin_amdgcn_cvt_pk_fp8_f32(v[0] * r8 * g0[0], v[1] * r8 * g0[1], 0, false); p0 = __builtin_amdgcn_cvt_pk_fp8_f32(v[2] * r8 * g0[2], v[3] * r8 * g0[3], p0, true);
                    int p1 = __builtin_amdgcn_cvt_pk_fp8_f32(v[4] * r8 * g1[0], v[5] * r8 * g1[1], 0, false); p1 = __builtin_amdgcn_cvt_pk_fp8_f32(v[6] * r8 * g1[2], v[7] * r8 * g1[3], p1, true);
                    *(u32x2*)((unsigned char*)dstp[u] + 8 * l16) = (u32x2){(unsigned)p0, (unsigned)p1};
                } else {
                u32x4 w; w.x = cvt_pk_bf16(v[0] * rstd * g0[0], v[1] * rstd * g0[1]); w.y = cvt_pk_bf16(v[2] * rstd * g0[2], v[3] * rstd * g0[3]);
                w.z = cvt_pk_bf16(v[4] * rstd * g1[0], v[5] * rstd * g1[1]); w.w = cvt_pk_bf16(v[6] * rstd * g1[2], v[7] * rstd * g1[3]);
                *(u32x4*)(dstp[u] + 8 * l16) = w; } }
        }
        bf16_t* Kc = (bf16_t*)(C.ws + WS_KC); bf16_t* Vc = Kc + (size_t)4 * T * 128;
#pragma unroll
        for (int i = 0; i < 8; ++i) { const int idx = tid + 512 * i, tok = idx >> 6, c16 = idx & 63, g = c16 >> 4, d8 = c16 & 15;
            const bf16_t* src = proj + (size_t)(t0 + tok) * NP + 8 * c16;
            const size_t dof = ((size_t)g * T + t0 + tok) * 128 + 8 * d8;
            *(u32x4*)(Kc + dof) = *(const u32x4*)(src + P_KC);
            *(u32x4*)(Vc + dof) = *(const u32x4*)(src + P_VC);
            { const u32x4 rv = *(const u32x4*)(src + P_VA);
              u32x4 w;
              w.x = __builtin_bit_cast(unsigned, __builtin_amdgcn_cvt_pkrtz(bflo(rv.x), bfhi(rv.x))); w.y = __builtin_bit_cast(unsigned, __builtin_amdgcn_cvt_pkrtz(bflo(rv.y), bfhi(rv.y)));
              w.z = __builtin_bit_cast(unsigned, __builtin_amdgcn_cvt_pkrtz(bflo(rv.z), bfhi(rv.z))); w.w = __builtin_bit_cast(unsigned, __builtin_amdgcn_cvt_pkrtz(bflo(rv.w), bfhi(rv.w)));
              *(u32x4*)(C.ws + WS_VA + ((size_t)(t0 + tok) * 512 + 8 * c16) * 2) = w; } }
        { const int tok = tid >> 3, c8 = tid & 7;
          *(u32x4*)((bf16_t*)(C.ws + WS_KIC) + (size_t)(t0 + tok) * 64 + 8 * c8) = *(const u32x4*)(proj + (size_t)(t0 + tok) * NP + P_KI + 8 * c8); }
#pragma unroll 1
        for (int which = 0; which < 2; ++which) {
            const int pcol = which ? P_VW : P_VS; bf16_t* dstT = (bf16_t*)(C.ws + (which ? WS_VWT : WS_VST));
            LAS unsigned* tl = (LAS unsigned*)C.lds;
#pragma unroll
            for (int i = 0; i < 8; ++i) { const int idx = tid + 512 * i, tok = idx >> 6, c16 = idx & 63;
                const u32x4 v = *(const u32x4*)(proj + (size_t)(t0 + tok) * NP + pcol + 8 * c16);
                LAS unsigned* q = tl + tok * 257 + 4 * c16; q[0] = v.x; q[1] = v.y; q[2] = v.z; q[3] = v.w; }
            __syncthreads();
#pragma unroll
            for (int i = 0; i < 8; ++i) { const int task = tid + 512 * i, col = task >> 3, tc = task & 7;
                unsigned short e[8];
#pragma unroll
                for (int j = 0; j < 8; ++j) { const unsigned dw = tl[(8 * tc + j) * 257 + (col >> 1)]; e[j] = (col & 1) ? (unsigned short)(dw >> 16) : (unsigned short)(dw & 0xFFFFu); }
                u32x4 w; w.x = e[0] | ((unsigned)e[1] << 16); w.y = e[2] | ((unsigned)e[3] << 16); w.z = e[4] | ((unsigned)e[5] << 16); w.w = e[6] | ((unsigned)e[7] << 16);
                *(u32x4*)(dstT + (size_t)col * T + t0 + 8 * tc) = w; }
            __syncthreads();
        }
    }
}

__device__ __forceinline__ void p5_cmp_out(const Ctx& C) {
    const float* part = (const float*)(C.ws + WS_HIDP); const float* b1 = (const float*)(C.ws + WS_B1);
    bf16_t* kcmp = (bf16_t*)(C.ws + WS_KCMP); bf16_t* vcT = (bf16_t*)(C.ws + WS_VCMPT);
    LAS float* hl = (LAS float*)(C.lds) + C.wave * 1024;
    const int lane = C.lane;
    for (int grp = blockIdx.x * 8 + C.wave; grp < 2048; grp += gridDim.x * 8) {
        const int R0 = grp * 4; const bool isv = R0 >= 4096;
        lds_sync();
        const f32x4 bb = *(const f32x4*)(b1 + (isv ? 256 : 0) + 4 * lane);
#pragma unroll
        for (int r = 0; r < 4; ++r) { f32x4 a = bb;
#pragma unroll
            for (int ks = 0; ks < 8; ++ks) a += *(const f32x4*)(part + ((size_t)ks * 8192 + R0 + r) * 256 + 4 * lane);
            f32x4 hg; hg[0] = gelu_tanh(a[0]); hg[1] = gelu_tanh(a[1]); hg[2] = gelu_tanh(a[2]); hg[3] = gelu_tanh(a[3]);
            *(LAS f32x4*)(hl + r * 256 + 4 * lane) = hg; }
        lds_sync();
        const float* w2 = C.in[isv ? I_W2V : I_W2K];
        float acc[4][2];
#pragma unroll
        for (int r = 0; r < 4; ++r) { acc[r][0] = 0.f; acc[r][1] = 0.f; }
#pragma unroll 8
        for (int e = 0; e < 256; ++e) { const float2 wv = *(const float2*)(w2 + e * 128 + 2 * lane);
#pragma unroll
            for (int r = 0; r < 4; ++r) { const float hv = hl[r * 256 + e]; acc[r][0] += hv * wv.x; acc[r][1] += hv * wv.y; } }
#pragma unroll
        for (int r = 0; r < 4; ++r) { const int R = R0 + r, Rl = R & 4095, g = Rl >> 10, n = Rl & 1023;
            const float a0 = (n < NCMP) ? acc[r][0] : 0.f, a1 = (n < NCMP) ? acc[r][1] : 0.f;
            if (!isv) { const float ss = wave_sum(a0 * a0 + a1 * a1); const float rstd = rsqrtf(ss * (1.f / 128.f) + EPS);
                const float2 gg = *(const float2*)(C.in[I_GKCMP] + 2 * lane);
                *(unsigned*)(kcmp + (size_t)Rl * 128 + 2 * lane) = (n < NCMP) ? cvt_pk_bf16(a0 * rstd * gg.x, a1 * rstd * gg.y) : 0u; }
            else { vcT[((size_t)g * 128 + 2 * lane) * 1024 + n] = f2bf(a0); vcT[((size_t)g * 128 + 2 * lane + 1) * 1024 + n] = f2bf(a1); } }
    }
}

constexpr int P6_WAVE_LDS = 18432, P6_SHARED = 8192;
__device__ __forceinline__ f32x16 mfma32(bf16x8 a, bf16x8 b, f32x16 c) { return __builtin_amdgcn_mfma_f32_32x32x16_bf16(a, b, c, 0, 0, 0); }
__device__ __forceinline__ int swap23(int r) { return (r & 0x13) | ((r & 4) << 1) | ((r & 8) >> 1); }

__device__ __forceinline__ void topk_prune(LAS u64* buf, int& cnt, u64& tau, LAS unsigned* hist, int lane) {
    u64 e[8];
#pragma unroll
    for (int i = 0; i < 8; ++i) { const int idx = lane + 64 * i; e[i] = idx < cnt ? buf[idx] : 0ull; }
    u64 prefix = 0ull; unsigned need = 256u;
    const u64 lt = (1ull << lane) - 1ull;
#pragma unroll 1
    for (int p = 0; p < 6; ++p) {
        const int shift = 40 - 8 * p;
        *(LAS u32x4*)(hist + 4 * lane) = (u32x4){0u, 0u, 0u, 0u};
        lds_sync();
#pragma unroll
        for (int i = 0; i < 8; ++i) { const bool m = (e[i] != 0ull) && ((e[i] >> (shift + 8)) == (prefix >> (shift + 8)));
            if (m) __hip_atomic_fetch_add(hist + (unsigned)((e[i] >> shift) & 255ull), 1u, __ATOMIC_RELAXED, __HIP_MEMORY_SCOPE_WORKGROUP); }
        lds_sync();
        const u32x4 c = *(LAS u32x4*)(hist + 4 * lane);
        const unsigned tot = c.x + c.y + c.z + c.w;
        unsigned pre = tot;
        pre += (unsigned)__builtin_amdgcn_update_dpp(0, (int)pre, 0x111, 0xF, 0xF, true); pre += (unsigned)__builtin_amdgcn_update_dpp(0, (int)pre, 0x112, 0xF, 0xF, true);
        pre += (unsigned)__builtin_amdgcn_update_dpp(0, (int)pre, 0x114, 0xF, 0xF, true); pre += (unsigned)__builtin_amdgcn_update_dpp(0, (int)pre, 0x118, 0xF, 0xF, true);
        const unsigned r0 = (unsigned)__builtin_amdgcn_readlane((int)pre, 15), r1 = (unsigned)__builtin_amdgcn_readlane((int)pre, 31), r2 = (unsigned)__builtin_amdgcn_readlane((int)pre, 47), r3 = (unsigned)__builtin_amdgcn_readlane((int)pre, 63);
        const int row = lane >> 4;
        pre += (row == 1) ? r0 : (row == 2) ? (r0 + r1) : (row == 3) ? (r0 + r1 + r2) : 0u;
        const unsigned a3 = (r0 + r1 + r2 + r3) - pre, a2 = a3 + c.w, a1 = a2 + c.z, a0 = a1 + c.y;
        int found = -1; unsigned above = 0u;
        if (a3 < need && need <= a3 + c.w) { found = 3; above = a3; }
        else if (a2 < need && need <= a2 + c.z) { found = 2; above = a2; }
        else if (a1 < need && need <= a1 + c.y) { found = 1; above = a1; }
        else if (a0 < need && need <= a0 + c.x) { found = 0; above = a0; }
        const u64 bm = __ballot(found >= 0);
        const int src = bm ? (__ffsll((long long)bm) - 1) : 0;
        const int bin = __builtin_amdgcn_readlane(4 * lane + found, src); const unsigned ab = (unsigned)__builtin_amdgcn_readlane((int)above, src);
        prefix |= ((u64)(unsigned)bin) << shift; need -= ab;
        lds_sync();
    }
    tau = prefix;
    int base = 0;
#pragma unroll
    for (int i = 0; i < 8; ++i) { const bool keep = (e[i] >= tau) && (e[i] != 0ull); const u64 m = __ballot(keep);
        if (keep) buf[base + __popcll(m & lt)] = e[i]; base += __popcll(m); }
    cnt = base;
    lds_sync();
}

#ifndef DSA_PROBE_MODE
#define DSA_PROBE_MODE 0
#endif
__device__ __forceinline__ void dsa_item(const Ctx& C, int qp, LAS unsigned char* wl, LAS const unsigned char* bkt, LAS const float* tbl, int pmode = 0) {
    const int lane = C.lane, r = lane & 31, h = lane >> 5;
    const bf16_t* proj = (const bf16_t*)(C.ws + WS_PROJ); const bf16_t* kic = (const bf16_t*)(C.ws + WS_KIC);
    unsigned char* ya = C.ws + WS_YA;
    const int t0 = 2 * qp;
    LAS u64* buf0 = (LAS u64*)wl; LAS u64* buf1 = (LAS u64*)(wl + 4096);
    LAS unsigned* hist = (LAS unsigned*)(wl + 8192);
    LAS unsigned char* qst = wl + 9216;
    LAS float* pl = (LAS float*)(wl + 10240);
    LAS unsigned* idxs = (LAS unsigned*)(wl + 14336);
    const u64 lt = (1ull << lane) - 1ull;
    {
    bf16x8 A[2][4]; unsigned wp[2][8];
#pragma unroll
    for (int q = 0; q < 2; ++q) {
        const bf16_t* pr = proj + (size_t)(t0 + q) * NP;
#pragma unroll
        for (int kk = 0; kk < 4; ++kk) A[q][kk] = *(const bf16x8*)(pr + P_QI + 64 * r + 32 * h + 8 * kk);
#pragma unroll
        for (int k2 = 0; k2 < 8; ++k2) { const int reg = 2 * k2; wp[q][k2] = *(const unsigned*)(pr + P_WI + (reg & 3) + 8 * (reg >> 2) + 4 * h); }
    }
    int cnt0 = 0, cnt1 = 0; u64 tau0 = 0ull, tau1 = 0ull;
    const int nkeys = (pmode == 2) ? 0 : t0 + 2;
    LAS unsigned char* stg = wl + 9216;
    const unsigned ixo0 = (unsigned)(((lane >> 3) * 64 + 8 * ((lane & 7) ^ ((lane >> 4) & 7))) * 2), ixo1 = (unsigned)(((lane >> 3) * 64 + 8 * ((lane & 7) ^ ((4 + (lane >> 4)) & 7))) * 2);
#define IX_STAGE(j0_) do { const char* _tb = (const char*)kic + (size_t)(j0_) * 128; _Pragma("unroll") for (int _i = 0; _i < 8; ++_i) \
        __builtin_amdgcn_global_load_lds((const unsigned*)(_tb + _i * 1024 + ((_i & 1) ? ixo1 : ixo0)), (LAS unsigned*)(stg + _i * 1024), 16, 0, 0); } while (0)
    if (nkeys > 0) IX_STAGE(0);
#pragma unroll 1
    for (int j0 = 0; j0 < nkeys; j0 += 64) {
        bf16x8 BA[4], BB[4];
        asm volatile("s_waitcnt vmcnt(0)" ::: "memory");
#pragma unroll
        for (int kk = 0; kk < 4; ++kk) { const int sw = (r >> 1) & 7;
            BA[kk] = *(LAS const bf16x8*)(stg + r * 128 + 16 * ((4 * h + kk) ^ sw));
            BB[kk] = *(LAS const bf16x8*)(stg + (32 + r) * 128 + 16 * ((4 * h + kk) ^ sw)); }
        asm volatile("s_waitcnt lgkmcnt(0)" ::: "memory");
        if (j0 + 64 < nkeys) IX_STAGE(j0 + 64);
        const int kidx = j0 + lane;
        f32x16 accA0, accB0, accA1, accB1;
#pragma unroll
        for (int i = 0; i < 16; ++i) { accA0[i] = 0.f; accB0[i] = 0.f; accA1[i] = 0.f; accB1[i] = 0.f; }
#pragma unroll
        for (int kk = 0; kk < 4; ++kk) { accA0 = mfma32(A[0][kk], BA[kk], accA0); accB0 = mfma32(A[0][kk], BB[kk], accB0); }
#pragma unroll
        for (int kk = 0; kk < 4; ++kk) { accA1 = mfma32(A[1][kk], BA[kk], accA1); accB1 = mfma32(A[1][kk], BB[kk], accB1); }
        float sc[2];
        { float pA = 0.f, pB = 0.f;
#pragma unroll
          for (int i = 0; i < 16; ++i) { const float wv = (i & 1) ? bfhi(wp[0][i >> 1]) : bflo(wp[0][i >> 1]);
              const float ta = __int_as_float(max(__float_as_int(accA0[i]), 0)), tb = __int_as_float(max(__float_as_int(accB0[i]), 0));
              pA = __builtin_fmaf(ta, wv, pA); pB = __builtin_fmaf(tb, wv, pB); }
          swap32f(pA, pB); sc[0] = pA + pB; }
        __builtin_amdgcn_sched_group_barrier(0x008, 8, 0);
#pragma unroll
        for (int i = 0; i < 8; ++i) { __builtin_amdgcn_sched_group_barrier(0x008, 1, 0); __builtin_amdgcn_sched_group_barrier(0x002, 9, 0); }
        { float pA = 0.f, pB = 0.f;
#pragma unroll
          for (int i = 0; i < 16; ++i) { const float wv = (i & 1) ? bfhi(wp[1][i >> 1]) : bflo(wp[1][i >> 1]);
              const float ta = __int_as_float(max(__float_as_int(accA1[i]), 0)), tb = __int_as_float(max(__float_as_int(accB1[i]), 0));
              pA = __builtin_fmaf(ta, wv, pA); pB = __builtin_fmaf(tb, wv, pB); }
          swap32f(pA, pB); sc[1] = pA + pB; }
#pragma unroll
        for (int q = 0; q < 2; ++q) {
            const float s = sc[q];
            const bool valid = kidx <= t0 + q;
            const u64 key = ((u64)sortable(s) << 14) | (u64)(unsigned)(16383 - kidx);
            const u64 tau = q ? tau1 : tau0;
            const bool pass = valid && key > tau && (pmode != 3);
            const u64 mask = __ballot(pass);
            if (mask) {
                LAS u64* buf = q ? buf1 : buf0; int& cnt = q ? cnt1 : cnt0;
                if (pass) buf[cnt + __popcll(mask & lt)] = key;
                cnt += __popcll(mask);
                if (cnt > 512 - 64) { lds_sync(); topk_prune(buf, cnt, q ? tau1 : tau0, hist, lane); }
            }
        }
    }
#undef IX_STAGE
    lds_sync();
    if (cnt0 > 256) topk_prune(buf0, cnt0, tau0, hist, lane);
    if (cnt1 > 256) topk_prune(buf1, cnt1, tau1, hist, lane);
    if (pmode == 2) { cnt0 = min(t0 + 1, 256); cnt1 = min(t0 + 2, 256);
#pragma unroll
        for (int i = 0; i < 4; ++i) { const int j = lane + 64 * i; buf0[j] = (u64)(unsigned)(16383 - ((j * 61) % (t0 + 1))); buf1[j] = (u64)(unsigned)(16383 - ((j * 59) % (t0 + 2))); } }
    if (lane == 0) { hist[0] = (unsigned)cnt0; hist[1] = (unsigned)cnt1; }
    lds_sync();
    }
    __builtin_amdgcn_s_setprio(0);
    if (pmode == 1 || pmode == 3) return;
    const int kq = lane >> 4, l16 = lane & 15;
    LAS float* plq = (LAS float*)wl;
    LAS unsigned short* idx2 = (LAS unsigned short*)(wl + 16384);
    LAS float* invl = (LAS float*)(wl + 17408);
    const int nsel0 = (int)hist[0], nsel1 = (int)hist[1];
    { unsigned iv0[4], iv1[4];
#pragma unroll
      for (int i = 0; i < 4; ++i) { const int j = lane + 64 * i; iv0[i] = (j < nsel0) ? (16383u - (unsigned)(buf0[j] & 0x3FFFull)) : 0u; iv1[i] = (j < nsel1) ? (16383u - (unsigned)(buf1[j] & 0x3FFFull)) : 0u; }
      lds_sync();
#pragma unroll
      for (int i = 0; i < 4; ++i) { const int j = lane + 64 * i; idx2[j] = (unsigned short)iv0[i]; idx2[256 + j] = (unsigned short)iv1[i]; }
      lds_sync(); }
    const unsigned char* KAp = (const unsigned char*)(C.ws + WS_KA) + 32 * kq;
    const float lsc = 1.f / (64.f * 512.f);
#pragma unroll 1
    for (int q = 0; q < 2; ++q) {
        const int t = t0 + q; const int nsel = q ? nsel1 : nsel0; LAS const unsigned short* idxs = idx2 + 256 * q;
        const bf16_t* prq = proj + (size_t)t * NP;
        lds_sync();
        {
            long Bz[4][4];
#pragma unroll
            for (int g = 0; g < 4; ++g)
#pragma unroll
                for (int sI = 0; sI < 4; ++sI) { long z = 0;
                    if ((l16 >> 2) == g) { const u32x4 raw = *(const u32x4*)(prq + P_QA + l16 * 128 + 32 * kq + 8 * sI);
                        int p0 = __builtin_amdgcn_cvt_pk_fp8_f32(bflo(raw.x) * 512.f, bfhi(raw.x) * 512.f, 0, false); p0 = __builtin_amdgcn_cvt_pk_fp8_f32(bflo(raw.y) * 512.f, bfhi(raw.y) * 512.f, p0, true);
                        int p1 = __builtin_amdgcn_cvt_pk_fp8_f32(bflo(raw.z) * 512.f, bfhi(raw.z) * 512.f, 0, false); p1 = __builtin_amdgcn_cvt_pk_fp8_f32(bflo(raw.w) * 512.f, bfhi(raw.w) * 512.f, p1, true);
                        z = (long)(((unsigned long long)(unsigned)p1 << 32) | (unsigned long long)(unsigned)p0); }
                    Bz[g][sI] = z; }
            u32x4 A0[2][2], A1[2][2];
            { const unsigned char* kr = KAp + (size_t)idxs[l16] * 512;
#pragma unroll
              for (int g = 0; g < 2; ++g) { A0[g][0] = *(const u32x4*)(kr + g * 128); A0[g][1] = *(const u32x4*)(kr + g * 128 + 16); } }
#pragma unroll 1
            for (int tile = 0; tile < 16; ++tile) {
                { const unsigned char* kr = KAp + (size_t)idxs[16 * tile + l16] * 512 + 256;
#pragma unroll
                  for (int g = 0; g < 2; ++g) { A1[g][0] = *(const u32x4*)(kr + g * 128); A1[g][1] = *(const u32x4*)(kr + g * 128 + 16); } }
                f32x4 acc = {0.f, 0.f, 0.f, 0.f};
#pragma unroll
                for (int g = 0; g < 2; ++g)
#pragma unroll
                    for (int sI = 0; sI < 4; ++sI) { const u32x4 v = A0[g][sI >> 1]; const long a = (sI & 1) ? (long)(((unsigned long long)v.w << 32) | v.z) : (long)(((unsigned long long)v.y << 32) | v.x);
                        acc = __builtin_amdgcn_mfma_f32_16x16x32_fp8_fp8(a, Bz[g][sI], acc, 0, 0, 0); }
                asm volatile("" ::: "memory");
                if (tile < 15) { const unsigned char* kr = KAp + (size_t)idxs[16 * (tile + 1) + l16] * 512;
#pragma unroll
                    for (int g = 0; g < 2; ++g) { A0[g][0] = *(const u32x4*)(kr + g * 128); A0[g][1] = *(const u32x4*)(kr + g * 128 + 16); } }
#pragma unroll
                for (int g = 0; g < 2; ++g)
#pragma unroll
                    for (int sI = 0; sI < 4; ++sI) { const u32x4 v = A1[g][sI >> 1]; const long a = (sI & 1) ? (long)(((unsigned long long)v.w << 32) | v.z) : (long)(((unsigned long long)v.y << 32) | v.x);
                        acc = __builtin_amdgcn_mfma_f32_16x16x32_fp8_fp8(a, Bz[2 + g][sI], acc, 0, 0, 0); }
#pragma unroll
                for (int r = 0; r < 4; ++r) { const int j = 16 * tile + 4 * kq + r; const int idx = (int)idxs[j]; const bool valid = j < nsel;
                    const int b = bkt[min(max(t - idx, 0), 2048)];
                    plq[j * 16 + l16] = valid ? (acc[r] * lsc + tbl[b * 32 + l16]) : -1e30f; }
            }
        }
        lds_sync();
        {
            float mx[16];
#pragma unroll
            for (int hh = 0; hh < 16; ++hh) mx[hh] = -1e30f;
#pragma unroll 1
            for (int ps = 0; ps < 4; ++ps) { const int j = ps * 64 + lane;
#pragma unroll
                for (int c4 = 0; c4 < 4; ++c4) { const f32x4 lv = *(LAS f32x4*)(plq + 16 * j + 4 * c4);
#pragma unroll
                    for (int e = 0; e < 4; ++e) mx[4 * c4 + e] = fmaxf(mx[4 * c4 + e], lv[e]); } }
#pragma unroll
            for (int hh = 0; hh < 16; ++hh) mx[hh] = wave_max(mx[hh]);
            float zs[16];
#pragma unroll
            for (int hh = 0; hh < 16; ++hh) zs[hh] = 0.f;
#pragma unroll 1
            for (int ps = 0; ps < 4; ++ps) { const int j = ps * 64 + lane; const bool valid = j < nsel;
#pragma unroll
                for (int c4 = 0; c4 < 4; ++c4) { f32x4 lv = *(LAS f32x4*)(plq + 16 * j + 4 * c4);
#pragma unroll
                    for (int e = 0; e < 4; ++e) { const float p = valid ? __expf(lv[e] - mx[4 * c4 + e]) : 0.f; lv[e] = __builtin_bit_cast(float, __builtin_amdgcn_cvt_pkrtz(p, p)); zs[4 * c4 + e] += p; }
                    *(LAS f32x4*)(plq + 16 * j + 4 * c4) = lv; } }
#pragma unroll
            for (int hh = 0; hh < 16; ++hh) { const float z = wave_sum(zs[hh]); if (lane == 0) invl[hh] = 1.f / fmaxf(z, 1e-30f); }
        }
        lds_sync();
#pragma unroll 1
        for (int g = 0; g < 4; ++g) {
            const f32x4 inv4 = *(LAS f32x4*)(invl + 4 * g);
            hx2_t o2[4][4];
#pragma unroll
            for (int rr = 0; rr < 4; ++rr)
#pragma unroll
                for (int d = 0; d < 4; ++d) o2[rr][d] = (hx2_t){(_Float16)0.f, (_Float16)0.f};
            const unsigned char* vbase = C.ws + WS_VA + (128 * g + 8 * l16) * 2;
            const int nb = (nsel + 63) >> 6;
            u32x4 vc[16], vn[16];
#pragma unroll
            for (int u = 0; u < 16; ++u) { const int idx = (int)idxs[4 * u + kq]; vc[u] = *(const u32x4*)(vbase + (size_t)idx * 1024); }
#pragma unroll 1
            for (int bb = 0; bb < nb; ++bb) {
                { const int bn = (bb + 1 < nb) ? bb + 1 : bb;
#pragma unroll
                    for (int u = 0; u < 16; ++u) { const int idx = (int)idxs[64 * bn + 4 * u + kq]; vn[u] = *(const u32x4*)(vbase + (size_t)idx * 1024); } }
#pragma unroll
                for (int u = 0; u < 16; ++u) { const u32x4 pw = *(LAS u32x4*)(plq + 16 * (64 * bb + 4 * u + kq) + 4 * g);
#pragma unroll
                    for (int rr = 0; rr < 4; ++rr) { const unsigned pwr = pw[rr]; const hx2_t pp = __builtin_bit_cast(hx2_t, pwr);
#pragma unroll
                        for (int d = 0; d < 4; ++d) { const unsigned vd = vc[u][d]; o2[rr][d] = pp * __builtin_bit_cast(hx2_t, vd) + o2[rr][d]; } } }
#pragma unroll
                for (int u = 0; u < 16; ++u) vc[u] = vn[u];
            }
            float o[4][8];
#pragma unroll
            for (int rr = 0; rr < 4; ++rr)
#pragma unroll
                for (int d = 0; d < 4; ++d) { o[rr][2 * d] = xsum16(xsum32((float)o2[rr][d].x)) * inv4[rr]; o[rr][2 * d + 1] = xsum16(xsum32((float)o2[rr][d].y)) * inv4[rr]; }
            if (kq == 0) {
#pragma unroll
                for (int rr = 0; rr < 4; ++rr) { int p0 = __builtin_amdgcn_cvt_pk_fp8_f32(o[rr][0] * 16.f, o[rr][1] * 16.f, 0, false); p0 = __builtin_amdgcn_cvt_pk_fp8_f32(o[rr][2] * 16.f, o[rr][3] * 16.f, p0, true);
                    int p1 = __builtin_amdgcn_cvt_pk_fp8_f32(o[rr][4] * 16.f, o[rr][5] * 16.f, 0, false); p1 = __builtin_amdgcn_cvt_pk_fp8_f32(o[rr][6] * 16.f, o[rr][7] * 16.f, p1, true);
                    *(u32x2*)(ya + (size_t)t * 2048 + (4 * g + rr) * 128 + 8 * l16) = (u32x2){(unsigned)p0, (unsigned)p1}; } }
        }
    }
}

constexpr int N2_KS = 0, N2_VS = 32768, N2_LUT = 65536, N2_IMP = 81920, N2_SEL = N2_IMP + 64 * 260 * 4, N2_UNI = N2_SEL + 2048, N2_LIST = N2_UNI + 64, N2_BKT = N2_LIST + 3 * 512, N2_TBL = N2_BKT + 2304, N2_END = N2_TBL + 4096;
static_assert(N2_END <= LDS_BYTES - 16, "NSA LDS map");
struct N2Src { const bf16_t* kbase; size_t kld; int krmax; const bf16_t* vT; size_t vld; };
__device__ __forceinline__ void n2_stage(const N2Src& s, int m, bool withV, LAS unsigned char* kbuf, LAS unsigned char* vbuf, int wave, int lane) {
#pragma unroll
    for (int j = 0; j < 2; ++j) { const int slot = (wave * 2 + j) * 64 + lane; const int row = slot >> 4, ch = (slot & 15) ^ (row & 15);
        __builtin_amdgcn_global_load_lds((const unsigned*)(s.kbase + (size_t)min(64 * m + row, s.krmax) * s.kld + 8 * ch), (LAS unsigned*)(kbuf + (wave * 2 + j) * 1024), 16, 0, 0); }
    if (withV) {
#pragma unroll
        for (int j = 0; j < 2; ++j) { const int slot = (wave * 2 + j) * 64 + lane; const int row = slot >> 3, ch = (slot & 7) ^ ((row >> 1) & 7);
            __builtin_amdgcn_global_load_lds((const unsigned*)(s.vT + (size_t)row * s.vld + 64 * m + 8 * ch), (LAS unsigned*)(vbuf + (wave * 2 + j) * 1024), 16, 0, 0); } }
}
__device__ __forceinline__ f32x16 n2_qk(const bf16x8 (&Bq)[8], LAS const unsigned char* kbuf, int hf, int rho, int h) {
    const int kr = 32 * hf + rho;
    f32x16 S;
#pragma unroll
    for (int i = 0; i < 16; ++i) S[i] = 0.f;
#pragma unroll
    for (int kk = 0; kk < 8; ++kk) { const int ch = 8 * h + kk; const bf16x8 a = *(LAS const bf16x8*)(kbuf + kr * 256 + 16 * (ch ^ (rho & 15))); S = mfma32(a, Bq[kk], S); }
    return S;
}
__device__ __forceinline__ void n2_pv(f32x16 (&O)[4], const float (&p)[16], LAS const unsigned char* vbuf, int hf, int lane) {
    bf16x8 pk[2];
#pragma unroll
    for (int s = 0; s < 2; ++s) { u32x4 w; w.x = cvt_pk_bf16(p[8 * s + 0], p[8 * s + 1]); w.y = cvt_pk_bf16(p[8 * s + 2], p[8 * s + 3]); w.z = cvt_pk_bf16(p[8 * s + 4], p[8 * s + 5]); w.w = cvt_pk_bf16(p[8 * s + 6], p[8 * s + 7]);
        pk[s] = __builtin_bit_cast(bf16x8, w); }
    const int r = lane & 31, h = lane >> 5;
#pragma unroll
    for (int dt = 0; dt < 4; ++dt)
#pragma unroll
        for (int s = 0; s < 2; ++s) { const int row = dt * 32 + r, ch = 4 * hf + 2 * s + h;
            const bf16x8 a = *(LAS const bf16x8*)(vbuf + row * 128 + 16 * (ch ^ ((r >> 1) & 7))); O[dt] = mfma32(a, pk[s], O[dt]); }
}
constexpr float N2_MASKED = -3.0e38f, N2_MINIT = -1.0e30f, LOG2E = 1.4426950408889634f;
template <int MODE, bool DEFER = false>
__device__ __forceinline__ float n2_bias_mask(f32x16& S, int posbase, int t, int t0w, int h, int ncv, int ncv0, unsigned sb, bool before_cur, float b31, LAS const bf16_t* lutr, LAS const unsigned char* bkt, LAS const float* tblh) {
    bool farT, fullT;
    if (MODE == 0) { farT = (t0w - (16 * (posbase + 31) + 31)) >= 1513; fullT = (posbase + 31) < ncv0; }
    else if (MODE == 1) { farT = (t0w - (posbase + 31)) >= 1513; fullT = before_cur; }
    else { farT = false; fullT = (posbase + 31 <= t0w) && ((t0w + 7 - posbase) < 512); }
    float cbu = b31;
    if (MODE != 0 && fullT && !farT) { const int b0 = (int)bkt[min(t0w - (posbase + 31), 2048)], b1 = (int)bkt[min(t0w + 7 - posbase, 2048)];
        if (b0 == b1) { farT = true; cbu = tblh[b0 * 32] * LOG2E; } }
    if (farT && fullT) {
        if (MODE == 1 && sb == 0u) {
#pragma unroll
            for (int reg = 0; reg < 16; ++reg) S[reg] = N2_MASKED;
            return 0.f; }
        if (DEFER) return cbu;
#pragma unroll
        for (int reg = 0; reg < 16; ++reg) S[reg] = S[reg] + cbu;
    } else {
#pragma unroll
        for (int reg = 0; reg < 16; ++reg) { const int pos = posbase + (reg & 7) + 8 * h + 16 * (reg >> 3);
            const int dist = (MODE == 0) ? (t - (16 * pos + 31)) : (t - pos);
            bool v;
            if (MODE == 0) v = pos < ncv; else if (MODE == 1) v = (sb != 0u) && (pos <= t); else v = (pos <= t) && (dist < 512);
            const float bias = bf2f(lutr[min(max(dist, 0), 2047)]);
            S[reg] = v ? (S[reg] + bias) : N2_MASKED; }
    }
    return 0.f;
}
__device__ __forceinline__ float n2_tilemax(const f32x16& S) {
    float a = fmax_fast(S[0], S[1]), b = fmax_fast(S[2], S[3]), c = fmax_fast(S[4], S[5]), d = fmax_fast(S[6], S[7]);
    float e = fmax_fast(S[8], S[9]), f = fmax_fast(S[10], S[11]), g = fmax_fast(S[12], S[13]), hh = fmax_fast(S[14], S[15]);
    a = fmax_fast(a, b); c = fmax_fast(c, d); e = fmax_fast(e, f); g = fmax_fast(g, hh); a = fmax_fast(a, c); e = fmax_fast(e, g); return fmax_fast(a, e);
}
__device__ __forceinline__ void n2_stat(const f32x16& S, float& m, float& Z) {
    const float mn = fmax_fast(m, n2_tilemax(S));
    float z = 0.f;
#pragma unroll
    for (int i = 0; i < 16; ++i) z += __builtin_amdgcn_exp2f(S[i] - mn);
    Z = Z * __builtin_amdgcn_exp2f(m - mn) + z; m = mn;
}
__device__ __forceinline__ void n2_combine(float& m, float& Z) {
    float ma = m, mb = m; swap32f(ma, mb); const float M = fmax_fast(ma, mb);
    Z = xsum32(Z * __builtin_amdgcn_exp2f(m - M)); m = M;
}
enum { N2_STATS = 0, N2_IMPP = 1, N2_PV = 2, N2_ONLINE = 3, N2_IMPV = 4 };
struct N2Lane { int t, t0w, h, rho, qq, rr, lane, ncv, ncv0, ncv7, cur; float b31; LAS const bf16_t* lutr; LAS const unsigned char* bkt; LAS const float* tblh; };
template <int MODE, int PASS>
__device__ __forceinline__ void n2_branch(const Ctx& C, int g, LAS const unsigned short* list, int n, const N2Lane& L, const bf16x8 (&Bq)[8], f32x16 (&O)[4],
                                          float& m, float& Z, float scale, LAS const unsigned* selq, LAS float* impw, float scale2 = 1.f) {
    if (n <= 0) return;
    constexpr bool withV = (PASS == N2_PV || PASS == N2_ONLINE || PASS == N2_IMPV);
    constexpr int NSL = (PASS == N2_IMPV) ? 2 : 4, LA = NSL - 1;
    N2Src src;
    if (MODE == 0) { src.kbase = (const bf16_t*)(C.ws + WS_KCMP) + (size_t)g * 1024 * 128; src.kld = 128; src.krmax = 1023; src.vT = (const bf16_t*)(C.ws + WS_VCMPT) + (size_t)g * 128 * 1024; src.vld = 1024; }
    else if (MODE == 1) { src.kbase = (const bf16_t*)(C.ws + WS_KSC) + (size_t)g * T * 128; src.kld = 128; src.krmax = T - 1; src.vT = (const bf16_t*)(C.ws + WS_VST) + (size_t)g * 128 * T; src.vld = (size_t)T; }
    else { src.kbase = (const bf16_t*)(C.ws + WS_KWC) + (size_t)g * T * 128; src.kld = 128; src.krmax = T - 1; src.vT = (const bf16_t*)(C.ws + WS_VWT) + (size_t)g * 128 * T; src.vld = (size_t)T; }
    LAS unsigned char* lds = C.lds;
#define N2_KSLOT(s_) (withV ? (((s_) < 2) ? (N2_KS + (s_) * 16384) : (N2_IMP + ((s_) - 2) * 32768)) : (N2_KS + (s_) * 16384))
#define N2_VSLOT(s_) (((s_) < 2) ? (N2_VS + (s_) * 16384) : (N2_IMP + ((s_) - 2) * 32768 + 16384))
#define N2_RAW_BARRIER() do { asm volatile("s_waitcnt lgkmcnt(0)" ::: "memory"); __builtin_amdgcn_s_barrier(); asm volatile("" ::: "memory"); } while (0)
#define N2_WAIT_LANDED() do { if (LA == 1) asm volatile("s_waitcnt vmcnt(0)" ::: "memory"); else if (withV) asm volatile("s_waitcnt vmcnt(8)" ::: "memory"); else asm volatile("s_waitcnt vmcnt(4)" ::: "memory"); } while (0)
#pragma unroll
    for (int j = 0; j < LA; ++j) if (j < n) n2_stage(src, (int)list[j], withV, lds + N2_KSLOT(j), lds + N2_VSLOT(j), C.wave, C.lane);
    if (n >= LA) N2_WAIT_LANDED(); else asm volatile("s_waitcnt vmcnt(0)" ::: "memory");
    N2_RAW_BARRIER();
#pragma unroll 1
    for (int i = 0; i < n; ++i) {
        const int mb = (int)list[i];
        if (i + LA < n) { const int sl = (i + LA) & (NSL - 1); n2_stage(src, (int)list[i + LA], withV, lds + N2_KSLOT(sl), lds + N2_VSLOT(sl), C.wave, C.lane); }
        LAS const unsigned char* kbuf = lds + N2_KSLOT(i & (NSL - 1)); LAS const unsigned char* vbuf = lds + N2_VSLOT(i & (NSL - 1));
        bool need; unsigned sb = 1u;
        if (MODE == 0) need = (64 * mb) < L.ncv7;
        else if (MODE == 1) { const unsigned sw = selq[mb >> 5]; sb = (sw >> (mb & 31)) & 1u; need = __ballot(sb != 0u) != 0ull; }
        else need = (64 * mb + 63 >= L.t0w - 511) && (64 * mb <= L.t0w + 7);
        if (need && PASS == N2_ONLINE) {
            f32x16 S0 = n2_qk(Bq, kbuf, 0, L.rho, L.h), S1 = n2_qk(Bq, kbuf, 1, L.rho, L.h);
            const float cb0 = n2_bias_mask<MODE, true>(S0, 64 * mb, L.t, L.t0w, L.h, L.ncv, L.ncv0, sb, mb < L.cur, L.b31, L.lutr, L.bkt, L.tblh);
            const float cb1 = n2_bias_mask<MODE, true>(S1, 64 * mb + 32, L.t, L.t0w, L.h, L.ncv, L.ncv0, sb, mb < L.cur, L.b31, L.lutr, L.bkt, L.tblh);
            const float tm = xmax32(fmax_fast(n2_tilemax(S0) + cb0, n2_tilemax(S1) + cb1));
            const float mn = fmax_fast(m, tm);
            if (__ballot(mn > m + 8.f)) { const float al = __builtin_amdgcn_exp2f(m - mn); Z *= al;
#pragma unroll
                for (int dt = 0; dt < 4; ++dt)
#pragma unroll
                    for (int r = 0; r < 16; ++r) O[dt][r] *= al;
                m = mn; }
            { float p[16]; float zs = 0.f; const float c2 = cb0 - m;
#pragma unroll
              for (int r = 0; r < 16; ++r) { p[r] = __builtin_amdgcn_exp2f(S0[r] + c2); zs += p[r]; }
              Z += zs; n2_pv(O, p, vbuf, 0, L.lane); }
            { float p[16]; float zs = 0.f; const float c2 = cb1 - m;
#pragma unroll
              for (int r = 0; r < 16; ++r) { p[r] = __builtin_amdgcn_exp2f(S1[r] + c2); zs += p[r]; }
              Z += zs; n2_pv(O, p, vbuf, 1, L.lane); }
        } else if (need && PASS == N2_STATS) {
            f32x16 S0 = n2_qk(Bq, kbuf, 0, L.rho, L.h), S1 = n2_qk(Bq, kbuf, 1, L.rho, L.h);
            n2_bias_mask<MODE>(S0, 64 * mb, L.t, L.t0w, L.h, L.ncv, L.ncv0, sb, mb < L.cur, L.b31, L.lutr, L.bkt, L.tblh);
            n2_bias_mask<MODE>(S1, 64 * mb + 32, L.t, L.t0w, L.h, L.ncv, L.ncv0, sb, mb < L.cur, L.b31, L.lutr, L.bkt, L.tblh);
            n2_stat(S0, m, Z); n2_stat(S1, m, Z);
        } else if (need) {
#pragma unroll 1
            for (int hf = 0; hf < 2; ++hf) {
                const int posbase = 64 * mb + 32 * hf;
                f32x16 S = n2_qk(Bq, kbuf, hf, L.rho, L.h);
                const float cbd = n2_bias_mask<MODE, PASS == N2_ONLINE>(S, posbase, L.t, L.t0w, L.h, L.ncv, L.ncv0, sb, mb < L.cur, L.b31, L.lutr, L.bkt, L.tblh);
                if (PASS == N2_STATS) { n2_stat(S, m, Z); }
                else if (PASS == N2_IMPP || PASS == N2_IMPV) {
                    float p[16];
#pragma unroll
                    for (int r = 0; r < 16; ++r) p[r] = __builtin_amdgcn_exp2f(S[r] - m) * scale;
#pragma unroll
                    for (int G = 0; G < 4; ++G) { float q4 = p[4 * G] + p[4 * G + 1] + p[4 * G + 2] + p[4 * G + 3], e = p[4 * G + 3];
                        q4 += dppf<0xB1>(q4); q4 += dppf<0x4E>(q4); e += dppf<0xB1>(e); e += dppf<0x4E>(e);
                        const int nb = posbase + ((4 * G) & 7) + 8 * L.h + 16 * ((4 * G) >> 3); const int mq = nb >> 2;
                        if (L.rr == 0) { __hip_atomic_fetch_add(impw + L.qq * 260 + mq, q4, __ATOMIC_RELAXED, __HIP_MEMORY_SCOPE_WORKGROUP);
                                         __hip_atomic_fetch_add(impw + L.qq * 260 + mq + 1, e, __ATOMIC_RELAXED, __HIP_MEMORY_SCOPE_WORKGROUP); } }
                    if (PASS == N2_IMPV) {
#pragma unroll
                        for (int r = 0; r < 16; ++r) p[r] *= scale2;
                        n2_pv(O, p, vbuf, hf, L.lane); }
                } else if (PASS == N2_PV) {
                    float p[16];
#pragma unroll
                    for (int r = 0; r < 16; ++r) p[r] = __builtin_amdgcn_exp2f(S[r] - m) * scale;
                    n2_pv(O, p, vbuf, hf, L.lane);
                } else {
                    const float tm = xmax32(n2_tilemax(S) + cbd);
                    const float mn = fmax_fast(m, tm);
                    if (__ballot(mn > m + 8.f)) { const float al = __builtin_amdgcn_exp2f(m - mn); Z *= al;
#pragma unroll
                        for (int dt = 0; dt < 4; ++dt)
#pragma unroll
                            for (int r = 0; r < 16; ++r) O[dt][r] *= al;
                        m = mn; }
                    float p[16]; float zs = 0.f;
                    const float c2 = cbd - m;
#pragma unroll
                    for (int r = 0; r < 16; ++r) { p[r] = __builtin_amdgcn_exp2f(S[r] + c2); zs += p[r]; }
                    Z += zs;
                    n2_pv(O, p, vbuf, hf, L.lane);
                }
            }
        }
        if (i + LA < n) N2_WAIT_LANDED(); else asm volatile("s_waitcnt vmcnt(0)" ::: "memory");
        N2_RAW_BARRIER();
    }
#undef N2_WAIT_LANDED
#undef N2_RAW_BARRIER
#undef N2_KSLOT
#undef N2_VSLOT
}

__device__ __forceinline__ void nsa2_item(const Ctx& C, int QB, int g) {
    LAS unsigned char* lds = C.lds;
    const int tid = C.tid, lane = C.lane, wave = C.wave;
    const int c = lane & 31, h = lane >> 5, qq = c >> 2, rr = c & 3;
    const int t0 = 64 * QB, t0w = t0 + 8 * wave, t = t0w + qq, head = 4 * g + rr;
    const bf16_t* proj = (const bf16_t*)(C.ws + WS_PROJ);
    LAS bf16_t* lut = (LAS bf16_t*)(lds + N2_LUT);
    LAS float* imp = (LAS float*)(lds + N2_IMP);
    LAS unsigned* selw = (LAS unsigned*)(lds + N2_SEL);
    LAS unsigned* uni = (LAS unsigned*)(lds + N2_UNI);
    LAS unsigned short* listC = (LAS unsigned short*)(lds + N2_LIST); LAS unsigned short* listS = listC + 256; LAS unsigned short* listW = listC + 512;
    LAS const unsigned char* bkt = lds + N2_BKT; LAS const float* tbl = (LAS const float*)(lds + N2_TBL);
    __syncthreads();
    for (int i = tid; i < 8192; i += NTHREADS) { const int r4 = i >> 11, d = i & 2047; lut[i] = f2bf(tbl[(int)bkt[d] * 32 + 16 + 4 * g + r4] * LOG2E); }
    for (int i = tid; i < 64 * 260; i += NTHREADS) imp[i] = 0.f;
    const int ncv_wg = (t0 + 63 >= 31) ? ((t0 + 63 - 31) >> 4) + 1 : 0; const int nC = (ncv_wg + 63) >> 6;
    const int wlo = max(t0 - 511, 0) >> 6; const int nW = QB - wlo + 1;
    if (tid < nC) listC[tid] = (unsigned short)tid;
    if (tid < nW) listW[tid] = (unsigned short)(wlo + tid);
    bf16x8 Bq[8];
#pragma unroll
    for (int kk = 0; kk < 8; ++kk) Bq[kk] = *(const bf16x8*)(proj + (size_t)t * NP + P_QB + 128 * head + 64 * h + 8 * kk);
    const float g0 = sigmoidf_(bf2f(proj[(size_t)t * NP + P_GB + 3 * head + 0]));
    const float g1 = sigmoidf_(bf2f(proj[(size_t)t * NP + P_GB + 3 * head + 1]));
    const float g2 = sigmoidf_(bf2f(proj[(size_t)t * NP + P_GB + 3 * head + 2]));
    f32x16 O[4];
#pragma unroll
    for (int dt = 0; dt < 4; ++dt)
#pragma unroll
        for (int i = 0; i < 16; ++i) O[dt][i] = 0.f;
    N2Lane L; L.t = t; L.t0w = t0w; L.h = h; L.rho = swap23(c); L.qq = qq; L.rr = rr; L.lane = lane;
    L.ncv = t >= 31 ? ((t - 31) >> 4) + 1 : 0; L.ncv0 = t0w >= 31 ? ((t0w - 31) >> 4) + 1 : 0; L.ncv7 = (t0w + 7 >= 31) ? ((t0w + 7 - 31) >> 4) + 1 : 0; L.cur = QB;
    L.b31 = tbl[31 * 32 + 16 + head] * LOG2E; L.lutr = lut + rr * 2048; L.bkt = bkt; L.tblh = tbl + 16 + head;
    LAS const unsigned* selq = selw + (wave * 8 + qq) * 8;
    LAS float* impw = imp + wave * 8 * 260;
    __syncthreads();
    float mC = N2_MINIT, ZC = 0.f;
    n2_branch<0, N2_STATS>(C, g, listC, nC, L, Bq, O, mC, ZC, 0.f, selq, impw);
    n2_combine(mC, ZC);
    const float invZC = 1.f / fmaxf(ZC, 1e-30f);
    n2_branch<0, N2_IMPV>(C, g, listC, nC, L, Bq, O, mC, ZC, invZC, selq, impw, g0);
#define N2_OACC() ({ unsigned to_ = (unsigned)tid; asm volatile("" : "+v"(to_)); (f32x4*)(C.ws + WS_OACC) + (size_t)blockIdx.x * 16 * 512 + to_; })
    f32x4* oacc = N2_OACC();
#pragma unroll
    for (int dt = 0; dt < 4; ++dt)
#pragma unroll
        for (int G = 0; G < 4; ++G) { oacc[(dt * 4 + G) * 512] = (f32x4){O[dt][4 * G], O[dt][4 * G + 1], O[dt][4 * G + 2], O[dt][4 * G + 3]}; O[dt][4 * G] = 0.f; O[dt][4 * G + 1] = 0.f; O[dt][4 * G + 2] = 0.f; O[dt][4 * G + 3] = 0.f; }
    lds_sync();
#pragma unroll 1
    for (int q8 = 0; q8 < 8; ++q8) {
        const int cur = QB;
        unsigned word = 0u;
        if (cur + 1 <= 16) { if (lane == 0) word = (1u << (cur + 1)) - 1u; }
        else {
            unsigned key[4];
#pragma unroll
            for (int i = 0; i < 4; ++i) { const int mblk = lane + 64 * i; const bool ok = mblk >= 1 && mblk <= cur - 2;
                key[i] = ok ? ((__float_as_uint(impw[q8 * 260 + mblk]) & 0xFFFFFF00u) | (unsigned)(255 - mblk)) : 0u; }
#pragma unroll 1
            for (int round = 0; round < 13; ++round) {
                unsigned lm = key[0] > key[1] ? key[0] : key[1]; const unsigned lm2 = key[2] > key[3] ? key[2] : key[3]; lm = lm > lm2 ? lm : lm2;
                const unsigned W = wave_maxu(lm);
#pragma unroll
                for (int i = 0; i < 4; ++i) if (key[i] == W) key[i] = 0u;
                const int mw = 255 - (int)(W & 0xFFu);
                if (W != 0u && lane == (mw >> 5)) word |= 1u << (mw & 31);
            }
            if (lane == 0) word |= 1u;
            if (lane == (cur >> 5)) word |= 1u << (cur & 31);
            if (lane == ((cur - 1) >> 5)) word |= 1u << ((cur - 1) & 31);
        }
        if (lane < 8) selw[(wave * 8 + q8) * 8 + lane] = word;
    }
    __syncthreads();
    if (tid < 8) { unsigned u = 0u; for (int q = 0; q < 64; ++q) u |= selw[q * 8 + tid]; uni[tid] = u; }
    __syncthreads();
    if (tid == 0) { int n = 0; for (int mblk = 0; mblk <= QB; ++mblk) if ((uni[mblk >> 5] >> (mblk & 31)) & 1u) listS[n++] = (unsigned short)mblk; uni[8] = (unsigned)n; }
    __syncthreads();
    const int nS = (int)uni[8];
    float mS = N2_MINIT, ZS = 0.f;
    n2_branch<1, N2_ONLINE>(C, g, listS, nS, L, Bq, O, mS, ZS, 0.f, selq, impw);
    { ZS = xsum32(ZS); const float sc = g1 / fmaxf(ZS, 1e-30f);
#pragma unroll
      for (int dt = 0; dt < 4; ++dt)
#pragma unroll
          for (int r = 0; r < 16; ++r) O[dt][r] *= sc; }
    oacc = N2_OACC();
#pragma unroll
    for (int dt = 0; dt < 4; ++dt)
#pragma unroll
        for (int G = 0; G < 4; ++G) { const f32x4 a = oacc[(dt * 4 + G) * 512];
            oacc[(dt * 4 + G) * 512] = (f32x4){O[dt][4 * G] + a[0], O[dt][4 * G + 1] + a[1], O[dt][4 * G + 2] + a[2], O[dt][4 * G + 3] + a[3]};
            O[dt][4 * G] = 0.f; O[dt][4 * G + 1] = 0.f; O[dt][4 * G + 2] = 0.f; O[dt][4 * G + 3] = 0.f; }
    float mW = N2_MINIT, ZW = 0.f;
    n2_branch<2, N2_ONLINE>(C, g, listW, nW, L, Bq, O, mW, ZW, 0.f, selq, impw);
    oacc = N2_OACC();
    { ZW = xsum32(ZW); const float sc = g2 / fmaxf(ZW, 1e-30f);
#pragma unroll
      for (int dt = 0; dt < 4; ++dt)
#pragma unroll
          for (int G = 0; G < 4; ++G) { const f32x4 a = oacc[(dt * 4 + G) * 512];
              O[dt][4 * G] = O[dt][4 * G] * sc + a[0]; O[dt][4 * G + 1] = O[dt][4 * G + 1] * sc + a[1]; O[dt][4 * G + 2] = O[dt][4 * G + 2] * sc + a[2]; O[dt][4 * G + 3] = O[dt][4 * G + 3] * sc + a[3]; } }
    unsigned char* yb = C.ws + WS_YB + (size_t)t * 2048 + head * 128;
#pragma unroll
    for (int dt = 0; dt < 4; ++dt)
#pragma unroll
        for (int G = 0; G < 4; ++G) { int p = __builtin_amdgcn_cvt_pk_fp8_f32(O[dt][4 * G] * 16.f, O[dt][4 * G + 1] * 16.f, 0, false); p = __builtin_amdgcn_cvt_pk_fp8_f32(O[dt][4 * G + 2] * 16.f, O[dt][4 * G + 3] * 16.f, p, true);
            *(unsigned*)(yb + dt * 32 + 8 * G + 4 * h) = (unsigned)p; }
}

#ifndef NREP_DSA
#define NREP_DSA 1
#endif
#ifndef NREP_NSA
#define NREP_NSA 1
#endif
__device__ __forceinline__ void p6_mixers(const Ctx& C, int which  , int crep = 0) {
    const Ctx& C0_ = C;
    unsigned* counter = (unsigned*)(C.ws + WS_CTL + CTL_CNT) + 128 * crep;
    static_assert(8 * P6_WAVE_LDS <= N2_BKT, "DSA per-wave LDS vs the shared bias tables");
    LAS unsigned char* bkt = C.lds + N2_BKT; LAS float* tbl = (LAS float*)(C.lds + N2_TBL);
    for (int d = C.tid; d <= 2048; d += NTHREADS) { int b;
        if (d < 16) b = d; else { b = 16 + (int)(logf((float)d / 16.f) / logf(128.f) * 16.f); b = b < 31 ? b : 31; }
        bkt[d] = (unsigned char)b; }
    for (int i = C.tid; i < 1024; i += NTHREADS) tbl[i] = C.in[I_RELB][i];
    __syncthreads();
    if (which != 1) {
        LAS int* slot = (LAS int*)(C.lds + N2_UNI + 48);
#pragma unroll 1
        for (int rep = 0; rep < NREP_NSA; ++rep)
        for (;;) {
            __syncthreads();
            if (C.tid == 0) *slot = (int)atomicAdd(counter + 64 + 128 * rep, 1u);
            __syncthreads();
            const int it = *slot;
            if (it >= 1024) break;
            nsa2_item(C, 255 - (it >> 2), it & 3);
#pragma unroll 1
            for (int c = 0; c < 3; ++c) { const int j = it + 1024 * c; if (j >= 2560) break;
                __syncthreads();
                Ctx C = C0_; { int t_ = threadIdx.x; asm volatile("" : "+v"(t_)); C.tid = t_; C.lane = t_ & 63; C.wave = __builtin_amdgcn_readfirstlane(t_ >> 6); }
                if (j < 512) tconv_tile_f8<false>(C, C.in[I_WBA], 4096, C.ws + WS_WBA, 2048, (j / 16) * 128, (j % 16) * 128);
                else if (j < 1024) { const int i = j - 512; tconv_tile_f8<false>(C, C.in[I_WBB], 4096, C.ws + WS_WBB, 2048, (i / 16) * 128, (i % 16) * 128); }
                else if (j < 2048) { const int i = j - 1024; tconv_tile_f8<false>(C, C.in[I_WOUT], 4096, C.ws + WS_WOUT, 4096, (i / 32) * 128, (i % 32) * 128); }
                else { const int i = j - 2048; wq_subkey_tile(C, i >> 5, (i & 31) * 128); } }
        }
        __syncthreads();
    }
    if (which != 2) {
        LAS unsigned char* wl = C.lds + C.wave * P6_WAVE_LDS;
#pragma unroll 1
        for (int rep = 0; rep < NREP_DSA; ++rep)
        for (;;) {
            int it = 0;
            if (C.lane == 0) it = (int)atomicAdd(counter + 128 * rep, 1u);
            it = __builtin_amdgcn_readfirstlane(it);
            if (it >= 8192) break;
            if (C.wave >= 4) __builtin_amdgcn_s_setprio(2);
            dsa_item(C, 8191 - it, wl, bkt, tbl, (rep < NREP_DSA - 1) ? DSA_PROBE_MODE : 0);
#pragma unroll 1
            for (int rr = 0; rr < 4; ++rr) peer_row_convert(C, 4 * it + rr, C.lane);
        }
        __builtin_amdgcn_s_setprio(0);
        __syncthreads();
    }
}

static __device__ const unsigned P12_IJ4[16] = {
    0xE0331000u, 0xF0401101u, 0xFF411202u, 0xFF421303u, 0xFF501404u, 0xFF511505u, 0xFF601606u, 0xFF611707u, 0xFF702008u, 0xFF712109u, 0xFF80220Au, 0xFF90230Bu, 0xFFA0240Cu, 0xFFB0300Du, 0xFFC0310Eu, 0xFFD0320Fu };
typedef __bf16 bf16x32_t __attribute__((ext_vector_type(32)));
typedef unsigned u32x16 __attribute__((ext_vector_type(16)));
typedef _Float16 h2_t __attribute__((ext_vector_type(2)));
typedef _Float16 h32_t __attribute__((ext_vector_type(32)));
__device__ __forceinline__ unsigned rowmax_u(unsigned v) { v = umaxu(v, dppu<0xB1>(v)); v = umaxu(v, dppu<0x4E>(v)); v = umaxu(v, dppu<0x141>(v)); v = umaxu(v, dppu<0x140>(v)); return v; }
__device__ __forceinline__ float rowmax_f(float v) { v = fmax_fast(v, dppf<0xB1>(v)); v = fmax_fast(v, dppf<0x4E>(v)); v = fmax_fast(v, dppf<0x141>(v)); v = fmax_fast(v, dppf<0x140>(v)); return v; }
__device__ __forceinline__ float rowsum_f(float v) { v += dppf<0xB1>(v); v += dppf<0x4E>(v); v += dppf<0x141>(v); v += dppf<0x140>(v); return v; }
#define P12_CE(a_, b_) do { const unsigned hi_ = umaxu(a_, b_), lo_ = (a_) < (b_) ? (a_) : (b_); a_ = hi_; b_ = lo_; } while (0)
__device__ __forceinline__ void p12_route(const bf16_t* srow, LAS float* tops, LAS int* topi, LAS unsigned short* exl, LAS float* gtl, int lane, unsigned ij4) {
    const int row = lane >> 4, l16 = lane & 15;
#pragma unroll 1
    for (int q = 0; q < 4; ++q) {
        const int p = 4 * q + row;
        const u32x4 raw = *(const u32x4*)(srow + p * 128 + 8 * l16);
        unsigned k[8];
#pragma unroll
        for (int e = 0; e < 8; ++e) { const unsigned bits = (e & 1) ? (raw[e >> 1] & 0xFFFF0000u) : (raw[e >> 1] << 16);
            k[e] = ((bits ^ ((bits >> 31) ? 0xFFFFFFFFu : 0x80000000u)) & 0xFFFFFF80u) | (unsigned)(127 - (8 * l16 + e)); }
        P12_CE(k[0], k[2]); P12_CE(k[1], k[3]); P12_CE(k[4], k[6]); P12_CE(k[5], k[7]);
        P12_CE(k[0], k[4]); P12_CE(k[1], k[5]); P12_CE(k[2], k[6]); P12_CE(k[3], k[7]);
        P12_CE(k[0], k[1]); P12_CE(k[2], k[3]); P12_CE(k[4], k[5]); P12_CE(k[6], k[7]);
        P12_CE(k[2], k[4]); P12_CE(k[3], k[5]);
        P12_CE(k[1], k[4]); P12_CE(k[3], k[6]);
        P12_CE(k[1], k[2]); P12_CE(k[3], k[4]); P12_CE(k[5], k[6]);
        unsigned myW = 0u;
#pragma unroll
        for (int r = 0; r < 16; ++r) {
            const unsigned W = rowmax_u(k[0]);
            const bool pop = k[0] == W;
#pragma unroll
            for (int e = 0; e < 7; ++e) k[e] = pop ? k[e + 1] : k[e];
            k[7] = pop ? 0u : k[7];
            myW = (l16 == r) ? W : myW;
        }
        const unsigned sb = myW & 0xFFFFFF80u;
        const unsigned bits = (sb & 0x80000000u) ? (sb ^ 0x80000000u) : ((~sb) & 0xFFFF0000u);
        tops[p * 16 + l16] = __uint_as_float(bits); topi[p * 16 + l16] = 127 - (int)(myW & 0x7Fu);
    }
    lds_sync();
#pragma unroll 1
    for (int q2 = 0; q2 < 2; ++q2) {
        const int hh = 4 * q2 + row;
        LAS const float* t1 = tops + (2 * hh) * 16; LAS const float* t2 = t1 + 16;
        unsigned k[4];
#pragma unroll
        for (int c = 0; c < 4; ++c) { const unsigned ij = (ij4 >> (8 * c)) & 0xFFu; const float cv = t1[ij >> 4] + t2[ij & 15u];
            k[c] = (ij != 0xFFu) ? ((sortable(cv) & 0xFFFFFF00u) | (255u - ij)) : 0u; }
        P12_CE(k[0], k[1]); P12_CE(k[2], k[3]); P12_CE(k[0], k[2]); P12_CE(k[1], k[3]); P12_CE(k[1], k[2]);
        unsigned myW = 0u;
#pragma unroll
        for (int r = 0; r < 16; ++r) {
            const unsigned W = rowmax_u(k[0]);
            const bool pop = k[0] == W;
            k[0] = pop ? k[1] : k[0]; k[1] = pop ? k[2] : k[1]; k[2] = pop ? k[3] : k[2]; k[3] = pop ? 0u : k[3];
            myW = (l16 == r) ? W : myW;
        }
        const unsigned flat = 255u - (myW & 0xFFu); const int ci = (int)(flat >> 4), cj = (int)(flat & 15u);
        const float cv = t1[ci] + t2[cj];
        const float ev = __expf(cv - rowmax_f(cv));
        const float es = rowsum_f(ev);
        exl[hh * 16 + l16] = (unsigned short)(topi[(2 * hh) * 16 + ci] * 128 + topi[(2 * hh + 1) * 16 + cj]);
        gtl[hh * 16 + l16] = ev * __builtin_amdgcn_rcpf(es);
    }
    lds_sync();
}
#undef P12_CE
__device__ __forceinline__ float gelu_fast(float x) { const float u = 0.7978845608028654f * (x + 0.044715f * x * x * x); const float e = __expf(2.f * u); return x - x * __builtin_amdgcn_rcpf(e + 1.f); }

#ifndef P12_HI
#define P12_HI 4
#endif
__device__ __forceinline__ void p12_peer(const Ctx& C, float* dst) {
    const bf16_t* pq = (const bf16_t*)(C.ws + WS_PQ);
    const bf16_t* h2 = (const bf16_t*)(C.ws + WS_H2);
    const float* gt2 = (const float*)(C.ws + WS_MOD) + 5 * D;
    const int lane = C.lane;
    LAS unsigned char* wl = C.lds + C.wave * 8192;
    LAS unsigned short* exl = (LAS unsigned short*)wl;
    LAS float* gtl = (LAS float*)(wl + 2048);
    LAS float* tops = (LAS float*)(wl + 6144);
    LAS int* topi = (LAS int*)(wl + 7168);
    const unsigned ij4 = P12_IJ4[lane & 15];
    const unsigned lo16 = 16u * (unsigned)lane; const unsigned char* pu6 = C.ws + WS_PU; const unsigned char* pv6 = C.ws + WS_PV;
    const float* su = (const float*)(C.ws + WS_PU + 96 * MB); const float* sv = (const float*)(C.ws + WS_PV + 96 * MB);
    const unsigned char* pu4 = C.ws + WS_PU4; const unsigned char* pv4 = C.ws + WS_PV4;
    const int tstride = gridDim.x * 8;
    for (int tb = blockIdx.x * 8 + C.wave; tb < T; tb += 8 * tstride) {
        int nb = 0;
#pragma unroll 1
        for (int s = 0; s < 8; ++s) { if (tb + s * tstride >= T) break; ++nb; }
        p12_route(pq + (size_t)tb * 2048, tops, topi, exl, gtl, lane, ij4);
        const int nflat = nb * 128;
        u32x4 UA[3], VA[3], UB[3], VB[3], UC[3], VC[3], UD[3], VD[3]; float suA, svA, suB, svB, suC, svC, suD, svD;
#define P12_FMT(idx_) ((((idx_) & 15) < P12_HI) ? 6 : 4)
#define P12_LOAD(S, idx_, fmt_) do { const int e_ = __builtin_amdgcn_readfirstlane((int)exl[(idx_) < nflat ? (idx_) : nflat - 1]); \
        if ((fmt_) == 6) { const unsigned char* pu_ = pu6 + (size_t)e_ * 3072 + lo16; const unsigned char* pv_ = pv6 + (size_t)e_ * 3072 + lo16; \
            U##S[0] = *(const u32x4*)pu_; U##S[1] = *(const u32x4*)(pu_ + 1024); U##S[2] = *(const u32x4*)(pu_ + 2048); \
            V##S[0] = *(const u32x4*)pv_; V##S[1] = *(const u32x4*)(pv_ + 1024); V##S[2] = *(const u32x4*)(pv_ + 2048); su##S = su[e_]; sv##S = sv[e_]; } \
        else { const unsigned char* pu_ = pu4 + (size_t)e_ * 2176; const unsigned char* pv_ = pv4 + (size_t)e_ * 2176; \
            U##S[0] = *(const u32x4*)(pu_ + lo16); U##S[1] = *(const u32x4*)(pu_ + 1024 + lo16); su##S = bf2f(*(const bf16_t*)(pu_ + 2048 + 2 * lane)); \
            V##S[0] = *(const u32x4*)(pv_ + lo16); V##S[1] = *(const u32x4*)(pv_ + 1024 + lo16); sv##S = bf2f(*(const bf16_t*)(pv_ + 2048 + 2 * lane)); } } while (0)
#define P12_U4(w_, hh_, j_) do { \
        a0_ = dot2bf(__builtin_bit_cast(unsigned, __builtin_amdgcn_cvt_scalef32_pk_bf16_fp4((w_), 1.0f, 0)), hh_[(j_)], a0_); a1_ = dot2bf(__builtin_bit_cast(unsigned, __builtin_amdgcn_cvt_scalef32_pk_bf16_fp4((w_), 1.0f, 1)), hh_[(j_) + 1], a1_); \
        a2_ = dot2bf(__builtin_bit_cast(unsigned, __builtin_amdgcn_cvt_scalef32_pk_bf16_fp4((w_), 1.0f, 2)), hh_[(j_) + 2], a2_); a3_ = dot2bf(__builtin_bit_cast(unsigned, __builtin_amdgcn_cvt_scalef32_pk_bf16_fp4((w_), 1.0f, 3)), hh_[(j_) + 3], a3_); } while (0)
#define P12_V4(w_, oo_, j_) do { \
        oo_[(j_)] = act2_ * __builtin_amdgcn_cvt_scalef32_pk_f16_fp4((w_), 1.0f, 0) + oo_[(j_)]; oo_[(j_) + 1] = act2_ * __builtin_amdgcn_cvt_scalef32_pk_f16_fp4((w_), 1.0f, 1) + oo_[(j_) + 1]; \
        oo_[(j_) + 2] = act2_ * __builtin_amdgcn_cvt_scalef32_pk_f16_fp4((w_), 1.0f, 2) + oo_[(j_) + 2]; oo_[(j_) + 3] = act2_ * __builtin_amdgcn_cvt_scalef32_pk_f16_fp4((w_), 1.0f, 3) + oo_[(j_) + 3]; } while (0)
#define P12_COMPUTE(S, idx_, fmt_) do { float a0_ = 0.f, a1_ = 0.f, a2_ = 0.f, a3_ = 0.f; \
        if ((fmt_) == 6) { \
            const u32x16 ua_ = __builtin_bit_cast(u32x16, __builtin_amdgcn_cvt_scalef32_pk32_bf16_fp6((u32x6){U##S[0].x, U##S[0].y, U##S[0].z, U##S[0].w, U##S[1].x, U##S[1].y}, 1.0f)); \
            const u32x16 ub_ = __builtin_bit_cast(u32x16, __builtin_amdgcn_cvt_scalef32_pk32_bf16_fp6((u32x6){U##S[1].z, U##S[1].w, U##S[2].x, U##S[2].y, U##S[2].z, U##S[2].w}, 1.0f)); \
            _Pragma("unroll") for (int j = 0; j < 16; j += 4) { a0_ = dot2bf(ua_[j], hA[j], a0_); a1_ = dot2bf(ua_[j + 1], hA[j + 1], a1_); a2_ = dot2bf(ua_[j + 2], hA[j + 2], a2_); a3_ = dot2bf(ua_[j + 3], hA[j + 3], a3_); } \
            _Pragma("unroll") for (int j = 0; j < 16; j += 4) { a0_ = dot2bf(ub_[j], hB[j], a0_); a1_ = dot2bf(ub_[j + 1], hB[j + 1], a1_); a2_ = dot2bf(ub_[j + 2], hB[j + 2], a2_); a3_ = dot2bf(ub_[j + 3], hB[j + 3], a3_); } \
            const float a_ = wave_sum((a0_ + a1_) + (a2_ + a3_)) * su##S; \
            const float act_ = gelu_fast(a_) * gtl[idx_] * sv##S; const h2_t act2_ = {(_Float16)act_, (_Float16)act_}; \
            const h32_t va_ = __builtin_amdgcn_cvt_scalef32_pk32_f16_fp6((u32x6){V##S[0].x, V##S[0].y, V##S[0].z, V##S[0].w, V##S[1].x, V##S[1].y}, 1.0f); \
            _Pragma("unroll") for (int j = 0; j < 16; ++j) oA[j] = act2_ * (h2_t){va_[2 * j], va_[2 * j + 1]} + oA[j]; \
            const h32_t vb_ = __builtin_amdgcn_cvt_scalef32_pk32_f16_fp6((u32x6){V##S[1].z, V##S[1].w, V##S[2].x, V##S[2].y, V##S[2].z, V##S[2].w}, 1.0f); \
            _Pragma("unroll") for (int j = 0; j < 16; ++j) oB[j] = act2_ * (h2_t){vb_[2 * j], vb_[2 * j + 1]} + oB[j]; \
        } else { \
            P12_U4(U##S[0].x, hA, 0); P12_U4(U##S[0].y, hA, 4); P12_U4(U##S[0].z, hA, 8); P12_U4(U##S[0].w, hA, 12); \
            P12_U4(U##S[1].x, hB, 0); P12_U4(U##S[1].y, hB, 4); P12_U4(U##S[1].z, hB, 8); P12_U4(U##S[1].w, hB, 12); \
            const float a_ = wave_sum(((a0_ + a1_) + (a2_ + a3_)) * su##S); \
            const float act_ = gelu_fast(a_) * gtl[idx_] * sv##S; const h2_t act2_ = {(_Float16)act_, (_Float16)act_}; \
            P12_V4(V##S[0].x, oA, 0); P12_V4(V##S[0].y, oA, 4); P12_V4(V##S[0].z, oA, 8); P12_V4(V##S[0].w, oA, 12); \
            P12_V4(V##S[1].x, oB, 0); P12_V4(V##S[1].y, oB, 4); P12_V4(V##S[1].z, oB, 8); P12_V4(V##S[1].w, oB, 12); } } while (0)
        P12_LOAD(A, 0, P12_FMT(0)); P12_LOAD(B, 1, P12_FMT(1)); P12_LOAD(C, 2, P12_FMT(2)); P12_LOAD(D, 3, P12_FMT(3));
#pragma unroll 1
        for (int s = 0; s < nb; ++s) {
            const int t = tb + s * tstride;
            if (s + 1 < nb) p12_route(pq + (size_t)(t + tstride) * 2048, tops, topi, exl + (s + 1) * 128, gtl + (s + 1) * 128, lane, ij4);
            unsigned hA[16], hB[16];
            { u32x4 ra[4], rb[4];
#pragma unroll
              for (int i = 0; i < 4; ++i) { ra[i] = *(const u32x4*)(h2 + (size_t)t * D + 16 * lane + 1024 * i); rb[i] = *(const u32x4*)(h2 + (size_t)t * D + 16 * lane + 1024 * i + 8); }
#pragma unroll
              for (int q = 0; q < 4; ++q) {
                  hA[2 * q] = __builtin_amdgcn_perm(ra[1][q], ra[0][q], 0x05040100u); hA[2 * q + 1] = __builtin_amdgcn_perm(ra[1][q], ra[0][q], 0x07060302u);
                  hA[8 + 2 * q] = __builtin_amdgcn_perm(rb[1][q], rb[0][q], 0x05040100u); hA[8 + 2 * q + 1] = __builtin_amdgcn_perm(rb[1][q], rb[0][q], 0x07060302u);
                  hB[2 * q] = __builtin_amdgcn_perm(ra[3][q], ra[2][q], 0x05040100u); hB[2 * q + 1] = __builtin_amdgcn_perm(ra[3][q], ra[2][q], 0x07060302u);
                  hB[8 + 2 * q] = __builtin_amdgcn_perm(rb[3][q], rb[2][q], 0x05040100u); hB[8 + 2 * q + 1] = __builtin_amdgcn_perm(rb[3][q], rb[2][q], 0x07060302u); } }
            h2_t oA[16], oB[16];
#pragma unroll
            for (int j = 0; j < 16; ++j) { oA[j] = (h2_t){(_Float16)0.f, (_Float16)0.f}; oB[j] = (h2_t){(_Float16)0.f, (_Float16)0.f}; }
#pragma unroll 1
            for (int hh = 0; hh < 8; ++hh) {
                const int f0 = s * 128 + hh * 16;
#pragma unroll
                for (int k = 0; k < 16; k += 4) {
                    P12_COMPUTE(A, f0 + k, P12_FMT(k)); P12_LOAD(A, f0 + k + 4, P12_FMT(k + 4));
                    P12_COMPUTE(B, f0 + k + 1, P12_FMT(k + 1)); P12_LOAD(B, f0 + k + 5, P12_FMT(k + 5));
                    P12_COMPUTE(C, f0 + k + 2, P12_FMT(k + 2)); P12_LOAD(C, f0 + k + 6, P12_FMT(k + 6));
                    P12_COMPUTE(D, f0 + k + 3, P12_FMT(k + 3)); P12_LOAD(D, f0 + k + 7, P12_FMT(k + 7));
                }
            }
#pragma unroll
            for (int i = 0; i < 4; ++i) { const int d0 = 16 * lane + 1024 * i; const float* op = C.out + (size_t)t * D + d0; float* dp = dst + (size_t)t * D + d0;
#pragma unroll
                for (int q = 0; q < 4; ++q) { const f32x4 xv = *(const f32x4*)(op + 4 * q); const f32x4 gv = *(const f32x4*)(gt2 + d0 + 4 * q); f32x4 r;
#pragma unroll
                    for (int j = 0; j < 4; ++j) { const h2_t ov = (i < 2) ? oA[4 * q + j] : oB[4 * q + j]; r[j] = xv[j] + gv[j] * ((i & 1) ? (float)ov.y : (float)ov.x); }
                    __builtin_nontemporal_store(r, (f32x4*)(dp + 4 * q)); } }
        }
#undef P12_U4
#undef P12_V4
#undef P12_FMT
#undef P12_LOAD
#undef P12_COMPUTE
        lds_sync();
    }
}

constexpr int N_PHASES = 13;
#ifndef DBG_MIX
#define DBG_MIX 0
#endif
__global__ void __launch_bounds__(NTHREADS, 2) fwd(Args args) {
    extern __shared__ __attribute__((aligned(16))) unsigned char lds_raw[];
    Ctx C0; C0.in = args.in; C0.out = args.out; C0.ws = args.ws; C0.lds = (LAS unsigned char*)lds_raw;
    C0.tid = threadIdx.x; C0.lane = C0.tid & 63; C0.wave = __builtin_amdgcn_readfirstlane(C0.tid >> 6);
#define PHASE_CTX() Ctx C = C0; { int t_ = threadIdx.x; asm volatile("" : "+v"(t_)); C.tid = t_; C.lane = t_ & 63; C.wave = __builtin_amdgcn_readfirstlane(t_ >> 6); }
    const Ctx& C = C0;
    const int lo = args.ph_lo, hi = args.ph_hi;
    const bool fused = (hi - lo) > 1;
    volatile LAS unsigned* bst = (volatile LAS unsigned*)(C.lds + LDS_BYTES - 16);
    XcdBarrier bar; bar.bar = (unsigned*)(C.ws + WS_CTL + CTL_BAR); bar.x = 0; bar.st = bst;
    if (fused) { if (C.tid == 0) { bst[0] = 0u; bst[1] = 0u; bst[2] = 0u; bst[3] = 0u; } __syncthreads(); bar = xcd_barrier_post((unsigned*)(C.ws + WS_CTL + CTL_BAR), bst); }
#ifndef ONLY_PHASE
#define ONLY_PHASE -1
#endif
#define IN(k) (lo <= (k) && (k) < hi && (ONLY_PHASE < 0 || ONLY_PHASE == (k)))
#ifndef REP_PHASE
#define REP_PHASE -1
#endif
#define REP(k, ...) if (REP_PHASE == (k)) { __VA_ARGS__ }
#define SEAM(k) do { if (IN(k) && IN((k) + 1)) xcd_barrier(bar); } while (0)
    const float* mod = (const float*)(C.ws + WS_MOD);
    bf16_t* proj = (bf16_t*)(C.ws + WS_PROJ);
    if (IN(0)) { PHASE_CTX(); REP(0, p0_prologue(C); __syncthreads();) p0_prologue(C); } SEAM(0);
    if (IN(1)) { PHASE_CTX(); norm_mod_phase(C, C.in[I_X], C.in[I_GMIX], mod + 0 * D, mod + 1 * D, (bf16_t*)(C.ws + WS_H), C.ws + WS_H8); } SEAM(1);
    if (IN(2)) { PHASE_CTX(); pg8::Gemm g{(const bf16_t*)(C.ws + WS_H), (const bf16_t*)(C.ws + WS_WIN), T, NP_BF, D, D, D}; pg8::StaticOrder S; S.init(T, NP_BF, gridDim.x, blockIdx.x);
                 pg8::EpiPlain E{proj, NP, 1.f}; pg8::gemm_phase(C.lds, g, S, E);
                 pg8::Gemm g8{(const bf16_t*)(C.ws + WS_H8), (const bf16_t*)(C.ws + WS_WIN8), T, NP_F8, D / 2, D / 2, D / 2}; pg8::Fp8Order S8{(int)blockIdx.x};
                 pg8::EpiSigU8 E8{(unsigned char*)(proj + P_GM), NP * 2, 1.f / 64.f}; pg8::gemm_phase<pg8::EpiSigU8, pg8::Fp8Order, true>(C.lds, g8, S8, E8); } SEAM(2);
    if (IN(3)) { PHASE_CTX(); p3_post(C); } SEAM(3);
    if (IN(4)) { PHASE_CTX(); pg8::Gemm g{(const bf16_t*)(C.ws + WS_KC), (const bf16_t*)(C.ws + WS_W1T), 8192, 512, 512, 2048, D}; pg8::CmpOrder S{(int)gridDim.x, (int)blockIdx.x};
                 pg8::EpiSlab E{(float*)(C.ws + WS_HIDP)}; pg8::gemm_phase(C.lds, g, S, E); } SEAM(4);
    if (IN(5)) { PHASE_CTX(); p5_cmp_out(C); } SEAM(5);
    if (IN(6)) { PHASE_CTX(); p6_mixers(C, DBG_MIX); } SEAM(6);
    if (IN(7)) { PHASE_CTX(); pg8::Gemm g{(const bf16_t*)(C.ws + WS_YA), (const bf16_t*)(C.ws + WS_WBA), T, D, 1024, 1024, 1024};   pg8::StaticOrder S; S.init(T, D, gridDim.x, blockIdx.x);
                 pg8::EpiGate<0> E{(bf16_t*)(C.ws + WS_MERGED), D, (const unsigned char*)(proj + P_GM), NP * 2, 1.f / (16.f * 64.f * 255.f), nullptr}; pg8::gemm_phase<pg8::EpiGate<0>, pg8::StaticOrder, true>(C.lds, g, S, E); } if (IN(7) && IN(8)) __syncthreads();
    if (IN(8)) { PHASE_CTX(); pg8::Gemm g{(const bf16_t*)(C.ws + WS_YB), (const bf16_t*)(C.ws + WS_WBB), T, D, 1024, 1024, 1024}; pg8::StaticOrder S; S.init(T, D, gridDim.x, blockIdx.x);
                 pg8::EpiGate<1> E{(bf16_t*)(C.ws + WS_MERGED), D, (const unsigned char*)(proj + P_GM) + 4096, NP * 2, 1.f / (16.f * 64.f * 255.f), C.ws + WS_H8}; pg8::gemm_phase<pg8::EpiGate<1>, pg8::StaticOrder, true>(C.lds, g, S, E); } SEAM(8);
    if (IN(9)) { PHASE_CTX(); pg8::Gemm g{(const bf16_t*)(C.ws + WS_H8), (const bf16_t*)(C.ws + WS_WOUT), T, D, D / 2, D / 2, D / 2};   pg8::StaticOrder S; S.init(T, D, gridDim.x, blockIdx.x);
                 pg8::EpiResid E{C.out, C.in[I_X], mod + 2 * D, D, 1.f / (32.f * 64.f)}; pg8::gemm_phase<pg8::EpiResid, pg8::StaticOrder, true>(C.lds, g, S, E); } SEAM(9);
    if (IN(10)) { PHASE_CTX(); norm_mod_phase(C, C.out, C.in[I_GFFN], mod + 3 * D, mod + 4 * D, (bf16_t*)(C.ws + WS_H2)); } SEAM(10);
    if (IN(11)) { PHASE_CTX(); pg8::Gemm g{(const bf16_t*)(C.ws + WS_H2), (const bf16_t*)(C.ws + WS_WQ), T, 2048, D, D, D}; pg8::StaticOrder S; S.init(T, 2048, gridDim.x, blockIdx.x);
                  pg8::EpiPlain E{(bf16_t*)(C.ws + WS_PQ), 2048, 1.f}; pg8::gemm_phase(C.lds, g, S, E); } SEAM(11);
    if (IN(12)) { PHASE_CTX(); REP(12, p12_peer(C, (float*)(C.ws + WS_PROJ)); __syncthreads();) p12_peer(C, C.out); }
#undef IN
#undef SEAM
}

#ifndef N_LAUNCH_MODE
#define N_LAUNCH_MODE 1
#endif
extern "C" void kernel_launch(void* const* d_in, const int* in_sizes, int n_in, void* d_out, int out_size, void* d_ws, size_t ws_size, hipStream_t stream) {
    static int grid = 0;
    if (grid == 0) {
        if (n_in != 27 || out_size != T * D || ws_size < WS_END) { fprintf(stderr, "kernel_launch: unexpected shapes (n_in %d out %d ws %zu need %zu)\n", n_in, out_size, ws_size, (size_t)WS_END); grid = -1; return; }
        int dev = 0, cus = 0;
        if (hipGetDevice(&dev) != hipSuccess || hipDeviceGetAttribute(&cus, hipDeviceAttributeMultiprocessorCount, dev) != hipSuccess) { grid = -1; return; }
        if (hipFuncSetAttribute((const void*)fwd, hipFuncAttributeMaxDynamicSharedMemorySize, LDS_BYTES) != hipSuccess) { fprintf(stderr, "kernel_launch: hipFuncSetAttribute failed\n"); grid = -1; return; }
        int per_cu = 0;
        if (hipOccupancyMaxActiveBlocksPerMultiprocessor(&per_cu, (const void*)fwd, NTHREADS, LDS_BYTES) != hipSuccess || per_cu < 1) { fprintf(stderr, "kernel_launch: occupancy query says %d\n", per_cu); }
        (void)hipGetLastError();
        grid = cus;
    }
    if (grid < 0) return;
    (void)hipMemsetAsync((char*)d_ws + WS_CTL, 0, 64 * 1024, stream);
    Args a{};
    for (int i = 0; i < 27; ++i) a.in[i] = (const float*)d_in[i];
    a.out = (float*)d_out; a.ws = (unsigned char*)d_ws;
#if N_LAUNCH_MODE == 1
    a.ph_lo = 0; a.ph_hi = N_PHASES;
    hipLaunchKernelGGL(fwd, dim3(grid), dim3(NTHREADS), LDS_BYTES, stream, a);
#else
    for (int p = 0; p < N_PHASES; ++p) { a.ph_lo = p; a.ph_hi = p + 1; hipLaunchKernelGGL(fwd, dim3(grid), dim3(NTHREADS), LDS_BYTES, stream, a); }
#endif
}
```

```cpp
#include <hip/hip_runtime.h>
#include <cstdio>
#include <cstdint>

#define LAS __attribute__((address_space(3)))
typedef unsigned short bf16_t;
typedef unsigned long long u64;
typedef short bf16x8 __attribute__((ext_vector_type(8)));
typedef float f32x4 __attribute__((ext_vector_type(4)));
typedef float f32x16 __attribute__((ext_vector_type(16)));
typedef unsigned u32x4 __attribute__((ext_vector_type(4)));
typedef unsigned u32x2 __attribute__((ext_vector_type(2)));
typedef __bf16 bf2_t __attribute__((ext_vector_type(2)));
typedef float f32x2 __attribute__((ext_vector_type(2)));
typedef float f32x32 __attribute__((ext_vector_type(32)));
typedef unsigned u32x6 __attribute__((ext_vector_type(6)));
typedef _Float16 hx2_t __attribute__((ext_vector_type(2)));

constexpr int T = 16384, D = 4096, NP = 18688;
constexpr int P_QA = 0, P_KA = 2048, P_VA = 2560, P_QI = 3072, P_QB = 5120, P_KC = 7168, P_VC = 7680, P_KS = 8192, P_VS = 8704,
              P_KW = 9216, P_VW = 9728, P_KI = 10240, P_WI = 10304, P_GB = 10336, P_GM = 10496;
constexpr int NP_BF = 10496, NP_F8 = 8192;
constexpr int NCMP = 1023;
constexpr float EPS = 1e-6f;
constexpr int NTHREADS = 512;
constexpr int LDS_BYTES = 160 * 1024;

constexpr size_t MB = 1024ull * 1024ull;
constexpr size_t WS_CTL = 0;
constexpr size_t WS_MOD = 64 * 1024;
constexpr size_t WS_B1 = 192 * 1024;
constexpr size_t WS_B1P = 196 * 1024;
constexpr size_t WS_W1T = 512 * 1024;
constexpr size_t WS_SUBK = WS_W1T + 4 * MB;
constexpr size_t WS_HID = WS_SUBK + 512 * 1024;
constexpr size_t WS_KCMP = WS_HID + 8 * MB;
constexpr size_t WS_VCMPT = WS_KCMP + 1 * MB;
constexpr size_t WS_KIC = WS_VCMPT + 1 * MB;
constexpr size_t WS_KC = WS_KIC + 2 * MB;
constexpr size_t WS_VST = WS_KC + 32 * MB + 64 * 1024;
constexpr size_t WS_VWT = WS_VST + 16 * MB;
constexpr size_t WS_WBA = WS_VWT + 16 * MB;
constexpr size_t WS_WBB = WS_WBA + 16 * MB;
constexpr size_t WS_WOUT = WS_WBB + 16 * MB;
constexpr size_t WS_WQ = WS_WOUT + 32 * MB;
constexpr size_t WS_PU = WS_WQ + 16 * MB;
constexpr size_t WS_PV = WS_PU + 128 * MB;
constexpr size_t WS_PU4 = WS_PU + 56 * MB, WS_PV4 = WS_PV + 56 * MB;
constexpr size_t WS_PROJ = WS_PV + 128 * MB;
constexpr size_t WS_WIN = WS_PROJ + (size_t)T * NP * 2;
constexpr size_t WS_H = WS_WIN + (size_t)NP * D * 2;
constexpr size_t WS_KA = WS_H + 128 * MB;
constexpr size_t WS_VA = WS_KA + 16 * MB;
constexpr size_t WS_KSC = WS_VA + 16 * MB;
constexpr size_t WS_KWC = WS_KSC + 16 * MB;
constexpr size_t WS_HIDP = WS_KWC + 16 * MB;
constexpr size_t WS_OACC = WS_HIDP + 64 * MB;
constexpr size_t WS_H8 = WS_OACC + 32 * MB;
constexpr size_t WS_END = WS_H8 + 64 * MB;
constexpr size_t WS_WIN8 = WS_WIN + (size_t)NP_BF * D * 2;
constexpr size_t WS_YA = WS_WIN, WS_YB = WS_WIN + 64 * MB, WS_H2 = WS_WIN;
constexpr size_t WS_MERGED = WS_H, WS_PQ = WS_H;
constexpr size_t CTL_BAR = 0, CTL_CNT = 16384;

__device__ __forceinline__ float bf2f(bf16_t b) { return __uint_as_float(((unsigned)b) << 16); }
__device__ __forceinline__ float bflo(unsigned u) { return __uint_as_float(u << 16); }
__device__ __forceinline__ float bfhi(unsigned u) { return __uint_as_float(u & 0xFFFF0000u); }
__device__ __forceinline__ unsigned cvt_pk_bf16(float lo, float hi) { unsigned r; asm volatile("v_cvt_pk_bf16_f32 %0, %1, %2" : "=v"(r) : "v"(lo), "v"(hi)); return r; }
__device__ __forceinline__ bf16_t f2bf(float f) { return (bf16_t)(cvt_pk_bf16(f, 0.f) & 0xFFFFu); }
__device__ __forceinline__ float dot2bf(unsigned a, unsigned b, float c) { return __builtin_amdgcn_fdot2_f32_bf16(__builtin_bit_cast(bf2_t, a), __builtin_bit_cast(bf2_t, b), c, false); }
template <int CTRL> __device__ __forceinline__ float dppf(float v) { return __builtin_bit_cast(float, __builtin_amdgcn_update_dpp(0, __builtin_bit_cast(int, v), CTRL, 0xF, 0xF, true)); }
template <int CTRL> __device__ __forceinline__ unsigned dppu(unsigned v) { return (unsigned)__builtin_amdgcn_update_dpp(0, (int)v, CTRL, 0xF, 0xF, true); }
__device__ __forceinline__ void swap32f(float& a, float& b) { asm volatile("s_nop 1\n\tv_permlane32_swap_b32 %0, %1" : "+v"(a), "+v"(b)); }
__device__ __forceinline__ void swap16f(float& a, float& b) { asm volatile("s_nop 1\n\tv_permlane16_swap_b32 %0, %1" : "+v"(a), "+v"(b)); }
__device__ __forceinline__ void swap32u(unsigned& a, unsigned& b) { asm volatile("s_nop 1\n\tv_permlane32_swap_b32 %0, %1" : "+v"(a), "+v"(b)); }
__device__ __forceinline__ void swap16u(unsigned& a, unsigned& b) { asm volatile("s_nop 1\n\tv_permlane16_swap_b32 %0, %1" : "+v"(a), "+v"(b)); }
__device__ __forceinline__ float fmax_fast(float a, float b) { float r; asm("v_max_f32 %0, %1, %2" : "=v"(r) : "v"(a), "v"(b)); return r; }
__device__ __forceinline__ float xsum32(float v) { float a = v, b = v; swap32f(a, b); return a + b; }
__device__ __forceinline__ float xsum16(float v) { float a = v, b = v; swap16f(a, b); return a + b; }
__device__ __forceinline__ float xmax32(float v) { float a = v, b = v; swap32f(a, b); return fmax_fast(a, b); }
__device__ __forceinline__ float xmax16(float v) { float a = v, b = v; swap16f(a, b); return fmax_fast(a, b); }
__device__ __forceinline__ float xor32f(float v, int h) { float a = v, b = v; swap32f(a, b); return h ? a : b; }
__device__ __forceinline__ float wave_sum(float v) { v += dppf<0xB1>(v); v += dppf<0x4E>(v); v += dppf<0x141>(v); v += dppf<0x140>(v); return xsum16(xsum32(v)); }
__device__ __forceinline__ float wave_max(float v) { v = fmax_fast(v, dppf<0xB1>(v)); v = fmax_fast(v, dppf<0x4E>(v)); v = fmax_fast(v, dppf<0x141>(v)); v = fmax_fast(v, dppf<0x140>(v)); return xmax16(xmax32(v)); }
__device__ __forceinline__ unsigned umaxu(unsigned a, unsigned b) { return a > b ? a : b; }
__device__ __forceinline__ unsigned wave_maxu(unsigned v) { v = umaxu(v, dppu<0xB1>(v)); v = umaxu(v, dppu<0x4E>(v)); v = umaxu(v, dppu<0x141>(v)); v = umaxu(v, dppu<0x140>(v));
    unsigned a = v, b = v; swap32u(a, b); v = umaxu(a, b); a = v; b = v; swap16u(a, b); return umaxu(a, b); }
__device__ __forceinline__ void lds_sync() { asm volatile("s_waitcnt lgkmcnt(0)" ::: "memory"); __builtin_amdgcn_wave_barrier(); }
__device__ __forceinline__ float gelu_tanh(float x) { const float u = 0.7978845608028654f * (x + 0.044715f * x * x * x); const float e = __expf(2.f * u); return 0.5f * x * (2.f - 2.f / (e + 1.f)); }
__device__ __forceinline__ float sigmoidf_(float x) { return __builtin_amdgcn_rcpf(1.f + __expf(-x)); }
__device__ __forceinline__ unsigned sortable(float s) { unsigned b = __float_as_uint(s); return b ^ ((b >> 31) ? 0xFFFFFFFFu : 0x80000000u); }

#define XB_TMO      128
#define XB_XCNT(j)  (256  + 64 * (j))
#define XB_XSUB(j)  (1280 + 64 * (j))
#define XB_XGEN(j)  (2304 + 64 * (j))
#define XB_TOP      3328
#define XB_TOPGEN   3392
#define XCD_BAR_WORDS 3456
#define XB_SPIN_CAP (1u << 24)
__device__ __forceinline__ unsigned xb_ld(unsigned* p)              { return __hip_atomic_load(p, __ATOMIC_RELAXED, __HIP_MEMORY_SCOPE_AGENT); }
__device__ __forceinline__ unsigned xb_add(unsigned* p, unsigned v) { return __hip_atomic_fetch_add(p, v, __ATOMIC_RELAXED, __HIP_MEMORY_SCOPE_AGENT); }
__device__ __forceinline__ unsigned xb_xcc_id() { return (unsigned)__builtin_amdgcn_s_getreg((3 << 11) | 20) & 0xFu; }
#define XB_SPIN(cond, bar) do { unsigned _sp = 0; while (cond) { __builtin_amdgcn_s_sleep(1); \
    if ((++_sp & 255u) == 0u) { if (xb_ld(&(bar)[XB_TMO])) break; if (_sp > XB_SPIN_CAP) { atomicAdd(&(bar)[XB_TMO], 1u); break; } } } } while (0)
struct XcdBarrier { unsigned* bar; unsigned x; volatile LAS unsigned* st; };
__device__ __forceinline__ XcdBarrier xcd_barrier_post(unsigned* bar, volatile LAS unsigned* st) {
    XcdBarrier b; b.bar = bar; b.x = xb_xcc_id(); b.st = st;
    if (threadIdx.x == 0) (void)xb_add(&bar[XB_XCNT(b.x)], 1u);
    return b;
}
__device__ __forceinline__ void xcd_barrier_complete(unsigned* bar, unsigned x, unsigned& nloc, unsigned& nx) {
    const unsigned G = gridDim.x * gridDim.y * gridDim.z;
    unsigned sum, cnt, mine, sp = 0u;
    for (;;) {
        sum = 0u; cnt = 0u; mine = 0u;
#pragma unroll
        for (unsigned j = 0; j < 16; ++j) { const unsigned c = xb_ld(&bar[XB_XCNT(j)]); sum += c; cnt += (c > 0u) ? 1u : 0u; mine = (j == x) ? c : mine; }
        if (sum == G) break;
        __builtin_amdgcn_s_sleep(1);
        if ((++sp & 255u) == 0u) { if (xb_ld(&bar[XB_TMO])) break; if (sp > XB_SPIN_CAP) { atomicAdd(&bar[XB_TMO], 1u); break; } }
    }
    nloc = mine > 0u ? mine : 1u; nx = cnt > 0u ? cnt : 1u;
}
__device__ __forceinline__ void xcd_barrier(const XcdBarrier& b) {
    asm volatile("s_waitcnt vmcnt(0)" ::: "memory");
    __syncthreads();
    if (threadIdx.x == 0) {
        unsigned* bar = b.bar;
        __builtin_amdgcn_s_waitcnt(0);
        unsigned nloc = b.st[0], nx = b.st[1];
        if (nloc == 0u) { xcd_barrier_complete(bar, b.x, nloc, nx); b.st[0] = nloc; b.st[1] = nx; }
        const unsigned old = xb_add(&bar[XB_XSUB(b.x)], 1u);
        const unsigned gen = old / nloc;
        if (old + 1u == (gen + 1u) * nloc) {
            __builtin_amdgcn_fence(__ATOMIC_RELEASE, "agent");
            asm volatile("s_waitcnt vmcnt(0)" ::: "memory");
            const unsigned og = xb_add(&bar[XB_TOP], 1u);
            const unsigned tg = og / nx;
            if (og + 1u == (tg + 1u) * nx) xb_add(&bar[XB_TOPGEN], 1u);
            else XB_SPIN(xb_ld(&bar[XB_TOPGEN]) == tg, bar);
            __builtin_amdgcn_fence(__ATOMIC_ACQUIRE, "agent");
            xb_add(&bar[XB_XGEN(b.x)], 1u);
            asm volatile("s_waitcnt vmcnt(0)" ::: "memory");
        } else {
            XB_SPIN(xb_ld(&bar[XB_XGEN(b.x)]) == gen, bar);
            __builtin_amdgcn_fence(__ATOMIC_ACQUIRE, "agent");
            asm volatile("s_waitcnt vmcnt(0)" ::: "memory");
        }
    }
    __syncthreads();
}

namespace pg8 {
constexpr int BM = 256, BK = 64, HALF = 128, HTB = HALF * BK * 2, STAGE_BYTES = 8 * HTB, NXCD = 8, WGM = 8;
__host__ __device__ __forceinline__ int lds_byte(int r, int c) { const int st = (r >> 4) * 2 + (c >> 5), rr = r & 15, cc = c & 31, ob = rr * 64 + cc * 2; return st * 1024 + (ob ^ (((ob >> 9) & 1) << 5)); }
__host__ __device__ __forceinline__ void stage_rc(int b, int& R, int& C) { const int st = b / 1024, sb = b % 1024, swz = sb ^ (((sb >> 9) & 1) << 5); R = (st >> 1) * 16 + swz / 64; C = (st & 1) * 32 + (swz % 64) / 2; }
__host__ __device__ __forceinline__ int perm32(int rho) { const int n = rho >> 4, i = rho & 15; return 8 * (i >> 2) + 4 * n + (i & 3); }
struct Unit { int pm, pn, kofs; };
struct Gemm { const bf16_t* A; const bf16_t* Bt; int M, N, K, lda, ldb; };
struct StaticOrder {
    int nM, nN, nwg, G, c;
    __host__ __device__ void init(int M, int N, int G_, int c_) { nM = M / BM; nN = N / BM; nwg = nM * nN; G = G_; c = c_; }
    __host__ __device__ bool next(int i, Unit& u) const {
        const long L = (long)i * G + c; if (L >= nwg) return false;
        int wgid = (int)L; { const int q = nwg / NXCD, r = nwg % NXCD, xcd = wgid % NXCD, off = wgid / NXCD; wgid = (xcd < r ? xcd * (q + 1) : r * (q + 1) + (xcd - r) * q) + off; }
        const int nig = WGM * nN, gid = wgid / nig, fm = gid * WGM, gsz = (nM - fm) < WGM ? (nM - fm) : WGM;
        u.pm = fm + ((wgid % nig) % gsz); u.pn = (wgid % nig) / gsz; u.kofs = 0; return true;
    }
};
struct Fp8Order {
    int c;
    __host__ __device__ bool next(int i, Unit& u) const {
        const int cnt = c < 64 ? 6 : (c < 192 ? 9 : 8); if (i >= cnt) return false;
        const int off = c < 64 ? 6 * c : (c < 192 ? 384 + 9 * (c - 64) : 1536 + 8 * (c - 192));
        const int L = off + i; u.pm = L & 63; u.pn = L >> 6; u.kofs = 0; return true; }
};
struct CmpOrder {
    int G, c;
    __host__ __device__ bool next(int i, Unit& u) const { const long L = (long)i * G + c; if (L >= 256) return false; u.pm = (int)(L & 31); u.pn = u.pm >> 4; u.kofs = (int)(L >> 5) * 512; return true; }
};

struct EpiPlain {
    static constexpr bool PERM = true;
    bf16_t* O; int ldc; float scale;
    __device__ __forceinline__ void operator()(const f32x4 (&acc)[2][2][4][2], const Unit& u, int wr, int wc, int fr, int fq) const {
        const int row0 = u.pm * BM + wr * 64 + fr, col0 = u.pn * BM + wc * 32 + 8 * fq;
#pragma unroll
        for (int ai = 0; ai < 2; ++ai)
#pragma unroll
            for (int m = 0; m < 4; ++m) { bf16_t* rowp = O + (size_t)(row0 + ai * HALF + m * 16) * ldc + col0;
#pragma unroll
                for (int bj = 0; bj < 2; ++bj) { const f32x4 v0 = acc[ai][bj][m][0] * scale, v1 = acc[ai][bj][m][1] * scale;
                    u32x4 w; w.x = cvt_pk_bf16(v0[0], v0[1]); w.y = cvt_pk_bf16(v0[2], v0[3]); w.z = cvt_pk_bf16(v1[0], v1[1]); w.w = cvt_pk_bf16(v1[2], v1[3]);
                    *(u32x4*)(rowp + bj * HALF) = w; } }
    }
};
struct EpiSigU8 {
    static constexpr bool PERM = true;
    unsigned char* O; int ldb; float scale;
    __device__ __forceinline__ void operator()(const f32x4 (&acc)[2][2][4][2], const Unit& u, int wr, int wc, int fr, int fq) const {
        const int row0 = u.pm * BM + wr * 64 + fr, col0 = u.pn * BM + wc * 32 + 8 * fq;
#pragma unroll
        for (int ai = 0; ai < 2; ++ai)
#pragma unroll
            for (int m = 0; m < 4; ++m) { unsigned char* rowp = O + (size_t)(row0 + ai * HALF + m * 16) * ldb + col0;
#pragma unroll
                for (int bj = 0; bj < 2; ++bj) { const f32x4 v0 = acc[ai][bj][m][0] * scale, v1 = acc[ai][bj][m][1] * scale;
                    unsigned w0 = 0u, w1 = 0u;
                    w0 = __builtin_amdgcn_cvt_pk_u8_f32(255.f * sigmoidf_(v0[0]), 0, w0); w0 = __builtin_amdgcn_cvt_pk_u8_f32(255.f * sigmoidf_(v0[1]), 1, w0);
                    w0 = __builtin_amdgcn_cvt_pk_u8_f32(255.f * sigmoidf_(v0[2]), 2, w0); w0 = __builtin_amdgcn_cvt_pk_u8_f32(255.f * sigmoidf_(v0[3]), 3, w0);
                    w1 = __builtin_amdgcn_cvt_pk_u8_f32(255.f * sigmoidf_(v1[0]), 0, w1); w1 = __builtin_amdgcn_cvt_pk_u8_f32(255.f * sigmoidf_(v1[1]), 1, w1);
                    w1 = __builtin_amdgcn_cvt_pk_u8_f32(255.f * sigmoidf_(v1[2]), 2, w1); w1 = __builtin_amdgcn_cvt_pk_u8_f32(255.f * sigmoidf_(v1[3]), 3, w1);
                    *(u32x2*)(rowp + bj * HALF) = (u32x2){w0, w1}; } }
    }
};
template <int SECOND> struct EpiGate {
    static constexpr bool PERM = true;
    bf16_t* O; int ldc; const unsigned char* gate; int ldg; float scale; unsigned char* O8;
    __device__ __forceinline__ void operator()(const f32x4 (&acc)[2][2][4][2], const Unit& u, int wr, int wc, int fr, int fq) const {
        const int row0 = u.pm * BM + wr * 64 + fr, col0 = u.pn * BM + wc * 32 + 8 * fq;
#pragma unroll
        for (int ai = 0; ai < 2; ++ai)
#pragma unroll
            for (int m = 0; m < 4; ++m) { const size_t row = (size_t)(row0 + ai * HALF + m * 16); bf16_t* rowp = O + row * ldc + col0; const unsigned char* gp = gate + row * ldg + col0;
#pragma unroll
                for (int bj = 0; bj < 2; ++bj) { const f32x4 v0 = acc[ai][bj][m][0] * scale, v1 = acc[ai][bj][m][1] * scale;
                    const u32x2 gv = *(const u32x2*)(gp + bj * HALF);
                    float r[8];
#pragma unroll
                    for (int e = 0; e < 4; ++e) { r[e] = (float)((gv.x >> (8 * e)) & 0xFFu) * v0[e]; r[4 + e] = (float)((gv.y >> (8 * e)) & 0xFFu) * v1[e]; }
                    if (SECOND) { const u32x4 pv = *(const u32x4*)(rowp + bj * HALF);
                        r[0] += bflo(pv.x); r[1] += bfhi(pv.x); r[2] += bflo(pv.y); r[3] += bfhi(pv.y); r[4] += bflo(pv.z); r[5] += bfhi(pv.z); r[6] += bflo(pv.w); r[7] += bfhi(pv.w);
                        int p0 = __builtin_amdgcn_cvt_pk_fp8_f32(r[0] * 32.f, r[1] * 32.f, 0, false); p0 = __builtin_amdgcn_cvt_pk_fp8_f32(r[2] * 32.f, r[3] * 32.f, p0, true);
                        int p1 = __builtin_amdgcn_cvt_pk_fp8_f32(r[4] * 32.f, r[5] * 32.f, 0, false); p1 = __builtin_amdgcn_cvt_pk_fp8_f32(r[6] * 32.f, r[7] * 32.f, p1, true);
                        *(u32x2*)(O8 + row * ldc + col0 + bj * HALF) = (u32x2){(unsigned)p0, (unsigned)p1};
                    } else {
                    u32x4 w; w.x = cvt_pk_bf16(r[0], r[1]); w.y = cvt_pk_bf16(r[2], r[3]); w.z = cvt_pk_bf16(r[4], r[5]); w.w = cvt_pk_bf16(r[6], r[7]);
                    *(u32x4*)(rowp + bj * HALF) = w; } } }
    }
};
struct EpiResid {
    static constexpr bool PERM = false;
    float* C; const float* X; const float* gt; int ldc; float scale;
    __device__ __forceinline__ void operator()(const f32x4 (&acc)[2][2][4][2], const Unit& u, int wr, int wc, int fr, int fq) const {
        const int row0 = u.pm * BM + wr * 64 + fr, col0 = u.pn * BM + wc * 32 + 4 * fq;
        f32x4 gv[2][2];
#pragma unroll
        for (int bj = 0; bj < 2; ++bj)
#pragma unroll
            for (int n = 0; n < 2; ++n) gv[bj][n] = *(const f32x4*)(gt + col0 + bj * HALF + n * 16) * scale;
#pragma unroll
        for (int ai = 0; ai < 2; ++ai)
#pragma unroll
            for (int m = 0; m < 4; ++m) { const size_t off = (size_t)(row0 + ai * HALF + m * 16) * ldc + col0;
#pragma unroll
                for (int bj = 0; bj < 2; ++bj)
#pragma unroll
                    for (int n = 0; n < 2; ++n) { const f32x4 xv = *(const f32x4*)(X + off + bj * HALF + n * 16);
                        *(f32x4*)(C + off + bj * HALF + n * 16) = xv + gv[bj][n] * acc[ai][bj][m][n]; } }
    }
};
struct EpiSlab {
    static constexpr bool PERM = false;
    float* C;
    __device__ __forceinline__ void operator()(const f32x4 (&acc)[2][2][4][2], const Unit& u, int wr, int wc, int fr, int fq) const {
        const int row0 = u.pm * BM + wr * 64 + fr, col0 = wc * 32 + 4 * fq;
        float* base = C + (size_t)(u.kofs >> 9) * 8192 * 256;
#pragma unroll
        for (int ai = 0; ai < 2; ++ai)
#pragma unroll
            for (int m = 0; m < 4; ++m) { float* rowp = base + (size_t)(row0 + ai * HALF + m * 16) * 256 + col0;
#pragma unroll
                for (int bj = 0; bj < 2; ++bj)
#pragma unroll
                    for (int n = 0; n < 2; ++n) *(f32x4*)(rowp + bj * HALF + n * 16) = acc[ai][bj][m][n]; }
    }
};

typedef int i32x8 __attribute__((ext_vector_type(8)));
template <class Epi, class Sched, bool FP8 = false>
__device__ __forceinline__ void gemm_phase(LAS unsigned char* lds, const Gemm g, const Sched& S, const Epi& E) {
    const int tid = threadIdx.x, wid = __builtin_amdgcn_readfirstlane(tid >> 6), lane = tid & 63, wr = wid >> 2, wc = wid & 3, fr = lane & 15, fq = lane >> 4;
    const int K = g.K, nt = K / BK, lda = g.lda, ldb = g.ldb;
    unsigned voffA[2], voffB[2];
#pragma unroll
    for (int i = 0; i < 2; ++i) { int R, C; stage_rc(tid * 16 + i * 8192, R, C); const int Rb = Epi::PERM ? ((R & ~31) + perm32(R & 31)) : R;
        voffA[i] = (unsigned)(R * lda + C) * 2u; voffB[i] = (unsigned)(Rb * ldb + C) * 2u; }
    const size_t kstep = (size_t)(BK * 2);
    const size_t hstepA = (size_t)HALF * lda * 2, hstepB = (size_t)HALF * ldb * 2;
    const size_t tstepA = 2 * hstepA, tstepB = 2 * hstepB;
    const unsigned ldsw = (unsigned)wid * 1024u;
    const int aoff = lds_byte(wr * 64 + fr, fq * 8), boff = lds_byte(wc * 32 + fr, fq * 8);
#define PG8_SA(b, h) (((b) * 2 + (h)) * HTB)
#define PG8_SB(b, h) ((4 + (b) * 2 + (h)) * HTB)
#define PG8_STAGE(bufoff, gbase, voff) do { _Pragma("unroll") for (int _i = 0; _i < 2; ++_i) \
        __builtin_amdgcn_global_load_lds((const unsigned*)((const char*)(gbase) + (voff)[_i]), (LAS unsigned*)(lds + (bufoff) + ldsw + _i * 8192), 16, 0, 0); } while (0)
#define PG8_LDA(dst, b, h) do { _Pragma("unroll") for (int m = 0; m < 4; ++m) { if constexpr (FP8) dst##8[m] = __builtin_shufflevector(*(const LAS i32x4_*)(lds + PG8_SA(b, h) + aoff + m * 2048), *(const LAS i32x4_*)(lds + PG8_SA(b, h) + aoff + m * 2048 + 1024), 0, 1, 2, 3, 4, 5, 6, 7); \
        else { _Pragma("unroll") for (int k = 0; k < 2; ++k) dst[m][k] = *(const LAS bf16x8*)(lds + PG8_SA(b, h) + aoff + m * 2048 + k * 1024); } } } while (0)
#define PG8_LDB(dst, b, h) do { _Pragma("unroll") for (int n = 0; n < 2; ++n) { if constexpr (FP8) dst##8[n] = __builtin_shufflevector(*(const LAS i32x4_*)(lds + PG8_SB(b, h) + boff + n * 2048), *(const LAS i32x4_*)(lds + PG8_SB(b, h) + boff + n * 2048 + 1024), 0, 1, 2, 3, 4, 5, 6, 7); \
        else { _Pragma("unroll") for (int k = 0; k < 2; ++k) dst[n][k] = *(const LAS bf16x8*)(lds + PG8_SB(b, h) + boff + n * 2048 + k * 1024); } } } while (0)
typedef int i32x4_ __attribute__((ext_vector_type(4)));
#define PG8_MMA(ai, bj, At, Bt) do { __builtin_amdgcn_s_setprio(1); _Pragma("unroll") for (int m = 0; m < 4; ++m) _Pragma("unroll") for (int n = 0; n < 2; ++n) { \
        if constexpr (FP8) asm volatile("v_mfma_scale_f32_16x16x128_f8f6f4 %0, %1, %2, %0, %3, %3 op_sel_hi:[0,0,0]" : "+v"(acc[ai][bj][m][n]) : "v"(Bt##8[n]), "v"(At##8[m]), "v"(one_scale)); \
        else { _Pragma("unroll") for (int k = 0; k < 2; ++k) acc[ai][bj][m][n] = __builtin_amdgcn_mfma_f32_16x16x32_bf16(Bt[n][k], At[m][k], acc[ai][bj][m][n], 0, 0, 0); } } \
        __builtin_amdgcn_s_setprio(0); } while (0)
#define PG8_WAIT_V(n) asm volatile("s_waitcnt vmcnt(" #n ")" ::: "memory")
#define PG8_WAIT_L(n) asm volatile("s_waitcnt lgkmcnt(" #n ")" ::: "memory")
#define PG8_BAR __builtin_amdgcn_s_barrier()
#define PG8_SCHED __builtin_amdgcn_sched_barrier(0)
    Unit cur, nxt; int ui = 0;
    if (!S.next(0, cur)) return;
    f32x4 acc[2][2][4][2];
#pragma unroll
    for (int a = 0; a < 2; ++a)
#pragma unroll
        for (int b = 0; b < 2; ++b)
#pragma unroll
            for (int m = 0; m < 4; ++m)
#pragma unroll
                for (int n = 0; n < 2; ++n) acc[a][b][m][n] = (f32x4){0.f, 0.f, 0.f, 0.f};
    bf16x8 At[4][2], B0[2][2], B1[2][2];
    i32x8 At8[4], B08[2], B18[2];
    const int one_scale = 0x7F7F7F7F;
    const char* cA = (const char*)g.A + (size_t)cur.pm * tstepA + (size_t)cur.kofs * 2; const char* cB = (const char*)g.Bt + (size_t)cur.pn * tstepB + (size_t)cur.kofs * 2;
    PG8_STAGE(PG8_SB(0, 0), cB, voffB); PG8_STAGE(PG8_SB(0, 1), cB + hstepB, voffB); PG8_STAGE(PG8_SA(0, 0), cA, voffA); PG8_STAGE(PG8_SA(0, 1), cA + hstepA, voffA);
    if (wr == 1) PG8_BAR;
    PG8_WAIT_V(2); PG8_BAR;
    PG8_STAGE(PG8_SB(1, 0), cB + kstep, voffB); PG8_STAGE(PG8_SA(1, 0), cA + kstep, voffA); PG8_STAGE(PG8_SB(1, 1), cB + hstepB + kstep, voffB);
    PG8_WAIT_V(6); PG8_BAR;
    for (;;) {
        const bool has_next = S.next(ui + 1, nxt);
        const char* nA = has_next ? (const char*)g.A + (size_t)nxt.pm * tstepA + (size_t)nxt.kofs * 2 : cA; const char* nB = has_next ? (const char*)g.Bt + (size_t)nxt.pn * tstepB + (size_t)nxt.kofs * 2 : cB;
        for (int t = 0; t < nt; t += 2) {
            const bool last = (t == nt - 2);
            const char* a1 = cA + (size_t)(t + 1) * kstep;
            const char* a2 = last ? nA : cA + (size_t)(t + 2) * kstep; const char* b2 = last ? nB : cB + (size_t)(t + 2) * kstep;
            const char* a3 = a2 + kstep; const char* b3 = b2 + kstep;
            PG8_LDB(B0, 0, 0); PG8_LDB(B1, 0, 1); PG8_SCHED; PG8_LDA(At, 0, 0); PG8_STAGE(PG8_SA(1, 1), a1 + hstepA, voffA);
            PG8_WAIT_V(8); PG8_WAIT_L(0); PG8_BAR; PG8_MMA(0, 0, At, B0); PG8_MMA(0, 1, At, B1); PG8_BAR; PG8_SCHED;
            PG8_LDA(At, 0, 1); PG8_STAGE(PG8_SB(0, 0), b2, voffB); PG8_STAGE(PG8_SB(0, 1), b2 + hstepB, voffB); PG8_STAGE(PG8_SA(0, 0), a2, voffA);
            PG8_WAIT_V(8); PG8_WAIT_L(0); PG8_BAR; PG8_MMA(1, 0, At, B0); PG8_MMA(1, 1, At, B1); PG8_BAR; PG8_SCHED;
            PG8_LDB(B0, 1, 0); PG8_LDB(B1, 1, 1); PG8_SCHED; PG8_LDA(At, 1, 0); PG8_STAGE(PG8_SA(0, 1), a2 + hstepA, voffA);
            PG8_WAIT_V(8); PG8_WAIT_L(0); PG8_BAR; PG8_MMA(0, 0, At, B0); PG8_MMA(0, 1, At, B1); PG8_BAR; PG8_SCHED;
            PG8_LDA(At, 1, 1); PG8_STAGE(PG8_SB(1, 0), b3, voffB); PG8_STAGE(PG8_SB(1, 1), b3 + hstepB, voffB); PG8_STAGE(PG8_SA(1, 0), a3, voffA);
            PG8_WAIT_V(8); PG8_WAIT_L(0); PG8_BAR; PG8_MMA(1, 0, At, B0); PG8_MMA(1, 1, At, B1); PG8_BAR; PG8_SCHED;
        }
        if (wr == 0) PG8_BAR;
        if constexpr (FP8) asm volatile("s_nop 15\n\ts_nop 15\n\ts_nop 15" ::: "memory");
        E(acc, cur, wr, wc, fr, fq);
        if (!has_next) break;
#pragma unroll
        for (int a = 0; a < 2; ++a)
#pragma unroll
            for (int b = 0; b < 2; ++b)
#pragma unroll
                for (int m = 0; m < 4; ++m)
#pragma unroll
                    for (int n = 0; n < 2; ++n) acc[a][b][m][n] = (f32x4){0.f, 0.f, 0.f, 0.f};
        cur = nxt; cA = nA; cB = nB; ++ui;
        if (wr == 1) PG8_BAR;
    }
    PG8_WAIT_V(0);
    PG8_BAR;
#undef PG8_SA
#undef PG8_SB
#undef PG8_STAGE
#undef PG8_LDA
#undef PG8_LDB
#undef PG8_MMA
#undef PG8_WAIT_V
#undef PG8_WAIT_L
#undef PG8_BAR
#undef PG8_SCHED
}
}

struct Args { const float* in[27]; float* out; unsigned char* ws; int ph_lo, ph_hi; };
struct Ctx { const float* const* in; float* out; unsigned char* ws; LAS unsigned char* lds; int tid, lane, wave; };

enum { I_X = 0, I_C, I_RELB, I_WADA, I_BADA, I_GMIX, I_WIN, I_GQA, I_GKA, I_GQB, I_GKCMP, I_GKSLC, I_GKWIN, I_PEK, I_W1K, I_W2K, I_PEV, I_W1V, I_W2V,
       I_WBA, I_WBB, I_WOUT, I_GFFN, I_WPQ, I_SUBK, I_PU, I_PV };

__device__ __forceinline__ int map_col(int c) {
    if (c < 5120) return c; if (c < 10240) return c + 96; if (c < 10336) return c - 5120; if (c < 10384) return c; if (c < 10496) return -1; return c - 112;
}

template <bool REMAP>
__device__ __forceinline__ void tconv_tile(const Ctx& C, const float* src, int srcN, bf16_t* dst, int dstK, int n0, int k0) {
    LAS float* tile = (LAS float*)C.lds;
    const int tx = C.tid & 31, ty = C.tid >> 5;
    const int nn = n0 + 4 * tx; const int sc = REMAP ? map_col(nn) : nn;
    f32x4 v[8];
#pragma unroll
    for (int i = 0; i < 8; ++i) { const int k = ty + 16 * i; v[i] = (sc >= 0) ? *(const f32x4*)(src + (size_t)(k0 + k) * srcN + sc) : (f32x4){0.f, 0.f, 0.f, 0.f}; }
#pragma unroll
    for (int i = 0; i < 8; ++i) { const int k = ty + 16 * i; LAS float* q = tile + k * 129 + 4 * tx; q[0] = v[i][0]; q[1] = v[i][1]; q[2] = v[i][2]; q[3] = v[i][3]; }
    __syncthreads();
#pragma unroll
    for (int i = 0; i < 4; ++i) { const int task = C.tid + 512 * i; const int nl = task >> 4, kc = task & 15;
        float e[8];
#pragma unroll
        for (int j = 0; j < 8; ++j) e[j] = tile[(kc * 8 + j) * 129 + nl];
        u32x4 w; w.x = cvt_pk_bf16(e[0], e[1]); w.y = cvt_pk_bf16(e[2], e[3]); w.z = cvt_pk_bf16(e[4], e[5]); w.w = cvt_pk_bf16(e[6], e[7]);
        *(u32x4*)(dst + (size_t)(n0 + nl) * dstK + k0 + kc * 8) = w; }
    __syncthreads();
}

template <bool REMAP>
__device__ __forceinline__ void tconv_tile_f8(const Ctx& C, const float* src, int srcN, unsigned char* dst, int dstK, int n0, int k0) {
    LAS float* tile = (LAS float*)C.lds;
    const int tx = C.tid & 31, ty = C.tid >> 5;
    const int nn = n0 + 4 * tx; const int sc = REMAP ? map_col(nn) : nn;
    f32x4 v[8];
#pragma unroll
    for (int i = 0; i < 8; ++i) { const int k = ty + 16 * i; v[i] = (sc >= 0) ? *(const f32x4*)(src + (size_t)(k0 + k) * srcN + sc) : (f32x4){0.f, 0.f, 0.f, 0.f}; }
#pragma unroll
    for (int i = 0; i < 8; ++i) { const int k = ty + 16 * i; LAS float* q = tile + k * 129 + 4 * tx; q[0] = v[i][0]; q[1] = v[i][1]; q[2] = v[i][2]; q[3] = v[i][3]; }
    __syncthreads();
#pragma unroll
    for (int i = 0; i < 2; ++i) { const int task = C.tid + 512 * i; const int nl = task >> 3, kc = task & 7;
        float e[16];
#pragma unroll
        for (int j = 0; j < 16; ++j) e[j] = tile[(kc * 16 + j) * 129 + nl] * 64.f;
        u32x4 w;
#pragma unroll
        for (int q4 = 0; q4 < 4; ++q4) { int p = __builtin_amdgcn_cvt_pk_fp8_f32(e[4 * q4], e[4 * q4 + 1], 0, false); p = __builtin_amdgcn_cvt_pk_fp8_f32(e[4 * q4 + 2], e[4 * q4 + 3], p, true); w[q4] = (unsigned)p; }
        *(u32x4*)(dst + (size_t)(n0 + nl) * dstK + k0 + kc * 16) = w; }
    __syncthreads();
}

__device__ __forceinline__ void wq_subkey_tile(const Ctx& C, int blk, int k0) {
    LAS float* As = (LAS float*)C.lds;
    LAS float* Bs = As + 128 * 132;
    const int tid = C.tid;
    const float* sk = C.in[I_SUBK] + (size_t)blk * 128 * 128; const float* wq = C.in[I_WPQ] + (size_t)k0 * 2048 + blk * 128;
#pragma unroll
    for (int i = 0; i < 8; ++i) { const int idx = tid + 512 * i, r = idx >> 5, c4 = idx & 31;
        const f32x4 a = *(const f32x4*)(sk + (size_t)r * 128 + 4 * c4), b = *(const f32x4*)(wq + (size_t)r * 2048 + 4 * c4);
        *(LAS f32x4*)(As + r * 132 + 4 * c4) = a; *(LAS f32x4*)(Bs + r * 132 + 4 * c4) = b; }
    __syncthreads();
    const int tn = tid >> 4, tk = tid & 15;
    float acc[4][8];
#pragma unroll
    for (int i = 0; i < 4; ++i)
#pragma unroll
        for (int j = 0; j < 8; ++j) acc[i][j] = 0.f;
#pragma unroll 2
    for (int d4 = 0; d4 < 32; ++d4) {
        f32x4 a[4], b[8];
#pragma unroll
        for (int i = 0; i < 4; ++i) a[i] = *(LAS const f32x4*)(As + (4 * tn + i) * 132 + 4 * d4);
#pragma unroll
        for (int j = 0; j < 8; ++j) b[j] = *(LAS const f32x4*)(Bs + (2 * tk + 32 * (j >> 1) + (j & 1)) * 132 + 4 * d4);
#pragma unroll
        for (int i = 0; i < 4; ++i)
#pragma unroll
            for (int j = 0; j < 8; ++j) acc[i][j] += a[i][0] * b[j][0] + a[i][1] * b[j][1] + a[i][2] * b[j][2] + a[i][3] * b[j][3];
    }
    bf16_t* dst = (bf16_t*)(C.ws + WS_WQ) + (size_t)(blk * 128 + 4 * tn) * 4096 + k0 + 2 * tk;
#pragma unroll
    for (int i = 0; i < 4; ++i)
#pragma unroll
        for (int j = 0; j < 4; ++j) *(unsigned*)(dst + (size_t)i * 4096 + 32 * j) = cvt_pk_bf16(acc[i][2 * j], acc[i][2 * j + 1]);
    __syncthreads();
}

__device__ __forceinline__ void peer_row_convert(const Ctx& C, int grow, int lane) {
            const bool second = grow >= 16384; const int row = grow & 16383;
            const float* src = C.in[second ? I_PV : I_PU] + (size_t)row * 4096;
            unsigned char* dst6 = C.ws + (second ? WS_PV : WS_PU) + (size_t)row * 3072;
            f32x16 v[4]; float am = 0.f;
#pragma unroll
            for (int i4 = 0; i4 < 4; ++i4)
#pragma unroll
                for (int q = 0; q < 4; ++q) { const f32x4 t4 = *(const f32x4*)(src + 16 * (lane + 64 * i4) + 4 * q);
                    v[i4][4 * q] = t4[0]; v[i4][4 * q + 1] = t4[1]; v[i4][4 * q + 2] = t4[2]; v[i4][4 * q + 3] = t4[3];
                    am = fmaxf(am, fmaxf(fmaxf(fabsf(t4[0]), fabsf(t4[1])), fmaxf(fabsf(t4[2]), fabsf(t4[3])))); }
            am = wave_max(am);
            const float sc = am > 0.f ? am * (1.f / 7.f) : 1.f, inv = 1.f / sc;
#pragma unroll
            for (int i4 = 0; i4 < 4; ++i4) v[i4] *= inv;
            const u32x6 pa = __builtin_amdgcn_cvt_scalef32_2xpk16_fp6_f32(v[0], v[1], 1.0f), pb = __builtin_amdgcn_cvt_scalef32_2xpk16_fp6_f32(v[2], v[3], 1.0f);
            *(u32x4*)(dst6 + 16 * lane) = (u32x4){pa[0], pa[1], pa[2], pa[3]};
            *(u32x4*)(dst6 + 1024 + 16 * lane) = (u32x4){pa[4], pa[5], pb[0], pb[1]};
            *(u32x4*)(dst6 + 2048 + 16 * lane) = (u32x4){pb[2], pb[3], pb[4], pb[5]};
            ((float*)(C.ws + (second ? WS_PV : WS_PU) + 96 * MB))[row] = sc;
            { float al = 0.f;
#pragma unroll
              for (int i4 = 0; i4 < 4; ++i4)
#pragma unroll
                  for (int j = 0; j < 16; ++j) al = fmaxf(al, fabsf(v[i4][j]));
              const float s4 = al > 0.f ? al * (1.f / 6.f) : 1.f, inv4 = 1.f / s4;
              unsigned wa[4] = {0u, 0u, 0u, 0u}, wb[4] = {0u, 0u, 0u, 0u};
#define PK4(d_) do { wa[d_] = __builtin_amdgcn_cvt_scalef32_pk_fp4_f32(wa[d_], v[0][4 * (d_)] * inv4, v[1][4 * (d_)] * inv4, 1.0f, 0); wa[d_] = __builtin_amdgcn_cvt_scalef32_pk_fp4_f32(wa[d_], v[0][4 * (d_) + 1] * inv4, v[1][4 * (d_) + 1] * inv4, 1.0f, 1); \
                     wa[d_] = __builtin_amdgcn_cvt_scalef32_pk_fp4_f32(wa[d_], v[0][4 * (d_) + 2] * inv4, v[1][4 * (d_) + 2] * inv4, 1.0f, 2); wa[d_] = __builtin_amdgcn_cvt_scalef32_pk_fp4_f32(wa[d_], v[0][4 * (d_) + 3] * inv4, v[1][4 * (d_) + 3] * inv4, 1.0f, 3); \
                     wb[d_] = __builtin_amdgcn_cvt_scalef32_pk_fp4_f32(wb[d_], v[2][4 * (d_)] * inv4, v[3][4 * (d_)] * inv4, 1.0f, 0); wb[d_] = __builtin_amdgcn_cvt_scalef32_pk_fp4_f32(wb[d_], v[2][4 * (d_) + 1] * inv4, v[3][4 * (d_) + 1] * inv4, 1.0f, 1); \
                     wb[d_] = __builtin_amdgcn_cvt_scalef32_pk_fp4_f32(wb[d_], v[2][4 * (d_) + 2] * inv4, v[3][4 * (d_) + 2] * inv4, 1.0f, 2); wb[d_] = __builtin_amdgcn_cvt_scalef32_pk_fp4_f32(wb[d_], v[2][4 * (d_) + 3] * inv4, v[3][4 * (d_) + 3] * inv4, 1.0f, 3); } while (0)
              PK4(0); PK4(1); PK4(2); PK4(3);
#undef PK4
              unsigned char* dst4 = second ? (C.ws + WS_PV4 + (size_t)row * 2048) : (C.ws + WS_PU4 + (size_t)row * 2304);
              *(u32x4*)(dst4 + 16 * lane) = (u32x4){wa[0], wa[1], wa[2], wa[3]};
              *(u32x4*)(dst4 + 1024 + 16 * lane) = (u32x4){wb[0], wb[1], wb[2], wb[3]};
              *(bf16_t*)(C.ws + WS_PU4 + (size_t)row * 2304 + 2048 + 4 * lane + (second ? 2 : 0)) = f2bf(sc * s4); }

}

__device__ __forceinline__ void p0_prologue(const Ctx& C) {
    constexpr int N_MOD = 256, N_WIN = (NP / 128) * (D / 128), N_W1 = 2 * 32, N_B1 = 64;
    constexpr int E0 = N_MOD, E1 = E0 + N_B1, E2 = E1 + N_WIN, E7 = E2 + N_W1, E8 = E7 + N_W1, E11 = E8;
    const int tid = C.tid;
    for (int it = blockIdx.x; it < E11; it += gridDim.x) {
        if (it < E0) {
            const int b = it; LAS float* red = (LAS float*)C.lds;
            const float* cvec = C.in[I_C]; const float* w = C.in[I_WADA];
            if (tid < 504) { const int cg = tid % 24, rs = tid / 24;
                f32x4 acc = {0.f, 0.f, 0.f, 0.f};
                const float* wp = w + 96 * b + 4 * cg;
#pragma unroll 4
                for (int k = rs; k < D; k += 21) { const float cv = cvec[k]; const f32x4 wv = *(const f32x4*)(wp + (size_t)k * 24576); acc += cv * wv; }
                *(LAS f32x4*)(red + (rs * 24 + cg) * 4) = acc; }
            __syncthreads();
            if (tid < 24) { f32x4 s = *(const f32x4*)(C.in[I_BADA] + 96 * b + 4 * tid);
                for (int rs = 0; rs < 21; ++rs) s += *(LAS f32x4*)(red + (rs * 24 + tid) * 4);
                *(f32x4*)((float*)(C.ws + WS_MOD) + 96 * b + 4 * tid) = s; }
            __syncthreads();
        } else if (it < E1) {
            const int s = (it - E0) >> 5, sl = (it - E0) & 31; const float* pe = C.in[s ? I_PEV : I_PEK]; const float* w1 = C.in[s ? I_W1V : I_W1K];
            const int e = tid & 255, half = tid >> 8; float a = 0.f;
            const int kb = sl * 128 + half * 64;
#pragma unroll 16
            for (int k = kb; k < kb + 64; ++k) a += pe[k] * w1[(size_t)k * 256 + e];
            LAS float* red = (LAS float*)C.lds; red[tid] = a; __syncthreads();
            if (tid < 256) ((float*)(C.ws + WS_B1P))[(s * 32 + sl) * 256 + tid] = red[tid] + red[tid + 256];
            __syncthreads();
        } else if (it < E2) { const int i = it - E1; const int n0 = (i / 32) * 128, k0 = (i % 32) * 128;
            if (n0 < NP_BF) tconv_tile<true>(C, C.in[I_WIN], 18576, (bf16_t*)(C.ws + WS_WIN), D, n0, k0);
            else tconv_tile_f8<true>(C, C.in[I_WIN], 18576, C.ws + WS_WIN8 - (size_t)NP_BF * D, D, n0, k0);
        } else if (it < E7) { const int i = it - E2; tconv_tile<false>(C, C.in[I_W1K], 256, (bf16_t*)(C.ws + WS_W1T), 4096, (i / 32) * 128, (i % 32) * 128);
        } else if (it < E8) { const int i = it - E7; tconv_tile<false>(C, C.in[I_W1V], 256, (bf16_t*)(C.ws + WS_W1T) + (size_t)256 * 4096, 4096, (i / 32) * 128, (i % 32) * 128);
        }
    }
}

__device__ __forceinline__ void norm_mod_phase(const Ctx& C, const float* xin, const float* gain, const float* sh, const float* sc, bf16_t* hout, unsigned char* h8out = nullptr) {
    LAS float* la = (LAS float*)C.lds; LAS float* lb = la + D;
    for (int i = C.tid; i < D / 4; i += NTHREADS) { const f32x4 g4 = *(const f32x4*)(gain + 4 * i), s4 = *(const f32x4*)(sc + 4 * i), h4 = *(const f32x4*)(sh + 4 * i);
        *(LAS f32x4*)(la + 4 * i) = g4 * (s4 + 1.f); *(LAS f32x4*)(lb + 4 * i) = h4; }
    __syncthreads();
    const int rstep = gridDim.x * 8;
    int row = blockIdx.x * 8 + C.wave;
    f32x4 v[16], vn[16];
    if (row < T) {
#pragma unroll
        for (int i = 0; i < 16; ++i) v[i] = ((const f32x4*)(xin + (size_t)row * D))[C.lane + 64 * i]; }
#pragma unroll 1
    for (; row < T; row += rstep) {
        const int nrow = row + rstep;
        if (nrow < T) {
#pragma unroll
            for (int i = 0; i < 16; ++i) vn[i] = ((const f32x4*)(xin + (size_t)nrow * D))[C.lane + 64 * i]; }
        float ss = 0.f;
#pragma unroll
        for (int i = 0; i < 16; ++i) ss += v[i][0] * v[i][0] + v[i][1] * v[i][1] + v[i][2] * v[i][2] + v[i][3] * v[i][3];
        ss = wave_sum(ss);
        const float rstd = rsqrtf(ss * (1.f / 4096.f) + EPS);
#pragma unroll
        for (int i = 0; i < 16; ++i) { const int col = 4 * (C.lane + 64 * i);
            const f32x4 a4 = *(LAS const f32x4*)(la + col), b4 = *(LAS const f32x4*)(lb + col);
            float y[4];
#pragma unroll
            for (int j = 0; j < 4; ++j) y[j] = v[i][j] * rstd * a4[j] + b4[j];
            u32x2 w; w.x = cvt_pk_bf16(y[0], y[1]); w.y = cvt_pk_bf16(y[2], y[3]);
            *(u32x2*)(hout + (size_t)row * D + col) = w;
            if (h8out) { int p = __builtin_amdgcn_cvt_pk_fp8_f32(y[0], y[1], 0, false); p = __builtin_amdgcn_cvt_pk_fp8_f32(y[2], y[3], p, true); *(unsigned*)(h8out + (size_t)row * D + col) = (unsigned)p; } }
#pragma unroll
        for (int i = 0; i < 16; ++i) v[i] = vn[i];
    }
    __syncthreads();
}

__device__ __forceinline__ void p3_post(const Ctx& C) {
    bf16_t* proj = (bf16_t*)(C.ws + WS_PROJ);
    const int tid = C.tid;
    const float qscale = 0.08838834764831845f;
    if (blockIdx.x == 0) { float a = 0.f; const float* part = (const float*)(C.ws + WS_B1P) + (size_t)(tid >> 8) * 32 * 256 + (tid & 255);
        for (int sl = 0; sl < 32; ++sl) a += part[sl * 256]; ((float*)(C.ws + WS_B1))[tid] = a; }
    for (int item = blockIdx.x; item < T / 64; item += gridDim.x) {
        const int t0 = item * 64;
#pragma unroll 1
        for (int hb = tid >> 4; hb < 64 * 44; hb += 128) {
            const int l16 = tid & 15;
            u32x4 raw[4]; bf16_t* dstp[4]; const float* gain[4]; float scl[4]; bool isk8[4];
#pragma unroll
            for (int u = 0; u < 4; ++u) { const int hr = hb + 32 * u; const int tok = hr / 44, hh = hr % 44; int col; isk8[u] = (hh >= 16 && hh < 20);
                if (hh < 16) { col = P_QA + 128 * hh; gain[u] = C.in[I_GQA]; scl[u] = qscale; dstp[u] = proj + (size_t)(t0 + tok) * NP + col; }
                else if (hh < 20) { col = P_KA + 128 * (hh - 16); gain[u] = C.in[I_GKA]; scl[u] = 1.f; dstp[u] = (bf16_t*)(C.ws + WS_KA + (size_t)(t0 + tok) * 512 + 128 * (hh - 16)); }
                else if (hh < 36) { col = P_QB + 128 * (hh - 20); gain[u] = C.in[I_GQB]; scl[u] = qscale * 1.4426950408889634f; dstp[u] = proj + (size_t)(t0 + tok) * NP + col; }
                else if (hh < 40) { col = P_KS + 128 * (hh - 36); gain[u] = C.in[I_GKSLC]; scl[u] = 1.f; dstp[u] = (bf16_t*)(C.ws + WS_KSC) + ((size_t)(hh - 36) * T + t0 + tok) * 128; }
                else { col = P_KW + 128 * (hh - 40); gain[u] = C.in[I_GKWIN]; scl[u] = 1.f; dstp[u] = (bf16_t*)(C.ws + WS_KWC) + ((size_t)(hh - 40) * T + t0 + tok) * 128; }
                raw[u] = *(const u32x4*)(proj + (size_t)(t0 + tok) * NP + col + 8 * l16); }
#pragma unroll
            for (int u = 0; u < 4; ++u) {
                float v[8] = {bflo(raw[u].x), bfhi(raw[u].x), bflo(raw[u].y), bfhi(raw[u].y), bflo(raw[u].z), bfhi(raw[u].z), bflo(raw[u].w), bfhi(raw[u].w)};
                float ss = 0.f;
#pragma unroll
                for (int j = 0; j < 8; ++j) ss += v[j] * v[j];
                ss += dppf<0xB1>(ss); ss += dppf<0x4E>(ss); ss += dppf<0x141>(ss); ss += dppf<0x140>(ss);
                const float rstd = rsqrtf(ss * (1.f / 128.f) + EPS) * scl[u];
                const f32x4 g0 = *(const f32x4*)(gain[u] + 8 * l16), g1 = *(const f32x4*)(gain[u] + 8 * l16 + 4);
                if (isk8[u]) {
                    const float r8 = rstd * 64.f;
                    int p0 = __builtin_amdgcn_cvt_pk_fp8_f32(v[0] * r8 * g0[0], v[1] * r8 * g0[1], 0, false); p0 = __builtin_amdgcn_cvt_pk_fp8_f32(v[2] * r8 * g0[2], v[3] * r8 * g0[3], p0, true);
                    int p1 = __builtin_amdgcn_cvt_pk_fp8_f32(v[4] * r8 * g1[0], v[5] * r8 * g1[1], 0, false); p1 = __builtin_amdgcn_cvt_pk_fp8_f32(v[6] * r8 * g1[2], v[7] * r8 * g1[3], p1, true);
                    *(u32x2*)((unsigned char*)dstp[u] + 8 * l16) = (u32x2){(unsigned)p0, (unsigned)p1};
                } else {
                u32x4 w; w.x = cvt_pk_bf16(v[0] * rstd * g0[0], v[1] * rstd * g0[1]); w.y = cvt_pk_bf16(v[2] * rstd * g0[2], v[3] * rstd * g0[3]);
                w.z = cvt_pk_bf16(v[4] * rstd * g1[0], v[5] * rstd * g1[1]); w.w = cvt_pk_bf16(v[6] * rstd * g1[2], v[7] * rstd * g1[3]);
                *(u32x4*)(dstp[u] + 8 * l16) = w; } }
        }
        bf16_t* Kc = (bf16_t*)(C.ws + WS_KC); bf16_t* Vc = Kc + (size_t)4 * T * 128;
#pragma unroll
        for (int i = 0; i < 8; ++i) { const int idx = tid + 512 * i, tok = idx >> 6, c16 = idx & 63, g = c16 >> 4, d8 = c16 & 15;
            const bf16_t* src = proj + (size_t)(t0 + tok) * NP + 8 * c16;
            const size_t dof = ((size_t)g * T + t0 + tok) * 128 + 8 * d8;
            *(u32x4*)(Kc + dof) = *(const u32x4*)(src + P_KC);
            *(u32x4*)(Vc + dof) = *(const u32x4*)(src + P_VC);
            { const u32x4 rv = *(const u32x4*)(src + P_VA);
              u32x4 w;
              w.x = __builtin_bit_cast(unsigned, __builtin_amdgcn_cvt_pkrtz(bflo(rv.x), bfhi(rv.x))); w.y = __builtin_bit_cast(unsigned, __builtin_amdgcn_cvt_pkrtz(bflo(rv.y), bfhi(rv.y)));
              w.z = __builtin_bit_cast(unsigned, __builtin_amdgcn_cvt_pkrtz(bflo(rv.z), bfhi(rv.z))); w.w = __builtin_bit_cast(unsigned, __builtin_amdgcn_cvt_pkrtz(bflo(rv.w), bfhi(rv.w)));
              *(u32x4*)(C.ws + WS_VA + ((size_t)(t0 + tok) * 512 + 8 * c16) * 2) = w; } }
        { const int tok = tid >> 3, c8 = tid & 7;
          *(u32x4*)((bf16_t*)(C.ws + WS_KIC) + (size_t)(t0 + tok) * 64 + 8 * c8) = *(const u32x4*)(proj + (size_t)(t0 + tok) * NP + P_KI + 8 * c8); }
#pragma unroll 1
        for (int which = 0; which < 2; ++which) {
            const int pcol = which ? P_VW : P_VS; bf16_t* dstT = (bf16_t*)(C.ws + (which ? WS_VWT : WS_VST));
            LAS unsigned* tl = (LAS unsigned*)C.lds;
#pragma unroll
            for (int i = 0; i < 8; ++i) { const int idx = tid + 512 * i, tok = idx >> 6, c16 = idx & 63;
                const u32x4 v = *(const u32x4*)(proj + (size_t)(t0 + tok) * NP + pcol + 8 * c16);
                LAS unsigned* q = tl + tok * 257 + 4 * c16; q[0] = v.x; q[1] = v.y; q[2] = v.z; q[3] = v.w; }
            __syncthreads();
#pragma unroll
            for (int i = 0; i < 8; ++i) { const int task = tid + 512 * i, col = task >> 3, tc = task & 7;
                unsigned short e[8];
#pragma unroll
                for (int j = 0; j < 8; ++j) { const unsigned dw = tl[(8 * tc + j) * 257 + (col >> 1)]; e[j] = (col & 1) ? (unsigned short)(dw >> 16) : (unsigned short)(dw & 0xFFFFu); }
                u32x4 w; w.x = e[0] | ((unsigned)e[1] << 16); w.y = e[2] | ((unsigned)e[3] << 16); w.z = e[4] | ((unsigned)e[5] << 16); w.w = e[6] | ((unsigned)e[7] << 16);
                *(u32x4*)(dstT + (size_t)col * T + t0 + 8 * tc) = w; }
            __syncthreads();
        }
    }
}

__device__ __forceinline__ void p5_cmp_out(const Ctx& C) {
    const float* part = (const float*)(C.ws + WS_HIDP); const float* b1 = (const float*)(C.ws + WS_B1);
    bf16_t* kcmp = (bf16_t*)(C.ws + WS_KCMP); bf16_t* vcT = (bf16_t*)(C.ws + WS_VCMPT);
    LAS float* hl = (LAS float*)(C.lds) + C.wave * 1024;
    const int lane = C.lane;
    for (int grp = blockIdx.x * 8 + C.wave; grp < 2048; grp += gridDim.x * 8) {
        const int R0 = grp * 4; const bool isv = R0 >= 4096;
        lds_sync();
        const f32x4 bb = *(const f32x4*)(b1 + (isv ? 256 : 0) + 4 * lane);
#pragma unroll
        for (int r = 0; r < 4; ++r) { f32x4 a = bb;
#pragma unroll
            for (int ks = 0; ks < 8; ++ks) a += *(const f32x4*)(part + ((size_t)ks * 8192 + R0 + r) * 256 + 4 * lane);
            f32x4 hg; hg[0] = gelu_tanh(a[0]); hg[1] = gelu_tanh(a[1]); hg[2] = gelu_tanh(a[2]); hg[3] = gelu_tanh(a[3]);
            *(LAS f32x4*)(hl + r * 256 + 4 * lane) = hg; }
        lds_sync();
        const float* w2 = C.in[isv ? I_W2V : I_W2K];
        float acc[4][2];
#pragma unroll
        for (int r = 0; r < 4; ++r) { acc[r][0] = 0.f; acc[r][1] = 0.f; }
#pragma unroll 8
        for (int e = 0; e < 256; ++e) { const float2 wv = *(const float2*)(w2 + e * 128 + 2 * lane);
#pragma unroll
            for (int r = 0; r < 4; ++r) { const float hv = hl[r * 256 + e]; acc[r][0] += hv * wv.x; acc[r][1] += hv * wv.y; } }
#pragma unroll
        for (int r = 0; r < 4; ++r) { const int R = R0 + r, Rl = R & 4095, g = Rl >> 10, n = Rl & 1023;
            const float a0 = (n < NCMP) ? acc[r][0] : 0.f, a1 = (n < NCMP) ? acc[r][1] : 0.f;
            if (!isv) { const float ss = wave_sum(a0 * a0 + a1 * a1); const float rstd = rsqrtf(ss * (1.f / 128.f) + EPS);
                const float2 gg = *(const float2*)(C.in[I_GKCMP] + 2 * lane);
                *(unsigned*)(kcmp + (size_t)Rl * 128 + 2 * lane) = (n < NCMP) ? cvt_pk_bf16(a0 * rstd * gg.x, a1 * rstd * gg.y) : 0u; }
            else { vcT[((size_t)g * 128 + 2 * lane) * 1024 + n] = f2bf(a0); vcT[((size_t)g * 128 + 2 * lane + 1) * 1024 + n] = f2bf(a1); } }
    }
}

constexpr int P6_WAVE_LDS = 18432, P6_SHARED = 8192;
__device__ __forceinline__ f32x16 mfma32(bf16x8 a, bf16x8 b, f32x16 c) { return __builtin_amdgcn_mfma_f32_32x32x16_bf16(a, b, c, 0, 0, 0); }
__device__ __forceinline__ int swap23(int r) { return (r & 0x13) | ((r & 4) << 1) | ((r & 8) >> 1); }

__device__ __forceinline__ void topk_prune(LAS u64* buf, int& cnt, u64& tau, LAS unsigned* hist, int lane) {
    u64 e[8];
#pragma unroll
    for (int i = 0; i < 8; ++i) { const int idx = lane + 64 * i; e[i] = idx < cnt ? buf[idx] : 0ull; }
    u64 prefix = 0ull; unsigned need = 256u;
    const u64 lt = (1ull << lane) - 1ull;
#pragma unroll 1
    for (int p = 0; p < 6; ++p) {
        const int shift = 40 - 8 * p;
        *(LAS u32x4*)(hist + 4 * lane) = (u32x4){0u, 0u, 0u, 0u};
        lds_sync();
#pragma unroll
        for (int i = 0; i < 8; ++i) { const bool m = (e[i] != 0ull) && ((e[i] >> (shift + 8)) == (prefix >> (shift + 8)));
            if (m) __hip_atomic_fetch_add(hist + (unsigned)((e[i] >> shift) & 255ull), 1u, __ATOMIC_RELAXED, __HIP_MEMORY_SCOPE_WORKGROUP); }
        lds_sync();
        const u32x4 c = *(LAS u32x4*)(hist + 4 * lane);
        const unsigned tot = c.x + c.y + c.z + c.w;
        unsigned pre = tot;
        pre += (unsigned)__builtin_amdgcn_update_dpp(0, (int)pre, 0x111, 0xF, 0xF, true); pre += (unsigned)__builtin_amdgcn_update_dpp(0, (int)pre, 0x112, 0xF, 0xF, true);
        pre += (unsigned)__builtin_amdgcn_update_dpp(0, (int)pre, 0x114, 0xF, 0xF, true); pre += (unsigned)__builtin_amdgcn_update_dpp(0, (int)pre, 0x118, 0xF, 0xF, true);
        const unsigned r0 = (unsigned)__builtin_amdgcn_readlane((int)pre, 15), r1 = (unsigned)__builtin_amdgcn_readlane((int)pre, 31), r2 = (unsigned)__builtin_amdgcn_readlane((int)pre, 47), r3 = (unsigned)__builtin_amdgcn_readlane((int)pre, 63);
        const int row = lane >> 4;
        pre += (row == 1) ? r0 : (row == 2) ? (r0 + r1) : (row == 3) ? (r0 + r1 + r2) : 0u;
        const unsigned a3 = (r0 + r1 + r2 + r3) - pre, a2 = a3 + c.w, a1 = a2 + c.z, a0 = a1 + c.y;
        int found = -1; unsigned above = 0u;
        if (a3 < need && need <= a3 + c.w) { found = 3; above = a3; }
        else if (a2 < need && need <= a2 + c.z) { found = 2; above = a2; }
        else if (a1 < need && need <= a1 + c.y) { found = 1; above = a1; }
        else if (a0 < need && need <= a0 + c.x) { found = 0; above = a0; }
        const u64 bm = __ballot(found >= 0);
        const int src = bm ? (__ffsll((long long)bm) - 1) : 0;
        const int bin = __builtin_amdgcn_readlane(4 * lane + found, src); const unsigned ab = (unsigned)__builtin_amdgcn_readlane((int)above, src);
        prefix |= ((u64)(unsigned)bin) << shift; need -= ab;
        lds_sync();
    }
    tau = prefix;
    int base = 0;
#pragma unroll
    for (int i = 0; i < 8; ++i) { const bool keep = (e[i] >= tau) && (e[i] != 0ull); const u64 m = __ballot(keep);
        if (keep) buf[base + __popcll(m & lt)] = e[i]; base += __popcll(m); }
    cnt = base;
    lds_sync();
}

#ifndef DSA_PROBE_MODE
#define DSA_PROBE_MODE 0
#endif
__device__ __forceinline__ void dsa_item(const Ctx& C, int qp, LAS unsigned char* wl, LAS const unsigned char* bkt, LAS const float* tbl, int pmode = 0) {
    const int lane = C.lane, r = lane & 31, h = lane >> 5;
    const bf16_t* proj = (const bf16_t*)(C.ws + WS_PROJ); const bf16_t* kic = (const bf16_t*)(C.ws + WS_KIC);
    unsigned char* ya = C.ws + WS_YA;
    const int t0 = 2 * qp;
    LAS u64* buf0 = (LAS u64*)wl; LAS u64* buf1 = (LAS u64*)(wl + 4096);
    LAS unsigned* hist = (LAS unsigned*)(wl + 8192);
    LAS unsigned char* qst = wl + 9216;
    LAS float* pl = (LAS float*)(wl + 10240);
    LAS unsigned* idxs = (LAS unsigned*)(wl + 14336);
    const u64 lt = (1ull << lane) - 1ull;
    {
    bf16x8 A[2][4]; unsigned wp[2][8];
#pragma unroll
    for (int q = 0; q < 2; ++q) {
        const bf16_t* pr = proj + (size_t)(t0 + q) * NP;
#pragma unroll
        for (int kk = 0; kk < 4; ++kk) A[q][kk] = *(const bf16x8*)(pr + P_QI + 64 * r + 32 * h + 8 * kk);
#pragma unroll
        for (int k2 = 0; k2 < 8; ++k2) { const int reg = 2 * k2; wp[q][k2] = *(const unsigned*)(pr + P_WI + (reg & 3) + 8 * (reg >> 2) + 4 * h); }
    }
    int cnt0 = 0, cnt1 = 0; u64 tau0 = 0ull, tau1 = 0ull;
    const int nkeys = (pmode == 2) ? 0 : t0 + 2;
    LAS unsigned char* stg = wl + 9216;
    const unsigned ixo0 = (unsigned)(((lane >> 3) * 64 + 8 * ((lane & 7) ^ ((lane >> 4) & 7))) * 2), ixo1 = (unsigned)(((lane >> 3) * 64 + 8 * ((lane & 7) ^ ((4 + (lane >> 4)) & 7))) * 2);
#define IX_STAGE(j0_) do { const char* _tb = (const char*)kic + (size_t)(j0_) * 128; _Pragma("unroll") for (int _i = 0; _i < 8; ++_i) \
        __builtin_amdgcn_global_load_lds((const unsigned*)(_tb + _i * 1024 + ((_i & 1) ? ixo1 : ixo0)), (LAS unsigned*)(stg + _i * 1024), 16, 0, 0); } while (0)
    if (nkeys > 0) IX_STAGE(0);
#pragma unroll 1
    for (int j0 = 0; j0 < nkeys; j0 += 64) {
        bf16x8 BA[4], BB[4];
        asm volatile("s_waitcnt vmcnt(0)" ::: "memory");
#pragma unroll
        for (int kk = 0; kk < 4; ++kk) { const int sw = (r >> 1) & 7;
            BA[kk] = *(LAS const bf16x8*)(stg + r * 128 + 16 * ((4 * h + kk) ^ sw));
            BB[kk] = *(LAS const bf16x8*)(stg + (32 + r) * 128 + 16 * ((4 * h + kk) ^ sw)); }
        asm volatile("s_waitcnt lgkmcnt(0)" ::: "memory");
        if (j0 + 64 < nkeys) IX_STAGE(j0 + 64);
        const int kidx = j0 + lane;
        f32x16 accA0, accB0, accA1, accB1;
#pragma unroll
        for (int i = 0; i < 16; ++i) { accA0[i] = 0.f; accB0[i] = 0.f; accA1[i] = 0.f; accB1[i] = 0.f; }
#pragma unroll
        for (int kk = 0; kk < 4; ++kk) { accA0 = mfma32(A[0][kk], BA[kk], accA0); accB0 = mfma32(A[0][kk], BB[kk], accB0); }
#pragma unroll
        for (int kk = 0; kk < 4; ++kk) { accA1 = mfma32(A[1][kk], BA[kk], accA1); accB1 = mfma32(A[1][kk], BB[kk], accB1); }
        float sc[2];
        { float pA = 0.f, pB = 0.f;
#pragma unroll
          for (int i = 0; i < 16; ++i) { const float wv = (i & 1) ? bfhi(wp[0][i >> 1]) : bflo(wp[0][i >> 1]);
              const float ta = __int_as_float(max(__float_as_int(accA0[i]), 0)), tb = __int_as_float(max(__float_as_int(accB0[i]), 0));
              pA = __builtin_fmaf(ta, wv, pA); pB = __builtin_fmaf(tb, wv, pB); }
          swap32f(pA, pB); sc[0] = pA + pB; }
        __builtin_amdgcn_sched_group_barrier(0x008, 8, 0);
#pragma unroll
        for (int i = 0; i < 8; ++i) { __builtin_amdgcn_sched_group_barrier(0x008, 1, 0); __builtin_amdgcn_sched_group_barrier(0x002, 9, 0); }
        { float pA = 0.f, pB = 0.f;
#pragma unroll
          for (int i = 0; i < 16; ++i) { const float wv = (i & 1) ? bfhi(wp[1][i >> 1]) : bflo(wp[1][i >> 1]);
              const float ta = __int_as_float(max(__float_as_int(accA1[i]), 0)), tb = __int_as_float(max(__float_as_int(accB1[i]), 0));
              pA = __builtin_fmaf(ta, wv, pA); pB = __builtin_fmaf(tb, wv, pB); }
          swap32f(pA, pB); sc[1] = pA + pB; }
#pragma unroll
        for (int q = 0; q < 2; ++q) {
            const float s = sc[q];
            const bool valid = kidx <= t0 + q;
            const u64 key = ((u64)sortable(s) << 14) | (u64)(unsigned)(16383 - kidx);
            const u64 tau = q ? tau1 : tau0;
            const bool pass = valid && key > tau && (pmode != 3);
            const u64 mask = __ballot(pass);
            if (mask) {
                LAS u64* buf = q ? buf1 : buf0; int& cnt = q ? cnt1 : cnt0;
                if (pass) buf[cnt + __popcll(mask & lt)] = key;
                cnt += __popcll(mask);
                if (cnt > 512 - 64) { lds_sync(); topk_prune(buf, cnt, q ? tau1 : tau0, hist, lane); }
            }
        }
    }
#undef IX_STAGE
    lds_sync();
    if (cnt0 > 256) topk_prune(buf0, cnt0, tau0, hist, lane);
    if (cnt1 > 256) topk_prune(buf1, cnt1, tau1, hist, lane);
    if (pmode == 2) { cnt0 = min(t0 + 1, 256); cnt1 = min(t0 + 2, 256);
#pragma unroll
        for (int i = 0; i < 4; ++i) { const int j = lane + 64 * i; buf0[j] = (u64)(unsigned)(16383 - ((j * 61) % (t0 + 1))); buf1[j] = (u64)(unsigned)(16383 - ((j * 59) % (t0 + 2))); } }
    if (lane == 0) { hist[0] = (unsigned)cnt0; hist[1] = (unsigned)cnt1; }
    lds_sync();
    }
    __builtin_amdgcn_s_setprio(0);
    if (pmode == 1 || pmode == 3) return;
    const int kq = lane >> 4, l16 = lane & 15;
    LAS float* plq = (LAS float*)wl;
    LAS unsigned short* idx2 = (LAS unsigned short*)(wl + 16384);
    LAS float* invl = (LAS float*)(wl + 17408);
    const int nsel0 = (int)hist[0], nsel1 = (int)hist[1];
    { unsigned iv0[4], iv1[4];
#pragma unroll
      for (int i = 0; i < 4; ++i) { const int j = lane + 64 * i; iv0[i] = (j < nsel0) ? (16383u - (unsigned)(buf0[j] & 0x3FFFull)) : 0u; iv1[i] = (j < nsel1) ? (16383u - (unsigned)(buf1[j] & 0x3FFFull)) : 0u; }
      lds_sync();
#pragma unroll
      for (int i = 0; i < 4; ++i) { const int j = lane + 64 * i; idx2[j] = (unsigned short)iv0[i]; idx2[256 + j] = (unsigned short)iv1[i]; }
      lds_sync(); }
    const unsigned char* KAp = (const unsigned char*)(C.ws + WS_KA) + 32 * kq;
    const float lsc = 1.f / (64.f * 512.f);
#pragma unroll 1
    for (int q = 0; q < 2; ++q) {
        const int t = t0 + q; const int nsel = q ? nsel1 : nsel0; LAS const unsigned short* idxs = idx2 + 256 * q;
        const bf16_t* prq = proj + (size_t)t * NP;
        lds_sync();
        {
            long Bz[4][4];
#pragma unroll
            for (int g = 0; g < 4; ++g)
#pragma unroll
                for (int sI = 0; sI < 4; ++sI) { long z = 0;
                    if ((l16 >> 2) == g) { const u32x4 raw = *(const u32x4*)(prq + P_QA + l16 * 128 + 32 * kq + 8 * sI);
                        int p0 = __builtin_amdgcn_cvt_pk_fp8_f32(bflo(raw.x) * 512.f, bfhi(raw.x) * 512.f, 0, false); p0 = __builtin_amdgcn_cvt_pk_fp8_f32(bflo(raw.y) * 512.f, bfhi(raw.y) * 512.f, p0, true);
                        int p1 = __builtin_amdgcn_cvt_pk_fp8_f32(bflo(raw.z) * 512.f, bfhi(raw.z) * 512.f, 0, false); p1 = __builtin_amdgcn_cvt_pk_fp8_f32(bflo(raw.w) * 512.f, bfhi(raw.w) * 512.f, p1, true);
                        z = (long)(((unsigned long long)(unsigned)p1 << 32) | (unsigned long long)(unsigned)p0); }
                    Bz[g][sI] = z; }
            u32x4 A0[2][2], A1[2][2];
            { const unsigned char* kr = KAp + (size_t)idxs[l16] * 512;
#pragma unroll
              for (int g = 0; g < 2; ++g) { A0[g][0] = *(const u32x4*)(kr + g * 128); A0[g][1] = *(const u32x4*)(kr + g * 128 + 16); } }
#pragma unroll 1
            for (int tile = 0; tile < 16; ++tile) {
                { const unsigned char* kr = KAp + (size_t)idxs[16 * tile + l16] * 512 + 256;
#pragma unroll
                  for (int g = 0; g < 2; ++g) { A1[g][0] = *(const u32x4*)(kr + g * 128); A1[g][1] = *(const u32x4*)(kr + g * 128 + 16); } }
                f32x4 acc = {0.f, 0.f, 0.f, 0.f};
#pragma unroll
                for (int g = 0; g < 2; ++g)
#pragma unroll
                    for (int sI = 0; sI < 4; ++sI) { const u32x4 v = A0[g][sI >> 1]; const long a = (sI & 1) ? (long)(((unsigned long long)v.w << 32) | v.z) : (long)(((unsigned long long)v.y << 32) | v.x);
                        acc = __builtin_amdgcn_mfma_f32_16x16x32_fp8_fp8(a, Bz[g][sI], acc, 0, 0, 0); }
                asm volatile("" ::: "memory");
                if (tile < 15) { const unsigned char* kr = KAp + (size_t)idxs[16 * (tile + 1) + l16] * 512;
#pragma unroll
                    for (int g = 0; g < 2; ++g) { A0[g][0] = *(const u32x4*)(kr + g * 128); A0[g][1] = *(const u32x4*)(kr + g * 128 + 16); } }
#pragma unroll
                for (int g = 0; g < 2; ++g)
#pragma unroll
                    for (int sI = 0; sI < 4; ++sI) { const u32x4 v = A1[g][sI >> 1]; const long a = (sI & 1) ? (long)(((unsigned long long)v.w << 32) | v.z) : (long)(((unsigned long long)v.y << 32) | v.x);
                        acc = __builtin_amdgcn_mfma_f32_16x16x32_fp8_fp8(a, Bz[2 + g][sI], acc, 0, 0, 0); }
#pragma unroll
                for (int r = 0; r < 4; ++r) { const int j = 16 * tile + 4 * kq + r; const int idx = (int)idxs[j]; const bool valid = j < nsel;
                    const int b = bkt[min(max(t - idx, 0), 2048)];
                    plq[j * 16 + l16] = valid ? (acc[r] * lsc + tbl[b * 32 + l16]) : -1e30f; }
            }
        }
        lds_sync();
        {
            float mx[16];
#pragma unroll
            for (int hh = 0; hh < 16; ++hh) mx[hh] = -1e30f;
#pragma unroll 1
            for (int ps = 0; ps < 4; ++ps) { const int j = ps * 64 + lane;
#pragma unroll
                for (int c4 = 0; c4 < 4; ++c4) { const f32x4 lv = *(LAS f32x4*)(plq + 16 * j + 4 * c4);
#pragma unroll
                    for (int e = 0; e < 4; ++e) mx[4 * c4 + e] = fmaxf(mx[4 * c4 + e], lv[e]); } }
#pragma unroll
            for (int hh = 0; hh < 16; ++hh) mx[hh] = wave_max(mx[hh]);
            float zs[16];
#pragma unroll
            for (int hh = 0; hh < 16; ++hh) zs[hh] = 0.f;
#pragma unroll 1
            for (int ps = 0; ps < 4; ++ps) { const int j = ps * 64 + lane; const bool valid = j < nsel;
#pragma unroll
                for (int c4 = 0; c4 < 4; ++c4) { f32x4 lv = *(LAS f32x4*)(plq + 16 * j + 4 * c4);
#pragma unroll
                    for (int e = 0; e < 4; ++e) { const float p = valid ? __expf(lv[e] - mx[4 * c4 + e]) : 0.f; lv[e] = __builtin_bit_cast(float, __builtin_amdgcn_cvt_pkrtz(p, p)); zs[4 * c4 + e] += p; }
                    *(LAS f32x4*)(plq + 16 * j + 4 * c4) = lv; } }
#pragma unroll
            for (int hh = 0; hh < 16; ++hh) { const float z = wave_sum(zs[hh]); if (lane == 0) invl[hh] = 1.f / fmaxf(z, 1e-30f); }
        }
        lds_sync();
#pragma unroll 1
        for (int g = 0; g < 4; ++g) {
            const f32x4 inv4 = *(LAS f32x4*)(invl + 4 * g);
            hx2_t o2[4][4];
#pragma unroll
            for (int rr = 0; rr < 4; ++rr)
#pragma unroll
                for (int d = 0; d < 4; ++d) o2[rr][d] = (hx2_t){(_Float16)0.f, (_Float16)0.f};
            const unsigned char* vbase = C.ws + WS_VA + (128 * g + 8 * l16) * 2;
            const int nb = (nsel + 63) >> 6;
            u32x4 vc[16], vn[16];
#pragma unroll
            for (int u = 0; u < 16; ++u) { const int idx = (int)idxs[4 * u + kq]; vc[u] = *(const u32x4*)(vbase + (size_t)idx * 1024); }
#pragma unroll 1
            for (int bb = 0; bb < nb; ++bb) {
                { const int bn = (bb + 1 < nb) ? bb + 1 : bb;
#pragma unroll
                    for (int u = 0; u < 16; ++u) { const int idx = (int)idxs[64 * bn + 4 * u + kq]; vn[u] = *(const u32x4*)(vbase + (size_t)idx * 1024); } }
#pragma unroll
                for (int u = 0; u < 16; ++u) { const u32x4 pw = *(LAS u32x4*)(plq + 16 * (64 * bb + 4 * u + kq) + 4 * g);
#pragma unroll
                    for (int rr = 0; rr < 4; ++rr) { const unsigned pwr = pw[rr]; const hx2_t pp = __builtin_bit_cast(hx2_t, pwr);
#pragma unroll
                        for (int d = 0; d < 4; ++d) { const unsigned vd = vc[u][d]; o2[rr][d] = pp * __builtin_bit_cast(hx2_t, vd) + o2[rr][d]; } } }
#pragma unroll
                for (int u = 0; u < 16; ++u) vc[u] = vn[u];
            }
            float o[4][8];
#pragma unroll
            for (int rr = 0; rr < 4; ++rr)
#pragma unroll
                for (int d = 0; d < 4; ++d) { o[rr][2 * d] = xsum16(xsum32((float)o2[rr][d].x)) * inv4[rr]; o[rr][2 * d + 1] = xsum16(xsum32((float)o2[rr][d].y)) * inv4[rr]; }
            if (kq == 0) {
#pragma unroll
                for (int rr = 0; rr < 4; ++rr) { int p0 = __builtin_amdgcn_cvt_pk_fp8_f32(o[rr][0] * 16.f, o[rr][1] * 16.f, 0, false); p0 = __builtin_amdgcn_cvt_pk_fp8_f32(o[rr][2] * 16.f, o[rr][3] * 16.f, p0, true);
                    int p1 = __builtin_amdgcn_cvt_pk_fp8_f32(o[rr][4] * 16.f, o[rr][5] * 16.f, 0, false); p1 = __builtin_amdgcn_cvt_pk_fp8_f32(o[rr][6] * 16.f, o[rr][7] * 16.f, p1, true);
                    *(u32x2*)(ya + (size_t)t * 2048 + (4 * g + rr) * 128 + 8 * l16) = (u32x2){(unsigned)p0, (unsigned)p1}; } }
        }
    }
}

constexpr int N2_KS = 0, N2_VS = 32768, N2_LUT = 65536, N2_IMP = 81920, N2_SEL = N2_IMP + 64 * 260 * 4, N2_UNI = N2_SEL + 2048, N2_LIST = N2_UNI + 64, N2_BKT = N2_LIST + 3 * 512, N2_TBL = N2_BKT + 2304, N2_END = N2_TBL + 4096;
static_assert(N2_END <= LDS_BYTES - 16, "NSA LDS map");
struct N2Src { const bf16_t* kbase; size_t kld; int krmax; const bf16_t* vT; size_t vld; };
__device__ __forceinline__ void n2_stage(const N2Src& s, int m, bool withV, LAS unsigned char* kbuf, LAS unsigned char* vbuf, int wave, int lane) {
#pragma unroll
    for (int j = 0; j < 2; ++j) { const int slot = (wave * 2 + j) * 64 + lane; const int row = slot >> 4, ch = (slot & 15) ^ (row & 15);
        __builtin_amdgcn_global_load_lds((const unsigned*)(s.kbase + (size_t)min(64 * m + row, s.krmax) * s.kld + 8 * ch), (LAS unsigned*)(kbuf + (wave * 2 + j) * 1024), 16, 0, 0); }
    if (withV) {
#pragma unroll
        for (int j = 0; j < 2; ++j) { const int slot = (wave * 2 + j) * 64 + lane; const int row = slot >> 3, ch = (slot & 7) ^ ((row >> 1) & 7);
            __builtin_amdgcn_global_load_lds((const unsigned*)(s.vT + (size_t)row * s.vld + 64 * m + 8 * ch), (LAS unsigned*)(vbuf + (wave * 2 + j) * 1024), 16, 0, 0); } }
}
__device__ __forceinline__ f32x16 n2_qk(const bf16x8 (&Bq)[8], LAS const unsigned char* kbuf, int hf, int rho, int h) {
    const int kr = 32 * hf + rho;
    f32x16 S;
#pragma unroll
    for (int i = 0; i < 16; ++i) S[i] = 0.f;
#pragma unroll
    for (int kk = 0; kk < 8; ++kk) { const int ch = 8 * h + kk; const bf16x8 a = *(LAS const bf16x8*)(kbuf + kr * 256 + 16 * (ch ^ (rho & 15))); S = mfma32(a, Bq[kk], S); }
    return S;
}
__device__ __forceinline__ void n2_pv(f32x16 (&O)[4], const float (&p)[16], LAS const unsigned char* vbuf, int hf, int lane) {
    bf16x8 pk[2];
#pragma unroll
    for (int s = 0; s < 2; ++s) { u32x4 w; w.x = cvt_pk_bf16(p[8 * s + 0], p[8 * s + 1]); w.y = cvt_pk_bf16(p[8 * s + 2], p[8 * s + 3]); w.z = cvt_pk_bf16(p[8 * s + 4], p[8 * s + 5]); w.w = cvt_pk_bf16(p[8 * s + 6], p[8 * s + 7]);
        pk[s] = __builtin_bit_cast(bf16x8, w); }
    const int r = lane & 31, h = lane >> 5;
#pragma unroll
    for (int dt = 0; dt < 4; ++dt)
#pragma unroll
        for (int s = 0; s < 2; ++s) { const int row = dt * 32 + r, ch = 4 * hf + 2 * s + h;
            const bf16x8 a = *(LAS const bf16x8*)(vbuf + row * 128 + 16 * (ch ^ ((r >> 1) & 7))); O[dt] = mfma32(a, pk[s], O[dt]); }
}
constexpr float N2_MASKED = -3.0e38f, N2_MINIT = -1.0e30f, LOG2E = 1.4426950408889634f;
template <int MODE, bool DEFER = false>
__device__ __forceinline__ float n2_bias_mask(f32x16& S, int posbase, int t, int t0w, int h, int ncv, int ncv0, unsigned sb, bool before_cur, float b31, LAS const bf16_t* lutr, LAS const unsigned char* bkt, LAS const float* tblh) {
    bool farT, fullT;
    if (MODE == 0) { farT = (t0w - (16 * (posbase + 31) + 31)) >= 1513; fullT = (posbase + 31) < ncv0; }
    else if (MODE == 1) { farT = (t0w - (posbase + 31)) >= 1513; fullT = before_cur; }
    else { farT = false; fullT = (posbase + 31 <= t0w) && ((t0w + 7 - posbase) < 512); }
    float cbu = b31;
    if (MODE != 0 && fullT && !farT) { const int b0 = (int)bkt[min(t0w - (posbase + 31), 2048)], b1 = (int)bkt[min(t0w + 7 - posbase, 2048)];
        if (b0 == b1) { farT = true; cbu = tblh[b0 * 32] * LOG2E; } }
    if (farT && fullT) {
        if (MODE == 1 && sb == 0u) {
#pragma unroll
            for (int reg = 0; reg < 16; ++reg) S[reg] = N2_MASKED;
            return 0.f; }
        if (DEFER) return cbu;
#pragma unroll
        for (int reg = 0; reg < 16; ++reg) S[reg] = S[reg] + cbu;
    } else {
#pragma unroll
        for (int reg = 0; reg < 16; ++reg) { const int pos = posbase + (reg & 7) + 8 * h + 16 * (reg >> 3);
            const int dist = (MODE == 0) ? (t - (16 * pos + 31)) : (t - pos);
            bool v;
            if (MODE == 0) v = pos < ncv; else if (MODE == 1) v = (sb != 0u) && (pos <= t); else v = (pos <= t) && (dist < 512);
            const float bias = bf2f(lutr[min(max(dist, 0), 2047)]);
            S[reg] = v ? (S[reg] + bias) : N2_MASKED; }
    }
    return 0.f;
}
__device__ __forceinline__ float n2_tilemax(const f32x16& S) {
    float a = fmax_fast(S[0], S[1]), b = fmax_fast(S[2], S[3]), c = fmax_fast(S[4], S[5]), d = fmax_fast(S[6], S[7]);
    float e = fmax_fast(S[8], S[9]), f = fmax_fast(S[10], S[11]), g = fmax_fast(S[12], S[13]), hh = fmax_fast(S[14], S[15]);
    a = fmax_fast(a, b); c = fmax_fast(c, d); e = fmax_fast(e, f); g = fmax_fast(g, hh); a = fmax_fast(a, c); e = fmax_fast(e, g); return fmax_fast(a, e);
}
__device__ __forceinline__ void n2_stat(const f32x16& S, float& m, float& Z) {
    const float mn = fmax_fast(m, n2_tilemax(S));
    float z = 0.f;
#pragma unroll
    for (int i = 0; i < 16; ++i) z += __builtin_amdgcn_exp2f(S[i] - mn);
    Z = Z * __builtin_amdgcn_exp2f(m - mn) + z; m = mn;
}
__device__ __forceinline__ void n2_combine(float& m, float& Z) {
    float ma = m, mb = m; swap32f(ma, mb); const float M = fmax_fast(ma, mb);
    Z = xsum32(Z * __builtin_amdgcn_exp2f(m - M)); m = M;
}
enum { N2_STATS = 0, N2_IMPP = 1, N2_PV = 2, N2_ONLINE = 3, N2_IMPV = 4 };
struct N2Lane { int t, t0w, h, rho, qq, rr, lane, ncv, ncv0, ncv7, cur; float b31; LAS const bf16_t* lutr; LAS const unsigned char* bkt; LAS const float* tblh; };
template <int MODE, int PASS>
__device__ __forceinline__ void n2_branch(const Ctx& C, int g, LAS const unsigned short* list, int n, const N2Lane& L, const bf16x8 (&Bq)[8], f32x16 (&O)[4],
                                          float& m, float& Z, float scale, LAS const unsigned* selq, LAS float* impw, float scale2 = 1.f) {
    if (n <= 0) return;
    constexpr bool withV = (PASS == N2_PV || PASS == N2_ONLINE || PASS == N2_IMPV);
    constexpr int NSL = (PASS == N2_IMPV) ? 2 : 4, LA = NSL - 1;
    N2Src src;
    if (MODE == 0) { src.kbase = (const bf16_t*)(C.ws + WS_KCMP) + (size_t)g * 1024 * 128; src.kld = 128; src.krmax = 1023; src.vT = (const bf16_t*)(C.ws + WS_VCMPT) + (size_t)g * 128 * 1024; src.vld = 1024; }
    else if (MODE == 1) { src.kbase = (const bf16_t*)(C.ws + WS_KSC) + (size_t)g * T * 128; src.kld = 128; src.krmax = T - 1; src.vT = (const bf16_t*)(C.ws + WS_VST) + (size_t)g * 128 * T; src.vld = (size_t)T; }
    else { src.kbase = (const bf16_t*)(C.ws + WS_KWC) + (size_t)g * T * 128; src.kld = 128; src.krmax = T - 1; src.vT = (const bf16_t*)(C.ws + WS_VWT) + (size_t)g * 128 * T; src.vld = (size_t)T; }
    LAS unsigned char* lds = C.lds;
#define N2_KSLOT(s_) (withV ? (((s_) < 2) ? (N2_KS + (s_) * 16384) : (N2_IMP + ((s_) - 2) * 32768)) : (N2_KS + (s_) * 16384))
#define N2_VSLOT(s_) (((s_) < 2) ? (N2_VS + (s_) * 16384) : (N2_IMP + ((s_) - 2) * 32768 + 16384))
#define N2_RAW_BARRIER() do { asm volatile("s_waitcnt lgkmcnt(0)" ::: "memory"); __builtin_amdgcn_s_barrier(); asm volatile("" ::: "memory"); } while (0)
#define N2_WAIT_LANDED() do { if (LA == 1) asm volatile("s_waitcnt vmcnt(0)" ::: "memory"); else if (withV) asm volatile("s_waitcnt vmcnt(8)" ::: "memory"); else asm volatile("s_waitcnt vmcnt(4)" ::: "memory"); } while (0)
#pragma unroll
    for (int j = 0; j < LA; ++j) if (j < n) n2_stage(src, (int)list[j], withV, lds + N2_KSLOT(j), lds + N2_VSLOT(j), C.wave, C.lane);
    if (n >= LA) N2_WAIT_LANDED(); else asm volatile("s_waitcnt vmcnt(0)" ::: "memory");
    N2_RAW_BARRIER();
#pragma unroll 1
    for (int i = 0; i < n; ++i) {
        const int mb = (int)list[i];
        if (i + LA < n) { const int sl = (i + LA) & (NSL - 1); n2_stage(src, (int)list[i + LA], withV, lds + N2_KSLOT(sl), lds + N2_VSLOT(sl), C.wave, C.lane); }
        LAS const unsigned char* kbuf = lds + N2_KSLOT(i & (NSL - 1)); LAS const unsigned char* vbuf = lds + N2_VSLOT(i & (NSL - 1));
        bool need; unsigned sb = 1u;
        if (MODE == 0) need = (64 * mb) < L.ncv7;
        else if (MODE == 1) { const unsigned sw = selq[mb >> 5]; sb = (sw >> (mb & 31)) & 1u; need = __ballot(sb != 0u) != 0ull; }
        else need = (64 * mb + 63 >= L.t0w - 511) && (64 * mb <= L.t0w + 7);
        if (need && PASS == N2_ONLINE) {
            f32x16 S0 = n2_qk(Bq, kbuf, 0, L.rho, L.h), S1 = n2_qk(Bq, kbuf, 1, L.rho, L.h);
            const float cb0 = n2_bias_mask<MODE, true>(S0, 64 * mb, L.t, L.t0w, L.h, L.ncv, L.ncv0, sb, mb < L.cur, L.b31, L.lutr, L.bkt, L.tblh);
            const float cb1 = n2_bias_mask<MODE, true>(S1, 64 * mb + 32, L.t, L.t0w, L.h, L.ncv, L.ncv0, sb, mb < L.cur, L.b31, L.lutr, L.bkt, L.tblh);
            const float tm = xmax32(fmax_fast(n2_tilemax(S0) + cb0, n2_tilemax(S1) + cb1));
            const float mn = fmax_fast(m, tm);
            if (__ballot(mn > m + 8.f)) { const float al = __builtin_amdgcn_exp2f(m - mn); Z *= al;
#pragma unroll
                for (int dt = 0; dt < 4; ++dt)
#pragma unroll
                    for (int r = 0; r < 16; ++r) O[dt][r] *= al;
                m = mn; }
            { float p[16]; float zs = 0.f; const float c2 = cb0 - m;
#pragma unroll
              for (int r = 0; r < 16; ++r) { p[r] = __builtin_amdgcn_exp2f(S0[r] + c2); zs += p[r]; }
              Z += zs; n2_pv(O, p, vbuf, 0, L.lane); }
            { float p[16]; float zs = 0.f; const float c2 = cb1 - m;
#pragma unroll
              for (int r = 0; r < 16; ++r) { p[r] = __builtin_amdgcn_exp2f(S1[r] + c2); zs += p[r]; }
              Z += zs; n2_pv(O, p, vbuf, 1, L.lane); }
        } else if (need && PASS == N2_STATS) {
            f32x16 S0 = n2_qk(Bq, kbuf, 0, L.rho, L.h), S1 = n2_qk(Bq, kbuf, 1, L.rho, L.h);
            n2_bias_mask<MODE>(S0, 64 * mb, L.t, L.t0w, L.h, L.ncv, L.ncv0, sb, mb < L.cur, L.b31, L.lutr, L.bkt, L.tblh);
            n2_bias_mask<MODE>(S1, 64 * mb + 32, L.t, L.t0w, L.h, L.ncv, L.ncv0, sb, mb < L.cur, L.b31, L.lutr, L.bkt, L.tblh);
            n2_stat(S0, m, Z); n2_stat(S1, m, Z);
        } else if (need) {
#pragma unroll 1
            for (int hf = 0; hf < 2; ++hf) {
                const int posbase = 64 * mb + 32 * hf;
                f32x16 S = n2_qk(Bq, kbuf, hf, L.rho, L.h);
                const float cbd = n2_bias_mask<MODE, PASS == N2_ONLINE>(S, posbase, L.t, L.t0w, L.h, L.ncv, L.ncv0, sb, mb < L.cur, L.b31, L.lutr, L.bkt, L.tblh);
                if (PASS == N2_STATS) { n2_stat(S, m, Z); }
                else if (PASS == N2_IMPP || PASS == N2_IMPV) {
                    float p[16];
#pragma unroll
                    for (int r = 0; r < 16; ++r) p[r] = __builtin_amdgcn_exp2f(S[r] - m) * scale;
#pragma unroll
                    for (int G = 0; G < 4; ++G) { float q4 = p[4 * G] + p[4 * G + 1] + p[4 * G + 2] + p[4 * G + 3], e = p[4 * G + 3];
                        q4 += dppf<0xB1>(q4); q4 += dppf<0x4E>(q4); e += dppf<0xB1>(e); e += dppf<0x4E>(e);
                        const int nb = posbase + ((4 * G) & 7) + 8 * L.h + 16 * ((4 * G) >> 3); const int mq = nb >> 2;
                        if (L.rr == 0) { __hip_atomic_fetch_add(impw + L.qq * 260 + mq, q4, __ATOMIC_RELAXED, __HIP_MEMORY_SCOPE_WORKGROUP);
                                         __hip_atomic_fetch_add(impw + L.qq * 260 + mq + 1, e, __ATOMIC_RELAXED, __HIP_MEMORY_SCOPE_WORKGROUP); } }
                    if (PASS == N2_IMPV) {
#pragma unroll
                        for (int r = 0; r < 16; ++r) p[r] *= scale2;
                        n2_pv(O, p, vbuf, hf, L.lane); }
                } else if (PASS == N2_PV) {
                    float p[16];
#pragma unroll
                    for (int r = 0; r < 16; ++r) p[r] = __builtin_amdgcn_exp2f(S[r] - m) * scale;
                    n2_pv(O, p, vbuf, hf, L.lane);
                } else {
                    const float tm = xmax32(n2_tilemax(S) + cbd);
                    const float mn = fmax_fast(m, tm);
                    if (__ballot(mn > m + 8.f)) { const float al = __builtin_amdgcn_exp2f(m - mn); Z *= al;
#pragma unroll
                        for (int dt = 0; dt < 4; ++dt)
#pragma unroll
                            for (int r = 0; r < 16; ++r) O[dt][r] *= al;
                        m = mn; }
                    float p[16]; float zs = 0.f;
                    const float c2 = cbd - m;
#pragma unroll
                    for (int r = 0; r < 16; ++r) { p[r] = __builtin_amdgcn_exp2f(S[r] + c2); zs += p[r]; }
                    Z += zs;
                    n2_pv(O, p, vbuf, hf, L.lane);
                }
            }
        }
        if (i + LA < n) N2_WAIT_LANDED(); else asm volatile("s_waitcnt vmcnt(0)" ::: "memory");
        N2_RAW_BARRIER();
    }
#undef N2_WAIT_LANDED
#undef N2_RAW_BARRIER
#undef N2_KSLOT
#undef N2_VSLOT
}

__device__ __forceinline__ void nsa2_item(const Ctx& C, int QB, int g) {
    LAS unsigned char* lds = C.lds;
    const int tid = C.tid, lane = C.lane, wave = C.wave;
    const int c = lane & 31, h = lane >> 5, qq = c >> 2, rr = c & 3;
    const int t0 = 64 * QB, t0w = t0 + 8 * wave, t = t0w + qq, head = 4 * g + rr;
    const bf16_t* proj = (const bf16_t*)(C.ws + WS_PROJ);
    LAS bf16_t* lut = (LAS bf16_t*)(lds + N2_LUT);
    LAS float* imp = (LAS float*)(lds + N2_IMP);
    LAS unsigned* selw = (LAS unsigned*)(lds + N2_SEL);
    LAS unsigned* uni = (LAS unsigned*)(lds + N2_UNI);
    LAS unsigned short* listC = (LAS unsigned short*)(lds + N2_LIST); LAS unsigned short* listS = listC + 256; LAS unsigned short* listW = listC + 512;
    LAS const unsigned char* bkt = lds + N2_BKT; LAS const float* tbl = (LAS const float*)(lds + N2_TBL);
    __syncthreads();
    for (int i = tid; i < 8192; i += NTHREADS) { const int r4 = i >> 11, d = i & 2047; lut[i] = f2bf(tbl[(int)bkt[d] * 32 + 16 + 4 * g + r4] * LOG2E); }
    for (int i = tid; i < 64 * 260; i += NTHREADS) imp[i] = 0.f;
    const int ncv_wg = (t0 + 63 >= 31) ? ((t0 + 63 - 31) >> 4) + 1 : 0; const int nC = (ncv_wg + 63) >> 6;
    const int wlo = max(t0 - 511, 0) >> 6; const int nW = QB - wlo + 1;
    if (tid < nC) listC[tid] = (unsigned short)tid;
    if (tid < nW) listW[tid] = (unsigned short)(wlo + tid);
    bf16x8 Bq[8];
#pragma unroll
    for (int kk = 0; kk < 8; ++kk) Bq[kk] = *(const bf16x8*)(proj + (size_t)t * NP + P_QB + 128 * head + 64 * h + 8 * kk);
    const float g0 = sigmoidf_(bf2f(proj[(size_t)t * NP + P_GB + 3 * head + 0]));
    const float g1 = sigmoidf_(bf2f(proj[(size_t)t * NP + P_GB + 3 * head + 1]));
    const float g2 = sigmoidf_(bf2f(proj[(size_t)t * NP + P_GB + 3 * head + 2]));
    f32x16 O[4];
#pragma unroll
    for (int dt = 0; dt < 4; ++dt)
#pragma unroll
        for (int i = 0; i < 16; ++i) O[dt][i] = 0.f;
    N2Lane L; L.t = t; L.t0w = t0w; L.h = h; L.rho = swap23(c); L.qq = qq; L.rr = rr; L.lane = lane;
    L.ncv = t >= 31 ? ((t - 31) >> 4) + 1 : 0; L.ncv0 = t0w >= 31 ? ((t0w - 31) >> 4) + 1 : 0; L.ncv7 = (t0w + 7 >= 31) ? ((t0w + 7 - 31) >> 4) + 1 : 0; L.cur = QB;
    L.b31 = tbl[31 * 32 + 16 + head] * LOG2E; L.lutr = lut + rr * 2048; L.bkt = bkt; L.tblh = tbl + 16 + head;
    LAS const unsigned* selq = selw + (wave * 8 + qq) * 8;
    LAS float* impw = imp + wave * 8 * 260;
    __syncthreads();
    float mC = N2_MINIT, ZC = 0.f;
    n2_branch<0, N2_STATS>(C, g, listC, nC, L, Bq, O, mC, ZC, 0.f, selq, impw);
    n2_combine(mC, ZC);
    const float invZC = 1.f / fmaxf(ZC, 1e-30f);
    n2_branch<0, N2_IMPV>(C, g, listC, nC, L, Bq, O, mC, ZC, invZC, selq, impw, g0);
#define N2_OACC() ({ unsigned to_ = (unsigned)tid; asm volatile("" : "+v"(to_)); (f32x4*)(C.ws + WS_OACC) + (size_t)blockIdx.x * 16 * 512 + to_; })
    f32x4* oacc = N2_OACC();
#pragma unroll
    for (int dt = 0; dt < 4; ++dt)
#pragma unroll
        for (int G = 0; G < 4; ++G) { oacc[(dt * 4 + G) * 512] = (f32x4){O[dt][4 * G], O[dt][4 * G + 1], O[dt][4 * G + 2], O[dt][4 * G + 3]}; O[dt][4 * G] = 0.f; O[dt][4 * G + 1] = 0.f; O[dt][4 * G + 2] = 0.f; O[dt][4 * G + 3] = 0.f; }
    lds_sync();
#pragma unroll 1
    for (int q8 = 0; q8 < 8; ++q8) {
        const int cur = QB;
        unsigned word = 0u;
        if (cur + 1 <= 16) { if (lane == 0) word = (1u << (cur + 1)) - 1u; }
        else {
            unsigned key[4];
#pragma unroll
            for (int i = 0; i < 4; ++i) { const int mblk = lane + 64 * i; const bool ok = mblk >= 1 && mblk <= cur - 2;
                key[i] = ok ? ((__float_as_uint(impw[q8 * 260 + mblk]) & 0xFFFFFF00u) | (unsigned)(255 - mblk)) : 0u; }
#pragma unroll 1
            for (int round = 0; round < 13; ++round) {
                unsigned lm = key[0] > key[1] ? key[0] : key[1]; const unsigned lm2 = key[2] > key[3] ? key[2] : key[3]; lm = lm > lm2 ? lm : lm2;
                const unsigned W = wave_maxu(lm);
#pragma unroll
                for (int i = 0; i < 4; ++i) if (key[i] == W) key[i] = 0u;
                const int mw = 255 - (int)(W & 0xFFu);
                if (W != 0u && lane == (mw >> 5)) word |= 1u << (mw & 31);
            }
            if (lane == 0) word |= 1u;
            if (lane == (cur >> 5)) word |= 1u << (cur & 31);
            if (lane == ((cur - 1) >> 5)) word |= 1u << ((cur - 1) & 31);
        }
        if (lane < 8) selw[(wave * 8 + q8) * 8 + lane] = word;
    }
    __syncthreads();
    if (tid < 8) { unsigned u = 0u; for (int q = 0; q < 64; ++q) u |= selw[q * 8 + tid]; uni[tid] = u; }
    __syncthreads();
    if (tid == 0) { int n = 0; for (int mblk = 0; mblk <= QB; ++mblk) if ((uni[mblk >> 5] >> (mblk & 31)) & 1u) listS[n++] = (unsigned short)mblk; uni[8] = (unsigned)n; }
    __syncthreads();
    const int nS = (int)uni[8];
    float mS = N2_MINIT, ZS = 0.f;
    n2_branch<1, N2_ONLINE>(C, g, listS, nS, L, Bq, O, mS, ZS, 0.f, selq, impw);
    { ZS = xsum32(ZS); const float sc = g1 / fmaxf(ZS, 1e-30f);
#pragma unroll
      for (int dt = 0; dt < 4; ++dt)
#pragma unroll
          for (int r = 0; r < 16; ++r) O[dt][r] *= sc; }
    oacc = N2_OACC();
#pragma unroll
    for (int dt = 0; dt < 4; ++dt)
#pragma unroll
        for (int G = 0; G < 4; ++G) { const f32x4 a = oacc[(dt * 4 + G) * 512];
            oacc[(dt * 4 + G) * 512] = (f32x4){O[dt][4 * G] + a[0], O[dt][4 * G + 1] + a[1], O[dt][4 * G + 2] + a[2], O[dt][4 * G + 3] + a[3]};
            O[dt][4 * G] = 0.f; O[dt][4 * G + 1] = 0.f; O[dt][4 * G + 2] = 0.f; O[dt][4 * G + 3] = 0.f; }
    float mW = N2_MINIT, ZW = 0.f;
    n2_branch<2, N2_ONLINE>(C, g, listW, nW, L, Bq, O, mW, ZW, 0.f, selq, impw);
    oacc = N2_OACC();
    { ZW = xsum32(ZW); const float sc = g2 / fmaxf(ZW, 1e-30f);
#pragma unroll
      for (int dt = 0; dt < 4; ++dt)
#pragma unroll
          for (int G = 0; G < 4; ++G) { const f32x4 a = oacc[(dt * 4 + G) * 512];
              O[dt][4 * G] = O[dt][4 * G] * sc + a[0]; O[dt][4 * G + 1] = O[dt][4 * G + 1] * sc + a[1]; O[dt][4 * G + 2] = O[dt][4 * G + 2] * sc + a[2]; O[dt][4 * G + 3] = O[dt][4 * G + 3] * sc + a[3]; } }
    unsigned char* yb = C.ws + WS_YB + (size_t)t * 2048 + head * 128;
#pragma unroll
    for (int dt = 0; dt < 4; ++dt)
#pragma unroll
        for (int G = 0; G < 4; ++G) { int p = __builtin_amdgcn_cvt_pk_fp8_f32(O[dt][4 * G] * 16.f, O[dt][4 * G + 1] * 16.f, 0, false); p = __builtin_amdgcn_cvt_pk_fp8_f32(O[dt][4 * G + 2] * 16.f, O[dt][4 * G + 3] * 16.f, p, true);
            *(unsigned*)(yb + dt * 32 + 8 * G + 4 * h) = (unsigned)p; }
}

#ifndef NREP_DSA
#define NREP_DSA 1
#endif
#ifndef NREP_NSA
#define NREP_NSA 1
#endif
__device__ __forceinline__ void p6_mixers(const Ctx& C, int which  , int crep = 0) {
    const Ctx& C0_ = C;
    unsigned* counter = (unsigned*)(C.ws + WS_CTL + CTL_CNT) + 128 * crep;
    static_assert(8 * P6_WAVE_LDS <= N2_BKT, "DSA per-wave LDS vs the shared bias tables");
    LAS unsigned char* bkt = C.lds + N2_BKT; LAS float* tbl = (LAS float*)(C.lds + N2_TBL);
    for (int d = C.tid; d <= 2048; d += NTHREADS) { int b;
        if (d < 16) b = d; else { b = 16 + (int)(logf((float)d / 16.f) / logf(128.f) * 16.f); b = b < 31 ? b : 31; }
        bkt[d] = (unsigned char)b; }
    for (int i = C.tid; i < 1024; i += NTHREADS) tbl[i] = C.in[I_RELB][i];
    __syncthreads();
    if (which != 1) {
        LAS int* slot = (LAS int*)(C.lds + N2_UNI + 48);
#pragma unroll 1
        for (int rep = 0; rep < NREP_NSA; ++rep)
        for (;;) {
            __syncthreads();
            if (C.tid == 0) *slot = (int)atomicAdd(counter + 64 + 128 * rep, 1u);
            __syncthreads();
            const int it = *slot;
            if (it >= 1024) break;
            nsa2_item(C, 255 - (it >> 2), it & 3);
#pragma unroll 1
            for (int c = 0; c < 3; ++c) { const int j = it + 1024 * c; if (j >= 2560) break;
                __syncthreads();
                Ctx C = C0_; { int t_ = threadIdx.x; asm volatile("" : "+v"(t_)); C.tid = t_; C.lane = t_ & 63; C.wave = __builtin_amdgcn_readfirstlane(t_ >> 6); }
                if (j < 512) tconv_tile_f8<false>(C, C.in[I_WBA], 4096, C.ws + WS_WBA, 2048, (j / 16) * 128, (j % 16) * 128);
                else if (j < 1024) { const int i = j - 512; tconv_tile_f8<false>(C, C.in[I_WBB], 4096, C.ws + WS_WBB, 2048, (i / 16) * 128, (i % 16) * 128); }
                else if (j < 2048) { const int i = j - 1024; tconv_tile_f8<false>(C, C.in[I_WOUT], 4096, C.ws + WS_WOUT, 4096, (i / 32) * 128, (i % 32) * 128); }
                else { const int i = j - 2048; wq_subkey_tile(C, i >> 5, (i & 31) * 128); } }
        }
        __syncthreads();
    }
    if (which != 2) {
        LAS unsigned char* wl = C.lds + C.wave * P6_WAVE_LDS;
#pragma unroll 1
        for (int rep = 0; rep < NREP_DSA; ++rep)
        for (;;) {
            int it = 0;
            if (C.lane == 0) it = (int)atomicAdd(counter + 128 * rep, 1u);
            it = __builtin_amdgcn_readfirstlane(it);
            if (it >= 8192) break;
            if (C.wave >= 4) __builtin_amdgcn_s_setprio(2);
            dsa_item(C, 8191 - it, wl, bkt, tbl, (rep < NREP_DSA - 1) ? DSA_PROBE_MODE : 0);
#pragma unroll 1
            for (int rr = 0; rr < 4; ++rr) peer_row_convert(C, 4 * it + rr, C.lane);
        }
        __builtin_amdgcn_s_setprio(0);
        __syncthreads();
    }
}

static __device__ const unsigned P12_IJ4[16] = {
    0xE0331000u, 0xF0401101u, 0xFF411202u, 0xFF421303u, 0xFF501404u, 0xFF511505u, 0xFF601606u, 0xFF611707u, 0xFF702008u, 0xFF712109u, 0xFF80220Au, 0xFF90230Bu, 0xFFA0240Cu, 0xFFB0300Du, 0xFFC0310Eu, 0xFFD0320Fu };
typedef __bf16 bf16x32_t __attribute__((ext_vector_type(32)));
typedef unsigned u32x16 __attribute__((ext_vector_type(16)));
typedef _Float16 h2_t __attribute__((ext_vector_type(2)));
typedef _Float16 h32_t __attribute__((ext_vector_type(32)));
__device__ __forceinline__ unsigned rowmax_u(unsigned v) { v = umaxu(v, dppu<0xB1>(v)); v = umaxu(v, dppu<0x4E>(v)); v = umaxu(v, dppu<0x141>(v)); v = umaxu(v, dppu<0x140>(v)); return v; }
__device__ __forceinline__ float rowmax_f(float v) { v = fmax_fast(v, dppf<0xB1>(v)); v = fmax_fast(v, dppf<0x4E>(v)); v = fmax_fast(v, dppf<0x141>(v)); v = fmax_fast(v, dppf<0x140>(v)); return v; }
__device__ __forceinline__ float rowsum_f(float v) { v += dppf<0xB1>(v); v += dppf<0x4E>(v); v += dppf<0x141>(v); v += dppf<0x140>(v); return v; }
#define P12_CE(a_, b_) do { const unsigned hi_ = umaxu(a_, b_), lo_ = (a_) < (b_) ? (a_) : (b_); a_ = hi_; b_ = lo_; } while (0)
__device__ __forceinline__ void p12_route(const bf16_t* srow, LAS float* tops, LAS int* topi, LAS unsigned short* exl, LAS float* gtl, int lane, unsigned ij4) {
    const int row = lane >> 4, l16 = lane & 15;
#pragma unroll 1
    for (int q = 0; q < 4; ++q) {
        const int p = 4 * q + row;
        const u32x4 raw = *(const u32x4*)(srow + p * 128 + 8 * l16);
        unsigned k[8];
#pragma unroll
        for (int e = 0; e < 8; ++e) { const unsigned bits = (e & 1) ? (raw[e >> 1] & 0xFFFF0000u) : (raw[e >> 1] << 16);
            k[e] = ((bits ^ ((bits >> 31) ? 0xFFFFFFFFu : 0x80000000u)) & 0xFFFFFF80u) | (unsigned)(127 - (8 * l16 + e)); }
        P12_CE(k[0], k[2]); P12_CE(k[1], k[3]); P12_CE(k[4], k[6]); P12_CE(k[5], k[7]);
        P12_CE(k[0], k[4]); P12_CE(k[1], k[5]); P12_CE(k[2], k[6]); P12_CE(k[3], k[7]);
        P12_CE(k[0], k[1]); P12_CE(k[2], k[3]); P12_CE(k[4], k[5]); P12_CE(k[6], k[7]);
        P12_CE(k[2], k[4]); P12_CE(k[3], k[5]);
        P12_CE(k[1], k[4]); P12_CE(k[3], k[6]);
        P12_CE(k[1], k[2]); P12_CE(k[3], k[4]); P12_CE(k[5], k[6]);
        unsigned myW = 0u;
#pragma unroll
        for (int r = 0; r < 16; ++r) {
            const unsigned W = rowmax_u(k[0]);
            const bool pop = k[0] == W;
#pragma unroll
            for (int e = 0; e < 7; ++e) k[e] = pop ? k[e + 1] : k[e];
            k[7] = pop ? 0u : k[7];
            myW = (l16 == r) ? W : myW;
        }
        const unsigned sb = myW & 0xFFFFFF80u;
        const unsigned bits = (sb & 0x80000000u) ? (sb ^ 0x80000000u) : ((~sb) & 0xFFFF0000u);
        tops[p * 16 + l16] = __uint_as_float(bits); topi[p * 16 + l16] = 127 - (int)(myW & 0x7Fu);
    }
    lds_sync();
#pragma unroll 1
    for (int q2 = 0; q2 < 2; ++q2) {
        const int hh = 4 * q2 + row;
        LAS const float* t1 = tops + (2 * hh) * 16; LAS const float* t2 = t1 + 16;
        unsigned k[4];
#pragma unroll
        for (int c = 0; c < 4; ++c) { const unsigned ij = (ij4 >> (8 * c)) & 0xFFu; const float cv = t1[ij >> 4] + t2[ij & 15u];
            k[c] = (ij != 0xFFu) ? ((sortable(cv) & 0xFFFFFF00u) | (255u - ij)) : 0u; }
        P12_CE(k[0], k[1]); P12_CE(k[2], k[3]); P12_CE(k[0], k[2]); P12_CE(k[1], k[3]); P12_CE(k[1], k[2]);
        unsigned myW = 0u;
#pragma unroll
        for (int r = 0; r < 16; ++r) {
            const unsigned W = rowmax_u(k[0]);
            const bool pop = k[0] == W;
            k[0] = pop ? k[1] : k[0]; k[1] = pop ? k[2] : k[1]; k[2] = pop ? k[3] : k[2]; k[3] = pop ? 0u : k[3];
            myW = (l16 == r) ? W : myW;
        }
        const unsigned flat = 255u - (myW & 0xFFu); const int ci = (int)(flat >> 4), cj = (int)(flat & 15u);
        const float cv = t1[ci] + t2[cj];
        const float ev = __expf(cv - rowmax_f(cv));
        const float es = rowsum_f(ev);
        exl[hh * 16 + l16] = (unsigned short)(topi[(2 * hh) * 16 + ci] * 128 + topi[(2 * hh + 1) * 16 + cj]);
        gtl[hh * 16 + l16] = ev * __builtin_amdgcn_rcpf(es);
    }
    lds_sync();
}
#undef P12_CE
__device__ __forceinline__ float gelu_fast(float x) { const float u = 0.7978845608028654f * (x + 0.044715f * x * x * x); const float e = __expf(2.f * u); return x - x * __builtin_amdgcn_rcpf(e + 1.f); }

#ifndef P12_HI
#define P12_HI 4
#endif
__device__ __forceinline__ void p12_peer(const Ctx& C, float* dst) {
    const bf16_t* pq = (const bf16_t*)(C.ws + WS_PQ);
    const bf16_t* h2 = (const bf16_t*)(C.ws + WS_H2);
    const float* gt2 = (const float*)(C.ws + WS_MOD) + 5 * D;
    const int lane = C.lane;
    LAS unsigned char* wl = C.lds + C.wave * 8192;
    LAS unsigned short* exl = (LAS unsigned short*)wl;
    LAS float* gtl = (LAS float*)(wl + 2048);
    LAS float* tops = (LAS float*)(wl + 6144);
    LAS int* topi = (LAS int*)(wl + 7168);
    const unsigned ij4 = P12_IJ4[lane & 15];
    const unsigned lo16 = 16u * (unsigned)lane; const unsigned char* pu6 = C.ws + WS_PU; const unsigned char* pv6 = C.ws + WS_PV;
    const float* su = (const float*)(C.ws + WS_PU + 96 * MB); const float* sv = (const float*)(C.ws + WS_PV + 96 * MB);
    const unsigned char* pu4 = C.ws + WS_PU4; const unsigned char* pv4 = C.ws + WS_PV4;
    const int tstride = gridDim.x * 8;
    for (int tb = blockIdx.x * 8 + C.wave; tb < T; tb += 8 * tstride) {
        int nb = 0;
#pragma unroll 1
        for (int s = 0; s < 8; ++s) { if (tb + s * tstride >= T) break; ++nb; }
        p12_route(pq + (size_t)tb * 2048, tops, topi, exl, gtl, lane, ij4);
        const int nflat = nb * 128;
        u32x4 UA[3], VA[3], UB[3], VB[3], UC[3], VC[3], UD[3], VD[3]; float suA, svA, suB, svB, suC, svC, suD, svD;
#define P12_FMT(idx_) ((((idx_) & 15) < P12_HI) ? 6 : 4)
#define P12_LOAD(S, idx_, fmt_) do { const int e_ = __builtin_amdgcn_readfirstlane((int)exl[(idx_) < nflat ? (idx_) : nflat - 1]); \
        if ((fmt_) == 6) { const unsigned char* pu_ = pu6 + (size_t)e_ * 3072 + lo16; const unsigned char* pv_ = pv6 + (size_t)e_ * 3072 + lo16; \
            U##S[0] = *(const u32x4*)pu_; U##S[1] = *(const u32x4*)(pu_ + 1024); U##S[2] = *(const u32x4*)(pu_ + 2048); \
            V##S[0] = *(const u32x4*)pv_; V##S[1] = *(const u32x4*)(pv_ + 1024); V##S[2] = *(const u32x4*)(pv_ + 2048); su##S = su[e_]; sv##S = sv[e_]; } \
        else { const unsigned char* pu_ = pu4 + (size_t)e_ * 2304; const unsigned char* pv_ = pv4 + (size_t)e_ * 2048; \
            U##S[0] = *(const u32x4*)(pu_ + lo16); U##S[1] = *(const u32x4*)(pu_ + 1024 + lo16); const unsigned sw_ = *(const unsigned*)(pu_ + 2048 + 4 * lane); su##S = bflo(sw_); sv##S = bfhi(sw_); \
            V##S[0] = *(const u32x4*)(pv_ + lo16); V##S[1] = *(const u32x4*)(pv_ + 1024 + lo16); } } while (0)
#define P12_U4(w_, hh_, j_) do { \
        a0_ = dot2bf(__builtin_bit_cast(unsigned, __builtin_amdgcn_cvt_scalef32_pk_bf16_fp4((w_), 1.0f, 0)), hh_[(j_)], a0_); a1_ = dot2bf(__builtin_bit_cast(unsigned, __builtin_amdgcn_cvt_scalef32_pk_bf16_fp4((w_), 1.0f, 1)), hh_[(j_) + 1], a1_); \
        a2_ = dot2bf(__builtin_bit_cast(unsigned, __builtin_amdgcn_cvt_scalef32_pk_bf16_fp4((w_), 1.0f, 2)), hh_[(j_) + 2], a2_); a3_ = dot2bf(__builtin_bit_cast(unsigned, __builtin_amdgcn_cvt_scalef32_pk_bf16_fp4((w_), 1.0f, 3)), hh_[(j_) + 3], a3_); } while (0)
#define P12_V4(w_, oo_, j_) do { \
        oo_[(j_)] = act2_ * __builtin_amdgcn_cvt_scalef32_pk_f16_fp4((w_), 1.0f, 0) + oo_[(j_)]; oo_[(j_) + 1] = act2_ * __builtin_amdgcn_cvt_scalef32_pk_f16_fp4((w_), 1.0f, 1) + oo_[(j_) + 1]; \
        oo_[(j_) + 2] = act2_ * __builtin_amdgcn_cvt_scalef32_pk_f16_fp4((w_), 1.0f, 2) + oo_[(j_) + 2]; oo_[(j_) + 3] = act2_ * __builtin_amdgcn_cvt_scalef32_pk_f16_fp4((w_), 1.0f, 3) + oo_[(j_) + 3]; } while (0)
#define P12_COMPUTE(S, idx_, fmt_) do { float a0_ = 0.f, a1_ = 0.f, a2_ = 0.f, a3_ = 0.f; \
        if ((fmt_) == 6) { \
            const u32x16 ua_ = __builtin_bit_cast(u32x16, __builtin_amdgcn_cvt_scalef32_pk32_bf16_fp6((u32x6){U##S[0].x, U##S[0].y, U##S[0].z, U##S[0].w, U##S[1].x, U##S[1].y}, 1.0f)); \
            const u32x16 ub_ = __builtin_bit_cast(u32x16, __builtin_amdgcn_cvt_scalef32_pk32_bf16_fp6((u32x6){U##S[1].z, U##S[1].w, U##S[2].x, U##S[2].y, U##S[2].z, U##S[2].w}, 1.0f)); \
            _Pragma("unroll") for (int j = 0; j < 16; j += 4) { a0_ = dot2bf(ua_[j], hA[j], a0_); a1_ = dot2bf(ua_[j + 1], hA[j + 1], a1_); a2_ = dot2bf(ua_[j + 2], hA[j + 2], a2_); a3_ = dot2bf(ua_[j + 3], hA[j + 3], a3_); } \
            _Pragma("unroll") for (int j = 0; j < 16; j += 4) { a0_ = dot2bf(ub_[j], hB[j], a0_); a1_ = dot2bf(ub_[j + 1], hB[j + 1], a1_); a2_ = dot2bf(ub_[j + 2], hB[j + 2], a2_); a3_ = dot2bf(ub_[j + 3], hB[j + 3], a3_); } \
            const float a_ = wave_sum((a0_ + a1_) + (a2_ + a3_)) * su##S; \
            const float act_ = gelu_fast(a_) * gtl[idx_] * sv##S; const h2_t act2_ = {(_Float16)act_, (_Float16)act_}; \
            const h32_t va_ = __builtin_amdgcn_cvt_scalef32_pk32_f16_fp6((u32x6){V##S[0].x, V##S[0].y, V##S[0].z, V##S[0].w, V##S[1].x, V##S[1].y}, 1.0f); \
            _Pragma("unroll") for (int j = 0; j < 16; ++j) oA[j] = act2_ * (h2_t){va_[2 * j], va_[2 * j + 1]} + oA[j]; \
            const h32_t vb_ = __builtin_amdgcn_cvt_scalef32_pk32_f16_fp6((u32x6){V##S[1].z, V##S[1].w, V##S[2].x, V##S[2].y, V##S[2].z, V##S[2].w}, 1.0f); \
            _Pragma("unroll") for (int j = 0; j < 16; ++j) oB[j] = act2_ * (h2_t){vb_[2 * j], vb_[2 * j + 1]} + oB[j]; \
        } else { \
            P12_U4(U##S[0].x, hA, 0); P12_U4(U##S[0].y, hA, 4); P12_U4(U##S[0].z, hA, 8); P12_U4(U##S[0].w, hA, 12); \
            P12_U4(U##S[1].x, hB, 0); P12_U4(U##S[1].y, hB, 4); P12_U4(U##S[1].z, hB, 8); P12_U4(U##S[1].w, hB, 12); \
            const float a_ = wave_sum(((a0_ + a1_) + (a2_ + a3_)) * su##S); \
            const float act_ = gelu_fast(a_) * gtl[idx_] * sv##S; const h2_t act2_ = {(_Float16)act_, (_Float16)act_}; \
            P12_V4(V##S[0].x, oA, 0); P12_V4(V##S[0].y, oA, 4); P12_V4(V##S[0].z, oA, 8); P12_V4(V##S[0].w, oA, 12); \
            P12_V4(V##S[1].x, oB, 0); P12_V4(V##S[1].y, oB, 4); P12_V4(V##S[1].z, oB, 8); P12_V4(V##S[1].w, oB, 12); } } while (0)
        P12_LOAD(A, 0, P12_FMT(0)); P12_LOAD(B, 1, P12_FMT(1)); P12_LOAD(C, 2, P12_FMT(2)); P12_LOAD(D, 3, P12_FMT(3));
#pragma unroll 1
        for (int s = 0; s < nb; ++s) {
            const int t = tb + s * tstride;
            if (s + 1 < nb) p12_route(pq + (size_t)(t + tstride) * 2048, tops, topi, exl + (s + 1) * 128, gtl + (s + 1) * 128, lane, ij4);
            unsigned hA[16], hB[16];
            { u32x4 ra[4], rb[4];
#pragma unroll
              for (int i = 0; i < 4; ++i) { ra[i] = *(const u32x4*)(h2 + (size_t)t * D + 16 * lane + 1024 * i); rb[i] = *(const u32x4*)(h2 + (size_t)t * D + 16 * lane + 1024 * i + 8); }
#pragma unroll
              for (int q = 0; q < 4; ++q) {
                  hA[2 * q] = __builtin_amdgcn_perm(ra[1][q], ra[0][q], 0x05040100u); hA[2 * q + 1] = __builtin_amdgcn_perm(ra[1][q], ra[0][q], 0x07060302u);
                  hA[8 + 2 * q] = __builtin_amdgcn_perm(rb[1][q], rb[0][q], 0x05040100u); hA[8 + 2 * q + 1] = __builtin_amdgcn_perm(rb[1][q], rb[0][q], 0x07060302u);
                  hB[2 * q] = __builtin_amdgcn_perm(ra[3][q], ra[2][q], 0x05040100u); hB[2 * q + 1] = __builtin_amdgcn_perm(ra[3][q], ra[2][q], 0x07060302u);
                  hB[8 + 2 * q] = __builtin_amdgcn_perm(rb[3][q], rb[2][q], 0x05040100u); hB[8 + 2 * q + 1] = __builtin_amdgcn_perm(rb[3][q], rb[2][q], 0x07060302u); } }
            h2_t oA[16], oB[16];
#pragma unroll
            for (int j = 0; j < 16; ++j) { oA[j] = (h2_t){(_Float16)0.f, (_Float16)0.f}; oB[j] = (h2_t){(_Float16)0.f, (_Float16)0.f}; }
#pragma unroll 1
            for (int hh = 0; hh < 8; ++hh) {
                const int f0 = s * 128 + hh * 16;
#pragma unroll
                for (int k = 0; k < 16; k += 4) {
                    P12_COMPUTE(A, f0 + k, P12_FMT(k)); P12_LOAD(A, f0 + k + 4, P12_FMT(k + 4));
                    P12_COMPUTE(B, f0 + k + 1, P12_FMT(k + 1)); P12_LOAD(B, f0 + k + 5, P12_FMT(k + 5));
                    P12_COMPUTE(C, f0 + k + 2, P12_FMT(k + 2)); P12_LOAD(C, f0 + k + 6, P12_FMT(k + 6));
                    P12_COMPUTE(D, f0 + k + 3, P12_FMT(k + 3)); P12_LOAD(D, f0 + k + 7, P12_FMT(k + 7));
                }
            }
#pragma unroll
            for (int i = 0; i < 4; ++i) { const int d0 = 16 * lane + 1024 * i; const float* op = C.out + (size_t)t * D + d0; float* dp = dst + (size_t)t * D + d0;
#pragma unroll
                for (int q = 0; q < 4; ++q) { const f32x4 xv = *(const f32x4*)(op + 4 * q); const f32x4 gv = *(const f32x4*)(gt2 + d0 + 4 * q); f32x4 r;
#pragma unroll
                    for (int j = 0; j < 4; ++j) { const h2_t ov = (i < 2) ? oA[4 * q + j] : oB[4 * q + j]; r[j] = xv[j] + gv[j] * ((i & 1) ? (float)ov.y : (float)ov.x); }
                    __builtin_nontemporal_store(r, (f32x4*)(dp + 4 * q)); } }
        }
#undef P12_U4
#undef P12_V4
#undef P12_FMT
#undef P12_LOAD
#undef P12_COMPUTE
        lds_sync();
    }
}

constexpr int N_PHASES = 13;
#ifndef DBG_MIX
#define DBG_MIX 0
#endif
__global__ void __launch_bounds__(NTHREADS, 2) fwd(Args args) {
    extern __shared__ __attribute__((aligned(16))) unsigned char lds_raw[];
    Ctx C0; C0.in = args.in; C0.out = args.out; C0.ws = args.ws; C0.lds = (LAS unsigned char*)lds_raw;
    C0.tid = threadIdx.x; C0.lane = C0.tid & 63; C0.wave = __builtin_amdgcn_readfirstlane(C0.tid >> 6);
#define PHASE_CTX() Ctx C = C0; { int t_ = threadIdx.x; asm volatile("" : "+v"(t_)); C.tid = t_; C.lane = t_ & 63; C.wave = __builtin_amdgcn_readfirstlane(t_ >> 6); }
    const Ctx& C = C0;
    const int lo = args.ph_lo, hi = args.ph_hi;
    const bool fused = (hi - lo) > 1;
    volatile LAS unsigned* bst = (volatile LAS unsigned*)(C.lds + LDS_BYTES - 16);
    XcdBarrier bar; bar.bar = (unsigned*)(C.ws + WS_CTL + CTL_BAR); bar.x = 0; bar.st = bst;
    if (fused) { if (C.tid == 0) { bst[0] = 0u; bst[1] = 0u; bst[2] = 0u; bst[3] = 0u; } __syncthreads(); bar = xcd_barrier_post((unsigned*)(C.ws + WS_CTL + CTL_BAR), bst); }
#ifndef ONLY_PHASE
#define ONLY_PHASE -1
#endif
#define IN(k) (lo <= (k) && (k) < hi && (ONLY_PHASE < 0 || ONLY_PHASE == (k)))
#ifndef REP_PHASE
#define REP_PHASE -1
#endif
#define REP(k, ...) if (REP_PHASE == (k)) { __VA_ARGS__ }
#define SEAM(k) do { if (IN(k) && IN((k) + 1)) xcd_barrier(bar); } while (0)
    const float* mod = (const float*)(C.ws + WS_MOD);
    bf16_t* proj = (bf16_t*)(C.ws + WS_PROJ);
    if (IN(0)) { PHASE_CTX(); REP(0, p0_prologue(C); __syncthreads();) p0_prologue(C); } SEAM(0);
    if (IN(1)) { PHASE_CTX(); norm_mod_phase(C, C.in[I_X], C.in[I_GMIX], mod + 0 * D, mod + 1 * D, (bf16_t*)(C.ws + WS_H), C.ws + WS_H8); } SEAM(1);
    if (IN(2)) { PHASE_CTX(); pg8::Gemm g{(const bf16_t*)(C.ws + WS_H), (const bf16_t*)(C.ws + WS_WIN), T, NP_BF, D, D, D}; pg8::StaticOrder S; S.init(T, NP_BF, gridDim.x, blockIdx.x);
                 pg8::EpiPlain E{proj, NP, 1.f}; pg8::gemm_phase(C.lds, g, S, E);
                 pg8::Gemm g8{(const bf16_t*)(C.ws + WS_H8), (const bf16_t*)(C.ws + WS_WIN8), T, NP_F8, D / 2, D / 2, D / 2}; pg8::Fp8Order S8{(int)blockIdx.x};
                 pg8::EpiSigU8 E8{(unsigned char*)(proj + P_GM), NP * 2, 1.f / 64.f}; pg8::gemm_phase<pg8::EpiSigU8, pg8::Fp8Order, true>(C.lds, g8, S8, E8); } SEAM(2);
    if (IN(3)) { PHASE_CTX(); p3_post(C); } SEAM(3);
    if (IN(4)) { PHASE_CTX(); pg8::Gemm g{(const bf16_t*)(C.ws + WS_KC), (const bf16_t*)(C.ws + WS_W1T), 8192, 512, 512, 2048, D}; pg8::CmpOrder S{(int)gridDim.x, (int)blockIdx.x};
                 pg8::EpiSlab E{(float*)(C.ws + WS_HIDP)}; pg8::gemm_phase(C.lds, g, S, E); } SEAM(4);
    if (IN(5)) { PHASE_CTX(); p5_cmp_out(C); } SEAM(5);
    if (IN(6)) { PHASE_CTX(); p6_mixers(C, DBG_MIX); } SEAM(6);
    if (IN(7)) { PHASE_CTX(); pg8::Gemm g{(const bf16_t*)(C.ws + WS_YA), (const bf16_t*)(C.ws + WS_WBA), T, D, 1024, 1024, 1024};   pg8::StaticOrder S; S.init(T, D, gridDim.x, blockIdx.x);
                 pg8::EpiGate<0> E{(bf16_t*)(C.ws + WS_MERGED), D, (const unsigned char*)(proj + P_GM), NP * 2, 1.f / (16.f * 64.f * 255.f), nullptr}; pg8::gemm_phase<pg8::EpiGate<0>, pg8::StaticOrder, true>(C.lds, g, S, E); } if (IN(7) && IN(8)) __syncthreads();
    if (IN(8)) { PHASE_CTX(); pg8::Gemm g{(const bf16_t*)(C.ws + WS_YB), (const bf16_t*)(C.ws + WS_WBB), T, D, 1024, 1024, 1024}; pg8::StaticOrder S; S.init(T, D, gridDim.x, blockIdx.x);
                 pg8::EpiGate<1> E{(bf16_t*)(C.ws + WS_MERGED), D, (const unsigned char*)(proj + P_GM) + 4096, NP * 2, 1.f / (16.f * 64.f * 255.f), C.ws + WS_H8}; pg8::gemm_phase<pg8::EpiGate<1>, pg8::StaticOrder, true>(C.lds, g, S, E); } SEAM(8);
    if (IN(9)) { PHASE_CTX(); pg8::Gemm g{(const bf16_t*)(C.ws + WS_H8), (const bf16_t*)(C.ws + WS_WOUT), T, D, D / 2, D / 2, D / 2};   pg8::StaticOrder S; S.init(T, D, gridDim.x, blockIdx.x);
                 pg8::EpiResid E{C.out, C.in[I_X], mod + 2 * D, D, 1.f / (32.f * 64.f)}; pg8::gemm_phase<pg8::EpiResid, pg8::StaticOrder, true>(C.lds, g, S, E); } SEAM(9);
    if (IN(10)) { PHASE_CTX(); norm_mod_phase(C, C.out, C.in[I_GFFN], mod + 3 * D, mod + 4 * D, (bf16_t*)(C.ws + WS_H2)); } SEAM(10);
    if (IN(11)) { PHASE_CTX(); pg8::Gemm g{(const bf16_t*)(C.ws + WS_H2), (const bf16_t*)(C.ws + WS_WQ), T, 2048, D, D, D}; pg8::StaticOrder S; S.init(T, 2048, gridDim.x, blockIdx.x);
                  pg8::EpiPlain E{(bf16_t*)(C.ws + WS_PQ), 2048, 1.f}; pg8::gemm_phase(C.lds, g, S, E); } SEAM(11);
    if (IN(12)) { PHASE_CTX(); REP(12, p12_peer(C, (float*)(C.ws + WS_PROJ)); __syncthreads();) p12_peer(C, C.out); }
#undef IN
#undef SEAM
}

#ifndef N_LAUNCH_MODE
#define N_LAUNCH_MODE 1
#endif
extern "C" void kernel_launch(void* const* d_in, const int* in_sizes, int n_in, void* d_out, int out_size, void* d_ws, size_t ws_size, hipStream_t stream) {
    static int grid = 0;
    if (grid == 0) {
        if (n_in != 27 || out_size != T * D || ws_size < WS_END) { fprintf(stderr, "kernel_launch: unexpected shapes (n_in %d out %d ws %zu need %zu)\n", n_in, out_size, ws_size, (size_t)WS_END); grid = -1; return; }
        int dev = 0, cus = 0;
        if (hipGetDevice(&dev) != hipSuccess || hipDeviceGetAttribute(&cus, hipDeviceAttributeMultiprocessorCount, dev) != hipSuccess) { grid = -1; return; }
        if (hipFuncSetAttribute((const void*)fwd, hipFuncAttributeMaxDynamicSharedMemorySize, LDS_BYTES) != hipSuccess) { fprintf(stderr, "kernel_launch: hipFuncSetAttribute failed\n"); grid = -1; return; }
        int per_cu = 0;
        if (hipOccupancyMaxActiveBlocksPerMultiprocessor(&per_cu, (const void*)fwd, NTHREADS, LDS_BYTES) != hipSuccess || per_cu < 1) { fprintf(stderr, "kernel_launch: occupancy query says %d\n", per_cu); }
        (void)hipGetLastError();
        grid = cus;
    }
    if (grid < 0) return;
    (void)hipMemsetAsync((char*)d_ws + WS_CTL, 0, 64 * 1024, stream);
    Args a{};
    for (int i = 0; i < 27; ++i) a.in[i] = (const float*)d_in[i];
    a.out = (float*)d_out; a.ws = (unsigned char*)d_ws;
#if N_LAUNCH_MODE == 1
    a.ph_lo = 0; a.ph_hi = N_PHASES;
    hipLaunchKernelGGL(fwd, dim3(grid), dim3(NTHREADS), LDS_BYTES, stream, a);
#else
    for (int p = 0; p < N_PHASES; ++p) { a.ph_lo = p; a.ph_hi = p + 1; hipLaunchKernelGGL(fwd, dim3(grid), dim3(NTHREADS), LDS_BYTES, stream, a); }
#endif
}
```
